# Optimizing an MI355X kernel written in HIP

```python
import math
import jax, jax.numpy as jnp
from jax import lax
import numpy as np

D_MODEL = 1024
BATCH = 1
SEQ = 16384
DEPTH = 1

D_MIX = D_MODEL
MLA_HEADS = 8
MLA_NOPE = 64
MLA_ROPE = 32
MLA_V = 64
MLA_Q_RANK = 384
MLA_KV_RANK = 256
ROPE_BASE = 10000.0
MOBA_HEADS = 8
MOBA_HEAD_DIM = 64
MOBA_BLOCK = 256
MOBA_TOPK = 3
Q_BLOCK = 128
D_FF = 2816
FFN_RES = 0.5
EPS = 1e-6
NEG_INF = -1e30

IN_SPLITS = (MLA_Q_RANK, MLA_KV_RANK, MLA_ROPE,
             MOBA_HEADS * MOBA_HEAD_DIM, MOBA_HEADS * MOBA_HEAD_DIM, MOBA_HEADS * MOBA_HEAD_DIM)
D_IN = sum(IN_SPLITS)
D_CAT = MLA_HEADS * MLA_V + MOBA_HEADS * MOBA_HEAD_DIM

kernel_name = "hybrid_mla_moba_macaron"


def rms_norm(x, g):
    xf = x.astype(jnp.float32)
    y = xf * lax.rsqrt(jnp.mean(xf * xf, axis=-1, keepdims=True) + EPS)
    return (y * g.astype(jnp.float32)).astype(x.dtype)


def swiglu(x, w_gate, w_up, w_down):
    return (jax.nn.silu(x @ w_gate) * (x @ w_up)) @ w_down


def apply_rope(x, pos):
    r = x.shape[-1]
    half = r // 2
    inv = jnp.power(ROPE_BASE, -jnp.arange(half, dtype=jnp.float32) * 2.0 / r)
    ang = pos.astype(jnp.float32)[:, :, None, None] * inv
    cos, sin = jnp.cos(ang), jnp.sin(ang)
    xf = x.astype(jnp.float32)
    x1, x2 = xf[..., :half], xf[..., half:]
    out = jnp.concatenate([x1 * cos - x2 * sin, x1 * sin + x2 * cos], axis=-1)
    return out.astype(x.dtype)


def alibi_slopes(n_heads):
    return jnp.exp2(-8.0 * jnp.arange(1, n_heads + 1, dtype=jnp.float32) / n_heads)


def mla_attention(c_q, c_kv, k_rope, pos, q_norm, w_uq, kv_norm, w_ukv):
    B, S, _ = c_q.shape
    H = MLA_HEADS
    q = (rms_norm(c_q, q_norm) @ w_uq).reshape(B, S, H, MLA_NOPE + MLA_ROPE)
    q = jnp.concatenate([q[..., :MLA_NOPE], apply_rope(q[..., MLA_NOPE:], pos)], axis=-1)
    kv = (rms_norm(c_kv, kv_norm) @ w_ukv).reshape(B, S, H, MLA_NOPE + MLA_V)
    k_nope, v = kv[..., :MLA_NOPE], kv[..., MLA_NOPE:]
    k_r = apply_rope(k_rope[:, :, None, :], pos)
    k = jnp.concatenate([k_nope, jnp.broadcast_to(k_r, (B, S, H, MLA_ROPE))], axis=-1)
    scale = (MLA_NOPE + MLA_ROPE) ** -0.5
    key_idx = jnp.arange(S)

    def one_block(start):
        qb = lax.dynamic_slice_in_dim(q, start, Q_BLOCK, axis=1)
        s = jnp.einsum('bqhd,bkhd->bhqk', qb, k).astype(jnp.float32) * scale
        q_idx = start + jnp.arange(Q_BLOCK)
        s = jnp.where(key_idx[None, :] <= q_idx[:, None], s, NEG_INF)
        p = jax.nn.softmax(s, axis=-1).astype(v.dtype)
        return jnp.einsum('bhqk,bkhd->bqhd', p, v)

    out = lax.map(one_block, jnp.arange(0, S, Q_BLOCK))
    return jnp.moveaxis(out, 0, 1).reshape(B, S, H * MLA_V)


def moba_attention(q, k, v, pos):
    B, S, H, D = q.shape
    L = MOBA_BLOCK
    NB = -(-S // L)
    pad = NB * L - S
    kp = jnp.pad(k, ((0, 0), (0, pad), (0, 0), (0, 0)))
    vp = jnp.pad(v, ((0, 0), (0, pad), (0, 0), (0, 0)))
    pp = jnp.pad(pos, ((0, 0), (0, pad)))
    k_sel = min(MOBA_TOPK, NB)
    scale = D ** -0.5
    slopes = alibi_slopes(H)
    kb = kp.reshape(B, NB, L, H, D)
    k_mean = jnp.mean(kb.astype(jnp.float32), axis=2).astype(k.dtype)
    kb_h = kb.transpose(0, 3, 1, 2, 4)
    vb_h = vp.reshape(B, NB, L, H, D).transpose(0, 3, 1, 2, 4)
    pos_b = pp.reshape(B, NB, L)
    bi = jnp.arange(B)[:, None, None, None]
    hi = jnp.arange(H)[None, :, None, None]

    def one_block(start):
        qb = lax.dynamic_slice_in_dim(q, start, Q_BLOCK, axis=1)
        pq = lax.dynamic_slice_in_dim(pos, start, Q_BLOCK, axis=1)
        own = start // L
        gate = jnp.einsum('bqhd,bnhd->bhqn', qb, k_mean).astype(jnp.float32)
        gate = jnp.where((jnp.arange(NB) < own)[None, None, None, :], gate, NEG_INF)
        _, idx = lax.top_k(gate, k_sel)
        valid = jnp.arange(k_sel) < own
        kg = kb_h[bi, hi, idx]
        vg = vb_h[bi, hi, idx]
        pg = pos_b[bi, idx]
        dist_sel = jnp.abs(pq[:, None, :, None, None] - pg).astype(jnp.float32)
        s_sel = jnp.einsum('bqhd,bhqkld->bhqkl', qb, kg).astype(jnp.float32) * scale
        s_sel = s_sel - slopes[None, :, None, None, None] * dist_sel
        s_sel = jnp.where(valid[None, None, None, :, None], s_sel, NEG_INF)
        k_own = lax.dynamic_slice_in_dim(kp, own * L, L, axis=1)
        v_own = lax.dynamic_slice_in_dim(vp, own * L, L, axis=1)
        p_own_pos = lax.dynamic_slice_in_dim(pp, own * L, L, axis=1)
        dist_own = jnp.abs(pq[:, None, :, None] - p_own_pos[:, None, None, :]).astype(jnp.float32)
        s_own = jnp.einsum('bqhd,blhd->bhql', qb, k_own).astype(jnp.float32) * scale
        s_own = s_own - slopes[None, :, None, None] * dist_own
        causal = (own * L + jnp.arange(L))[None, :] <= (start + jnp.arange(Q_BLOCK))[:, None]
        s_own = jnp.where(causal[None, None], s_own, NEG_INF)
        s = jnp.concatenate([s_sel.reshape(B, H, Q_BLOCK, k_sel * L), s_own], axis=-1)
        p = jax.nn.softmax(s, axis=-1).astype(v.dtype)
        p_sel = p[..., :k_sel * L].reshape(B, H, Q_BLOCK, k_sel, L)
        p_o = p[..., k_sel * L:]
        return (jnp.einsum('bhqkl,bhqkld->bqhd', p_sel, vg)
                + jnp.einsum('bhql,blhd->bqhd', p_o, v_own))

    out = lax.map(one_block, jnp.arange(0, S, Q_BLOCK))
    return jnp.moveaxis(out, 0, 1).reshape(B, S, H * D)


def setup_inputs(seed: int = 0) -> dict:
    key = jax.random.key(seed)
    ks = jax.random.split(key, 20)

    def dense(k, fan_in, fan_out):
        return jax.random.normal(k, (DEPTH, fan_in, fan_out), jnp.float32) * fan_in ** -0.5

    def gain(k, n):
        return 1.0 + 0.02 * jax.random.normal(k, (DEPTH, n), jnp.float32)

    x = jax.random.normal(ks[0], (BATCH, SEQ, D_MODEL), jnp.float32)
    positions = jnp.broadcast_to(jnp.arange(SEQ, dtype=jnp.int32)[None, :], (BATCH, SEQ))
    return {
        "x": x,
        "positions": positions,
        "ffn1_norm": gain(ks[1], D_MODEL),
        "ffn1_w_gate": dense(ks[2], D_MODEL, D_FF),
        "ffn1_w_up": dense(ks[3], D_MODEL, D_FF),
        "ffn1_w_down": dense(ks[4], D_FF, D_MODEL),
        "mix_norm": gain(ks[5], D_MODEL),
        "w_in": dense(ks[6], D_MODEL, D_IN),
        "mla_q_norm": gain(ks[7], MLA_Q_RANK),
        "mla_w_uq": dense(ks[8], MLA_Q_RANK, MLA_HEADS * (MLA_NOPE + MLA_ROPE)),
        "mla_kv_norm": gain(ks[9], MLA_KV_RANK),
        "mla_w_ukv": dense(ks[10], MLA_KV_RANK, MLA_HEADS * (MLA_NOPE + MLA_V)),
        "w_out": dense(ks[11], D_CAT, D_MODEL),
        "ffn2_norm": gain(ks[12], D_MODEL),
        "ffn2_w_gate": dense(ks[13], D_MODEL, D_FF),
        "ffn2_w_up": dense(ks[14], D_MODEL, D_FF),
        "ffn2_w_down": dense(ks[15], D_FF, D_MODEL),
        "final_norm": 1.0 + 0.02 * jax.random.normal(ks[16], (D_MODEL,), jnp.float32),
    }


def reference(x, positions, ffn1_norm, ffn1_w_gate, ffn1_w_up, ffn1_w_down, mix_norm, w_in,
              mla_q_norm, mla_w_uq, mla_kv_norm, mla_w_ukv, w_out, ffn2_norm, ffn2_w_gate,
              ffn2_w_up, ffn2_w_down, final_norm):
    B, S, _ = x.shape
    cuts = np.cumsum(IN_SPLITS)[:-1].tolist()
    for l in range(DEPTH):
        x = x + FFN_RES * swiglu(rms_norm(x, ffn1_norm[l]), ffn1_w_gate[l], ffn1_w_up[l], ffn1_w_down[l])
        u = rms_norm(x, mix_norm[l]) @ w_in[l]
        c_q, c_kv, k_rope, mq, mk, mv = jnp.split(u, cuts, axis=-1)
        a_out = mla_attention(c_q, c_kv, k_rope, positions, mla_q_norm[l], mla_w_uq[l],
                              mla_kv_norm[l], mla_w_ukv[l])
        shp = (B, S, MOBA_HEADS, MOBA_HEAD_DIM)
        b_out = moba_attention(mq.reshape(shp), mk.reshape(shp), mv.reshape(shp), positions)
        x = x + jnp.concatenate([a_out, b_out], axis=-1) @ w_out[l]
        x = x + FFN_RES * swiglu(rms_norm(x, ffn2_norm[l]), ffn2_w_gate[l], ffn2_w_up[l], ffn2_w_down[l])
    return rms_norm(x, final_norm)
```

```cpp
#include <hip/hip_runtime.h>
#include <cstdio>
#include <cstdint>
#include <cmath>

namespace nv {
constexpr int S = 16384, DM = 1024, DFF = 2816, DIN = 2208;
constexpr float EPS = 1e-6f;

__global__ void __launch_bounds__(256) rmsnorm_k(const float* in, int ld_in, const float* g, float* out, int ld_out, int n) {
    __shared__ float red[4];
    const int row = blockIdx.x, t = threadIdx.x;
    const float* x = in + (size_t)row * ld_in;
    float s = 0.f;
    for (int c = t; c < n; c += 256) { float v = x[c]; s += v * v; }
    for (int o = 32; o > 0; o >>= 1) s += __shfl_xor(s, o);
    if ((t & 63) == 0) red[t >> 6] = s;
    __syncthreads();
    const float tot = red[0] + red[1] + red[2] + red[3];
    const float r = 1.0f / sqrtf(tot / (float)n + EPS);
    float* y = out + (size_t)row * ld_out;
    for (int c = t; c < n; c += 256) y[c] = x[c] * r * g[c];
}

__global__ void __launch_bounds__(256) gemm_k(const float* A, int lda, const float* B, int ldb, float* C, int ldc, int M, int N, int K, int accumulate) {
    __shared__ float As[8][128 + 4];
    __shared__ float Bs[8][128 + 4];
    const int t = threadIdx.x, tx = t & 15, ty = t >> 4;
    const int m0 = blockIdx.y * 128, n0 = blockIdx.x * 128;
    float acc[8][8];
#pragma unroll
    for (int i = 0; i < 8; ++i)
#pragma unroll
        for (int j = 0; j < 8; ++j) acc[i][j] = 0.f;
    const int ar = t >> 1, ac = (t & 1) * 4;
    const int br = t >> 5, bc = (t & 31) * 4;
    for (int k0 = 0; k0 < K; k0 += 8) {
        const float4 av = *(const float4*)(A + (size_t)(m0 + ar) * lda + k0 + ac);
        float4 bv = make_float4(0.f, 0.f, 0.f, 0.f);
        if (n0 + bc < N) bv = *(const float4*)(B + (size_t)(k0 + br) * ldb + n0 + bc);
        __syncthreads();
        As[ac + 0][ar] = av.x; As[ac + 1][ar] = av.y; As[ac + 2][ar] = av.z; As[ac + 3][ar] = av.w;
        *(float4*)&Bs[br][bc] = bv;
        __syncthreads();
#pragma unroll
        for (int k = 0; k < 8; ++k) {
            float a[8], b[8];
#pragma unroll
            for (int i = 0; i < 8; ++i) a[i] = As[k][ty * 8 + i];
#pragma unroll
            for (int j = 0; j < 8; ++j) b[j] = Bs[k][tx * 8 + j];
#pragma unroll
            for (int i = 0; i < 8; ++i)
#pragma unroll
                for (int j = 0; j < 8; ++j) acc[i][j] = fmaf(a[i], b[j], acc[i][j]);
        }
    }
#pragma unroll
    for (int i = 0; i < 8; ++i) {
        const int r = m0 + ty * 8 + i;
#pragma unroll
        for (int j = 0; j < 8; ++j) {
            const int c = n0 + tx * 8 + j;
            if (c < N) { float* p = C + (size_t)r * ldc + c; *p = accumulate ? (*p + acc[i][j]) : acc[i][j]; }
        }
    }
}

__global__ void swiglu_k(float* g, const float* u, size_t n) {
    size_t i = (size_t)blockIdx.x * blockDim.x + threadIdx.x;
    if (i < n) { float a = g[i]; g[i] = a / (1.0f + expf(-a)) * u[i]; }
}
__global__ void axpy_k(float* out, const float* x, const float* y, float alpha, size_t n) {
    size_t i = (size_t)blockIdx.x * blockDim.x + threadIdx.x;
    if (i < n) out[i] = x[i] + alpha * y[i];
}

__global__ void rope_k(float* x, const int* pos, int nh, int hd, int off) {
    const int idx = blockIdx.x * blockDim.x + threadIdx.x;
    if (idx >= S * nh * 16) return;
    const int i = idx & 15, h = (idx >> 4) % nh, s = idx / (16 * nh);
    const float inv = (float)pow(10000.0, -(double)i / 16.0);
    const float ang = (float)pos[s] * inv;
    const float c = (float)cos((double)ang), sn = (float)sin((double)ang);
    float* p = x + ((size_t)s * nh + h) * hd + off;
    const float x1 = p[i], x2 = p[16 + i];
    p[i] = x1 * c - x2 * sn; p[16 + i] = x1 * sn + x2 * c;
}

__global__ void __launch_bounds__(256) mla_k(const float* q  , const float* kv  , const float* kr  , float* out  ) {
    __shared__ float Ks[32][96];
    __shared__ float Vs[32][64];
    const int h = blockIdx.y, qb = blockIdx.x, t = threadIdx.x, i = qb * 256 + t;
    const float scale = 0.10206207261596577f;
    float qv[96], o[64];
#pragma unroll
    for (int d = 0; d < 96; ++d) qv[d] = q[(size_t)i * 768 + h * 96 + d] * scale;
#pragma unroll
    for (int d = 0; d < 64; ++d) o[d] = 0.f;
    float m = -1e30f, l = 0.f;
    const int ntile = (qb * 256 + 256) / 32;
    for (int tt = 0; tt < ntile; ++tt) {
        __syncthreads();
        for (int e = t; e < 32 * 96; e += 256) { const int j = e / 96, d = e % 96; const int key = tt * 32 + j;
            Ks[j][d] = d < 64 ? kv[(size_t)key * 1024 + h * 128 + d] : kr[(size_t)key * 32 + (d - 64)]; }
        for (int e = t; e < 32 * 64; e += 256) { const int j = e / 64, d = e % 64; const int key = tt * 32 + j;
            Vs[j][d] = kv[(size_t)key * 1024 + h * 128 + 64 + d]; }
        __syncthreads();
        for (int j = 0; j < 32; ++j) {
            const int key = tt * 32 + j;
            if (key > i) break;
            float s = 0.f;
#pragma unroll
            for (int d = 0; d < 96; ++d) s = fmaf(qv[d], Ks[j][d], s);
            if (s > m) { const float a = expf(m - s); l *= a;
#pragma unroll
                for (int d = 0; d < 64; ++d) o[d] *= a;
                m = s; }
            const float p = expf(s - m); l += p;
#pragma unroll
            for (int d = 0; d < 64; ++d) o[d] = fmaf(p, Vs[j][d], o[d]);
        }
    }
    const float rl = 1.0f / l;
#pragma unroll
    for (int d = 0; d < 64; ++d) out[(size_t)i * 512 + h * 64 + d] = o[d] * rl;
}

__global__ void kmean_k(const float* mk  , float* km  ) {
    const int n = blockIdx.x, c = threadIdx.x + blockIdx.y * 256;
    float s = 0.f;
    for (int r = 0; r < 256; ++r) s += mk[(size_t)(n * 256 + r) * 512 + c];
    km[n * 512 + c] = s * (1.0f / 256.0f);
}
__global__ void __launch_bounds__(256) moba_k(const float* mq, const float* mk, const float* mv, const float* km, const int* pos, float* out  ) {
    const int h = blockIdx.y, own = blockIdx.x, t = threadIdx.x, i = own * 256 + t;
    float qv[64], o[64];
#pragma unroll
    for (int d = 0; d < 64; ++d) { qv[d] = mq[(size_t)i * 512 + h * 64 + d]; o[d] = 0.f; }
    float g0 = -3e38f, g1 = -3e38f, g2 = -3e38f; int i0 = -1, i1 = -1, i2 = -1;
    for (int n = 0; n < own; ++n) {
        float g = 0.f;
#pragma unroll
        for (int d = 0; d < 64; ++d) g = fmaf(qv[d], km[n * 512 + h * 64 + d], g);
        if (g > g0) { g2 = g1; i2 = i1; g1 = g0; i1 = i0; g0 = g; i0 = n; }
        else if (g > g1) { g2 = g1; i2 = i1; g1 = g; i1 = n; }
        else if (g > g2) { g2 = g; i2 = n; }
    }
    const float slope = exp2f(-(float)(h + 1)), scale = 0.125f;
    const int pq = pos[i];
    float m = -1e30f, l = 0.f;
    for (int b = 0; b < 4; ++b) {
        const int blk = b == 0 ? i0 : b == 1 ? i1 : b == 2 ? i2 : own;
        if (blk < 0) continue;
        const int kend = (b == 3) ? (t + 1) : 256;
        for (int j = 0; j < kend; ++j) {
            const int key = blk * 256 + j;
            const float4* kp = (const float4*)(mk + (size_t)key * 512 + h * 64);
            float s = 0.f;
#pragma unroll
            for (int d4 = 0; d4 < 16; ++d4) { const float4 kk = kp[d4]; s = fmaf(qv[4 * d4], kk.x, s); s = fmaf(qv[4 * d4 + 1], kk.y, s); s = fmaf(qv[4 * d4 + 2], kk.z, s); s = fmaf(qv[4 * d4 + 3], kk.w, s); }
            s = s * scale - slope * fabsf((float)(pq - pos[key]));
            if (s > m) { const float a = expf(m - s); l *= a;
#pragma unroll
                for (int d = 0; d < 64; ++d) o[d] *= a;
                m = s; }
            const float p = expf(s - m); l += p;
            const float4* vp = (const float4*)(mv + (size_t)key * 512 + h * 64);
#pragma unroll
            for (int d4 = 0; d4 < 16; ++d4) { const float4 vv = vp[d4]; o[4 * d4] = fmaf(p, vv.x, o[4 * d4]); o[4 * d4 + 1] = fmaf(p, vv.y, o[4 * d4 + 1]); o[4 * d4 + 2] = fmaf(p, vv.z, o[4 * d4 + 2]); o[4 * d4 + 3] = fmaf(p, vv.w, o[4 * d4 + 3]); }
        }
    }
    const float rl = 1.0f / l;
#pragma unroll
    for (int d = 0; d < 64; ++d) out[(size_t)i * 512 + h * 64 + d] = o[d] * rl;
}

static void gemm(hipStream_t st, const float* A, int lda, const float* B, int ldb, float* C, int ldc, int M, int N, int K, int acc) {
    dim3 grid((N + 127) / 128, M / 128);
    hipLaunchKernelGGL(gemm_k, grid, dim3(256), 0, st, A, lda, B, ldb, C, ldc, M, N, K, acc);
}
static void ffn(hipStream_t st, float* xio  , const float* xin, const float* gain, const float* wg, const float* wu, const float* wd, float* ws) {
    const size_t MiB = 1u << 20;
    float* H = ws; float* G = (float*)((char*)ws + 64 * MiB); float* U = (float*)((char*)ws + 108 * MiB); float* Y = (float*)((char*)ws + 152 * MiB);
    hipLaunchKernelGGL(rmsnorm_k, dim3(S), dim3(256), 0, st, xin, DM, gain, H, DM, DM);
    for (int rc = 0; rc < 4; ++rc) {
        const size_t r0 = (size_t)rc * 4096;
        gemm(st, H + r0 * DM, DM, wg, DFF, G, DFF, 4096, DFF, DM, 0);
        gemm(st, H + r0 * DM, DM, wu, DFF, U, DFF, 4096, DFF, DM, 0);
        const size_t n = (size_t)4096 * DFF;
        hipLaunchKernelGGL(swiglu_k, dim3((unsigned)((n + 255) / 256)), dim3(256), 0, st, G, (const float*)U, n);
        gemm(st, G, DFF, wd, DM, Y, DM, 4096, DM, DFF, 0);
        const size_t n2 = (size_t)4096 * DM;
        hipLaunchKernelGGL(axpy_k, dim3((unsigned)((n2 + 255) / 256)), dim3(256), 0, st, xio + r0 * DM, xin + r0 * DM, (const float*)Y, 0.5f, n2);
    }
}
static void forward(void* const* d_in, float* out, void* d_ws, hipStream_t st) {
    const size_t MiB = 1u << 20;
    const float* x = (const float*)d_in[0]; const int* pos = (const int*)d_in[1];
    float* ws = (float*)d_ws; char* wb = (char*)d_ws;
    ffn(st, out, x, (const float*)d_in[2], (const float*)d_in[3], (const float*)d_in[4], (const float*)d_in[5], ws);
    float* H = ws;
    float* CQ = (float*)(wb + 64 * MiB); float* CKV = (float*)(wb + 88 * MiB); float* KR = (float*)(wb + 104 * MiB);
    float* MQ = (float*)(wb + 106 * MiB); float* MK = (float*)(wb + 138 * MiB); float* MV = (float*)(wb + 170 * MiB);
    float* BO = (float*)(wb + 202 * MiB); float* KM = (float*)(wb + 234 * MiB);
    float* Q = ws; float* KV = (float*)(wb + 106 * MiB); float* AO = (float*)(wb + 170 * MiB); float* Y = ws;
    const float* w_in = (const float*)d_in[7];
    hipLaunchKernelGGL(rmsnorm_k, dim3(S), dim3(256), 0, st, (const float*)out, DM, (const float*)d_in[6], H, DM, DM);
    gemm(st, H, DM, w_in + 0, DIN, CQ, 384, S, 384, DM, 0);
    gemm(st, H, DM, w_in + 384, DIN, CKV, 256, S, 256, DM, 0);
    gemm(st, H, DM, w_in + 640, DIN, KR, 32, S, 32, DM, 0);
    gemm(st, H, DM, w_in + 672, DIN, MQ, 512, S, 512, DM, 0);
    gemm(st, H, DM, w_in + 1184, DIN, MK, 512, S, 512, DM, 0);
    gemm(st, H, DM, w_in + 1696, DIN, MV, 512, S, 512, DM, 0);
    hipLaunchKernelGGL(kmean_k, dim3(64, 2), dim3(256), 0, st, (const float*)MK, KM);
    hipLaunchKernelGGL(moba_k, dim3(64, 8), dim3(256), 0, st, (const float*)MQ, (const float*)MK, (const float*)MV, (const float*)KM, pos, BO);
    hipLaunchKernelGGL(rmsnorm_k, dim3(S), dim3(256), 0, st, (const float*)CQ, 384, (const float*)d_in[8], CQ, 384, 384);
    hipLaunchKernelGGL(rmsnorm_k, dim3(S), dim3(256), 0, st, (const float*)CKV, 256, (const float*)d_in[10], CKV, 256, 256);
    gemm(st, CQ, 384, (const float*)d_in[9], 768, Q, 768, S, 768, 384, 0);
    gemm(st, CKV, 256, (const float*)d_in[11], 1024, KV, 1024, S, 1024, 256, 0);
    hipLaunchKernelGGL(rope_k, dim3(S * 8 * 16 / 256), dim3(256), 0, st, Q, pos, 8, 96, 64);
    hipLaunchKernelGGL(rope_k, dim3(S * 16 / 256), dim3(256), 0, st, KR, pos, 1, 32, 0);
    hipLaunchKernelGGL(mla_k, dim3(64, 8), dim3(256), 0, st, (const float*)Q, (const float*)KV, (const float*)KR, AO);
    const float* w_out = (const float*)d_in[12];
    gemm(st, AO, 512, w_out, DM, Y, DM, S, DM, 512, 0);
    gemm(st, BO, 512, w_out + (size_t)512 * DM, DM, Y, DM, S, DM, 512, 1);
    const size_t n = (size_t)S * DM;
    hipLaunchKernelGGL(axpy_k, dim3((unsigned)((n + 255) / 256)), dim3(256), 0, st, out, (const float*)out, (const float*)Y, 1.0f, n);
    ffn(st, out, out, (const float*)d_in[13], (const float*)d_in[14], (const float*)d_in[15], (const float*)d_in[16], ws);
    hipLaunchKernelGGL(rmsnorm_k, dim3(S), dim3(256), 0, st, (const float*)out, DM, (const float*)d_in[17], out, DM, DM);
}
}

#ifndef NAIVE_NO_ENTRY
extern "C" void kernel_launch(void* const* d_in, const int* in_sizes, int n_in, void* d_out, int out_size, void* d_ws, size_t ws_size, hipStream_t stream) {
    nv::forward(d_in, (float*)d_out, d_ws, stream);
}
#endif
```

```cpp
#define MK_BRINGUP 3
#include <hip/hip_runtime.h>
#include <cstdio>
#include <cstdint>
#include <cmath>
#include <hip/hip_cooperative_groups.h>
namespace cg = cooperative_groups;

namespace mkc {
constexpr int S = 16384, DM = 1024, DFF = 2816, NGU = 2 * DFF, NWIN = 2304;
constexpr float LOG2E = 1.4426950408889634f;
constexpr float C2Q = 0.10206207261596577f * LOG2E;
constexpr float C2M = 0.125f * LOG2E;
constexpr size_t MiB = 1u << 20;
constexpr size_t WS_CNT = 0;
constexpr size_t WS_SS1 = 1 * MiB, WS_SS2 = WS_SS1 + 65536, WS_SSQ = WS_SS2 + 65536, WS_SSKV = WS_SSQ + 65536, WS_SS3 = WS_SSKV + 65536, WS_SS4 = WS_SS3 + 65536;
constexpr size_t WS_KMS = WS_SS1 + 512 * 1024;
constexpr size_t WS_POSF = 2 * MiB, WS_COS = 3 * MiB, WS_SIN = 4 * MiB;
constexpr size_t WS_WGU1 = 6 * MiB, WS_WD1 = 17 * MiB, WS_WGU2 = WS_WD1 + 5632 * 1024, WS_WD2 = WS_WGU2 + 11 * MiB, WS_WIN = 39 * MiB, WS_WUQ = WS_WIN + 4608 * 1024, WS_WUKV = WS_WUQ + 768 * 1024, WS_WOUT = 45 * MiB;
constexpr size_t WS_XB = 48 * MiB, WS_CQKV = 80 * MiB, WS_PART = 48 * MiB, WS_PLSE = 112 * MiB;
constexpr size_t WS_ACT = 114 * MiB, WS_MQKV = 114 * MiB, WS_CAT = 114 * MiB, WS_Q = 162 * MiB, WS_KN = 186 * MiB, WS_V = 202 * MiB, WS_KR = 218 * MiB, WS_LIST = 220 * MiB, WS_END = 236 * MiB;
static_assert(WS_WD2 + 5632 * 1024 <= WS_WIN && WS_WUKV + 512 * 1024 <= WS_WOUT && WS_WOUT + 2 * MiB <= WS_XB, "weight map");
}
namespace pg8 {
#define PG8_LAS __attribute__((address_space(3)))
typedef unsigned short bf16_t;
typedef short bf16x8 __attribute__((ext_vector_type(8)));
typedef float f32x4 __attribute__((ext_vector_type(4)));
typedef unsigned u32x4 __attribute__((ext_vector_type(4)));
__device__ __forceinline__ int lane_id_v() { int l; asm volatile("v_mbcnt_lo_u32_b32 %0, -1, 0\n\tv_mbcnt_hi_u32_b32 %0, -1, %0" : "=v"(l)); return l; }
constexpr int BM = 256, BK = 64, HALF = 128, HTB = HALF * BK * 2  , STAGE_BYTES = 8 * HTB, NXCD = 8, WGM = 8;

__host__ __device__ __forceinline__ int lds_byte(int r, int c) { const int st = (r >> 4) * 2 + (c >> 5), rr = r & 15, cc = c & 31, ob = rr * 64 + cc * 2; return st * 1024 + (ob ^ (((ob >> 9) & 1) << 5)); }
__host__ __device__ __forceinline__ void stage_rc(int b, int& R, int& C) { const int st = b / 1024, sb = b % 1024, swz = sb ^ (((sb >> 9) & 1) << 5); R = (st >> 1) * 16 + swz / 64; C = (st & 1) * 32 + (swz % 64) / 2; }
__host__ __device__ __forceinline__ int perm32(int rho) { const int n = rho >> 4, i = rho & 15; return 8 * (i >> 2) + 4 * n + (i & 3); }

struct Unit { int pm, pn; };
struct Gemm { const bf16_t* A; const bf16_t* Bt; int M, N, K, lda; };

struct StaticOrder {
    int nM, nN, nwg, G, c;
    __host__ __device__ void init(int M, int N, int G_, int c_) { nM = M / BM; nN = N / BM; nwg = nM * nN; G = G_; c = c_; }
    __host__ __device__ bool next(int i, Unit& u) const {
        const long L = (long)i * G + c; if (L >= nwg) return false;
        int wgid = (int)L; { const int q = nwg / NXCD, r = nwg % NXCD, xcd = wgid % NXCD, off = wgid / NXCD; wgid = (xcd < r ? xcd * (q + 1) : r * (q + 1) + (xcd - r) * q) + off; }
        const int nig = WGM * nN, gid = wgid / nig, fm = gid * WGM, gsz = (nM - fm) < WGM ? (nM - fm) : WGM;
        u.pm = fm + ((wgid % nig) % gsz); u.pn = (wgid % nig) / gsz; return true;
    }
    __device__ __forceinline__ void a_ready(const Unit&) const {}
    __device__ __forceinline__ void done(const Unit&) const {}
};

__device__ __forceinline__ unsigned cvt_pk_bf16(float lo, float hi) { unsigned r; asm volatile("v_cvt_pk_bf16_f32 %0, %1, %2" : "=v"(r) : "v"(lo), "v"(hi)); return r; }
typedef unsigned u32x2 __attribute__((ext_vector_type(2)));
constexpr float RMS_EPS = 1e-6f;
__device__ __forceinline__ float rs_of(const float* ss, int row, float invn) { return __builtin_amdgcn_rsqf(ss[row] * invn + RMS_EPS); }
__device__ __forceinline__ float silu_f(float g) { return g * __builtin_amdgcn_rcpf(1.0f + __builtin_amdgcn_exp2f(-1.4426950408889634f * g)); }
__device__ __forceinline__ u32x4 pack8(const f32x4 a, const f32x4 b) { u32x4 w; w.x = cvt_pk_bf16(a[0], a[1]); w.y = cvt_pk_bf16(a[2], a[3]); w.z = cvt_pk_bf16(b[0], b[1]); w.w = cvt_pk_bf16(b[2], b[3]); return w; }

struct EpiSwiGLU {
    static constexpr bool PERM = true, AFTER_DRAIN = false;
    unsigned char* ws; int which;
    __device__ __forceinline__ void operator()(const f32x4 (&acc)[2][2][4][2], const Unit& u, int wr, int wc, int fr, int fq) const {
        bf16_t* O = (bf16_t*)(ws + mkc::WS_ACT); const int ldo = mkc::DFF; const float* ss = (const float*)(ws + (which ? mkc::WS_SS3 : mkc::WS_SS1)); const float invn = 1.0f / 1024.0f;
        const int row0 = u.pm * BM + wr * 64 + fr, col0 = u.pn * HALF + wc * 32 + 8 * fq;
#pragma unroll
        for (int ai = 0; ai < 2; ++ai)
#pragma unroll
            for (int m = 0; m < 4; ++m) { const int row = row0 + ai * HALF + m * 16; const float rs = rs_of(ss, row, invn);
                f32x4 a0, a1;
#pragma unroll
                for (int j = 0; j < 4; ++j) { a0[j] = silu_f(acc[ai][0][m][0][j] * rs) * (acc[ai][1][m][0][j] * rs); a1[j] = silu_f(acc[ai][0][m][1][j] * rs) * (acc[ai][1][m][1][j] * rs); }
                *(u32x4*)(O + (size_t)row * ldo + col0) = pack8(a0, a1); }
    }
};
struct EpiResid {
    static constexpr bool PERM = false, AFTER_DRAIN = false;
    const float* base; float* out; unsigned char* ws; int ss_off; int has_xb; float alpha;
    __device__ __forceinline__ void operator()(const f32x4 (&acc)[2][2][4][2], const Unit& u, int wr, int wc, int fr, int fq) const {
        bf16_t* xb = has_xb ? (bf16_t*)(ws + mkc::WS_XB) : nullptr; float* ss_out = (float*)(ws + ss_off);
        const int row0 = u.pm * BM + wr * 64 + fr, col0 = u.pn * BM + wc * 32 + 4 * fq;
#pragma unroll
        for (int ai = 0; ai < 2; ++ai)
#pragma unroll
            for (int m = 0; m < 4; ++m) { const int row = row0 + ai * HALF + m * 16; const size_t off = (size_t)row * 1024 + col0; float s = 0.f;
#pragma unroll
                for (int bj = 0; bj < 2; ++bj)
#pragma unroll
                    for (int n = 0; n < 2; ++n) { const f32x4 b = *(const f32x4*)(base + off + bj * HALF + n * 16); const f32x4 o = b + acc[ai][bj][m][n] * alpha;
                        *(f32x4*)(out + off + bj * HALF + n * 16) = o; s += (o[0] * o[0] + o[1] * o[1]) + (o[2] * o[2] + o[3] * o[3]);
                        if (xb) { u32x2 w; w.x = cvt_pk_bf16(o[0], o[1]); w.y = cvt_pk_bf16(o[2], o[3]); *(u32x2*)(xb + off + bj * HALF + n * 16) = w; } }
                s += __shfl_xor(s, 16); s += __shfl_xor(s, 32);
                if (fq == 0) atomicAdd(ss_out + row, s);
                asm volatile("" ::: "memory"); }
    }
};
struct EpiWin {
    static constexpr bool PERM = true, AFTER_DRAIN = false;
    unsigned char* ws;
    __device__ __forceinline__ void operator()(const f32x4 (&acc)[2][2][4][2], const Unit& u, int wr, int wc, int fr, int fq) const {
        bf16_t* cqkv = (bf16_t*)(ws + mkc::WS_CQKV); bf16_t* mqkv = (bf16_t*)(ws + mkc::WS_MQKV); const float* ss_in = (const float*)(ws + mkc::WS_SS2);
        float* ssq = (float*)(ws + mkc::WS_SSQ); float* sskv = (float*)(ws + mkc::WS_SSKV); float* kmsum = (float*)(ws + mkc::WS_KMS);
        const int row0 = u.pm * BM + wr * 64 + fr;
        const bool is_mk = (u.pn == 5 || u.pn == 6);
        f32x4 cs[2][2];
#pragma unroll
        for (int bj = 0; bj < 2; ++bj)
#pragma unroll
            for (int n = 0; n < 2; ++n) cs[bj][n] = (f32x4){0.f, 0.f, 0.f, 0.f};
#pragma unroll
        for (int ai = 0; ai < 2; ++ai)
#pragma unroll
            for (int m = 0; m < 4; ++m) { const int row = row0 + ai * HALF + m * 16; const float rs = rs_of(ss_in, row, 1.0f / 1024.0f);
#pragma unroll
                for (int bj = 0; bj < 2; ++bj) { const int colt = u.pn * BM + bj * HALF, col0 = colt + wc * 32 + 8 * fq;
                    const f32x4 v0 = acc[ai][bj][m][0] * rs, v1 = acc[ai][bj][m][1] * rs;
                    bf16_t* dst = (colt < 768) ? (cqkv + (size_t)row * 768 + col0) : (mqkv + (size_t)row * 1536 + (col0 - 768));
                    *(u32x4*)dst = pack8(v0, v1);
                    if (colt < 640) { float s = (v0[0] * v0[0] + v0[1] * v0[1]) + (v0[2] * v0[2] + v0[3] * v0[3]) + (v1[0] * v1[0] + v1[1] * v1[1]) + (v1[2] * v1[2] + v1[3] * v1[3]);
                        s += __shfl_xor(s, 16); s += __shfl_xor(s, 32);
                        if (fq == 0) atomicAdd((colt < 384 ? ssq : sskv) + row, s); }
                    if (is_mk) { cs[bj][0] += v0; cs[bj][1] += v1; } } }
        if (is_mk) {
#pragma unroll
            for (int bj = 0; bj < 2; ++bj)
#pragma unroll
                for (int n = 0; n < 2; ++n)
#pragma unroll
                    for (int j = 0; j < 4; ++j) { float s = cs[bj][n][j]; s += __shfl_xor(s, 1); s += __shfl_xor(s, 2); s += __shfl_xor(s, 4); s += __shfl_xor(s, 8);
                        if (fr == 0) atomicAdd(kmsum + (size_t)u.pm * 512 + (u.pn * BM + bj * HALF + wc * 32 + 8 * fq + 4 * n + j - 1280), s); }
        }
    }
};
struct EpiKV {
    static constexpr bool PERM = true, AFTER_DRAIN = false;
    unsigned char* ws;
    __device__ __forceinline__ void operator()(const f32x4 (&acc)[2][2][4][2], const Unit& u, int wr, int wc, int fr, int fq) const {
        bf16_t* Kn = (bf16_t*)(ws + mkc::WS_KN); bf16_t* V = (bf16_t*)(ws + mkc::WS_V); const float* ss = (const float*)(ws + mkc::WS_SSKV);
        const int row0 = u.pm * BM + wr * 64 + fr;
#pragma unroll
        for (int ai = 0; ai < 2; ++ai)
#pragma unroll
            for (int m = 0; m < 4; ++m) { const int row = row0 + ai * HALF + m * 16; const float rs = rs_of(ss, row, 1.0f / 256.0f);
#pragma unroll
                for (int bj = 0; bj < 2; ++bj) { const int colt = u.pn * BM + bj * HALF, col0 = colt + wc * 32 + 8 * fq;
                    bf16_t* dst = (colt < 512) ? (Kn + (size_t)row * 512 + col0) : (V + (size_t)row * 512 + (col0 - 512));
                    *(u32x4*)dst = pack8(acc[ai][bj][m][0] * rs, acc[ai][bj][m][1] * rs); } }
    }
};
struct EpiQ {
    static constexpr bool PERM = true, AFTER_DRAIN = false;
    unsigned char* ws;
    __device__ __forceinline__ void operator()(const f32x4 (&acc)[2][2][4][2], const Unit& u, int wr, int wc, int fr, int fq) const {
        bf16_t* Q = (bf16_t*)(ws + mkc::WS_Q); const float* ss = (const float*)(ws + mkc::WS_SSQ); const float* cosT = (const float*)(ws + mkc::WS_COS); const float* sinT = (const float*)(ws + mkc::WS_SIN);
        const int row0 = u.pm * BM + wr * 64 + fr;
#pragma unroll
        for (int ai = 0; ai < 2; ++ai)
#pragma unroll
            for (int m = 0; m < 4; ++m) { const int row = row0 + ai * HALF + m * 16; const float rs = rs_of(ss, row, 1.0f / 384.0f);
#pragma unroll
                for (int bj = 0; bj < 2; ++bj) { const int col0 = u.pn * BM + bj * HALF + wc * 32 + 8 * fq; const int d = col0 % 96;
                    f32x4 v0 = acc[ai][bj][m][0] * rs, v1 = acc[ai][bj][m][1] * rs;
                    if (d >= 64) { const int g = (d - 64) >> 3; const f32x4 c = *(const f32x4*)(cosT + (size_t)row * 16 + 4 * g), s = *(const f32x4*)(sinT + (size_t)row * 16 + 4 * g);
                        const f32x4 o0 = v0 * c - v1 * s, o1 = v0 * s + v1 * c; v0 = o0; v1 = o1; }
                    *(u32x4*)(Q + (size_t)row * 768 + col0) = pack8(v0, v1); }
                asm volatile("" ::: "memory"); }
    }
};

template <class Epi, class Sched, bool ALIGN_EPI = false, bool SP2 = false>
__device__ __forceinline__ void gemm_phase(PG8_LAS unsigned char* lds, const Gemm g, const Sched& S, const Epi& E, const int wid) {
    const int lane = lane_id_v(), tid = wid * 64 + lane, wr = wid >> 2, wc = wid & 3, fr = lane & 15, fq = lane >> 4;
    const int K = g.K, nt = K / BK, lda = g.lda;
    unsigned voffA[2], voffB[2];
#pragma unroll
    for (int i = 0; i < 2; ++i) { int R, C; stage_rc(tid * 16 + i * 8192, R, C); const int Rb = Epi::PERM ? ((R & ~31) + perm32(R & 31)) : R;
        voffA[i] = (unsigned)(R * lda + C) * 2u; voffB[i] = (unsigned)(Rb * K + C) * 2u; }
    const size_t kstep = (size_t)(BK * 2);
    const size_t hstep = (size_t)HALF * K * 2;
    const size_t tstep = 2 * hstep; const size_t hstepA = (size_t)HALF * lda * 2, tstepA = 2 * hstepA;
    const unsigned ldsw = (unsigned)wid * 1024u;
    const int aoff = lds_byte(wr * 64 + fr, fq * 8), boff = lds_byte(wc * 32 + fr, fq * 8);
#define PG8_SA(b, h) (((b) * 2 + (h)) * HTB)
#define PG8_SB(b, h) ((4 + (b) * 2 + (h)) * HTB)
#define PG8_STAGE(bufoff, gbase, voff) do { _Pragma("unroll") for (int _i = 0; _i < 2; ++_i) \
        __builtin_amdgcn_global_load_lds((const unsigned*)((const char*)(gbase) + (voff)[_i]), (PG8_LAS unsigned*)(lds + (bufoff) + ldsw + _i * 8192), 16, 0, 0); } while (0)
#define PG8_LDA(dst, b, h) do { _Pragma("unroll") for (int m = 0; m < 4; ++m) _Pragma("unroll") for (int k = 0; k < 2; ++k) dst[m][k] = *(const PG8_LAS bf16x8*)(lds + PG8_SA(b, h) + aoff + m * 2048 + k * 1024); } while (0)
#define PG8_LDB(dst, b, h) do { _Pragma("unroll") for (int n = 0; n < 2; ++n) _Pragma("unroll") for (int k = 0; k < 2; ++k) dst[n][k] = *(const PG8_LAS bf16x8*)(lds + PG8_SB(b, h) + boff + n * 2048 + k * 1024); } while (0)
#define PG8_MMA(ai, bj, At, Bt) do { __builtin_amdgcn_s_setprio(1); _Pragma("unroll") for (int m = 0; m < 4; ++m) _Pragma("unroll") for (int n = 0; n < 2; ++n) _Pragma("unroll") for (int k = 0; k < 2; ++k) \
        acc[ai][bj][m][n] = __builtin_amdgcn_mfma_f32_16x16x32_bf16(Bt[n][k], At[m][k], acc[ai][bj][m][n], 0, 0, 0); __builtin_amdgcn_s_setprio(0); } while (0)
#define PG8_WAIT_V(n) asm volatile("s_waitcnt vmcnt(" #n ")" ::: "memory")
#define PG8_WAIT_L(n) asm volatile("s_waitcnt lgkmcnt(" #n ")" ::: "memory")
#define PG8_BAR __builtin_amdgcn_s_barrier()
#define PG8_SCHED __builtin_amdgcn_sched_barrier(0)
    Unit cur, nxt; int ui = 0;
    if (!S.next(0, cur)) return;
    f32x4 acc[2][2][4][2];
#pragma unroll
    for (int a = 0; a < 2; ++a)
#pragma unroll
        for (int b = 0; b < 2; ++b)
#pragma unroll
            for (int m = 0; m < 4; ++m)
#pragma unroll
                for (int n = 0; n < 2; ++n) acc[a][b][m][n] = (f32x4){0.f, 0.f, 0.f, 0.f};
    bf16x8 At[4][2], B0[2][2], B1[2][2];
    const char* cA = (const char*)g.A + (size_t)cur.pm * tstepA; const char* cB = (const char*)g.Bt + (size_t)cur.pn * tstep;
    S.a_ready(cur);
    if constexpr (SP2) {
        PG8_STAGE(PG8_SB(0, 0), cB, voffB); PG8_STAGE(PG8_SB(0, 1), cB + hstep, voffB); PG8_STAGE(PG8_SA(0, 0), cA, voffA); PG8_STAGE(PG8_SA(0, 1), cA + hstepA, voffA);
        if (wr == 1) PG8_BAR;
        PG8_WAIT_V(2); PG8_BAR;
        PG8_STAGE(PG8_SB(1, 0), cB + kstep, voffB); PG8_STAGE(PG8_SA(1, 0), cA + kstep, voffA); PG8_STAGE(PG8_SB(1, 1), cB + hstep + kstep, voffB);
        PG8_WAIT_V(6); PG8_BAR;
    } else {
        PG8_STAGE(PG8_SB(0, 0), cB, voffB); PG8_STAGE(PG8_SA(0, 0), cA, voffA); PG8_STAGE(PG8_SB(0, 1), cB + hstep, voffB); PG8_STAGE(PG8_SA(0, 1), cA + hstepA, voffA);
        if (wr == 1) PG8_BAR;
        PG8_WAIT_V(4); PG8_BAR;
        PG8_STAGE(PG8_SB(1, 0), cB + kstep, voffB); PG8_STAGE(PG8_SA(1, 0), cA + kstep, voffA); PG8_STAGE(PG8_SB(1, 1), cB + hstep + kstep, voffB);
        PG8_WAIT_V(6); PG8_BAR;
    }
    for (;;) {
        const bool has_next = S.next(ui + 1, nxt);
        const char* nA = has_next ? (const char*)g.A + (size_t)nxt.pm * tstepA : cA; const char* nB = has_next ? (const char*)g.Bt + (size_t)nxt.pn * tstep : cB;
#pragma nounroll
        for (int t = 0; t < nt; t += 2) {
            const bool last = (t == nt - 2);
            const char* a1 = cA + (size_t)(t + 1) * kstep;
            const char* a2 = last ? nA : cA + (size_t)(t + 2) * kstep; const char* b2 = last ? nB : cB + (size_t)(t + 2) * kstep;
            const char* a3 = a2 + kstep; const char* b3 = b2 + kstep;
            if (last && has_next) S.a_ready(nxt);
            if constexpr (SP2) {
            PG8_LDB(B0, 0, 0); PG8_LDB(B1, 0, 1); PG8_SCHED; PG8_LDA(At, 0, 0); PG8_STAGE(PG8_SA(1, 1), a1 + hstepA, voffA);
            PG8_WAIT_V(8); PG8_WAIT_L(0); PG8_BAR; PG8_MMA(0, 0, At, B0); PG8_MMA(0, 1, At, B1); PG8_BAR; PG8_SCHED;
            PG8_LDA(At, 0, 1); PG8_STAGE(PG8_SB(0, 0), b2, voffB); PG8_STAGE(PG8_SB(0, 1), b2 + hstep, voffB); PG8_STAGE(PG8_SA(0, 0), a2, voffA);
            PG8_WAIT_V(8); PG8_WAIT_L(0); PG8_BAR; PG8_MMA(1, 0, At, B0); PG8_MMA(1, 1, At, B1); PG8_BAR; PG8_SCHED;
            PG8_LDB(B0, 1, 0); PG8_LDB(B1, 1, 1); PG8_SCHED; PG8_LDA(At, 1, 0); PG8_STAGE(PG8_SA(0, 1), a2 + hstepA, voffA);
            PG8_WAIT_V(8); PG8_WAIT_L(0); PG8_BAR; PG8_MMA(0, 0, At, B0); PG8_MMA(0, 1, At, B1); PG8_BAR; PG8_SCHED;
            PG8_LDA(At, 1, 1); PG8_STAGE(PG8_SB(1, 0), b3, voffB); PG8_STAGE(PG8_SB(1, 1), b3 + hstep, voffB); PG8_STAGE(PG8_SA(1, 0), a3, voffA);
            PG8_WAIT_V(8); PG8_WAIT_L(0); PG8_BAR; PG8_MMA(1, 0, At, B0); PG8_MMA(1, 1, At, B1); PG8_BAR; PG8_SCHED;
            } else {
            PG8_LDB(B0, 0, 0); PG8_SCHED; PG8_LDA(At, 0, 0); PG8_STAGE(PG8_SA(1, 1), a1 + hstepA, voffA);
            PG8_WAIT_L(8); PG8_BAR; PG8_WAIT_L(0); PG8_MMA(0, 0, At, B0); PG8_BAR; PG8_SCHED;
            PG8_LDB(B1, 0, 1); PG8_STAGE(PG8_SB(0, 0), b2, voffB);
            PG8_BAR; PG8_WAIT_L(0); PG8_MMA(0, 1, At, B1); PG8_BAR;
            PG8_LDA(At, 0, 1); PG8_STAGE(PG8_SA(0, 0), a2, voffA);
            PG8_BAR; PG8_WAIT_L(0); PG8_MMA(1, 0, At, B0); PG8_BAR; PG8_SCHED;
            PG8_STAGE(PG8_SB(0, 1), b2 + hstep, voffB);
            PG8_WAIT_V(6); PG8_BAR; PG8_MMA(1, 1, At, B1); PG8_BAR;
            PG8_LDB(B0, 1, 0); PG8_SCHED; PG8_LDA(At, 1, 0); PG8_STAGE(PG8_SA(0, 1), a2 + hstepA, voffA);
            PG8_WAIT_L(8); PG8_BAR; PG8_WAIT_L(0); PG8_MMA(0, 0, At, B0); PG8_BAR; PG8_SCHED;
            PG8_LDB(B1, 1, 1); PG8_STAGE(PG8_SB(1, 0), b3, voffB);
            PG8_BAR; PG8_WAIT_L(0); PG8_MMA(0, 1, At, B1); PG8_BAR;
            PG8_LDA(At, 1, 1); PG8_STAGE(PG8_SA(1, 0), a3, voffA);
            PG8_BAR; PG8_WAIT_L(0); PG8_MMA(1, 0, At, B0); PG8_BAR; PG8_SCHED;
            PG8_STAGE(PG8_SB(1, 1), b3 + hstep, voffB);
            PG8_WAIT_V(6); PG8_BAR; PG8_MMA(1, 1, At, B1); PG8_BAR;
            }
        }
        if constexpr (ALIGN_EPI) { if (wr == 0) PG8_BAR; }
        if constexpr (!Epi::AFTER_DRAIN) { E(acc, cur, wr, wc, fr, fq); S.done(cur); }
        if (!has_next) break;
#pragma unroll
        for (int a = 0; a < 2; ++a)
#pragma unroll
            for (int b = 0; b < 2; ++b)
#pragma unroll
                for (int m = 0; m < 4; ++m)
#pragma unroll
                    for (int n = 0; n < 2; ++n) acc[a][b][m][n] = (f32x4){0.f, 0.f, 0.f, 0.f};
        cur = nxt; cA = nA; cB = nB; ++ui;
        if constexpr (ALIGN_EPI) { if (wr == 1) PG8_BAR; }
    }
    PG8_WAIT_V(0);
    if constexpr (!ALIGN_EPI) { if (wr == 0) PG8_BAR; }
    PG8_BAR;
    if constexpr (Epi::AFTER_DRAIN) { E.fused(acc, cur, wr, wc, fr, fq, lds, wid, lane); S.done(cur); }
#undef PG8_SA
#undef PG8_SB
#undef PG8_STAGE
#undef PG8_LDA
#undef PG8_LDB
#undef PG8_MMA
#undef PG8_WAIT_V
#undef PG8_WAIT_L
#undef PG8_BAR
#undef PG8_SCHED
}
}
namespace att {
typedef unsigned short bf16_t;
using bf16x8 = __attribute__((ext_vector_type(8))) short;
using s16x4 = __attribute__((ext_vector_type(4))) short;
using f32x16 = __attribute__((ext_vector_type(16))) float;
using f32x4 = __attribute__((ext_vector_type(4))) float;
using u32x4 = __attribute__((ext_vector_type(4))) unsigned;
typedef short v4i16_t __attribute__((ext_vector_type(4)));
#define ATT_LAS __attribute__((address_space(3)))
typedef ATT_LAS const char* lds_cptr;
constexpr int NW = 8, KVBLK = 64;
constexpr int KSLOT = 12288, VSLOT = 8192, NSLOT = 3;
constexpr int LDS_K = 0, LDS_V = NSLOT * KSLOT, LDS_WS = LDS_V + NSLOT * VSLOT, LDS_OST = LDS_WS + NW * 64 * 4, LDS_POSK = LDS_OST + NW * 4096, LDS_BYTES = LDS_POSK + 1024;
__device__ __forceinline__ int crow(int r, int hi) { return (r & 3) + 8 * (r >> 2) + 4 * hi; }
__device__ __forceinline__ void glds16(const void* gsrc, unsigned lds_dst) { unsigned keep;
    asm volatile("s_mov_b32 %0, m0\n\ts_mov_b32 m0, %2\n\ts_nop 0\n\tglobal_load_lds_dwordx4 %1, off\n\ts_mov_b32 m0, %0" : "=&s"(keep) : "v"(gsrc), "s"(lds_dst) : "memory"); }
__device__ __forceinline__ unsigned cvtpk(float lo, float hi) { unsigned r; asm volatile("v_cvt_pk_bf16_f32 %0, %1, %2" : "=v"(r) : "v"(lo), "v"(hi)); return r; }
__device__ __forceinline__ s16x4 vtr(lds_cptr p) { return __builtin_bit_cast(s16x4, __builtin_amdgcn_ds_read_tr16_b64_v4i16((ATT_LAS v4i16_t*)p)); }
#define ATT_WAIT_BAR() asm volatile("s_waitcnt vmcnt(0) lgkmcnt(0)\n\ts_barrier" ::: "memory")

struct Unit {
    const bf16_t* Q; int q_pitch;
    const bf16_t* K; int k_pitch;
    const bf16_t* Kr;
    const bf16_t* V; int v_pitch;
    int key0, ntiles;
    int q0;
    const unsigned short* list; int len;
    const float* posf;
    float slope2;
    bf16_t* O; int o_pitch;
    bf16_t* part; float* plse; int h;
};

template <int MODE> __device__ __forceinline__ void unit(const Unit& U, char* shm, const int wid) {
    constexpr int DQK = (MODE == 0) ? 96 : 64, ND0 = DQK / 16;
    const int lane = pg8::lane_id_v(), tid = wid * 64 + lane, r32 = lane & 31, hi = lane >> 5;
    const unsigned lds0 = (unsigned)(uintptr_t)shm;
    const lds_cptr shm3 = (lds_cptr)shm;
    ATT_LAS float* wsf = (ATT_LAS float*)(shm3 + LDS_WS) + wid * 64;
    int qrow, slot = 0; bool valid = true;
    if (MODE == 2) { const int e = wid * 32 + r32; valid = e < U.len; const unsigned ent = valid ? (unsigned)U.list[e] : (unsigned)U.list[0]; qrow = (int)(ent & 0x3FFFu); slot = 1 + (int)(ent >> 14); }
    else qrow = U.q0 + wid * 32 + r32;
    const bf16_t* ksrc = U.K + (size_t)(U.key0 + lane) * U.k_pitch + wid * 8;
    const bf16_t* krsrc = (MODE == 0) ? U.Kr + (size_t)(U.key0 + lane) * 32 + (wid & 3) * 8 : nullptr;
    const bf16_t* vsrc = U.V + (size_t)(U.key0 + 16 * (wid & 3) + (lane >> 2)) * U.v_pitch + (wid >> 2) * 32 + (lane & 3) * 8;
    const unsigned kdst = lds0 + LDS_K + wid * 1024, krdst = lds0 + LDS_K + (8 + (wid & 3)) * 1024, vdst = lds0 + LDS_V + wid * 1024;
#define ATT_DMA(t, ks, vs) do { glds16(ksrc + (size_t)(t) * KVBLK * U.k_pitch, (unsigned)__builtin_amdgcn_readfirstlane(kdst + (ks))); \
        if (MODE == 0 && wid < 4) glds16(krsrc + (size_t)(t) * KVBLK * 32, (unsigned)__builtin_amdgcn_readfirstlane(krdst + (ks))); \
        glds16(vsrc + (size_t)(t) * KVBLK * U.v_pitch, (unsigned)__builtin_amdgcn_readfirstlane(vdst + (vs))); } while (0)
    const int NT = U.ntiles;
    ATT_DMA(0, 0, 0);
    if (NT > 1) ATT_DMA(1, KSLOT, VSLOT);
    bf16x8 qr[ND0];
    { const bf16_t* Qw = U.Q + (size_t)qrow * U.q_pitch + hi * 8;
#pragma unroll
      for (int d0 = 0; d0 < ND0; ++d0) qr[d0] = *reinterpret_cast<const bf16x8*>(Qw + d0 * 16); }
    float pq = 0.f;
    if (MODE != 0) { pq = U.posf[qrow]; if (tid < 256) ((ATT_LAS float*)(shm3 + LDS_POSK))[tid] = U.posf[U.key0 + tid]; }
    float mhat = -1e30f, l_reg = 0.f; f32x16 o[2]; o[0] = f32x16{}; o[1] = f32x16{};
    const lds_cptr kp0 = shm3 + LDS_K + hi * 1024 + r32 * 16;
    const lds_cptr vp0 = shm3 + LDS_V + ((lane >> 4) & 1) * 32 + (lane & 3) * 8 + (4 * hi + ((lane & 15) >> 2)) * 64;
    int ks_cur = 0, vs_cur = 0, ks_free = 2 * KSLOT, vs_free = 2 * VSLOT;
    for (int t = 0; t < NT; ++t) {
        ATT_WAIT_BAR();
        if (t + 2 < NT) ATT_DMA(t + 2, ks_free, vs_free);
        bool active = true;
        if (MODE == 1) active = (64 * t <= wid * 32 + 31);
        if (active) {
            f32x16 p0 = f32x16{}, p1 = f32x16{};
            const lds_cptr kp = kp0 + ks_cur;
#pragma unroll
            for (int d0 = 0; d0 < ND0; ++d0) {
                const bf16x8 b0 = *(const ATT_LAS bf16x8*)(kp + d0 * 2048);
                const bf16x8 b1 = *(const ATT_LAS bf16x8*)(kp + d0 * 2048 + 512);
                p0 = __builtin_amdgcn_mfma_f32_32x32x16_bf16(b0, qr[d0], p0, 0, 0, 0);
                p1 = __builtin_amdgcn_mfma_f32_32x32x16_bf16(b1, qr[d0], p1, 0, 0, 0);
            }
            if (MODE != 0) {
                const ATT_LAS float* pk = (const ATT_LAS float*)(shm3 + LDS_POSK) + 64 * t + 4 * hi;
#pragma unroll
                for (int g = 0; g < 4; ++g) { const f32x4 a = *(const ATT_LAS f32x4*)(pk + 8 * g), b = *(const ATT_LAS f32x4*)(pk + 8 * g + 32);
#pragma unroll
                    for (int j = 0; j < 4; ++j) { p0[4 * g + j] -= U.slope2 * __builtin_fabsf(pq - a[j]); p1[4 * g + j] -= U.slope2 * __builtin_fabsf(pq - b[j]); } }
            }
            if (MODE == 0 || MODE == 1) {
                const int kb = U.key0 + 64 * t;
                if (kb + 63 > U.q0 + wid * 32) {
                    const int dq = qrow - kb - 4 * hi;
#pragma unroll
                    for (int r = 0; r < 16; ++r) { const int c = (r & 3) + 8 * (r >> 2); if (c > dq) p0[r] = -INFINITY; if (c + 32 > dq) p1[r] = -INFINITY; }
                }
            }
            float rm = p0[0];
#pragma unroll
            for (int r = 1; r < 16; ++r) rm = fmaxf(rm, p0[r]);
#pragma unroll
            for (int r = 0; r < 16; ++r) rm = fmaxf(rm, p1[r]);
            { auto rr = __builtin_amdgcn_permlane32_swap(__float_as_uint(rm), __float_as_uint(rm), false, false); rm = fmaxf(__uint_as_float(rr[0]), __uint_as_float(rr[1])); }
            if (__any(rm > mhat)) {
                const float mn = fmaxf(mhat, rm), f = __builtin_amdgcn_exp2f(mhat - mn);
                mhat = mn; l_reg *= f;
                if (hi == 0) wsf[r32] = f;
                asm volatile("s_waitcnt lgkmcnt(0)" ::: "memory");
#pragma unroll
                for (int g = 0; g < 4; ++g) { const f32x4 fv = *(const ATT_LAS f32x4*)(wsf + 8 * g + 4 * hi);
#pragma unroll
                    for (int j = 0; j < 4; ++j) { o[0][4 * g + j] *= fv[j]; o[1][4 * g + j] *= fv[j]; } }
            }
            float sacc = 0.f;
#pragma unroll
            for (int r = 0; r < 16; ++r) { p0[r] = __builtin_amdgcn_exp2f(p0[r] - mhat); p1[r] = __builtin_amdgcn_exp2f(p1[r] - mhat); sacc += p0[r] + p1[r]; }
            l_reg += sacc;
            u32x4 pw[4];
#pragma unroll
            for (int s = 0; s < 2; ++s) { pw[s] = (u32x4){cvtpk(p0[8 * s], p0[8 * s + 1]), cvtpk(p0[8 * s + 2], p0[8 * s + 3]), cvtpk(p0[8 * s + 4], p0[8 * s + 5]), cvtpk(p0[8 * s + 6], p0[8 * s + 7])};
                pw[2 + s] = (u32x4){cvtpk(p1[8 * s], p1[8 * s + 1]), cvtpk(p1[8 * s + 2], p1[8 * s + 3]), cvtpk(p1[8 * s + 4], p1[8 * s + 5]), cvtpk(p1[8 * s + 6], p1[8 * s + 7])}; }
            const lds_cptr vp = vp0 + vs_cur;
#pragma unroll
            for (int d0 = 0; d0 < 2; ++d0)
#pragma unroll
                for (int ks = 0; ks < 4; ++ks) { const s16x4 lo = vtr(vp + d0 * 4096 + ks * 1024), hh = vtr(vp + d0 * 4096 + ks * 1024 + 512);
                    const bf16x8 vf = (bf16x8){lo[0], lo[1], lo[2], lo[3], hh[0], hh[1], hh[2], hh[3]};
                    o[d0] = __builtin_amdgcn_mfma_f32_32x32x16_bf16(__builtin_bit_cast(bf16x8, pw[ks]), vf, o[d0], 0, 0, 0); }
        }
        { const int kn = ks_cur + KSLOT, vn = vs_cur + VSLOT; const int kf = ks_cur, vf_ = vs_cur; ks_cur = (kn == NSLOT * KSLOT) ? 0 : kn; vs_cur = (vn == NSLOT * VSLOT) ? 0 : vn; ks_free = kf; vs_free = vf_; }
    }
    { auto rr = __builtin_amdgcn_permlane32_swap(__float_as_uint(l_reg), __float_as_uint(l_reg), false, false); l_reg = __uint_as_float(rr[0]) + __uint_as_float(rr[1]); }
    if (hi == 0) wsf[32 + r32] = l_reg;
    asm volatile("s_waitcnt lgkmcnt(0)" ::: "memory");
    float rli[16];
#pragma unroll
    for (int r = 0; r < 16; ++r) rli[r] = __builtin_amdgcn_rcpf(wsf[32 + crow(r, hi)]);
    ATT_LAS bf16_t* stg = (ATT_LAS bf16_t*)(shm3 + LDS_OST) + wid * 2048;
#pragma unroll
    for (int r = 0; r < 16; ++r) { const int orow = crow(r, hi);
#pragma unroll
        for (int d0 = 0; d0 < 2; ++d0) { const unsigned w = cvtpk(o[d0][r] * rli[r], 0.f); stg[orow * 64 + d0 * 32 + r32] = (bf16_t)(w & 0xFFFFu); } }
    asm volatile("s_waitcnt lgkmcnt(0)" ::: "memory");
    if (MODE == 0) {
        bf16_t* Ow = U.O + (size_t)(U.q0 + wid * 32) * U.o_pitch;
#pragma unroll
        for (int i = 0; i < 4; ++i) { const int row = i * 8 + (lane >> 3), ch = lane & 7; const u32x4 v = *(const ATT_LAS u32x4*)(stg + row * 64 + ch * 8); *(u32x4*)(Ow + (size_t)row * U.o_pitch + ch * 8) = v; }
    } else {
        const int meta = valid ? ((qrow << 2) | slot) : -1;
#pragma unroll
        for (int i = 0; i < 4; ++i) { const int row = i * 8 + (lane >> 3), ch = lane & 7; const int mt = __shfl(meta, row); const u32x4 v = *(const ATT_LAS u32x4*)(stg + row * 64 + ch * 8);
            if (mt >= 0) *(u32x4*)(U.part + ((size_t)((mt >> 2) * 8 + U.h) * 4 + (mt & 3)) * 64 + ch * 8) = v; }
        if (hi == 0 && valid) U.plse[(size_t)(qrow * 8 + U.h) * 4 + slot] = mhat + __builtin_log2f(l_reg);
    }
    asm volatile("s_waitcnt vmcnt(0) lgkmcnt(0)\n\ts_barrier" ::: "memory");
#undef ATT_DMA
}
}

namespace mk {
typedef unsigned short bf16;
typedef unsigned v4u __attribute__((ext_vector_type(4)));
typedef float f32x4 __attribute__((ext_vector_type(4)));
#define MK_LAS __attribute__((address_space(3)))
using namespace mkc;
constexpr int NWAVES = 8;
constexpr int RING_BYTES = 131072, LDS_EXTRA = RING_BYTES, LDS_BYTES = 147456;

struct Args { const float* in[18]; float* out; unsigned char* ws; int ph_lo, ph_hi; };
struct Frame { MK_LAS unsigned char* lds; int tid, lane, wave, vcu, G; };
typedef const __attribute__((address_space(4))) Args* kargs_t;
__device__ __forceinline__ kargs_t kargs() { kargs_t p = (kargs_t)__builtin_amdgcn_kernarg_segment_ptr(); asm volatile("" : "+s"(p)); return p; }
__device__ __forceinline__ Frame mkframe(MK_LAS unsigned char* lds, int wave) { Frame F; F.lds = lds; F.wave = wave; F.lane = pg8::lane_id_v(); F.tid = wave * 64 + F.lane; F.G = gridDim.x;
    { const int bx = blockIdx.x; F.vcu = (F.G % 8 == 0) ? (bx % 8) * (F.G / 8) + bx / 8 : bx; } return F; }

__device__ __forceinline__ unsigned f2bf(float f) { unsigned u = __builtin_bit_cast(unsigned, f); return (u + 0x7fffu + ((u >> 16) & 1u)) >> 16; }
__device__ __forceinline__ unsigned pk2(float lo, float hi) { return f2bf(lo) | (f2bf(hi) << 16); }
__device__ __forceinline__ float bf2f(unsigned short b) { return __builtin_bit_cast(float, (unsigned)b << 16); }
__device__ __forceinline__ float wave_sum(float v) {
#pragma unroll
    for (int o = 1; o < 64; o <<= 1) v += __shfl_xor(v, o);
    return v;
}
__constant__ float ROPE_INV[16] = {1.000000000e+00f, 5.623413324e-01f, 3.162277639e-01f, 1.778279394e-01f, 1.000000015e-01f, 5.623413250e-02f, 3.162277490e-02f, 1.778279431e-02f,
                                   9.999999776e-03f, 5.623413250e-03f, 3.162277630e-03f, 1.778279431e-03f, 1.000000047e-03f, 5.623413017e-04f, 3.162277571e-04f, 1.778279402e-04f};
__device__ __forceinline__ int rope_phys(int L) { return L < 16 ? 8 * (L >> 2) + (L & 3) : 8 * ((L - 16) >> 2) + 4 + ((L - 16) & 3); }

__device__ __forceinline__ void p0_item(const float* W, int K, int N, bf16* WT, const float* gain, int kind, MK_LAS float* scr, int item, int lane) {
    const int nblk = N / 32, kb = item / nblk, nb = item % nblk, k0 = 64 * kb, n0 = 32 * nb;
    int dbase = n0; bool perm = false; float mul = 1.0f;
    if (kind == 1) dbase = (n0 >> 7) * 256 + (n0 & 127);
    else if (kind == 2) dbase = (n0 >> 7) * 256 + 128 + (n0 & 127);
    else if (kind == 3) { if (n0 == 640) perm = true; else if (n0 >= 672) { dbase = n0 + 96; if (n0 < 1184) mul = C2M; } }
    else if (kind == 4) { perm = (n0 % 96) == 64; mul = C2Q; }
    else if (kind == 5) { const int h = n0 >> 7, e = n0 & 127; dbase = e < 64 ? h * 64 + e : 512 + h * 64 + (e - 64); }
#pragma unroll 8
    for (int i = 0; i < 32; ++i) { const int kk = 2 * i + (lane >> 5); const float g = gain ? gain[k0 + kk] * mul : mul; scr[kk * 33 + (lane & 31)] = W[(size_t)(k0 + kk) * N + n0 + (lane & 31)] * g; }
    asm volatile("s_waitcnt lgkmcnt(0)" ::: "memory");
    const int c = lane & 7;
#pragma unroll
    for (int j = 0; j < 4; ++j) { const int n = (lane >> 3) + 8 * j; const MK_LAS float* s = scr + (8 * c) * 33 + n;
        v4u o; o.x = pk2(s[0 * 33], s[1 * 33]); o.y = pk2(s[2 * 33], s[3 * 33]); o.z = pk2(s[4 * 33], s[5 * 33]); o.w = pk2(s[6 * 33], s[7 * 33]);
        const int drow = dbase + (perm ? rope_phys(n) : n);
        *(v4u*)(WT + (size_t)drow * K + k0 + 8 * c) = o; }
    asm volatile("s_waitcnt lgkmcnt(0)" ::: "memory");
}
__device__ __forceinline__ void p0_prologue(const Frame& F, kargs_t ap) {
    unsigned char* ws = ap->ws;
    MK_LAS float* scr = (MK_LAS float*)(F.lds + F.wave * 16384);
    const int gw = F.vcu * NWAVES + F.wave, NGW = F.G * NWAVES;
    constexpr int I_G = (DM / 64) * (DFF / 32), I_D = (DFF / 64) * (DM / 32), I_IN = (DM / 64) * (2208 / 32), I_UQ = (384 / 64) * (768 / 32), I_UKV = (256 / 64) * (1024 / 32), I_O = (DM / 64) * (DM / 32);
    constexpr int NITEMS = 4 * I_G + 2 * I_D + I_IN + I_UQ + I_UKV + I_O;
    for (int it = gw; it < NITEMS; it += NGW) {
        int r = it;
        if (r < I_G) { p0_item(ap->in[3], DM, DFF, (bf16*)(ws + WS_WGU1), ap->in[2], 1, scr, r, F.lane); continue; } r -= I_G;
        if (r < I_G) { p0_item(ap->in[4], DM, DFF, (bf16*)(ws + WS_WGU1), ap->in[2], 2, scr, r, F.lane); continue; } r -= I_G;
        if (r < I_D) { p0_item(ap->in[5], DFF, DM, (bf16*)(ws + WS_WD1), nullptr, 0, scr, r, F.lane); continue; } r -= I_D;
        if (r < I_G) { p0_item(ap->in[14], DM, DFF, (bf16*)(ws + WS_WGU2), ap->in[13], 1, scr, r, F.lane); continue; } r -= I_G;
        if (r < I_G) { p0_item(ap->in[15], DM, DFF, (bf16*)(ws + WS_WGU2), ap->in[13], 2, scr, r, F.lane); continue; } r -= I_G;
        if (r < I_D) { p0_item(ap->in[16], DFF, DM, (bf16*)(ws + WS_WD2), nullptr, 0, scr, r, F.lane); continue; } r -= I_D;
        if (r < I_IN) { p0_item(ap->in[7], DM, 2208, (bf16*)(ws + WS_WIN), ap->in[6], 3, scr, r, F.lane); continue; } r -= I_IN;
        if (r < I_UQ) { p0_item(ap->in[9], 384, 768, (bf16*)(ws + WS_WUQ), ap->in[8], 4, scr, r, F.lane); continue; } r -= I_UQ;
        if (r < I_UKV) { p0_item(ap->in[11], 256, 1024, (bf16*)(ws + WS_WUKV), ap->in[10], 5, scr, r, F.lane); continue; } r -= I_UKV;
        p0_item(ap->in[12], DM, DM, (bf16*)(ws + WS_WOUT), nullptr, 0, scr, r, F.lane);
    }
    const float* x = ap->in[0]; bf16* xb = (bf16*)(ws + WS_XB); float* ss1 = (float*)(ws + WS_SS1);
    for (int m = gw; m < S; m += NGW) {
        const f32x4* xr = (const f32x4*)(x + (size_t)m * DM) + F.lane; unsigned long long* o8 = (unsigned long long*)(xb + (size_t)m * DM) + F.lane; float s = 0.f;
#pragma unroll
        for (int j = 0; j < 4; ++j) { const f32x4 v = xr[64 * j]; s += (v[0] * v[0] + v[1] * v[1]) + (v[2] * v[2] + v[3] * v[3]); o8[64 * j] = (unsigned long long)pk2(v[0], v[1]) | ((unsigned long long)pk2(v[2], v[3]) << 32); }
        s = wave_sum(s); if (F.lane == 0) ss1[m] = s;
    }
    const int* pos = (const int*)ap->in[1]; float* posf = (float*)(ws + WS_POSF); float* cosT = (float*)(ws + WS_COS); float* sinT = (float*)(ws + WS_SIN);
    const int gt = (F.vcu * NWAVES + F.wave) * 64 + F.lane, NGT = NGW * 64;
    for (int e = gt; e < S * 16; e += NGT) { const int s_ = e >> 4, i = e & 15; const float ang = (float)pos[s_] * ROPE_INV[i]; float sn, cs; sincosf(ang, &sn, &cs); cosT[e] = cs; sinT[e] = sn; if (i == 0) posf[s_] = (float)pos[s_]; }
    float* z = (float*)(ws + WS_SS2);
    for (int e = gt; e < 5 * S; e += NGT) z[e] = 0.f;
    float* km = (float*)(ws + WS_KMS);
    for (int e = gt; e < 64 * 512; e += NGT) km[e] = 0.f;
    unsigned* cnt = (unsigned*)(ws + WS_CNT);
    for (int e = gt; e < 512; e += NGT) cnt[e] = 0u;
    unsigned* padz = (unsigned*)((bf16*)(ws + WS_WIN) + (size_t)672 * DM);
    for (int e = gt; e < 96 * DM / 2; e += NGT) padz[e] = 0u;
}

__device__ __forceinline__ void p4_krope(const Frame& F, kargs_t ap) { unsigned char* const wsb = ap->ws;
    const bf16* cqkv = (const bf16*)(wsb + WS_CQKV); bf16* Kr = (bf16*)(wsb + WS_KR); const float* cosT = (const float*)(wsb + WS_COS); const float* sinT = (const float*)(wsb + WS_SIN);
    const int gt = (F.vcu * NWAVES + F.wave) * 64 + F.lane, NGT = F.G * NWAVES * 64;
    for (int e = gt; e < S * 16; e += NGT) { const int s_ = e >> 4, i = e & 15, g = i >> 2, j = i & 3;
        const float x1 = bf2f(cqkv[(size_t)s_ * 768 + 640 + 8 * g + j]), x2 = bf2f(cqkv[(size_t)s_ * 768 + 640 + 8 * g + 4 + j]); const float c = cosT[e], sn = sinT[e];
        Kr[(size_t)s_ * 32 + 8 * g + j] = (bf16)f2bf(x1 * c - x2 * sn); Kr[(size_t)s_ * 32 + 8 * g + 4 + j] = (bf16)f2bf(x1 * sn + x2 * c); }
}
__device__ __forceinline__ void p4_gating(const Frame& F, kargs_t ap) { unsigned char* const wsb = ap->ws;
    const bf16* mqkv = (const bf16*)(wsb + WS_MQKV); const float* kms = (const float*)(wsb + WS_KMS); unsigned* cnt = (unsigned*)(wsb + WS_CNT); unsigned short* lists = (unsigned short*)(wsb + WS_LIST);
    MK_LAS float* km = (MK_LAS float*)F.lds;
    for (int u = F.vcu; u < 256; u += F.G) {
        const int h = u & 7, q = (u >> 3) * 512 + F.tid, own = q >> 8;
        __syncthreads();
        for (int e = F.tid; e < 4096; e += 512) km[e] = kms[(size_t)(e >> 6) * 512 + h * 64 + (e & 63)] * (1.0f / 256.0f);
        __syncthreads();
        float qv[64];
        { const v4u* qp = (const v4u*)(mqkv + (size_t)q * 1536 + h * 64);
#pragma unroll
          for (int c = 0; c < 8; ++c) { const v4u w = qp[c];
#pragma unroll
              for (int j = 0; j < 4; ++j) { qv[8 * c + 2 * j] = __builtin_bit_cast(float, w[j] << 16); qv[8 * c + 2 * j + 1] = __builtin_bit_cast(float, w[j] & 0xFFFF0000u); } } }
        float g0 = -3e38f, g1 = -3e38f, g2 = -3e38f; int i0 = -1, i1 = -1, i2 = -1;
        const int own_max = __builtin_amdgcn_readfirstlane(own);
        for (int n = 0; n < own_max; ++n) {
            float g = 0.f;
#pragma unroll
            for (int c = 0; c < 16; ++c) { const f32x4 kk = *(const MK_LAS f32x4*)(km + n * 64 + 4 * c); g = fmaf(qv[4 * c], kk[0], g); g = fmaf(qv[4 * c + 1], kk[1], g); g = fmaf(qv[4 * c + 2], kk[2], g); g = fmaf(qv[4 * c + 3], kk[3], g); }
            if (g > g0) { g2 = g1; i2 = i1; g1 = g0; i1 = i0; g0 = g; i0 = n; }
            else if (g > g1) { g2 = g1; i2 = i1; g1 = g; i1 = n; }
            else if (g > g2) { g2 = g; i2 = n; }
        }
#pragma unroll
        for (int k = 0; k < 3; ++k) { const int n = k == 0 ? i0 : k == 1 ? i1 : i2;
            if (n >= 0) { const unsigned p = atomicAdd(cnt + h * 64 + n, 1u); lists[(size_t)(h * 64 + n) * S + p] = (unsigned short)(q | (k << 14)); } }
    }
    __syncthreads();
}
__device__ __forceinline__ void p5_combine(const Frame& F, kargs_t ap) { unsigned char* const wsb = ap->ws;
    const bf16* part = (const bf16*)(wsb + WS_PART); const float* plse = (const float*)(wsb + WS_PLSE); bf16* cat = (bf16*)(wsb + WS_CAT);
    const int gt = (F.vcu * NWAVES + F.wave) * 64 + F.lane, NGT = F.G * NWAVES * 64;
    for (int e = gt; e < S * 8 * 8; e += NGT) { const int dg = e & 7, qh = e >> 3, q = qh >> 3, h = qh & 7; const int ns = 1 + min(3, q >> 8);
        const f32x4 ls = *(const f32x4*)(plse + (size_t)qh * 4);
        float M = ls[0]; for (int s = 1; s < 4; ++s) if (s < ns) M = fmaxf(M, ls[s]);
        float acc[8], wsum = 0.f;
#pragma unroll
        for (int j = 0; j < 8; ++j) acc[j] = 0.f;
#pragma unroll
        for (int s = 0; s < 4; ++s) if (s < ns) { const float w = __builtin_amdgcn_exp2f(ls[s] - M); wsum += w; const v4u v = *(const v4u*)(part + ((size_t)qh * 4 + s) * 64 + dg * 8);
#pragma unroll
            for (int j = 0; j < 4; ++j) { acc[2 * j] += w * __builtin_bit_cast(float, v[j] << 16); acc[2 * j + 1] += w * __builtin_bit_cast(float, v[j] & 0xFFFF0000u); } }
        const float r = 1.0f / wsum; v4u o; o.x = pk2(acc[0] * r, acc[1] * r); o.y = pk2(acc[2] * r, acc[3] * r); o.z = pk2(acc[4] * r, acc[5] * r); o.w = pk2(acc[6] * r, acc[7] * r);
        *(v4u*)(cat + (size_t)q * 1024 + 512 + h * 64 + dg * 8) = o; }
}
__device__ __forceinline__ void p9_final(const Frame& F, kargs_t ap) { unsigned char* const wsb = ap->ws;
    const float* ss = (const float*)(wsb + WS_SS4); const float* g = ap->in[17];
    const int gw = F.vcu * NWAVES + F.wave, NGW = F.G * NWAVES;
    for (int m = gw; m < S; m += NGW) { const float rs = 1.0f / sqrtf(ss[m] * (1.0f / 1024.0f) + 1e-6f); f32x4* xr = (f32x4*)(ap->out + (size_t)m * DM) + F.lane; const f32x4* gr = (const f32x4*)g + F.lane;
#pragma unroll
        for (int j = 0; j < 4; ++j) { const f32x4 v = xr[64 * j]; xr[64 * j] = v * rs * gr[64 * j]; } }
}

__global__ void __launch_bounds__(NWAVES * 64, 2) mk_fwd(Args a_unused) {
    extern __shared__ __attribute__((aligned(16))) unsigned char lds[];
    const int wave = __builtin_amdgcn_readfirstlane(threadIdx.x >> 6);
    MK_LAS unsigned char* const ldsp = (MK_LAS unsigned char*)lds;
    int lo, hi; { kargs_t ap = kargs(); lo = ap->ph_lo; hi = ap->ph_hi; }
#ifndef MK_ONLY
#define MK_ONLY -1
#endif
#define IN(k) ((MK_ONLY < 0 || MK_ONLY == (k)) && lo <= (k) && (k) < hi)
#define SEAM(k) do { if (IN(k) && IN((k) + 1)) { cg::this_grid().sync(); } } while (0)
    if (IN(0)) { kargs_t ap = kargs(); const Frame F = mkframe(ldsp, wave); p0_prologue(F, ap); } SEAM(0);
    if (IN(1)) { kargs_t ap = kargs(); unsigned char* ws = ap->ws; pg8::Gemm g{(const bf16*)(ws + WS_XB), (const bf16*)(ws + WS_WGU1), S, NGU, DM, DM}; pg8::StaticOrder So; So.init(S, NGU, (int)gridDim.x, (int)blockIdx.x);
        pg8::EpiSwiGLU E{ws, 0}; pg8::gemm_phase<pg8::EpiSwiGLU, pg8::StaticOrder, true, true>(ldsp, g, So, E, wave); } SEAM(1);
    if (IN(2)) { kargs_t ap = kargs(); unsigned char* ws = ap->ws; pg8::Gemm g{(const bf16*)(ws + WS_ACT), (const bf16*)(ws + WS_WD1), S, DM, DFF, DFF}; pg8::StaticOrder So; So.init(S, DM, (int)gridDim.x, (int)blockIdx.x);
        pg8::EpiResid E{ap->in[0], ap->out, ws, (int)WS_SS2, 1, 0.5f}; pg8::gemm_phase<pg8::EpiResid, pg8::StaticOrder, true, true>(ldsp, g, So, E, wave); } SEAM(2);
    if (IN(3)) { kargs_t ap = kargs(); unsigned char* ws = ap->ws; pg8::Gemm g{(const bf16*)(ws + WS_XB), (const bf16*)(ws + WS_WIN), S, NWIN, DM, DM}; pg8::StaticOrder So; So.init(S, NWIN, (int)gridDim.x, (int)blockIdx.x);
        pg8::EpiWin E{ws}; pg8::gemm_phase<pg8::EpiWin, pg8::StaticOrder, true, true>(ldsp, g, So, E, wave); } SEAM(3);
    if (IN(4)) {
        { kargs_t ap = kargs(); unsigned char* ws = ap->ws; pg8::Gemm g{(const bf16*)(ws + WS_CQKV) + 384, (const bf16*)(ws + WS_WUKV), S, 1024, 256, 768}; pg8::StaticOrder So; So.init(S, 1024, (int)gridDim.x, (int)blockIdx.x);
          pg8::EpiKV E{ws}; pg8::gemm_phase<pg8::EpiKV, pg8::StaticOrder, true, true>(ldsp, g, So, E, wave); }
        { kargs_t ap = kargs(); unsigned char* ws = ap->ws; pg8::Gemm g{(const bf16*)(ws + WS_CQKV), (const bf16*)(ws + WS_WUQ), S, 768, 384, 768}; pg8::StaticOrder So; So.init(S, 768, (int)gridDim.x, (int)blockIdx.x);
          pg8::EpiQ E{ws}; pg8::gemm_phase<pg8::EpiQ, pg8::StaticOrder, true, true>(ldsp, g, So, E, wave); }
        { kargs_t ap = kargs(); const Frame F = mkframe(ldsp, wave); p4_krope(F, ap); }
#ifndef MK_NO_GATE
        { kargs_t ap = kargs(); const Frame F = mkframe(ldsp, wave); p4_gating(F, ap); }
#endif
    } SEAM(4);
#ifndef MK_NO_ATT5
    if (IN(5)) {
        kargs_t ap = kargs(); unsigned char* ws = ap->ws; const Frame F = mkframe(ldsp, wave);
        const bf16* mqkv = (const bf16*)(ws + WS_MQKV); const float* posf = (const float*)(ws + WS_POSF);
        att::Unit U; U.Kr = nullptr; U.posf = posf; U.part = (bf16*)(ws + WS_PART); U.plse = (float*)(ws + WS_PLSE); U.O = nullptr; U.o_pitch = 0; U.q_pitch = 1536; U.k_pitch = 1536; U.v_pitch = 1536; U.ntiles = 4;
        for (int u = F.vcu; u < 512; u += F.G) { const int h = u & 7, n = u >> 3;
            U.h = h; U.Q = mqkv + h * 64; U.K = mqkv + 512 + h * 64; U.V = mqkv + 1024 + h * 64; U.key0 = n * 256; U.q0 = n * 256; U.list = nullptr; U.len = 0; U.slope2 = exp2f(-(float)(h + 1)) * LOG2E;
            att::unit<1>(U, (char*)lds, wave); }
        MK_LAS int* pre = (MK_LAS int*)(ldsp + LDS_EXTRA);
        const unsigned* cnt = (const unsigned*)(ws + WS_CNT);
        __syncthreads();
        { const int c = (int)cnt[F.tid]; pre[F.tid] = (c + 255) >> 8; }
        __syncthreads();
        for (int o = 1; o < 512; o <<= 1) { const int v = pre[F.tid] + (F.tid >= o ? pre[F.tid - o] : 0); __syncthreads(); pre[F.tid] = v; __syncthreads(); }
        const int total = pre[511];
        for (int gI = F.vcu; gI < total; gI += F.G) {
            int lo_ = 0, hi_ = 511;
            while (lo_ < hi_) { const int mid = (lo_ + hi_) >> 1; if (pre[mid] > gI) hi_ = mid; else lo_ = mid + 1; }
            const int hn = __builtin_amdgcn_readfirstlane(lo_), c = gI - (hn ? pre[hn - 1] : 0), h = hn >> 6, n = hn & 63; const int len = (int)cnt[hn] - c * 256;
            U.h = h; U.Q = mqkv + h * 64; U.K = mqkv + 512 + h * 64; U.V = mqkv + 1024 + h * 64; U.key0 = n * 256; U.q0 = 0; U.list = (const unsigned short*)(ws + WS_LIST) + (size_t)hn * S + c * 256; U.len = len < 256 ? len : 256;
            U.slope2 = exp2f(-(float)(h + 1)) * LOG2E;
            att::unit<2>(U, (char*)lds, wave); }
    }
#endif
    SEAM(5);
    if (IN(6)) {
        { kargs_t ap = kargs(); const Frame F = mkframe(ldsp, wave); p5_combine(F, ap); }
#ifndef MK_NO_ATT6
        kargs_t ap = kargs(); unsigned char* ws = ap->ws; const Frame F = mkframe(ldsp, wave);
        att::Unit U; U.posf = nullptr; U.part = nullptr; U.plse = nullptr; U.list = nullptr; U.len = 0; U.slope2 = 0.f; U.q_pitch = 768; U.k_pitch = 512; U.v_pitch = 512; U.o_pitch = 1024; U.key0 = 0; U.Kr = (const bf16*)(ws + WS_KR);
        for (int v = F.vcu; v < 256; v += F.G) { const int h = v >> 5, s_ = v & 31;
            for (int i = 0; i < 2; ++i) { const int qb = i == 0 ? 63 - s_ : s_;
                U.h = h; U.Q = (const bf16*)(ws + WS_Q) + h * 96; U.K = (const bf16*)(ws + WS_KN) + h * 64; U.V = (const bf16*)(ws + WS_V) + h * 64; U.O = (bf16*)(ws + WS_CAT) + h * 64; U.q0 = qb * 256; U.ntiles = 4 * (qb + 1);
                att::unit<0>(U, (char*)lds, wave); } }
#endif
    } SEAM(6);
    if (IN(7)) { kargs_t ap = kargs(); unsigned char* ws = ap->ws; pg8::Gemm g{(const bf16*)(ws + WS_CAT), (const bf16*)(ws + WS_WOUT), S, DM, DM, DM}; pg8::StaticOrder So; So.init(S, DM, (int)gridDim.x, (int)blockIdx.x);
        pg8::EpiResid E{ap->out, ap->out, ws, (int)WS_SS3, 1, 1.0f}; pg8::gemm_phase<pg8::EpiResid, pg8::StaticOrder, true, true>(ldsp, g, So, E, wave); } SEAM(7);
    if (IN(8)) { kargs_t ap = kargs(); unsigned char* ws = ap->ws; pg8::Gemm g{(const bf16*)(ws + WS_XB), (const bf16*)(ws + WS_WGU2), S, NGU, DM, DM}; pg8::StaticOrder So; So.init(S, NGU, (int)gridDim.x, (int)blockIdx.x);
        pg8::EpiSwiGLU E{ws, 1}; pg8::gemm_phase<pg8::EpiSwiGLU, pg8::StaticOrder, true, true>(ldsp, g, So, E, wave); } SEAM(8);
    if (IN(9)) { kargs_t ap = kargs(); unsigned char* ws = ap->ws; pg8::Gemm g{(const bf16*)(ws + WS_ACT), (const bf16*)(ws + WS_WD2), S, DM, DFF, DFF}; pg8::StaticOrder So; So.init(S, DM, (int)gridDim.x, (int)blockIdx.x);
        pg8::EpiResid E{ap->out, ap->out, ws, (int)WS_SS4, 0, 0.5f}; pg8::gemm_phase<pg8::EpiResid, pg8::StaticOrder, true, true>(ldsp, g, So, E, wave); } SEAM(9);
    if (IN(10)) { kargs_t ap = kargs(); const Frame F = mkframe(ldsp, wave); p9_final(F, ap); }
#undef IN
#undef SEAM
}
constexpr int N_PHASES = 11;
}
#ifndef MK_BRINGUP
#define MK_BRINGUP 0
#endif
extern "C" void kernel_launch(void* const* d_in, const int* in_sizes, int n_in, void* d_out, int out_size, void* d_ws, size_t ws_size, hipStream_t stream) {
    static int grid = 0;
    if (grid == 0) {
        if (hipFuncSetAttribute((const void*)mk::mk_fwd, hipFuncAttributeMaxDynamicSharedMemorySize, mk::LDS_BYTES) != hipSuccess) { fprintf(stderr, "kernel_launch: hipFuncSetAttribute failed\n"); grid = -1; return; }
        int dev = 0, cus = 0, per_cu = 0;
        hipGetDevice(&dev); hipDeviceGetAttribute(&cus, hipDeviceAttributeMultiprocessorCount, dev);
        hipOccupancyMaxActiveBlocksPerMultiprocessor(&per_cu, (const void*)mk::mk_fwd, mk::NWAVES * 64, mk::LDS_BYTES);
        (void)hipGetLastError();
        grid = cus * (per_cu < 1 ? 1 : (per_cu > 1 ? 1 : per_cu));
        if (grid % 8 != 0 || grid <= 0) grid = 256;
        if (ws_size < mk::WS_END) { fprintf(stderr, "kernel_launch: workspace too small (%zu)\n", ws_size); grid = -1; return; }
    }
    if (grid < 0) return;
    mk::Args a{};
    for (int i = 0; i < 18; ++i) a.in[i] = (const float*)d_in[i];
    a.out = (float*)d_out; a.ws = (unsigned char*)d_ws;
#if MK_BRINGUP == 0
    a.ph_lo = 0; a.ph_hi = mk::N_PHASES;
    void* args[] = {&a};
    hipError_t e = hipLaunchCooperativeKernel((const void*)mk::mk_fwd, dim3(grid), dim3(mk::NWAVES * 64), args, mk::LDS_BYTES, stream);
    if (e != hipSuccess) fprintf(stderr, "cooperative launch failed: %s (grid %d)\n", hipGetErrorString(e), grid);
#else
    const int nph = MK_BRINGUP == 1 ? 3 : MK_BRINGUP == 2 ? 8 : mk::N_PHASES;
    for (int ph = 0; ph < nph; ++ph) { a.ph_lo = ph; a.ph_hi = ph + 1; hipLaunchKernelGGL(mk::mk_fwd, dim3(grid), dim3(mk::NWAVES * 64), mk::LDS_BYTES, stream, a); }
#if MK_BRINGUP == 1
    nv::part_mix(d_in, (float*)d_out, d_ws, stream); nv::part_ffn2_final(d_in, (float*)d_out, d_ws, stream);
#elif MK_BRINGUP == 2
    nv::part_ffn2_final(d_in, (float*)d_out, d_ws, stream);
#endif
#endif
}
```

```cpp
#define MK_BRINGUP 0
#include <hip/hip_runtime.h>
#include <cstdio>
#include <cstdint>
#include <cmath>
#include <hip/hip_cooperative_groups.h>
namespace cg = cooperative_groups;

namespace mkc {
constexpr int S = 16384, DM = 1024, DFF = 2816, NGU = 2 * DFF, NWIN = 2304;
constexpr float LOG2E = 1.4426950408889634f;
constexpr float C2Q = 0.10206207261596577f * LOG2E;
constexpr float C2M = 0.125f * LOG2E;
constexpr size_t MiB = 1u << 20;
constexpr size_t WS_CNT = 0;
constexpr size_t WS_SS1 = 1 * MiB, WS_SS2 = WS_SS1 + 65536, WS_SSQ = WS_SS2 + 65536, WS_SSKV = WS_SSQ + 65536, WS_SS3 = WS_SSKV + 65536, WS_SS4 = WS_SS3 + 65536;
constexpr size_t WS_KMS = WS_SS1 + 512 * 1024;
constexpr size_t WS_POSF = 2 * MiB, WS_COS = 3 * MiB, WS_SIN = 4 * MiB;
constexpr size_t WS_WGU1 = 6 * MiB, WS_WD1 = 17 * MiB, WS_WGU2 = WS_WD1 + 5632 * 1024, WS_WD2 = WS_WGU2 + 11 * MiB, WS_WIN = 39 * MiB, WS_WUQ = WS_WIN + 4608 * 1024, WS_WUKV = WS_WUQ + 768 * 1024, WS_WOUT = 45 * MiB;
constexpr size_t WS_XB = 48 * MiB, WS_CQKV = 80 * MiB, WS_PART = 48 * MiB, WS_PLSE = 112 * MiB;
constexpr size_t WS_ACT = 114 * MiB, WS_MQKV = 114 * MiB, WS_CAT = 114 * MiB, WS_Q = 162 * MiB, WS_KN = 186 * MiB, WS_V = 202 * MiB, WS_KR = 218 * MiB, WS_LIST = 220 * MiB, WS_END = 236 * MiB;
static_assert(WS_WD2 + 5632 * 1024 <= WS_WIN && WS_WUKV + 512 * 1024 <= WS_WOUT && WS_WOUT + 2 * MiB <= WS_XB, "weight map");
}
namespace pg8 {
#define PG8_LAS __attribute__((address_space(3)))
typedef unsigned short bf16_t;
typedef short bf16x8 __attribute__((ext_vector_type(8)));
typedef float f32x4 __attribute__((ext_vector_type(4)));
typedef unsigned u32x4 __attribute__((ext_vector_type(4)));
__device__ __forceinline__ int lane_id_v() { int l; asm volatile("v_mbcnt_lo_u32_b32 %0, -1, 0\n\tv_mbcnt_hi_u32_b32 %0, -1, %0" : "=v"(l)); return l; }
constexpr int BM = 256, BK = 64, HALF = 128, HTB = HALF * BK * 2  , STAGE_BYTES = 8 * HTB, NXCD = 8, WGM = 8;

__host__ __device__ __forceinline__ int lds_byte(int r, int c) { const int st = (r >> 4) * 2 + (c >> 5), rr = r & 15, cc = c & 31, ob = rr * 64 + cc * 2; return st * 1024 + (ob ^ (((ob >> 9) & 1) << 5)); }
__host__ __device__ __forceinline__ void stage_rc(int b, int& R, int& C) { const int st = b / 1024, sb = b % 1024, swz = sb ^ (((sb >> 9) & 1) << 5); R = (st >> 1) * 16 + swz / 64; C = (st & 1) * 32 + (swz % 64) / 2; }
__host__ __device__ __forceinline__ int perm32(int rho) { const int n = rho >> 4, i = rho & 15; return 8 * (i >> 2) + 4 * n + (i & 3); }

struct Unit { int pm, pn; };
struct Gemm { const bf16_t* A; const bf16_t* Bt; int M, N, K, lda; };

struct StaticOrder {
    int nM, nN, nwg, G, c;
    __host__ __device__ void init(int M, int N, int G_, int c_) { nM = M / BM; nN = N / BM; nwg = nM * nN; G = G_; c = c_; }
    __host__ __device__ bool next(int i, Unit& u) const {
        const long L = (long)i * G + c; if (L >= nwg) return false;
        int wgid = (int)L; { const int q = nwg / NXCD, r = nwg % NXCD, xcd = wgid % NXCD, off = wgid / NXCD; wgid = (xcd < r ? xcd * (q + 1) : r * (q + 1) + (xcd - r) * q) + off; }
        const int nig = WGM * nN, gid = wgid / nig, fm = gid * WGM, gsz = (nM - fm) < WGM ? (nM - fm) : WGM;
        u.pm = fm + ((wgid % nig) % gsz); u.pn = (wgid % nig) / gsz; return true;
    }
    __device__ __forceinline__ void a_ready(const Unit&) const {}
    __device__ __forceinline__ void done(const Unit&) const {}
};

__device__ __forceinline__ unsigned cvt_pk_bf16(float lo, float hi) { unsigned r; asm volatile("v_cvt_pk_bf16_f32 %0, %1, %2" : "=v"(r) : "v"(lo), "v"(hi)); return r; }
typedef unsigned u32x2 __attribute__((ext_vector_type(2)));
constexpr float RMS_EPS = 1e-6f;
__device__ __forceinline__ float rs_of(const float* ss, int row, float invn) { return __builtin_amdgcn_rsqf(ss[row] * invn + RMS_EPS); }
__device__ __forceinline__ float silu_f(float g) { return g * __builtin_amdgcn_rcpf(1.0f + __builtin_amdgcn_exp2f(-1.4426950408889634f * g)); }
__device__ __forceinline__ u32x4 pack8(const f32x4 a, const f32x4 b) { u32x4 w; w.x = cvt_pk_bf16(a[0], a[1]); w.y = cvt_pk_bf16(a[2], a[3]); w.z = cvt_pk_bf16(b[0], b[1]); w.w = cvt_pk_bf16(b[2], b[3]); return w; }

struct EpiSwiGLU {
    static constexpr bool PERM = true, AFTER_DRAIN = false;
    unsigned char* ws; int which;
    __device__ __forceinline__ void operator()(const f32x4 (&acc)[2][2][4][2], const Unit& u, int wr, int wc, int fr, int fq) const {
        bf16_t* O = (bf16_t*)(ws + mkc::WS_ACT); const int ldo = mkc::DFF; const float* ss = (const float*)(ws + (which ? mkc::WS_SS3 : mkc::WS_SS1)); const float invn = 1.0f / 1024.0f;
        const int row0 = u.pm * BM + wr * 64 + fr, col0 = u.pn * HALF + wc * 32 + 8 * fq;
#pragma unroll
        for (int ai = 0; ai < 2; ++ai)
#pragma unroll
            for (int m = 0; m < 4; ++m) { const int row = row0 + ai * HALF + m * 16; const float rs = rs_of(ss, row, invn);
                f32x4 a0, a1;
#pragma unroll
                for (int j = 0; j < 4; ++j) { a0[j] = silu_f(acc[ai][0][m][0][j] * rs) * (acc[ai][1][m][0][j] * rs); a1[j] = silu_f(acc[ai][0][m][1][j] * rs) * (acc[ai][1][m][1][j] * rs); }
                *(u32x4*)(O + (size_t)row * ldo + col0) = pack8(a0, a1); }
    }
};
struct EpiResid {
    static constexpr bool PERM = false, AFTER_DRAIN = false;
    const float* base; float* out; unsigned char* ws; int ss_off; int has_xb; float alpha;
    __device__ __forceinline__ void operator()(const f32x4 (&acc)[2][2][4][2], const Unit& u, int wr, int wc, int fr, int fq) const {
        bf16_t* xb = has_xb ? (bf16_t*)(ws + mkc::WS_XB) : nullptr; float* ss_out = (float*)(ws + ss_off);
        const int row0 = u.pm * BM + wr * 64 + fr, col0 = u.pn * BM + wc * 32 + 4 * fq;
#pragma unroll
        for (int ai = 0; ai < 2; ++ai)
#pragma unroll
            for (int m = 0; m < 4; ++m) { const int row = row0 + ai * HALF + m * 16; const size_t off = (size_t)row * 1024 + col0; float s = 0.f;
#pragma unroll
                for (int bj = 0; bj < 2; ++bj)
#pragma unroll
                    for (int n = 0; n < 2; ++n) { const f32x4 b = *(const f32x4*)(base + off + bj * HALF + n * 16); const f32x4 o = b + acc[ai][bj][m][n] * alpha;
                        *(f32x4*)(out + off + bj * HALF + n * 16) = o; s += (o[0] * o[0] + o[1] * o[1]) + (o[2] * o[2] + o[3] * o[3]);
                        if (xb) { u32x2 w; w.x = cvt_pk_bf16(o[0], o[1]); w.y = cvt_pk_bf16(o[2], o[3]); *(u32x2*)(xb + off + bj * HALF + n * 16) = w; } }
                s += __shfl_xor(s, 16); s += __shfl_xor(s, 32);
                if (fq == 0) atomicAdd(ss_out + row, s);
                asm volatile("" ::: "memory"); }
    }
};
struct EpiWin {
    static constexpr bool PERM = true, AFTER_DRAIN = false;
    unsigned char* ws;
    __device__ __forceinline__ void operator()(const f32x4 (&acc)[2][2][4][2], const Unit& u, int wr, int wc, int fr, int fq) const {
        bf16_t* cqkv = (bf16_t*)(ws + mkc::WS_CQKV); bf16_t* mqkv = (bf16_t*)(ws + mkc::WS_MQKV); const float* ss_in = (const float*)(ws + mkc::WS_SS2);
        float* ssq = (float*)(ws + mkc::WS_SSQ); float* sskv = (float*)(ws + mkc::WS_SSKV); float* kmsum = (float*)(ws + mkc::WS_KMS);
        const int row0 = u.pm * BM + wr * 64 + fr;
        const bool is_mk = (u.pn == 5 || u.pn == 6);
        f32x4 cs[2][2];
#pragma unroll
        for (int bj = 0; bj < 2; ++bj)
#pragma unroll
            for (int n = 0; n < 2; ++n) cs[bj][n] = (f32x4){0.f, 0.f, 0.f, 0.f};
#pragma unroll
        for (int ai = 0; ai < 2; ++ai)
#pragma unroll
            for (int m = 0; m < 4; ++m) { const int row = row0 + ai * HALF + m * 16; const float rs = rs_of(ss_in, row, 1.0f / 1024.0f);
#pragma unroll
                for (int bj = 0; bj < 2; ++bj) { const int colt = u.pn * BM + bj * HALF, col0 = colt + wc * 32 + 8 * fq;
                    const f32x4 v0 = acc[ai][bj][m][0] * rs, v1 = acc[ai][bj][m][1] * rs;
                    bf16_t* dst = (colt < 768) ? (cqkv + (size_t)row * 768 + col0) : (mqkv + (size_t)row * 1536 + (col0 - 768));
                    *(u32x4*)dst = pack8(v0, v1);
                    if (colt < 640) { float s = (v0[0] * v0[0] + v0[1] * v0[1]) + (v0[2] * v0[2] + v0[3] * v0[3]) + (v1[0] * v1[0] + v1[1] * v1[1]) + (v1[2] * v1[2] + v1[3] * v1[3]);
                        s += __shfl_xor(s, 16); s += __shfl_xor(s, 32);
                        if (fq == 0) atomicAdd((colt < 384 ? ssq : sskv) + row, s); }
                    if (is_mk) { cs[bj][0] += v0; cs[bj][1] += v1; } } }
        if (is_mk) {
#pragma unroll
            for (int bj = 0; bj < 2; ++bj)
#pragma unroll
                for (int n = 0; n < 2; ++n)
#pragma unroll
                    for (int j = 0; j < 4; ++j) { float s = cs[bj][n][j]; s += __shfl_xor(s, 1); s += __shfl_xor(s, 2); s += __shfl_xor(s, 4); s += __shfl_xor(s, 8);
                        if (fr == 0) atomicAdd(kmsum + (size_t)u.pm * 512 + (u.pn * BM + bj * HALF + wc * 32 + 8 * fq + 4 * n + j - 1280), s); }
        }
    }
};
struct EpiKV {
    static constexpr bool PERM = true, AFTER_DRAIN = false;
    unsigned char* ws;
    __device__ __forceinline__ void operator()(const f32x4 (&acc)[2][2][4][2], const Unit& u, int wr, int wc, int fr, int fq) const {
        bf16_t* Kn = (bf16_t*)(ws + mkc::WS_KN); bf16_t* V = (bf16_t*)(ws + mkc::WS_V); const float* ss = (const float*)(ws + mkc::WS_SSKV);
        const int row0 = u.pm * BM + wr * 64 + fr;
#pragma unroll
        for (int ai = 0; ai < 2; ++ai)
#pragma unroll
            for (int m = 0; m < 4; ++m) { const int row = row0 + ai * HALF + m * 16; const float rs = rs_of(ss, row, 1.0f / 256.0f);
#pragma unroll
                for (int bj = 0; bj < 2; ++bj) { const int colt = u.pn * BM + bj * HALF, col0 = colt + wc * 32 + 8 * fq;
                    bf16_t* dst = (colt < 512) ? (Kn + (size_t)row * 512 + col0) : (V + (size_t)row * 512 + (col0 - 512));
                    *(u32x4*)dst = pack8(acc[ai][bj][m][0] * rs, acc[ai][bj][m][1] * rs); } }
    }
};
struct EpiQ {
    static constexpr bool PERM = true, AFTER_DRAIN = false;
    unsigned char* ws;
    __device__ __forceinline__ void operator()(const f32x4 (&acc)[2][2][4][2], const Unit& u, int wr, int wc, int fr, int fq) const {
        bf16_t* Q = (bf16_t*)(ws + mkc::WS_Q); const float* ss = (const float*)(ws + mkc::WS_SSQ); const float* cosT = (const float*)(ws + mkc::WS_COS); const float* sinT = (const float*)(ws + mkc::WS_SIN);
        const int row0 = u.pm * BM + wr * 64 + fr;
#pragma unroll
        for (int ai = 0; ai < 2; ++ai)
#pragma unroll
            for (int m = 0; m < 4; ++m) { const int row = row0 + ai * HALF + m * 16; const float rs = rs_of(ss, row, 1.0f / 384.0f);
#pragma unroll
                for (int bj = 0; bj < 2; ++bj) { const int col0 = u.pn * BM + bj * HALF + wc * 32 + 8 * fq; const int d = col0 % 96;
                    f32x4 v0 = acc[ai][bj][m][0] * rs, v1 = acc[ai][bj][m][1] * rs;
                    if (d >= 64) { const int g = (d - 64) >> 3; const f32x4 c = *(const f32x4*)(cosT + (size_t)row * 16 + 4 * g), s = *(const f32x4*)(sinT + (size_t)row * 16 + 4 * g);
                        const f32x4 o0 = v0 * c - v1 * s, o1 = v0 * s + v1 * c; v0 = o0; v1 = o1; }
                    *(u32x4*)(Q + (size_t)row * 768 + col0) = pack8(v0, v1); }
                asm volatile("" ::: "memory"); }
    }
};

template <class Epi, class Sched, bool ALIGN_EPI = false, bool SP2 = false>
__device__ __forceinline__ void gemm_phase(PG8_LAS unsigned char* lds, const Gemm g, const Sched& S, const Epi& E, const int wid) {
    const int lane = lane_id_v(), tid = wid * 64 + lane, wr = wid >> 2, wc = wid & 3, fr = lane & 15, fq = lane >> 4;
    const int K = g.K, nt = K / BK, lda = g.lda;
    unsigned voffA[2], voffB[2];
#pragma unroll
    for (int i = 0; i < 2; ++i) { int R, C; stage_rc(tid * 16 + i * 8192, R, C); const int Rb = Epi::PERM ? ((R & ~31) + perm32(R & 31)) : R;
        voffA[i] = (unsigned)(R * lda + C) * 2u; voffB[i] = (unsigned)(Rb * K + C) * 2u; }
    const size_t kstep = (size_t)(BK * 2);
    const size_t hstep = (size_t)HALF * K * 2;
    const size_t tstep = 2 * hstep; const size_t hstepA = (size_t)HALF * lda * 2, tstepA = 2 * hstepA;
    const unsigned ldsw = (unsigned)wid * 1024u;
    const int aoff = lds_byte(wr * 64 + fr, fq * 8), boff = lds_byte(wc * 32 + fr, fq * 8);
#define PG8_SA(b, h) (((b) * 2 + (h)) * HTB)
#define PG8_SB(b, h) ((4 + (b) * 2 + (h)) * HTB)
#define PG8_STAGE(bufoff, gbase, voff) do { _Pragma("unroll") for (int _i = 0; _i < 2; ++_i) \
        __builtin_amdgcn_global_load_lds((const unsigned*)((const char*)(gbase) + (voff)[_i]), (PG8_LAS unsigned*)(lds + (bufoff) + ldsw + _i * 8192), 16, 0, 0); } while (0)
#define PG8_LDA(dst, b, h) do { _Pragma("unroll") for (int m = 0; m < 4; ++m) _Pragma("unroll") for (int k = 0; k < 2; ++k) dst[m][k] = *(const PG8_LAS bf16x8*)(lds + PG8_SA(b, h) + aoff + m * 2048 + k * 1024); } while (0)
#define PG8_LDB(dst, b, h) do { _Pragma("unroll") for (int n = 0; n < 2; ++n) _Pragma("unroll") for (int k = 0; k < 2; ++k) dst[n][k] = *(const PG8_LAS bf16x8*)(lds + PG8_SB(b, h) + boff + n * 2048 + k * 1024); } while (0)
#define PG8_MMA(ai, bj, At, Bt) do { __builtin_amdgcn_s_setprio(1); _Pragma("unroll") for (int m = 0; m < 4; ++m) _Pragma("unroll") for (int n = 0; n < 2; ++n) _Pragma("unroll") for (int k = 0; k < 2; ++k) \
        acc[ai][bj][m][n] = __builtin_amdgcn_mfma_f32_16x16x32_bf16(Bt[n][k], At[m][k], acc[ai][bj][m][n], 0, 0, 0); __builtin_amdgcn_s_setprio(0); } while (0)
#define PG8_WAIT_V(n) asm volatile("s_waitcnt vmcnt(" #n ")" ::: "memory")
#define PG8_WAIT_L(n) asm volatile("s_waitcnt lgkmcnt(" #n ")" ::: "memory")
#define PG8_BAR __builtin_amdgcn_s_barrier()
#define PG8_SCHED __builtin_amdgcn_sched_barrier(0)
    Unit cur, nxt; int ui = 0;
    if (!S.next(0, cur)) return;
    f32x4 acc[2][2][4][2];
#pragma unroll
    for (int a = 0; a < 2; ++a)
#pragma unroll
        for (int b = 0; b < 2; ++b)
#pragma unroll
            for (int m = 0; m < 4; ++m)
#pragma unroll
                for (int n = 0; n < 2; ++n) acc[a][b][m][n] = (f32x4){0.f, 0.f, 0.f, 0.f};
    bf16x8 At[4][2], B0[2][2], B1[2][2];
    const char* cA = (const char*)g.A + (size_t)cur.pm * tstepA; const char* cB = (const char*)g.Bt + (size_t)cur.pn * tstep;
    S.a_ready(cur);
    if constexpr (SP2) {
        PG8_STAGE(PG8_SB(0, 0), cB, voffB); PG8_STAGE(PG8_SB(0, 1), cB + hstep, voffB); PG8_STAGE(PG8_SA(0, 0), cA, voffA); PG8_STAGE(PG8_SA(0, 1), cA + hstepA, voffA);
        if (wr == 1) PG8_BAR;
        PG8_WAIT_V(2); PG8_BAR;
        PG8_STAGE(PG8_SB(1, 0), cB + kstep, voffB); PG8_STAGE(PG8_SA(1, 0), cA + kstep, voffA); PG8_STAGE(PG8_SB(1, 1), cB + hstep + kstep, voffB);
        PG8_WAIT_V(6); PG8_BAR;
    } else {
        PG8_STAGE(PG8_SB(0, 0), cB, voffB); PG8_STAGE(PG8_SA(0, 0), cA, voffA); PG8_STAGE(PG8_SB(0, 1), cB + hstep, voffB); PG8_STAGE(PG8_SA(0, 1), cA + hstepA, voffA);
        if (wr == 1) PG8_BAR;
        PG8_WAIT_V(4); PG8_BAR;
        PG8_STAGE(PG8_SB(1, 0), cB + kstep, voffB); PG8_STAGE(PG8_SA(1, 0), cA + kstep, voffA); PG8_STAGE(PG8_SB(1, 1), cB + hstep + kstep, voffB);
        PG8_WAIT_V(6); PG8_BAR;
    }
    for (;;) {
        const bool has_next = S.next(ui + 1, nxt);
        const char* nA = has_next ? (const char*)g.A + (size_t)nxt.pm * tstepA : cA; const char* nB = has_next ? (const char*)g.Bt + (size_t)nxt.pn * tstep : cB;
#pragma nounroll
        for (int t = 0; t < nt; t += 2) {
            const bool last = (t == nt - 2);
            const char* a1 = cA + (size_t)(t + 1) * kstep;
            const char* a2 = last ? nA : cA + (size_t)(t + 2) * kstep; const char* b2 = last ? nB : cB + (size_t)(t + 2) * kstep;
            const char* a3 = a2 + kstep; const char* b3 = b2 + kstep;
            if (last && has_next) S.a_ready(nxt);
            if constexpr (SP2) {
            PG8_LDB(B0, 0, 0); PG8_LDB(B1, 0, 1); PG8_SCHED; PG8_LDA(At, 0, 0); PG8_STAGE(PG8_SA(1, 1), a1 + hstepA, voffA);
            PG8_WAIT_V(8); PG8_WAIT_L(0); PG8_BAR; PG8_MMA(0, 0, At, B0); PG8_MMA(0, 1, At, B1); PG8_BAR; PG8_SCHED;
            PG8_LDA(At, 0, 1); PG8_STAGE(PG8_SB(0, 0), b2, voffB); PG8_STAGE(PG8_SB(0, 1), b2 + hstep, voffB); PG8_STAGE(PG8_SA(0, 0), a2, voffA);
            PG8_WAIT_V(8); PG8_WAIT_L(0); PG8_BAR; PG8_MMA(1, 0, At, B0); PG8_MMA(1, 1, At, B1); PG8_BAR; PG8_SCHED;
            PG8_LDB(B0, 1, 0); PG8_LDB(B1, 1, 1); PG8_SCHED; PG8_LDA(At, 1, 0); PG8_STAGE(PG8_SA(0, 1), a2 + hstepA, voffA);
            PG8_WAIT_V(8); PG8_WAIT_L(0); PG8_BAR; PG8_MMA(0, 0, At, B0); PG8_MMA(0, 1, At, B1); PG8_BAR; PG8_SCHED;
            PG8_LDA(At, 1, 1); PG8_STAGE(PG8_SB(1, 0), b3, voffB); PG8_STAGE(PG8_SB(1, 1), b3 + hstep, voffB); PG8_STAGE(PG8_SA(1, 0), a3, voffA);
            PG8_WAIT_V(8); PG8_WAIT_L(0); PG8_BAR; PG8_MMA(1, 0, At, B0); PG8_MMA(1, 1, At, B1); PG8_BAR; PG8_SCHED;
            } else {
            PG8_LDB(B0, 0, 0); PG8_SCHED; PG8_LDA(At, 0, 0); PG8_STAGE(PG8_SA(1, 1), a1 + hstepA, voffA);
            PG8_WAIT_L(8); PG8_BAR; PG8_WAIT_L(0); PG8_MMA(0, 0, At, B0); PG8_BAR; PG8_SCHED;
            PG8_LDB(B1, 0, 1); PG8_STAGE(PG8_SB(0, 0), b2, voffB);
            PG8_BAR; PG8_WAIT_L(0); PG8_MMA(0, 1, At, B1); PG8_BAR;
            PG8_LDA(At, 0, 1); PG8_STAGE(PG8_SA(0, 0), a2, voffA);
            PG8_BAR; PG8_WAIT_L(0); PG8_MMA(1, 0, At, B0); PG8_BAR; PG8_SCHED;
            PG8_STAGE(PG8_SB(0, 1), b2 + hstep, voffB);
            PG8_WAIT_V(6); PG8_BAR; PG8_MMA(1, 1, At, B1); PG8_BAR;
            PG8_LDB(B0, 1, 0); PG8_SCHED; PG8_LDA(At, 1, 0); PG8_STAGE(PG8_SA(0, 1), a2 + hstepA, voffA);
            PG8_WAIT_L(8); PG8_BAR; PG8_WAIT_L(0); PG8_MMA(0, 0, At, B0); PG8_BAR; PG8_SCHED;
            PG8_LDB(B1, 1, 1); PG8_STAGE(PG8_SB(1, 0), b3, voffB);
            PG8_BAR; PG8_WAIT_L(0); PG8_MMA(0, 1, At, B1); PG8_BAR;
            PG8_LDA(At, 1, 1); PG8_STAGE(PG8_SA(1, 0), a3, voffA);
            PG8_BAR; PG8_WAIT_L(0); PG8_MMA(1, 0, At, B0); PG8_BAR; PG8_SCHED;
            PG8_STAGE(PG8_SB(1, 1), b3 + hstep, voffB);
            PG8_WAIT_V(6); PG8_BAR; PG8_MMA(1, 1, At, B1); PG8_BAR;
            }
        }
        if constexpr (ALIGN_EPI) { if (wr == 0) PG8_BAR; }
        if constexpr (!Epi::AFTER_DRAIN) { E(acc, cur, wr, wc, fr, fq); S.done(cur); }
        if (!has_next) break;
#pragma unroll
        for (int a = 0; a < 2; ++a)
#pragma unroll
            for (int b = 0; b < 2; ++b)
#pragma unroll
                for (int m = 0; m < 4; ++m)
#pragma unroll
                    for (int n = 0; n < 2; ++n) acc[a][b][m][n] = (f32x4){0.f, 0.f, 0.f, 0.f};
        cur = nxt; cA = nA; cB = nB; ++ui;
        if constexpr (ALIGN_EPI) { if (wr == 1) PG8_BAR; }
    }
    PG8_WAIT_V(0);
    if constexpr (!ALIGN_EPI) { if (wr == 0) PG8_BAR; }
    PG8_BAR;
    if constexpr (Epi::AFTER_DRAIN) { E.fused(acc, cur, wr, wc, fr, fq, lds, wid, lane); S.done(cur); }
#undef PG8_SA
#undef PG8_SB
#undef PG8_STAGE
#undef PG8_LDA
#undef PG8_LDB
#undef PG8_MMA
#undef PG8_WAIT_V
#undef PG8_WAIT_L
#undef PG8_BAR
#undef PG8_SCHED
}
}
namespace att {
typedef unsigned short bf16_t;
using bf16x8 = __attribute__((ext_vector_type(8))) short;
using s16x4 = __attribute__((ext_vector_type(4))) short;
using f32x16 = __attribute__((ext_vector_type(16))) float;
using f32x4 = __attribute__((ext_vector_type(4))) float;
using u32x4 = __attribute__((ext_vector_type(4))) unsigned;
typedef short v4i16_t __attribute__((ext_vector_type(4)));
#define ATT_LAS __attribute__((address_space(3)))
typedef ATT_LAS const char* lds_cptr;
constexpr int NW = 8, KVBLK = 64;
constexpr int KSLOT = 12288, VSLOT = 8192, NSLOT = 3;
constexpr int LDS_K = 0, LDS_V = NSLOT * KSLOT, LDS_WS = LDS_V + NSLOT * VSLOT, LDS_OST = LDS_WS + NW * 64 * 4, LDS_POSK = LDS_OST + NW * 4096, LDS_BYTES = LDS_POSK + 1024;
__device__ __forceinline__ int crow(int r, int hi) { return (r & 3) + 8 * (r >> 2) + 4 * hi; }
__device__ __forceinline__ void glds16(const void* gsrc, unsigned lds_dst) { unsigned keep;
    asm volatile("s_mov_b32 %0, m0\n\ts_mov_b32 m0, %2\n\ts_nop 0\n\tglobal_load_lds_dwordx4 %1, off\n\ts_mov_b32 m0, %0" : "=&s"(keep) : "v"(gsrc), "s"(lds_dst) : "memory"); }
__device__ __forceinline__ unsigned cvtpk(float lo, float hi) { unsigned r; asm volatile("v_cvt_pk_bf16_f32 %0, %1, %2" : "=v"(r) : "v"(lo), "v"(hi)); return r; }
__device__ __forceinline__ s16x4 vtr(lds_cptr p) { return __builtin_bit_cast(s16x4, __builtin_amdgcn_ds_read_tr16_b64_v4i16((ATT_LAS v4i16_t*)p)); }
#define ATT_WAIT_BAR() asm volatile("s_waitcnt vmcnt(0) lgkmcnt(0)\n\ts_barrier" ::: "memory")

struct Unit {
    const bf16_t* Q; int q_pitch;
    const bf16_t* K; int k_pitch;
    const bf16_t* Kr;
    const bf16_t* V; int v_pitch;
    int key0, ntiles;
    int q0;
    const unsigned short* list; int len;
    const float* posf;
    float slope2;
    bf16_t* O; int o_pitch;
    bf16_t* part; float* plse; int h;
};

template <int MODE> __device__ __forceinline__ void unit(const Unit& U, char* shm, const int wid) {
    constexpr int DQK = (MODE == 0) ? 96 : 64, ND0 = DQK / 16;
    const int lane = pg8::lane_id_v(), tid = wid * 64 + lane, r32 = lane & 31, hi = lane >> 5;
    const unsigned lds0 = (unsigned)(uintptr_t)shm;
    const lds_cptr shm3 = (lds_cptr)shm;
    ATT_LAS float* wsf = (ATT_LAS float*)(shm3 + LDS_WS) + wid * 64;
    int qrow, slot = 0; bool valid = true;
    if (MODE == 2) { const int e = wid * 32 + r32; valid = e < U.len; const unsigned ent = valid ? (unsigned)U.list[e] : (unsigned)U.list[0]; qrow = (int)(ent & 0x3FFFu); slot = 1 + (int)(ent >> 14); }
    else qrow = U.q0 + wid * 32 + r32;
    const bf16_t* ksrc = U.K + (size_t)(U.key0 + lane) * U.k_pitch + wid * 8;
    const bf16_t* krsrc = (MODE == 0) ? U.Kr + (size_t)(U.key0 + lane) * 32 + (wid & 3) * 8 : nullptr;
    const bf16_t* vsrc = U.V + (size_t)(U.key0 + 16 * (wid & 3) + (lane >> 2)) * U.v_pitch + (wid >> 2) * 32 + (lane & 3) * 8;
    const unsigned kdst = lds0 + LDS_K + wid * 1024, krdst = lds0 + LDS_K + (8 + (wid & 3)) * 1024, vdst = lds0 + LDS_V + wid * 1024;
#define ATT_DMA(t, ks, vs) do { glds16(ksrc + (size_t)(t) * KVBLK * U.k_pitch, (unsigned)__builtin_amdgcn_readfirstlane(kdst + (ks))); \
        if (MODE == 0 && wid < 4) glds16(krsrc + (size_t)(t) * KVBLK * 32, (unsigned)__builtin_amdgcn_readfirstlane(krdst + (ks))); \
        glds16(vsrc + (size_t)(t) * KVBLK * U.v_pitch, (unsigned)__builtin_amdgcn_readfirstlane(vdst + (vs))); } while (0)
    const int NT = U.ntiles;
    ATT_DMA(0, 0, 0);
    if (NT > 1) ATT_DMA(1, KSLOT, VSLOT);
    bf16x8 qr[ND0];
    { const bf16_t* Qw = U.Q + (size_t)qrow * U.q_pitch + hi * 8;
#pragma unroll
      for (int d0 = 0; d0 < ND0; ++d0) qr[d0] = *reinterpret_cast<const bf16x8*>(Qw + d0 * 16); }
    float pq = 0.f;
    if (MODE != 0) { pq = U.posf[qrow]; if (tid < 256) ((ATT_LAS float*)(shm3 + LDS_POSK))[tid] = U.posf[U.key0 + tid]; }
    float mhat = -1e30f, l_reg = 0.f; f32x16 o[2]; o[0] = f32x16{}; o[1] = f32x16{};
    const lds_cptr kp0 = shm3 + LDS_K + hi * 1024 + r32 * 16;
    const lds_cptr vp0 = shm3 + LDS_V + ((lane >> 4) & 1) * 32 + (lane & 3) * 8 + (4 * hi + ((lane & 15) >> 2)) * 64;
    int ks_cur = 0, vs_cur = 0, ks_free = 2 * KSLOT, vs_free = 2 * VSLOT;
    for (int t = 0; t < NT; ++t) {
        ATT_WAIT_BAR();
        if (t + 2 < NT) ATT_DMA(t + 2, ks_free, vs_free);
        bool active = true;
        if (MODE == 1) active = (64 * t <= wid * 32 + 31);
        if (active) {
            f32x16 p0 = f32x16{}, p1 = f32x16{};
            const lds_cptr kp = kp0 + ks_cur;
#pragma unroll
            for (int d0 = 0; d0 < ND0; ++d0) {
                const bf16x8 b0 = *(const ATT_LAS bf16x8*)(kp + d0 * 2048);
                const bf16x8 b1 = *(const ATT_LAS bf16x8*)(kp + d0 * 2048 + 512);
                p0 = __builtin_amdgcn_mfma_f32_32x32x16_bf16(b0, qr[d0], p0, 0, 0, 0);
                p1 = __builtin_amdgcn_mfma_f32_32x32x16_bf16(b1, qr[d0], p1, 0, 0, 0);
            }
            if (MODE != 0) {
                const ATT_LAS float* pk = (const ATT_LAS float*)(shm3 + LDS_POSK) + 64 * t + 4 * hi;
#pragma unroll
                for (int g = 0; g < 4; ++g) { const f32x4 a = *(const ATT_LAS f32x4*)(pk + 8 * g), b = *(const ATT_LAS f32x4*)(pk + 8 * g + 32);
#pragma unroll
                    for (int j = 0; j < 4; ++j) { p0[4 * g + j] -= U.slope2 * __builtin_fabsf(pq - a[j]); p1[4 * g + j] -= U.slope2 * __builtin_fabsf(pq - b[j]); } }
            }
            if (MODE == 0 || MODE == 1) {
                const int kb = U.key0 + 64 * t;
                if (kb + 63 > U.q0 + wid * 32) {
                    const int dq = qrow - kb - 4 * hi;
#pragma unroll
                    for (int r = 0; r < 16; ++r) { const int c = (r & 3) + 8 * (r >> 2); if (c > dq) p0[r] = -INFINITY; if (c + 32 > dq) p1[r] = -INFINITY; }
                }
            }
            float rm = p0[0];
#pragma unroll
            for (int r = 1; r < 16; ++r) rm = fmaxf(rm, p0[r]);
#pragma unroll
            for (int r = 0; r < 16; ++r) rm = fmaxf(rm, p1[r]);
            { auto rr = __builtin_amdgcn_permlane32_swap(__float_as_uint(rm), __float_as_uint(rm), false, false); rm = fmaxf(__uint_as_float(rr[0]), __uint_as_float(rr[1])); }
            if (__any(rm > mhat)) {
                const float mn = fmaxf(mhat, rm), f = __builtin_amdgcn_exp2f(mhat - mn);
                mhat = mn; l_reg *= f;
                if (hi == 0) wsf[r32] = f;
                asm volatile("s_waitcnt lgkmcnt(0)" ::: "memory");
#pragma unroll
                for (int g = 0; g < 4; ++g) { const f32x4 fv = *(const ATT_LAS f32x4*)(wsf + 8 * g + 4 * hi);
#pragma unroll
                    for (int j = 0; j < 4; ++j) { o[0][4 * g + j] *= fv[j]; o[1][4 * g + j] *= fv[j]; } }
            }
            float sacc = 0.f;
#pragma unroll
            for (int r = 0; r < 16; ++r) { p0[r] = __builtin_amdgcn_exp2f(p0[r] - mhat); p1[r] = __builtin_amdgcn_exp2f(p1[r] - mhat); sacc += p0[r] + p1[r]; }
            l_reg += sacc;
            u32x4 pw[4];
#pragma unroll
            for (int s = 0; s < 2; ++s) { pw[s] = (u32x4){cvtpk(p0[8 * s], p0[8 * s + 1]), cvtpk(p0[8 * s + 2], p0[8 * s + 3]), cvtpk(p0[8 * s + 4], p0[8 * s + 5]), cvtpk(p0[8 * s + 6], p0[8 * s + 7])};
                pw[2 + s] = (u32x4){cvtpk(p1[8 * s], p1[8 * s + 1]), cvtpk(p1[8 * s + 2], p1[8 * s + 3]), cvtpk(p1[8 * s + 4], p1[8 * s + 5]), cvtpk(p1[8 * s + 6], p1[8 * s + 7])}; }
            const lds_cptr vp = vp0 + vs_cur;
#pragma unroll
            for (int d0 = 0; d0 < 2; ++d0)
#pragma unroll
                for (int ks = 0; ks < 4; ++ks) { const s16x4 lo = vtr(vp + d0 * 4096 + ks * 1024), hh = vtr(vp + d0 * 4096 + ks * 1024 + 512);
                    const bf16x8 vf = (bf16x8){lo[0], lo[1], lo[2], lo[3], hh[0], hh[1], hh[2], hh[3]};
                    o[d0] = __builtin_amdgcn_mfma_f32_32x32x16_bf16(__builtin_bit_cast(bf16x8, pw[ks]), vf, o[d0], 0, 0, 0); }
        }
        { const int kn = ks_cur + KSLOT, vn = vs_cur + VSLOT; const int kf = ks_cur, vf_ = vs_cur; ks_cur = (kn == NSLOT * KSLOT) ? 0 : kn; vs_cur = (vn == NSLOT * VSLOT) ? 0 : vn; ks_free = kf; vs_free = vf_; }
    }
    { auto rr = __builtin_amdgcn_permlane32_swap(__float_as_uint(l_reg), __float_as_uint(l_reg), false, false); l_reg = __uint_as_float(rr[0]) + __uint_as_float(rr[1]); }
    if (hi == 0) wsf[32 + r32] = l_reg;
    asm volatile("s_waitcnt lgkmcnt(0)" ::: "memory");
    float rli[16];
#pragma unroll
    for (int r = 0; r < 16; ++r) rli[r] = __builtin_amdgcn_rcpf(wsf[32 + crow(r, hi)]);
    ATT_LAS bf16_t* stg = (ATT_LAS bf16_t*)(shm3 + LDS_OST) + wid * 2048;
#pragma unroll
    for (int r = 0; r < 16; ++r) { const int orow = crow(r, hi);
#pragma unroll
        for (int d0 = 0; d0 < 2; ++d0) { const unsigned w = cvtpk(o[d0][r] * rli[r], 0.f); stg[orow * 64 + d0 * 32 + r32] = (bf16_t)(w & 0xFFFFu); } }
    asm volatile("s_waitcnt lgkmcnt(0)" ::: "memory");
    if (MODE == 0) {
        bf16_t* Ow = U.O + (size_t)(U.q0 + wid * 32) * U.o_pitch;
#pragma unroll
        for (int i = 0; i < 4; ++i) { const int row = i * 8 + (lane >> 3), ch = lane & 7; const u32x4 v = *(const ATT_LAS u32x4*)(stg + row * 64 + ch * 8); *(u32x4*)(Ow + (size_t)row * U.o_pitch + ch * 8) = v; }
    } else {
        const int meta = valid ? ((qrow << 2) | slot) : -1;
#pragma unroll
        for (int i = 0; i < 4; ++i) { const int row = i * 8 + (lane >> 3), ch = lane & 7; const int mt = __shfl(meta, row); const u32x4 v = *(const ATT_LAS u32x4*)(stg + row * 64 + ch * 8);
            if (mt >= 0) *(u32x4*)(U.part + ((size_t)((mt >> 2) * 8 + U.h) * 4 + (mt & 3)) * 64 + ch * 8) = v; }
        if (hi == 0 && valid) U.plse[(size_t)(qrow * 8 + U.h) * 4 + slot] = mhat + __builtin_log2f(l_reg);
    }
    asm volatile("s_waitcnt vmcnt(0) lgkmcnt(0)\n\ts_barrier" ::: "memory");
#undef ATT_DMA
}
}

namespace mk {
typedef unsigned short bf16;
typedef unsigned v4u __attribute__((ext_vector_type(4)));
typedef float f32x4 __attribute__((ext_vector_type(4)));
#define MK_LAS __attribute__((address_space(3)))
using namespace mkc;
constexpr int NWAVES = 8;
constexpr int RING_BYTES = 131072, LDS_EXTRA = RING_BYTES, LDS_BYTES = 147456;

struct Args { const float* in[18]; float* out; unsigned char* ws; int ph_lo, ph_hi; };
struct Frame { MK_LAS unsigned char* lds; int tid, lane, wave, vcu, G; };
typedef const __attribute__((address_space(4))) Args* kargs_t;
__device__ __forceinline__ kargs_t kargs() { kargs_t p = (kargs_t)__builtin_amdgcn_kernarg_segment_ptr(); asm volatile("" : "+s"(p)); return p; }
__device__ __forceinline__ Frame mkframe(MK_LAS unsigned char* lds, int wave) { Frame F; F.lds = lds; F.wave = wave; F.lane = pg8::lane_id_v(); F.tid = wave * 64 + F.lane; F.G = gridDim.x;
    { const int bx = blockIdx.x; F.vcu = (F.G % 8 == 0) ? (bx % 8) * (F.G / 8) + bx / 8 : bx; } return F; }

__device__ __forceinline__ unsigned f2bf(float f) { unsigned u = __builtin_bit_cast(unsigned, f); return (u + 0x7fffu + ((u >> 16) & 1u)) >> 16; }
__device__ __forceinline__ unsigned pk2(float lo, float hi) { return f2bf(lo) | (f2bf(hi) << 16); }
__device__ __forceinline__ float bf2f(unsigned short b) { return __builtin_bit_cast(float, (unsigned)b << 16); }
__device__ __forceinline__ float wave_sum(float v) {
#pragma unroll
    for (int o = 1; o < 64; o <<= 1) v += __shfl_xor(v, o);
    return v;
}
__constant__ float ROPE_INV[16] = {1.000000000e+00f, 5.623413324e-01f, 3.162277639e-01f, 1.778279394e-01f, 1.000000015e-01f, 5.623413250e-02f, 3.162277490e-02f, 1.778279431e-02f,
                                   9.999999776e-03f, 5.623413250e-03f, 3.162277630e-03f, 1.778279431e-03f, 1.000000047e-03f, 5.623413017e-04f, 3.162277571e-04f, 1.778279402e-04f};
__device__ __forceinline__ int rope_phys(int L) { return L < 16 ? 8 * (L >> 2) + (L & 3) : 8 * ((L - 16) >> 2) + 4 + ((L - 16) & 3); }

__device__ __forceinline__ void p0_item(const float* W, int K, int N, bf16* WT, const float* gain, int kind, MK_LAS float* scr, int item, int lane) {
    const int nblk = N / 32, kb = item / nblk, nb = item % nblk, k0 = 64 * kb, n0 = 32 * nb;
    int dbase = n0; bool perm = false; float mul = 1.0f;
    if (kind == 1) dbase = (n0 >> 7) * 256 + (n0 & 127);
    else if (kind == 2) dbase = (n0 >> 7) * 256 + 128 + (n0 & 127);
    else if (kind == 3) { if (n0 == 640) perm = true; else if (n0 >= 672) { dbase = n0 + 96; if (n0 < 1184) mul = C2M; } }
    else if (kind == 4) { perm = (n0 % 96) == 64; mul = C2Q; }
    else if (kind == 5) { const int h = n0 >> 7, e = n0 & 127; dbase = e < 64 ? h * 64 + e : 512 + h * 64 + (e - 64); }
#pragma unroll 8
    for (int i = 0; i < 32; ++i) { const int kk = 2 * i + (lane >> 5); const float g = gain ? gain[k0 + kk] * mul : mul; scr[kk * 33 + (lane & 31)] = W[(size_t)(k0 + kk) * N + n0 + (lane & 31)] * g; }
    asm volatile("s_waitcnt lgkmcnt(0)" ::: "memory");
    const int c = lane & 7;
#pragma unroll
    for (int j = 0; j < 4; ++j) { const int n = (lane >> 3) + 8 * j; const MK_LAS float* s = scr + (8 * c) * 33 + n;
        v4u o; o.x = pk2(s[0 * 33], s[1 * 33]); o.y = pk2(s[2 * 33], s[3 * 33]); o.z = pk2(s[4 * 33], s[5 * 33]); o.w = pk2(s[6 * 33], s[7 * 33]);
        const int drow = dbase + (perm ? rope_phys(n) : n);
        *(v4u*)(WT + (size_t)drow * K + k0 + 8 * c) = o; }
    asm volatile("s_waitcnt lgkmcnt(0)" ::: "memory");
}
__device__ __forceinline__ void p0_prologue(const Frame& F, kargs_t ap) {
    unsigned char* ws = ap->ws;
    MK_LAS float* scr = (MK_LAS float*)(F.lds + F.wave * 16384);
    const int gw = F.vcu * NWAVES + F.wave, NGW = F.G * NWAVES;
    constexpr int I_G = (DM / 64) * (DFF / 32), I_D = (DFF / 64) * (DM / 32), I_IN = (DM / 64) * (2208 / 32), I_UQ = (384 / 64) * (768 / 32), I_UKV = (256 / 64) * (1024 / 32), I_O = (DM / 64) * (DM / 32);
    constexpr int NITEMS = 4 * I_G + 2 * I_D + I_IN + I_UQ + I_UKV + I_O;
    for (int it = gw; it < NITEMS; it += NGW) {
        int r = it;
        if (r < I_G) { p0_item(ap->in[3], DM, DFF, (bf16*)(ws + WS_WGU1), ap->in[2], 1, scr, r, F.lane); continue; } r -= I_G;
        if (r < I_G) { p0_item(ap->in[4], DM, DFF, (bf16*)(ws + WS_WGU1), ap->in[2], 2, scr, r, F.lane); continue; } r -= I_G;
        if (r < I_D) { p0_item(ap->in[5], DFF, DM, (bf16*)(ws + WS_WD1), nullptr, 0, scr, r, F.lane); continue; } r -= I_D;
        if (r < I_G) { p0_item(ap->in[14], DM, DFF, (bf16*)(ws + WS_WGU2), ap->in[13], 1, scr, r, F.lane); continue; } r -= I_G;
        if (r < I_G) { p0_item(ap->in[15], DM, DFF, (bf16*)(ws + WS_WGU2), ap->in[13], 2, scr, r, F.lane); continue; } r -= I_G;
        if (r < I_D) { p0_item(ap->in[16], DFF, DM, (bf16*)(ws + WS_WD2), nullptr, 0, scr, r, F.lane); continue; } r -= I_D;
        if (r < I_IN) { p0_item(ap->in[7], DM, 2208, (bf16*)(ws + WS_WIN), ap->in[6], 3, scr, r, F.lane); continue; } r -= I_IN;
        if (r < I_UQ) { p0_item(ap->in[9], 384, 768, (bf16*)(ws + WS_WUQ), ap->in[8], 4, scr, r, F.lane); continue; } r -= I_UQ;
        if (r < I_UKV) { p0_item(ap->in[11], 256, 1024, (bf16*)(ws + WS_WUKV), ap->in[10], 5, scr, r, F.lane); continue; } r -= I_UKV;
        p0_item(ap->in[12], DM, DM, (bf16*)(ws + WS_WOUT), nullptr, 0, scr, r, F.lane);
    }
    const float* x = ap->in[0]; bf16* xb = (bf16*)(ws + WS_XB); float* ss1 = (float*)(ws + WS_SS1);
    for (int m = gw; m < S; m += NGW) {
        const f32x4* xr = (const f32x4*)(x + (size_t)m * DM) + F.lane; unsigned long long* o8 = (unsigned long long*)(xb + (size_t)m * DM) + F.lane; float s = 0.f;
#pragma unroll
        for (int j = 0; j < 4; ++j) { const f32x4 v = xr[64 * j]; s += (v[0] * v[0] + v[1] * v[1]) + (v[2] * v[2] + v[3] * v[3]); o8[64 * j] = (unsigned long long)pk2(v[0], v[1]) | ((unsigned long long)pk2(v[2], v[3]) << 32); }
        s = wave_sum(s); if (F.lane == 0) ss1[m] = s;
    }
    const int* pos = (const int*)ap->in[1]; float* posf = (float*)(ws + WS_POSF); float* cosT = (float*)(ws + WS_COS); float* sinT = (float*)(ws + WS_SIN);
    const int gt = (F.vcu * NWAVES + F.wave) * 64 + F.lane, NGT = NGW * 64;
    for (int e = gt; e < S * 16; e += NGT) { const int s_ = e >> 4, i = e & 15; const float ang = (float)pos[s_] * ROPE_INV[i]; float sn, cs; sincosf(ang, &sn, &cs); cosT[e] = cs; sinT[e] = sn; if (i == 0) posf[s_] = (float)pos[s_]; }
    float* z = (float*)(ws + WS_SS2);
    for (int e = gt; e < 5 * S; e += NGT) z[e] = 0.f;
    float* km = (float*)(ws + WS_KMS);
    for (int e = gt; e < 64 * 512; e += NGT) km[e] = 0.f;
    unsigned* cnt = (unsigned*)(ws + WS_CNT);
    for (int e = gt; e < 512; e += NGT) cnt[e] = 0u;
    unsigned* padz = (unsigned*)((bf16*)(ws + WS_WIN) + (size_t)672 * DM);
    for (int e = gt; e < 96 * DM / 2; e += NGT) padz[e] = 0u;
}

__device__ __forceinline__ void p4_krope(const Frame& F, kargs_t ap) { unsigned char* const wsb = ap->ws;
    const bf16* cqkv = (const bf16*)(wsb + WS_CQKV); bf16* Kr = (bf16*)(wsb + WS_KR); const float* cosT = (const float*)(wsb + WS_COS); const float* sinT = (const float*)(wsb + WS_SIN);
    const int gt = (F.vcu * NWAVES + F.wave) * 64 + F.lane, NGT = F.G * NWAVES * 64;
    for (int e = gt; e < S * 16; e += NGT) { const int s_ = e >> 4, i = e & 15, g = i >> 2, j = i & 3;
        const float x1 = bf2f(cqkv[(size_t)s_ * 768 + 640 + 8 * g + j]), x2 = bf2f(cqkv[(size_t)s_ * 768 + 640 + 8 * g + 4 + j]); const float c = cosT[e], sn = sinT[e];
        Kr[(size_t)s_ * 32 + 8 * g + j] = (bf16)f2bf(x1 * c - x2 * sn); Kr[(size_t)s_ * 32 + 8 * g + 4 + j] = (bf16)f2bf(x1 * sn + x2 * c); }
}
__device__ __forceinline__ void p4_gating(const Frame& F, kargs_t ap) { unsigned char* const wsb = ap->ws;
    const bf16* mqkv = (const bf16*)(wsb + WS_MQKV); const float* kms = (const float*)(wsb + WS_KMS); unsigned* cnt = (unsigned*)(wsb + WS_CNT); unsigned short* lists = (unsigned short*)(wsb + WS_LIST);
    MK_LAS float* km = (MK_LAS float*)F.lds;
    for (int u = F.vcu; u < 256; u += F.G) {
        const int h = u & 7, q = (u >> 3) * 512 + F.tid, own = q >> 8;
        __syncthreads();
        for (int e = F.tid; e < 4096; e += 512) km[e] = kms[(size_t)(e >> 6) * 512 + h * 64 + (e & 63)] * (1.0f / 256.0f);
        __syncthreads();
        float qv[64];
        { const v4u* qp = (const v4u*)(mqkv + (size_t)q * 1536 + h * 64);
#pragma unroll
          for (int c = 0; c < 8; ++c) { const v4u w = qp[c];
#pragma unroll
              for (int j = 0; j < 4; ++j) { qv[8 * c + 2 * j] = __builtin_bit_cast(float, w[j] << 16); qv[8 * c + 2 * j + 1] = __builtin_bit_cast(float, w[j] & 0xFFFF0000u); } } }
        float g0 = -3e38f, g1 = -3e38f, g2 = -3e38f; int i0 = -1, i1 = -1, i2 = -1;
        const int own_max = __builtin_amdgcn_readfirstlane(own);
        for (int n = 0; n < own_max; ++n) {
            float g = 0.f;
#pragma unroll
            for (int c = 0; c < 16; ++c) { const f32x4 kk = *(const MK_LAS f32x4*)(km + n * 64 + 4 * c); g = fmaf(qv[4 * c], kk[0], g); g = fmaf(qv[4 * c + 1], kk[1], g); g = fmaf(qv[4 * c + 2], kk[2], g); g = fmaf(qv[4 * c + 3], kk[3], g); }
            if (g > g0) { g2 = g1; i2 = i1; g1 = g0; i1 = i0; g0 = g; i0 = n; }
            else if (g > g1) { g2 = g1; i2 = i1; g1 = g; i1 = n; }
            else if (g > g2) { g2 = g; i2 = n; }
        }
#pragma unroll
        for (int k = 0; k < 3; ++k) { const int n = k == 0 ? i0 : k == 1 ? i1 : i2;
            if (n >= 0) { const unsigned p = atomicAdd(cnt + h * 64 + n, 1u); lists[(size_t)(h * 64 + n) * S + p] = (unsigned short)(q | (k << 14)); } }
    }
    __syncthreads();
}
__device__ __forceinline__ void p5_combine(const Frame& F, kargs_t ap) { unsigned char* const wsb = ap->ws;
    const bf16* part = (const bf16*)(wsb + WS_PART); const float* plse = (const float*)(wsb + WS_PLSE); bf16* cat = (bf16*)(wsb + WS_CAT);
    const int gt = (F.vcu * NWAVES + F.wave) * 64 + F.lane, NGT = F.G * NWAVES * 64;
    for (int e = gt; e < S * 8 * 8; e += NGT) { const int dg = e & 7, qh = e >> 3, q = qh >> 3, h = qh & 7; const int ns = 1 + min(3, q >> 8);
        const f32x4 ls = *(const f32x4*)(plse + (size_t)qh * 4);
        float M = ls[0]; for (int s = 1; s < 4; ++s) if (s < ns) M = fmaxf(M, ls[s]);
        float acc[8], wsum = 0.f;
#pragma unroll
        for (int j = 0; j < 8; ++j) acc[j] = 0.f;
#pragma unroll
        for (int s = 0; s < 4; ++s) if (s < ns) { const float w = __builtin_amdgcn_exp2f(ls[s] - M); wsum += w; const v4u v = *(const v4u*)(part + ((size_t)qh * 4 + s) * 64 + dg * 8);
#pragma unroll
            for (int j = 0; j < 4; ++j) { acc[2 * j] += w * __builtin_bit_cast(float, v[j] << 16); acc[2 * j + 1] += w * __builtin_bit_cast(float, v[j] & 0xFFFF0000u); } }
        const float r = 1.0f / wsum; v4u o; o.x = pk2(acc[0] * r, acc[1] * r); o.y = pk2(acc[2] * r, acc[3] * r); o.z = pk2(acc[4] * r, acc[5] * r); o.w = pk2(acc[6] * r, acc[7] * r);
        *(v4u*)(cat + (size_t)q * 1024 + 512 + h * 64 + dg * 8) = o; }
}
__device__ __forceinline__ void p9_final(const Frame& F, kargs_t ap) { unsigned char* const wsb = ap->ws;
    const float* ss = (const float*)(wsb + WS_SS4); const float* g = ap->in[17];
    const int gw = F.vcu * NWAVES + F.wave, NGW = F.G * NWAVES;
    for (int m = gw; m < S; m += NGW) { const float rs = 1.0f / sqrtf(ss[m] * (1.0f / 1024.0f) + 1e-6f); f32x4* xr = (f32x4*)(ap->out + (size_t)m * DM) + F.lane; const f32x4* gr = (const f32x4*)g + F.lane;
#pragma unroll
        for (int j = 0; j < 4; ++j) { const f32x4 v = xr[64 * j]; xr[64 * j] = v * rs * gr[64 * j]; } }
}

__global__ void __launch_bounds__(NWAVES * 64, 2) mk_fwd(Args a_unused) {
    extern __shared__ __attribute__((aligned(16))) unsigned char lds[];
    const int wave = __builtin_amdgcn_readfirstlane(threadIdx.x >> 6);
    MK_LAS unsigned char* const ldsp = (MK_LAS unsigned char*)lds;
    int lo, hi; { kargs_t ap = kargs(); lo = ap->ph_lo; hi = ap->ph_hi; }
#ifndef MK_ONLY
#define MK_ONLY -1
#endif
#define IN(k) ((MK_ONLY < 0 || MK_ONLY == (k)) && lo <= (k) && (k) < hi)
#define SEAM(k) do { if (IN(k) && IN((k) + 1)) { cg::this_grid().sync(); } } while (0)
    if (IN(0)) { kargs_t ap = kargs(); const Frame F = mkframe(ldsp, wave); p0_prologue(F, ap); } SEAM(0);
    if (IN(1)) { kargs_t ap = kargs(); unsigned char* ws = ap->ws; pg8::Gemm g{(const bf16*)(ws + WS_XB), (const bf16*)(ws + WS_WGU1), S, NGU, DM, DM}; pg8::StaticOrder So; So.init(S, NGU, (int)gridDim.x, (int)blockIdx.x);
        pg8::EpiSwiGLU E{ws, 0}; pg8::gemm_phase<pg8::EpiSwiGLU, pg8::StaticOrder, true, true>(ldsp, g, So, E, wave); } SEAM(1);
    if (IN(2)) { kargs_t ap = kargs(); unsigned char* ws = ap->ws; pg8::Gemm g{(const bf16*)(ws + WS_ACT), (const bf16*)(ws + WS_WD1), S, DM, DFF, DFF}; pg8::StaticOrder So; So.init(S, DM, (int)gridDim.x, (int)blockIdx.x);
        pg8::EpiResid E{ap->in[0], ap->out, ws, (int)WS_SS2, 1, 0.5f}; pg8::gemm_phase<pg8::EpiResid, pg8::StaticOrder, true, true>(ldsp, g, So, E, wave); } SEAM(2);
    if (IN(3)) { kargs_t ap = kargs(); unsigned char* ws = ap->ws; pg8::Gemm g{(const bf16*)(ws + WS_XB), (const bf16*)(ws + WS_WIN), S, NWIN, DM, DM}; pg8::StaticOrder So; So.init(S, NWIN, (int)gridDim.x, (int)blockIdx.x);
        pg8::EpiWin E{ws}; pg8::gemm_phase<pg8::EpiWin, pg8::StaticOrder, true, true>(ldsp, g, So, E, wave); } SEAM(3);
    if (IN(4)) {
        { kargs_t ap = kargs(); unsigned char* ws = ap->ws; pg8::Gemm g{(const bf16*)(ws + WS_CQKV) + 384, (const bf16*)(ws + WS_WUKV), S, 1024, 256, 768}; pg8::StaticOrder So; So.init(S, 1024, (int)gridDim.x, (int)blockIdx.x);
          pg8::EpiKV E{ws}; pg8::gemm_phase<pg8::EpiKV, pg8::StaticOrder, true, true>(ldsp, g, So, E, wave); }
        { kargs_t ap = kargs(); unsigned char* ws = ap->ws; pg8::Gemm g{(const bf16*)(ws + WS_CQKV), (const bf16*)(ws + WS_WUQ), S, 768, 384, 768}; pg8::StaticOrder So; So.init(S, 768, (int)gridDim.x, (int)blockIdx.x);
          pg8::EpiQ E{ws}; pg8::gemm_phase<pg8::EpiQ, pg8::StaticOrder, true, true>(ldsp, g, So, E, wave); }
        { kargs_t ap = kargs(); const Frame F = mkframe(ldsp, wave); p4_krope(F, ap); }
#ifndef MK_NO_GATE
        { kargs_t ap = kargs(); const Frame F = mkframe(ldsp, wave); p4_gating(F, ap); }
#endif
    } SEAM(4);
#ifndef MK_NO_ATT5
    if (IN(5)) {
        kargs_t ap = kargs(); unsigned char* ws = ap->ws; const Frame F = mkframe(ldsp, wave);
        const bf16* mqkv = (const bf16*)(ws + WS_MQKV); const float* posf = (const float*)(ws + WS_POSF);
        att::Unit U; U.Kr = nullptr; U.posf = posf; U.part = (bf16*)(ws + WS_PART); U.plse = (float*)(ws + WS_PLSE); U.O = nullptr; U.o_pitch = 0; U.q_pitch = 1536; U.k_pitch = 1536; U.v_pitch = 1536; U.ntiles = 4;
        for (int u = F.vcu; u < 512; u += F.G) { const int h = u & 7, n = u >> 3;
            U.h = h; U.Q = mqkv + h * 64; U.K = mqkv + 512 + h * 64; U.V = mqkv + 1024 + h * 64; U.key0 = n * 256; U.q0 = n * 256; U.list = nullptr; U.len = 0; U.slope2 = exp2f(-(float)(h + 1)) * LOG2E;
            att::unit<1>(U, (char*)lds, wave); }
        MK_LAS int* pre = (MK_LAS int*)(ldsp + LDS_EXTRA);
        const unsigned* cnt = (const unsigned*)(ws + WS_CNT);
        __syncthreads();
        { const int c = (int)cnt[F.tid]; pre[F.tid] = (c + 255) >> 8; }
        __syncthreads();
        for (int o = 1; o < 512; o <<= 1) { const int v = pre[F.tid] + (F.tid >= o ? pre[F.tid - o] : 0); __syncthreads(); pre[F.tid] = v; __syncthreads(); }
        const int total = pre[511];
        for (int gI = F.vcu; gI < total; gI += F.G) {
            int lo_ = 0, hi_ = 511;
            while (lo_ < hi_) { const int mid = (lo_ + hi_) >> 1; if (pre[mid] > gI) hi_ = mid; else lo_ = mid + 1; }
            const int hn = __builtin_amdgcn_readfirstlane(lo_), c = gI - (hn ? pre[hn - 1] : 0), h = hn >> 6, n = hn & 63; const int len = (int)cnt[hn] - c * 256;
            U.h = h; U.Q = mqkv + h * 64; U.K = mqkv + 512 + h * 64; U.V = mqkv + 1024 + h * 64; U.key0 = n * 256; U.q0 = 0; U.list = (const unsigned short*)(ws + WS_LIST) + (size_t)hn * S + c * 256; U.len = len < 256 ? len : 256;
            U.slope2 = exp2f(-(float)(h + 1)) * LOG2E;
            att::unit<2>(U, (char*)lds, wave); }
    }
#endif
    SEAM(5);
    if (IN(6)) {
        { kargs_t ap = kargs(); const Frame F = mkframe(ldsp, wave); p5_combine(F, ap); }
#ifndef MK_NO_ATT6
        kargs_t ap = kargs(); unsigned char* ws = ap->ws; const Frame F = mkframe(ldsp, wave);
        att::Unit U; U.posf = nullptr; U.part = nullptr; U.plse = nullptr; U.list = nullptr; U.len = 0; U.slope2 = 0.f; U.q_pitch = 768; U.k_pitch = 512; U.v_pitch = 512; U.o_pitch = 1024; U.key0 = 0; U.Kr = (const bf16*)(ws + WS_KR);
        for (int v = F.vcu; v < 256; v += F.G) { const int h = v >> 5, s_ = v & 31;
            for (int i = 0; i < 2; ++i) { const int qb = i == 0 ? 63 - s_ : s_;
                U.h = h; U.Q = (const bf16*)(ws + WS_Q) + h * 96; U.K = (const bf16*)(ws + WS_KN) + h * 64; U.V = (const bf16*)(ws + WS_V) + h * 64; U.O = (bf16*)(ws + WS_CAT) + h * 64; U.q0 = qb * 256; U.ntiles = 4 * (qb + 1);
                att::unit<0>(U, (char*)lds, wave); } }
#endif
    } SEAM(6);
    if (IN(7)) { kargs_t ap = kargs(); unsigned char* ws = ap->ws; pg8::Gemm g{(const bf16*)(ws + WS_CAT), (const bf16*)(ws + WS_WOUT), S, DM, DM, DM}; pg8::StaticOrder So; So.init(S, DM, (int)gridDim.x, (int)blockIdx.x);
        pg8::EpiResid E{ap->out, ap->out, ws, (int)WS_SS3, 1, 1.0f}; pg8::gemm_phase<pg8::EpiResid, pg8::StaticOrder, true, true>(ldsp, g, So, E, wave); } SEAM(7);
    if (IN(8)) { kargs_t ap = kargs(); unsigned char* ws = ap->ws; pg8::Gemm g{(const bf16*)(ws + WS_XB), (const bf16*)(ws + WS_WGU2), S, NGU, DM, DM}; pg8::StaticOrder So; So.init(S, NGU, (int)gridDim.x, (int)blockIdx.x);
        pg8::EpiSwiGLU E{ws, 1}; pg8::gemm_phase<pg8::EpiSwiGLU, pg8::StaticOrder, true, true>(ldsp, g, So, E, wave); } SEAM(8);
    if (IN(9)) { kargs_t ap = kargs(); unsigned char* ws = ap->ws; pg8::Gemm g{(const bf16*)(ws + WS_ACT), (const bf16*)(ws + WS_WD2), S, DM, DFF, DFF}; pg8::StaticOrder So; So.init(S, DM, (int)gridDim.x, (int)blockIdx.x);
        pg8::EpiResid E{ap->out, ap->out, ws, (int)WS_SS4, 0, 0.5f}; pg8::gemm_phase<pg8::EpiResid, pg8::StaticOrder, true, true>(ldsp, g, So, E, wave); } SEAM(9);
    if (IN(10)) { kargs_t ap = kargs(); const Frame F = mkframe(ldsp, wave); p9_final(F, ap); }
#undef IN
#undef SEAM
}
constexpr int N_PHASES = 11;
}
#ifndef MK_BRINGUP
#define MK_BRINGUP 0
#endif
extern "C" void kernel_launch(void* const* d_in, const int* in_sizes, int n_in, void* d_out, int out_size, void* d_ws, size_t ws_size, hipStream_t stream) {
    static int grid = 0;
    if (grid == 0) {
        if (hipFuncSetAttribute((const void*)mk::mk_fwd, hipFuncAttributeMaxDynamicSharedMemorySize, mk::LDS_BYTES) != hipSuccess) { fprintf(stderr, "kernel_launch: hipFuncSetAttribute failed\n"); grid = -1; return; }
        int dev = 0, cus = 0, per_cu = 0;
        hipGetDevice(&dev); hipDeviceGetAttribute(&cus, hipDeviceAttributeMultiprocessorCount, dev);
        hipOccupancyMaxActiveBlocksPerMultiprocessor(&per_cu, (const void*)mk::mk_fwd, mk::NWAVES * 64, mk::LDS_BYTES);
        (void)hipGetLastError();
        grid = cus * (per_cu < 1 ? 1 : (per_cu > 1 ? 1 : per_cu));
        if (grid % 8 != 0 || grid <= 0) grid = 256;
        if (ws_size < mk::WS_END) { fprintf(stderr, "kernel_launch: workspace too small (%zu)\n", ws_size); grid = -1; return; }
    }
    if (grid < 0) return;
    mk::Args a{};
    for (int i = 0; i < 18; ++i) a.in[i] = (const float*)d_in[i];
    a.out = (float*)d_out; a.ws = (unsigned char*)d_ws;
#if MK_BRINGUP == 0
    a.ph_lo = 0; a.ph_hi = mk::N_PHASES;
    void* args[] = {&a};
    hipError_t e = hipLaunchCooperativeKernel((const void*)mk::mk_fwd, dim3(grid), dim3(mk::NWAVES * 64), args, mk::LDS_BYTES, stream);
    if (e != hipSuccess) fprintf(stderr, "cooperative launch failed: %s (grid %d)\n", hipGetErrorString(e), grid);
#else
    const int nph = MK_BRINGUP == 1 ? 3 : MK_BRINGUP == 2 ? 8 : mk::N_PHASES;
    for (int ph = 0; ph < nph; ++ph) { a.ph_lo = ph; a.ph_hi = ph + 1; hipLaunchKernelGGL(mk::mk_fwd, dim3(grid), dim3(mk::NWAVES * 64), mk::LDS_BYTES, stream, a); }
#if MK_BRINGUP == 1
    nv::part_mix(d_in, (float*)d_out, d_ws, stream); nv::part_ffn2_final(d_in, (float*)d_out, d_ws, stream);
#elif MK_BRINGUP == 2
    nv::part_ffn2_final(d_in, (float*)d_out, d_ws, stream);
#endif
#endif
}
```

```cpp
#define MK_BRINGUP 0
#include <hip/hip_runtime.h>
#include <cstdio>
#include <cstdint>
#include <cmath>
#include <hip/hip_cooperative_groups.h>
namespace cg = cooperative_groups;

namespace mkc {
constexpr int S = 16384, DM = 1024, DFF = 2816, NGU = 2 * DFF, NWIN = 2304;
constexpr float LOG2E = 1.4426950408889634f;
constexpr float C2Q = 0.10206207261596577f * LOG2E;
constexpr float C2M = 0.125f * LOG2E;
constexpr size_t MiB = 1u << 20;
constexpr size_t WS_CNT = 0;
constexpr size_t WS_SS1 = 1 * MiB, WS_SS2 = WS_SS1 + 65536, WS_SSQ = WS_SS2 + 65536, WS_SSKV = WS_SSQ + 65536, WS_SS3 = WS_SSKV + 65536, WS_SS4 = WS_SS3 + 65536;
constexpr size_t WS_KMS = WS_SS1 + 512 * 1024;
constexpr size_t WS_POSF = 2 * MiB, WS_COS = 3 * MiB, WS_SIN = 4 * MiB;
constexpr size_t WS_WGU1 = 6 * MiB, WS_WD1 = 17 * MiB, WS_WGU2 = WS_WD1 + 5632 * 1024, WS_WD2 = WS_WGU2 + 11 * MiB, WS_WIN = 39 * MiB, WS_WUQ = WS_WIN + 4608 * 1024, WS_WUKV = WS_WUQ + 768 * 1024, WS_WOUT = 45 * MiB;
constexpr size_t WS_XB = 48 * MiB, WS_CQKV = 80 * MiB, WS_PART = 48 * MiB, WS_PLSE = 112 * MiB;
constexpr size_t WS_ACT = 114 * MiB, WS_MQKV = 114 * MiB, WS_CAT = 114 * MiB, WS_Q = 162 * MiB, WS_KN = 186 * MiB, WS_V = 202 * MiB, WS_KR = 218 * MiB, WS_LIST = 220 * MiB, WS_END = 236 * MiB;
static_assert(WS_WD2 + 5632 * 1024 <= WS_WIN && WS_WUKV + 512 * 1024 <= WS_WOUT && WS_WOUT + 2 * MiB <= WS_XB, "weight map");
}
namespace pg8 {
#define PG8_LAS __attribute__((address_space(3)))
typedef unsigned short bf16_t;
typedef short bf16x8 __attribute__((ext_vector_type(8)));
typedef float f32x4 __attribute__((ext_vector_type(4)));
typedef unsigned u32x4 __attribute__((ext_vector_type(4)));
__device__ __forceinline__ int lane_id_v() { int l; asm volatile("v_mbcnt_lo_u32_b32 %0, -1, 0\n\tv_mbcnt_hi_u32_b32 %0, -1, %0" : "=v"(l)); return l; }
constexpr int BM = 256, BK = 64, HALF = 128, HTB = HALF * BK * 2  , STAGE_BYTES = 8 * HTB, NXCD = 8, WGM = 8;

__host__ __device__ __forceinline__ int lds_byte(int r, int c) { const int st = (r >> 4) * 2 + (c >> 5), rr = r & 15, cc = c & 31, ob = rr * 64 + cc * 2; return st * 1024 + (ob ^ (((ob >> 9) & 1) << 5)); }
__host__ __device__ __forceinline__ void stage_rc(int b, int& R, int& C) { const int st = b / 1024, sb = b % 1024, swz = sb ^ (((sb >> 9) & 1) << 5); R = (st >> 1) * 16 + swz / 64; C = (st & 1) * 32 + (swz % 64) / 2; }
__host__ __device__ __forceinline__ int perm32(int rho) { const int n = rho >> 4, i = rho & 15; return 8 * (i >> 2) + 4 * n + (i & 3); }

struct Unit { int pm, pn; };
struct Gemm { const bf16_t* A; const bf16_t* Bt; int M, N, K, lda; };

struct StaticOrder {
    int nM, nN, nwg, G, c;
    __host__ __device__ void init(int M, int N, int G_, int c_) { nM = M / BM; nN = N / BM; nwg = nM * nN; G = G_; c = c_; }
    __host__ __device__ bool next(int i, Unit& u) const {
        const long L = (long)i * G + c; if (L >= nwg) return false;
        int wgid = (int)L; { const int q = nwg / NXCD, r = nwg % NXCD, xcd = wgid % NXCD, off = wgid / NXCD; wgid = (xcd < r ? xcd * (q + 1) : r * (q + 1) + (xcd - r) * q) + off; }
        const int nig = WGM * nN, gid = wgid / nig, fm = gid * WGM, gsz = (nM - fm) < WGM ? (nM - fm) : WGM;
        u.pm = fm + ((wgid % nig) % gsz); u.pn = (wgid % nig) / gsz; return true;
    }
    __device__ __forceinline__ void a_ready(const Unit&) const {}
    __device__ __forceinline__ void done(const Unit&) const {}
};

__device__ __forceinline__ unsigned cvt_pk_bf16(float lo, float hi) { unsigned r; asm volatile("v_cvt_pk_bf16_f32 %0, %1, %2" : "=v"(r) : "v"(lo), "v"(hi)); return r; }
typedef unsigned u32x2 __attribute__((ext_vector_type(2)));
constexpr float RMS_EPS = 1e-6f;
__device__ __forceinline__ float rs_of(const float* ss, int row, float invn) { return __builtin_amdgcn_rsqf(ss[row] * invn + RMS_EPS); }
__device__ __forceinline__ float silu_f(float g) { return g * __builtin_amdgcn_rcpf(1.0f + __builtin_amdgcn_exp2f(-1.4426950408889634f * g)); }
__device__ __forceinline__ u32x4 pack8(const f32x4 a, const f32x4 b) { u32x4 w; w.x = cvt_pk_bf16(a[0], a[1]); w.y = cvt_pk_bf16(a[2], a[3]); w.z = cvt_pk_bf16(b[0], b[1]); w.w = cvt_pk_bf16(b[2], b[3]); return w; }

struct EpiSwiGLU {
    static constexpr bool PERM = true, AFTER_DRAIN = false;
    unsigned char* ws; int which;
    __device__ __forceinline__ void operator()(const f32x4 (&acc)[2][2][4][2], const Unit& u, int wr, int wc, int fr, int fq) const {
        bf16_t* O = (bf16_t*)(ws + mkc::WS_ACT); const int ldo = mkc::DFF; const float* ss = (const float*)(ws + (which ? mkc::WS_SS3 : mkc::WS_SS1)); const float invn = 1.0f / 1024.0f;
        const int row0 = u.pm * BM + wr * 64 + fr, col0 = u.pn * HALF + wc * 32 + 8 * fq;
#pragma unroll
        for (int ai = 0; ai < 2; ++ai)
#pragma unroll
            for (int m = 0; m < 4; ++m) { const int row = row0 + ai * HALF + m * 16; const float rs = rs_of(ss, row, invn);
                f32x4 a0, a1;
#pragma unroll
                for (int j = 0; j < 4; ++j) { a0[j] = silu_f(acc[ai][0][m][0][j] * rs) * (acc[ai][1][m][0][j] * rs); a1[j] = silu_f(acc[ai][0][m][1][j] * rs) * (acc[ai][1][m][1][j] * rs); }
                *(u32x4*)(O + (size_t)row * ldo + col0) = pack8(a0, a1); }
    }
};
struct EpiResid {
    static constexpr bool PERM = false, AFTER_DRAIN = false;
    const float* base; float* out; unsigned char* ws; int ss_off; int has_xb; float alpha;
    __device__ __forceinline__ void operator()(const f32x4 (&acc)[2][2][4][2], const Unit& u, int wr, int wc, int fr, int fq) const {
        bf16_t* xb = has_xb ? (bf16_t*)(ws + mkc::WS_XB) : nullptr; float* ss_out = (float*)(ws + ss_off);
        const int row0 = u.pm * BM + wr * 64 + fr, col0 = u.pn * BM + wc * 32 + 4 * fq;
#pragma unroll
        for (int ai = 0; ai < 2; ++ai)
#pragma unroll
            for (int m = 0; m < 4; ++m) { const int row = row0 + ai * HALF + m * 16; const size_t off = (size_t)row * 1024 + col0; float s = 0.f;
#pragma unroll
                for (int bj = 0; bj < 2; ++bj)
#pragma unroll
                    for (int n = 0; n < 2; ++n) { const f32x4 b = *(const f32x4*)(base + off + bj * HALF + n * 16); const f32x4 o = b + acc[ai][bj][m][n] * alpha;
                        *(f32x4*)(out + off + bj * HALF + n * 16) = o; s += (o[0] * o[0] + o[1] * o[1]) + (o[2] * o[2] + o[3] * o[3]);
                        if (xb) { u32x2 w; w.x = cvt_pk_bf16(o[0], o[1]); w.y = cvt_pk_bf16(o[2], o[3]); *(u32x2*)(xb + off + bj * HALF + n * 16) = w; } }
                s += __shfl_xor(s, 16); s += __shfl_xor(s, 32);
                if (fq == 0) atomicAdd(ss_out + row, s);
                asm volatile("" ::: "memory"); }
    }
};
struct EpiWin {
    static constexpr bool PERM = true, AFTER_DRAIN = false;
    unsigned char* ws;
    __device__ __forceinline__ void operator()(const f32x4 (&acc)[2][2][4][2], const Unit& u, int wr, int wc, int fr, int fq) const {
        bf16_t* cqkv = (bf16_t*)(ws + mkc::WS_CQKV); bf16_t* mqkv = (bf16_t*)(ws + mkc::WS_MQKV); const float* ss_in = (const float*)(ws + mkc::WS_SS2);
        float* ssq = (float*)(ws + mkc::WS_SSQ); float* sskv = (float*)(ws + mkc::WS_SSKV); float* kmsum = (float*)(ws + mkc::WS_KMS);
        const int row0 = u.pm * BM + wr * 64 + fr;
        const bool is_mk = (u.pn == 5 || u.pn == 6);
        f32x4 cs[2][2];
#pragma unroll
        for (int bj = 0; bj < 2; ++bj)
#pragma unroll
            for (int n = 0; n < 2; ++n) cs[bj][n] = (f32x4){0.f, 0.f, 0.f, 0.f};
#pragma unroll
        for (int ai = 0; ai < 2; ++ai)
#pragma unroll
            for (int m = 0; m < 4; ++m) { const int row = row0 + ai * HALF + m * 16; const float rs = rs_of(ss_in, row, 1.0f / 1024.0f);
#pragma unroll
                for (int bj = 0; bj < 2; ++bj) { const int colt = u.pn * BM + bj * HALF, col0 = colt + wc * 32 + 8 * fq;
                    const f32x4 v0 = acc[ai][bj][m][0] * rs, v1 = acc[ai][bj][m][1] * rs;
                    bf16_t* dst = (colt < 768) ? (cqkv + (size_t)row * 768 + col0) : (mqkv + (size_t)row * 1536 + (col0 - 768));
                    *(u32x4*)dst = pack8(v0, v1);
                    if (colt < 640) { float s = (v0[0] * v0[0] + v0[1] * v0[1]) + (v0[2] * v0[2] + v0[3] * v0[3]) + (v1[0] * v1[0] + v1[1] * v1[1]) + (v1[2] * v1[2] + v1[3] * v1[3]);
                        s += __shfl_xor(s, 16); s += __shfl_xor(s, 32);
                        if (fq == 0) atomicAdd((colt < 384 ? ssq : sskv) + row, s); }
                    if (is_mk) { cs[bj][0] += v0; cs[bj][1] += v1; } } }
        if (is_mk) {
#pragma unroll
            for (int bj = 0; bj < 2; ++bj)
#pragma unroll
                for (int n = 0; n < 2; ++n)
#pragma unroll
                    for (int j = 0; j < 4; ++j) { float s = cs[bj][n][j]; s += __shfl_xor(s, 1); s += __shfl_xor(s, 2); s += __shfl_xor(s, 4); s += __shfl_xor(s, 8);
                        if (fr == 0) atomicAdd(kmsum + (size_t)u.pm * 512 + (u.pn * BM + bj * HALF + wc * 32 + 8 * fq + 4 * n + j - 1280), s); }
        }
    }
};
struct EpiKV {
    static constexpr bool PERM = true, AFTER_DRAIN = false;
    unsigned char* ws;
    __device__ __forceinline__ void operator()(const f32x4 (&acc)[2][2][4][2], const Unit& u, int wr, int wc, int fr, int fq) const {
        bf16_t* Kn = (bf16_t*)(ws + mkc::WS_KN); bf16_t* V = (bf16_t*)(ws + mkc::WS_V); const float* ss = (const float*)(ws + mkc::WS_SSKV);
        const int row0 = u.pm * BM + wr * 64 + fr;
#pragma unroll
        for (int ai = 0; ai < 2; ++ai)
#pragma unroll
            for (int m = 0; m < 4; ++m) { const int row = row0 + ai * HALF + m * 16; const float rs = rs_of(ss, row, 1.0f / 256.0f);
#pragma unroll
                for (int bj = 0; bj < 2; ++bj) { const int colt = u.pn * BM + bj * HALF, col0 = colt + wc * 32 + 8 * fq;
                    bf16_t* dst = (colt < 512) ? (Kn + (size_t)row * 512 + col0) : (V + (size_t)row * 512 + (col0 - 512));
                    *(u32x4*)dst = pack8(acc[ai][bj][m][0] * rs, acc[ai][bj][m][1] * rs); } }
    }
};
struct EpiQ {
    static constexpr bool PERM = true, AFTER_DRAIN = false;
    unsigned char* ws;
    __device__ __forceinline__ void operator()(const f32x4 (&acc)[2][2][4][2], const Unit& u, int wr, int wc, int fr, int fq) const {
        bf16_t* Q = (bf16_t*)(ws + mkc::WS_Q); const float* ss = (const float*)(ws + mkc::WS_SSQ); const float* cosT = (const float*)(ws + mkc::WS_COS); const float* sinT = (const float*)(ws + mkc::WS_SIN);
        const int row0 = u.pm * BM + wr * 64 + fr;
#pragma unroll
        for (int ai = 0; ai < 2; ++ai)
#pragma unroll
            for (int m = 0; m < 4; ++m) { const int row = row0 + ai * HALF + m * 16; const float rs = rs_of(ss, row, 1.0f / 384.0f);
#pragma unroll
                for (int bj = 0; bj < 2; ++bj) { const int col0 = u.pn * BM + bj * HALF + wc * 32 + 8 * fq; const int d = col0 % 96;
                    f32x4 v0 = acc[ai][bj][m][0] * rs, v1 = acc[ai][bj][m][1] * rs;
                    if (d >= 64) { const int g = (d - 64) >> 3; const f32x4 c = *(const f32x4*)(cosT + (size_t)row * 16 + 4 * g), s = *(const f32x4*)(sinT + (size_t)row * 16 + 4 * g);
                        const f32x4 o0 = v0 * c - v1 * s, o1 = v0 * s + v1 * c; v0 = o0; v1 = o1; }
                    *(u32x4*)(Q + (size_t)row * 768 + col0) = pack8(v0, v1); }
                asm volatile("" ::: "memory"); }
    }
};

template <class Epi, class Sched, bool ALIGN_EPI = false, bool SP2 = false>
__device__ __forceinline__ void gemm_phase(PG8_LAS unsigned char* lds, const Gemm g, const Sched& S, const Epi& E, const int wid) {
    const int lane = lane_id_v(), tid = wid * 64 + lane, wr = wid >> 2, wc = wid & 3, fr = lane & 15, fq = lane >> 4;
    const int K = g.K, nt = K / BK, lda = g.lda;
    unsigned voffA[2], voffB[2];
#pragma unroll
    for (int i = 0; i < 2; ++i) { int R, C; stage_rc(tid * 16 + i * 8192, R, C); const int Rb = Epi::PERM ? ((R & ~31) + perm32(R & 31)) : R;
        voffA[i] = (unsigned)(R * lda + C) * 2u; voffB[i] = (unsigned)(Rb * K + C) * 2u; }
    const size_t kstep = (size_t)(BK * 2);
    const size_t hstep = (size_t)HALF * K * 2;
    const size_t tstep = 2 * hstep; const size_t hstepA = (size_t)HALF * lda * 2, tstepA = 2 * hstepA;
    const unsigned ldsw = (unsigned)wid * 1024u;
    const int aoff = lds_byte(wr * 64 + fr, fq * 8), boff = lds_byte(wc * 32 + fr, fq * 8);
#define PG8_SA(b, h) (((b) * 2 + (h)) * HTB)
#define PG8_SB(b, h) ((4 + (b) * 2 + (h)) * HTB)
#define PG8_STAGE(bufoff, gbase, voff) do { _Pragma("unroll") for (int _i = 0; _i < 2; ++_i) \
        __builtin_amdgcn_global_load_lds((const unsigned*)((const char*)(gbase) + (voff)[_i]), (PG8_LAS unsigned*)(lds + (bufoff) + ldsw + _i * 8192), 16, 0, 0); } while (0)
#define PG8_LDA(dst, b, h) do { _Pragma("unroll") for (int m = 0; m < 4; ++m) _Pragma("unroll") for (int k = 0; k < 2; ++k) dst[m][k] = *(const PG8_LAS bf16x8*)(lds + PG8_SA(b, h) + aoff + m * 2048 + k * 1024); } while (0)
#define PG8_LDB(dst, b, h) do { _Pragma("unroll") for (int n = 0; n < 2; ++n) _Pragma("unroll") for (int k = 0; k < 2; ++k) dst[n][k] = *(const PG8_LAS bf16x8*)(lds + PG8_SB(b, h) + boff + n * 2048 + k * 1024); } while (0)
#define PG8_MMA(ai, bj, At, Bt) do { __builtin_amdgcn_s_setprio(1); _Pragma("unroll") for (int m = 0; m < 4; ++m) _Pragma("unroll") for (int n = 0; n < 2; ++n) _Pragma("unroll") for (int k = 0; k < 2; ++k) \
        acc[ai][bj][m][n] = __builtin_amdgcn_mfma_f32_16x16x32_bf16(Bt[n][k], At[m][k], acc[ai][bj][m][n], 0, 0, 0); __builtin_amdgcn_s_setprio(0); } while (0)
#define PG8_WAIT_V(n) asm volatile("s_waitcnt vmcnt(" #n ")" ::: "memory")
#define PG8_WAIT_L(n) asm volatile("s_waitcnt lgkmcnt(" #n ")" ::: "memory")
#define PG8_BAR __builtin_amdgcn_s_barrier()
#define PG8_SCHED __builtin_amdgcn_sched_barrier(0)
    Unit cur, nxt; int ui = 0;
    if (!S.next(0, cur)) return;
    f32x4 acc[2][2][4][2];
#pragma unroll
    for (int a = 0; a < 2; ++a)
#pragma unroll
        for (int b = 0; b < 2; ++b)
#pragma unroll
            for (int m = 0; m < 4; ++m)
#pragma unroll
                for (int n = 0; n < 2; ++n) acc[a][b][m][n] = (f32x4){0.f, 0.f, 0.f, 0.f};
    bf16x8 At[4][2], B0[2][2], B1[2][2];
    const char* cA = (const char*)g.A + (size_t)cur.pm * tstepA; const char* cB = (const char*)g.Bt + (size_t)cur.pn * tstep;
    S.a_ready(cur);
    if constexpr (SP2) {
        PG8_STAGE(PG8_SB(0, 0), cB, voffB); PG8_STAGE(PG8_SB(0, 1), cB + hstep, voffB); PG8_STAGE(PG8_SA(0, 0), cA, voffA); PG8_STAGE(PG8_SA(0, 1), cA + hstepA, voffA);
        if (wr == 1) PG8_BAR;
        PG8_WAIT_V(2); PG8_BAR;
        PG8_STAGE(PG8_SB(1, 0), cB + kstep, voffB); PG8_STAGE(PG8_SA(1, 0), cA + kstep, voffA); PG8_STAGE(PG8_SB(1, 1), cB + hstep + kstep, voffB);
        PG8_WAIT_V(6); PG8_BAR;
    } else {
        PG8_STAGE(PG8_SB(0, 0), cB, voffB); PG8_STAGE(PG8_SA(0, 0), cA, voffA); PG8_STAGE(PG8_SB(0, 1), cB + hstep, voffB); PG8_STAGE(PG8_SA(0, 1), cA + hstepA, voffA);
        if (wr == 1) PG8_BAR;
        PG8_WAIT_V(4); PG8_BAR;
        PG8_STAGE(PG8_SB(1, 0), cB + kstep, voffB); PG8_STAGE(PG8_SA(1, 0), cA + kstep, voffA); PG8_STAGE(PG8_SB(1, 1), cB + hstep + kstep, voffB);
        PG8_WAIT_V(6); PG8_BAR;
    }
    for (;;) {
        const bool has_next = S.next(ui + 1, nxt);
        const char* nA = has_next ? (const char*)g.A + (size_t)nxt.pm * tstepA : cA; const char* nB = has_next ? (const char*)g.Bt + (size_t)nxt.pn * tstep : cB;
#pragma nounroll
        for (int t = 0; t < nt; t += 2) {
            const bool last = (t == nt - 2);
            const char* a1 = cA + (size_t)(t + 1) * kstep;
            const char* a2 = last ? nA : cA + (size_t)(t + 2) * kstep; const char* b2 = last ? nB : cB + (size_t)(t + 2) * kstep;
            const char* a3 = a2 + kstep; const char* b3 = b2 + kstep;
            if (last && has_next) S.a_ready(nxt);
            if constexpr (SP2) {
            PG8_LDB(B0, 0, 0); PG8_LDB(B1, 0, 1); PG8_SCHED; PG8_LDA(At, 0, 0); PG8_STAGE(PG8_SA(1, 1), a1 + hstepA, voffA);
            PG8_WAIT_V(8); PG8_WAIT_L(0); PG8_BAR; PG8_MMA(0, 0, At, B0); PG8_MMA(0, 1, At, B1); PG8_BAR; PG8_SCHED;
            PG8_LDA(At, 0, 1); PG8_STAGE(PG8_SB(0, 0), b2, voffB); PG8_STAGE(PG8_SB(0, 1), b2 + hstep, voffB); PG8_STAGE(PG8_SA(0, 0), a2, voffA);
            PG8_WAIT_V(8); PG8_WAIT_L(0); PG8_BAR; PG8_MMA(1, 0, At, B0); PG8_MMA(1, 1, At, B1); PG8_BAR; PG8_SCHED;
            PG8_LDB(B0, 1, 0); PG8_LDB(B1, 1, 1); PG8_SCHED; PG8_LDA(At, 1, 0); PG8_STAGE(PG8_SA(0, 1), a2 + hstepA, voffA);
            PG8_WAIT_V(8); PG8_WAIT_L(0); PG8_BAR; PG8_MMA(0, 0, At, B0); PG8_MMA(0, 1, At, B1); PG8_BAR; PG8_SCHED;
            PG8_LDA(At, 1, 1); PG8_STAGE(PG8_SB(1, 0), b3, voffB); PG8_STAGE(PG8_SB(1, 1), b3 + hstep, voffB); PG8_STAGE(PG8_SA(1, 0), a3, voffA);
            PG8_WAIT_V(8); PG8_WAIT_L(0); PG8_BAR; PG8_MMA(1, 0, At, B0); PG8_MMA(1, 1, At, B1); PG8_BAR; PG8_SCHED;
            } else {
            PG8_LDB(B0, 0, 0); PG8_SCHED; PG8_LDA(At, 0, 0); PG8_STAGE(PG8_SA(1, 1), a1 + hstepA, voffA);
            PG8_WAIT_L(8); PG8_BAR; PG8_WAIT_L(0); PG8_MMA(0, 0, At, B0); PG8_BAR; PG8_SCHED;
            PG8_LDB(B1, 0, 1); PG8_STAGE(PG8_SB(0, 0), b2, voffB);
            PG8_BAR; PG8_WAIT_L(0); PG8_MMA(0, 1, At, B1); PG8_BAR;
            PG8_LDA(At, 0, 1); PG8_STAGE(PG8_SA(0, 0), a2, voffA);
            PG8_BAR; PG8_WAIT_L(0); PG8_MMA(1, 0, At, B0); PG8_BAR; PG8_SCHED;
            PG8_STAGE(PG8_SB(0, 1), b2 + hstep, voffB);
            PG8_WAIT_V(6); PG8_BAR; PG8_MMA(1, 1, At, B1); PG8_BAR;
            PG8_LDB(B0, 1, 0); PG8_SCHED; PG8_LDA(At, 1, 0); PG8_STAGE(PG8_SA(0, 1), a2 + hstepA, voffA);
            PG8_WAIT_L(8); PG8_BAR; PG8_WAIT_L(0); PG8_MMA(0, 0, At, B0); PG8_BAR; PG8_SCHED;
            PG8_LDB(B1, 1, 1); PG8_STAGE(PG8_SB(1, 0), b3, voffB);
            PG8_BAR; PG8_WAIT_L(0); PG8_MMA(0, 1, At, B1); PG8_BAR;
            PG8_LDA(At, 1, 1); PG8_STAGE(PG8_SA(1, 0), a3, voffA);
            PG8_BAR; PG8_WAIT_L(0); PG8_MMA(1, 0, At, B0); PG8_BAR; PG8_SCHED;
            PG8_STAGE(PG8_SB(1, 1), b3 + hstep, voffB);
            PG8_WAIT_V(6); PG8_BAR; PG8_MMA(1, 1, At, B1); PG8_BAR;
            }
        }
        if constexpr (ALIGN_EPI) { if (wr == 0) PG8_BAR; }
        if constexpr (!Epi::AFTER_DRAIN) { E(acc, cur, wr, wc, fr, fq); S.done(cur); }
        if (!has_next) break;
#pragma unroll
        for (int a = 0; a < 2; ++a)
#pragma unroll
            for (int b = 0; b < 2; ++b)
#pragma unroll
                for (int m = 0; m < 4; ++m)
#pragma unroll
                    for (int n = 0; n < 2; ++n) acc[a][b][m][n] = (f32x4){0.f, 0.f, 0.f, 0.f};
        cur = nxt; cA = nA; cB = nB; ++ui;
        if constexpr (ALIGN_EPI) { if (wr == 1) PG8_BAR; }
    }
    PG8_WAIT_V(0);
    if constexpr (!ALIGN_EPI) { if (wr == 0) PG8_BAR; }
    PG8_BAR;
    if constexpr (Epi::AFTER_DRAIN) { E.fused(acc, cur, wr, wc, fr, fq, lds, wid, lane); S.done(cur); }
#undef PG8_SA
#undef PG8_SB
#undef PG8_STAGE
#undef PG8_LDA
#undef PG8_LDB
#undef PG8_MMA
#undef PG8_WAIT_V
#undef PG8_WAIT_L
#undef PG8_BAR
#undef PG8_SCHED
}
}
namespace att {
typedef unsigned short bf16_t;
using bf16x8 = __attribute__((ext_vector_type(8))) short;
using s16x4 = __attribute__((ext_vector_type(4))) short;
using f32x16 = __attribute__((ext_vector_type(16))) float;
using f32x4 = __attribute__((ext_vector_type(4))) float;
using u32x4 = __attribute__((ext_vector_type(4))) unsigned;
typedef short v4i16_t __attribute__((ext_vector_type(4)));
#define ATT_LAS __attribute__((address_space(3)))
typedef ATT_LAS const char* lds_cptr;
constexpr int NW = 8, KVBLK = 64;
constexpr int KSLOT = 12288, VSLOT = 8192, NSLOT = 3;
constexpr int LDS_K = 0, LDS_V = NSLOT * KSLOT, LDS_WS = LDS_V + NSLOT * VSLOT, LDS_OST = LDS_WS + NW * 64 * 4, LDS_POSK = LDS_OST + NW * 4096, LDS_BYTES = LDS_POSK + 1024;
__device__ __forceinline__ int crow(int r, int hi) { return (r & 3) + 8 * (r >> 2) + 4 * hi; }
__device__ __forceinline__ void glds16(const void* gsrc, unsigned lds_dst) { unsigned keep;
    asm volatile("s_mov_b32 %0, m0\n\ts_mov_b32 m0, %2\n\ts_nop 0\n\tglobal_load_lds_dwordx4 %1, off\n\ts_mov_b32 m0, %0" : "=&s"(keep) : "v"(gsrc), "s"(lds_dst) : "memory"); }
__device__ __forceinline__ unsigned cvtpk(float lo, float hi) { unsigned r; asm volatile("v_cvt_pk_bf16_f32 %0, %1, %2" : "=v"(r) : "v"(lo), "v"(hi)); return r; }
__device__ __forceinline__ s16x4 vtr(lds_cptr p) { return __builtin_bit_cast(s16x4, __builtin_amdgcn_ds_read_tr16_b64_v4i16((ATT_LAS v4i16_t*)p)); }
#define ATT_WAIT_BAR() asm volatile("s_waitcnt vmcnt(0) lgkmcnt(0)\n\ts_barrier" ::: "memory")

struct Unit {
    const bf16_t* Q; int q_pitch;
    const bf16_t* K; int k_pitch;
    const bf16_t* Kr;
    const bf16_t* V; int v_pitch;
    int key0, ntiles;
    int q0;
    const unsigned short* list; int len;
    const float* posf;
    float slope2;
    bf16_t* O; int o_pitch;
    bf16_t* part; float* plse; int h;
};

template <int MODE> __device__ __forceinline__ void unit(const Unit& U, char* shm, const int wid) {
    constexpr int DQK = (MODE == 0) ? 96 : 64, ND0 = DQK / 16;
    const int lane = pg8::lane_id_v(), tid = wid * 64 + lane, r32 = lane & 31, hi = lane >> 5;
    const unsigned lds0 = (unsigned)(uintptr_t)shm;
    const lds_cptr shm3 = (lds_cptr)shm;
    ATT_LAS float* wsf = (ATT_LAS float*)(shm3 + LDS_WS) + wid * 64;
    int qrow, slot = 0; bool valid = true;
    if (MODE == 2) { const int e = wid * 32 + r32; valid = e < U.len; const unsigned ent = valid ? (unsigned)U.list[e] : (unsigned)U.list[0]; qrow = (int)(ent & 0x3FFFu); slot = 1 + (int)(ent >> 14); }
    else qrow = U.q0 + wid * 32 + r32;
    const bf16_t* ksrc = U.K + (size_t)(U.key0 + lane) * U.k_pitch + wid * 8;
    const bf16_t* krsrc = (MODE == 0) ? U.Kr + (size_t)(U.key0 + lane) * 32 + (wid & 3) * 8 : nullptr;
    const bf16_t* vsrc = U.V + (size_t)(U.key0 + 16 * (wid & 3) + (lane >> 2)) * U.v_pitch + (wid >> 2) * 32 + (lane & 3) * 8;
    const unsigned kdst = lds0 + LDS_K + wid * 1024, krdst = lds0 + LDS_K + (8 + (wid & 3)) * 1024, vdst = lds0 + LDS_V + wid * 1024;
#define ATT_DMA(t, ks, vs) do { glds16(ksrc + (size_t)(t) * KVBLK * U.k_pitch, (unsigned)__builtin_amdgcn_readfirstlane(kdst + (ks))); \
        if (MODE == 0 && wid < 4) glds16(krsrc + (size_t)(t) * KVBLK * 32, (unsigned)__builtin_amdgcn_readfirstlane(krdst + (ks))); \
        glds16(vsrc + (size_t)(t) * KVBLK * U.v_pitch, (unsigned)__builtin_amdgcn_readfirstlane(vdst + (vs))); } while (0)
    const int NT = U.ntiles;
    ATT_DMA(0, 0, 0);
    if (NT > 1) ATT_DMA(1, KSLOT, VSLOT);
    bf16x8 qr[ND0];
    { const bf16_t* Qw = U.Q + (size_t)qrow * U.q_pitch + hi * 8;
#pragma unroll
      for (int d0 = 0; d0 < ND0; ++d0) qr[d0] = *reinterpret_cast<const bf16x8*>(Qw + d0 * 16); }
    float pq = 0.f;
    if (MODE != 0) { pq = U.posf[qrow]; if (tid < 256) ((ATT_LAS float*)(shm3 + LDS_POSK))[tid] = U.posf[U.key0 + tid]; }
    float mhat = -1e30f, l_reg = 0.f; f32x16 o[2]; o[0] = f32x16{}; o[1] = f32x16{};
    const lds_cptr kp0 = shm3 + LDS_K + hi * 1024 + r32 * 16;
    const lds_cptr vp0 = shm3 + LDS_V + ((lane >> 4) & 1) * 32 + (lane & 3) * 8 + (4 * hi + ((lane & 15) >> 2)) * 64;
    int ks_cur = 0, vs_cur = 0, ks_free = 2 * KSLOT, vs_free = 2 * VSLOT;
    for (int t = 0; t < NT; ++t) {
        ATT_WAIT_BAR();
        if (t + 2 < NT) ATT_DMA(t + 2, ks_free, vs_free);
        bool active = true;
        if (MODE == 1) active = (64 * t <= wid * 32 + 31);
        if (active) {
            f32x16 p0 = f32x16{}, p1 = f32x16{};
            const lds_cptr kp = kp0 + ks_cur;
#pragma unroll
            for (int d0 = 0; d0 < ND0; ++d0) {
                const bf16x8 b0 = *(const ATT_LAS bf16x8*)(kp + d0 * 2048);
                const bf16x8 b1 = *(const ATT_LAS bf16x8*)(kp + d0 * 2048 + 512);
                p0 = __builtin_amdgcn_mfma_f32_32x32x16_bf16(b0, qr[d0], p0, 0, 0, 0);
                p1 = __builtin_amdgcn_mfma_f32_32x32x16_bf16(b1, qr[d0], p1, 0, 0, 0);
            }
            if (MODE != 0) {
                const ATT_LAS float* pk = (const ATT_LAS float*)(shm3 + LDS_POSK) + 64 * t + 4 * hi;
#pragma unroll
                for (int g = 0; g < 4; ++g) { const f32x4 a = *(const ATT_LAS f32x4*)(pk + 8 * g), b = *(const ATT_LAS f32x4*)(pk + 8 * g + 32);
#pragma unroll
                    for (int j = 0; j < 4; ++j) { p0[4 * g + j] -= U.slope2 * __builtin_fabsf(pq - a[j]); p1[4 * g + j] -= U.slope2 * __builtin_fabsf(pq - b[j]); } }
            }
            if (MODE == 0 || MODE == 1) {
                const int kb = U.key0 + 64 * t;
                if (kb + 63 > U.q0 + wid * 32) {
                    const int dq = qrow - kb - 4 * hi;
#pragma unroll
                    for (int r = 0; r < 16; ++r) { const int c = (r & 3) + 8 * (r >> 2); if (c > dq) p0[r] = -INFINITY; if (c + 32 > dq) p1[r] = -INFINITY; }
                }
            }
            float rm = p0[0];
#pragma unroll
            for (int r = 1; r < 16; ++r) rm = fmaxf(rm, p0[r]);
#pragma unroll
            for (int r = 0; r < 16; ++r) rm = fmaxf(rm, p1[r]);
            { auto rr = __builtin_amdgcn_permlane32_swap(__float_as_uint(rm), __float_as_uint(rm), false, false); rm = fmaxf(__uint_as_float(rr[0]), __uint_as_float(rr[1])); }
            if (__any(rm > mhat)) {
                const float mn = fmaxf(mhat, rm), f = __builtin_amdgcn_exp2f(mhat - mn);
                mhat = mn; l_reg *= f;
                if (hi == 0) wsf[r32] = f;
                asm volatile("s_waitcnt lgkmcnt(0)" ::: "memory");
#pragma unroll
                for (int g = 0; g < 4; ++g) { const f32x4 fv = *(const ATT_LAS f32x4*)(wsf + 8 * g + 4 * hi);
#pragma unroll
                    for (int j = 0; j < 4; ++j) { o[0][4 * g + j] *= fv[j]; o[1][4 * g + j] *= fv[j]; } }
            }
            float sacc = 0.f;
#pragma unroll
            for (int r = 0; r < 16; ++r) { p0[r] = __builtin_amdgcn_exp2f(p0[r] - mhat); p1[r] = __builtin_amdgcn_exp2f(p1[r] - mhat); sacc += p0[r] + p1[r]; }
            l_reg += sacc;
            u32x4 pw[4];
#pragma unroll
            for (int s = 0; s < 2; ++s) { pw[s] = (u32x4){cvtpk(p0[8 * s], p0[8 * s + 1]), cvtpk(p0[8 * s + 2], p0[8 * s + 3]), cvtpk(p0[8 * s + 4], p0[8 * s + 5]), cvtpk(p0[8 * s + 6], p0[8 * s + 7])};
                pw[2 + s] = (u32x4){cvtpk(p1[8 * s], p1[8 * s + 1]), cvtpk(p1[8 * s + 2], p1[8 * s + 3]), cvtpk(p1[8 * s + 4], p1[8 * s + 5]), cvtpk(p1[8 * s + 6], p1[8 * s + 7])}; }
            const lds_cptr vp = vp0 + vs_cur;
#pragma unroll
            for (int d0 = 0; d0 < 2; ++d0)
#pragma unroll
                for (int ks = 0; ks < 4; ++ks) { const s16x4 lo = vtr(vp + d0 * 4096 + ks * 1024), hh = vtr(vp + d0 * 4096 + ks * 1024 + 512);
                    const bf16x8 vf = (bf16x8){lo[0], lo[1], lo[2], lo[3], hh[0], hh[1], hh[2], hh[3]};
                    o[d0] = __builtin_amdgcn_mfma_f32_32x32x16_bf16(__builtin_bit_cast(bf16x8, pw[ks]), vf, o[d0], 0, 0, 0); }
        }
        { const int kn = ks_cur + KSLOT, vn = vs_cur + VSLOT; const int kf = ks_cur, vf_ = vs_cur; ks_cur = (kn == NSLOT * KSLOT) ? 0 : kn; vs_cur = (vn == NSLOT * VSLOT) ? 0 : vn; ks_free = kf; vs_free = vf_; }
    }
    { auto rr = __builtin_amdgcn_permlane32_swap(__float_as_uint(l_reg), __float_as_uint(l_reg), false, false); l_reg = __uint_as_float(rr[0]) + __uint_as_float(rr[1]); }
    if (hi == 0) wsf[32 + r32] = l_reg;
    asm volatile("s_waitcnt lgkmcnt(0)" ::: "memory");
    float rli[16];
#pragma unroll
    for (int r = 0; r < 16; ++r) rli[r] = __builtin_amdgcn_rcpf(wsf[32 + crow(r, hi)]);
    ATT_LAS bf16_t* stg = (ATT_LAS bf16_t*)(shm3 + LDS_OST) + wid * 2048;
#pragma unroll
    for (int r = 0; r < 16; ++r) { const int orow = crow(r, hi);
#pragma unroll
        for (int d0 = 0; d0 < 2; ++d0) { const unsigned w = cvtpk(o[d0][r] * rli[r], 0.f); stg[orow * 64 + d0 * 32 + r32] = (bf16_t)(w & 0xFFFFu); } }
    asm volatile("s_waitcnt lgkmcnt(0)" ::: "memory");
    if (MODE == 0) {
        bf16_t* Ow = U.O + (size_t)(U.q0 + wid * 32) * U.o_pitch;
#pragma unroll
        for (int i = 0; i < 4; ++i) { const int row = i * 8 + (lane >> 3), ch = lane & 7; const u32x4 v = *(const ATT_LAS u32x4*)(stg + row * 64 + ch * 8); *(u32x4*)(Ow + (size_t)row * U.o_pitch + ch * 8) = v; }
    } else {
        const int meta = valid ? ((qrow << 2) | slot) : -1;
#pragma unroll
        for (int i = 0; i < 4; ++i) { const int row = i * 8 + (lane >> 3), ch = lane & 7; const int mt = __shfl(meta, row); const u32x4 v = *(const ATT_LAS u32x4*)(stg + row * 64 + ch * 8);
            if (mt >= 0) *(u32x4*)(U.part + ((size_t)((mt >> 2) * 8 + U.h) * 4 + (mt & 3)) * 64 + ch * 8) = v; }
        if (hi == 0 && valid) U.plse[(size_t)(qrow * 8 + U.h) * 4 + slot] = mhat + __builtin_log2f(l_reg);
    }
    asm volatile("s_waitcnt vmcnt(0) lgkmcnt(0)\n\ts_barrier" ::: "memory");
#undef ATT_DMA
}
}

namespace xb {
#define LAS __attribute__((address_space(3)))
#define XB_TMO      128
#define XB_XCNT(j)  (256  + 64 * (j))
#define XB_XSUB(j)  (1280 + 64 * (j))
#define XB_XGEN(j)  (2304 + 64 * (j))
#define XB_TOP      3328
#define XB_TOPGEN   3392
#define XCD_BAR_WORDS 3456
#define XB_SPIN_CAP (1u << 21)

__device__ __forceinline__ unsigned xb_ld(unsigned* p)              { return __hip_atomic_load(p, __ATOMIC_RELAXED, __HIP_MEMORY_SCOPE_AGENT); }
__device__ __forceinline__ unsigned xb_add(unsigned* p, unsigned v) { return __hip_atomic_fetch_add(p, v, __ATOMIC_RELAXED, __HIP_MEMORY_SCOPE_AGENT); }
__device__ __forceinline__ unsigned xb_xcc_id() { return (unsigned)__builtin_amdgcn_s_getreg((3 << 11) | 20) & 0xFu; }
#define XB_SPIN(cond, bar) do { unsigned _sp = 0; while (cond) { __builtin_amdgcn_s_sleep(1); \
    if ((++_sp & 255u) == 0u) { if (xb_ld(&(bar)[XB_TMO])) break; if (_sp > XB_SPIN_CAP) { atomicAdd(&(bar)[XB_TMO], 1u); break; } } } } while (0)

struct XcdBarrier {
    unsigned* bar; unsigned x;
    volatile LAS unsigned* st;
};

__device__ __forceinline__ XcdBarrier xcd_barrier_post(unsigned* bar, volatile LAS unsigned* st, bool leader) {
    XcdBarrier b; b.bar = bar; b.x = xb_xcc_id(); b.st = st;
    if (leader) (void)xb_add(&bar[XB_XCNT(b.x)], 1u);
    return b;
}
__device__ __forceinline__ void xcd_barrier_complete(unsigned* bar, unsigned x, unsigned& nloc, unsigned& nx) {
    const unsigned G = gridDim.x * gridDim.y * gridDim.z;
    unsigned sum, cnt, mine, sp = 0u;
    for (;;) {
        sum = 0u; cnt = 0u; mine = 0u;
#pragma unroll
        for (unsigned j = 0; j < 16; ++j) { const unsigned c = xb_ld(&bar[XB_XCNT(j)]); sum += c; cnt += (c > 0u) ? 1u : 0u; mine = (j == x) ? c : mine; }
        if (sum == G) break;
        __builtin_amdgcn_s_sleep(1);
        if ((++sp & 255u) == 0u) { if (xb_ld(&bar[XB_TMO])) break; if (sp > XB_SPIN_CAP) { atomicAdd(&bar[XB_TMO], 1u); break; } }
    }
    nloc = mine > 0u ? mine : 1u; nx = cnt > 0u ? cnt : 1u;
}

__device__ __forceinline__ void xcd_barrier(const XcdBarrier& b, bool leader) {
    asm volatile("s_waitcnt vmcnt(0)" ::: "memory");
    __syncthreads();
    if (leader) {
        unsigned* bar = b.bar;
        __builtin_amdgcn_s_waitcnt(0);
        unsigned nloc = b.st[0], nx = b.st[1];
        if (nloc == 0u) { xcd_barrier_complete(bar, b.x, nloc, nx); b.st[0] = nloc; b.st[1] = nx; }
        const unsigned old = xb_add(&bar[XB_XSUB(b.x)], 1u);
        const unsigned gen = old / nloc;
        if (old + 1u == (gen + 1u) * nloc) {
            __builtin_amdgcn_fence(__ATOMIC_RELEASE, "agent");
            asm volatile("s_waitcnt vmcnt(0)" ::: "memory");
            const unsigned og = xb_add(&bar[XB_TOP], 1u);
            const unsigned tg = og / nx;
            if (og + 1u == (tg + 1u) * nx) xb_add(&bar[XB_TOPGEN], 1u);
            else XB_SPIN(xb_ld(&bar[XB_TOPGEN]) == tg, bar);
            __builtin_amdgcn_fence(__ATOMIC_ACQUIRE, "agent");
            xb_add(&bar[XB_XGEN(b.x)], 1u);
            asm volatile("s_waitcnt vmcnt(0)" ::: "memory");
        } else {
            XB_SPIN(xb_ld(&bar[XB_XGEN(b.x)]) == gen, bar);
            __builtin_amdgcn_fence(__ATOMIC_ACQUIRE, "agent");
            asm volatile("s_waitcnt vmcnt(0)" ::: "memory");
        }
    }
    __syncthreads();
}

#undef LAS
}
namespace mk {
typedef unsigned short bf16;
typedef unsigned v4u __attribute__((ext_vector_type(4)));
typedef float f32x4 __attribute__((ext_vector_type(4)));
#define MK_LAS __attribute__((address_space(3)))
using namespace mkc;
constexpr int NWAVES = 8;
constexpr int RING_BYTES = 131072, LDS_EXTRA = RING_BYTES, LDS_MISC = RING_BYTES + 8192, LDS_BYTES = 147456;
constexpr size_t WS_BAR = 4096, BAR_BYTES = 16384;

struct Args { const float* in[18]; float* out; unsigned char* ws; int ph_lo, ph_hi; };
struct Frame { MK_LAS unsigned char* lds; int tid, lane, wave, vcu, G; };
typedef const __attribute__((address_space(4))) Args* kargs_t;
__device__ __forceinline__ kargs_t kargs() { kargs_t p = (kargs_t)__builtin_amdgcn_kernarg_segment_ptr(); asm volatile("" : "+s"(p)); return p; }
__device__ __forceinline__ Frame mkframe(MK_LAS unsigned char* lds, int wave) { Frame F; F.lds = lds; F.wave = wave; F.lane = pg8::lane_id_v(); F.tid = wave * 64 + F.lane; F.G = gridDim.x;
    { const int bx = blockIdx.x; F.vcu = (F.G % 8 == 0) ? (bx % 8) * (F.G / 8) + bx / 8 : bx; } return F; }

__device__ __forceinline__ unsigned f2bf(float f) { unsigned u = __builtin_bit_cast(unsigned, f); return (u + 0x7fffu + ((u >> 16) & 1u)) >> 16; }
__device__ __forceinline__ unsigned pk2(float lo, float hi) { return f2bf(lo) | (f2bf(hi) << 16); }
__device__ __forceinline__ float bf2f(unsigned short b) { return __builtin_bit_cast(float, (unsigned)b << 16); }
__device__ __forceinline__ float wave_sum(float v) {
#pragma unroll
    for (int o = 1; o < 64; o <<= 1) v += __shfl_xor(v, o);
    return v;
}
__constant__ float ROPE_INV[16] = {1.000000000e+00f, 5.623413324e-01f, 3.162277639e-01f, 1.778279394e-01f, 1.000000015e-01f, 5.623413250e-02f, 3.162277490e-02f, 1.778279431e-02f,
                                   9.999999776e-03f, 5.623413250e-03f, 3.162277630e-03f, 1.778279431e-03f, 1.000000047e-03f, 5.623413017e-04f, 3.162277571e-04f, 1.778279402e-04f};
__device__ __forceinline__ int rope_phys(int L) { return L < 16 ? 8 * (L >> 2) + (L & 3) : 8 * ((L - 16) >> 2) + 4 + ((L - 16) & 3); }

__device__ __forceinline__ void p0_item(const float* W, int K, int N, bf16* WT, const float* gain, int kind, MK_LAS float* scr, int item, int lane) {
    const int nblk = N / 32, kb = item / nblk, nb = item % nblk, k0 = 64 * kb, n0 = 32 * nb;
    int dbase = n0; bool perm = false; float mul = 1.0f;
    if (kind == 1) dbase = (n0 >> 7) * 256 + (n0 & 127);
    else if (kind == 2) dbase = (n0 >> 7) * 256 + 128 + (n0 & 127);
    else if (kind == 3) { if (n0 == 640) perm = true; else if (n0 >= 672) { dbase = n0 + 96; if (n0 < 1184) mul = C2M; } }
    else if (kind == 4) { perm = (n0 % 96) == 64; mul = C2Q; }
    else if (kind == 5) { const int h = n0 >> 7, e = n0 & 127; dbase = e < 64 ? h * 64 + e : 512 + h * 64 + (e - 64); }
#pragma unroll 8
    for (int i = 0; i < 32; ++i) { const int kk = 2 * i + (lane >> 5); const float g = gain ? gain[k0 + kk] * mul : mul; scr[kk * 33 + (lane & 31)] = W[(size_t)(k0 + kk) * N + n0 + (lane & 31)] * g; }
    asm volatile("s_waitcnt lgkmcnt(0)" ::: "memory");
    const int c = lane & 7;
#pragma unroll
    for (int j = 0; j < 4; ++j) { const int n = (lane >> 3) + 8 * j; const MK_LAS float* s = scr + (8 * c) * 33 + n;
        v4u o; o.x = pk2(s[0 * 33], s[1 * 33]); o.y = pk2(s[2 * 33], s[3 * 33]); o.z = pk2(s[4 * 33], s[5 * 33]); o.w = pk2(s[6 * 33], s[7 * 33]);
        const int drow = dbase + (perm ? rope_phys(n) : n);
        *(v4u*)(WT + (size_t)drow * K + k0 + 8 * c) = o; }
    asm volatile("s_waitcnt lgkmcnt(0)" ::: "memory");
}
__device__ __forceinline__ void p0_prologue(const Frame& F, kargs_t ap) {
    unsigned char* ws = ap->ws;
    MK_LAS float* scr = (MK_LAS float*)(F.lds + F.wave * 16384);
    const int gw = F.vcu * NWAVES + F.wave, NGW = F.G * NWAVES;
    constexpr int I_G = (DM / 64) * (DFF / 32), I_D = (DFF / 64) * (DM / 32), I_IN = (DM / 64) * (2208 / 32), I_UQ = (384 / 64) * (768 / 32), I_UKV = (256 / 64) * (1024 / 32), I_O = (DM / 64) * (DM / 32);
    constexpr int NITEMS = 4 * I_G + 2 * I_D + I_IN + I_UQ + I_UKV + I_O;
    for (int it = gw; it < NITEMS; it += NGW) {
        int r = it;
        if (r < I_G) { p0_item(ap->in[3], DM, DFF, (bf16*)(ws + WS_WGU1), ap->in[2], 1, scr, r, F.lane); continue; } r -= I_G;
        if (r < I_G) { p0_item(ap->in[4], DM, DFF, (bf16*)(ws + WS_WGU1), ap->in[2], 2, scr, r, F.lane); continue; } r -= I_G;
        if (r < I_D) { p0_item(ap->in[5], DFF, DM, (bf16*)(ws + WS_WD1), nullptr, 0, scr, r, F.lane); continue; } r -= I_D;
        if (r < I_G) { p0_item(ap->in[14], DM, DFF, (bf16*)(ws + WS_WGU2), ap->in[13], 1, scr, r, F.lane); continue; } r -= I_G;
        if (r < I_G) { p0_item(ap->in[15], DM, DFF, (bf16*)(ws + WS_WGU2), ap->in[13], 2, scr, r, F.lane); continue; } r -= I_G;
        if (r < I_D) { p0_item(ap->in[16], DFF, DM, (bf16*)(ws + WS_WD2), nullptr, 0, scr, r, F.lane); continue; } r -= I_D;
        if (r < I_IN) { p0_item(ap->in[7], DM, 2208, (bf16*)(ws + WS_WIN), ap->in[6], 3, scr, r, F.lane); continue; } r -= I_IN;
        if (r < I_UQ) { p0_item(ap->in[9], 384, 768, (bf16*)(ws + WS_WUQ), ap->in[8], 4, scr, r, F.lane); continue; } r -= I_UQ;
        if (r < I_UKV) { p0_item(ap->in[11], 256, 1024, (bf16*)(ws + WS_WUKV), ap->in[10], 5, scr, r, F.lane); continue; } r -= I_UKV;
        p0_item(ap->in[12], DM, DM, (bf16*)(ws + WS_WOUT), nullptr, 0, scr, r, F.lane);
    }
    const float* x = ap->in[0]; bf16* xb = (bf16*)(ws + WS_XB); float* ss1 = (float*)(ws + WS_SS1);
    for (int m = gw; m < S; m += NGW) {
        const f32x4* xr = (const f32x4*)(x + (size_t)m * DM) + F.lane; unsigned long long* o8 = (unsigned long long*)(xb + (size_t)m * DM) + F.lane; float s = 0.f;
#pragma unroll
        for (int j = 0; j < 4; ++j) { const f32x4 v = xr[64 * j]; s += (v[0] * v[0] + v[1] * v[1]) + (v[2] * v[2] + v[3] * v[3]); o8[64 * j] = (unsigned long long)pk2(v[0], v[1]) | ((unsigned long long)pk2(v[2], v[3]) << 32); }
        s = wave_sum(s); if (F.lane == 0) ss1[m] = s;
    }
    const int* pos = (const int*)ap->in[1]; float* posf = (float*)(ws + WS_POSF); float* cosT = (float*)(ws + WS_COS); float* sinT = (float*)(ws + WS_SIN);
    const int gt = (F.vcu * NWAVES + F.wave) * 64 + F.lane, NGT = NGW * 64;
    for (int e = gt; e < S * 16; e += NGT) { const int s_ = e >> 4, i = e & 15; const float ang = (float)pos[s_] * ROPE_INV[i]; float sn, cs; sincosf(ang, &sn, &cs); cosT[e] = cs; sinT[e] = sn; if (i == 0) posf[s_] = (float)pos[s_]; }
    float* z = (float*)(ws + WS_SS2);
    for (int e = gt; e < 5 * S; e += NGT) z[e] = 0.f;
    float* km = (float*)(ws + WS_KMS);
    for (int e = gt; e < 64 * 512; e += NGT) km[e] = 0.f;
    unsigned* cnt = (unsigned*)(ws + WS_CNT);
    for (int e = gt; e < 512; e += NGT) cnt[e] = 0u;
    unsigned* padz = (unsigned*)((bf16*)(ws + WS_WIN) + (size_t)672 * DM);
    for (int e = gt; e < 96 * DM / 2; e += NGT) padz[e] = 0u;
}

__device__ __forceinline__ void p4_krope(const Frame& F, kargs_t ap) { unsigned char* const wsb = ap->ws;
    const bf16* cqkv = (const bf16*)(wsb + WS_CQKV); bf16* Kr = (bf16*)(wsb + WS_KR); const float* cosT = (const float*)(wsb + WS_COS); const float* sinT = (const float*)(wsb + WS_SIN);
    const int gt = (F.vcu * NWAVES + F.wave) * 64 + F.lane, NGT = F.G * NWAVES * 64;
    for (int e = gt; e < S * 16; e += NGT) { const int s_ = e >> 4, i = e & 15, g = i >> 2, j = i & 3;
        const float x1 = bf2f(cqkv[(size_t)s_ * 768 + 640 + 8 * g + j]), x2 = bf2f(cqkv[(size_t)s_ * 768 + 640 + 8 * g + 4 + j]); const float c = cosT[e], sn = sinT[e];
        Kr[(size_t)s_ * 32 + 8 * g + j] = (bf16)f2bf(x1 * c - x2 * sn); Kr[(size_t)s_ * 32 + 8 * g + 4 + j] = (bf16)f2bf(x1 * sn + x2 * c); }
}
__device__ __forceinline__ void p4_gating(const Frame& F, kargs_t ap) { unsigned char* const wsb = ap->ws;
    const bf16* mqkv = (const bf16*)(wsb + WS_MQKV); const float* kms = (const float*)(wsb + WS_KMS); unsigned* cnt = (unsigned*)(wsb + WS_CNT); unsigned short* lists = (unsigned short*)(wsb + WS_LIST);
    MK_LAS float* km = (MK_LAS float*)F.lds;
    for (int u = F.vcu; u < 256; u += F.G) {
        const int h = u & 7, q = (u >> 3) * 512 + F.tid, own = q >> 8;
        __syncthreads();
        for (int e = F.tid; e < 4096; e += 512) km[e] = kms[(size_t)(e >> 6) * 512 + h * 64 + (e & 63)] * (1.0f / 256.0f);
        __syncthreads();
        float qv[64];
        { const v4u* qp = (const v4u*)(mqkv + (size_t)q * 1536 + h * 64);
#pragma unroll
          for (int c = 0; c < 8; ++c) { const v4u w = qp[c];
#pragma unroll
              for (int j = 0; j < 4; ++j) { qv[8 * c + 2 * j] = __builtin_bit_cast(float, w[j] << 16); qv[8 * c + 2 * j + 1] = __builtin_bit_cast(float, w[j] & 0xFFFF0000u); } } }
        float g0 = -3e38f, g1 = -3e38f, g2 = -3e38f; int i0 = -1, i1 = -1, i2 = -1;
        const int own_max = __builtin_amdgcn_readfirstlane(own);
        for (int n = 0; n < own_max; ++n) {
            float g = 0.f;
#pragma unroll
            for (int c = 0; c < 16; ++c) { const f32x4 kk = *(const MK_LAS f32x4*)(km + n * 64 + 4 * c); g = fmaf(qv[4 * c], kk[0], g); g = fmaf(qv[4 * c + 1], kk[1], g); g = fmaf(qv[4 * c + 2], kk[2], g); g = fmaf(qv[4 * c + 3], kk[3], g); }
            if (g > g0) { g2 = g1; i2 = i1; g1 = g0; i1 = i0; g0 = g; i0 = n; }
            else if (g > g1) { g2 = g1; i2 = i1; g1 = g; i1 = n; }
            else if (g > g2) { g2 = g; i2 = n; }
        }
#pragma unroll
        for (int k = 0; k < 3; ++k) { const int n = k == 0 ? i0 : k == 1 ? i1 : i2;
            if (n >= 0) { const unsigned p = atomicAdd(cnt + h * 64 + n, 1u); lists[(size_t)(h * 64 + n) * S + p] = (unsigned short)(q | (k << 14)); } }
    }
    __syncthreads();
}
__device__ __forceinline__ void p5_combine(const Frame& F, kargs_t ap) { unsigned char* const wsb = ap->ws;
    const bf16* part = (const bf16*)(wsb + WS_PART); const float* plse = (const float*)(wsb + WS_PLSE); bf16* cat = (bf16*)(wsb + WS_CAT);
    const int gt = (F.vcu * NWAVES + F.wave) * 64 + F.lane, NGT = F.G * NWAVES * 64;
    for (int e = gt; e < S * 8 * 8; e += NGT) { const int dg = e & 7, qh = e >> 3, q = qh >> 3, h = qh & 7; const int ns = 1 + min(3, q >> 8);
        const f32x4 ls = *(const f32x4*)(plse + (size_t)qh * 4);
        float M = ls[0]; for (int s = 1; s < 4; ++s) if (s < ns) M = fmaxf(M, ls[s]);
        float acc[8], wsum = 0.f;
#pragma unroll
        for (int j = 0; j < 8; ++j) acc[j] = 0.f;
#pragma unroll
        for (int s = 0; s < 4; ++s) if (s < ns) { const float w = __builtin_amdgcn_exp2f(ls[s] - M); wsum += w; const v4u v = *(const v4u*)(part + ((size_t)qh * 4 + s) * 64 + dg * 8);
#pragma unroll
            for (int j = 0; j < 4; ++j) { acc[2 * j] += w * __builtin_bit_cast(float, v[j] << 16); acc[2 * j + 1] += w * __builtin_bit_cast(float, v[j] & 0xFFFF0000u); } }
        const float r = 1.0f / wsum; v4u o; o.x = pk2(acc[0] * r, acc[1] * r); o.y = pk2(acc[2] * r, acc[3] * r); o.z = pk2(acc[4] * r, acc[5] * r); o.w = pk2(acc[6] * r, acc[7] * r);
        *(v4u*)(cat + (size_t)q * 1024 + 512 + h * 64 + dg * 8) = o; }
}
__device__ __forceinline__ void p9_final(const Frame& F, kargs_t ap) { unsigned char* const wsb = ap->ws;
    const float* ss = (const float*)(wsb + WS_SS4); const float* g = ap->in[17];
    const int gw = F.vcu * NWAVES + F.wave, NGW = F.G * NWAVES;
    for (int m = gw; m < S; m += NGW) { const float rs = 1.0f / sqrtf(ss[m] * (1.0f / 1024.0f) + 1e-6f); f32x4* xr = (f32x4*)(ap->out + (size_t)m * DM) + F.lane; const f32x4* gr = (const f32x4*)g + F.lane;
#pragma unroll
        for (int j = 0; j < 4; ++j) { const f32x4 v = xr[64 * j]; xr[64 * j] = v * rs * gr[64 * j]; } }
}

__global__ void __launch_bounds__(NWAVES * 64, 2) mk_fwd(Args a_unused) {
    extern __shared__ __attribute__((aligned(16))) unsigned char lds[];
    const int wave = __builtin_amdgcn_readfirstlane(threadIdx.x >> 6);
    MK_LAS unsigned char* const ldsp = (MK_LAS unsigned char*)lds;
    int lo, hi; { kargs_t ap = kargs(); lo = ap->ph_lo; hi = ap->ph_hi; }
#ifndef MK_ONLY
#define MK_ONLY -1
#endif
#define IN(k) ((MK_ONLY < 0 || MK_ONLY == (k)) && lo <= (k) && (k) < hi)
    const bool multi = (hi - lo) > 1;
    if (multi) {
        const int l0 = pg8::lane_id_v();
        if (wave == 0 && l0 < 2) ((volatile MK_LAS unsigned*)(ldsp + LDS_MISC))[l0] = 0u;
        __syncthreads();
        kargs_t ap = kargs(); (void)xb::xcd_barrier_post((unsigned*)(ap->ws + WS_BAR), (volatile MK_LAS unsigned*)(ldsp + LDS_MISC), wave == 0 && l0 == 0);
    }
    if (lo < -1) cg::this_grid().sync();
#define SEAM(k) do { if (IN(k) && IN((k) + 1)) { kargs_t ap_ = kargs(); xb::XcdBarrier b_; b_.bar = (unsigned*)(ap_->ws + WS_BAR); b_.x = xb::xb_xcc_id(); b_.st = (volatile MK_LAS unsigned*)(ldsp + LDS_MISC); \
        xb::xcd_barrier(b_, wave == 0 && pg8::lane_id_v() == 0); } } while (0)
    if (IN(0)) { kargs_t ap = kargs(); const Frame F = mkframe(ldsp, wave); p0_prologue(F, ap); } SEAM(0);
    if (IN(1)) { kargs_t ap = kargs(); unsigned char* ws = ap->ws; pg8::Gemm g{(const bf16*)(ws + WS_XB), (const bf16*)(ws + WS_WGU1), S, NGU, DM, DM}; pg8::StaticOrder So; So.init(S, NGU, (int)gridDim.x, (int)blockIdx.x);
        pg8::EpiSwiGLU E{ws, 0}; pg8::gemm_phase<pg8::EpiSwiGLU, pg8::StaticOrder, true, true>(ldsp, g, So, E, wave); } SEAM(1);
    if (IN(2)) { kargs_t ap = kargs(); unsigned char* ws = ap->ws; pg8::Gemm g{(const bf16*)(ws + WS_ACT), (const bf16*)(ws + WS_WD1), S, DM, DFF, DFF}; pg8::StaticOrder So; So.init(S, DM, (int)gridDim.x, (int)blockIdx.x);
        pg8::EpiResid E{ap->in[0], ap->out, ws, (int)WS_SS2, 1, 0.5f}; pg8::gemm_phase<pg8::EpiResid, pg8::StaticOrder, true, true>(ldsp, g, So, E, wave); } SEAM(2);
    if (IN(3)) { kargs_t ap = kargs(); unsigned char* ws = ap->ws; pg8::Gemm g{(const bf16*)(ws + WS_XB), (const bf16*)(ws + WS_WIN), S, NWIN, DM, DM}; pg8::StaticOrder So; So.init(S, NWIN, (int)gridDim.x, (int)blockIdx.x);
        pg8::EpiWin E{ws}; pg8::gemm_phase<pg8::EpiWin, pg8::StaticOrder, true, true>(ldsp, g, So, E, wave); } SEAM(3);
    if (IN(4)) {
        { kargs_t ap = kargs(); unsigned char* ws = ap->ws; pg8::Gemm g{(const bf16*)(ws + WS_CQKV) + 384, (const bf16*)(ws + WS_WUKV), S, 1024, 256, 768}; pg8::StaticOrder So; So.init(S, 1024, (int)gridDim.x, (int)blockIdx.x);
          pg8::EpiKV E{ws}; pg8::gemm_phase<pg8::EpiKV, pg8::StaticOrder, true, true>(ldsp, g, So, E, wave); }
        { kargs_t ap = kargs(); unsigned char* ws = ap->ws; pg8::Gemm g{(const bf16*)(ws + WS_CQKV), (const bf16*)(ws + WS_WUQ), S, 768, 384, 768}; pg8::StaticOrder So; So.init(S, 768, (int)gridDim.x, (int)blockIdx.x);
          pg8::EpiQ E{ws}; pg8::gemm_phase<pg8::EpiQ, pg8::StaticOrder, true, true>(ldsp, g, So, E, wave); }
        { kargs_t ap = kargs(); const Frame F = mkframe(ldsp, wave); p4_krope(F, ap); }
#ifndef MK_NO_GATE
        { kargs_t ap = kargs(); const Frame F = mkframe(ldsp, wave); p4_gating(F, ap); }
#endif
    } SEAM(4);
#ifndef MK_NO_ATT5
    if (IN(5)) {
        kargs_t ap = kargs(); unsigned char* ws = ap->ws; const Frame F = mkframe(ldsp, wave);
        const bf16* mqkv = (const bf16*)(ws + WS_MQKV); const float* posf = (const float*)(ws + WS_POSF);
        att::Unit U; U.Kr = nullptr; U.posf = posf; U.part = (bf16*)(ws + WS_PART); U.plse = (float*)(ws + WS_PLSE); U.O = nullptr; U.o_pitch = 0; U.q_pitch = 1536; U.k_pitch = 1536; U.v_pitch = 1536; U.ntiles = 4;
        for (int u = F.vcu; u < 512; u += F.G) { const int h = u & 7, n = u >> 3;
            U.h = h; U.Q = mqkv + h * 64; U.K = mqkv + 512 + h * 64; U.V = mqkv + 1024 + h * 64; U.key0 = n * 256; U.q0 = n * 256; U.list = nullptr; U.len = 0; U.slope2 = exp2f(-(float)(h + 1)) * LOG2E;
            att::unit<1>(U, (char*)lds, wave); }
        MK_LAS int* pre = (MK_LAS int*)(ldsp + LDS_EXTRA);
        const unsigned* cnt = (const unsigned*)(ws + WS_CNT);
        __syncthreads();
        { const int c = (int)cnt[F.tid]; pre[F.tid] = (c + 255) >> 8; }
        __syncthreads();
        for (int o = 1; o < 512; o <<= 1) { const int v = pre[F.tid] + (F.tid >= o ? pre[F.tid - o] : 0); __syncthreads(); pre[F.tid] = v; __syncthreads(); }
        const int total = pre[511];
        for (int gI = F.vcu; gI < total; gI += F.G) {
            int lo_ = 0, hi_ = 511;
            while (lo_ < hi_) { const int mid = (lo_ + hi_) >> 1; if (pre[mid] > gI) hi_ = mid; else lo_ = mid + 1; }
            const int hn = __builtin_amdgcn_readfirstlane(lo_), c = gI - (hn ? pre[hn - 1] : 0), h = hn >> 6, n = hn & 63; const int len = (int)cnt[hn] - c * 256;
            U.h = h; U.Q = mqkv + h * 64; U.K = mqkv + 512 + h * 64; U.V = mqkv + 1024 + h * 64; U.key0 = n * 256; U.q0 = 0; U.list = (const unsigned short*)(ws + WS_LIST) + (size_t)hn * S + c * 256; U.len = len < 256 ? len : 256;
            U.slope2 = exp2f(-(float)(h + 1)) * LOG2E;
            att::unit<2>(U, (char*)lds, wave); }
    }
#endif
    SEAM(5);
    if (IN(6)) {
        { kargs_t ap = kargs(); const Frame F = mkframe(ldsp, wave); p5_combine(F, ap); }
#ifndef MK_NO_ATT6
        kargs_t ap = kargs(); unsigned char* ws = ap->ws; const Frame F = mkframe(ldsp, wave);
        att::Unit U; U.posf = nullptr; U.part = nullptr; U.plse = nullptr; U.list = nullptr; U.len = 0; U.slope2 = 0.f; U.q_pitch = 768; U.k_pitch = 512; U.v_pitch = 512; U.o_pitch = 1024; U.key0 = 0; U.Kr = (const bf16*)(ws + WS_KR);
        for (int v = F.vcu; v < 256; v += F.G) { const int h = v >> 5, s_ = v & 31;
            for (int i = 0; i < 2; ++i) { const int qb = i == 0 ? 63 - s_ : s_;
                U.h = h; U.Q = (const bf16*)(ws + WS_Q) + h * 96; U.K = (const bf16*)(ws + WS_KN) + h * 64; U.V = (const bf16*)(ws + WS_V) + h * 64; U.O = (bf16*)(ws + WS_CAT) + h * 64; U.q0 = qb * 256; U.ntiles = 4 * (qb + 1);
                att::unit<0>(U, (char*)lds, wave); } }
#endif
    } SEAM(6);
    if (IN(7)) { kargs_t ap = kargs(); unsigned char* ws = ap->ws; pg8::Gemm g{(const bf16*)(ws + WS_CAT), (const bf16*)(ws + WS_WOUT), S, DM, DM, DM}; pg8::StaticOrder So; So.init(S, DM, (int)gridDim.x, (int)blockIdx.x);
        pg8::EpiResid E{ap->out, ap->out, ws, (int)WS_SS3, 1, 1.0f}; pg8::gemm_phase<pg8::EpiResid, pg8::StaticOrder, true, true>(ldsp, g, So, E, wave); } SEAM(7);
    if (IN(8)) { kargs_t ap = kargs(); unsigned char* ws = ap->ws; pg8::Gemm g{(const bf16*)(ws + WS_XB), (const bf16*)(ws + WS_WGU2), S, NGU, DM, DM}; pg8::StaticOrder So; So.init(S, NGU, (int)gridDim.x, (int)blockIdx.x);
        pg8::EpiSwiGLU E{ws, 1}; pg8::gemm_phase<pg8::EpiSwiGLU, pg8::StaticOrder, true, true>(ldsp, g, So, E, wave); } SEAM(8);
    if (IN(9)) { kargs_t ap = kargs(); unsigned char* ws = ap->ws; pg8::Gemm g{(const bf16*)(ws + WS_ACT), (const bf16*)(ws + WS_WD2), S, DM, DFF, DFF}; pg8::StaticOrder So; So.init(S, DM, (int)gridDim.x, (int)blockIdx.x);
        pg8::EpiResid E{ap->out, ap->out, ws, (int)WS_SS4, 0, 0.5f}; pg8::gemm_phase<pg8::EpiResid, pg8::StaticOrder, true, true>(ldsp, g, So, E, wave); } SEAM(9);
    if (IN(10)) { kargs_t ap = kargs(); const Frame F = mkframe(ldsp, wave); p9_final(F, ap); }
#undef IN
#undef SEAM
}
constexpr int N_PHASES = 11;
}
#ifndef MK_BRINGUP
#define MK_BRINGUP 0
#endif
extern "C" void kernel_launch(void* const* d_in, const int* in_sizes, int n_in, void* d_out, int out_size, void* d_ws, size_t ws_size, hipStream_t stream) {
    static int grid = 0;
    if (grid == 0) {
        if (hipFuncSetAttribute((const void*)mk::mk_fwd, hipFuncAttributeMaxDynamicSharedMemorySize, mk::LDS_BYTES) != hipSuccess) { fprintf(stderr, "kernel_launch: hipFuncSetAttribute failed\n"); grid = -1; return; }
        int dev = 0, cus = 0, per_cu = 0;
        hipGetDevice(&dev); hipDeviceGetAttribute(&cus, hipDeviceAttributeMultiprocessorCount, dev);
        hipOccupancyMaxActiveBlocksPerMultiprocessor(&per_cu, (const void*)mk::mk_fwd, mk::NWAVES * 64, mk::LDS_BYTES);
        (void)hipGetLastError();
        grid = cus * (per_cu < 1 ? 1 : (per_cu > 1 ? 1 : per_cu));
        if (grid % 8 != 0 || grid <= 0) grid = 256;
        if (ws_size < mk::WS_END) { fprintf(stderr, "kernel_launch: workspace too small (%zu)\n", ws_size); grid = -1; return; }
    }
    if (grid < 0) return;
    mk::Args a{};
    for (int i = 0; i < 18; ++i) a.in[i] = (const float*)d_in[i];
    a.out = (float*)d_out; a.ws = (unsigned char*)d_ws;
#if MK_BRINGUP == 0
    if (hipMemsetAsync((char*)d_ws + mk::WS_BAR, 0, mk::BAR_BYTES, stream) != hipSuccess) { fprintf(stderr, "kernel_launch: memset failed\n"); return; }
    a.ph_lo = 0; a.ph_hi = mk::N_PHASES;
    void* args[] = {&a};
    hipError_t e = hipLaunchCooperativeKernel((const void*)mk::mk_fwd, dim3(grid), dim3(mk::NWAVES * 64), args, mk::LDS_BYTES, stream);
    if (e != hipSuccess) fprintf(stderr, "cooperative launch failed: %s (grid %d)\n", hipGetErrorString(e), grid);
#else
    const int nph = MK_BRINGUP == 1 ? 3 : MK_BRINGUP == 2 ? 8 : mk::N_PHASES;
    for (int ph = 0; ph < nph; ++ph) { a.ph_lo = ph; a.ph_hi = ph + 1; hipLaunchKernelGGL(mk::mk_fwd, dim3(grid), dim3(mk::NWAVES * 64), mk::LDS_BYTES, stream, a); }
#if MK_BRINGUP == 1
    nv::part_mix(d_in, (float*)d_out, d_ws, stream); nv::part_ffn2_final(d_in, (float*)d_out, d_ws, stream);
#elif MK_BRINGUP == 2
    nv::part_ffn2_final(d_in, (float*)d_out, d_ws, stream);
#endif
#endif
}
```

```cpp
#define MK_BRINGUP 0
#include <hip/hip_runtime.h>
#include <cstdio>
#include <cstdint>
#include <cmath>
#include <hip/hip_cooperative_groups.h>
namespace cg = cooperative_groups;

namespace mkc {
constexpr int S = 16384, DM = 1024, DFF = 2816, NGU = 2 * DFF, NWIN = 2304;
constexpr float LOG2E = 1.4426950408889634f;
constexpr float C2Q = 0.10206207261596577f * LOG2E;
constexpr float C2M = 0.125f * LOG2E;
constexpr size_t MiB = 1u << 20;
constexpr size_t WS_PANEL = 4096 + 16384;
constexpr size_t WS_CNT = 0;
constexpr size_t WS_SS1 = 1 * MiB, WS_SS2 = WS_SS1 + 65536, WS_SSQ = WS_SS2 + 65536, WS_SSKV = WS_SSQ + 65536, WS_SS3 = WS_SSKV + 65536, WS_SS4 = WS_SS3 + 65536;
constexpr size_t WS_KMS = WS_SS1 + 512 * 1024;
constexpr size_t WS_SSDUMMY = WS_SS1 + 384 * 1024, WS_KMSDUMMY = WS_SS1 + 640 * 1024;
constexpr size_t WS_POSF = 2 * MiB, WS_COS = 3 * MiB, WS_SIN = 4 * MiB;
constexpr size_t WS_WGU1 = 6 * MiB, WS_WD1 = 17 * MiB, WS_WGU2 = WS_WD1 + 5632 * 1024, WS_WD2 = WS_WGU2 + 11 * MiB, WS_WIN = 39 * MiB, WS_WUQ = WS_WIN + 4608 * 1024, WS_WUKV = WS_WUQ + 768 * 1024, WS_WOUT = 45 * MiB;
constexpr size_t WS_XB = 48 * MiB, WS_CQKV = 80 * MiB, WS_PLSE = 112 * MiB;
constexpr size_t WS_ACT = 114 * MiB, WS_MQKV = 114 * MiB, WS_CAT = 114 * MiB, WS_Q = 162 * MiB, WS_KN = 186 * MiB, WS_V = 202 * MiB, WS_KR = 218 * MiB, WS_LIST = 220 * MiB, WS_END = 252 * MiB;
static_assert(WS_WD2 + 5632 * 1024 <= WS_WIN && WS_WUKV + 512 * 1024 <= WS_WOUT && WS_WOUT + 2 * MiB <= WS_XB, "weight map");
}
namespace pg8 {
#define PG8_LAS __attribute__((address_space(3)))
typedef unsigned short bf16_t;
typedef short bf16x8 __attribute__((ext_vector_type(8)));
typedef float f32x4 __attribute__((ext_vector_type(4)));
typedef unsigned u32x4 __attribute__((ext_vector_type(4)));
__device__ __forceinline__ int lane_id_v() { int l; asm volatile("v_mbcnt_lo_u32_b32 %0, -1, 0\n\tv_mbcnt_hi_u32_b32 %0, -1, %0" : "=v"(l)); return l; }
constexpr int BM = 256, BK = 64, HALF = 128, HTB = HALF * BK * 2  , STAGE_BYTES = 8 * HTB, NXCD = 8, WGM = 4;

__host__ __device__ __forceinline__ int lds_byte(int r, int c) { const int st = (r >> 4) * 2 + (c >> 5), rr = r & 15, cc = c & 31, ob = rr * 64 + cc * 2; return st * 1024 + (ob ^ (((ob >> 9) & 1) << 5)); }
__host__ __device__ __forceinline__ void stage_rc(int b, int& R, int& C) { const int st = b / 1024, sb = b % 1024, swz = sb ^ (((sb >> 9) & 1) << 5); R = (st >> 1) * 16 + swz / 64; C = (st & 1) * 32 + (swz % 64) / 2; }
__host__ __device__ __forceinline__ int perm32(int rho) { const int n = rho >> 4, i = rho & 15; return 8 * (i >> 2) + 4 * n + (i & 3); }

struct Unit { int pm, pn; };
struct Gemm { const bf16_t* A; const bf16_t* Bt; int M, N, K, lda; };

struct StaticOrder {
    int nM, nN, nwg, G, c;
    __host__ __device__ void init(int M, int N, int G_, int c_) { nM = M / BM; nN = N / BM; nwg = nM * nN; G = G_; c = c_; }
    __host__ __device__ bool next(int i, Unit& u) const {
        const long L = (long)i * G + c; if (L >= nwg) return false;
        int wgid = (int)L; { const int q = nwg / NXCD, r = nwg % NXCD, xcd = wgid % NXCD, off = wgid / NXCD; wgid = (xcd < r ? xcd * (q + 1) : r * (q + 1) + (xcd - r) * q) + off; }
        const int nig = WGM * nN, gid = wgid / nig, fm = gid * WGM, gsz = (nM - fm) < WGM ? (nM - fm) : WGM;
        u.pm = fm + ((wgid % nig) % gsz); u.pn = (wgid % nig) / gsz; return true;
    }
    __device__ __forceinline__ void a_ready(const Unit&) const {}
    __device__ __forceinline__ void done(const Unit&) const {}
};
struct TailOrder {
    int nM, pn, G, c;
    __host__ __device__ void init(int M, int pn_, int G_, int c_) { nM = M / BM; pn = pn_; G = G_; c = c_; }
    __host__ __device__ bool next(int i, Unit& u) const { const int j = c - (G - nM); if (i != 0 || j < 0 || j >= nM) return false; u.pm = j; u.pn = pn; return true; }
    __device__ __forceinline__ void a_ready(const Unit&) const {}
    __device__ __forceinline__ void done(const Unit&) const {}
};
__device__ __forceinline__ unsigned cvt_pk_bf16(float lo, float hi) { unsigned r; asm volatile("v_cvt_pk_bf16_f32 %0, %1, %2" : "=v"(r) : "v"(lo), "v"(hi)); return r; }
typedef unsigned u32x2 __attribute__((ext_vector_type(2)));
constexpr float RMS_EPS = 1e-6f;
__device__ __forceinline__ float rs_of(const float* ss, int row, float invn) { return __builtin_amdgcn_rsqf(ss[row] * invn + RMS_EPS); }
__device__ __forceinline__ float silu_f(float g) { return g * __builtin_amdgcn_rcpf(1.0f + __builtin_amdgcn_exp2f(-1.4426950408889634f * g)); }
__device__ __forceinline__ u32x4 pack8(const f32x4 a, const f32x4 b) { u32x4 w; w.x = cvt_pk_bf16(a[0], a[1]); w.y = cvt_pk_bf16(a[2], a[3]); w.z = cvt_pk_bf16(b[0], b[1]); w.w = cvt_pk_bf16(b[2], b[3]); return w; }

struct EpiSwiGLU {
    static constexpr bool PERM = true, AFTER_DRAIN = false;
    unsigned char* ws; int which;
    __device__ __forceinline__ void operator()(const f32x4 (&acc)[2][2][4][2], const Unit& u, int wr, int wc, int fr, int fq) const {
        bf16_t* O = (bf16_t*)(ws + mkc::WS_ACT); const int ldo = mkc::DFF; const float* ss = (const float*)(ws + (which ? mkc::WS_SS3 : mkc::WS_SS1)); const float invn = 1.0f / 1024.0f;
        const int row0 = u.pm * BM + wr * 64 + fr, col0 = u.pn * HALF + wc * 32 + 8 * fq;
#pragma unroll
        for (int ai = 0; ai < 2; ++ai)
#pragma unroll
            for (int m = 0; m < 4; ++m) { const int row = row0 + ai * HALF + m * 16; const float rs = rs_of(ss, row, invn);
                f32x4 a0, a1;
#pragma unroll
                for (int j = 0; j < 4; ++j) { a0[j] = silu_f(acc[ai][0][m][0][j] * rs) * (acc[ai][1][m][0][j] * rs); a1[j] = silu_f(acc[ai][0][m][1][j] * rs) * (acc[ai][1][m][1][j] * rs); }
                *(u32x4*)(O + (size_t)row * ldo + col0) = pack8(a0, a1); }
    }
};
__device__ __forceinline__ f32x4 bf4_to_f32(const u32x2 w) { f32x4 r; r[0] = __builtin_bit_cast(float, w.x << 16); r[1] = __builtin_bit_cast(float, w.x & 0xFFFF0000u); r[2] = __builtin_bit_cast(float, w.y << 16); r[3] = __builtin_bit_cast(float, w.y & 0xFFFF0000u); return r; }
struct EpiResid {
    static constexpr bool PERM = false, AFTER_DRAIN = false;
    float* out; unsigned char* ws; int ss_off; float alpha;
    __device__ __forceinline__ void operator()(const f32x4 (&acc)[2][2][4][2], const Unit& u, int wr, int wc, int fr, int fq) const {
        bf16_t* xb = (bf16_t*)(ws + mkc::WS_XB); float* ss_out = (float*)(ws + ss_off);
        const int row0 = u.pm * BM + wr * 64 + fr, col0 = u.pn * BM + wc * 32 + 4 * fq;
#pragma unroll
        for (int ai = 0; ai < 2; ++ai)
#pragma unroll
            for (int m = 0; m < 4; ++m) { const int row = row0 + ai * HALF + m * 16; const size_t off = (size_t)row * 1024 + col0; float s = 0.f;
#pragma unroll
                for (int bj = 0; bj < 2; ++bj)
#pragma unroll
                    for (int n = 0; n < 2; ++n) { const f32x4 b = bf4_to_f32(*(const u32x2*)(xb + off + bj * HALF + n * 16)); const f32x4 o = b + acc[ai][bj][m][n] * alpha;
                        if (out) *(f32x4*)(out + off + bj * HALF + n * 16) = o;
                        s += (o[0] * o[0] + o[1] * o[1]) + (o[2] * o[2] + o[3] * o[3]);
                        u32x2 w; w.x = cvt_pk_bf16(o[0], o[1]); w.y = cvt_pk_bf16(o[2], o[3]); *(u32x2*)(xb + off + bj * HALF + n * 16) = w; }
                s += __shfl_xor(s, 16); s += __shfl_xor(s, 32);
                if (fq == 0) atomicAdd(ss_out + row, s);
                asm volatile("" ::: "memory"); }
    }
};
struct EpiWin {
    static constexpr bool PERM = true, AFTER_DRAIN = false;
    unsigned char* ws; int dummy;
    __device__ __forceinline__ void operator()(const f32x4 (&acc)[2][2][4][2], const Unit& u, int wr, int wc, int fr, int fq) const {
        bf16_t* cqkv = (bf16_t*)(ws + mkc::WS_CQKV); bf16_t* mqkv = (bf16_t*)(ws + mkc::WS_MQKV); const float* ss_in = (const float*)(ws + mkc::WS_SS2);
        float* ssq = (float*)(ws + (dummy ? mkc::WS_SSDUMMY : mkc::WS_SSQ)); float* sskv = (float*)(ws + (dummy ? mkc::WS_SSDUMMY + 65536 : mkc::WS_SSKV)); float* kmsum = (float*)(ws + (dummy ? mkc::WS_KMSDUMMY : mkc::WS_KMS));
        const int row0 = u.pm * BM + wr * 64 + fr;
        const bool is_mk = (u.pn == 5 || u.pn == 6);
        f32x4 cs[2][2];
#pragma unroll
        for (int bj = 0; bj < 2; ++bj)
#pragma unroll
            for (int n = 0; n < 2; ++n) cs[bj][n] = (f32x4){0.f, 0.f, 0.f, 0.f};
#pragma unroll
        for (int ai = 0; ai < 2; ++ai)
#pragma unroll
            for (int m = 0; m < 4; ++m) { const int row = row0 + ai * HALF + m * 16; const float rs = rs_of(ss_in, row, 1.0f / 1024.0f);
#pragma unroll
                for (int bj = 0; bj < 2; ++bj) { const int colt = u.pn * BM + bj * HALF, col0 = colt + wc * 32 + 8 * fq;
                    const f32x4 v0 = acc[ai][bj][m][0] * rs, v1 = acc[ai][bj][m][1] * rs;
                    bf16_t* dst = (colt < 768) ? (cqkv + (size_t)row * 768 + col0) : (mqkv + (size_t)row * 1536 + (col0 - 768));
                    *(u32x4*)dst = pack8(v0, v1);
                    if (colt < 640) { float s = (v0[0] * v0[0] + v0[1] * v0[1]) + (v0[2] * v0[2] + v0[3] * v0[3]) + (v1[0] * v1[0] + v1[1] * v1[1]) + (v1[2] * v1[2] + v1[3] * v1[3]);
                        s += __shfl_xor(s, 16); s += __shfl_xor(s, 32);
                        if (fq == 0) atomicAdd((colt < 384 ? ssq : sskv) + row, s); }
                    if (is_mk) { cs[bj][0] += v0; cs[bj][1] += v1; } } }
        if (is_mk) {
#pragma unroll
            for (int bj = 0; bj < 2; ++bj)
#pragma unroll
                for (int n = 0; n < 2; ++n)
#pragma unroll
                    for (int j = 0; j < 4; ++j) { float s = cs[bj][n][j]; s += __shfl_xor(s, 1); s += __shfl_xor(s, 2); s += __shfl_xor(s, 4); s += __shfl_xor(s, 8);
                        if (fr == 0) atomicAdd(kmsum + (size_t)u.pm * 512 + (u.pn * BM + bj * HALF + wc * 32 + 8 * fq + 4 * n + j - 1280), s); }
        }
    }
};
struct EpiKV {
    static constexpr bool PERM = true, AFTER_DRAIN = false;
    unsigned char* ws;
    __device__ __forceinline__ void operator()(const f32x4 (&acc)[2][2][4][2], const Unit& u, int wr, int wc, int fr, int fq) const {
        bf16_t* Kn = (bf16_t*)(ws + mkc::WS_KN); bf16_t* V = (bf16_t*)(ws + mkc::WS_V); const float* ss = (const float*)(ws + mkc::WS_SSKV);
        const int row0 = u.pm * BM + wr * 64 + fr;
#pragma unroll
        for (int ai = 0; ai < 2; ++ai)
#pragma unroll
            for (int m = 0; m < 4; ++m) { const int row = row0 + ai * HALF + m * 16; const float rs = rs_of(ss, row, 1.0f / 256.0f);
#pragma unroll
                for (int bj = 0; bj < 2; ++bj) { const int colt = u.pn * BM + bj * HALF, col0 = colt + wc * 32 + 8 * fq;
                    bf16_t* dst = (colt < 512) ? (Kn + (size_t)row * 512 + col0) : (V + (size_t)row * 512 + (col0 - 512));
                    *(u32x4*)dst = pack8(acc[ai][bj][m][0] * rs, acc[ai][bj][m][1] * rs); } }
    }
};
struct EpiQ {
    static constexpr bool PERM = true, AFTER_DRAIN = false;
    unsigned char* ws;
    __device__ __forceinline__ void operator()(const f32x4 (&acc)[2][2][4][2], const Unit& u, int wr, int wc, int fr, int fq) const {
        bf16_t* Q = (bf16_t*)(ws + mkc::WS_Q); const float* ss = (const float*)(ws + mkc::WS_SSQ); const float* cosT = (const float*)(ws + mkc::WS_COS); const float* sinT = (const float*)(ws + mkc::WS_SIN);
        const int row0 = u.pm * BM + wr * 64 + fr;
#pragma unroll
        for (int ai = 0; ai < 2; ++ai)
#pragma unroll
            for (int m = 0; m < 4; ++m) { const int row = row0 + ai * HALF + m * 16; const float rs = rs_of(ss, row, 1.0f / 384.0f);
#pragma unroll
                for (int bj = 0; bj < 2; ++bj) { const int col0 = u.pn * BM + bj * HALF + wc * 32 + 8 * fq; const int d = col0 % 96;
                    f32x4 v0 = acc[ai][bj][m][0] * rs, v1 = acc[ai][bj][m][1] * rs;
                    if (d >= 64) { const int g = (d - 64) >> 3; const f32x4 c = *(const f32x4*)(cosT + (size_t)row * 16 + 4 * g), s = *(const f32x4*)(sinT + (size_t)row * 16 + 4 * g);
                        const f32x4 o0 = v0 * c - v1 * s, o1 = v0 * s + v1 * c; v0 = o0; v1 = o1; }
                    *(u32x4*)(Q + (size_t)row * 768 + col0) = pack8(v0, v1); }
                asm volatile("" ::: "memory"); }
    }
};
struct EpiResidNorm {
    static constexpr bool PERM = false, AFTER_DRAIN = true;
    float* out; unsigned char* ws; const float* gain; float alpha;
    __device__ __forceinline__ void fused(f32x4 (&acc)[2][2][4][2], const Unit& u, int wr, int wc, int fr, int fq, PG8_LAS unsigned char* lds, int wid, int lane) const {
        float* ss = (float*)(ws + mkc::WS_SS4); unsigned* pcnt = (unsigned*)(ws + mkc::WS_PANEL) + 64 * u.pm; const bf16_t* xb = (const bf16_t*)(ws + mkc::WS_XB);
        const int row0 = u.pm * BM + wr * 64 + fr, col0 = u.pn * BM + wc * 32 + 4 * fq;
#pragma unroll
        for (int ai = 0; ai < 2; ++ai)
#pragma unroll
            for (int m = 0; m < 4; ++m) { const int row = row0 + ai * HALF + m * 16; const size_t off = (size_t)row * 1024 + col0; float s = 0.f;
#pragma unroll
                for (int bj = 0; bj < 2; ++bj)
#pragma unroll
                    for (int n = 0; n < 2; ++n) { const f32x4 b = bf4_to_f32(*(const u32x2*)(xb + off + bj * HALF + n * 16)); const f32x4 o = b + acc[ai][bj][m][n] * alpha; acc[ai][bj][m][n] = o;
                        s += (o[0] * o[0] + o[1] * o[1]) + (o[2] * o[2] + o[3] * o[3]); }
                s += __shfl_xor(s, 16); s += __shfl_xor(s, 32);
                if (fq == 0) atomicAdd(ss + row, s);
                asm volatile("" : "+v"(acc[ai][0][m][0]), "+v"(acc[ai][0][m][1]), "+v"(acc[ai][1][m][0]), "+v"(acc[ai][1][m][1]));
                if (m & 1) asm volatile("" ::: "memory"); }
        asm volatile("s_waitcnt vmcnt(0)" ::: "memory"); __builtin_amdgcn_s_barrier(); asm volatile("" ::: "memory");
        if (wid == 0) {
            if (lane == 0) { __builtin_amdgcn_fence(__ATOMIC_RELEASE, "agent"); asm volatile("s_waitcnt vmcnt(0)" ::: "memory"); __hip_atomic_fetch_add(pcnt, 1u, __ATOMIC_RELAXED, __HIP_MEMORY_SCOPE_AGENT); }
            unsigned spins = 0;
            while ((unsigned)__builtin_amdgcn_readfirstlane(__hip_atomic_load(pcnt, __ATOMIC_RELAXED, __HIP_MEMORY_SCOPE_AGENT)) < 4u) { __builtin_amdgcn_s_sleep(2); if (++spins > (1u << 22)) break; }
            __builtin_amdgcn_fence(__ATOMIC_ACQUIRE, "agent");
        }
        asm volatile("s_waitcnt vmcnt(0) lgkmcnt(0)" ::: "memory"); __builtin_amdgcn_s_barrier(); asm volatile("" ::: "memory");
        f32x4 gv[2][2];
#pragma unroll
        for (int bj = 0; bj < 2; ++bj)
#pragma unroll
            for (int n = 0; n < 2; ++n) gv[bj][n] = *(const f32x4*)(gain + col0 + bj * HALF + n * 16);
#pragma unroll
        for (int ai = 0; ai < 2; ++ai)
#pragma unroll
            for (int m = 0; m < 4; ++m) { const int row = row0 + ai * HALF + m * 16; const size_t off = (size_t)row * 1024 + col0;
                const float tot = __hip_atomic_load(ss + row, __ATOMIC_RELAXED, __HIP_MEMORY_SCOPE_AGENT); const float rs = __builtin_amdgcn_rsqf(tot * (1.0f / 1024.0f) + RMS_EPS);
#pragma unroll
                for (int bj = 0; bj < 2; ++bj)
#pragma unroll
                    for (int n = 0; n < 2; ++n) *(f32x4*)(out + off + bj * HALF + n * 16) = acc[ai][bj][m][n] * rs * gv[bj][n]; }
    }
};

template <class Epi, class Sched, bool ALIGN_EPI = false, bool SP2 = false>
__device__ __forceinline__ void gemm_phase(PG8_LAS unsigned char* lds, const Gemm g, const Sched& S, const Epi& E, const int wid) {
    const int lane = lane_id_v(), tid = wid * 64 + lane, wr = wid >> 2, wc = wid & 3, fr = lane & 15, fq = lane >> 4;
    const int K = g.K, nt = K / BK, lda = g.lda;
    unsigned voffA[2], voffB[2];
#pragma unroll
    for (int i = 0; i < 2; ++i) { int R, C; stage_rc(tid * 16 + i * 8192, R, C); const int Rb = Epi::PERM ? ((R & ~31) + perm32(R & 31)) : R;
        voffA[i] = (unsigned)(R * lda + C) * 2u; voffB[i] = (unsigned)(Rb * K + C) * 2u; }
    const size_t kstep = (size_t)(BK * 2);
    const size_t hstep = (size_t)HALF * K * 2;
    const size_t tstep = 2 * hstep; const size_t hstepA = (size_t)HALF * lda * 2, tstepA = 2 * hstepA;
    const unsigned ldsw = (unsigned)wid * 1024u;
    const int aoff = lds_byte(wr * 64 + fr, fq * 8), boff = lds_byte(wc * 32 + fr, fq * 8);
#define PG8_SA(b, h) (((b) * 2 + (h)) * HTB)
#define PG8_SB(b, h) ((4 + (b) * 2 + (h)) * HTB)
#define PG8_STAGE(bufoff, gbase, voff) do { _Pragma("unroll") for (int _i = 0; _i < 2; ++_i) \
        __builtin_amdgcn_global_load_lds((const unsigned*)((const char*)(gbase) + (voff)[_i]), (PG8_LAS unsigned*)(lds + (bufoff) + ldsw + _i * 8192), 16, 0, 0); } while (0)
#define PG8_LDA(dst, b, h) do { _Pragma("unroll") for (int m = 0; m < 4; ++m) _Pragma("unroll") for (int k = 0; k < 2; ++k) dst[m][k] = *(const PG8_LAS bf16x8*)(lds + PG8_SA(b, h) + aoff + m * 2048 + k * 1024); } while (0)
#define PG8_LDB(dst, b, h) do { _Pragma("unroll") for (int n = 0; n < 2; ++n) _Pragma("unroll") for (int k = 0; k < 2; ++k) dst[n][k] = *(const PG8_LAS bf16x8*)(lds + PG8_SB(b, h) + boff + n * 2048 + k * 1024); } while (0)
#define PG8_MMA(ai, bj, At, Bt) do { __builtin_amdgcn_s_setprio(1); _Pragma("unroll") for (int m = 0; m < 4; ++m) _Pragma("unroll") for (int n = 0; n < 2; ++n) _Pragma("unroll") for (int k = 0; k < 2; ++k) \
        acc[ai][bj][m][n] = __builtin_amdgcn_mfma_f32_16x16x32_bf16(Bt[n][k], At[m][k], acc[ai][bj][m][n], 0, 0, 0); __builtin_amdgcn_s_setprio(0); } while (0)
#define PG8_WAIT_V(n) asm volatile("s_waitcnt vmcnt(" #n ")" ::: "memory")
#define PG8_WAIT_L(n) asm volatile("s_waitcnt lgkmcnt(" #n ")" ::: "memory")
#define PG8_BAR __builtin_amdgcn_s_barrier()
#define PG8_SCHED __builtin_amdgcn_sched_barrier(0)
    Unit cur, nxt; int ui = 0;
    if (!S.next(0, cur)) return;
    f32x4 acc[2][2][4][2];
#pragma unroll
    for (int a = 0; a < 2; ++a)
#pragma unroll
        for (int b = 0; b < 2; ++b)
#pragma unroll
            for (int m = 0; m < 4; ++m)
#pragma unroll
                for (int n = 0; n < 2; ++n) acc[a][b][m][n] = (f32x4){0.f, 0.f, 0.f, 0.f};
    bf16x8 At[4][2], B0[2][2], B1[2][2];
    const char* cA = (const char*)g.A + (size_t)cur.pm * tstepA; const char* cB = (const char*)g.Bt + (size_t)cur.pn * tstep;
    S.a_ready(cur);
    if constexpr (SP2) {
        PG8_STAGE(PG8_SB(0, 0), cB, voffB); PG8_STAGE(PG8_SB(0, 1), cB + hstep, voffB); PG8_STAGE(PG8_SA(0, 0), cA, voffA); PG8_STAGE(PG8_SA(0, 1), cA + hstepA, voffA);
        if (wr == 1) PG8_BAR;
        PG8_WAIT_V(2); PG8_BAR;
        PG8_STAGE(PG8_SB(1, 0), cB + kstep, voffB); PG8_STAGE(PG8_SA(1, 0), cA + kstep, voffA); PG8_STAGE(PG8_SB(1, 1), cB + hstep + kstep, voffB);
        PG8_WAIT_V(6); PG8_BAR;
    } else {
        PG8_STAGE(PG8_SB(0, 0), cB, voffB); PG8_STAGE(PG8_SA(0, 0), cA, voffA); PG8_STAGE(PG8_SB(0, 1), cB + hstep, voffB); PG8_STAGE(PG8_SA(0, 1), cA + hstepA, voffA);
        if (wr == 1) PG8_BAR;
        PG8_WAIT_V(4); PG8_BAR;
        PG8_STAGE(PG8_SB(1, 0), cB + kstep, voffB); PG8_STAGE(PG8_SA(1, 0), cA + kstep, voffA); PG8_STAGE(PG8_SB(1, 1), cB + hstep + kstep, voffB);
        PG8_WAIT_V(6); PG8_BAR;
    }
    for (;;) {
        const bool has_next = S.next(ui + 1, nxt);
        const char* nA = has_next ? (const char*)g.A + (size_t)nxt.pm * tstepA : cA; const char* nB = has_next ? (const char*)g.Bt + (size_t)nxt.pn * tstep : cB;
#pragma nounroll
        for (int t = 0; t < nt; t += 2) {
            const bool last = (t == nt - 2);
            const char* a1 = cA + (size_t)(t + 1) * kstep;
            const char* a2 = last ? nA : cA + (size_t)(t + 2) * kstep; const char* b2 = last ? nB : cB + (size_t)(t + 2) * kstep;
            const char* a3 = a2 + kstep; const char* b3 = b2 + kstep;
            if (last && has_next) S.a_ready(nxt);
            if constexpr (SP2) {
            PG8_LDB(B0, 0, 0); PG8_LDB(B1, 0, 1); PG8_SCHED; PG8_LDA(At, 0, 0); PG8_STAGE(PG8_SA(1, 1), a1 + hstepA, voffA);
            PG8_WAIT_V(8); PG8_WAIT_L(0); PG8_BAR; PG8_MMA(0, 0, At, B0); PG8_MMA(0, 1, At, B1); PG8_BAR; PG8_SCHED;
            PG8_LDA(At, 0, 1); PG8_STAGE(PG8_SB(0, 0), b2, voffB); PG8_STAGE(PG8_SB(0, 1), b2 + hstep, voffB); PG8_STAGE(PG8_SA(0, 0), a2, voffA);
            PG8_WAIT_V(8); PG8_WAIT_L(0); PG8_BAR; PG8_MMA(1, 0, At, B0); PG8_MMA(1, 1, At, B1); PG8_BAR; PG8_SCHED;
            PG8_LDB(B0, 1, 0); PG8_LDB(B1, 1, 1); PG8_SCHED; PG8_LDA(At, 1, 0); PG8_STAGE(PG8_SA(0, 1), a2 + hstepA, voffA);
            PG8_WAIT_V(8); PG8_WAIT_L(0); PG8_BAR; PG8_MMA(0, 0, At, B0); PG8_MMA(0, 1, At, B1); PG8_BAR; PG8_SCHED;
            PG8_LDA(At, 1, 1); PG8_STAGE(PG8_SB(1, 0), b3, voffB); PG8_STAGE(PG8_SB(1, 1), b3 + hstep, voffB); PG8_STAGE(PG8_SA(1, 0), a3, voffA);
            PG8_WAIT_V(8); PG8_WAIT_L(0); PG8_BAR; PG8_MMA(1, 0, At, B0); PG8_MMA(1, 1, At, B1); PG8_BAR; PG8_SCHED;
            } else {
            PG8_LDB(B0, 0, 0); PG8_SCHED; PG8_LDA(At, 0, 0); PG8_STAGE(PG8_SA(1, 1), a1 + hstepA, voffA);
            PG8_WAIT_L(8); PG8_BAR; PG8_WAIT_L(0); PG8_MMA(0, 0, At, B0); PG8_BAR; PG8_SCHED;
            PG8_LDB(B1, 0, 1); PG8_STAGE(PG8_SB(0, 0), b2, voffB);
            PG8_BAR; PG8_WAIT_L(0); PG8_MMA(0, 1, At, B1); PG8_BAR;
            PG8_LDA(At, 0, 1); PG8_STAGE(PG8_SA(0, 0), a2, voffA);
            PG8_BAR; PG8_WAIT_L(0); PG8_MMA(1, 0, At, B0); PG8_BAR; PG8_SCHED;
            PG8_STAGE(PG8_SB(0, 1), b2 + hstep, voffB);
            PG8_WAIT_V(6); PG8_BAR; PG8_MMA(1, 1, At, B1); PG8_BAR;
            PG8_LDB(B0, 1, 0); PG8_SCHED; PG8_LDA(At, 1, 0); PG8_STAGE(PG8_SA(0, 1), a2 + hstepA, voffA);
            PG8_WAIT_L(8); PG8_BAR; PG8_WAIT_L(0); PG8_MMA(0, 0, At, B0); PG8_BAR; PG8_SCHED;
            PG8_LDB(B1, 1, 1); PG8_STAGE(PG8_SB(1, 0), b3, voffB);
            PG8_BAR; PG8_WAIT_L(0); PG8_MMA(0, 1, At, B1); PG8_BAR;
            PG8_LDA(At, 1, 1); PG8_STAGE(PG8_SA(1, 0), a3, voffA);
            PG8_BAR; PG8_WAIT_L(0); PG8_MMA(1, 0, At, B0); PG8_BAR; PG8_SCHED;
            PG8_STAGE(PG8_SB(1, 1), b3 + hstep, voffB);
            PG8_WAIT_V(6); PG8_BAR; PG8_MMA(1, 1, At, B1); PG8_BAR;
            }
        }
        if constexpr (ALIGN_EPI) { if (wr == 0) PG8_BAR; }
        if constexpr (!Epi::AFTER_DRAIN) { E(acc, cur, wr, wc, fr, fq); S.done(cur); }
        if (!has_next) break;
#pragma unroll
        for (int a = 0; a < 2; ++a)
#pragma unroll
            for (int b = 0; b < 2; ++b)
#pragma unroll
                for (int m = 0; m < 4; ++m)
#pragma unroll
                    for (int n = 0; n < 2; ++n) acc[a][b][m][n] = (f32x4){0.f, 0.f, 0.f, 0.f};
        cur = nxt; cA = nA; cB = nB; ++ui;
        if constexpr (ALIGN_EPI) { if (wr == 1) PG8_BAR; }
    }
    PG8_WAIT_V(0);
    if constexpr (!ALIGN_EPI) { if (wr == 0) PG8_BAR; }
    PG8_BAR;
    if constexpr (Epi::AFTER_DRAIN) { E.fused(acc, cur, wr, wc, fr, fq, lds, wid, lane); S.done(cur); }
#undef PG8_SA
#undef PG8_SB
#undef PG8_STAGE
#undef PG8_LDA
#undef PG8_LDB
#undef PG8_MMA
#undef PG8_WAIT_V
#undef PG8_WAIT_L
#undef PG8_BAR
#undef PG8_SCHED
}
}
namespace att {
typedef unsigned short bf16_t;
using bf16x8 = __attribute__((ext_vector_type(8))) short;
using s16x4 = __attribute__((ext_vector_type(4))) short;
using f32x16 = __attribute__((ext_vector_type(16))) float;
using f32x4 = __attribute__((ext_vector_type(4))) float;
using u32x4 = __attribute__((ext_vector_type(4))) unsigned;
typedef short v4i16_t __attribute__((ext_vector_type(4)));
#define ATT_LAS __attribute__((address_space(3)))
typedef ATT_LAS const char* lds_cptr;
constexpr int NW = 8, KVBLK = 64;
constexpr int KSLOT = 12288, VSLOT = 8192, NSLOT = 4;
constexpr int LDS_K = 0, LDS_V = NSLOT * KSLOT, LDS_WS = LDS_V + NSLOT * VSLOT, LDS_OST = LDS_WS + NW * 64 * 4, LDS_POSK = LDS_OST + NW * 4096, LDS_BYTES = LDS_POSK + 1024;
__device__ __forceinline__ int crow(int r, int hi) { return (r & 3) + 8 * (r >> 2) + 4 * hi; }
__device__ __forceinline__ void glds16(const void* gsrc, unsigned lds_dst) { unsigned keep;
    asm volatile("s_mov_b32 %0, m0\n\ts_mov_b32 m0, %2\n\ts_nop 0\n\tglobal_load_lds_dwordx4 %1, off\n\ts_mov_b32 m0, %0" : "=&s"(keep) : "v"(gsrc), "s"(lds_dst) : "memory"); }
typedef float f32x2_t __attribute__((ext_vector_type(2))); typedef __bf16 bf16x2_t __attribute__((ext_vector_type(2)));
__device__ __forceinline__ unsigned cvtpk(float lo, float hi) { f32x2_t v = {lo, hi}; bf16x2_t b = __builtin_convertvector(v, bf16x2_t); return __builtin_bit_cast(unsigned, b); }
__device__ __forceinline__ float att_bf16_up(float x) { unsigned u = __float_as_uint(x); if (u & 0xFFFFu) { u &= 0xFFFF0000u; if (x > 0.f) u += 0x10000u; } return __uint_as_float(u); }
__device__ __forceinline__ s16x4 vtr(lds_cptr p) { return __builtin_bit_cast(s16x4, __builtin_amdgcn_ds_read_tr16_b64_v4i16((ATT_LAS v4i16_t*)p)); }
#define ATT_KS(j) (((j) & (NSLOT - 1)) * KSLOT)
#define ATT_VS(j) (((j) & (NSLOT - 1)) * VSLOT)
#define ATT_WAIT_BAR() asm volatile("s_waitcnt vmcnt(0) lgkmcnt(0)\n\ts_barrier" ::: "memory")
#define ATT_WAIT_BAR_N(three) do { if (three) asm volatile("s_waitcnt vmcnt(3) lgkmcnt(0)\n\ts_barrier" ::: "memory"); else asm volatile("s_waitcnt vmcnt(2) lgkmcnt(0)\n\ts_barrier" ::: "memory"); } while (0)

struct Unit {
    const bf16_t* Q; int q_pitch;
    const bf16_t* K; int k_pitch;
    const bf16_t* Kr;
    const bf16_t* V; int v_pitch;
    int key0, ntiles;
    int q0;
    const unsigned short* list; int len;
    const float* posf;
    float slope2;
    bf16_t* O; int o_pitch;
    bf16_t* part; float* plse; int h;
};

template <int MODE> __device__ __forceinline__ void unit(const Unit& U, char* shm, const int wid) {
    constexpr int DQK = (MODE == 0) ? 96 : 64, ND0 = DQK / 16;
    const int lane = pg8::lane_id_v(), tid = wid * 64 + lane, r32 = lane & 31, hi = lane >> 5;
    const unsigned lds0 = (unsigned)(uintptr_t)shm;
    const lds_cptr shm3 = (lds_cptr)shm;
    ATT_LAS float* wsf = (ATT_LAS float*)(shm3 + LDS_WS) + wid * 64;
    int qrow, slot = 0; bool valid = true;
    if (MODE == 2) { const int e = wid * 32 + r32; valid = e < U.len; const unsigned ent = valid ? (unsigned)U.list[e] : (unsigned)U.list[0]; qrow = (int)(ent & 0x3FFFu); slot = 1 + (int)(ent >> 14); }
    else qrow = U.q0 + wid * 32 + r32;
    const unsigned koff = (unsigned)((U.key0 + 8 * wid + (lane >> 3)) * U.k_pitch + (((lane & 7) ^ ((4 * wid + (lane >> 4)) & 7)) * 8)) * 2u;
    const unsigned kroff = (MODE == 0) ? (unsigned)((U.key0 + 16 * (wid & 3) + (lane >> 2)) * 32 + (((lane & 3) ^ ((lane >> 4) & 3)) * 8)) * 2u : 0u;
    const unsigned voff = (unsigned)((U.key0 + 16 * (wid & 3) + (lane >> 2)) * U.v_pitch + (wid >> 2) * 32 + (lane & 3) * 8) * 2u;
#define ATT_DMA(t, ks, vs) do { glds16((const char*)U.K + koff + (size_t)(t) * (KVBLK * 2) * U.k_pitch, (unsigned)(lds0 + LDS_K + wid * 1024 + (ks))); \
        if (MODE == 0 && wid < 4) glds16((const char*)U.Kr + kroff + (size_t)(t) * (KVBLK * 64), (unsigned)(lds0 + LDS_K + (8 + (wid & 3)) * 1024 + (ks))); \
        glds16((const char*)U.V + voff + (size_t)(t) * (KVBLK * 2) * U.v_pitch, (unsigned)(lds0 + LDS_V + wid * 1024 + (vs))); } while (0)
    const int NT = U.ntiles;
    ATT_DMA(0, 0, 0);
    if (NT > 1) ATT_DMA(1, KSLOT, VSLOT);
    bf16x8 qr[ND0];
    { const bf16_t* Qw = U.Q + (size_t)qrow * U.q_pitch + hi * 8;
#pragma unroll
      for (int d0 = 0; d0 < ND0; ++d0) qr[d0] = *reinterpret_cast<const bf16x8*>(Qw + d0 * 16); }
    float pq = 0.f;
    if (MODE != 0) { pq = U.posf[qrow]; if (tid < 256) ((ATT_LAS float*)(shm3 + LDS_POSK))[tid] = U.posf[U.key0 + tid]; }
    float mhat = -1e30f, l_reg = 0.f; f32x16 o[2]; o[0] = f32x16{}; o[1] = f32x16{};
    const int km_ = (r32 >> 1) & 7, kmr_ = (r32 >> 2) & 3;
    const int ka0 = LDS_K + r32 * 128 + 32 * (km_ >> 1) + 16 * (hi ^ (km_ & 1));
    const int kb0 = LDS_K + 8192 + r32 * 64 + 32 * (kmr_ >> 1) + 16 * (hi ^ (kmr_ & 1));
#define ATT_KADDR(d0, half, KS) (shm3 + (KS) + (((d0) < 4) ? ((ka0 ^ ((d0) << 5)) + (half) * 4096) : ((kb0 ^ (((d0) - 4) << 5)) + (half) * 2048)))
    const lds_cptr vp0 = shm3 + LDS_V + ((lane >> 4) & 1) * 32 + (lane & 3) * 8 + (4 * hi + ((lane & 15) >> 2)) * 64;
#define ATT_QKT(P0, P1, KS) do { P0 = f32x16{}; P1 = f32x16{}; bf16x8 kk_[2 * ND0]; \
        _Pragma("unroll") for (int d0 = 0; d0 < ND0; ++d0) { kk_[2 * d0] = *(const ATT_LAS bf16x8*)ATT_KADDR(d0, 0, KS); kk_[2 * d0 + 1] = *(const ATT_LAS bf16x8*)ATT_KADDR(d0, 1, KS); }     \
        __builtin_amdgcn_sched_barrier(0); \
        _Pragma("unroll") for (int d0 = 0; d0 < ND0; ++d0) { \
            P0 = __builtin_amdgcn_mfma_f32_32x32x16_bf16(kk_[2 * d0], qr[d0], P0, 0, 0, 0); P1 = __builtin_amdgcn_mfma_f32_32x32x16_bf16(kk_[2 * d0 + 1], qr[d0], P1, 0, 0, 0); } } while (0)
#define ATT_SMPV(P0, P1, T, VS) do { \
        if (MODE != 0) { const ATT_LAS float* pk_ = (const ATT_LAS float*)(shm3 + LDS_POSK) + 64 * (T) + 4 * hi; \
            _Pragma("unroll") for (int g = 0; g < 4; ++g) { const f32x4 a_ = *(const ATT_LAS f32x4*)(pk_ + 8 * g), b_ = *(const ATT_LAS f32x4*)(pk_ + 8 * g + 32); \
                _Pragma("unroll") for (int j = 0; j < 4; ++j) { P0[4 * g + j] -= U.slope2 * __builtin_fabsf(pq - a_[j]); P1[4 * g + j] -= U.slope2 * __builtin_fabsf(pq - b_[j]); } } } \
        if (MODE == 0 || MODE == 1) { const int kb_ = U.key0 + 64 * (T); \
            if (kb_ + 63 > U.q0 + wid * 32) { const int dq_ = qrow - kb_ - 4 * hi; \
                _Pragma("unroll") for (int r = 0; r < 16; ++r) { const int c_ = (r & 3) + 8 * (r >> 2); if (c_ > dq_) P0[r] = -INFINITY; if (c_ + 32 > dq_) P1[r] = -INFINITY; } } } \
        float rm_ = P0[0]; \
        _Pragma("unroll") for (int r = 1; r < 16; ++r) rm_ = fmaxf(rm_, P0[r]); \
        _Pragma("unroll") for (int r = 0; r < 16; ++r) rm_ = fmaxf(rm_, P1[r]); \
        { auto rr_ = __builtin_amdgcn_permlane32_swap(__float_as_uint(rm_), __float_as_uint(rm_), false, false); rm_ = fmaxf(__uint_as_float(rr_[0]), __uint_as_float(rr_[1])); } \
        if (__any(rm_ > mhat + 10.0f)) { const float mn_ = fmaxf(mhat, rm_), f_ = __builtin_amdgcn_exp2f(mhat - mn_); mhat = mn_; l_reg *= f_; \
            if (hi == 0) wsf[r32] = f_; \
            asm volatile("s_waitcnt lgkmcnt(0)" ::: "memory"); \
            _Pragma("unroll") for (int g = 0; g < 4; ++g) { const f32x4 fv_ = *(const ATT_LAS f32x4*)(wsf + 8 * g + 4 * hi); \
                _Pragma("unroll") for (int j = 0; j < 4; ++j) { o[0][4 * g + j] *= fv_[j]; o[1][4 * g + j] *= fv_[j]; } } } \
        float sacc_ = 0.f; \
        _Pragma("unroll") for (int r = 0; r < 16; ++r) { P0[r] = __builtin_amdgcn_exp2f(P0[r] - mhat); P1[r] = __builtin_amdgcn_exp2f(P1[r] - mhat); sacc_ += P0[r] + P1[r]; } \
        l_reg += sacc_; \
        u32x4 pw_[4]; \
        _Pragma("unroll") for (int s_ = 0; s_ < 2; ++s_) { \
            pw_[s_] = (u32x4){cvtpk(P0[8 * s_], P0[8 * s_ + 1]), cvtpk(P0[8 * s_ + 2], P0[8 * s_ + 3]), cvtpk(P0[8 * s_ + 4], P0[8 * s_ + 5]), cvtpk(P0[8 * s_ + 6], P0[8 * s_ + 7])}; \
            pw_[2 + s_] = (u32x4){cvtpk(P1[8 * s_], P1[8 * s_ + 1]), cvtpk(P1[8 * s_ + 2], P1[8 * s_ + 3]), cvtpk(P1[8 * s_ + 4], P1[8 * s_ + 5]), cvtpk(P1[8 * s_ + 6], P1[8 * s_ + 7])}; } \
        const lds_cptr vp_ = vp0 + (VS); s16x4 vl_[8], vh_[8]; \
        _Pragma("unroll") for (int i_ = 0; i_ < 8; ++i_) { vl_[i_] = vtr(vp_ + (i_ >> 2) * 4096 + (i_ & 3) * 1024); vh_[i_] = vtr(vp_ + (i_ >> 2) * 4096 + (i_ & 3) * 1024 + 512); }     \
        __builtin_amdgcn_sched_barrier(0); \
        _Pragma("unroll") for (int i_ = 0; i_ < 8; ++i_) { \
            const bf16x8 vf_ = (bf16x8){vl_[i_][0], vl_[i_][1], vl_[i_][2], vl_[i_][3], vh_[i_][0], vh_[i_][1], vh_[i_][2], vh_[i_][3]}; \
            o[i_ >> 2] = __builtin_amdgcn_mfma_f32_32x32x16_bf16(__builtin_bit_cast(bf16x8, pw_[i_ & 3]), vf_, o[i_ >> 2], 0, 0, 0); } } while (0)
#define ATT_ACT(T) (MODE != 1 || (64 * (T) <= wid * 32 + 31))
#define ATT_ITER(SC0, SC1, SN0, SN1, T) do { const bool has_next_ = (T) + 1 < NT; \
        if (has_next_ && ATT_ACT((T) + 1)) ATT_QKT(SN0, SN1, ATT_KS((T) + 1)); \
        if (ATT_ACT(T)) ATT_SMPV(SC0, SC1, T, ATT_VS(T)); \
        if (has_next_ && (MODE == 0 || NT > NSLOT)) { if ((T) + 3 < NT) ATT_WAIT_BAR_N(dma3); else ATT_WAIT_BAR(); if ((T) + 4 < NT) ATT_DMA((T) + 4, ATT_KS(T), ATT_VS(T)); }   \
        } while (0)
    const bool dma3 = (MODE == 0) && wid < 4;
    if (NT > 2) ATT_DMA(2, 2 * KSLOT, 2 * VSLOT);
    if (NT > 3) ATT_DMA(3, 3 * KSLOT, 3 * VSLOT);
    if (MODE == 0 && NT > 3) ATT_WAIT_BAR_N(dma3); else ATT_WAIT_BAR();
    f32x16 pA0, pA1, pB0, pB1;
    ATT_QKT(pA0, pA1, 0);
    int t = 0;
    if (MODE == 0 && NT > 4) {
#define ATT_SB() __builtin_amdgcn_sched_barrier(0)
#define ATT_KLD(i, KS) kf[i] = *(const ATT_LAS bf16x8*)ATT_KADDR((i) >> 1, (i) & 1, KS)
#define ATT_VLD(i, VS) do { vlo[i] = vtr(vp0 + (VS) + ((i) >> 2) * 4096 + ((i) & 3) * 1024); vhi[i] = vtr(vp0 + (VS) + ((i) >> 2) * 4096 + ((i) & 3) * 1024 + 512); } while (0)
#define ATT_SCR(SC0, SC1, j) ((j) < 16 ? SC0[(j) & 15] : SC1[(j) & 15])
#define ATT_EXP4(SC0, SC1, g) do { if ((g) < 4) { _Pragma("unroll") for (int j_ = 0; j_ < 4; ++j_) SC0[4 * (g) + j_] = __builtin_amdgcn_exp2f(SC0[4 * (g) + j_]); } \
                                   else { _Pragma("unroll") for (int j_ = 0; j_ < 4; ++j_) SC1[4 * ((g) - 4) + j_] = __builtin_amdgcn_exp2f(SC1[4 * ((g) - 4) + j_]); } } while (0)
#define ATT_ADD4(SC0, SC1, g) do { if ((g) < 4) sacc_ += (SC0[4 * (g)] + SC0[4 * (g) + 1]) + (SC0[4 * (g) + 2] + SC0[4 * (g) + 3]); else sacc_ += (SC1[4 * ((g) - 4)] + SC1[4 * ((g) - 4) + 1]) + (SC1[4 * ((g) - 4) + 2] + SC1[4 * ((g) - 4) + 3]); } while (0)
#define ATT_CVT4(SC0, SC1, g) do { if ((g) < 4) { pw[(g) >> 1][2 * ((g) & 1)] = cvtpk(SC0[4 * (g)], SC0[4 * (g) + 1]); pw[(g) >> 1][2 * ((g) & 1) + 1] = cvtpk(SC0[4 * (g) + 2], SC0[4 * (g) + 3]); } \
                                   else { pw[(g) >> 1][2 * ((g) & 1)] = cvtpk(SC1[4 * ((g) - 4)], SC1[4 * ((g) - 4) + 1]); pw[(g) >> 1][2 * ((g) & 1) + 1] = cvtpk(SC1[4 * ((g) - 4) + 2], SC1[4 * ((g) - 4) + 3]); } } while (0)
#define ATT_GAPA(i, SC0, SC1, SN0, SN1) do { \
        if (((i) & 1) == 0) SN0 = __builtin_amdgcn_mfma_f32_32x32x16_bf16(kf[i], qr[(i) >> 1], SN0, 0, 0, 0); else SN1 = __builtin_amdgcn_mfma_f32_32x32x16_bf16(kf[i], qr[(i) >> 1], SN1, 0, 0, 0); \
        if ((i) < 8) { ATT_VLD(i, vs_); ATT_EXP4(SC0, SC1, i); } \
        if ((i) >= 1 && (i) <= 8) ATT_ADD4(SC0, SC1, (i) - 1); \
        if ((i) >= 2 && (i) <= 9) ATT_CVT4(SC0, SC1, (i) - 2); \
        ATT_SB(); } while (0)
#define ATT_VF(j) (bf16x8){vlo[j][0], vlo[j][1], vlo[j][2], vlo[j][3], vhi[j][0], vhi[j][1], vhi[j][2], vhi[j][3]}
#define ATT_GAPB(j, SN0, SN1) do { \
        o[(j) >> 2] = __builtin_amdgcn_mfma_f32_32x32x16_bf16(__builtin_bit_cast(bf16x8, pw[(j) & 3]), ATT_VF(j), o[(j) >> 2], 0, 0, 0); \
        if ((j) < 6) { ATT_KLD(2 * (j), ks2_); ATT_KLD(2 * (j) + 1, ks2_); } \
        if ((j) >= 2 && (j) < 6) { const int b_ = 4 * ((j) - 2); ma_ = fmaxf(fmaxf(ma_, SN0[b_]), SN0[b_ + 1]); mb_ = fmaxf(fmaxf(mb_, SN0[b_ + 2]), SN0[b_ + 3]); ma_ = fmaxf(fmaxf(ma_, SN1[b_]), SN1[b_ + 1]); mb_ = fmaxf(fmaxf(mb_, SN1[b_ + 2]), SN1[b_ + 3]); } \
        ATT_SB(); } while (0)
#define ATT_FAST(SC0, SC1, SN0, SN1, T) do { const int vs_ = ATT_VS(T), ks2_ = ATT_KS((T) + 2); \
        if (__any(rm > 10.0f)) { const float mn_ = att_bf16_up(mhat + fmaxf(rm, 0.f)), dl_ = mn_ - mhat, f_ = __builtin_amdgcn_exp2f(-dl_); mhat = mn_; l_reg *= f_; \
            _Pragma("unroll") for (int r = 0; r < 16; ++r) { SC0[r] -= dl_; SC1[r] -= dl_; } \
            qx[0] = (hi == 0) ? (short)(__float_as_uint(-mhat) >> 16) : (short)0; \
            if (hi == 0) wsf[r32] = f_; \
            asm volatile("s_waitcnt lgkmcnt(0)" ::: "memory"); \
            _Pragma("unroll") for (int g = 0; g < 4; ++g) { const f32x4 fv_ = *(const ATT_LAS f32x4*)(wsf + 8 * g + 4 * hi); \
                _Pragma("unroll") for (int j = 0; j < 4; ++j) { o[0][4 * g + j] *= fv_[j]; o[1][4 * g + j] *= fv_[j]; } } } \
        ATT_SB(); \
        float sacc_ = 0.f; \
        SN0 = __builtin_amdgcn_mfma_f32_32x32x16_bf16(kx, qx, f32x16{}, 0, 0, 0); SN1 = __builtin_amdgcn_mfma_f32_32x32x16_bf16(kx, qx, f32x16{}, 0, 0, 0);     \
        ATT_GAPA(0, SC0, SC1, SN0, SN1); ATT_GAPA(1, SC0, SC1, SN0, SN1); ATT_GAPA(2, SC0, SC1, SN0, SN1); ATT_GAPA(3, SC0, SC1, SN0, SN1); \
        ATT_GAPA(4, SC0, SC1, SN0, SN1); ATT_GAPA(5, SC0, SC1, SN0, SN1); ATT_GAPA(6, SC0, SC1, SN0, SN1); ATT_GAPA(7, SC0, SC1, SN0, SN1); \
        ATT_GAPA(8, SC0, SC1, SN0, SN1); ATT_GAPA(9, SC0, SC1, SN0, SN1); ATT_GAPA(10, SC0, SC1, SN0, SN1); ATT_GAPA(11, SC0, SC1, SN0, SN1); \
        l_reg += sacc_; \
        float ma_ = -INFINITY, mb_ = -INFINITY; \
        ATT_GAPB(0, SN0, SN1); ATT_GAPB(1, SN0, SN1); ATT_GAPB(2, SN0, SN1); ATT_GAPB(3, SN0, SN1); ATT_GAPB(4, SN0, SN1); ATT_GAPB(5, SN0, SN1); ATT_GAPB(6, SN0, SN1); ATT_GAPB(7, SN0, SN1); \
        rm = fmaxf(ma_, mb_); \
        { auto rr_ = __builtin_amdgcn_permlane32_swap(__float_as_uint(rm), __float_as_uint(rm), false, false); rm = fmaxf(__uint_as_float(rr_[0]), __uint_as_float(rr_[1])); } \
        ATT_SB(); \
        ATT_WAIT_BAR(); ATT_DMA((T) + 4, ATT_KS(T), vs_); } while (0)
        bf16x8 kf[12]; s16x4 vlo[8], vhi[8]; u32x4 pw[4];
        float rm = pA0[0];
#pragma unroll
        for (int r = 1; r < 16; ++r) rm = fmaxf(rm, pA0[r]);
#pragma unroll
        for (int r = 0; r < 16; ++r) rm = fmaxf(rm, pA1[r]);
        { auto rr_ = __builtin_amdgcn_permlane32_swap(__float_as_uint(rm), __float_as_uint(rm), false, false); rm = fmaxf(__uint_as_float(rr_[0]), __uint_as_float(rr_[1])); }
        mhat = att_bf16_up(rm);
#pragma unroll
        for (int r = 0; r < 16; ++r) { pA0[r] -= mhat; pA1[r] -= mhat; }
        rm -= mhat;
        const bf16x8 kx = (bf16x8){(short)0x3F80, 0, 0, 0, 0, 0, 0, 0};
        bf16x8 qx = (bf16x8){0, 0, 0, 0, 0, 0, 0, 0};
        if (hi == 0) qx[0] = (short)(__float_as_uint(-mhat) >> 16);
#pragma unroll
        for (int i = 0; i < 12; ++i) ATT_KLD(i, KSLOT);
        if (wid >= 4) __builtin_amdgcn_s_setprio(1);
        for (; t + 4 < NT; t += 2) { ATT_FAST(pA0, pA1, pB0, pB1, t); ATT_FAST(pB0, pB1, pA0, pA1, t + 1); }
        if (wid >= 4) __builtin_amdgcn_s_setprio(0);
#pragma unroll
        for (int r = 0; r < 16; ++r) { pA0[r] += mhat; pA1[r] += mhat; }
#undef ATT_FAST
#undef ATT_GAPA
#undef ATT_GAPB
#undef ATT_VF
#undef ATT_EXP4
#undef ATT_ADD4
#undef ATT_CVT4
#undef ATT_SCR
#undef ATT_KLD
#undef ATT_VLD
#undef ATT_SB
    }
    for (; t < NT; t += 2) {
        ATT_ITER(pA0, pA1, pB0, pB1, t);
        if (t + 1 < NT) ATT_ITER(pB0, pB1, pA0, pA1, t + 1);
    }
#undef ATT_QKT
#undef ATT_SMPV
#undef ATT_ACT
#undef ATT_ITER
    { auto rr = __builtin_amdgcn_permlane32_swap(__float_as_uint(l_reg), __float_as_uint(l_reg), false, false); l_reg = __uint_as_float(rr[0]) + __uint_as_float(rr[1]); }
    if (hi == 0) wsf[32 + r32] = l_reg;
    asm volatile("s_waitcnt lgkmcnt(0)" ::: "memory");
    float rli[16];
#pragma unroll
    for (int r = 0; r < 16; ++r) rli[r] = __builtin_amdgcn_rcpf(wsf[32 + crow(r, hi)]);
    ATT_LAS bf16_t* stg = (ATT_LAS bf16_t*)(shm3 + LDS_OST) + wid * 2048;
#pragma unroll
    for (int r = 0; r < 16; ++r) { const int orow = crow(r, hi);
#pragma unroll
        for (int d0 = 0; d0 < 2; ++d0) { const unsigned w = cvtpk(o[d0][r] * rli[r], 0.f); stg[orow * 64 + d0 * 32 + r32] = (bf16_t)(w & 0xFFFFu); } }
    asm volatile("s_waitcnt lgkmcnt(0)" ::: "memory");
    if (MODE == 0) {
        bf16_t* Ow = U.O + (size_t)(U.q0 + wid * 32) * U.o_pitch;
#pragma unroll
        for (int i = 0; i < 4; ++i) { const int row = i * 8 + (lane >> 3), ch = lane & 7; const u32x4 v = *(const ATT_LAS u32x4*)(stg + row * 64 + ch * 8); *(u32x4*)(Ow + (size_t)row * U.o_pitch + ch * 8) = v; }
    } else {
        const int meta = valid ? ((qrow << 2) | slot) : -1;
#pragma unroll
        for (int i = 0; i < 4; ++i) { const int row = i * 8 + (lane >> 3), ch = lane & 7; const int mt = __shfl(meta, row); const u32x4 v = *(const ATT_LAS u32x4*)(stg + row * 64 + ch * 8);
            if (mt >= 0) *(u32x4*)(U.part + ((size_t)((mt >> 2) * 8 + U.h) * 4 + (mt & 3)) * 64 + ch * 8) = v; }
        if (hi == 0 && valid) U.plse[(size_t)(qrow * 8 + U.h) * 4 + slot] = mhat + __builtin_log2f(l_reg);
    }
    asm volatile("s_waitcnt vmcnt(0) lgkmcnt(0)\n\ts_barrier" ::: "memory");
#undef ATT_DMA
}
}

namespace att {
constexpr int MB_REG = 65536, MB_TILE = 16384, MB_V = 8192, MB_POSK = 131072, MB_PRE = MB_POSK + 3072, MB_UT = MB_PRE + 2048, MB_NUT = 62, MB_TM = MB_UT + 1024, MB_KB = 140288, MB_ENT = MB_KB + 8192, MB_END = MB_ENT + 2048;
struct MobaCtx { const bf16_t* mqkv; const float* posf; bf16_t* part; float* plse; const unsigned* lists; const unsigned* cnt; int total, vcu, G; };
struct MobaDesc { int own, h, n; };
__device__ __forceinline__ unsigned att_bf16_rne(float f) { unsigned u = __float_as_uint(f); return (u + 0x7fffu + ((u >> 16) & 1u)) >> 16; }
__device__ __forceinline__ float att_bf2f(unsigned b) { return __uint_as_float(b << 16); }
__device__ __forceinline__ void att_split3(float c, unsigned& w1, unsigned& w2) { const unsigned c0 = att_bf16_rne(c); const float r1 = c - att_bf2f(c0); const unsigned c1 = att_bf16_rne(r1); const float r2 = r1 - att_bf2f(c1);
    w1 = c0 | (c1 << 16); w2 = att_bf16_rne(r2); }

__device__ __forceinline__ u32x4 moba_get(const MobaCtx& C, ATT_LAS const int* pre, int i) {
    const int ng = (C.vcu < C.total) ? (C.total - C.vcu + C.G - 1) / C.G : 0;
    if (i < ng) { const int gI = C.vcu + i * C.G; int lo = 0, hi = 511;
        while (lo < hi) { const int mid = (lo + hi) >> 1; if (pre[mid] > gI) hi = mid; else lo = mid + 1; }
        const int hn = lo, c = gI - (hn ? pre[hn - 1] : 0); const int len = (int)C.cnt[hn] - c * 256;
        return (u32x4){1u | ((unsigned)(hn >> 6) << 2) | ((unsigned)(hn & 63) << 5), (unsigned)(len < 256 ? len : 256), (unsigned)hn * 16384u + (unsigned)c * 256u, 0u}; }
    const int u = C.vcu + (i - ng) * C.G; if (u >= 512) return (u32x4){0u, 0u, 0u, 0u};
    return (u32x4){1u | 2u | ((unsigned)(u & 7) << 2) | ((unsigned)(u >> 3) << 5), 256u, 0u, 0u};
}
__device__ __forceinline__ void glds4(const void* gsrc, unsigned lds_dst) { unsigned keep;
    asm volatile("s_mov_b32 %0, m0\n\ts_mov_b32 m0, %2\n\ts_nop 0\n\tglobal_load_lds_dword %1, off\n\ts_mov_b32 m0, %0" : "=&s"(keep) : "v"(gsrc), "s"(lds_dst) : "memory"); }

template <int PROBE> __device__ __forceinline__ void moba_run(const MobaCtx& C, char* shm, const int wid) {
    const int lane = pg8::lane_id_v(), tid = wid * 64 + lane, r32 = lane & 31, hi = lane >> 5;
    const unsigned lds0 = (unsigned)(uintptr_t)shm; const lds_cptr shm3 = (lds_cptr)shm;
    ATT_LAS const int* pre = (ATT_LAS const int*)(shm3 + MB_PRE);
    const float* pmax = C.posf + 16384;
    const int km_ = (r32 >> 1) & 7;
    const int ka0 = r32 * 128 + 32 * (km_ >> 1) + 16 * (hi ^ (km_ & 1));
    const int vpl = MB_V + ((lane >> 4) & 1) * 32 + (lane & 3) * 8 + (4 * hi + ((lane & 15) >> 2)) * 64;
    const unsigned koff = (unsigned)((8 * wid + (lane >> 3)) * 1536 + (((lane & 7) ^ ((4 * wid + (lane >> 4)) & 7)) * 8)) * 2u;
    const unsigned voff = (unsigned)((16 * (wid & 3) + (lane >> 2)) * 1536 + (wid >> 2) * 32 + (lane & 3) * 8) * 2u;
#define MB_UNPACK(X_, D_) do { (D_).own = (int)(((X_) >> 1) & 1u); (D_).h = (int)(((X_) >> 2) & 7u); (D_).n = (PROBE & 4) ? 0 : (int)((X_) >> 5); } while (0)
#define MB_DMA(D_, R_) do { const char* kb_ = (const char*)(C.mqkv + 512 + (D_).h * 64 + (size_t)(D_).n * 256 * 1536); const char* vb_ = kb_ + 1024; \
        unsigned db_ = (unsigned)(lds0 + (R_) + wid * 1024); asm volatile("" : "+s"(db_));     \
        _Pragma("unroll") for (int t_ = 0; t_ < 4; ++t_) { glds16(kb_ + koff + (size_t)t_ * (64 * 1536 * 2), db_ + t_ * MB_TILE); \
                                                           glds16(vb_ + voff + (size_t)t_ * (64 * 1536 * 2), db_ + t_ * MB_TILE + MB_V); } } while (0)
#define MB_FETCH(I_, E_, X_) do { E_ = ((const ATT_LAS u32x4*)(shm3 + MB_UT))[(I_)]; X_ = (unsigned)__builtin_amdgcn_readfirstlane((int)E_[0]); } while (0)
#define MB_SMALL(U_, E_, D_) do { \
        if (!(D_).own) { const int e = wid * 32 + r32; if (hi == 0 && e < (int)E_[1]) glds4(C.lists + E_[2] + e, (unsigned)(lds0 + MB_ENT + ((U_) & 1) * 1024 + wid * 128)); } \
        if (wid < 4) glds4(C.posf + (D_).n * 256 + tid, (unsigned)(lds0 + MB_POSK + ((U_) % 3) * 1024 + wid * 256)); \
        if (tid < 4) glds4(pmax + 4 * (D_).n + tid, (unsigned)(lds0 + MB_TM + ((U_) % 3) * 16)); } while (0)
#define MB_STAGE(U_, D_) do { if (tid < 256) { const ATT_LAS float* pp_ = (const ATT_LAS float*)(shm3 + MB_POSK + ((U_) % 3) * 1024); \
            const float v_ = exp2f(-(float)((D_).h + 1)) * 1.4426950408889634f * (pp_[tid] - pp_[0]); const unsigned vh_ = att_bf16_rne(v_), vl_ = att_bf16_rne(v_ - att_bf2f(vh_)); \
            ((ATT_LAS u32x4*)(shm3 + MB_KB + ((U_) & 1) * 4096))[tid] = (u32x4){vh_ | (vl_ << 16), 0x3F803F80u, 0x00003F80u, 0u}; } } while (0)
#define MB_QROW(U_, E_, D_, META_, QR_, PQ_) do { const int e_ = wid * 32 + r32; \
        if ((D_).own) META_ = (((D_).n * 256 + e_) << 2); \
        else { const unsigned en_ = ((const ATT_LAS unsigned*)(shm3 + MB_ENT + ((U_) & 1) * 1024))[e_]; META_ = (e_ < (int)E_[1]) ? (int)(((en_ & 0x3FFFu) << 2) | (1u + ((en_ >> 14) & 3u))) : -1; } \
        const int qr_ = (PROBE & 4) ? (16128 + e_) : ((META_) >= 0 ? ((META_) >> 2) : 0); const bf16_t* Qw_ = C.mqkv + (D_).h * 64 + (size_t)qr_ * 1536 + hi * 8; \
        _Pragma("unroll") for (int d0 = 0; d0 < 4; ++d0) QR_[d0] = *reinterpret_cast<const bf16x8*>(Qw_ + d0 * 16); PQ_ = C.posf[qr_]; } while (0)
#define MB_CHEAP(U_, D_, META_, PQ_, CM_) do { const f32x4 tm_ = *(const ATT_LAS f32x4*)(shm3 + MB_TM + ((U_) % 3) * 16); CM_ = 0; \
        _Pragma("unroll") for (int t_ = 0; t_ < 4; ++t_) { bool ok_ = __all((META_) < 0 || (PQ_) >= tm_[t_]); if ((D_).own) ok_ = ok_ && (64 * t_ + 63 <= wid * 32); if (ok_) CM_ |= 1 << t_; } } while (0)
  for (int base = 0; ; base += MB_NUT) {
    __syncthreads();
    if (tid < MB_NUT) ((ATT_LAS u32x4*)(shm3 + MB_UT))[tid] = moba_get(C, pre, base + tid);
    if (tid == MB_NUT || tid == MB_NUT + 1) ((ATT_LAS u32x4*)(shm3 + MB_UT))[tid] = (u32x4){0u, 0u, 0u, 0u};
    __syncthreads();
    u32x4 ent_; unsigned xc, xn, xnn = 0u; MobaDesc D, Dn;
    MB_FETCH(0, ent_, xc);
    if (!(xc & 1u)) break;
    MB_UNPACK(xc, D);
    MB_DMA(D, 0); MB_SMALL(0, ent_, D);
    { u32x4 e1_; MB_FETCH(1, e1_, xn); MB_UNPACK(xn, Dn); if (xn & 1u) MB_SMALL(1, e1_, Dn); }
    __builtin_amdgcn_s_waitcnt(0); __builtin_amdgcn_s_barrier();
    int meta = -1, cm = 0; float pq = 0.f, pbase = 0.f; bf16x8 qr[4];
    MB_STAGE(0, D); MB_QROW(0, ent_, D, meta, qr, pq);
    pbase = ((const ATT_LAS float*)(shm3 + MB_POSK))[0];
    __builtin_amdgcn_s_waitcnt(0); __builtin_amdgcn_s_barrier();
    MB_CHEAP(0, D, meta, pq, cm);
    if (xn & 1u) MB_DMA(Dn, MB_REG);
    int i = 0;
    for (; xc & 1u; ++i) {
        int meta_n = -1; float pq_n = 0.f;
        MB_UNPACK(xn, Dn);
        const int cur = i & 1, rb = cur * MB_REG; const float slope2 = exp2f(-(float)(D.h + 1)) * 1.4426950408889634f;
        const bool valid = meta >= 0; const int qrow = valid ? (meta >> 2) : 0, slot = meta & 3;
        const ATT_LAS float* posk = (const ATT_LAS float*)(shm3 + MB_POSK + (i % 3) * 1024);
        const lds_cptr kbx = shm3 + MB_KB + cur * 4096 + r32 * 16;
        float mhat = 0.f, l_reg = 0.f; bool first_ = true; f32x16 o[2]; o[0] = f32x16{}; o[1] = f32x16{};
        unsigned qxa0 = 0u, qxa1 = 0u, qxa2 = 0u, qxr1 = 0u, qxr2 = 0u;
#define MB_QX() do { unsigned a1_, a2_, r1_, r2_; att_split3(-slope2 * (pq - pbase) - mhat, a1_, a2_); att_split3(-mhat, r1_, r2_); \
            qxa0 = hi == 0 ? 0x3F803F80u : 0u; qxa1 = hi == 0 ? a1_ : 0u; qxa2 = hi == 0 ? a2_ : 0u; qxr1 = hi == 0 ? r1_ : 0u; qxr2 = hi == 0 ? r2_ : 0u; } while (0)
        MB_QX();
        f32x16 pA0, pA1, pB0, pB1; float mA = 0.f, mB = 0.f;
#define MB_ACT(T) (!D.own || (64 * (T) <= wid * 32 + 31))
#define MB_CH(T) ((cm >> (T)) & 1)
#define MB_QKT(P0, P1, MR, T) do { bf16x8 kk_[8]; const lds_cptr kb_ = shm3 + rb + (T) * MB_TILE; \
            const bf16x8 kx0_ = *(const ATT_LAS bf16x8*)(kbx + (T) * 1024), kx1_ = *(const ATT_LAS bf16x8*)(kbx + (T) * 1024 + 512); \
            _Pragma("unroll") for (int d0 = 0; d0 < 4; ++d0) { kk_[2 * d0] = *(const ATT_LAS bf16x8*)(kb_ + (ka0 ^ (d0 << 5))); kk_[2 * d0 + 1] = *(const ATT_LAS bf16x8*)(kb_ + (ka0 ^ (d0 << 5)) + 4096); } \
            const bool ch_ = MB_CH(T); const u32x4 qs_ = (u32x4){ch_ ? qxa0 : 0u, ch_ ? qxa1 : qxr1, ch_ ? qxa2 : qxr2, 0u}; \
            __builtin_amdgcn_sched_barrier(0); \
            P0 = __builtin_amdgcn_mfma_f32_32x32x16_bf16(kx0_, __builtin_bit_cast(bf16x8, qs_), f32x16{}, 0, 0, 0); P1 = __builtin_amdgcn_mfma_f32_32x32x16_bf16(kx1_, __builtin_bit_cast(bf16x8, qs_), f32x16{}, 0, 0, 0); \
            _Pragma("unroll") for (int d0 = 0; d0 < 4; ++d0) { P0 = __builtin_amdgcn_mfma_f32_32x32x16_bf16(kk_[2 * d0], qr[d0], P0, 0, 0, 0); P1 = __builtin_amdgcn_mfma_f32_32x32x16_bf16(kk_[2 * d0 + 1], qr[d0], P1, 0, 0, 0); } \
            MR = mhat; } while (0)
#define MB_SMPV(P0, P1, MC, T) do { \
            if (__any(MC != mhat)) { const float d_ = mhat - MC; _Pragma("unroll") for (int r = 0; r < 16; ++r) { P0[r] -= d_; P1[r] -= d_; } }     \
            if (!MB_CH(T)) { const ATT_LAS float* pk_ = posk + 64 * (T) + 4 * hi; \
                _Pragma("unroll") for (int g = 0; g < 4; ++g) { const f32x4 a_ = *(const ATT_LAS f32x4*)(pk_ + 8 * g), b_ = *(const ATT_LAS f32x4*)(pk_ + 8 * g + 32); \
                    _Pragma("unroll") for (int j = 0; j < 4; ++j) { P0[4 * g + j] -= slope2 * __builtin_fabsf(pq - a_[j]); P1[4 * g + j] -= slope2 * __builtin_fabsf(pq - b_[j]); } } } \
            if (D.own && 64 * (T) + 63 > wid * 32) { int dq_ = wid * 32 + r32 - 64 * (T) - 4 * hi; asm volatile("" : "+v"(dq_));     \
                _Pragma("unroll") for (int r = 0; r < 16; ++r) { const int c_ = (r & 3) + 8 * (r >> 2); if (c_ > dq_) P0[r] = -INFINITY; if (c_ + 32 > dq_) P1[r] = -INFINITY; } } \
            float rm_ = P0[0]; \
            _Pragma("unroll") for (int r = 1; r < 16; ++r) rm_ = fmaxf(rm_, P0[r]); \
            _Pragma("unroll") for (int r = 0; r < 16; ++r) rm_ = fmaxf(rm_, P1[r]); \
            { auto rr_ = __builtin_amdgcn_permlane32_swap(__float_as_uint(rm_), __float_as_uint(rm_), false, false); rm_ = fmaxf(__uint_as_float(rr_[0]), __uint_as_float(rr_[1])); } \
            if (first_ || __any(rm_ > 10.0f)) { const float dl_ = first_ ? rm_ : fmaxf(rm_, 0.f); mhat += dl_; \
                _Pragma("unroll") for (int r = 0; r < 16; ++r) { P0[r] -= dl_; P1[r] -= dl_; } \
                if (!first_) { const float f_ = __builtin_amdgcn_exp2f(-dl_); l_reg *= f_; \
                    _Pragma("unroll") for (int r = 0; r < 16; ++r) { o[0][r] *= f_; o[1][r] *= f_; } }                        \
                first_ = false; MB_QX(); } \
            float sacc_ = 0.f; \
            _Pragma("unroll") for (int r = 0; r < 16; ++r) { P0[r] = __builtin_amdgcn_exp2f(P0[r]); P1[r] = __builtin_amdgcn_exp2f(P1[r]); sacc_ += P0[r] + P1[r]; } \
            l_reg += sacc_; \
            u32x4 pw_[4]; \
            _Pragma("unroll") for (int s_ = 0; s_ < 2; ++s_) { \
                pw_[s_] = (u32x4){cvtpk(P0[8 * s_], P0[8 * s_ + 1]), cvtpk(P0[8 * s_ + 2], P0[8 * s_ + 3]), cvtpk(P0[8 * s_ + 4], P0[8 * s_ + 5]), cvtpk(P0[8 * s_ + 6], P0[8 * s_ + 7])}; \
                pw_[2 + s_] = (u32x4){cvtpk(P1[8 * s_], P1[8 * s_ + 1]), cvtpk(P1[8 * s_ + 2], P1[8 * s_ + 3]), cvtpk(P1[8 * s_ + 4], P1[8 * s_ + 5]), cvtpk(P1[8 * s_ + 6], P1[8 * s_ + 7])}; } \
            const lds_cptr vp_ = shm3 + rb + (T) * MB_TILE + vpl; s16x4 vl_[8], vh_[8]; \
            _Pragma("unroll") for (int i_ = 0; i_ < 8; ++i_) { vl_[i_] = vtr(vp_ + (i_ >> 2) * 4096 + (i_ & 3) * 1024); vh_[i_] = vtr(vp_ + (i_ >> 2) * 4096 + (i_ & 3) * 1024 + 512); } \
            __builtin_amdgcn_sched_barrier(0); \
            _Pragma("unroll") for (int i_ = 0; i_ < 8; ++i_) { \
                const bf16x8 vf_ = (bf16x8){vl_[i_][0], vl_[i_][1], vl_[i_][2], vl_[i_][3], vh_[i_][0], vh_[i_][1], vh_[i_][2], vh_[i_][3]}; \
                o[i_ >> 2] = __builtin_amdgcn_mfma_f32_32x32x16_bf16(vf_, __builtin_bit_cast(bf16x8, pw_[i_ & 3]), o[i_ >> 2], 0, 0, 0); } } while (0)
        if (!(PROBE & 1)) {
        if (MB_ACT(3)) MB_QKT(pA0, pA1, mA, 3);
        if (MB_ACT(2)) MB_QKT(pB0, pB1, mB, 2);
        if (MB_ACT(3)) MB_SMPV(pA0, pA1, mA, 3);
        }
        if (xn & 1u) { MB_STAGE(i + 1, Dn);
            MB_FETCH(i + 2, ent_, xnn); if (xnn & 1u) { MobaDesc Dnn; MB_UNPACK(xnn, Dnn); MB_SMALL(i + 2, ent_, Dnn); } } else xnn = 0u;
        if (!(PROBE & 1)) {
        if (!(PROBE & 64)) if (MB_ACT(1)) MB_QKT(pA0, pA1, mA, 1);
        if (MB_ACT(2)) MB_SMPV(pB0, pB1, mB, 2);
        if (!(PROBE & 64)) MB_QKT(pB0, pB1, mB, 0);
        }
        if (xn & 1u) { MB_FETCH(i + 1, ent_, xn); MB_QROW(i + 1, ent_, Dn, meta_n, qr, pq_n); }
        if (!(PROBE & 1)) {
        if (!(PROBE & 64)) if (MB_ACT(1)) MB_SMPV(pA0, pA1, mA, 1);
        if (!(PROBE & 64)) MB_SMPV(pB0, pB1, mB, 0);
        }
#undef MB_QKT
#undef MB_SMPV
#undef MB_ACT
#undef MB_CH
#undef MB_QX
        __builtin_amdgcn_s_waitcnt(0); __builtin_amdgcn_s_barrier();
        const int h_o = D.h; const bool valid_o = valid; const int qrow_o = qrow, slot_o = slot;
        xc = xn; xn = xnn; D = Dn; meta = meta_n; pq = pq_n;
        if (xc & 1u) { pbase = ((const ATT_LAS float*)(shm3 + MB_POSK + ((i + 1) % 3) * 1024))[0]; MB_CHEAP(i + 1, D, meta, pq, cm); }
        if (xn & 1u) { MobaDesc Dt; MB_UNPACK(xn, Dt); MB_DMA(Dt, cur * MB_REG); }
        { auto rr = __builtin_amdgcn_permlane32_swap(__float_as_uint(l_reg), __float_as_uint(l_reg), false, false); l_reg = __uint_as_float(rr[0]) + __uint_as_float(rr[1]); }
        { const float rl = __builtin_amdgcn_rcpf(l_reg);
          bf16_t* prow = C.part + ((((size_t)(qrow_o * 8 + h_o) * 4 + slot_o) * 64) & (PROBE ? ((PROBE & 4) ? (size_t)0x3FFC0 : (size_t)0x7FFFC0) : ~(size_t)0)) + 8 * hi;
#pragma unroll
          for (int dh = 0; dh < 2; ++dh)
#pragma unroll
            for (int jp = 0; jp < 2; ++jp) {
                unsigned a0 = cvtpk(o[dh][8 * jp] * rl, o[dh][8 * jp + 1] * rl), a1 = cvtpk(o[dh][8 * jp + 2] * rl, o[dh][8 * jp + 3] * rl);
                unsigned b0 = cvtpk(o[dh][8 * jp + 4] * rl, o[dh][8 * jp + 5] * rl), b1 = cvtpk(o[dh][8 * jp + 6] * rl, o[dh][8 * jp + 7] * rl);
                const auto s0 = __builtin_amdgcn_permlane32_swap(a0, b0, false, false); const auto s1 = __builtin_amdgcn_permlane32_swap(a1, b1, false, false);
                if (!(PROBE & 2)) if (valid_o) *(u32x4*)(prow + 32 * dh + 16 * jp) = (u32x4){s0[0], s1[0], s0[1], s1[1]}; }
          if (!(PROBE & 2)) if (hi == 0 && valid_o) C.plse[(size_t)(qrow_o * 8 + h_o) * 4 + slot_o] = mhat + __builtin_log2f(l_reg); }
    }
    if (i < MB_NUT) break;
  }
#undef MB_UNPACK
#undef MB_DMA
#undef MB_FETCH
#undef MB_SMALL
#undef MB_STAGE
#undef MB_QROW
#undef MB_CHEAP
}
}

namespace xb {
#define LAS __attribute__((address_space(3)))
#define XB_TMO      128
#define XB_XCNT(j)  (256  + 64 * (j))
#define XB_XSUB(j)  (1280 + 64 * (j))
#define XB_XGEN(j)  (2304 + 64 * (j))
#define XB_TOP      3328
#define XB_TOPGEN   3392
#define XCD_BAR_WORDS 3456
#define XB_SPIN_CAP (1u << 21)

__device__ __forceinline__ unsigned xb_ld(unsigned* p)              { return __hip_atomic_load(p, __ATOMIC_RELAXED, __HIP_MEMORY_SCOPE_AGENT); }
__device__ __forceinline__ unsigned xb_add(unsigned* p, unsigned v) { return __hip_atomic_fetch_add(p, v, __ATOMIC_RELAXED, __HIP_MEMORY_SCOPE_AGENT); }
__device__ __forceinline__ unsigned xb_xcc_id() { return (unsigned)__builtin_amdgcn_s_getreg((3 << 11) | 20) & 0xFu; }
#define XB_SPIN(cond, bar) do { unsigned _sp = 0; while (cond) { __builtin_amdgcn_s_sleep(1); \
    if ((++_sp & 255u) == 0u) { if (xb_ld(&(bar)[XB_TMO])) break; if (_sp > XB_SPIN_CAP) { atomicAdd(&(bar)[XB_TMO], 1u); break; } } } } while (0)

struct XcdBarrier {
    unsigned* bar; unsigned x;
    volatile LAS unsigned* st;
};

__device__ __forceinline__ XcdBarrier xcd_barrier_post(unsigned* bar, volatile LAS unsigned* st, bool leader) {
    XcdBarrier b; b.bar = bar; b.x = xb_xcc_id(); b.st = st;
    if (leader) (void)xb_add(&bar[XB_XCNT(b.x)], 1u);
    return b;
}
__device__ __forceinline__ void xcd_barrier_complete(unsigned* bar, unsigned x, unsigned& nloc, unsigned& nx) {
    const unsigned G = gridDim.x * gridDim.y * gridDim.z;
    unsigned sum, cnt, mine, sp = 0u;
    for (;;) {
        sum = 0u; cnt = 0u; mine = 0u;
#pragma unroll
        for (unsigned j = 0; j < 16; ++j) { const unsigned c = xb_ld(&bar[XB_XCNT(j)]); sum += c; cnt += (c > 0u) ? 1u : 0u; mine = (j == x) ? c : mine; }
        if (sum == G) break;
        __builtin_amdgcn_s_sleep(1);
        if ((++sp & 255u) == 0u) { if (xb_ld(&bar[XB_TMO])) break; if (sp > XB_SPIN_CAP) { atomicAdd(&bar[XB_TMO], 1u); break; } }
    }
    nloc = mine > 0u ? mine : 1u; nx = cnt > 0u ? cnt : 1u;
}

__device__ __forceinline__ void xcd_barrier(const XcdBarrier& b, bool leader) {
    asm volatile("s_waitcnt vmcnt(0)" ::: "memory");
    __syncthreads();
    if (leader) {
        unsigned* bar = b.bar;
        __builtin_amdgcn_s_waitcnt(0);
        unsigned nloc = b.st[0], nx = b.st[1];
        if (nloc == 0u) { xcd_barrier_complete(bar, b.x, nloc, nx); b.st[0] = nloc; b.st[1] = nx; }
        const unsigned old = xb_add(&bar[XB_XSUB(b.x)], 1u);
        const unsigned gen = old / nloc;
        if (old + 1u == (gen + 1u) * nloc) {
            __builtin_amdgcn_fence(__ATOMIC_RELEASE, "agent");
            asm volatile("s_waitcnt vmcnt(0)" ::: "memory");
            const unsigned og = xb_add(&bar[XB_TOP], 1u);
            const unsigned tg = og / nx;
            if (og + 1u == (tg + 1u) * nx) xb_add(&bar[XB_TOPGEN], 1u);
            else XB_SPIN(xb_ld(&bar[XB_TOPGEN]) == tg, bar);
            __builtin_amdgcn_fence(__ATOMIC_ACQUIRE, "agent");
            xb_add(&bar[XB_XGEN(b.x)], 1u);
            asm volatile("s_waitcnt vmcnt(0)" ::: "memory");
        } else {
            XB_SPIN(xb_ld(&bar[XB_XGEN(b.x)]) == gen, bar);
            __builtin_amdgcn_fence(__ATOMIC_ACQUIRE, "agent");
            asm volatile("s_waitcnt vmcnt(0)" ::: "memory");
        }
    }
    __syncthreads();
}

#undef LAS
}
namespace mk {
typedef unsigned short bf16;
typedef unsigned v4u __attribute__((ext_vector_type(4)));
typedef float f32x4 __attribute__((ext_vector_type(4)));
#define MK_LAS __attribute__((address_space(3)))
using namespace mkc;
constexpr int NWAVES = 8;
constexpr int RING_BYTES = 131072, LDS_EXTRA = RING_BYTES, LDS_MISC = RING_BYTES + 8192, LDS_BYTES = 150528;
constexpr size_t WS_BAR = 4096, BAR_BYTES = 32768;

struct Args { const float* in[18]; float* out; unsigned char* ws; int ph_lo, ph_hi; };
struct Frame { MK_LAS unsigned char* lds; int tid, lane, wave, vcu, G; };
typedef const __attribute__((address_space(4))) Args* kargs_t;
__device__ __forceinline__ kargs_t kargs() { kargs_t p = (kargs_t)__builtin_amdgcn_kernarg_segment_ptr(); asm volatile("" : "+s"(p)); return p; }
__device__ __forceinline__ Frame mkframe(MK_LAS unsigned char* lds, int wave) { Frame F; F.lds = lds; F.wave = wave; F.lane = pg8::lane_id_v(); F.tid = wave * 64 + F.lane; F.G = gridDim.x;
    { const int bx = blockIdx.x; F.vcu = (F.G % 8 == 0) ? (bx % 8) * (F.G / 8) + bx / 8 : bx; } return F; }

__device__ __forceinline__ unsigned f2bf(float f) { unsigned u = __builtin_bit_cast(unsigned, f); return (u + 0x7fffu + ((u >> 16) & 1u)) >> 16; }
__device__ __forceinline__ unsigned pk2(float lo, float hi) { return f2bf(lo) | (f2bf(hi) << 16); }
__device__ __forceinline__ float bf2f(unsigned short b) { return __builtin_bit_cast(float, (unsigned)b << 16); }
__device__ __forceinline__ float wave_sum(float v) {
#pragma unroll
    for (int o = 1; o < 64; o <<= 1) v += __shfl_xor(v, o);
    return v;
}
__constant__ float ROPE_INV[16] = {1.000000000e+00f, 5.623413324e-01f, 3.162277639e-01f, 1.778279394e-01f, 1.000000015e-01f, 5.623413250e-02f, 3.162277490e-02f, 1.778279431e-02f,
                                   9.999999776e-03f, 5.623413250e-03f, 3.162277630e-03f, 1.778279431e-03f, 1.000000047e-03f, 5.623413017e-04f, 3.162277571e-04f, 1.778279402e-04f};
__device__ __forceinline__ int rope_phys(int L) { return L < 16 ? 8 * (L >> 2) + (L & 3) : 8 * ((L - 16) >> 2) + 4 + ((L - 16) & 3); }

__device__ __forceinline__ void p0_item(const float* W, int K, int N, bf16* WT, const float* gain, int kind, MK_LAS float* scr, int item, int lane) {
    const int nblk = N / 32, kb = item / nblk, nb = item % nblk, k0 = 64 * kb, n0 = 32 * nb;
    int dbase = n0; bool perm = false; float mul = 1.0f;
    if (kind == 1) dbase = (n0 >> 7) * 256 + (n0 & 127);
    else if (kind == 2) dbase = (n0 >> 7) * 256 + 128 + (n0 & 127);
    else if (kind == 3) { if (n0 == 640) perm = true; else if (n0 >= 672) { dbase = n0 + 96; if (n0 < 1184) mul = C2M; } }
    else if (kind == 4) { perm = (n0 % 96) == 64; mul = C2Q; }
    else if (kind == 5) { const int h = n0 >> 7, e = n0 & 127; dbase = e < 64 ? h * 64 + e : 512 + h * 64 + (e - 64); }
    float wv[32];
#pragma unroll
    for (int i = 0; i < 32; ++i) wv[i] = W[(size_t)(k0 + 2 * i + (lane >> 5)) * N + n0 + (lane & 31)];
#pragma unroll
    for (int i = 0; i < 32; ++i) { const int kk = 2 * i + (lane >> 5); const float g = gain ? gain[k0 + kk] * mul : mul; scr[kk * 33 + (lane & 31)] = wv[i] * g; }
    asm volatile("s_waitcnt lgkmcnt(0)" ::: "memory");
    const int c = lane & 7;
#pragma unroll
    for (int j = 0; j < 4; ++j) { const int n = (lane >> 3) + 8 * j; const MK_LAS float* s = scr + (8 * c) * 33 + n;
        v4u o; o.x = pk2(s[0 * 33], s[1 * 33]); o.y = pk2(s[2 * 33], s[3 * 33]); o.z = pk2(s[4 * 33], s[5 * 33]); o.w = pk2(s[6 * 33], s[7 * 33]);
        const int drow = dbase + (perm ? rope_phys(n) : n);
        *(v4u*)(WT + (size_t)drow * K + k0 + 8 * c) = o; }
    asm volatile("s_waitcnt lgkmcnt(0)" ::: "memory");
}
constexpr int I_G = (DM / 64) * (DFF / 32), I_D = (DFF / 64) * (DM / 32), I_IN = (DM / 64) * (2208 / 32), I_UQ = (384 / 64) * (768 / 32), I_UKV = (256 / 64) * (1024 / 32), I_O = (DM / 64) * (DM / 32);
constexpr int NITEMS = 4 * I_G + 2 * I_D + I_IN + I_UQ + I_UKV + I_O;
__device__ __forceinline__ void p0_one_item(kargs_t ap, unsigned char* ws, MK_LAS float* scr, int it, int lane) {
    int r = it;
    if (r < I_G) { p0_item(ap->in[3], DM, DFF, (bf16*)(ws + WS_WGU1), ap->in[2], 1, scr, r, lane); return; } r -= I_G;
    if (r < I_G) { p0_item(ap->in[4], DM, DFF, (bf16*)(ws + WS_WGU1), ap->in[2], 2, scr, r, lane); return; } r -= I_G;
    if (r < I_D) { p0_item(ap->in[5], DFF, DM, (bf16*)(ws + WS_WD1), nullptr, 0, scr, r, lane); return; } r -= I_D;
    if (r < I_G) { p0_item(ap->in[14], DM, DFF, (bf16*)(ws + WS_WGU2), ap->in[13], 1, scr, r, lane); return; } r -= I_G;
    if (r < I_G) { p0_item(ap->in[15], DM, DFF, (bf16*)(ws + WS_WGU2), ap->in[13], 2, scr, r, lane); return; } r -= I_G;
    if (r < I_D) { p0_item(ap->in[16], DFF, DM, (bf16*)(ws + WS_WD2), nullptr, 0, scr, r, lane); return; } r -= I_D;
    if (r < I_IN) { p0_item(ap->in[7], DM, 2208, (bf16*)(ws + WS_WIN), ap->in[6], 3, scr, r, lane); return; } r -= I_IN;
    if (r < I_UQ) { p0_item(ap->in[9], 384, 768, (bf16*)(ws + WS_WUQ), ap->in[8], 4, scr, r, lane); return; } r -= I_UQ;
    if (r < I_UKV) { p0_item(ap->in[11], 256, 1024, (bf16*)(ws + WS_WUKV), ap->in[10], 5, scr, r, lane); return; } r -= I_UKV;
    p0_item(ap->in[12], DM, DM, (bf16*)(ws + WS_WOUT), nullptr, 0, scr, r, lane);
}
__device__ __forceinline__ void p0_tables_and_zero(kargs_t ap, const int gt, const int NGT) {
    unsigned char* ws = ap->ws;
    const int* pos = (const int*)ap->in[1]; float* posf = (float*)(ws + WS_POSF); float* cosT = (float*)(ws + WS_COS); float* sinT = (float*)(ws + WS_SIN);
    for (int e = gt; e < S * 16; e += NGT) { const int s_ = e >> 4, i = e & 15; const float ang = (float)pos[s_] * ROPE_INV[i]; float sn, cs; sincosf(ang, &sn, &cs); cosT[e] = cs; sinT[e] = sn; if (i == 0) posf[s_] = (float)pos[s_]; }
    for (int e = gt; e < S / 64; e += NGT) { int m_ = pos[64 * e]; for (int j = 1; j < 64; ++j) m_ = max(m_, pos[64 * e + j]); posf[S + e] = (float)m_; }
    float* z = (float*)(ws + WS_SS2);
    for (int e = gt; e < 5 * S; e += NGT) z[e] = 0.f;
    float* km = (float*)(ws + WS_KMS);
    for (int e = gt; e < 64 * 512; e += NGT) km[e] = 0.f;
    unsigned* cnt = (unsigned*)(ws + WS_CNT);
    for (int e = gt; e < 512; e += NGT) cnt[e] = 0u;
    unsigned* padz = (unsigned*)((bf16*)(ws + WS_WIN) + (size_t)672 * DM);
    for (int e = gt; e < 96 * DM / 2; e += NGT) padz[e] = 0u;
}
__device__ __forceinline__ void p0_late_items(const Frame& F, kargs_t ap) {
    unsigned char* ws = ap->ws; MK_LAS float* scr = (MK_LAS float*)(F.lds + F.wave * 16384);
    const int w = ((int)blockIdx.x - 128) * NWAVES + F.wave, NW_ = 128 * NWAVES;
    for (int it = 2 * I_G + w; it < NITEMS; it += NW_) p0_one_item(ap, ws, scr, it, F.lane);
    p0_tables_and_zero(ap, w * 64 + F.lane, NW_ * 64);
}
__device__ __forceinline__ void p0_prologue(const Frame& F, kargs_t ap) {
    unsigned char* ws = ap->ws;
    MK_LAS float* scr = (MK_LAS float*)(F.lds + F.wave * 16384);
    const int gw = F.vcu * NWAVES + F.wave, NGW = F.G * NWAVES;
    constexpr int N_EARLY = 2 * I_G;
    const int n_here = (F.G == 256) ? N_EARLY : NITEMS;
    for (int it = gw; it < n_here; it += NGW) p0_one_item(ap, ws, scr, it, F.lane);
    const float* x = ap->in[0]; bf16* xb = (bf16*)(ws + WS_XB); float* ss1 = (float*)(ws + WS_SS1);
    for (int m = gw; m < S; m += 4 * NGW) {
        f32x4 v[4][4];
#pragma unroll
        for (int r = 0; r < 4; ++r) { const int mr = m + r * NGW; if (mr < S) { const f32x4* xr = (const f32x4*)(x + (size_t)mr * DM) + F.lane;
#pragma unroll
            for (int j = 0; j < 4; ++j) v[r][j] = xr[64 * j]; } }
#pragma unroll
        for (int r = 0; r < 4; ++r) { const int mr = m + r * NGW; if (mr < S) { unsigned long long* o8 = (unsigned long long*)(xb + (size_t)mr * DM) + F.lane; float s = 0.f;
#pragma unroll
            for (int j = 0; j < 4; ++j) { const f32x4 w = v[r][j]; s += (w[0] * w[0] + w[1] * w[1]) + (w[2] * w[2] + w[3] * w[3]); o8[64 * j] = (unsigned long long)pk2(w[0], w[1]) | ((unsigned long long)pk2(w[2], w[3]) << 32); }
            s = wave_sum(s); if (F.lane == 0) ss1[mr] = s; } }
    }
    if (F.G != 256) p0_tables_and_zero(ap, (F.vcu * NWAVES + F.wave) * 64 + F.lane, NGW * 64);
}

__device__ __forceinline__ void p4_krope(const Frame& F, kargs_t ap) { unsigned char* const wsb = ap->ws;
    const bf16* cqkv = (const bf16*)(wsb + WS_CQKV); bf16* Kr = (bf16*)(wsb + WS_KR); const float* cosT = (const float*)(wsb + WS_COS); const float* sinT = (const float*)(wsb + WS_SIN);
    const int gt = (F.vcu * NWAVES + F.wave) * 64 + F.lane, NGT = F.G * NWAVES * 64;
    for (int e = gt; e < S * 16; e += NGT) { const int s_ = e >> 4, i = e & 15, g = i >> 2, j = i & 3;
        const float x1 = bf2f(cqkv[(size_t)s_ * 768 + 640 + 8 * g + j]), x2 = bf2f(cqkv[(size_t)s_ * 768 + 640 + 8 * g + 4 + j]); const float c = cosT[e], sn = sinT[e];
        Kr[(size_t)s_ * 32 + 8 * g + j] = (bf16)f2bf(x1 * c - x2 * sn); Kr[(size_t)s_ * 32 + 8 * g + 4 + j] = (bf16)f2bf(x1 * sn + x2 * c); }
}
__device__ __forceinline__ void p4_gating(const Frame& F, kargs_t ap) { unsigned char* const wsb = ap->ws;
    const bf16* mqkv = (const bf16*)(wsb + WS_MQKV); const float* kms = (const float*)(wsb + WS_KMS); unsigned* cnt = (unsigned*)(wsb + WS_CNT); unsigned* lists = (unsigned*)(wsb + WS_LIST);
    MK_LAS float* km = (MK_LAS float*)F.lds;
    const int u0 = (F.G == 256) ? ((int)blockIdx.x < 192 ? (int)blockIdx.x : 256) : F.vcu, ustep = (F.G == 256) ? 192 : F.G;
    for (int u = u0; u < 256; u += ustep) {
        const int h = u & 7, q = (u >> 3) * 512 + F.tid, own = q >> 8;
        __syncthreads();
        for (int e = F.tid; e < 4096; e += 512) km[e] = kms[(size_t)(e >> 6) * 512 + h * 64 + (e & 63)] * (1.0f / 256.0f);
        __syncthreads();
        float qv[64];
        { const v4u* qp = (const v4u*)(mqkv + (size_t)q * 1536 + h * 64);
#pragma unroll
          for (int c = 0; c < 8; ++c) { const v4u w = qp[c];
#pragma unroll
              for (int j = 0; j < 4; ++j) { qv[8 * c + 2 * j] = __builtin_bit_cast(float, w[j] << 16); qv[8 * c + 2 * j + 1] = __builtin_bit_cast(float, w[j] & 0xFFFF0000u); } } }
        float g0 = -3e38f, g1 = -3e38f, g2 = -3e38f; int i0 = -1, i1 = -1, i2 = -1;
        const int own_max = __builtin_amdgcn_readfirstlane(own);
        for (int n = 0; n < own_max; ++n) {
            float g = 0.f;
#pragma unroll
            for (int c = 0; c < 16; ++c) { const f32x4 kk = *(const MK_LAS f32x4*)(km + n * 64 + 4 * c); g = fmaf(qv[4 * c], kk[0], g); g = fmaf(qv[4 * c + 1], kk[1], g); g = fmaf(qv[4 * c + 2], kk[2], g); g = fmaf(qv[4 * c + 3], kk[3], g); }
            if (g > g0) { g2 = g1; i2 = i1; g1 = g0; i1 = i0; g0 = g; i0 = n; }
            else if (g > g1) { g2 = g1; i2 = i1; g1 = g; i1 = n; }
            else if (g > g2) { g2 = g; i2 = n; }
        }
        MK_LAS unsigned* lcnt = (MK_LAS unsigned*)(F.lds + 16384);
        __syncthreads();
        if (F.tid < 64) lcnt[F.tid] = 0u;
        __syncthreads();
        unsigned r0 = 0u, r1 = 0u, r2 = 0u;
        if (i0 >= 0) r0 = __hip_atomic_fetch_add(lcnt + i0, 1u, __ATOMIC_RELAXED, __HIP_MEMORY_SCOPE_WORKGROUP);
        if (i1 >= 0) r1 = __hip_atomic_fetch_add(lcnt + i1, 1u, __ATOMIC_RELAXED, __HIP_MEMORY_SCOPE_WORKGROUP);
        if (i2 >= 0) r2 = __hip_atomic_fetch_add(lcnt + i2, 1u, __ATOMIC_RELAXED, __HIP_MEMORY_SCOPE_WORKGROUP);
        __syncthreads();
        if (F.tid < 64) { const unsigned c = lcnt[F.tid]; lcnt[64 + F.tid] = c ? atomicAdd(cnt + h * 64 + F.tid, c) : 0u; }
        __syncthreads();
        if (i0 >= 0) lists[(size_t)(h * 64 + i0) * S + lcnt[64 + i0] + r0] = (unsigned)(q | (0 << 14));
        if (i1 >= 0) lists[(size_t)(h * 64 + i1) * S + lcnt[64 + i1] + r1] = (unsigned)(q | (1 << 14));
        if (i2 >= 0) lists[(size_t)(h * 64 + i2) * S + lcnt[64 + i2] + r2] = (unsigned)(q | (2 << 14));
    }
    __syncthreads();
}
__device__ __forceinline__ void p5_combine(const Frame& F, kargs_t ap) { unsigned char* const wsb = ap->ws;
    const bf16* part = (const bf16*)ap->out;     const float* plse = (const float*)(wsb + WS_PLSE); bf16* cat = (bf16*)(wsb + WS_CAT);
    const int gt = (F.vcu * NWAVES + F.wave) * 64 + F.lane, NGT = F.G * NWAVES * 64;
    for (int e = gt; e < S * 8 * 8; e += NGT) { const int dg = e & 7, qh = e >> 3, q = qh >> 3, h = qh & 7; const int ns = 1 + min(3, q >> 8);
        const f32x4 ls = *(const f32x4*)(plse + (size_t)qh * 4);
        float M = ls[0]; for (int s = 1; s < 4; ++s) if (s < ns) M = fmaxf(M, ls[s]);
        float acc[8], wsum = 0.f;
#pragma unroll
        for (int j = 0; j < 8; ++j) acc[j] = 0.f;
#pragma unroll
        for (int s = 0; s < 4; ++s) if (s < ns) { const float w = __builtin_amdgcn_exp2f(ls[s] - M); wsum += w; const v4u v = *(const v4u*)(part + ((size_t)qh * 4 + s) * 64 + dg * 8);
#pragma unroll
            for (int j = 0; j < 4; ++j) { acc[2 * j] += w * __builtin_bit_cast(float, v[j] << 16); acc[2 * j + 1] += w * __builtin_bit_cast(float, v[j] & 0xFFFF0000u); } }
        const float r = 1.0f / wsum; v4u o; o.x = pk2(acc[0] * r, acc[1] * r); o.y = pk2(acc[2] * r, acc[3] * r); o.z = pk2(acc[4] * r, acc[5] * r); o.w = pk2(acc[6] * r, acc[7] * r);
        *(v4u*)(cat + (size_t)q * 1024 + 512 + h * 64 + dg * 8) = o; }
}
__device__ __forceinline__ void p9_final(const Frame& F, kargs_t ap) { unsigned char* const wsb = ap->ws;
    const float* ss = (const float*)(wsb + WS_SS4); const float* g = ap->in[17];
    const int gw = F.vcu * NWAVES + F.wave, NGW = F.G * NWAVES;
    float tsc = 1.0f;
#ifdef MK_TS
    { const unsigned long long* ts = (const unsigned long long*)(wsb + 2048); tsc = 1.0f + (float)(ts[MK_TS + 1] - ts[MK_TS]) * (float)MK_TS_SCALE; }
#endif
    for (int m = gw; m < S; m += NGW) { const float rs = tsc / sqrtf(ss[m] * (1.0f / 1024.0f) + 1e-6f); f32x4* xr = (f32x4*)(ap->out + (size_t)m * DM) + F.lane; const f32x4* gr = (const f32x4*)g + F.lane;
#pragma unroll
        for (int j = 0; j < 4; ++j) { const f32x4 v = xr[64 * j]; xr[64 * j] = v * rs * gr[64 * j]; } }
}

__global__ void __launch_bounds__(NWAVES * 64, 2) mk_fwd(Args a_unused) {
    extern __shared__ __attribute__((aligned(16))) unsigned char lds[];
    const int wave = __builtin_amdgcn_readfirstlane(threadIdx.x >> 6);
    MK_LAS unsigned char* const ldsp = (MK_LAS unsigned char*)lds;
    int lo, hi; { kargs_t ap = kargs(); lo = ap->ph_lo; hi = ap->ph_hi; }
#ifndef MK_ONLY
#define MK_ONLY -1
#endif
#define IN(k) ((MK_ONLY < 0 || MK_ONLY == (k)) && lo <= (k) && (k) < hi)
    const bool multi = (hi - lo) > 1;
    if (multi) {
        const int l0 = pg8::lane_id_v();
        if (wave == 0 && l0 < 2) ((volatile MK_LAS unsigned*)(ldsp + LDS_MISC))[l0] = 0u;
        __syncthreads();
        kargs_t ap = kargs(); (void)xb::xcd_barrier_post((unsigned*)(ap->ws + WS_BAR), (volatile MK_LAS unsigned*)(ldsp + LDS_MISC), wave == 0 && l0 == 0);
    }
    if (lo < -1) cg::this_grid().sync();
#ifdef MK_TS
#define MK_STAMP(i) do { if (blockIdx.x == 0 && wave == 0 && pg8::lane_id_v() == 0) { kargs_t ap__ = kargs(); ((unsigned long long*)(ap__->ws + 2048))[(i)] = __builtin_amdgcn_s_memrealtime(); } } while (0)
#else
#define MK_STAMP(i) do { } while (0)
#endif
    MK_STAMP(0);
#define SEAM(k) do { if (IN(k) && IN((k) + 1)) { kargs_t ap_ = kargs(); xb::XcdBarrier b_; b_.bar = (unsigned*)(ap_->ws + WS_BAR); b_.x = xb::xb_xcc_id(); b_.st = (volatile MK_LAS unsigned*)(ldsp + LDS_MISC); \
        xb::xcd_barrier(b_, wave == 0 && pg8::lane_id_v() == 0); MK_STAMP((k) + 1); } } while (0)
    if (IN(0)) { kargs_t ap = kargs(); const Frame F = mkframe(ldsp, wave); p0_prologue(F, ap); } SEAM(0);
    if (IN(1)) { kargs_t ap = kargs(); unsigned char* ws = ap->ws; pg8::Gemm g{(const bf16*)(ws + WS_XB), (const bf16*)(ws + WS_WGU1), S, NGU, DM, DM}; pg8::StaticOrder So; So.init(S, NGU, (int)gridDim.x, (int)blockIdx.x);
        pg8::EpiSwiGLU E{ws, 0}; pg8::gemm_phase<pg8::EpiSwiGLU, pg8::StaticOrder, true, true>(ldsp, g, So, E, wave);
        if (gridDim.x == 256 && blockIdx.x >= 128) { kargs_t ap2 = kargs(); const Frame F = mkframe(ldsp, wave); __syncthreads(); p0_late_items(F, ap2); } } SEAM(1);
    if (IN(2)) { kargs_t ap = kargs(); unsigned char* ws = ap->ws; pg8::Gemm g{(const bf16*)(ws + WS_ACT), (const bf16*)(ws + WS_WD1), S, DM, DFF, DFF}; pg8::StaticOrder So; So.init(S, DM, (int)gridDim.x, (int)blockIdx.x);
        pg8::EpiResid E{nullptr, ws, (int)WS_SS2, 0.5f}; pg8::gemm_phase<pg8::EpiResid, pg8::StaticOrder, true, true>(ldsp, g, So, E, wave); } SEAM(2);
    if (IN(3)) { kargs_t ap = kargs(); unsigned char* ws = ap->ws; pg8::Gemm g{(const bf16*)(ws + WS_XB), (const bf16*)(ws + WS_WIN), S, NWIN, DM, DM}; pg8::StaticOrder So; So.init(S, gridDim.x == 256 ? NWIN - 256 : NWIN, (int)gridDim.x, (int)blockIdx.x);
        pg8::EpiWin E{ws, 0}; pg8::gemm_phase<pg8::EpiWin, pg8::StaticOrder, true, true>(ldsp, g, So, E, wave); } SEAM(3);
    if (IN(4)) {
        { kargs_t ap = kargs(); unsigned char* ws = ap->ws; pg8::Gemm g{(const bf16*)(ws + WS_CQKV) + 384, (const bf16*)(ws + WS_WUKV), S, 1024, 256, 768}; pg8::StaticOrder So; So.init(S, 1024, (int)gridDim.x, (int)blockIdx.x);
          pg8::EpiKV E{ws}; pg8::gemm_phase<pg8::EpiKV, pg8::StaticOrder, true, true>(ldsp, g, So, E, wave); }
        { kargs_t ap = kargs(); unsigned char* ws = ap->ws; pg8::Gemm g{(const bf16*)(ws + WS_CQKV), (const bf16*)(ws + WS_WUQ), S, 768, 384, 768}; pg8::StaticOrder So; So.init(S, 768, (int)gridDim.x, (int)blockIdx.x);
          pg8::EpiQ E{ws}; pg8::gemm_phase<pg8::EpiQ, pg8::StaticOrder, true, true>(ldsp, g, So, E, wave); }
        if (gridDim.x == 256) { kargs_t ap = kargs(); unsigned char* ws = ap->ws; pg8::Gemm g{(const bf16*)(ws + WS_XB), (const bf16*)(ws + WS_WIN), S, NWIN, DM, DM}; pg8::TailOrder So; So.init(S, 8, (int)gridDim.x, (int)blockIdx.x);
          pg8::EpiWin E{ws, 0}; pg8::gemm_phase<pg8::EpiWin, pg8::TailOrder, true, true>(ldsp, g, So, E, wave); }
        { kargs_t ap = kargs(); const Frame F = mkframe(ldsp, wave); p4_krope(F, ap); }
#ifndef MK_NO_GATE
        { kargs_t ap = kargs(); const Frame F = mkframe(ldsp, wave); p4_gating(F, ap); }
#endif
    } SEAM(4);
#ifndef MK_NO_ATT5
    if (IN(5)) {
        kargs_t ap = kargs(); unsigned char* ws = ap->ws; const Frame F = mkframe(ldsp, wave);
        MK_LAS int* pre = (MK_LAS int*)(ldsp + att::MB_PRE);
        const unsigned* cnt = (const unsigned*)(ws + WS_CNT);
        __syncthreads();
        { const int c = (int)cnt[F.tid]; pre[F.tid] = (c + 255) >> 8; }
        __syncthreads();
        for (int o = 1; o < 512; o <<= 1) { const int v = pre[F.tid] + (F.tid >= o ? pre[F.tid - o] : 0); __syncthreads(); pre[F.tid] = v; __syncthreads(); }
        att::MobaCtx C; C.mqkv = (const bf16*)(ws + WS_MQKV); C.posf = (const float*)(ws + WS_POSF); C.part = (bf16*)ap->out; C.plse = (float*)(ws + WS_PLSE);
        C.lists = (const unsigned*)(ws + WS_LIST); C.cnt = cnt; C.total = pre[511]; C.vcu = F.vcu; C.G = F.G;
        att::moba_run<0>(C, (char*)lds, wave);
#ifdef MK_PROBE5
        __syncthreads(); C.part = (bf16*)(ws + WS_CQKV); C.plse = (float*)(ws + WS_CQKV + (16u << 20)); att::moba_run<MK_PROBE5>(C, (char*)lds, wave);
#endif
    }
#endif
    SEAM(5);
    if (IN(6)) {
        { kargs_t ap = kargs(); const Frame F = mkframe(ldsp, wave); p5_combine(F, ap); }
#ifndef MK_NO_ATT6
        kargs_t ap = kargs(); unsigned char* ws = ap->ws; const Frame F = mkframe(ldsp, wave);
        att::Unit U; U.posf = nullptr; U.part = nullptr; U.plse = nullptr; U.list = nullptr; U.len = 0; U.slope2 = 0.f; U.q_pitch = 768; U.k_pitch = 512; U.v_pitch = 512; U.o_pitch = 1024; U.key0 = 0; U.Kr = (const bf16*)(ws + WS_KR);
        for (int v = F.vcu; v < 256; v += F.G) { const int h = v >> 5, s_ = v & 31;
            for (int i = 0; i < 2; ++i) { const int qb = i == 0 ? 63 - s_ : s_;
                U.h = h; U.Q = (const bf16*)(ws + WS_Q) + h * 96; U.K = (const bf16*)(ws + WS_KN) + h * 64; U.V = (const bf16*)(ws + WS_V) + h * 64; U.O = (bf16*)(ws + WS_CAT) + h * 64; U.q0 = qb * 256; U.ntiles = 4 * (qb + 1);
                att::unit<0>(U, (char*)lds, wave); } }
#endif
    } SEAM(6);
    if (IN(7)) { kargs_t ap = kargs(); unsigned char* ws = ap->ws; pg8::Gemm g{(const bf16*)(ws + WS_CAT), (const bf16*)(ws + WS_WOUT), S, DM, DM, DM}; pg8::StaticOrder So; So.init(S, DM, (int)gridDim.x, (int)blockIdx.x);
        pg8::EpiResid E{nullptr, ws, (int)WS_SS3, 1.0f}; pg8::gemm_phase<pg8::EpiResid, pg8::StaticOrder, true, true>(ldsp, g, So, E, wave); } SEAM(7);
    if (IN(8)) { kargs_t ap = kargs(); unsigned char* ws = ap->ws; pg8::Gemm g{(const bf16*)(ws + WS_XB), (const bf16*)(ws + WS_WGU2), S, NGU, DM, DM}; pg8::StaticOrder So; So.init(S, NGU, (int)gridDim.x, (int)blockIdx.x);
        pg8::EpiSwiGLU E{ws, 1}; pg8::gemm_phase<pg8::EpiSwiGLU, pg8::StaticOrder, true, true>(ldsp, g, So, E, wave); } SEAM(8);
    if (IN(9)) { kargs_t ap = kargs(); unsigned char* ws = ap->ws; pg8::Gemm g{(const bf16*)(ws + WS_ACT), (const bf16*)(ws + WS_WD2), S, DM, DFF, DFF}; pg8::StaticOrder So; So.init(S, DM, (int)gridDim.x, (int)blockIdx.x);
        if (gridDim.x == 256) { pg8::EpiResidNorm E{ap->out, ws, ap->in[17], 0.5f}; pg8::gemm_phase<pg8::EpiResidNorm, pg8::StaticOrder, false, true>(ldsp, g, So, E, wave); }
        else { pg8::EpiResid E{ap->out, ws, (int)WS_SS4, 0.5f}; pg8::gemm_phase<pg8::EpiResid, pg8::StaticOrder, true, true>(ldsp, g, So, E, wave); } }
    if (gridDim.x != 256) SEAM(9);
    if (IN(10) && gridDim.x != 256) { kargs_t ap = kargs(); const Frame F = mkframe(ldsp, wave); p9_final(F, ap); }
#undef IN
#undef SEAM
}
constexpr int N_PHASES = 11;
}
#ifndef MK_BRINGUP
#define MK_BRINGUP 0
#endif
extern "C" void kernel_launch(void* const* d_in, const int* in_sizes, int n_in, void* d_out, int out_size, void* d_ws, size_t ws_size, hipStream_t stream) {
    static int grid = 0;
    if (grid == 0) {
        if (hipFuncSetAttribute((const void*)mk::mk_fwd, hipFuncAttributeMaxDynamicSharedMemorySize, mk::LDS_BYTES) != hipSuccess) { fprintf(stderr, "kernel_launch: hipFuncSetAttribute failed\n"); grid = -1; return; }
        int dev = 0, cus = 0, per_cu = 0;
        hipGetDevice(&dev); hipDeviceGetAttribute(&cus, hipDeviceAttributeMultiprocessorCount, dev);
        hipOccupancyMaxActiveBlocksPerMultiprocessor(&per_cu, (const void*)mk::mk_fwd, mk::NWAVES * 64, mk::LDS_BYTES);
        (void)hipGetLastError();
        grid = cus * (per_cu < 1 ? 1 : (per_cu > 1 ? 1 : per_cu));
        if (grid % 8 != 0 || grid <= 0) grid = 256;
        if (ws_size < mk::WS_END) { fprintf(stderr, "kernel_launch: workspace too small (%zu)\n", ws_size); grid = -1; return; }
    }
    if (grid < 0) return;
    mk::Args a{};
    for (int i = 0; i < 18; ++i) a.in[i] = (const float*)d_in[i];
    a.out = (float*)d_out; a.ws = (unsigned char*)d_ws;
#if MK_BRINGUP == 0
    if (hipMemsetAsync((char*)d_ws + mk::WS_BAR, 0, mk::BAR_BYTES, stream) != hipSuccess) { fprintf(stderr, "kernel_launch: memset failed\n"); return; }
    a.ph_lo = 0; a.ph_hi = mk::N_PHASES;
    void* args[] = {&a};
    hipError_t e = hipLaunchCooperativeKernel((const void*)mk::mk_fwd, dim3(grid), dim3(mk::NWAVES * 64), args, mk::LDS_BYTES, stream);
    if (e != hipSuccess) fprintf(stderr, "cooperative launch failed: %s (grid %d)\n", hipGetErrorString(e), grid);
#else
    const int nph = MK_BRINGUP == 1 ? 3 : MK_BRINGUP == 2 ? 8 : mk::N_PHASES;
    for (int ph = 0; ph < nph; ++ph) { a.ph_lo = ph; a.ph_hi = ph + 1; hipLaunchKernelGGL(mk::mk_fwd, dim3(grid), dim3(mk::NWAVES * 64), mk::LDS_BYTES, stream, a); }
#if MK_BRINGUP == 1
    nv::part_mix(d_in, (float*)d_out, d_ws, stream); nv::part_ffn2_final(d_in, (float*)d_out, d_ws, stream);
#elif MK_BRINGUP == 2
    nv::part_ffn2_final(d_in, (float*)d_out, d_ws, stream);
#endif
#endif
}
```

```cpp
#define MK_BRINGUP 0
#include <hip/hip_runtime.h>
#include <cstdio>
#include <cstdint>
#include <cmath>
#include <hip/hip_cooperative_groups.h>
namespace cg = cooperative_groups;

namespace mkc {
constexpr int S = 16384, DM = 1024, DFF = 2816, NGU = 2 * DFF, NWIN = 2304;
constexpr float LOG2E = 1.4426950408889634f;
constexpr float C2Q = 0.10206207261596577f * LOG2E;
constexpr float C2M = 0.125f * LOG2E;
constexpr size_t MiB = 1u << 20;
constexpr size_t WS_PANEL = 4096 + 16384;
constexpr size_t WS_CNT = 0;
constexpr size_t WS_SS1 = 1 * MiB, WS_SS2 = WS_SS1 + 65536, WS_SSQ = WS_SS2 + 65536, WS_SSKV = WS_SSQ + 65536, WS_SS3 = WS_SSKV + 65536, WS_SS4 = WS_SS3 + 65536;
constexpr size_t WS_KMS = WS_SS1 + 512 * 1024;
constexpr size_t WS_SSDUMMY = WS_SS1 + 384 * 1024, WS_KMSDUMMY = WS_SS1 + 640 * 1024;
constexpr size_t WS_POSF = 2 * MiB, WS_COS = 3 * MiB, WS_SIN = 4 * MiB;
constexpr size_t WS_WGU1 = 6 * MiB, WS_WD1 = 17 * MiB, WS_WGU2 = WS_WD1 + 5632 * 1024, WS_WD2 = WS_WGU2 + 11 * MiB, WS_WIN = 39 * MiB, WS_WUQ = WS_WIN + 4608 * 1024, WS_WUKV = WS_WUQ + 768 * 1024, WS_WOUT = 45 * MiB;
constexpr size_t WS_XB = 48 * MiB, WS_CQKV = 80 * MiB, WS_PLSE = 112 * MiB;
constexpr size_t WS_ACT = 114 * MiB, WS_MQKV = 114 * MiB, WS_CAT = 114 * MiB, WS_Q = 162 * MiB, WS_KN = 186 * MiB, WS_V = 202 * MiB, WS_KR = 218 * MiB, WS_LIST = 220 * MiB, WS_END = 252 * MiB;
static_assert(WS_WD2 + 5632 * 1024 <= WS_WIN && WS_WUKV + 512 * 1024 <= WS_WOUT && WS_WOUT + 2 * MiB <= WS_XB, "weight map");
}
namespace pg8 {
#define PG8_LAS __attribute__((address_space(3)))
typedef unsigned short bf16_t;
typedef short bf16x8 __attribute__((ext_vector_type(8)));
typedef float f32x4 __attribute__((ext_vector_type(4)));
typedef unsigned u32x4 __attribute__((ext_vector_type(4)));
__device__ __forceinline__ int lane_id_v() { int l; asm volatile("v_mbcnt_lo_u32_b32 %0, -1, 0\n\tv_mbcnt_hi_u32_b32 %0, -1, %0" : "=v"(l)); return l; }
constexpr int BM = 256, BK = 64, HALF = 128, HTB = HALF * BK * 2  , STAGE_BYTES = 8 * HTB, NXCD = 8, WGM = 4;

__host__ __device__ __forceinline__ int lds_byte(int r, int c) { const int st = (r >> 4) * 2 + (c >> 5), rr = r & 15, cc = c & 31, ob = rr * 64 + cc * 2; return st * 1024 + (ob ^ (((ob >> 9) & 1) << 5)); }
__host__ __device__ __forceinline__ void stage_rc(int b, int& R, int& C) { const int st = b / 1024, sb = b % 1024, swz = sb ^ (((sb >> 9) & 1) << 5); R = (st >> 1) * 16 + swz / 64; C = (st & 1) * 32 + (swz % 64) / 2; }
__host__ __device__ __forceinline__ int perm32(int rho) { const int n = rho >> 4, i = rho & 15; return 8 * (i >> 2) + 4 * n + (i & 3); }

struct Unit { int pm, pn; };
struct Gemm { const bf16_t* A; const bf16_t* Bt; int M, N, K, lda; };

struct StaticOrder {
    int nM, nN, nwg, G, c;
    __host__ __device__ void init(int M, int N, int G_, int c_) { nM = M / BM; nN = N / BM; nwg = nM * nN; G = G_; c = c_; }
    __host__ __device__ bool next(int i, Unit& u) const {
        const long L = (long)i * G + c; if (L >= nwg) return false;
        int wgid = (int)L; { const int q = nwg / NXCD, r = nwg % NXCD, xcd = wgid % NXCD, off = wgid / NXCD; wgid = (xcd < r ? xcd * (q + 1) : r * (q + 1) + (xcd - r) * q) + off; }
        const int nig = WGM * nN, gid = wgid / nig, fm = gid * WGM, gsz = (nM - fm) < WGM ? (nM - fm) : WGM;
        u.pm = fm + ((wgid % nig) % gsz); u.pn = (wgid % nig) / gsz; return true;
    }
    __device__ __forceinline__ void a_ready(const Unit&) const {}
    __device__ __forceinline__ void done(const Unit&) const {}
};
struct TailOrder {
    int nM, pn, G, c;
    __host__ __device__ void init(int M, int pn_, int G_, int c_) { nM = M / BM; pn = pn_; G = G_; c = c_; }
    __host__ __device__ bool next(int i, Unit& u) const { const int j = c - (G - nM); if (i != 0 || j < 0 || j >= nM) return false; u.pm = j; u.pn = pn; return true; }
    __device__ __forceinline__ void a_ready(const Unit&) const {}
    __device__ __forceinline__ void done(const Unit&) const {}
};
__device__ __forceinline__ unsigned cvt_pk_bf16(float lo, float hi) { unsigned r; asm volatile("v_cvt_pk_bf16_f32 %0, %1, %2" : "=v"(r) : "v"(lo), "v"(hi)); return r; }
typedef unsigned u32x2 __attribute__((ext_vector_type(2)));
constexpr float RMS_EPS = 1e-6f;
__device__ __forceinline__ float rs_of(const float* ss, int row, float invn) { return __builtin_amdgcn_rsqf(ss[row] * invn + RMS_EPS); }
__device__ __forceinline__ float silu_f(float g) { return g * __builtin_amdgcn_rcpf(1.0f + __builtin_amdgcn_exp2f(-1.4426950408889634f * g)); }
__device__ __forceinline__ u32x4 pack8(const f32x4 a, const f32x4 b) { u32x4 w; w.x = cvt_pk_bf16(a[0], a[1]); w.y = cvt_pk_bf16(a[2], a[3]); w.z = cvt_pk_bf16(b[0], b[1]); w.w = cvt_pk_bf16(b[2], b[3]); return w; }

struct EpiSwiGLU {
    static constexpr bool PERM = true, AFTER_DRAIN = false;
    unsigned char* ws; int which;
    __device__ __forceinline__ void operator()(const f32x4 (&acc)[2][2][4][2], const Unit& u, int wr, int wc, int fr, int fq) const {
        bf16_t* O = (bf16_t*)(ws + mkc::WS_ACT); const int ldo = mkc::DFF; const float* ss = (const float*)(ws + (which ? mkc::WS_SS3 : mkc::WS_SS1)); const float invn = 1.0f / 1024.0f;
        const int row0 = u.pm * BM + wr * 64 + fr, col0 = u.pn * HALF + wc * 32 + 8 * fq;
#pragma unroll
        for (int ai = 0; ai < 2; ++ai)
#pragma unroll
            for (int m = 0; m < 4; ++m) { const int row = row0 + ai * HALF + m * 16; const float rs = rs_of(ss, row, invn);
                f32x4 a0, a1;
#pragma unroll
                for (int j = 0; j < 4; ++j) { a0[j] = silu_f(acc[ai][0][m][0][j] * rs) * (acc[ai][1][m][0][j] * rs); a1[j] = silu_f(acc[ai][0][m][1][j] * rs) * (acc[ai][1][m][1][j] * rs); }
                *(u32x4*)(O + (size_t)row * ldo + col0) = pack8(a0, a1); }
    }
};
__device__ __forceinline__ f32x4 bf4_to_f32(const u32x2 w) { f32x4 r; r[0] = __builtin_bit_cast(float, w.x << 16); r[1] = __builtin_bit_cast(float, w.x & 0xFFFF0000u); r[2] = __builtin_bit_cast(float, w.y << 16); r[3] = __builtin_bit_cast(float, w.y & 0xFFFF0000u); return r; }
struct EpiResid {
    static constexpr bool PERM = false, AFTER_DRAIN = false;
    float* out; unsigned char* ws; int ss_off; float alpha;
    __device__ __forceinline__ void operator()(const f32x4 (&acc)[2][2][4][2], const Unit& u, int wr, int wc, int fr, int fq) const {
        bf16_t* xb = (bf16_t*)(ws + mkc::WS_XB); float* ss_out = (float*)(ws + ss_off);
        const int row0 = u.pm * BM + wr * 64 + fr, col0 = u.pn * BM + wc * 32 + 4 * fq;
#pragma unroll
        for (int ai = 0; ai < 2; ++ai)
#pragma unroll
            for (int m = 0; m < 4; ++m) { const int row = row0 + ai * HALF + m * 16; const size_t off = (size_t)row * 1024 + col0; float s = 0.f;
#pragma unroll
                for (int bj = 0; bj < 2; ++bj)
#pragma unroll
                    for (int n = 0; n < 2; ++n) { const f32x4 b = bf4_to_f32(*(const u32x2*)(xb + off + bj * HALF + n * 16)); const f32x4 o = b + acc[ai][bj][m][n] * alpha;
                        if (out) *(f32x4*)(out + off + bj * HALF + n * 16) = o;
                        s += (o[0] * o[0] + o[1] * o[1]) + (o[2] * o[2] + o[3] * o[3]);
                        u32x2 w; w.x = cvt_pk_bf16(o[0], o[1]); w.y = cvt_pk_bf16(o[2], o[3]); *(u32x2*)(xb + off + bj * HALF + n * 16) = w; }
                s += __shfl_xor(s, 16); s += __shfl_xor(s, 32);
                if (fq == 0) atomicAdd(ss_out + row, s);
                asm volatile("" ::: "memory"); }
    }
};
struct EpiWin {
    static constexpr bool PERM = true, AFTER_DRAIN = false;
    unsigned char* ws; int dummy;
    __device__ __forceinline__ void operator()(const f32x4 (&acc)[2][2][4][2], const Unit& u, int wr, int wc, int fr, int fq) const {
        bf16_t* cqkv = (bf16_t*)(ws + mkc::WS_CQKV); bf16_t* mqkv = (bf16_t*)(ws + mkc::WS_MQKV); const float* ss_in = (const float*)(ws + mkc::WS_SS2);
        float* ssq = (float*)(ws + (dummy ? mkc::WS_SSDUMMY : mkc::WS_SSQ)); float* sskv = (float*)(ws + (dummy ? mkc::WS_SSDUMMY + 65536 : mkc::WS_SSKV)); float* kmsum = (float*)(ws + (dummy ? mkc::WS_KMSDUMMY : mkc::WS_KMS));
        const int row0 = u.pm * BM + wr * 64 + fr;
        const bool is_mk = (u.pn == 5 || u.pn == 6);
        f32x4 cs[2][2];
#pragma unroll
        for (int bj = 0; bj < 2; ++bj)
#pragma unroll
            for (int n = 0; n < 2; ++n) cs[bj][n] = (f32x4){0.f, 0.f, 0.f, 0.f};
#pragma unroll
        for (int ai = 0; ai < 2; ++ai)
#pragma unroll
            for (int m = 0; m < 4; ++m) { const int row = row0 + ai * HALF + m * 16; const float rs = rs_of(ss_in, row, 1.0f / 1024.0f);
#pragma unroll
                for (int bj = 0; bj < 2; ++bj) { const int colt = u.pn * BM + bj * HALF, col0 = colt + wc * 32 + 8 * fq;
                    const f32x4 v0 = acc[ai][bj][m][0] * rs, v1 = acc[ai][bj][m][1] * rs;
                    bf16_t* dst = (colt < 768) ? (cqkv + (size_t)row * 768 + col0) : (mqkv + (size_t)row * 1536 + (col0 - 768));
                    *(u32x4*)dst = pack8(v0, v1);
                    if (colt < 640) { float s = (v0[0] * v0[0] + v0[1] * v0[1]) + (v0[2] * v0[2] + v0[3] * v0[3]) + (v1[0] * v1[0] + v1[1] * v1[1]) + (v1[2] * v1[2] + v1[3] * v1[3]);
                        s += __shfl_xor(s, 16); s += __shfl_xor(s, 32);
                        if (fq == 0) atomicAdd((colt < 384 ? ssq : sskv) + row, s); }
                    if (is_mk) { cs[bj][0] += v0; cs[bj][1] += v1; } } }
        if (is_mk) {
#pragma unroll
            for (int bj = 0; bj < 2; ++bj)
#pragma unroll
                for (int n = 0; n < 2; ++n)
#pragma unroll
                    for (int j = 0; j < 4; ++j) { float s = cs[bj][n][j]; s += __shfl_xor(s, 1); s += __shfl_xor(s, 2); s += __shfl_xor(s, 4); s += __shfl_xor(s, 8);
                        if (fr == 0) atomicAdd(kmsum + (size_t)u.pm * 512 + (u.pn * BM + bj * HALF + wc * 32 + 8 * fq + 4 * n + j - 1280), s); }
        }
    }
};
struct EpiKV {
    static constexpr bool PERM = true, AFTER_DRAIN = false;
    unsigned char* ws;
    __device__ __forceinline__ void operator()(const f32x4 (&acc)[2][2][4][2], const Unit& u, int wr, int wc, int fr, int fq) const {
        bf16_t* Kn = (bf16_t*)(ws + mkc::WS_KN); bf16_t* V = (bf16_t*)(ws + mkc::WS_V); const float* ss = (const float*)(ws + mkc::WS_SSKV);
        const int row0 = u.pm * BM + wr * 64 + fr;
#pragma unroll
        for (int ai = 0; ai < 2; ++ai)
#pragma unroll
            for (int m = 0; m < 4; ++m) { const int row = row0 + ai * HALF + m * 16; const float rs = rs_of(ss, row, 1.0f / 256.0f);
#pragma unroll
                for (int bj = 0; bj < 2; ++bj) { const int colt = u.pn * BM + bj * HALF, col0 = colt + wc * 32 + 8 * fq;
                    bf16_t* dst = (colt < 512) ? (Kn + (size_t)row * 512 + col0) : (V + (size_t)row * 512 + (col0 - 512));
                    *(u32x4*)dst = pack8(acc[ai][bj][m][0] * rs, acc[ai][bj][m][1] * rs); } }
    }
};
struct EpiQ {
    static constexpr bool PERM = true, AFTER_DRAIN = false;
    unsigned char* ws;
    __device__ __forceinline__ void operator()(const f32x4 (&acc)[2][2][4][2], const Unit& u, int wr, int wc, int fr, int fq) const {
        bf16_t* Q = (bf16_t*)(ws + mkc::WS_Q); const float* ss = (const float*)(ws + mkc::WS_SSQ); const float* cosT = (const float*)(ws + mkc::WS_COS); const float* sinT = (const float*)(ws + mkc::WS_SIN);
        const int row0 = u.pm * BM + wr * 64 + fr;
#pragma unroll
        for (int ai = 0; ai < 2; ++ai)
#pragma unroll
            for (int m = 0; m < 4; ++m) { const int row = row0 + ai * HALF + m * 16; const float rs = rs_of(ss, row, 1.0f / 384.0f);
#pragma unroll
                for (int bj = 0; bj < 2; ++bj) { const int col0 = u.pn * BM + bj * HALF + wc * 32 + 8 * fq; const int d = col0 % 96;
                    f32x4 v0 = acc[ai][bj][m][0] * rs, v1 = acc[ai][bj][m][1] * rs;
                    if (d >= 64) { const int g = (d - 64) >> 3; const f32x4 c = *(const f32x4*)(cosT + (size_t)row * 16 + 4 * g), s = *(const f32x4*)(sinT + (size_t)row * 16 + 4 * g);
                        const f32x4 o0 = v0 * c - v1 * s, o1 = v0 * s + v1 * c; v0 = o0; v1 = o1; }
                    *(u32x4*)(Q + (size_t)row * 768 + col0) = pack8(v0, v1); }
                asm volatile("" ::: "memory"); }
    }
};
struct EpiResidNorm {
    static constexpr bool PERM = false, AFTER_DRAIN = true;
    float* out; unsigned char* ws; const float* gain; float alpha;
    __device__ __forceinline__ void fused(f32x4 (&acc)[2][2][4][2], const Unit& u, int wr, int wc, int fr, int fq, PG8_LAS unsigned char* lds, int wid, int lane) const {
        float* ss = (float*)(ws + mkc::WS_SS4); unsigned* pcnt = (unsigned*)(ws + mkc::WS_PANEL) + 64 * u.pm; const bf16_t* xb = (const bf16_t*)(ws + mkc::WS_XB);
        const int row0 = u.pm * BM + wr * 64 + fr, col0 = u.pn * BM + wc * 32 + 4 * fq;
#pragma unroll
        for (int ai = 0; ai < 2; ++ai)
#pragma unroll
            for (int m = 0; m < 4; ++m) { const int row = row0 + ai * HALF + m * 16; const size_t off = (size_t)row * 1024 + col0; float s = 0.f;
#pragma unroll
                for (int bj = 0; bj < 2; ++bj)
#pragma unroll
                    for (int n = 0; n < 2; ++n) { const f32x4 b = bf4_to_f32(*(const u32x2*)(xb + off + bj * HALF + n * 16)); const f32x4 o = b + acc[ai][bj][m][n] * alpha; acc[ai][bj][m][n] = o;
                        s += (o[0] * o[0] + o[1] * o[1]) + (o[2] * o[2] + o[3] * o[3]); }
                s += __shfl_xor(s, 16); s += __shfl_xor(s, 32);
                if (fq == 0) atomicAdd(ss + row, s);
                asm volatile("" : "+v"(acc[ai][0][m][0]), "+v"(acc[ai][0][m][1]), "+v"(acc[ai][1][m][0]), "+v"(acc[ai][1][m][1]));
                if (m & 1) asm volatile("" ::: "memory"); }
        asm volatile("s_waitcnt vmcnt(0)" ::: "memory"); __builtin_amdgcn_s_barrier(); asm volatile("" ::: "memory");
        if (wid == 0) {
            if (lane == 0) { __builtin_amdgcn_fence(__ATOMIC_RELEASE, "agent"); asm volatile("s_waitcnt vmcnt(0)" ::: "memory"); __hip_atomic_fetch_add(pcnt, 1u, __ATOMIC_RELAXED, __HIP_MEMORY_SCOPE_AGENT); }
            unsigned spins = 0;
            while ((unsigned)__builtin_amdgcn_readfirstlane(__hip_atomic_load(pcnt, __ATOMIC_RELAXED, __HIP_MEMORY_SCOPE_AGENT)) < 4u) { __builtin_amdgcn_s_sleep(2); if (++spins > (1u << 22)) break; }
            __builtin_amdgcn_fence(__ATOMIC_ACQUIRE, "agent");
        }
        asm volatile("s_waitcnt vmcnt(0) lgkmcnt(0)" ::: "memory"); __builtin_amdgcn_s_barrier(); asm volatile("" ::: "memory");
        f32x4 gv[2][2];
#pragma unroll
        for (int bj = 0; bj < 2; ++bj)
#pragma unroll
            for (int n = 0; n < 2; ++n) gv[bj][n] = *(const f32x4*)(gain + col0 + bj * HALF + n * 16);
#pragma unroll
        for (int ai = 0; ai < 2; ++ai)
#pragma unroll
            for (int m = 0; m < 4; ++m) { const int row = row0 + ai * HALF + m * 16; const size_t off = (size_t)row * 1024 + col0;
                const float tot = __hip_atomic_load(ss + row, __ATOMIC_RELAXED, __HIP_MEMORY_SCOPE_AGENT); const float rs = __builtin_amdgcn_rsqf(tot * (1.0f / 1024.0f) + RMS_EPS);
#pragma unroll
                for (int bj = 0; bj < 2; ++bj)
#pragma unroll
                    for (int n = 0; n < 2; ++n) *(f32x4*)(out + off + bj * HALF + n * 16) = acc[ai][bj][m][n] * rs * gv[bj][n]; }
    }
};

template <class Epi, class Sched, bool ALIGN_EPI = false, bool SP2 = false>
__device__ __forceinline__ void gemm_phase(PG8_LAS unsigned char* lds, const Gemm g, const Sched& S, const Epi& E, const int wid) {
    const int lane = lane_id_v(), tid = wid * 64 + lane, wr = wid >> 2, wc = wid & 3, fr = lane & 15, fq = lane >> 4;
    const int K = g.K, nt = K / BK, lda = g.lda;
    unsigned voffA[2], voffB[2];
#pragma unroll
    for (int i = 0; i < 2; ++i) { int R, C; stage_rc(tid * 16 + i * 8192, R, C); const int Rb = Epi::PERM ? ((R & ~31) + perm32(R & 31)) : R;
        voffA[i] = (unsigned)(R * lda + C) * 2u; voffB[i] = (unsigned)(Rb * K + C) * 2u; }
    const size_t kstep = (size_t)(BK * 2);
    const size_t hstep = (size_t)HALF * K * 2;
    const size_t tstep = 2 * hstep; const size_t hstepA = (size_t)HALF * lda * 2, tstepA = 2 * hstepA;
    const unsigned ldsw = (unsigned)wid * 1024u;
    const int aoff = lds_byte(wr * 64 + fr, fq * 8), boff = lds_byte(wc * 32 + fr, fq * 8);
#define PG8_SA(b, h) (((b) * 2 + (h)) * HTB)
#define PG8_SB(b, h) ((4 + (b) * 2 + (h)) * HTB)
#define PG8_STAGE(bufoff, gbase, voff) do { _Pragma("unroll") for (int _i = 0; _i < 2; ++_i) \
        __builtin_amdgcn_global_load_lds((const unsigned*)((const char*)(gbase) + (voff)[_i]), (PG8_LAS unsigned*)(lds + (bufoff) + ldsw + _i * 8192), 16, 0, 0); } while (0)
#define PG8_LDA(dst, b, h) do { _Pragma("unroll") for (int m = 0; m < 4; ++m) _Pragma("unroll") for (int k = 0; k < 2; ++k) dst[m][k] = *(const PG8_LAS bf16x8*)(lds + PG8_SA(b, h) + aoff + m * 2048 + k * 1024); } while (0)
#define PG8_LDB(dst, b, h) do { _Pragma("unroll") for (int n = 0; n < 2; ++n) _Pragma("unroll") for (int k = 0; k < 2; ++k) dst[n][k] = *(const PG8_LAS bf16x8*)(lds + PG8_SB(b, h) + boff + n * 2048 + k * 1024); } while (0)
#define PG8_MMA(ai, bj, At, Bt) do { __builtin_amdgcn_s_setprio(1); _Pragma("unroll") for (int m = 0; m < 4; ++m) _Pragma("unroll") for (int n = 0; n < 2; ++n) _Pragma("unroll") for (int k = 0; k < 2; ++k) \
        acc[ai][bj][m][n] = __builtin_amdgcn_mfma_f32_16x16x32_bf16(Bt[n][k], At[m][k], acc[ai][bj][m][n], 0, 0, 0); __builtin_amdgcn_s_setprio(0); } while (0)
#define PG8_WAIT_V(n) asm volatile("s_waitcnt vmcnt(" #n ")" ::: "memory")
#define PG8_WAIT_L(n) asm volatile("s_waitcnt lgkmcnt(" #n ")" ::: "memory")
#define PG8_BAR __builtin_amdgcn_s_barrier()
#define PG8_SCHED __builtin_amdgcn_sched_barrier(0)
    Unit cur, nxt; int ui = 0;
    if (!S.next(0, cur)) return;
    f32x4 acc[2][2][4][2];
#pragma unroll
    for (int a = 0; a < 2; ++a)
#pragma unroll
        for (int b = 0; b < 2; ++b)
#pragma unroll
            for (int m = 0; m < 4; ++m)
#pragma unroll
                for (int n = 0; n < 2; ++n) acc[a][b][m][n] = (f32x4){0.f, 0.f, 0.f, 0.f};
    bf16x8 At[4][2], B0[2][2], B1[2][2];
    const char* cA = (const char*)g.A + (size_t)cur.pm * tstepA; const char* cB = (const char*)g.Bt + (size_t)cur.pn * tstep;
    S.a_ready(cur);
    if constexpr (SP2) {
        PG8_STAGE(PG8_SB(0, 0), cB, voffB); PG8_STAGE(PG8_SB(0, 1), cB + hstep, voffB); PG8_STAGE(PG8_SA(0, 0), cA, voffA); PG8_STAGE(PG8_SA(0, 1), cA + hstepA, voffA);
        if (wr == 1) PG8_BAR;
        PG8_WAIT_V(2); PG8_BAR;
        PG8_STAGE(PG8_SB(1, 0), cB + kstep, voffB); PG8_STAGE(PG8_SA(1, 0), cA + kstep, voffA); PG8_STAGE(PG8_SB(1, 1), cB + hstep + kstep, voffB);
        PG8_WAIT_V(6); PG8_BAR;
    } else {
        PG8_STAGE(PG8_SB(0, 0), cB, voffB); PG8_STAGE(PG8_SA(0, 0), cA, voffA); PG8_STAGE(PG8_SB(0, 1), cB + hstep, voffB); PG8_STAGE(PG8_SA(0, 1), cA + hstepA, voffA);
        if (wr == 1) PG8_BAR;
        PG8_WAIT_V(4); PG8_BAR;
        PG8_STAGE(PG8_SB(1, 0), cB + kstep, voffB); PG8_STAGE(PG8_SA(1, 0), cA + kstep, voffA); PG8_STAGE(PG8_SB(1, 1), cB + hstep + kstep, voffB);
        PG8_WAIT_V(6); PG8_BAR;
    }
    for (;;) {
        const bool has_next = S.next(ui + 1, nxt);
        const char* nA = has_next ? (const char*)g.A + (size_t)nxt.pm * tstepA : cA; const char* nB = has_next ? (const char*)g.Bt + (size_t)nxt.pn * tstep : cB;
#pragma nounroll
        for (int t = 0; t < nt; t += 2) {
            const bool last = (t == nt - 2);
            const char* a1 = cA + (size_t)(t + 1) * kstep;
            const char* a2 = last ? nA : cA + (size_t)(t + 2) * kstep; const char* b2 = last ? nB : cB + (size_t)(t + 2) * kstep;
            const char* a3 = a2 + kstep; const char* b3 = b2 + kstep;
            if (last && has_next) S.a_ready(nxt);
            if constexpr (SP2) {
            PG8_LDB(B0, 0, 0); PG8_LDB(B1, 0, 1); PG8_SCHED; PG8_LDA(At, 0, 0); PG8_STAGE(PG8_SA(1, 1), a1 + hstepA, voffA);
            PG8_WAIT_V(8); PG8_WAIT_L(0); PG8_BAR; PG8_MMA(0, 0, At, B0); PG8_MMA(0, 1, At, B1); PG8_BAR; PG8_SCHED;
            PG8_LDA(At, 0, 1); PG8_STAGE(PG8_SB(0, 0), b2, voffB); PG8_STAGE(PG8_SB(0, 1), b2 + hstep, voffB); PG8_STAGE(PG8_SA(0, 0), a2, voffA);
            PG8_WAIT_V(8); PG8_WAIT_L(0); PG8_BAR; PG8_MMA(1, 0, At, B0); PG8_MMA(1, 1, At, B1); PG8_BAR; PG8_SCHED;
            PG8_LDB(B0, 1, 0); PG8_LDB(B1, 1, 1); PG8_SCHED; PG8_LDA(At, 1, 0); PG8_STAGE(PG8_SA(0, 1), a2 + hstepA, voffA);
            PG8_WAIT_V(8); PG8_WAIT_L(0); PG8_BAR; PG8_MMA(0, 0, At, B0); PG8_MMA(0, 1, At, B1); PG8_BAR; PG8_SCHED;
            PG8_LDA(At, 1, 1); PG8_STAGE(PG8_SB(1, 0), b3, voffB); PG8_STAGE(PG8_SB(1, 1), b3 + hstep, voffB); PG8_STAGE(PG8_SA(1, 0), a3, voffA);
            PG8_WAIT_V(8); PG8_WAIT_L(0); PG8_BAR; PG8_MMA(1, 0, At, B0); PG8_MMA(1, 1, At, B1); PG8_BAR; PG8_SCHED;
            } else {
            PG8_LDB(B0, 0, 0); PG8_SCHED; PG8_LDA(At, 0, 0); PG8_STAGE(PG8_SA(1, 1), a1 + hstepA, voffA);
            PG8_WAIT_L(8); PG8_BAR; PG8_WAIT_L(0); PG8_MMA(0, 0, At, B0); PG8_BAR; PG8_SCHED;
            PG8_LDB(B1, 0, 1); PG8_STAGE(PG8_SB(0, 0), b2, voffB);
            PG8_BAR; PG8_WAIT_L(0); PG8_MMA(0, 1, At, B1); PG8_BAR;
            PG8_LDA(At, 0, 1); PG8_STAGE(PG8_SA(0, 0), a2, voffA);
            PG8_BAR; PG8_WAIT_L(0); PG8_MMA(1, 0, At, B0); PG8_BAR; PG8_SCHED;
            PG8_STAGE(PG8_SB(0, 1), b2 + hstep, voffB);
            PG8_WAIT_V(6); PG8_BAR; PG8_MMA(1, 1, At, B1); PG8_BAR;
            PG8_LDB(B0, 1, 0); PG8_SCHED; PG8_LDA(At, 1, 0); PG8_STAGE(PG8_SA(0, 1), a2 + hstepA, voffA);
            PG8_WAIT_L(8); PG8_BAR; PG8_WAIT_L(0); PG8_MMA(0, 0, At, B0); PG8_BAR; PG8_SCHED;
            PG8_LDB(B1, 1, 1); PG8_STAGE(PG8_SB(1, 0), b3, voffB);
            PG8_BAR; PG8_WAIT_L(0); PG8_MMA(0, 1, At, B1); PG8_BAR;
            PG8_LDA(At, 1, 1); PG8_STAGE(PG8_SA(1, 0), a3, voffA);
            PG8_BAR; PG8_WAIT_L(0); PG8_MMA(1, 0, At, B0); PG8_BAR; PG8_SCHED;
            PG8_STAGE(PG8_SB(1, 1), b3 + hstep, voffB);
            PG8_WAIT_V(6); PG8_BAR; PG8_MMA(1, 1, At, B1); PG8_BAR;
            }
        }
        if constexpr (ALIGN_EPI) { if (wr == 0) PG8_BAR; }
        if constexpr (!Epi::AFTER_DRAIN) { E(acc, cur, wr, wc, fr, fq); S.done(cur); }
        if (!has_next) break;
#pragma unroll
        for (int a = 0; a < 2; ++a)
#pragma unroll
            for (int b = 0; b < 2; ++b)
#pragma unroll
                for (int m = 0; m < 4; ++m)
#pragma unroll
                    for (int n = 0; n < 2; ++n) acc[a][b][m][n] = (f32x4){0.f, 0.f, 0.f, 0.f};
        cur = nxt; cA = nA; cB = nB; ++ui;
        if constexpr (ALIGN_EPI) { if (wr == 1) PG8_BAR; }
    }
    PG8_WAIT_V(0);
    if constexpr (!ALIGN_EPI) { if (wr == 0) PG8_BAR; }
    PG8_BAR;
    if constexpr (Epi::AFTER_DRAIN) { E.fused(acc, cur, wr, wc, fr, fq, lds, wid, lane); S.done(cur); }
#undef PG8_SA
#undef PG8_SB
#undef PG8_STAGE
#undef PG8_LDA
#undef PG8_LDB
#undef PG8_MMA
#undef PG8_WAIT_V
#undef PG8_WAIT_L
#undef PG8_BAR
#undef PG8_SCHED
}
}
namespace att {
typedef unsigned short bf16_t;
using bf16x8 = __attribute__((ext_vector_type(8))) short;
using s16x4 = __attribute__((ext_vector_type(4))) short;
using f32x16 = __attribute__((ext_vector_type(16))) float;
using f32x4 = __attribute__((ext_vector_type(4))) float;
using u32x4 = __attribute__((ext_vector_type(4))) unsigned;
typedef short v4i16_t __attribute__((ext_vector_type(4)));
#define ATT_LAS __attribute__((address_space(3)))
typedef ATT_LAS const char* lds_cptr;
constexpr int NW = 8, KVBLK = 64;
constexpr int KSLOT = 12288, VSLOT = 8192, NSLOT = 4;
constexpr int LDS_K = 0, LDS_V = NSLOT * KSLOT, LDS_WS = LDS_V + NSLOT * VSLOT, LDS_OST = LDS_WS + NW * 64 * 4, LDS_POSK = LDS_OST + NW * 4096, LDS_BYTES = LDS_POSK + 1024;
__device__ __forceinline__ int crow(int r, int hi) { return (r & 3) + 8 * (r >> 2) + 4 * hi; }
__device__ __forceinline__ void glds16(const void* gsrc, unsigned lds_dst) { unsigned keep;
    asm volatile("s_mov_b32 %0, m0\n\ts_mov_b32 m0, %2\n\ts_nop 0\n\tglobal_load_lds_dwordx4 %1, off\n\ts_mov_b32 m0, %0" : "=&s"(keep) : "v"(gsrc), "s"(lds_dst) : "memory"); }
typedef float f32x2_t __attribute__((ext_vector_type(2))); typedef __bf16 bf16x2_t __attribute__((ext_vector_type(2)));
__device__ __forceinline__ unsigned cvtpk(float lo, float hi) { f32x2_t v = {lo, hi}; bf16x2_t b = __builtin_convertvector(v, bf16x2_t); return __builtin_bit_cast(unsigned, b); }
__device__ __forceinline__ float att_bf16_up(float x) { unsigned u = __float_as_uint(x); if (u & 0xFFFFu) { u &= 0xFFFF0000u; if (x > 0.f) u += 0x10000u; } return __uint_as_float(u); }
__device__ __forceinline__ s16x4 vtr(lds_cptr p) { return __builtin_bit_cast(s16x4, __builtin_amdgcn_ds_read_tr16_b64_v4i16((ATT_LAS v4i16_t*)p)); }
#define ATT_KS(j) (((j) & (NSLOT - 1)) * KSLOT)
#define ATT_VS(j) (((j) & (NSLOT - 1)) * VSLOT)
#define ATT_WAIT_BAR() asm volatile("s_waitcnt vmcnt(0) lgkmcnt(0)\n\ts_barrier" ::: "memory")
#define ATT_WAIT_BAR_N(three) do { if (three) asm volatile("s_waitcnt vmcnt(3) lgkmcnt(0)\n\ts_barrier" ::: "memory"); else asm volatile("s_waitcnt vmcnt(2) lgkmcnt(0)\n\ts_barrier" ::: "memory"); } while (0)

struct Unit {
    const bf16_t* Q; int q_pitch;
    const bf16_t* K; int k_pitch;
    const bf16_t* Kr;
    const bf16_t* V; int v_pitch;
    int key0, ntiles;
    int q0;
    const unsigned short* list; int len;
    const float* posf;
    float slope2;
    bf16_t* O; int o_pitch;
    bf16_t* part; float* plse; int h;
};

template <int MODE> __device__ __forceinline__ void unit(const Unit& U, char* shm, const int wid) {
    constexpr int DQK = (MODE == 0) ? 96 : 64, ND0 = DQK / 16;
    const int lane = pg8::lane_id_v(), tid = wid * 64 + lane, r32 = lane & 31, hi = lane >> 5;
    const unsigned lds0 = (unsigned)(uintptr_t)shm;
    const lds_cptr shm3 = (lds_cptr)shm;
    ATT_LAS float* wsf = (ATT_LAS float*)(shm3 + LDS_WS) + wid * 64;
    int qrow, slot = 0; bool valid = true;
    if (MODE == 2) { const int e = wid * 32 + r32; valid = e < U.len; const unsigned ent = valid ? (unsigned)U.list[e] : (unsigned)U.list[0]; qrow = (int)(ent & 0x3FFFu); slot = 1 + (int)(ent >> 14); }
    else qrow = U.q0 + wid * 32 + r32;
    const unsigned koff = (unsigned)((U.key0 + 8 * wid + (lane >> 3)) * U.k_pitch + (((lane & 7) ^ ((4 * wid + (lane >> 4)) & 7)) * 8)) * 2u;
    const unsigned kroff = (MODE == 0) ? (unsigned)((U.key0 + 16 * (wid & 3) + (lane >> 2)) * 32 + (((lane & 3) ^ ((lane >> 4) & 3)) * 8)) * 2u : 0u;
    const unsigned voff = (unsigned)((U.key0 + 16 * (wid & 3) + (lane >> 2)) * U.v_pitch + (wid >> 2) * 32 + (lane & 3) * 8) * 2u;
#define ATT_DMA(t, ks, vs) do { glds16((const char*)U.K + koff + (size_t)(t) * (KVBLK * 2) * U.k_pitch, (unsigned)(lds0 + LDS_K + wid * 1024 + (ks))); \
        if (MODE == 0 && wid < 4) glds16((const char*)U.Kr + kroff + (size_t)(t) * (KVBLK * 64), (unsigned)(lds0 + LDS_K + (8 + (wid & 3)) * 1024 + (ks))); \
        glds16((const char*)U.V + voff + (size_t)(t) * (KVBLK * 2) * U.v_pitch, (unsigned)(lds0 + LDS_V + wid * 1024 + (vs))); } while (0)
    const int NT = U.ntiles;
    ATT_DMA(0, 0, 0);
    if (NT > 1) ATT_DMA(1, KSLOT, VSLOT);
    bf16x8 qr[ND0];
    { const bf16_t* Qw = U.Q + (size_t)qrow * U.q_pitch + hi * 8;
#pragma unroll
      for (int d0 = 0; d0 < ND0; ++d0) qr[d0] = *reinterpret_cast<const bf16x8*>(Qw + d0 * 16); }
    float pq = 0.f;
    if (MODE != 0) { pq = U.posf[qrow]; if (tid < 256) ((ATT_LAS float*)(shm3 + LDS_POSK))[tid] = U.posf[U.key0 + tid]; }
    float mhat = -1e30f, l_reg = 0.f; f32x16 o[2]; o[0] = f32x16{}; o[1] = f32x16{};
    const int km_ = (r32 >> 1) & 7, kmr_ = (r32 >> 2) & 3;
    const int ka0 = LDS_K + r32 * 128 + 32 * (km_ >> 1) + 16 * (hi ^ (km_ & 1));
    const int kb0 = LDS_K + 8192 + r32 * 64 + 32 * (kmr_ >> 1) + 16 * (hi ^ (kmr_ & 1));
#define ATT_KADDR(d0, half, KS) (shm3 + (KS) + (((d0) < 4) ? ((ka0 ^ ((d0) << 5)) + (half) * 4096) : ((kb0 ^ (((d0) - 4) << 5)) + (half) * 2048)))
    const lds_cptr vp0 = shm3 + LDS_V + ((lane >> 4) & 1) * 32 + (lane & 3) * 8 + (4 * hi + ((lane & 15) >> 2)) * 64;
#define ATT_QKT(P0, P1, KS) do { P0 = f32x16{}; P1 = f32x16{}; bf16x8 kk_[2 * ND0]; \
        _Pragma("unroll") for (int d0 = 0; d0 < ND0; ++d0) { kk_[2 * d0] = *(const ATT_LAS bf16x8*)ATT_KADDR(d0, 0, KS); kk_[2 * d0 + 1] = *(const ATT_LAS bf16x8*)ATT_KADDR(d0, 1, KS); }     \
        __builtin_amdgcn_sched_barrier(0); \
        _Pragma("unroll") for (int d0 = 0; d0 < ND0; ++d0) { \
            P0 = __builtin_amdgcn_mfma_f32_32x32x16_bf16(kk_[2 * d0], qr[d0], P0, 0, 0, 0); P1 = __builtin_amdgcn_mfma_f32_32x32x16_bf16(kk_[2 * d0 + 1], qr[d0], P1, 0, 0, 0); } } while (0)
#define ATT_SMPV(P0, P1, T, VS) do { \
        if (MODE != 0) { const ATT_LAS float* pk_ = (const ATT_LAS float*)(shm3 + LDS_POSK) + 64 * (T) + 4 * hi; \
            _Pragma("unroll") for (int g = 0; g < 4; ++g) { const f32x4 a_ = *(const ATT_LAS f32x4*)(pk_ + 8 * g), b_ = *(const ATT_LAS f32x4*)(pk_ + 8 * g + 32); \
                _Pragma("unroll") for (int j = 0; j < 4; ++j) { P0[4 * g + j] -= U.slope2 * __builtin_fabsf(pq - a_[j]); P1[4 * g + j] -= U.slope2 * __builtin_fabsf(pq - b_[j]); } } } \
        if (MODE == 0 || MODE == 1) { const int kb_ = U.key0 + 64 * (T); \
            if (kb_ + 63 > U.q0 + wid * 32) { const int dq_ = qrow - kb_ - 4 * hi; \
                _Pragma("unroll") for (int r = 0; r < 16; ++r) { const int c_ = (r & 3) + 8 * (r >> 2); if (c_ > dq_) P0[r] = -INFINITY; if (c_ + 32 > dq_) P1[r] = -INFINITY; } } } \
        float rm_ = P0[0]; \
        _Pragma("unroll") for (int r = 1; r < 16; ++r) rm_ = fmaxf(rm_, P0[r]); \
        _Pragma("unroll") for (int r = 0; r < 16; ++r) rm_ = fmaxf(rm_, P1[r]); \
        { auto rr_ = __builtin_amdgcn_permlane32_swap(__float_as_uint(rm_), __float_as_uint(rm_), false, false); rm_ = fmaxf(__uint_as_float(rr_[0]), __uint_as_float(rr_[1])); } \
        if (__any(rm_ > mhat + 10.0f)) { const float mn_ = fmaxf(mhat, rm_), f_ = __builtin_amdgcn_exp2f(mhat - mn_); mhat = mn_; l_reg *= f_; \
            _Pragma("unroll") for (int r = 0; r < 16; ++r) { o[0][r] *= f_; o[1][r] *= f_; } }                        \
        float sacc_ = 0.f; \
        _Pragma("unroll") for (int r = 0; r < 16; ++r) { P0[r] = __builtin_amdgcn_exp2f(P0[r] - mhat); P1[r] = __builtin_amdgcn_exp2f(P1[r] - mhat); sacc_ += P0[r] + P1[r]; } \
        l_reg += sacc_; \
        u32x4 pw_[4]; \
        _Pragma("unroll") for (int s_ = 0; s_ < 2; ++s_) { \
            pw_[s_] = (u32x4){cvtpk(P0[8 * s_], P0[8 * s_ + 1]), cvtpk(P0[8 * s_ + 2], P0[8 * s_ + 3]), cvtpk(P0[8 * s_ + 4], P0[8 * s_ + 5]), cvtpk(P0[8 * s_ + 6], P0[8 * s_ + 7])}; \
            pw_[2 + s_] = (u32x4){cvtpk(P1[8 * s_], P1[8 * s_ + 1]), cvtpk(P1[8 * s_ + 2], P1[8 * s_ + 3]), cvtpk(P1[8 * s_ + 4], P1[8 * s_ + 5]), cvtpk(P1[8 * s_ + 6], P1[8 * s_ + 7])}; } \
        const lds_cptr vp_ = vp0 + (VS); s16x4 vl_[8], vh_[8]; \
        _Pragma("unroll") for (int i_ = 0; i_ < 8; ++i_) { vl_[i_] = vtr(vp_ + (i_ >> 2) * 4096 + (i_ & 3) * 1024); vh_[i_] = vtr(vp_ + (i_ >> 2) * 4096 + (i_ & 3) * 1024 + 512); }     \
        __builtin_amdgcn_sched_barrier(0); \
        _Pragma("unroll") for (int i_ = 0; i_ < 8; ++i_) { \
            const bf16x8 vf_ = (bf16x8){vl_[i_][0], vl_[i_][1], vl_[i_][2], vl_[i_][3], vh_[i_][0], vh_[i_][1], vh_[i_][2], vh_[i_][3]}; \
            o[i_ >> 2] = __builtin_amdgcn_mfma_f32_32x32x16_bf16(vf_, __builtin_bit_cast(bf16x8, pw_[i_ & 3]), o[i_ >> 2], 0, 0, 0); } } while (0)
#define ATT_ACT(T) (MODE != 1 || (64 * (T) <= wid * 32 + 31))
#define ATT_ITER(SC0, SC1, SN0, SN1, T) do { const bool has_next_ = (T) + 1 < NT; \
        if (has_next_ && ATT_ACT((T) + 1)) ATT_QKT(SN0, SN1, ATT_KS((T) + 1)); \
        if (ATT_ACT(T)) ATT_SMPV(SC0, SC1, T, ATT_VS(T)); \
        if (has_next_ && (MODE == 0 || NT > NSLOT)) { if ((T) + 3 < NT) ATT_WAIT_BAR_N(dma3); else ATT_WAIT_BAR(); if ((T) + 4 < NT) ATT_DMA((T) + 4, ATT_KS(T), ATT_VS(T)); }   \
        } while (0)
    const bool dma3 = (MODE == 0) && wid < 4;
    if (NT > 2) ATT_DMA(2, 2 * KSLOT, 2 * VSLOT);
    if (NT > 3) ATT_DMA(3, 3 * KSLOT, 3 * VSLOT);
    if (MODE == 0 && NT > 3) ATT_WAIT_BAR_N(dma3); else ATT_WAIT_BAR();
    f32x16 pA0, pA1, pB0, pB1;
    ATT_QKT(pA0, pA1, 0);
    int t = 0;
    if (MODE == 0 && NT > 4) {
#define ATT_SB() __builtin_amdgcn_sched_barrier(0)
#define ATT_KLD(i, KS) kf[i] = *(const ATT_LAS bf16x8*)ATT_KADDR((i) >> 1, (i) & 1, KS)
#define ATT_VLD(i, VS) do { vlo[i] = vtr(vp0 + (VS) + ((i) >> 2) * 4096 + ((i) & 3) * 1024); vhi[i] = vtr(vp0 + (VS) + ((i) >> 2) * 4096 + ((i) & 3) * 1024 + 512); } while (0)
#define ATT_SCR(SC0, SC1, j) ((j) < 16 ? SC0[(j) & 15] : SC1[(j) & 15])
#define ATT_EXP4(SC0, SC1, g) do { if ((g) < 4) { _Pragma("unroll") for (int j_ = 0; j_ < 4; ++j_) SC0[4 * (g) + j_] = __builtin_amdgcn_exp2f(SC0[4 * (g) + j_]); } \
                                   else { _Pragma("unroll") for (int j_ = 0; j_ < 4; ++j_) SC1[4 * ((g) - 4) + j_] = __builtin_amdgcn_exp2f(SC1[4 * ((g) - 4) + j_]); } } while (0)
#define ATT_ADD4(SC0, SC1, g) do { if ((g) < 4) sacc_ += (SC0[4 * (g)] + SC0[4 * (g) + 1]) + (SC0[4 * (g) + 2] + SC0[4 * (g) + 3]); else sacc_ += (SC1[4 * ((g) - 4)] + SC1[4 * ((g) - 4) + 1]) + (SC1[4 * ((g) - 4) + 2] + SC1[4 * ((g) - 4) + 3]); } while (0)
#define ATT_CVT4(SC0, SC1, g) do { if ((g) < 4) { pw[(g) >> 1][2 * ((g) & 1)] = cvtpk(SC0[4 * (g)], SC0[4 * (g) + 1]); pw[(g) >> 1][2 * ((g) & 1) + 1] = cvtpk(SC0[4 * (g) + 2], SC0[4 * (g) + 3]); } \
                                   else { pw[(g) >> 1][2 * ((g) & 1)] = cvtpk(SC1[4 * ((g) - 4)], SC1[4 * ((g) - 4) + 1]); pw[(g) >> 1][2 * ((g) & 1) + 1] = cvtpk(SC1[4 * ((g) - 4) + 2], SC1[4 * ((g) - 4) + 3]); } } while (0)
#define ATT_GAPA(i, SC0, SC1, SN0, SN1) do { \
        if (((i) & 1) == 0) SN0 = __builtin_amdgcn_mfma_f32_32x32x16_bf16(kf[i], qr[(i) >> 1], SN0, 0, 0, 0); else SN1 = __builtin_amdgcn_mfma_f32_32x32x16_bf16(kf[i], qr[(i) >> 1], SN1, 0, 0, 0); \
        if ((i) < 8) { ATT_VLD(i, vs_); ATT_EXP4(SC0, SC1, i); } \
        if ((i) >= 1 && (i) <= 8) ATT_ADD4(SC0, SC1, (i) - 1); \
        if ((i) >= 2 && (i) <= 9) ATT_CVT4(SC0, SC1, (i) - 2); \
        ATT_SB(); } while (0)
#define ATT_VF(j) (bf16x8){vlo[j][0], vlo[j][1], vlo[j][2], vlo[j][3], vhi[j][0], vhi[j][1], vhi[j][2], vhi[j][3]}
#define ATT_GAPB(j, SN0, SN1) do { \
        o[(j) >> 2] = __builtin_amdgcn_mfma_f32_32x32x16_bf16(ATT_VF(j), __builtin_bit_cast(bf16x8, pw[(j) & 3]), o[(j) >> 2], 0, 0, 0); \
        if ((j) < 6) { ATT_KLD(2 * (j), ks2_); ATT_KLD(2 * (j) + 1, ks2_); } \
        if ((j) >= 2 && (j) < 6) { const int b_ = 4 * ((j) - 2); ma_ = fmaxf(fmaxf(ma_, SN0[b_]), SN0[b_ + 1]); mb_ = fmaxf(fmaxf(mb_, SN0[b_ + 2]), SN0[b_ + 3]); ma_ = fmaxf(fmaxf(ma_, SN1[b_]), SN1[b_ + 1]); mb_ = fmaxf(fmaxf(mb_, SN1[b_ + 2]), SN1[b_ + 3]); } \
        ATT_SB(); } while (0)
#define ATT_FAST(SC0, SC1, SN0, SN1, T) do { const int vs_ = ATT_VS(T), ks2_ = ATT_KS((T) + 2); \
        { const unsigned long long bal_ = __builtin_amdgcn_ballot_w64(rm > 10.0f); float f_ = 1.f; \
          if (bal_ != 0ull) { const float mn_ = att_bf16_up(mhat + fmaxf(rm, 0.f)), dl_ = mn_ - mhat; f_ = __builtin_amdgcn_exp2f(-dl_); mhat = mn_; l_reg *= f_; \
            _Pragma("unroll") for (int r = 0; r < 16; ++r) { SC0[r] -= dl_; SC1[r] -= dl_; } \
            qx[0] = (hi == 0) ? (short)(__float_as_uint(-mhat) >> 16) : (short)0; } \
            \
          _Pragma("unroll") for (int g_ = 0; g_ < 4; ++g_) { const int d_ = g_ >> 1, b_ = 8 * (g_ & 1); \
            asm volatile("s_cmp_eq_u64 %[b], 0\n\ts_cbranch_scc1 .Lsk%=\n\tv_mul_f32_e32 %0, %[f], %0\n\tv_mul_f32_e32 %1, %[f], %1\n\tv_mul_f32_e32 %2, %[f], %2\n\tv_mul_f32_e32 %3, %[f], %3\n\t" \
                         "v_mul_f32_e32 %4, %[f], %4\n\tv_mul_f32_e32 %5, %[f], %5\n\tv_mul_f32_e32 %6, %[f], %6\n\tv_mul_f32_e32 %7, %[f], %7\n.Lsk%=:" \
                         : "+v"(o[d_][b_]), "+v"(o[d_][b_ + 1]), "+v"(o[d_][b_ + 2]), "+v"(o[d_][b_ + 3]), "+v"(o[d_][b_ + 4]), "+v"(o[d_][b_ + 5]), "+v"(o[d_][b_ + 6]), "+v"(o[d_][b_ + 7]) \
                         : [f] "v"(f_), [b] "s"(bal_) : "scc"); } } \
        ATT_SB(); \
        float sacc_ = 0.f; \
        SN0 = __builtin_amdgcn_mfma_f32_32x32x16_bf16(kx, qx, f32x16{}, 0, 0, 0); SN1 = __builtin_amdgcn_mfma_f32_32x32x16_bf16(kx, qx, f32x16{}, 0, 0, 0);     \
        ATT_GAPA(0, SC0, SC1, SN0, SN1); ATT_GAPA(1, SC0, SC1, SN0, SN1); ATT_GAPA(2, SC0, SC1, SN0, SN1); ATT_GAPA(3, SC0, SC1, SN0, SN1); \
        ATT_GAPA(4, SC0, SC1, SN0, SN1); ATT_GAPA(5, SC0, SC1, SN0, SN1); ATT_GAPA(6, SC0, SC1, SN0, SN1); ATT_GAPA(7, SC0, SC1, SN0, SN1); \
        ATT_GAPA(8, SC0, SC1, SN0, SN1); ATT_GAPA(9, SC0, SC1, SN0, SN1); ATT_GAPA(10, SC0, SC1, SN0, SN1); ATT_GAPA(11, SC0, SC1, SN0, SN1); \
        l_reg += sacc_; \
        float ma_ = -INFINITY, mb_ = -INFINITY; \
        ATT_GAPB(0, SN0, SN1); ATT_GAPB(1, SN0, SN1); ATT_GAPB(2, SN0, SN1); ATT_GAPB(3, SN0, SN1); ATT_GAPB(4, SN0, SN1); ATT_GAPB(5, SN0, SN1); ATT_GAPB(6, SN0, SN1); ATT_GAPB(7, SN0, SN1); \
        rm = fmaxf(ma_, mb_); \
        { auto rr_ = __builtin_amdgcn_permlane32_swap(__float_as_uint(rm), __float_as_uint(rm), false, false); rm = fmaxf(__uint_as_float(rr_[0]), __uint_as_float(rr_[1])); } \
        ATT_SB(); \
        ATT_WAIT_BAR(); ATT_DMA((T) + 4, ATT_KS(T), vs_); } while (0)
        bf16x8 kf[12]; s16x4 vlo[8], vhi[8]; u32x4 pw[4];
        float rm = pA0[0];
#pragma unroll
        for (int r = 1; r < 16; ++r) rm = fmaxf(rm, pA0[r]);
#pragma unroll
        for (int r = 0; r < 16; ++r) rm = fmaxf(rm, pA1[r]);
        { auto rr_ = __builtin_amdgcn_permlane32_swap(__float_as_uint(rm), __float_as_uint(rm), false, false); rm = fmaxf(__uint_as_float(rr_[0]), __uint_as_float(rr_[1])); }
        mhat = att_bf16_up(rm);
#pragma unroll
        for (int r = 0; r < 16; ++r) { pA0[r] -= mhat; pA1[r] -= mhat; }
        rm -= mhat;
        const bf16x8 kx = (bf16x8){(short)0x3F80, 0, 0, 0, 0, 0, 0, 0};
        bf16x8 qx = (bf16x8){0, 0, 0, 0, 0, 0, 0, 0};
        if (hi == 0) qx[0] = (short)(__float_as_uint(-mhat) >> 16);
#pragma unroll
        for (int i = 0; i < 12; ++i) ATT_KLD(i, KSLOT);
        if (wid >= 4) __builtin_amdgcn_s_setprio(1);
        for (; t + 4 < NT; t += 2) { ATT_FAST(pA0, pA1, pB0, pB1, t); ATT_FAST(pB0, pB1, pA0, pA1, t + 1); }
        if (wid >= 4) __builtin_amdgcn_s_setprio(0);
#pragma unroll
        for (int r = 0; r < 16; ++r) { pA0[r] += mhat; pA1[r] += mhat; }
#undef ATT_FAST
#undef ATT_GAPA
#undef ATT_GAPB
#undef ATT_VF
#undef ATT_EXP4
#undef ATT_ADD4
#undef ATT_CVT4
#undef ATT_SCR
#undef ATT_KLD
#undef ATT_VLD
#undef ATT_SB
    }
    for (; t < NT; t += 2) {
        ATT_ITER(pA0, pA1, pB0, pB1, t);
        if (t + 1 < NT) ATT_ITER(pB0, pB1, pA0, pA1, t + 1);
    }
#undef ATT_QKT
#undef ATT_SMPV
#undef ATT_ACT
#undef ATT_ITER
    { auto rr = __builtin_amdgcn_permlane32_swap(__float_as_uint(l_reg), __float_as_uint(l_reg), false, false); l_reg = __uint_as_float(rr[0]) + __uint_as_float(rr[1]); }
    { const float rl = __builtin_amdgcn_rcpf(l_reg);
      bf16_t* prow = U.O + (size_t)(U.q0 + wid * 32 + r32) * U.o_pitch + 8 * hi;
#pragma unroll
      for (int dh = 0; dh < 2; ++dh)
#pragma unroll
        for (int jp = 0; jp < 2; ++jp) {
            unsigned a0 = cvtpk(o[dh][8 * jp] * rl, o[dh][8 * jp + 1] * rl), a1 = cvtpk(o[dh][8 * jp + 2] * rl, o[dh][8 * jp + 3] * rl);
            unsigned b0 = cvtpk(o[dh][8 * jp + 4] * rl, o[dh][8 * jp + 5] * rl), b1 = cvtpk(o[dh][8 * jp + 6] * rl, o[dh][8 * jp + 7] * rl);
            const auto s0 = __builtin_amdgcn_permlane32_swap(a0, b0, false, false); const auto s1 = __builtin_amdgcn_permlane32_swap(a1, b1, false, false);
            *(u32x4*)(prow + 32 * dh + 16 * jp) = (u32x4){s0[0], s1[0], s0[1], s1[1]}; } }
    asm volatile("s_waitcnt vmcnt(0) lgkmcnt(0)\n\ts_barrier" ::: "memory");
#undef ATT_DMA
}
}

namespace att {
constexpr int MB_REG = 65536, MB_TILE = 16384, MB_V = 8192, MB_POSK = 131072, MB_PRE = MB_POSK + 3072, MB_UT = MB_PRE + 2048, MB_NUT = 62, MB_TM = MB_UT + 1024, MB_KB = 140288, MB_ENT = MB_KB + 8192, MB_END = MB_ENT + 2048;
struct MobaCtx { const bf16_t* mqkv; const float* posf; bf16_t* part; float* plse; const unsigned* lists; const unsigned* cnt; int total, vcu, G; };
struct MobaDesc { int own, h, n; };
__device__ __forceinline__ unsigned att_bf16_rne(float f) { unsigned u = __float_as_uint(f); return (u + 0x7fffu + ((u >> 16) & 1u)) >> 16; }
__device__ __forceinline__ float att_bf2f(unsigned b) { return __uint_as_float(b << 16); }
__device__ __forceinline__ void att_split3(float c, unsigned& w1, unsigned& w2) { const unsigned c0 = att_bf16_rne(c); const float r1 = c - att_bf2f(c0); const unsigned c1 = att_bf16_rne(r1); const float r2 = r1 - att_bf2f(c1);
    w1 = c0 | (c1 << 16); w2 = att_bf16_rne(r2); }

__device__ __forceinline__ u32x4 moba_get(const MobaCtx& C, ATT_LAS const int* pre, int i) {
    const int ng = (C.vcu < C.total) ? (C.total - C.vcu + C.G - 1) / C.G : 0;
    if (i < ng) { const int gI = C.vcu + i * C.G; int lo = 0, hi = 511;
        while (lo < hi) { const int mid = (lo + hi) >> 1; if (pre[mid] > gI) hi = mid; else lo = mid + 1; }
        const int hn = lo, c = gI - (hn ? pre[hn - 1] : 0); const int len = (int)C.cnt[hn] - c * 256;
        return (u32x4){1u | ((unsigned)(hn >> 6) << 2) | ((unsigned)(hn & 63) << 5), (unsigned)(len < 256 ? len : 256), (unsigned)hn * 16384u + (unsigned)c * 256u, 0u}; }
    const int u = C.vcu + (i - ng) * C.G; if (u >= 512) return (u32x4){0u, 0u, 0u, 0u};
    return (u32x4){1u | 2u | ((unsigned)(u & 7) << 2) | ((unsigned)(u >> 3) << 5), 256u, 0u, 0u};
}
__device__ __forceinline__ void glds4(const void* gsrc, unsigned lds_dst) { unsigned keep;
    asm volatile("s_mov_b32 %0, m0\n\ts_mov_b32 m0, %2\n\ts_nop 0\n\tglobal_load_lds_dword %1, off\n\ts_mov_b32 m0, %0" : "=&s"(keep) : "v"(gsrc), "s"(lds_dst) : "memory"); }

template <int PROBE> __device__ __forceinline__ void moba_run(const MobaCtx& C, char* shm, const int wid) {
    const int lane = pg8::lane_id_v(), tid = wid * 64 + lane, r32 = lane & 31, hi = lane >> 5;
    const unsigned lds0 = (unsigned)(uintptr_t)shm; const lds_cptr shm3 = (lds_cptr)shm;
    ATT_LAS const int* pre = (ATT_LAS const int*)(shm3 + MB_PRE);
    const float* pmax = C.posf + 16384;
    const int km_ = (r32 >> 1) & 7;
    const int ka0 = r32 * 128 + 32 * (km_ >> 1) + 16 * (hi ^ (km_ & 1));
    const int vpl = MB_V + ((lane >> 4) & 1) * 32 + (lane & 3) * 8 + (4 * hi + ((lane & 15) >> 2)) * 64;
    const unsigned koff = (unsigned)((8 * wid + (lane >> 3)) * 1536 + (((lane & 7) ^ ((4 * wid + (lane >> 4)) & 7)) * 8)) * 2u;
    const unsigned voff = (unsigned)((16 * (wid & 3) + (lane >> 2)) * 1536 + (wid >> 2) * 32 + (lane & 3) * 8) * 2u;
#define MB_UNPACK(X_, D_) do { (D_).own = (int)(((X_) >> 1) & 1u); (D_).h = (int)(((X_) >> 2) & 7u); (D_).n = (PROBE & 4) ? 0 : (int)((X_) >> 5); } while (0)
#define MB_DMA(D_, R_) do { const char* kb_ = (const char*)(C.mqkv + 512 + (D_).h * 64 + (size_t)(D_).n * 256 * 1536); const char* vb_ = kb_ + 1024; \
        unsigned db_ = (unsigned)(lds0 + (R_) + wid * 1024); asm volatile("" : "+s"(db_));     \
        _Pragma("unroll") for (int t_ = 0; t_ < 4; ++t_) { glds16(kb_ + koff + (size_t)t_ * (64 * 1536 * 2), db_ + t_ * MB_TILE); \
                                                           glds16(vb_ + voff + (size_t)t_ * (64 * 1536 * 2), db_ + t_ * MB_TILE + MB_V); } } while (0)
#define MB_FETCH(I_, E_, X_) do { E_ = ((const ATT_LAS u32x4*)(shm3 + MB_UT))[(I_)]; X_ = (unsigned)__builtin_amdgcn_readfirstlane((int)E_[0]); } while (0)
#define MB_SMALL(U_, E_, D_) do { \
        if (!(D_).own) { const int e = wid * 32 + r32; if (hi == 0 && e < (int)E_[1]) glds4(C.lists + E_[2] + e, (unsigned)(lds0 + MB_ENT + ((U_) & 1) * 1024 + wid * 128)); } \
        if (wid < 4) glds4(C.posf + (D_).n * 256 + tid, (unsigned)(lds0 + MB_POSK + ((U_) % 3) * 1024 + wid * 256)); \
        if (tid < 4) glds4(pmax + 4 * (D_).n + tid, (unsigned)(lds0 + MB_TM + ((U_) % 3) * 16)); } while (0)
#define MB_STAGE(U_, D_) do { if (tid < 256) { const ATT_LAS float* pp_ = (const ATT_LAS float*)(shm3 + MB_POSK + ((U_) % 3) * 1024); \
            const float v_ = exp2f(-(float)((D_).h + 1)) * 1.4426950408889634f * (pp_[tid] - pp_[0]); const unsigned vh_ = att_bf16_rne(v_), vl_ = att_bf16_rne(v_ - att_bf2f(vh_)); \
            ((ATT_LAS u32x4*)(shm3 + MB_KB + ((U_) & 1) * 4096))[tid] = (u32x4){vh_ | (vl_ << 16), 0x3F803F80u, 0x00003F80u, 0u}; } } while (0)
#define MB_QROW(U_, E_, D_, META_, QR_, PQ_) do { const int e_ = wid * 32 + r32; \
        if ((D_).own) META_ = (((D_).n * 256 + e_) << 2); \
        else { const unsigned en_ = ((const ATT_LAS unsigned*)(shm3 + MB_ENT + ((U_) & 1) * 1024))[e_]; META_ = (e_ < (int)E_[1]) ? (int)(((en_ & 0x3FFFu) << 2) | (1u + ((en_ >> 14) & 3u))) : -1; } \
        const int qr_ = (PROBE & 4) ? (16128 + e_) : ((META_) >= 0 ? ((META_) >> 2) : 0); const bf16_t* Qw_ = C.mqkv + (D_).h * 64 + (size_t)qr_ * 1536 + hi * 8; \
        _Pragma("unroll") for (int d0 = 0; d0 < 4; ++d0) QR_[d0] = *reinterpret_cast<const bf16x8*>(Qw_ + d0 * 16); PQ_ = C.posf[qr_]; } while (0)
#define MB_CHEAP(U_, D_, META_, PQ_, CM_) do { const f32x4 tm_ = *(const ATT_LAS f32x4*)(shm3 + MB_TM + ((U_) % 3) * 16); CM_ = 0; \
        _Pragma("unroll") for (int t_ = 0; t_ < 4; ++t_) { bool ok_ = __all((META_) < 0 || (PQ_) >= tm_[t_]); if ((D_).own) ok_ = ok_ && (64 * t_ + 63 <= wid * 32); if (ok_) CM_ |= 1 << t_; } } while (0)
  for (int base = 0; ; base += MB_NUT) {
    __syncthreads();
    if (tid < MB_NUT) ((ATT_LAS u32x4*)(shm3 + MB_UT))[tid] = moba_get(C, pre, base + tid);
    if (tid == MB_NUT || tid == MB_NUT + 1) ((ATT_LAS u32x4*)(shm3 + MB_UT))[tid] = (u32x4){0u, 0u, 0u, 0u};
    __syncthreads();
    u32x4 ent_; unsigned xc, xn, xnn = 0u; MobaDesc D, Dn;
    MB_FETCH(0, ent_, xc);
    if (!(xc & 1u)) break;
    MB_UNPACK(xc, D);
    MB_DMA(D, 0); MB_SMALL(0, ent_, D);
    { u32x4 e1_; MB_FETCH(1, e1_, xn); MB_UNPACK(xn, Dn); if (xn & 1u) MB_SMALL(1, e1_, Dn); }
    __builtin_amdgcn_s_waitcnt(0); __builtin_amdgcn_s_barrier();
    int meta = -1, cm = 0; float pq = 0.f, pbase = 0.f; bf16x8 qr[4];
    MB_STAGE(0, D); MB_QROW(0, ent_, D, meta, qr, pq);
    pbase = ((const ATT_LAS float*)(shm3 + MB_POSK))[0];
    __builtin_amdgcn_s_waitcnt(0); __builtin_amdgcn_s_barrier();
    MB_CHEAP(0, D, meta, pq, cm);
    if (xn & 1u) MB_DMA(Dn, MB_REG);
    int i = 0;
    for (; xc & 1u; ++i) {
        int meta_n = -1; float pq_n = 0.f;
        MB_UNPACK(xn, Dn);
        const int cur = i & 1, rb = cur * MB_REG; const float slope2 = exp2f(-(float)(D.h + 1)) * 1.4426950408889634f;
        const bool valid = meta >= 0; const int qrow = valid ? (meta >> 2) : 0, slot = meta & 3;
        const ATT_LAS float* posk = (const ATT_LAS float*)(shm3 + MB_POSK + (i % 3) * 1024);
        const lds_cptr kbx = shm3 + MB_KB + cur * 4096 + r32 * 16;
        float mhat = 0.f, l_reg = 0.f; bool first_ = true; f32x16 o[2]; o[0] = f32x16{}; o[1] = f32x16{};
        unsigned qxa0 = 0u, qxa1 = 0u, qxa2 = 0u, qxr1 = 0u, qxr2 = 0u;
#define MB_QX() do { unsigned a1_, a2_, r1_, r2_; att_split3(-slope2 * (pq - pbase) - mhat, a1_, a2_); att_split3(-mhat, r1_, r2_); \
            qxa0 = hi == 0 ? 0x3F803F80u : 0u; qxa1 = hi == 0 ? a1_ : 0u; qxa2 = hi == 0 ? a2_ : 0u; qxr1 = hi == 0 ? r1_ : 0u; qxr2 = hi == 0 ? r2_ : 0u; } while (0)
        MB_QX();
        f32x16 pA0, pA1, pB0, pB1; float mA = 0.f, mB = 0.f;
#define MB_ACT(T) (!D.own || (64 * (T) <= wid * 32 + 31))
#define MB_CH(T) ((cm >> (T)) & 1)
#define MB_QKT(P0, P1, MR, T) do { bf16x8 kk_[8]; const lds_cptr kb_ = shm3 + rb + (T) * MB_TILE; \
            const bf16x8 kx0_ = *(const ATT_LAS bf16x8*)(kbx + (T) * 1024), kx1_ = *(const ATT_LAS bf16x8*)(kbx + (T) * 1024 + 512); \
            _Pragma("unroll") for (int d0 = 0; d0 < 4; ++d0) { kk_[2 * d0] = *(const ATT_LAS bf16x8*)(kb_ + (ka0 ^ (d0 << 5))); kk_[2 * d0 + 1] = *(const ATT_LAS bf16x8*)(kb_ + (ka0 ^ (d0 << 5)) + 4096); } \
            const bool ch_ = MB_CH(T); const u32x4 qs_ = (u32x4){ch_ ? qxa0 : 0u, ch_ ? qxa1 : qxr1, ch_ ? qxa2 : qxr2, 0u}; \
            __builtin_amdgcn_sched_barrier(0); \
            P0 = __builtin_amdgcn_mfma_f32_32x32x16_bf16(kx0_, __builtin_bit_cast(bf16x8, qs_), f32x16{}, 0, 0, 0); P1 = __builtin_amdgcn_mfma_f32_32x32x16_bf16(kx1_, __builtin_bit_cast(bf16x8, qs_), f32x16{}, 0, 0, 0); \
            _Pragma("unroll") for (int d0 = 0; d0 < 4; ++d0) { P0 = __builtin_amdgcn_mfma_f32_32x32x16_bf16(kk_[2 * d0], qr[d0], P0, 0, 0, 0); P1 = __builtin_amdgcn_mfma_f32_32x32x16_bf16(kk_[2 * d0 + 1], qr[d0], P1, 0, 0, 0); } \
            MR = mhat; } while (0)
#define MB_SMPV(P0, P1, MC, T) do { \
            if (__any(MC != mhat)) { const float d_ = mhat - MC; _Pragma("unroll") for (int r = 0; r < 16; ++r) { P0[r] -= d_; P1[r] -= d_; } }     \
            if (!MB_CH(T)) { const ATT_LAS float* pk_ = posk + 64 * (T) + 4 * hi; \
                _Pragma("unroll") for (int g = 0; g < 4; ++g) { const f32x4 a_ = *(const ATT_LAS f32x4*)(pk_ + 8 * g), b_ = *(const ATT_LAS f32x4*)(pk_ + 8 * g + 32); \
                    _Pragma("unroll") for (int j = 0; j < 4; ++j) { P0[4 * g + j] -= slope2 * __builtin_fabsf(pq - a_[j]); P1[4 * g + j] -= slope2 * __builtin_fabsf(pq - b_[j]); } } } \
            if (D.own && 64 * (T) + 63 > wid * 32) { int dq_ = wid * 32 + r32 - 64 * (T) - 4 * hi; asm volatile("" : "+v"(dq_));     \
                _Pragma("unroll") for (int r = 0; r < 16; ++r) { const int c_ = (r & 3) + 8 * (r >> 2); if (c_ > dq_) P0[r] = -INFINITY; if (c_ + 32 > dq_) P1[r] = -INFINITY; } } \
            float rm_ = P0[0]; \
            _Pragma("unroll") for (int r = 1; r < 16; ++r) rm_ = fmaxf(rm_, P0[r]); \
            _Pragma("unroll") for (int r = 0; r < 16; ++r) rm_ = fmaxf(rm_, P1[r]); \
            { auto rr_ = __builtin_amdgcn_permlane32_swap(__float_as_uint(rm_), __float_as_uint(rm_), false, false); rm_ = fmaxf(__uint_as_float(rr_[0]), __uint_as_float(rr_[1])); } \
            if (first_ || __any(rm_ > 10.0f)) { const float dl_ = first_ ? rm_ : fmaxf(rm_, 0.f); mhat += dl_; \
                _Pragma("unroll") for (int r = 0; r < 16; ++r) { P0[r] -= dl_; P1[r] -= dl_; } \
                if (!first_) { const float f_ = __builtin_amdgcn_exp2f(-dl_); l_reg *= f_; \
                    _Pragma("unroll") for (int r = 0; r < 16; ++r) { o[0][r] *= f_; o[1][r] *= f_; } }                        \
                first_ = false; MB_QX(); } \
            float sacc_ = 0.f; \
            _Pragma("unroll") for (int r = 0; r < 16; ++r) { P0[r] = __builtin_amdgcn_exp2f(P0[r]); P1[r] = __builtin_amdgcn_exp2f(P1[r]); sacc_ += P0[r] + P1[r]; } \
            l_reg += sacc_; \
            u32x4 pw_[4]; \
            _Pragma("unroll") for (int s_ = 0; s_ < 2; ++s_) { \
                pw_[s_] = (u32x4){cvtpk(P0[8 * s_], P0[8 * s_ + 1]), cvtpk(P0[8 * s_ + 2], P0[8 * s_ + 3]), cvtpk(P0[8 * s_ + 4], P0[8 * s_ + 5]), cvtpk(P0[8 * s_ + 6], P0[8 * s_ + 7])}; \
                pw_[2 + s_] = (u32x4){cvtpk(P1[8 * s_], P1[8 * s_ + 1]), cvtpk(P1[8 * s_ + 2], P1[8 * s_ + 3]), cvtpk(P1[8 * s_ + 4], P1[8 * s_ + 5]), cvtpk(P1[8 * s_ + 6], P1[8 * s_ + 7])}; } \
            const lds_cptr vp_ = shm3 + rb + (T) * MB_TILE + vpl; s16x4 vl_[8], vh_[8]; \
            _Pragma("unroll") for (int i_ = 0; i_ < 8; ++i_) { vl_[i_] = vtr(vp_ + (i_ >> 2) * 4096 + (i_ & 3) * 1024); vh_[i_] = vtr(vp_ + (i_ >> 2) * 4096 + (i_ & 3) * 1024 + 512); } \
            __builtin_amdgcn_sched_barrier(0); \
            _Pragma("unroll") for (int i_ = 0; i_ < 8; ++i_) { \
                const bf16x8 vf_ = (bf16x8){vl_[i_][0], vl_[i_][1], vl_[i_][2], vl_[i_][3], vh_[i_][0], vh_[i_][1], vh_[i_][2], vh_[i_][3]}; \
                o[i_ >> 2] = __builtin_amdgcn_mfma_f32_32x32x16_bf16(vf_, __builtin_bit_cast(bf16x8, pw_[i_ & 3]), o[i_ >> 2], 0, 0, 0); } } while (0)
        if (!(PROBE & 1)) {
        if (MB_ACT(3)) MB_QKT(pA0, pA1, mA, 3);
        if (MB_ACT(2)) MB_QKT(pB0, pB1, mB, 2);
        if (MB_ACT(3)) MB_SMPV(pA0, pA1, mA, 3);
        }
        if (xn & 1u) { MB_STAGE(i + 1, Dn);
            MB_FETCH(i + 2, ent_, xnn); if (xnn & 1u) { MobaDesc Dnn; MB_UNPACK(xnn, Dnn); MB_SMALL(i + 2, ent_, Dnn); } } else xnn = 0u;
        if (!(PROBE & 1)) {
        if (!(PROBE & 64)) if (MB_ACT(1)) MB_QKT(pA0, pA1, mA, 1);
        if (MB_ACT(2)) MB_SMPV(pB0, pB1, mB, 2);
        if (!(PROBE & 64)) MB_QKT(pB0, pB1, mB, 0);
        }
        if (xn & 1u) { MB_FETCH(i + 1, ent_, xn); MB_QROW(i + 1, ent_, Dn, meta_n, qr, pq_n); }
        if (!(PROBE & 1)) {
        if (!(PROBE & 64)) if (MB_ACT(1)) MB_SMPV(pA0, pA1, mA, 1);
        if (!(PROBE & 64)) MB_SMPV(pB0, pB1, mB, 0);
        }
#undef MB_QKT
#undef MB_SMPV
#undef MB_ACT
#undef MB_CH
#undef MB_QX
        __builtin_amdgcn_s_waitcnt(0); __builtin_amdgcn_s_barrier();
        const int h_o = D.h; const bool valid_o = valid; const int qrow_o = qrow, slot_o = slot;
        xc = xn; xn = xnn; D = Dn; meta = meta_n; pq = pq_n;
        if (xc & 1u) { pbase = ((const ATT_LAS float*)(shm3 + MB_POSK + ((i + 1) % 3) * 1024))[0]; MB_CHEAP(i + 1, D, meta, pq, cm); }
        if (xn & 1u) { MobaDesc Dt; MB_UNPACK(xn, Dt); MB_DMA(Dt, cur * MB_REG); }
        { auto rr = __builtin_amdgcn_permlane32_swap(__float_as_uint(l_reg), __float_as_uint(l_reg), false, false); l_reg = __uint_as_float(rr[0]) + __uint_as_float(rr[1]); }
        { const float rl = __builtin_amdgcn_rcpf(l_reg);
          bf16_t* prow = C.part + ((((size_t)(qrow_o * 8 + h_o) * 4 + slot_o) * 64) & (PROBE ? ((PROBE & 4) ? (size_t)0x3FFC0 : (size_t)0x7FFFC0) : ~(size_t)0)) + 8 * hi;
#pragma unroll
          for (int dh = 0; dh < 2; ++dh)
#pragma unroll
            for (int jp = 0; jp < 2; ++jp) {
                unsigned a0 = cvtpk(o[dh][8 * jp] * rl, o[dh][8 * jp + 1] * rl), a1 = cvtpk(o[dh][8 * jp + 2] * rl, o[dh][8 * jp + 3] * rl);
                unsigned b0 = cvtpk(o[dh][8 * jp + 4] * rl, o[dh][8 * jp + 5] * rl), b1 = cvtpk(o[dh][8 * jp + 6] * rl, o[dh][8 * jp + 7] * rl);
                const auto s0 = __builtin_amdgcn_permlane32_swap(a0, b0, false, false); const auto s1 = __builtin_amdgcn_permlane32_swap(a1, b1, false, false);
                if (!(PROBE & 2)) if (valid_o) *(u32x4*)(prow + 32 * dh + 16 * jp) = (u32x4){s0[0], s1[0], s0[1], s1[1]}; }
          if (!(PROBE & 2)) if (hi == 0 && valid_o) C.plse[(size_t)(qrow_o * 8 + h_o) * 4 + slot_o] = mhat + __builtin_log2f(l_reg); }
    }
    if (i < MB_NUT) break;
  }
#undef MB_UNPACK
#undef MB_DMA
#undef MB_FETCH
#undef MB_SMALL
#undef MB_STAGE
#undef MB_QROW
#undef MB_CHEAP
}
}

namespace xb {
#define LAS __attribute__((address_space(3)))
#define XB_TMO      128
#define XB_XCNT(j)  (256  + 64 * (j))
#define XB_XSUB(j)  (1280 + 64 * (j))
#define XB_XGEN(j)  (2304 + 64 * (j))
#define XB_TOP      3328
#define XB_TOPGEN   3392
#define XCD_BAR_WORDS 3456
#define XB_SPIN_CAP (1u << 21)

__device__ __forceinline__ unsigned xb_ld(unsigned* p)              { return __hip_atomic_load(p, __ATOMIC_RELAXED, __HIP_MEMORY_SCOPE_AGENT); }
__device__ __forceinline__ unsigned xb_add(unsigned* p, unsigned v) { return __hip_atomic_fetch_add(p, v, __ATOMIC_RELAXED, __HIP_MEMORY_SCOPE_AGENT); }
__device__ __forceinline__ unsigned xb_xcc_id() { return (unsigned)__builtin_amdgcn_s_getreg((3 << 11) | 20) & 0xFu; }
#define XB_SPIN(cond, bar) do { unsigned _sp = 0; while (cond) { __builtin_amdgcn_s_sleep(1); \
    if ((++_sp & 255u) == 0u) { if (xb_ld(&(bar)[XB_TMO])) break; if (_sp > XB_SPIN_CAP) { atomicAdd(&(bar)[XB_TMO], 1u); break; } } } } while (0)

struct XcdBarrier {
    unsigned* bar; unsigned x;
    volatile LAS unsigned* st;
};

__device__ __forceinline__ XcdBarrier xcd_barrier_post(unsigned* bar, volatile LAS unsigned* st, bool leader) {
    XcdBarrier b; b.bar = bar; b.x = xb_xcc_id(); b.st = st;
    if (leader) (void)xb_add(&bar[XB_XCNT(b.x)], 1u);
    return b;
}
__device__ __forceinline__ void xcd_barrier_complete(unsigned* bar, unsigned x, unsigned& nloc, unsigned& nx) {
    const unsigned G = gridDim.x * gridDim.y * gridDim.z;
    unsigned sum, cnt, mine, sp = 0u;
    for (;;) {
        sum = 0u; cnt = 0u; mine = 0u;
#pragma unroll
        for (unsigned j = 0; j < 16; ++j) { const unsigned c = xb_ld(&bar[XB_XCNT(j)]); sum += c; cnt += (c > 0u) ? 1u : 0u; mine = (j == x) ? c : mine; }
        if (sum == G) break;
        __builtin_amdgcn_s_sleep(1);
        if ((++sp & 255u) == 0u) { if (xb_ld(&bar[XB_TMO])) break; if (sp > XB_SPIN_CAP) { atomicAdd(&bar[XB_TMO], 1u); break; } }
    }
    nloc = mine > 0u ? mine : 1u; nx = cnt > 0u ? cnt : 1u;
}

__device__ __forceinline__ void xcd_barrier(const XcdBarrier& b, bool leader) {
    asm volatile("s_waitcnt vmcnt(0)" ::: "memory");
    __syncthreads();
    if (leader) {
        unsigned* bar = b.bar;
        __builtin_amdgcn_s_waitcnt(0);
        unsigned nloc = b.st[0], nx = b.st[1];
        if (nloc == 0u) { xcd_barrier_complete(bar, b.x, nloc, nx); b.st[0] = nloc; b.st[1] = nx; }
        const unsigned old = xb_add(&bar[XB_XSUB(b.x)], 1u);
        const unsigned gen = old / nloc;
        if (old + 1u == (gen + 1u) * nloc) {
            __builtin_amdgcn_fence(__ATOMIC_RELEASE, "agent");
            asm volatile("s_waitcnt vmcnt(0)" ::: "memory");
            const unsigned og = xb_add(&bar[XB_TOP], 1u);
            const unsigned tg = og / nx;
            if (og + 1u == (tg + 1u) * nx) xb_add(&bar[XB_TOPGEN], 1u);
            else XB_SPIN(xb_ld(&bar[XB_TOPGEN]) == tg, bar);
            __builtin_amdgcn_fence(__ATOMIC_ACQUIRE, "agent");
            xb_add(&bar[XB_XGEN(b.x)], 1u);
            asm volatile("s_waitcnt vmcnt(0)" ::: "memory");
        } else {
            XB_SPIN(xb_ld(&bar[XB_XGEN(b.x)]) == gen, bar);
            __builtin_amdgcn_fence(__ATOMIC_ACQUIRE, "agent");
            asm volatile("s_waitcnt vmcnt(0)" ::: "memory");
        }
    }
    __syncthreads();
}

#undef LAS
}
namespace mk {
typedef unsigned short bf16;
typedef unsigned v4u __attribute__((ext_vector_type(4)));
typedef float f32x4 __attribute__((ext_vector_type(4)));
#define MK_LAS __attribute__((address_space(3)))
using namespace mkc;
constexpr int NWAVES = 8;
constexpr int RING_BYTES = 131072, LDS_EXTRA = RING_BYTES, LDS_MISC = RING_BYTES + 8192, LDS_BYTES = 150528;
constexpr size_t WS_BAR = 4096, BAR_BYTES = 32768;

struct Args { const float* in[18]; float* out; unsigned char* ws; int ph_lo, ph_hi; };
struct Frame { MK_LAS unsigned char* lds; int tid, lane, wave, vcu, G; };
typedef const __attribute__((address_space(4))) Args* kargs_t;
__device__ __forceinline__ kargs_t kargs() { kargs_t p = (kargs_t)__builtin_amdgcn_kernarg_segment_ptr(); asm volatile("" : "+s"(p)); return p; }
__device__ __forceinline__ Frame mkframe(MK_LAS unsigned char* lds, int wave) { Frame F; F.lds = lds; F.wave = wave; F.lane = pg8::lane_id_v(); F.tid = wave * 64 + F.lane; F.G = gridDim.x;
    { const int bx = blockIdx.x; F.vcu = (F.G % 8 == 0) ? (bx % 8) * (F.G / 8) + bx / 8 : bx; } return F; }

__device__ __forceinline__ unsigned f2bf(float f) { unsigned u = __builtin_bit_cast(unsigned, f); return (u + 0x7fffu + ((u >> 16) & 1u)) >> 16; }
__device__ __forceinline__ unsigned pk2(float lo, float hi) { return f2bf(lo) | (f2bf(hi) << 16); }
__device__ __forceinline__ float bf2f(unsigned short b) { return __builtin_bit_cast(float, (unsigned)b << 16); }
__device__ __forceinline__ float wave_sum(float v) {
#pragma unroll
    for (int o = 1; o < 64; o <<= 1) v += __shfl_xor(v, o);
    return v;
}
__constant__ float ROPE_INV[16] = {1.000000000e+00f, 5.623413324e-01f, 3.162277639e-01f, 1.778279394e-01f, 1.000000015e-01f, 5.623413250e-02f, 3.162277490e-02f, 1.778279431e-02f,
                                   9.999999776e-03f, 5.623413250e-03f, 3.162277630e-03f, 1.778279431e-03f, 1.000000047e-03f, 5.623413017e-04f, 3.162277571e-04f, 1.778279402e-04f};
__device__ __forceinline__ int rope_phys(int L) { return L < 16 ? 8 * (L >> 2) + (L & 3) : 8 * ((L - 16) >> 2) + 4 + ((L - 16) & 3); }

__device__ __forceinline__ void p0_item(const float* W, int K, int N, bf16* WT, const float* gain, int kind, MK_LAS float* scr, int item, int lane) {
    const int nblk = N / 32, kb = item / nblk, nb = item % nblk, k0 = 64 * kb, n0 = 32 * nb;
    int dbase = n0; bool perm = false; float mul = 1.0f;
    if (kind == 1) dbase = (n0 >> 7) * 256 + (n0 & 127);
    else if (kind == 2) dbase = (n0 >> 7) * 256 + 128 + (n0 & 127);
    else if (kind == 3) { if (n0 == 640) perm = true; else if (n0 >= 672) { dbase = n0 + 96; if (n0 < 1184) mul = C2M; } }
    else if (kind == 4) { perm = (n0 % 96) == 64; mul = C2Q; }
    else if (kind == 5) { const int h = n0 >> 7, e = n0 & 127; dbase = e < 64 ? h * 64 + e : 512 + h * 64 + (e - 64); }
    float wv[32];
#pragma unroll
    for (int i = 0; i < 32; ++i) wv[i] = W[(size_t)(k0 + 2 * i + (lane >> 5)) * N + n0 + (lane & 31)];
#pragma unroll
    for (int i = 0; i < 32; ++i) { const int kk = 2 * i + (lane >> 5); const float g = gain ? gain[k0 + kk] * mul : mul; scr[kk * 33 + (lane & 31)] = wv[i] * g; }
    asm volatile("s_waitcnt lgkmcnt(0)" ::: "memory");
    const int c = lane & 7;
#pragma unroll
    for (int j = 0; j < 4; ++j) { const int n = (lane >> 3) + 8 * j; const MK_LAS float* s = scr + (8 * c) * 33 + n;
        v4u o; o.x = pk2(s[0 * 33], s[1 * 33]); o.y = pk2(s[2 * 33], s[3 * 33]); o.z = pk2(s[4 * 33], s[5 * 33]); o.w = pk2(s[6 * 33], s[7 * 33]);
        const int drow = dbase + (perm ? rope_phys(n) : n);
        *(v4u*)(WT + (size_t)drow * K + k0 + 8 * c) = o; }
    asm volatile("s_waitcnt lgkmcnt(0)" ::: "memory");
}
constexpr int I_G = (DM / 64) * (DFF / 32), I_D = (DFF / 64) * (DM / 32), I_IN = (DM / 64) * (2208 / 32), I_UQ = (384 / 64) * (768 / 32), I_UKV = (256 / 64) * (1024 / 32), I_O = (DM / 64) * (DM / 32);
constexpr int NITEMS = 4 * I_G + 2 * I_D + I_IN + I_UQ + I_UKV + I_O;
__device__ __forceinline__ void p0_one_item(kargs_t ap, unsigned char* ws, MK_LAS float* scr, int it, int lane) {
    int r = it;
    if (r < I_G) { p0_item(ap->in[3], DM, DFF, (bf16*)(ws + WS_WGU1), ap->in[2], 1, scr, r, lane); return; } r -= I_G;
    if (r < I_G) { p0_item(ap->in[4], DM, DFF, (bf16*)(ws + WS_WGU1), ap->in[2], 2, scr, r, lane); return; } r -= I_G;
    if (r < I_D) { p0_item(ap->in[5], DFF, DM, (bf16*)(ws + WS_WD1), nullptr, 0, scr, r, lane); return; } r -= I_D;
    if (r < I_G) { p0_item(ap->in[14], DM, DFF, (bf16*)(ws + WS_WGU2), ap->in[13], 1, scr, r, lane); return; } r -= I_G;
    if (r < I_G) { p0_item(ap->in[15], DM, DFF, (bf16*)(ws + WS_WGU2), ap->in[13], 2, scr, r, lane); return; } r -= I_G;
    if (r < I_D) { p0_item(ap->in[16], DFF, DM, (bf16*)(ws + WS_WD2), nullptr, 0, scr, r, lane); return; } r -= I_D;
    if (r < I_IN) { p0_item(ap->in[7], DM, 2208, (bf16*)(ws + WS_WIN), ap->in[6], 3, scr, r, lane); return; } r -= I_IN;
    if (r < I_UQ) { p0_item(ap->in[9], 384, 768, (bf16*)(ws + WS_WUQ), ap->in[8], 4, scr, r, lane); return; } r -= I_UQ;
    if (r < I_UKV) { p0_item(ap->in[11], 256, 1024, (bf16*)(ws + WS_WUKV), ap->in[10], 5, scr, r, lane); return; } r -= I_UKV;
    p0_item(ap->in[12], DM, DM, (bf16*)(ws + WS_WOUT), nullptr, 0, scr, r, lane);
}
__device__ __forceinline__ void p0_tables_and_zero(kargs_t ap, const int gt, const int NGT) {
    unsigned char* ws = ap->ws;
    const int* pos = (const int*)ap->in[1]; float* posf = (float*)(ws + WS_POSF); float* cosT = (float*)(ws + WS_COS); float* sinT = (float*)(ws + WS_SIN);
    for (int e = gt; e < S * 16; e += NGT) { const int s_ = e >> 4, i = e & 15; const float ang = (float)pos[s_] * ROPE_INV[i]; float sn, cs; sincosf(ang, &sn, &cs); cosT[e] = cs; sinT[e] = sn; if (i == 0) posf[s_] = (float)pos[s_]; }
    for (int e = gt; e < S / 64; e += NGT) { int m_ = pos[64 * e]; for (int j = 1; j < 64; ++j) m_ = max(m_, pos[64 * e + j]); posf[S + e] = (float)m_; }
    float* z = (float*)(ws + WS_SS2);
    for (int e = gt; e < 5 * S; e += NGT) z[e] = 0.f;
    float* km = (float*)(ws + WS_KMS);
    for (int e = gt; e < 64 * 512; e += NGT) km[e] = 0.f;
    unsigned* cnt = (unsigned*)(ws + WS_CNT);
    for (int e = gt; e < 512; e += NGT) cnt[e] = 0u;
    unsigned* padz = (unsigned*)((bf16*)(ws + WS_WIN) + (size_t)672 * DM);
    for (int e = gt; e < 96 * DM / 2; e += NGT) padz[e] = 0u;
}
__device__ __forceinline__ void p0_late_items(const Frame& F, kargs_t ap) {
    unsigned char* ws = ap->ws; MK_LAS float* scr = (MK_LAS float*)(F.lds + F.wave * 16384);
    const int w = ((int)blockIdx.x - 128) * NWAVES + F.wave, NW_ = 128 * NWAVES;
    for (int it = 2 * I_G + w; it < NITEMS; it += NW_) p0_one_item(ap, ws, scr, it, F.lane);
    p0_tables_and_zero(ap, w * 64 + F.lane, NW_ * 64);
}
__device__ __forceinline__ void p0_prologue(const Frame& F, kargs_t ap) {
    unsigned char* ws = ap->ws;
    MK_LAS float* scr = (MK_LAS float*)(F.lds + F.wave * 16384);
    const int gw = F.vcu * NWAVES + F.wave, NGW = F.G * NWAVES;
    constexpr int N_EARLY = 2 * I_G;
    const int n_here = (F.G == 256) ? N_EARLY : NITEMS;
    for (int it = gw; it < n_here; it += NGW) p0_one_item(ap, ws, scr, it, F.lane);
    const float* x = ap->in[0]; bf16* xb = (bf16*)(ws + WS_XB); float* ss1 = (float*)(ws + WS_SS1);
    for (int m = gw; m < S; m += 4 * NGW) {
        f32x4 v[4][4];
#pragma unroll
        for (int r = 0; r < 4; ++r) { const int mr = m + r * NGW; if (mr < S) { const f32x4* xr = (const f32x4*)(x + (size_t)mr * DM) + F.lane;
#pragma unroll
            for (int j = 0; j < 4; ++j) v[r][j] = xr[64 * j]; } }
#pragma unroll
        for (int r = 0; r < 4; ++r) { const int mr = m + r * NGW; if (mr < S) { unsigned long long* o8 = (unsigned long long*)(xb + (size_t)mr * DM) + F.lane; float s = 0.f;
#pragma unroll
            for (int j = 0; j < 4; ++j) { const f32x4 w = v[r][j]; s += (w[0] * w[0] + w[1] * w[1]) + (w[2] * w[2] + w[3] * w[3]); o8[64 * j] = (unsigned long long)pk2(w[0], w[1]) | ((unsigned long long)pk2(w[2], w[3]) << 32); }
            s = wave_sum(s); if (F.lane == 0) ss1[mr] = s; } }
    }
    if (F.G != 256) p0_tables_and_zero(ap, (F.vcu * NWAVES + F.wave) * 64 + F.lane, NGW * 64);
}

__device__ __forceinline__ void p4_krope(const Frame& F, kargs_t ap) { unsigned char* const wsb = ap->ws;
    const bf16* cqkv = (const bf16*)(wsb + WS_CQKV); bf16* Kr = (bf16*)(wsb + WS_KR); const float* cosT = (const float*)(wsb + WS_COS); const float* sinT = (const float*)(wsb + WS_SIN);
    const int gt = (F.vcu * NWAVES + F.wave) * 64 + F.lane, NGT = F.G * NWAVES * 64;
    for (int e = gt; e < S * 16; e += NGT) { const int s_ = e >> 4, i = e & 15, g = i >> 2, j = i & 3;
        const float x1 = bf2f(cqkv[(size_t)s_ * 768 + 640 + 8 * g + j]), x2 = bf2f(cqkv[(size_t)s_ * 768 + 640 + 8 * g + 4 + j]); const float c = cosT[e], sn = sinT[e];
        Kr[(size_t)s_ * 32 + 8 * g + j] = (bf16)f2bf(x1 * c - x2 * sn); Kr[(size_t)s_ * 32 + 8 * g + 4 + j] = (bf16)f2bf(x1 * sn + x2 * c); }
}
__device__ __forceinline__ void p4_gating(const Frame& F, kargs_t ap) { unsigned char* const wsb = ap->ws;
    const bf16* mqkv = (const bf16*)(wsb + WS_MQKV); const float* kms = (const float*)(wsb + WS_KMS); unsigned* cnt = (unsigned*)(wsb + WS_CNT); unsigned* lists = (unsigned*)(wsb + WS_LIST);
    MK_LAS float* km = (MK_LAS float*)F.lds;
    const int u0 = (F.G == 256) ? ((int)blockIdx.x < 192 ? (int)blockIdx.x : 256) : F.vcu, ustep = (F.G == 256) ? 192 : F.G;
    for (int u = u0; u < 256; u += ustep) {
        const int h = u & 7, q = (u >> 3) * 512 + F.tid, own = q >> 8;
        __syncthreads();
        for (int e = F.tid; e < 4096; e += 512) km[e] = kms[(size_t)(e >> 6) * 512 + h * 64 + (e & 63)] * (1.0f / 256.0f);
        __syncthreads();
        float qv[64];
        { const v4u* qp = (const v4u*)(mqkv + (size_t)q * 1536 + h * 64);
#pragma unroll
          for (int c = 0; c < 8; ++c) { const v4u w = qp[c];
#pragma unroll
              for (int j = 0; j < 4; ++j) { qv[8 * c + 2 * j] = __builtin_bit_cast(float, w[j] << 16); qv[8 * c + 2 * j + 1] = __builtin_bit_cast(float, w[j] & 0xFFFF0000u); } } }
        float g0 = -3e38f, g1 = -3e38f, g2 = -3e38f; int i0 = -1, i1 = -1, i2 = -1;
        const int own_max = __builtin_amdgcn_readfirstlane(own);
        for (int n = 0; n < own_max; ++n) {
            float g = 0.f;
#pragma unroll
            for (int c = 0; c < 16; ++c) { const f32x4 kk = *(const MK_LAS f32x4*)(km + n * 64 + 4 * c); g = fmaf(qv[4 * c], kk[0], g); g = fmaf(qv[4 * c + 1], kk[1], g); g = fmaf(qv[4 * c + 2], kk[2], g); g = fmaf(qv[4 * c + 3], kk[3], g); }
            if (g > g0) { g2 = g1; i2 = i1; g1 = g0; i1 = i0; g0 = g; i0 = n; }
            else if (g > g1) { g2 = g1; i2 = i1; g1 = g; i1 = n; }
            else if (g > g2) { g2 = g; i2 = n; }
        }
        MK_LAS unsigned* lcnt = (MK_LAS unsigned*)(F.lds + 16384);
        __syncthreads();
        if (F.tid < 64) lcnt[F.tid] = 0u;
        __syncthreads();
        unsigned r0 = 0u, r1 = 0u, r2 = 0u;
        if (i0 >= 0) r0 = __hip_atomic_fetch_add(lcnt + i0, 1u, __ATOMIC_RELAXED, __HIP_MEMORY_SCOPE_WORKGROUP);
        if (i1 >= 0) r1 = __hip_atomic_fetch_add(lcnt + i1, 1u, __ATOMIC_RELAXED, __HIP_MEMORY_SCOPE_WORKGROUP);
        if (i2 >= 0) r2 = __hip_atomic_fetch_add(lcnt + i2, 1u, __ATOMIC_RELAXED, __HIP_MEMORY_SCOPE_WORKGROUP);
        __syncthreads();
        if (F.tid < 64) { const unsigned c = lcnt[F.tid]; lcnt[64 + F.tid] = c ? atomicAdd(cnt + h * 64 + F.tid, c) : 0u; }
        __syncthreads();
        if (i0 >= 0) lists[(size_t)(h * 64 + i0) * S + lcnt[64 + i0] + r0] = (unsigned)(q | (0 << 14));
        if (i1 >= 0) lists[(size_t)(h * 64 + i1) * S + lcnt[64 + i1] + r1] = (unsigned)(q | (1 << 14));
        if (i2 >= 0) lists[(size_t)(h * 64 + i2) * S + lcnt[64 + i2] + r2] = (unsigned)(q | (2 << 14));
    }
    __syncthreads();
}
__device__ __forceinline__ void p5_combine(const Frame& F, kargs_t ap) { unsigned char* const wsb = ap->ws;
    const bf16* part = (const bf16*)ap->out;     const float* plse = (const float*)(wsb + WS_PLSE); bf16* cat = (bf16*)(wsb + WS_CAT);
    const int gt = (F.vcu * NWAVES + F.wave) * 64 + F.lane, NGT = F.G * NWAVES * 64;
    for (int e = gt; e < S * 8 * 8; e += NGT) { const int dg = e & 7, qh = e >> 3, q = qh >> 3, h = qh & 7; const int ns = 1 + min(3, q >> 8);
        const f32x4 ls = *(const f32x4*)(plse + (size_t)qh * 4);
        float M = ls[0]; for (int s = 1; s < 4; ++s) if (s < ns) M = fmaxf(M, ls[s]);
        float acc[8], wsum = 0.f;
#pragma unroll
        for (int j = 0; j < 8; ++j) acc[j] = 0.f;
#pragma unroll
        for (int s = 0; s < 4; ++s) if (s < ns) { const float w = __builtin_amdgcn_exp2f(ls[s] - M); wsum += w; const v4u v = *(const v4u*)(part + ((size_t)qh * 4 + s) * 64 + dg * 8);
#pragma unroll
            for (int j = 0; j < 4; ++j) { acc[2 * j] += w * __builtin_bit_cast(float, v[j] << 16); acc[2 * j + 1] += w * __builtin_bit_cast(float, v[j] & 0xFFFF0000u); } }
        const float r = 1.0f / wsum; v4u o; o.x = pk2(acc[0] * r, acc[1] * r); o.y = pk2(acc[2] * r, acc[3] * r); o.z = pk2(acc[4] * r, acc[5] * r); o.w = pk2(acc[6] * r, acc[7] * r);
        *(v4u*)(cat + (size_t)q * 1024 + 512 + h * 64 + dg * 8) = o; }
}
__device__ __forceinline__ void p9_final(const Frame& F, kargs_t ap) { unsigned char* const wsb = ap->ws;
    const float* ss = (const float*)(wsb + WS_SS4); const float* g = ap->in[17];
    const int gw = F.vcu * NWAVES + F.wave, NGW = F.G * NWAVES;
    float tsc = 1.0f;
#ifdef MK_TS
    { const unsigned long long* ts = (const unsigned long long*)(wsb + 2048); tsc = 1.0f + (float)(ts[MK_TS + 1] - ts[MK_TS]) * (float)MK_TS_SCALE; }
#endif
    for (int m = gw; m < S; m += NGW) { const float rs = tsc / sqrtf(ss[m] * (1.0f / 1024.0f) + 1e-6f); f32x4* xr = (f32x4*)(ap->out + (size_t)m * DM) + F.lane; const f32x4* gr = (const f32x4*)g + F.lane;
#pragma unroll
        for (int j = 0; j < 4; ++j) { const f32x4 v = xr[64 * j]; xr[64 * j] = v * rs * gr[64 * j]; } }
}

__global__ void __launch_bounds__(NWAVES * 64, 2) mk_fwd(Args a_unused) {
    extern __shared__ __attribute__((aligned(16))) unsigned char lds[];
    const int wave = __builtin_amdgcn_readfirstlane(threadIdx.x >> 6);
    MK_LAS unsigned char* const ldsp = (MK_LAS unsigned char*)lds;
    int lo, hi; { kargs_t ap = kargs(); lo = ap->ph_lo; hi = ap->ph_hi; }
#ifndef MK_ONLY
#define MK_ONLY -1
#endif
#define IN(k) ((MK_ONLY < 0 || MK_ONLY == (k)) && lo <= (k) && (k) < hi)
    const bool multi = (hi - lo) > 1;
    if (multi) {
        const int l0 = pg8::lane_id_v();
        if (wave == 0 && l0 < 2) ((volatile MK_LAS unsigned*)(ldsp + LDS_MISC))[l0] = 0u;
        __syncthreads();
        kargs_t ap = kargs(); (void)xb::xcd_barrier_post((unsigned*)(ap->ws + WS_BAR), (volatile MK_LAS unsigned*)(ldsp + LDS_MISC), wave == 0 && l0 == 0);
    }
    if (lo < -1) cg::this_grid().sync();
#ifdef MK_TS
#define MK_STAMP(i) do { if (blockIdx.x == 0 && wave == 0 && pg8::lane_id_v() == 0) { kargs_t ap__ = kargs(); ((unsigned long long*)(ap__->ws + 2048))[(i)] = __builtin_amdgcn_s_memrealtime(); } } while (0)
#else
#define MK_STAMP(i) do { } while (0)
#endif
    MK_STAMP(0);
#define SEAM(k) do { if (IN(k) && IN((k) + 1)) { kargs_t ap_ = kargs(); xb::XcdBarrier b_; b_.bar = (unsigned*)(ap_->ws + WS_BAR); b_.x = xb::xb_xcc_id(); b_.st = (volatile MK_LAS unsigned*)(ldsp + LDS_MISC); \
        xb::xcd_barrier(b_, wave == 0 && pg8::lane_id_v() == 0); MK_STAMP((k) + 1); } } while (0)
    if (IN(0)) { kargs_t ap = kargs(); const Frame F = mkframe(ldsp, wave); p0_prologue(F, ap); } SEAM(0);
    if (IN(1)) { kargs_t ap = kargs(); unsigned char* ws = ap->ws; pg8::Gemm g{(const bf16*)(ws + WS_XB), (const bf16*)(ws + WS_WGU1), S, NGU, DM, DM}; pg8::StaticOrder So; So.init(S, NGU, (int)gridDim.x, (int)blockIdx.x);
        pg8::EpiSwiGLU E{ws, 0}; pg8::gemm_phase<pg8::EpiSwiGLU, pg8::StaticOrder, true, true>(ldsp, g, So, E, wave);
        if (gridDim.x == 256 && blockIdx.x >= 128) { kargs_t ap2 = kargs(); const Frame F = mkframe(ldsp, wave); __syncthreads(); p0_late_items(F, ap2); } } SEAM(1);
    if (IN(2)) { kargs_t ap = kargs(); unsigned char* ws = ap->ws; pg8::Gemm g{(const bf16*)(ws + WS_ACT), (const bf16*)(ws + WS_WD1), S, DM, DFF, DFF}; pg8::StaticOrder So; So.init(S, DM, (int)gridDim.x, (int)blockIdx.x);
        pg8::EpiResid E{nullptr, ws, (int)WS_SS2, 0.5f}; pg8::gemm_phase<pg8::EpiResid, pg8::StaticOrder, true, true>(ldsp, g, So, E, wave); } SEAM(2);
    if (IN(3)) { kargs_t ap = kargs(); unsigned char* ws = ap->ws; pg8::Gemm g{(const bf16*)(ws + WS_XB), (const bf16*)(ws + WS_WIN), S, NWIN, DM, DM}; pg8::StaticOrder So; So.init(S, gridDim.x == 256 ? NWIN - 256 : NWIN, (int)gridDim.x, (int)blockIdx.x);
        pg8::EpiWin E{ws, 0}; pg8::gemm_phase<pg8::EpiWin, pg8::StaticOrder, true, true>(ldsp, g, So, E, wave); } SEAM(3);
    if (IN(4)) {
        { kargs_t ap = kargs(); unsigned char* ws = ap->ws; pg8::Gemm g{(const bf16*)(ws + WS_CQKV) + 384, (const bf16*)(ws + WS_WUKV), S, 1024, 256, 768}; pg8::StaticOrder So; So.init(S, 1024, (int)gridDim.x, (int)blockIdx.x);
          pg8::EpiKV E{ws}; pg8::gemm_phase<pg8::EpiKV, pg8::StaticOrder, true, true>(ldsp, g, So, E, wave); }
        { kargs_t ap = kargs(); unsigned char* ws = ap->ws; pg8::Gemm g{(const bf16*)(ws + WS_CQKV), (const bf16*)(ws + WS_WUQ), S, 768, 384, 768}; pg8::StaticOrder So; So.init(S, 768, (int)gridDim.x, (int)blockIdx.x);
          pg8::EpiQ E{ws}; pg8::gemm_phase<pg8::EpiQ, pg8::StaticOrder, true, true>(ldsp, g, So, E, wave); }
        if (gridDim.x == 256) { kargs_t ap = kargs(); unsigned char* ws = ap->ws; pg8::Gemm g{(const bf16*)(ws + WS_XB), (const bf16*)(ws + WS_WIN), S, NWIN, DM, DM}; pg8::TailOrder So; So.init(S, 8, (int)gridDim.x, (int)blockIdx.x);
          pg8::EpiWin E{ws, 0}; pg8::gemm_phase<pg8::EpiWin, pg8::TailOrder, true, true>(ldsp, g, So, E, wave); }
        { kargs_t ap = kargs(); const Frame F = mkframe(ldsp, wave); p4_krope(F, ap); }
#ifndef MK_NO_GATE
        { kargs_t ap = kargs(); const Frame F = mkframe(ldsp, wave); p4_gating(F, ap); }
#endif
    } SEAM(4);
#ifndef MK_NO_ATT5
    if (IN(5)) {
        kargs_t ap = kargs(); unsigned char* ws = ap->ws; const Frame F = mkframe(ldsp, wave);
        MK_LAS int* pre = (MK_LAS int*)(ldsp + att::MB_PRE);
        const unsigned* cnt = (const unsigned*)(ws + WS_CNT);
        __syncthreads();
        { const int c = (int)cnt[F.tid]; pre[F.tid] = (c + 255) >> 8; }
        __syncthreads();
        for (int o = 1; o < 512; o <<= 1) { const int v = pre[F.tid] + (F.tid >= o ? pre[F.tid - o] : 0); __syncthreads(); pre[F.tid] = v; __syncthreads(); }
        att::MobaCtx C; C.mqkv = (const bf16*)(ws + WS_MQKV); C.posf = (const float*)(ws + WS_POSF); C.part = (bf16*)ap->out; C.plse = (float*)(ws + WS_PLSE);
        C.lists = (const unsigned*)(ws + WS_LIST); C.cnt = cnt; C.total = pre[511]; C.vcu = F.vcu; C.G = F.G;
        att::moba_run<0>(C, (char*)lds, wave);
#ifdef MK_PROBE5
        __syncthreads(); C.part = (bf16*)(ws + WS_CQKV); C.plse = (float*)(ws + WS_CQKV + (16u << 20)); att::moba_run<MK_PROBE5>(C, (char*)lds, wave);
#endif
    }
#endif
    SEAM(5);
    if (IN(6)) {
        { kargs_t ap = kargs(); const Frame F = mkframe(ldsp, wave); p5_combine(F, ap); }
#ifndef MK_NO_ATT6
        kargs_t ap = kargs(); unsigned char* ws = ap->ws; const Frame F = mkframe(ldsp, wave);
        att::Unit U; U.posf = nullptr; U.part = nullptr; U.plse = nullptr; U.list = nullptr; U.len = 0; U.slope2 = 0.f; U.q_pitch = 768; U.k_pitch = 512; U.v_pitch = 512; U.o_pitch = 1024; U.key0 = 0; U.Kr = (const bf16*)(ws + WS_KR);
        for (int v = F.vcu; v < 256; v += F.G) { const int h = v >> 5, s_ = v & 31;
            for (int i = 0; i < 2; ++i) { const int qb = i == 0 ? 63 - s_ : s_;
                U.h = h; U.Q = (const bf16*)(ws + WS_Q) + h * 96; U.K = (const bf16*)(ws + WS_KN) + h * 64; U.V = (const bf16*)(ws + WS_V) + h * 64; U.O = (bf16*)(ws + WS_CAT) + h * 64; U.q0 = qb * 256; U.ntiles = 4 * (qb + 1);
                att::unit<0>(U, (char*)lds, wave); } }
#endif
    } SEAM(6);
    if (IN(7)) { kargs_t ap = kargs(); unsigned char* ws = ap->ws; pg8::Gemm g{(const bf16*)(ws + WS_CAT), (const bf16*)(ws + WS_WOUT), S, DM, DM, DM}; pg8::StaticOrder So; So.init(S, DM, (int)gridDim.x, (int)blockIdx.x);
        pg8::EpiResid E{nullptr, ws, (int)WS_SS3, 1.0f}; pg8::gemm_phase<pg8::EpiResid, pg8::StaticOrder, true, true>(ldsp, g, So, E, wave); } SEAM(7);
    if (IN(8)) { kargs_t ap = kargs(); unsigned char* ws = ap->ws; pg8::Gemm g{(const bf16*)(ws + WS_XB), (const bf16*)(ws + WS_WGU2), S, NGU, DM, DM}; pg8::StaticOrder So; So.init(S, NGU, (int)gridDim.x, (int)blockIdx.x);
        pg8::EpiSwiGLU E{ws, 1}; pg8::gemm_phase<pg8::EpiSwiGLU, pg8::StaticOrder, true, true>(ldsp, g, So, E, wave); } SEAM(8);
    if (IN(9)) { kargs_t ap = kargs(); unsigned char* ws = ap->ws; pg8::Gemm g{(const bf16*)(ws + WS_ACT), (const bf16*)(ws + WS_WD2), S, DM, DFF, DFF}; pg8::StaticOrder So; So.init(S, DM, (int)gridDim.x, (int)blockIdx.x);
        if (gridDim.x == 256) { pg8::EpiResidNorm E{ap->out, ws, ap->in[17], 0.5f}; pg8::gemm_phase<pg8::EpiResidNorm, pg8::StaticOrder, false, true>(ldsp, g, So, E, wave); }
        else { pg8::EpiResid E{ap->out, ws, (int)WS_SS4, 0.5f}; pg8::gemm_phase<pg8::EpiResid, pg8::StaticOrder, true, true>(ldsp, g, So, E, wave); } }
    if (gridDim.x != 256) SEAM(9);
    if (IN(10) && gridDim.x != 256) { kargs_t ap = kargs(); const Frame F = mkframe(ldsp, wave); p9_final(F, ap); }
#undef IN
#undef SEAM
}
constexpr int N_PHASES = 11;
}
#ifndef MK_BRINGUP
#define MK_BRINGUP 0
#endif
extern "C" void kernel_launch(void* const* d_in, const int* in_sizes, int n_in, void* d_out, int out_size, void* d_ws, size_t ws_size, hipStream_t stream) {
    static int grid = 0;
    if (grid == 0) {
        if (hipFuncSetAttribute((const void*)mk::mk_fwd, hipFuncAttributeMaxDynamicSharedMemorySize, mk::LDS_BYTES) != hipSuccess) { fprintf(stderr, "kernel_launch: hipFuncSetAttribute failed\n"); grid = -1; return; }
        int dev = 0, cus = 0, per_cu = 0;
        hipGetDevice(&dev); hipDeviceGetAttribute(&cus, hipDeviceAttributeMultiprocessorCount, dev);
        hipOccupancyMaxActiveBlocksPerMultiprocessor(&per_cu, (const void*)mk::mk_fwd, mk::NWAVES * 64, mk::LDS_BYTES);
        (void)hipGetLastError();
        grid = cus * (per_cu < 1 ? 1 : (per_cu > 1 ? 1 : per_cu));
        if (grid % 8 != 0 || grid <= 0) grid = 256;
        if (ws_size < mk::WS_END) { fprintf(stderr, "kernel_launch: workspace too small (%zu)\n", ws_size); grid = -1; return; }
    }
    if (grid < 0) return;
    mk::Args a{};
    for (int i = 0; i < 18; ++i) a.in[i] = (const float*)d_in[i];
    a.out = (float*)d_out; a.ws = (unsigned char*)d_ws;
#if MK_BRINGUP == 0
    if (hipMemsetAsync((char*)d_ws + mk::WS_BAR, 0, mk::BAR_BYTES, stream) != hipSuccess) { fprintf(stderr, "kernel_launch: memset failed\n"); return; }
    a.ph_lo = 0; a.ph_hi = mk::N_PHASES;
    void* args[] = {&a};
    hipError_t e = hipLaunchCooperativeKernel((const void*)mk::mk_fwd, dim3(grid), dim3(mk::NWAVES * 64), args, mk::LDS_BYTES, stream);
    if (e != hipSuccess) fprintf(stderr, "cooperative launch failed: %s (grid %d)\n", hipGetErrorString(e), grid);
#else
    const int nph = MK_BRINGUP == 1 ? 3 : MK_BRINGUP == 2 ? 8 : mk::N_PHASES;
    for (int ph = 0; ph < nph; ++ph) { a.ph_lo = ph; a.ph_hi = ph + 1; hipLaunchKernelGGL(mk::mk_fwd, dim3(grid), dim3(mk::NWAVES * 64), mk::LDS_BYTES, stream, a); }
#if MK_BRINGUP == 1
    nv::part_mix(d_in, (float*)d_out, d_ws, stream); nv::part_ffn2_final(d_in, (float*)d_out, d_ws, stream);
#elif MK_BRINGUP == 2
    nv::part_ffn2_final(d_in, (float*)d_out, d_ws, stream);
#endif
#endif
}
```

```cpp
#define MK_BRINGUP 0
#include <hip/hip_runtime.h>
#include <cstdio>
#include <cstdint>
#include <cmath>
#include <hip/hip_cooperative_groups.h>
namespace cg = cooperative_groups;

namespace mkc {
constexpr int S = 16384, DM = 1024, DFF = 2816, NGU = 2 * DFF, NWIN = 2304;
constexpr float LOG2E = 1.4426950408889634f;
constexpr float C2Q = 0.10206207261596577f * LOG2E;
constexpr float C2M = 0.125f * LOG2E;
constexpr size_t MiB = 1u << 20;
constexpr size_t WS_PANEL = 4096 + 16384;
constexpr size_t WS_CNT = 0;
constexpr size_t WS_SS1 = 1 * MiB, WS_SS2 = WS_SS1 + 65536, WS_SSQ = WS_SS2 + 65536, WS_SSKV = WS_SSQ + 65536, WS_SS3 = WS_SSKV + 65536, WS_SS4 = WS_SS3 + 65536;
constexpr size_t WS_KMS = WS_SS1 + 512 * 1024;
constexpr size_t WS_SSDUMMY = WS_SS1 + 384 * 1024, WS_KMSDUMMY = WS_SS1 + 640 * 1024;
constexpr size_t WS_POSF = 2 * MiB, WS_COS = 3 * MiB, WS_SIN = 4 * MiB;
constexpr size_t WS_WGU1 = 6 * MiB, WS_WD1 = 17 * MiB, WS_WGU2 = WS_WD1 + 5632 * 1024, WS_WD2 = WS_WGU2 + 11 * MiB, WS_WIN = 39 * MiB, WS_WUQ = WS_WIN + 4608 * 1024, WS_WUKV = WS_WUQ + 768 * 1024, WS_WOUT = 45 * MiB;
constexpr size_t WS_XB = 48 * MiB, WS_CQKV = 80 * MiB, WS_PLSE = 112 * MiB;
constexpr size_t WS_ACT = 114 * MiB, WS_MQKV = 114 * MiB, WS_CAT = 114 * MiB, WS_Q = 162 * MiB, WS_KN = 186 * MiB, WS_V = 202 * MiB, WS_KR = 218 * MiB, WS_LIST = 220 * MiB, WS_END = 252 * MiB;
static_assert(WS_WD2 + 5632 * 1024 <= WS_WIN && WS_WUKV + 512 * 1024 <= WS_WOUT && WS_WOUT + 2 * MiB <= WS_XB, "weight map");
}
namespace pg8 {
#define PG8_LAS __attribute__((address_space(3)))
typedef unsigned short bf16_t;
typedef short bf16x8 __attribute__((ext_vector_type(8)));
typedef float f32x4 __attribute__((ext_vector_type(4)));
typedef unsigned u32x4 __attribute__((ext_vector_type(4)));
__device__ __forceinline__ int lane_id_v() { int l; asm volatile("v_mbcnt_lo_u32_b32 %0, -1, 0\n\tv_mbcnt_hi_u32_b32 %0, -1, %0" : "=v"(l)); return l; }
constexpr int BM = 256, BK = 64, HALF = 128, HTB = HALF * BK * 2  , STAGE_BYTES = 8 * HTB, NXCD = 8, WGM = 4;

__host__ __device__ __forceinline__ int lds_byte(int r, int c) { const int st = (r >> 4) * 2 + (c >> 5), rr = r & 15, cc = c & 31, ob = rr * 64 + cc * 2; return st * 1024 + (ob ^ (((ob >> 9) & 1) << 5)); }
__host__ __device__ __forceinline__ void stage_rc(int b, int& R, int& C) { const int st = b / 1024, sb = b % 1024, swz = sb ^ (((sb >> 9) & 1) << 5); R = (st >> 1) * 16 + swz / 64; C = (st & 1) * 32 + (swz % 64) / 2; }
__host__ __device__ __forceinline__ int perm32(int rho) { const int n = rho >> 4, i = rho & 15; return 8 * (i >> 2) + 4 * n + (i & 3); }

struct Unit { int pm, pn; };
struct Gemm { const bf16_t* A; const bf16_t* Bt; int M, N, K, lda; };

struct StaticOrder {
    int nM, nN, nwg, G, c;
    __host__ __device__ void init(int M, int N, int G_, int c_) { nM = M / BM; nN = N / BM; nwg = nM * nN; G = G_; c = c_; }
    __host__ __device__ bool next(int i, Unit& u) const {
        const long L = (long)i * G + c; if (L >= nwg) return false;
        int wgid = (int)L; { const int q = nwg / NXCD, r = nwg % NXCD, xcd = wgid % NXCD, off = wgid / NXCD; wgid = (xcd < r ? xcd * (q + 1) : r * (q + 1) + (xcd - r) * q) + off; }
        const int nig = WGM * nN, gid = wgid / nig, fm = gid * WGM, gsz = (nM - fm) < WGM ? (nM - fm) : WGM;
        u.pm = fm + ((wgid % nig) % gsz); u.pn = (wgid % nig) / gsz; return true;
    }
    __device__ __forceinline__ void a_ready(const Unit&) const {}
    __device__ __forceinline__ void done(const Unit&) const {}
};
struct TailOrder {
    int nM, pn, G, c;
    __host__ __device__ void init(int M, int pn_, int G_, int c_) { nM = M / BM; pn = pn_; G = G_; c = c_; }
    __host__ __device__ bool next(int i, Unit& u) const { const int j = c - (G - nM); if (i != 0 || j < 0 || j >= nM) return false; u.pm = j; u.pn = pn; return true; }
    __device__ __forceinline__ void a_ready(const Unit&) const {}
    __device__ __forceinline__ void done(const Unit&) const {}
};
__device__ __forceinline__ unsigned cvt_pk_bf16(float lo, float hi) { unsigned r; asm volatile("v_cvt_pk_bf16_f32 %0, %1, %2" : "=v"(r) : "v"(lo), "v"(hi)); return r; }
typedef unsigned u32x2 __attribute__((ext_vector_type(2)));
constexpr float RMS_EPS = 1e-6f;
__device__ __forceinline__ float rs_of(const float* ss, int row, float invn) { return __builtin_amdgcn_rsqf(ss[row] * invn + RMS_EPS); }
__device__ __forceinline__ float silu_f(float g) { return g * __builtin_amdgcn_rcpf(1.0f + __builtin_amdgcn_exp2f(-1.4426950408889634f * g)); }
__device__ __forceinline__ u32x4 pack8(const f32x4 a, const f32x4 b) { u32x4 w; w.x = cvt_pk_bf16(a[0], a[1]); w.y = cvt_pk_bf16(a[2], a[3]); w.z = cvt_pk_bf16(b[0], b[1]); w.w = cvt_pk_bf16(b[2], b[3]); return w; }

struct EpiSwiGLU {
    static constexpr bool PERM = true, AFTER_DRAIN = false;
    unsigned char* ws; int which;
    __device__ __forceinline__ void operator()(const f32x4 (&acc)[2][2][4][2], const Unit& u, int wr, int wc, int fr, int fq) const {
        bf16_t* O = (bf16_t*)(ws + mkc::WS_ACT); const int ldo = mkc::DFF; const float* ss = (const float*)(ws + (which ? mkc::WS_SS3 : mkc::WS_SS1)); const float invn = 1.0f / 1024.0f;
        const int row0 = u.pm * BM + wr * 64 + fr, col0 = u.pn * HALF + wc * 32 + 8 * fq;
#pragma unroll
        for (int ai = 0; ai < 2; ++ai)
#pragma unroll
            for (int m = 0; m < 4; ++m) { const int row = row0 + ai * HALF + m * 16; const float rs = rs_of(ss, row, invn);
                f32x4 a0, a1;
#pragma unroll
                for (int j = 0; j < 4; ++j) { a0[j] = silu_f(acc[ai][0][m][0][j] * rs) * (acc[ai][1][m][0][j] * rs); a1[j] = silu_f(acc[ai][0][m][1][j] * rs) * (acc[ai][1][m][1][j] * rs); }
                *(u32x4*)(O + (size_t)row * ldo + col0) = pack8(a0, a1); }
    }
};
__device__ __forceinline__ f32x4 bf4_to_f32(const u32x2 w) { f32x4 r; r[0] = __builtin_bit_cast(float, w.x << 16); r[1] = __builtin_bit_cast(float, w.x & 0xFFFF0000u); r[2] = __builtin_bit_cast(float, w.y << 16); r[3] = __builtin_bit_cast(float, w.y & 0xFFFF0000u); return r; }
struct EpiResid {
    static constexpr bool PERM = false, AFTER_DRAIN = false;
    float* out; unsigned char* ws; int ss_off; float alpha;
    __device__ __forceinline__ void operator()(const f32x4 (&acc)[2][2][4][2], const Unit& u, int wr, int wc, int fr, int fq) const {
        bf16_t* xb = (bf16_t*)(ws + mkc::WS_XB); float* ss_out = (float*)(ws + ss_off);
        const int row0 = u.pm * BM + wr * 64 + fr, col0 = u.pn * BM + wc * 32 + 4 * fq;
#pragma unroll
        for (int ai = 0; ai < 2; ++ai)
#pragma unroll
            for (int m = 0; m < 4; ++m) { const int row = row0 + ai * HALF + m * 16; const size_t off = (size_t)row * 1024 + col0; float s = 0.f;
#pragma unroll
                for (int bj = 0; bj < 2; ++bj)
#pragma unroll
                    for (int n = 0; n < 2; ++n) { const f32x4 b = bf4_to_f32(*(const u32x2*)(xb + off + bj * HALF + n * 16)); const f32x4 o = b + acc[ai][bj][m][n] * alpha;
                        if (out) *(f32x4*)(out + off + bj * HALF + n * 16) = o;
                        s += (o[0] * o[0] + o[1] * o[1]) + (o[2] * o[2] + o[3] * o[3]);
                        u32x2 w; w.x = cvt_pk_bf16(o[0], o[1]); w.y = cvt_pk_bf16(o[2], o[3]); *(u32x2*)(xb + off + bj * HALF + n * 16) = w; }
                s += __shfl_xor(s, 16); s += __shfl_xor(s, 32);
                if (fq == 0) atomicAdd(ss_out + row, s);
                asm volatile("" ::: "memory"); }
    }
};
struct EpiWin {
    static constexpr bool PERM = true, AFTER_DRAIN = false;
    unsigned char* ws; int dummy;
    __device__ __forceinline__ void operator()(const f32x4 (&acc)[2][2][4][2], const Unit& u, int wr, int wc, int fr, int fq) const {
        bf16_t* cqkv = (bf16_t*)(ws + mkc::WS_CQKV); bf16_t* mqkv = (bf16_t*)(ws + mkc::WS_MQKV); const float* ss_in = (const float*)(ws + mkc::WS_SS2);
        float* ssq = (float*)(ws + (dummy ? mkc::WS_SSDUMMY : mkc::WS_SSQ)); float* sskv = (float*)(ws + (dummy ? mkc::WS_SSDUMMY + 65536 : mkc::WS_SSKV)); float* kmsum = (float*)(ws + (dummy ? mkc::WS_KMSDUMMY : mkc::WS_KMS));
        const int row0 = u.pm * BM + wr * 64 + fr;
        const bool is_mk = (u.pn == 5 || u.pn == 6);
        f32x4 cs[2][2];
#pragma unroll
        for (int bj = 0; bj < 2; ++bj)
#pragma unroll
            for (int n = 0; n < 2; ++n) cs[bj][n] = (f32x4){0.f, 0.f, 0.f, 0.f};
#pragma unroll
        for (int ai = 0; ai < 2; ++ai)
#pragma unroll
            for (int m = 0; m < 4; ++m) { const int row = row0 + ai * HALF + m * 16; const float rs = rs_of(ss_in, row, 1.0f / 1024.0f);
#pragma unroll
                for (int bj = 0; bj < 2; ++bj) { const int colt = u.pn * BM + bj * HALF, col0 = colt + wc * 32 + 8 * fq;
                    const f32x4 v0 = acc[ai][bj][m][0] * rs, v1 = acc[ai][bj][m][1] * rs;
                    bf16_t* dst = (colt < 768) ? (cqkv + (size_t)row * 768 + col0) : (mqkv + (size_t)row * 1536 + (col0 - 768));
                    *(u32x4*)dst = pack8(v0, v1);
                    if (colt < 640) { float s = (v0[0] * v0[0] + v0[1] * v0[1]) + (v0[2] * v0[2] + v0[3] * v0[3]) + (v1[0] * v1[0] + v1[1] * v1[1]) + (v1[2] * v1[2] + v1[3] * v1[3]);
                        s += __shfl_xor(s, 16); s += __shfl_xor(s, 32);
                        if (fq == 0) atomicAdd((colt < 384 ? ssq : sskv) + row, s); }
                    if (is_mk) { cs[bj][0] += v0; cs[bj][1] += v1; } } }
        if (is_mk) {
#pragma unroll
            for (int bj = 0; bj < 2; ++bj)
#pragma unroll
                for (int n = 0; n < 2; ++n)
#pragma unroll
                    for (int j = 0; j < 4; ++j) { float s = cs[bj][n][j]; s += __shfl_xor(s, 1); s += __shfl_xor(s, 2); s += __shfl_xor(s, 4); s += __shfl_xor(s, 8);
                        if (fr == 0) atomicAdd(kmsum + (size_t)u.pm * 512 + (u.pn * BM + bj * HALF + wc * 32 + 8 * fq + 4 * n + j - 1280), s); }
        }
    }
};
struct EpiKV {
    static constexpr bool PERM = true, AFTER_DRAIN = false;
    unsigned char* ws;
    __device__ __forceinline__ void operator()(const f32x4 (&acc)[2][2][4][2], const Unit& u, int wr, int wc, int fr, int fq) const {
        bf16_t* Kn = (bf16_t*)(ws + mkc::WS_KN); bf16_t* V = (bf16_t*)(ws + mkc::WS_V); const float* ss = (const float*)(ws + mkc::WS_SSKV);
        const int row0 = u.pm * BM + wr * 64 + fr;
#pragma unroll
        for (int ai = 0; ai < 2; ++ai)
#pragma unroll
            for (int m = 0; m < 4; ++m) { const int row = row0 + ai * HALF + m * 16; const float rs = rs_of(ss, row, 1.0f / 256.0f);
#pragma unroll
                for (int bj = 0; bj < 2; ++bj) { const int colt = u.pn * BM + bj * HALF, col0 = colt + wc * 32 + 8 * fq;
                    bf16_t* dst = (colt < 512) ? (Kn + (size_t)row * 512 + col0) : (V + (size_t)row * 512 + (col0 - 512));
                    *(u32x4*)dst = pack8(acc[ai][bj][m][0] * rs, acc[ai][bj][m][1] * rs); } }
    }
};
struct EpiQ {
    static constexpr bool PERM = true, AFTER_DRAIN = false;
    unsigned char* ws;
    __device__ __forceinline__ void operator()(const f32x4 (&acc)[2][2][4][2], const Unit& u, int wr, int wc, int fr, int fq) const {
        bf16_t* Q = (bf16_t*)(ws + mkc::WS_Q); const float* ss = (const float*)(ws + mkc::WS_SSQ); const float* cosT = (const float*)(ws + mkc::WS_COS); const float* sinT = (const float*)(ws + mkc::WS_SIN);
        const int row0 = u.pm * BM + wr * 64 + fr;
#pragma unroll
        for (int ai = 0; ai < 2; ++ai)
#pragma unroll
            for (int m = 0; m < 4; ++m) { const int row = row0 + ai * HALF + m * 16; const float rs = rs_of(ss, row, 1.0f / 384.0f);
#pragma unroll
                for (int bj = 0; bj < 2; ++bj) { const int col0 = u.pn * BM + bj * HALF + wc * 32 + 8 * fq; const int d = col0 % 96;
                    f32x4 v0 = acc[ai][bj][m][0] * rs, v1 = acc[ai][bj][m][1] * rs;
                    if (d >= 64) { const int g = (d - 64) >> 3; const f32x4 c = *(const f32x4*)(cosT + (size_t)row * 16 + 4 * g), s = *(const f32x4*)(sinT + (size_t)row * 16 + 4 * g);
                        const f32x4 o0 = v0 * c - v1 * s, o1 = v0 * s + v1 * c; v0 = o0; v1 = o1; }
                    *(u32x4*)(Q + (size_t)row * 768 + col0) = pack8(v0, v1); }
                asm volatile("" ::: "memory"); }
    }
};
struct EpiResidNorm {
    static constexpr bool PERM = false, AFTER_DRAIN = true;
    float* out; unsigned char* ws; const float* gain; float alpha;
    __device__ __forceinline__ void fused(f32x4 (&acc)[2][2][4][2], const Unit& u, int wr, int wc, int fr, int fq, PG8_LAS unsigned char* lds, int wid, int lane) const {
        float* ss = (float*)(ws + mkc::WS_SS4); unsigned* pcnt = (unsigned*)(ws + mkc::WS_PANEL) + 64 * u.pm; const bf16_t* xb = (const bf16_t*)(ws + mkc::WS_XB);
        const int row0 = u.pm * BM + wr * 64 + fr, col0 = u.pn * BM + wc * 32 + 4 * fq;
#pragma unroll
        for (int ai = 0; ai < 2; ++ai)
#pragma unroll
            for (int m = 0; m < 4; ++m) { const int row = row0 + ai * HALF + m * 16; const size_t off = (size_t)row * 1024 + col0; float s = 0.f;
#pragma unroll
                for (int bj = 0; bj < 2; ++bj)
#pragma unroll
                    for (int n = 0; n < 2; ++n) { const f32x4 b = bf4_to_f32(*(const u32x2*)(xb + off + bj * HALF + n * 16)); const f32x4 o = b + acc[ai][bj][m][n] * alpha; acc[ai][bj][m][n] = o;
                        s += (o[0] * o[0] + o[1] * o[1]) + (o[2] * o[2] + o[3] * o[3]); }
                s += __shfl_xor(s, 16); s += __shfl_xor(s, 32);
                if (fq == 0) atomicAdd(ss + row, s);
                asm volatile("" : "+v"(acc[ai][0][m][0]), "+v"(acc[ai][0][m][1]), "+v"(acc[ai][1][m][0]), "+v"(acc[ai][1][m][1]));
                if (m & 1) asm volatile("" ::: "memory"); }
        asm volatile("s_waitcnt vmcnt(0)" ::: "memory"); __builtin_amdgcn_s_barrier(); asm volatile("" ::: "memory");
        if (wid == 0) {
            if (lane == 0) { __builtin_amdgcn_fence(__ATOMIC_RELEASE, "agent"); asm volatile("s_waitcnt vmcnt(0)" ::: "memory"); __hip_atomic_fetch_add(pcnt, 1u, __ATOMIC_RELAXED, __HIP_MEMORY_SCOPE_AGENT); }
            unsigned spins = 0;
            while ((unsigned)__builtin_amdgcn_readfirstlane(__hip_atomic_load(pcnt, __ATOMIC_RELAXED, __HIP_MEMORY_SCOPE_AGENT)) < 4u) { __builtin_amdgcn_s_sleep(2); if (++spins > (1u << 22)) break; }
            __builtin_amdgcn_fence(__ATOMIC_ACQUIRE, "agent");
        }
        asm volatile("s_waitcnt vmcnt(0) lgkmcnt(0)" ::: "memory"); __builtin_amdgcn_s_barrier(); asm volatile("" ::: "memory");
        f32x4 gv[2][2];
#pragma unroll
        for (int bj = 0; bj < 2; ++bj)
#pragma unroll
            for (int n = 0; n < 2; ++n) gv[bj][n] = *(const f32x4*)(gain + col0 + bj * HALF + n * 16);
#pragma unroll
        for (int ai = 0; ai < 2; ++ai)
#pragma unroll
            for (int m = 0; m < 4; ++m) { const int row = row0 + ai * HALF + m * 16; const size_t off = (size_t)row * 1024 + col0;
                const float tot = __hip_atomic_load(ss + row, __ATOMIC_RELAXED, __HIP_MEMORY_SCOPE_AGENT); const float rs = __builtin_amdgcn_rsqf(tot * (1.0f / 1024.0f) + RMS_EPS);
#pragma unroll
                for (int bj = 0; bj < 2; ++bj)
#pragma unroll
                    for (int n = 0; n < 2; ++n) *(f32x4*)(out + off + bj * HALF + n * 16) = acc[ai][bj][m][n] * rs * gv[bj][n]; }
    }
};

template <class Epi, class Sched, bool ALIGN_EPI = false, bool SP2 = false>
__device__ __forceinline__ void gemm_phase(PG8_LAS unsigned char* lds, const Gemm g, const Sched& S, const Epi& E, const int wid) {
    const int lane = lane_id_v(), tid = wid * 64 + lane, wr = wid >> 2, wc = wid & 3, fr = lane & 15, fq = lane >> 4;
    const int K = g.K, nt = K / BK, lda = g.lda;
    unsigned voffA[2], voffB[2];
#pragma unroll
    for (int i = 0; i < 2; ++i) { int R, C; stage_rc(tid * 16 + i * 8192, R, C); const int Rb = Epi::PERM ? ((R & ~31) + perm32(R & 31)) : R;
        voffA[i] = (unsigned)(R * lda + C) * 2u; voffB[i] = (unsigned)(Rb * K + C) * 2u; }
    const size_t kstep = (size_t)(BK * 2);
    const size_t hstep = (size_t)HALF * K * 2;
    const size_t tstep = 2 * hstep; const size_t hstepA = (size_t)HALF * lda * 2, tstepA = 2 * hstepA;
    const unsigned ldsw = (unsigned)wid * 1024u;
    const int aoff = lds_byte(wr * 64 + fr, fq * 8), boff = lds_byte(wc * 32 + fr, fq * 8);
#define PG8_SA(b, h) (((b) * 2 + (h)) * HTB)
#define PG8_SB(b, h) ((4 + (b) * 2 + (h)) * HTB)
#define PG8_STAGE(bufoff, gbase, voff) do { _Pragma("unroll") for (int _i = 0; _i < 2; ++_i) \
        __builtin_amdgcn_global_load_lds((const unsigned*)((const char*)(gbase) + (voff)[_i]), (PG8_LAS unsigned*)(lds + (bufoff) + ldsw + _i * 8192), 16, 0, 0); } while (0)
#define PG8_LDA(dst, b, h) do { _Pragma("unroll") for (int m = 0; m < 4; ++m) _Pragma("unroll") for (int k = 0; k < 2; ++k) dst[m][k] = *(const PG8_LAS bf16x8*)(lds + PG8_SA(b, h) + aoff + m * 2048 + k * 1024); } while (0)
#define PG8_LDB(dst, b, h) do { _Pragma("unroll") for (int n = 0; n < 2; ++n) _Pragma("unroll") for (int k = 0; k < 2; ++k) dst[n][k] = *(const PG8_LAS bf16x8*)(lds + PG8_SB(b, h) + boff + n * 2048 + k * 1024); } while (0)
#define PG8_MMA(ai, bj, At, Bt) do { __builtin_amdgcn_s_setprio(1); _Pragma("unroll") for (int m = 0; m < 4; ++m) _Pragma("unroll") for (int n = 0; n < 2; ++n) _Pragma("unroll") for (int k = 0; k < 2; ++k) \
        acc[ai][bj][m][n] = __builtin_amdgcn_mfma_f32_16x16x32_bf16(Bt[n][k], At[m][k], acc[ai][bj][m][n], 0, 0, 0); __builtin_amdgcn_s_setprio(0); } while (0)
#define PG8_WAIT_V(n) asm volatile("s_waitcnt vmcnt(" #n ")" ::: "memory")
#define PG8_WAIT_L(n) asm volatile("s_waitcnt lgkmcnt(" #n ")" ::: "memory")
#define PG8_BAR __builtin_amdgcn_s_barrier()
#define PG8_SCHED __builtin_amdgcn_sched_barrier(0)
    Unit cur, nxt; int ui = 0;
    if (!S.next(0, cur)) return;
    f32x4 acc[2][2][4][2];
#pragma unroll
    for (int a = 0; a < 2; ++a)
#pragma unroll
        for (int b = 0; b < 2; ++b)
#pragma unroll
            for (int m = 0; m < 4; ++m)
#pragma unroll
                for (int n = 0; n < 2; ++n) acc[a][b][m][n] = (f32x4){0.f, 0.f, 0.f, 0.f};
    bf16x8 At[4][2], B0[2][2], B1[2][2];
    const char* cA = (const char*)g.A + (size_t)cur.pm * tstepA; const char* cB = (const char*)g.Bt + (size_t)cur.pn * tstep;
    S.a_ready(cur);
    if constexpr (SP2) {
        PG8_STAGE(PG8_SB(0, 0), cB, voffB); PG8_STAGE(PG8_SB(0, 1), cB + hstep, voffB); PG8_STAGE(PG8_SA(0, 0), cA, voffA); PG8_STAGE(PG8_SA(0, 1), cA + hstepA, voffA);
        if (wr == 1) PG8_BAR;
        PG8_WAIT_V(2); PG8_BAR;
        PG8_STAGE(PG8_SB(1, 0), cB + kstep, voffB); PG8_STAGE(PG8_SA(1, 0), cA + kstep, voffA); PG8_STAGE(PG8_SB(1, 1), cB + hstep + kstep, voffB);
        PG8_WAIT_V(6); PG8_BAR;
    } else {
        PG8_STAGE(PG8_SB(0, 0), cB, voffB); PG8_STAGE(PG8_SA(0, 0), cA, voffA); PG8_STAGE(PG8_SB(0, 1), cB + hstep, voffB); PG8_STAGE(PG8_SA(0, 1), cA + hstepA, voffA);
        if (wr == 1) PG8_BAR;
        PG8_WAIT_V(4); PG8_BAR;
        PG8_STAGE(PG8_SB(1, 0), cB + kstep, voffB); PG8_STAGE(PG8_SA(1, 0), cA + kstep, voffA); PG8_STAGE(PG8_SB(1, 1), cB + hstep + kstep, voffB);
        PG8_WAIT_V(6); PG8_BAR;
    }
    for (;;) {
        const bool has_next = S.next(ui + 1, nxt);
        const char* nA = has_next ? (const char*)g.A + (size_t)nxt.pm * tstepA : cA; const char* nB = has_next ? (const char*)g.Bt + (size_t)nxt.pn * tstep : cB;
#pragma nounroll
        for (int t = 0; t < nt; t += 2) {
            const bool last = (t == nt - 2);
            const char* a1 = cA + (size_t)(t + 1) * kstep;
            const char* a2 = last ? nA : cA + (size_t)(t + 2) * kstep; const char* b2 = last ? nB : cB + (size_t)(t + 2) * kstep;
            const char* a3 = a2 + kstep; const char* b3 = b2 + kstep;
            if (last && has_next) S.a_ready(nxt);
            if constexpr (SP2) {
            PG8_LDB(B0, 0, 0); PG8_LDB(B1, 0, 1); PG8_SCHED; PG8_LDA(At, 0, 0); PG8_STAGE(PG8_SA(1, 1), a1 + hstepA, voffA);
            PG8_WAIT_V(8); PG8_WAIT_L(0); PG8_BAR; PG8_MMA(0, 0, At, B0); PG8_MMA(0, 1, At, B1); PG8_BAR; PG8_SCHED;
            PG8_LDA(At, 0, 1); PG8_STAGE(PG8_SB(0, 0), b2, voffB); PG8_STAGE(PG8_SB(0, 1), b2 + hstep, voffB); PG8_STAGE(PG8_SA(0, 0), a2, voffA);
            PG8_WAIT_V(8); PG8_WAIT_L(0); PG8_BAR; PG8_MMA(1, 0, At, B0); PG8_MMA(1, 1, At, B1); PG8_BAR; PG8_SCHED;
            PG8_LDB(B0, 1, 0); PG8_LDB(B1, 1, 1); PG8_SCHED; PG8_LDA(At, 1, 0); PG8_STAGE(PG8_SA(0, 1), a2 + hstepA, voffA);
            PG8_WAIT_V(8); PG8_WAIT_L(0); PG8_BAR; PG8_MMA(0, 0, At, B0); PG8_MMA(0, 1, At, B1); PG8_BAR; PG8_SCHED;
            PG8_LDA(At, 1, 1); PG8_STAGE(PG8_SB(1, 0), b3, voffB); PG8_STAGE(PG8_SB(1, 1), b3 + hstep, voffB); PG8_STAGE(PG8_SA(1, 0), a3, voffA);
            PG8_WAIT_V(8); PG8_WAIT_L(0); PG8_BAR; PG8_MMA(1, 0, At, B0); PG8_MMA(1, 1, At, B1); PG8_BAR; PG8_SCHED;
            } else {
            PG8_LDB(B0, 0, 0); PG8_SCHED; PG8_LDA(At, 0, 0); PG8_STAGE(PG8_SA(1, 1), a1 + hstepA, voffA);
            PG8_WAIT_L(8); PG8_BAR; PG8_WAIT_L(0); PG8_MMA(0, 0, At, B0); PG8_BAR; PG8_SCHED;
            PG8_LDB(B1, 0, 1); PG8_STAGE(PG8_SB(0, 0), b2, voffB);
            PG8_BAR; PG8_WAIT_L(0); PG8_MMA(0, 1, At, B1); PG8_BAR;
            PG8_LDA(At, 0, 1); PG8_STAGE(PG8_SA(0, 0), a2, voffA);
            PG8_BAR; PG8_WAIT_L(0); PG8_MMA(1, 0, At, B0); PG8_BAR; PG8_SCHED;
            PG8_STAGE(PG8_SB(0, 1), b2 + hstep, voffB);
            PG8_WAIT_V(6); PG8_BAR; PG8_MMA(1, 1, At, B1); PG8_BAR;
            PG8_LDB(B0, 1, 0); PG8_SCHED; PG8_LDA(At, 1, 0); PG8_STAGE(PG8_SA(0, 1), a2 + hstepA, voffA);
            PG8_WAIT_L(8); PG8_BAR; PG8_WAIT_L(0); PG8_MMA(0, 0, At, B0); PG8_BAR; PG8_SCHED;
            PG8_LDB(B1, 1, 1); PG8_STAGE(PG8_SB(1, 0), b3, voffB);
            PG8_BAR; PG8_WAIT_L(0); PG8_MMA(0, 1, At, B1); PG8_BAR;
            PG8_LDA(At, 1, 1); PG8_STAGE(PG8_SA(1, 0), a3, voffA);
            PG8_BAR; PG8_WAIT_L(0); PG8_MMA(1, 0, At, B0); PG8_BAR; PG8_SCHED;
            PG8_STAGE(PG8_SB(1, 1), b3 + hstep, voffB);
            PG8_WAIT_V(6); PG8_BAR; PG8_MMA(1, 1, At, B1); PG8_BAR;
            }
        }
        if constexpr (ALIGN_EPI) { if (wr == 0) PG8_BAR; }
        if constexpr (!Epi::AFTER_DRAIN) { E(acc, cur, wr, wc, fr, fq); S.done(cur); }
        if (!has_next) break;
#pragma unroll
        for (int a = 0; a < 2; ++a)
#pragma unroll
            for (int b = 0; b < 2; ++b)
#pragma unroll
                for (int m = 0; m < 4; ++m)
#pragma unroll
                    for (int n = 0; n < 2; ++n) acc[a][b][m][n] = (f32x4){0.f, 0.f, 0.f, 0.f};
        cur = nxt; cA = nA; cB = nB; ++ui;
        if constexpr (ALIGN_EPI) { if (wr == 1) PG8_BAR; }
    }
    PG8_WAIT_V(0);
    if constexpr (!ALIGN_EPI) { if (wr == 0) PG8_BAR; }
    PG8_BAR;
    if constexpr (Epi::AFTER_DRAIN) { E.fused(acc, cur, wr, wc, fr, fq, lds, wid, lane); S.done(cur); }
#undef PG8_SA
#undef PG8_SB
#undef PG8_STAGE
#undef PG8_LDA
#undef PG8_LDB
#undef PG8_MMA
#undef PG8_WAIT_V
#undef PG8_WAIT_L
#undef PG8_BAR
#undef PG8_SCHED
}
}
namespace att {
typedef unsigned short bf16_t;
using bf16x8 = __attribute__((ext_vector_type(8))) short;
using s16x4 = __attribute__((ext_vector_type(4))) short;
using f32x16 = __attribute__((ext_vector_type(16))) float;
using f32x4 = __attribute__((ext_vector_type(4))) float;
using u32x4 = __attribute__((ext_vector_type(4))) unsigned;
typedef short v4i16_t __attribute__((ext_vector_type(4)));
#define ATT_LAS __attribute__((address_space(3)))
typedef ATT_LAS const char* lds_cptr;
constexpr int NW = 8, KVBLK = 64;
constexpr int KSLOT = 12288, VSLOT = 8192, NSLOT = 4;
constexpr int LDS_K = 0, LDS_V = NSLOT * KSLOT, LDS_WS = LDS_V + NSLOT * VSLOT, LDS_OST = LDS_WS + NW * 64 * 4, LDS_POSK = LDS_OST + NW * 4096, LDS_BYTES = LDS_POSK + 1024;
__device__ __forceinline__ int crow(int r, int hi) { return (r & 3) + 8 * (r >> 2) + 4 * hi; }
__device__ __forceinline__ void glds16(const void* gsrc, unsigned lds_dst) { unsigned keep;
    asm volatile("s_mov_b32 %0, m0\n\ts_mov_b32 m0, %2\n\ts_nop 0\n\tglobal_load_lds_dwordx4 %1, off\n\ts_mov_b32 m0, %0" : "=&s"(keep) : "v"(gsrc), "s"(lds_dst) : "memory"); }
typedef float f32x2_t __attribute__((ext_vector_type(2))); typedef __bf16 bf16x2_t __attribute__((ext_vector_type(2)));
__device__ __forceinline__ unsigned cvtpk(float lo, float hi) { f32x2_t v = {lo, hi}; bf16x2_t b = __builtin_convertvector(v, bf16x2_t); return __builtin_bit_cast(unsigned, b); }
__device__ __forceinline__ float att_bf16_up(float x) { unsigned u = __float_as_uint(x); if (u & 0xFFFFu) { u &= 0xFFFF0000u; if (x > 0.f) u += 0x10000u; } return __uint_as_float(u); }
__device__ __forceinline__ s16x4 vtr(lds_cptr p) { return __builtin_bit_cast(s16x4, __builtin_amdgcn_ds_read_tr16_b64_v4i16((ATT_LAS v4i16_t*)p)); }
#define ATT_KS(j) (((j) & (NSLOT - 1)) * KSLOT)
#define ATT_VS(j) (((j) & (NSLOT - 1)) * VSLOT)
#define ATT_WAIT_BAR() asm volatile("s_waitcnt vmcnt(0) lgkmcnt(0)\n\ts_barrier" ::: "memory")
#define ATT_WAIT_BAR_N(three) do { if (three) asm volatile("s_waitcnt vmcnt(3) lgkmcnt(0)\n\ts_barrier" ::: "memory"); else asm volatile("s_waitcnt vmcnt(2) lgkmcnt(0)\n\ts_barrier" ::: "memory"); } while (0)

struct Unit {
    const bf16_t* Q; int q_pitch;
    const bf16_t* K; int k_pitch;
    const bf16_t* Kr;
    const bf16_t* V; int v_pitch;
    int key0, ntiles;
    int q0;
    const unsigned short* list; int len;
    const float* posf;
    float slope2;
    bf16_t* O; int o_pitch;
    bf16_t* part; float* plse; int h;
};

template <int MODE> __device__ __forceinline__ void unit(const Unit& U, char* shm, const int wid) {
    constexpr int DQK = (MODE == 0) ? 96 : 64, ND0 = DQK / 16;
    const int lane = pg8::lane_id_v(), tid = wid * 64 + lane, r32 = lane & 31, hi = lane >> 5;
    const unsigned lds0 = (unsigned)(uintptr_t)shm;
    const lds_cptr shm3 = (lds_cptr)shm;
    ATT_LAS float* wsf = (ATT_LAS float*)(shm3 + LDS_WS) + wid * 64;
    int qrow, slot = 0; bool valid = true;
    if (MODE == 2) { const int e = wid * 32 + r32; valid = e < U.len; const unsigned ent = valid ? (unsigned)U.list[e] : (unsigned)U.list[0]; qrow = (int)(ent & 0x3FFFu); slot = 1 + (int)(ent >> 14); }
    else qrow = U.q0 + wid * 32 + r32;
    const unsigned koff = (unsigned)((U.key0 + 8 * wid + (lane >> 3)) * U.k_pitch + (((lane & 7) ^ ((4 * wid + (lane >> 4)) & 7)) * 8)) * 2u;
    const unsigned kroff = (MODE == 0) ? (unsigned)((U.key0 + 16 * (wid & 3) + (lane >> 2)) * 32 + (((lane & 3) ^ ((lane >> 4) & 3)) * 8)) * 2u : 0u;
    const unsigned voff = (unsigned)((U.key0 + 16 * (wid & 3) + (lane >> 2)) * U.v_pitch + (wid >> 2) * 32 + (lane & 3) * 8) * 2u;
#define ATT_DMA(t, ks, vs) do { glds16((const char*)U.K + koff + (size_t)(t) * (KVBLK * 2) * U.k_pitch, (unsigned)(lds0 + LDS_K + wid * 1024 + (ks))); \
        if (MODE == 0 && wid < 4) glds16((const char*)U.Kr + kroff + (size_t)(t) * (KVBLK * 64), (unsigned)(lds0 + LDS_K + (8 + (wid & 3)) * 1024 + (ks))); \
        glds16((const char*)U.V + voff + (size_t)(t) * (KVBLK * 2) * U.v_pitch, (unsigned)(lds0 + LDS_V + wid * 1024 + (vs))); } while (0)
    const int NT = U.ntiles;
    ATT_DMA(0, 0, 0);
    if (NT > 1) ATT_DMA(1, KSLOT, VSLOT);
    bf16x8 qr[ND0];
    { const bf16_t* Qw = U.Q + (size_t)qrow * U.q_pitch + hi * 8;
#pragma unroll
      for (int d0 = 0; d0 < ND0; ++d0) qr[d0] = *reinterpret_cast<const bf16x8*>(Qw + d0 * 16); }
    float pq = 0.f;
    if (MODE != 0) { pq = U.posf[qrow]; if (tid < 256) ((ATT_LAS float*)(shm3 + LDS_POSK))[tid] = U.posf[U.key0 + tid]; }
    float mhat = -1e30f, l_reg = 0.f; f32x16 o[2]; o[0] = f32x16{}; o[1] = f32x16{};
    const int km_ = (r32 >> 1) & 7, kmr_ = (r32 >> 2) & 3;
    const int ka0 = LDS_K + r32 * 128 + 32 * (km_ >> 1) + 16 * (hi ^ (km_ & 1));
    const int kb0 = LDS_K + 8192 + r32 * 64 + 32 * (kmr_ >> 1) + 16 * (hi ^ (kmr_ & 1));
#define ATT_KADDR(d0, half, KS) (shm3 + (KS) + (((d0) < 4) ? ((ka0 ^ ((d0) << 5)) + (half) * 4096) : ((kb0 ^ (((d0) - 4) << 5)) + (half) * 2048)))
    const lds_cptr vp0 = shm3 + LDS_V + ((lane >> 4) & 1) * 32 + (lane & 3) * 8 + (4 * hi + ((lane & 15) >> 2)) * 64;
#define ATT_QKT(P0, P1, KS) do { P0 = f32x16{}; P1 = f32x16{}; bf16x8 kk_[2 * ND0]; \
        _Pragma("unroll") for (int d0 = 0; d0 < ND0; ++d0) { kk_[2 * d0] = *(const ATT_LAS bf16x8*)ATT_KADDR(d0, 0, KS); kk_[2 * d0 + 1] = *(const ATT_LAS bf16x8*)ATT_KADDR(d0, 1, KS); }     \
        __builtin_amdgcn_sched_barrier(0); \
        _Pragma("unroll") for (int d0 = 0; d0 < ND0; ++d0) { \
            P0 = __builtin_amdgcn_mfma_f32_32x32x16_bf16(kk_[2 * d0], qr[d0], P0, 0, 0, 0); P1 = __builtin_amdgcn_mfma_f32_32x32x16_bf16(kk_[2 * d0 + 1], qr[d0], P1, 0, 0, 0); } } while (0)
#define ATT_SMPV(P0, P1, T, VS) do { \
        if (MODE != 0) { const ATT_LAS float* pk_ = (const ATT_LAS float*)(shm3 + LDS_POSK) + 64 * (T) + 4 * hi; \
            _Pragma("unroll") for (int g = 0; g < 4; ++g) { const f32x4 a_ = *(const ATT_LAS f32x4*)(pk_ + 8 * g), b_ = *(const ATT_LAS f32x4*)(pk_ + 8 * g + 32); \
                _Pragma("unroll") for (int j = 0; j < 4; ++j) { P0[4 * g + j] -= U.slope2 * __builtin_fabsf(pq - a_[j]); P1[4 * g + j] -= U.slope2 * __builtin_fabsf(pq - b_[j]); } } } \
        if (MODE == 0 || MODE == 1) { const int kb_ = U.key0 + 64 * (T); \
            if (kb_ + 63 > U.q0 + wid * 32) { const int dq_ = qrow - kb_ - 4 * hi; \
                _Pragma("unroll") for (int r = 0; r < 16; ++r) { const int c_ = (r & 3) + 8 * (r >> 2); if (c_ > dq_) P0[r] = -INFINITY; if (c_ + 32 > dq_) P1[r] = -INFINITY; } } } \
        float rm_ = P0[0]; \
        _Pragma("unroll") for (int r = 1; r < 16; ++r) rm_ = fmaxf(rm_, P0[r]); \
        _Pragma("unroll") for (int r = 0; r < 16; ++r) rm_ = fmaxf(rm_, P1[r]); \
        { auto rr_ = __builtin_amdgcn_permlane32_swap(__float_as_uint(rm_), __float_as_uint(rm_), false, false); rm_ = fmaxf(__uint_as_float(rr_[0]), __uint_as_float(rr_[1])); } \
        if (__any(rm_ > mhat + 10.0f)) { const float mn_ = fmaxf(mhat, rm_), f_ = __builtin_amdgcn_exp2f(mhat - mn_); mhat = mn_; l_reg *= f_; \
            _Pragma("unroll") for (int r = 0; r < 16; ++r) { o[0][r] *= f_; o[1][r] *= f_; } }                        \
        float sacc_ = 0.f; \
        _Pragma("unroll") for (int r = 0; r < 16; ++r) { P0[r] = __builtin_amdgcn_exp2f(P0[r] - mhat); P1[r] = __builtin_amdgcn_exp2f(P1[r] - mhat); sacc_ += P0[r] + P1[r]; } \
        l_reg += sacc_; \
        u32x4 pw_[4]; \
        _Pragma("unroll") for (int s_ = 0; s_ < 2; ++s_) { \
            pw_[s_] = (u32x4){cvtpk(P0[8 * s_], P0[8 * s_ + 1]), cvtpk(P0[8 * s_ + 2], P0[8 * s_ + 3]), cvtpk(P0[8 * s_ + 4], P0[8 * s_ + 5]), cvtpk(P0[8 * s_ + 6], P0[8 * s_ + 7])}; \
            pw_[2 + s_] = (u32x4){cvtpk(P1[8 * s_], P1[8 * s_ + 1]), cvtpk(P1[8 * s_ + 2], P1[8 * s_ + 3]), cvtpk(P1[8 * s_ + 4], P1[8 * s_ + 5]), cvtpk(P1[8 * s_ + 6], P1[8 * s_ + 7])}; } \
        const lds_cptr vp_ = vp0 + (VS); s16x4 vl_[8], vh_[8]; \
        _Pragma("unroll") for (int i_ = 0; i_ < 8; ++i_) { vl_[i_] = vtr(vp_ + (i_ >> 2) * 4096 + (i_ & 3) * 1024); vh_[i_] = vtr(vp_ + (i_ >> 2) * 4096 + (i_ & 3) * 1024 + 512); }     \
        __builtin_amdgcn_sched_barrier(0); \
        _Pragma("unroll") for (int i_ = 0; i_ < 8; ++i_) { \
            const bf16x8 vf_ = (bf16x8){vl_[i_][0], vl_[i_][1], vl_[i_][2], vl_[i_][3], vh_[i_][0], vh_[i_][1], vh_[i_][2], vh_[i_][3]}; \
            o[i_ >> 2] = __builtin_amdgcn_mfma_f32_32x32x16_bf16(vf_, __builtin_bit_cast(bf16x8, pw_[i_ & 3]), o[i_ >> 2], 0, 0, 0); } } while (0)
#define ATT_ACT(T) (MODE != 1 || (64 * (T) <= wid * 32 + 31))
#define ATT_ITER(SC0, SC1, SN0, SN1, T) do { const bool has_next_ = (T) + 1 < NT; \
        if (has_next_ && ATT_ACT((T) + 1)) ATT_QKT(SN0, SN1, ATT_KS((T) + 1)); \
        if (ATT_ACT(T)) ATT_SMPV(SC0, SC1, T, ATT_VS(T)); \
        if (has_next_ && (MODE == 0 || NT > NSLOT)) { if ((T) + 3 < NT) ATT_WAIT_BAR_N(dma3); else ATT_WAIT_BAR(); if ((T) + 4 < NT) ATT_DMA((T) + 4, ATT_KS(T), ATT_VS(T)); }   \
        } while (0)
    const bool dma3 = (MODE == 0) && wid < 4;
    if (NT > 2) ATT_DMA(2, 2 * KSLOT, 2 * VSLOT);
    if (NT > 3) ATT_DMA(3, 3 * KSLOT, 3 * VSLOT);
    if (MODE == 0 && NT > 3) ATT_WAIT_BAR_N(dma3); else ATT_WAIT_BAR();
    f32x16 pA0, pA1, pB0, pB1;
    ATT_QKT(pA0, pA1, 0);
    int t = 0;
    if (MODE == 0 && NT > 4) {
#define ATT_SB() __builtin_amdgcn_sched_barrier(0)
#define ATT_KLD(i, KS) kf[i] = *(const ATT_LAS bf16x8*)ATT_KADDR((i) >> 1, (i) & 1, KS)
#define ATT_VLD(i, VS) do { vlo[i] = vtr(vp0 + (VS) + ((i) >> 2) * 4096 + ((i) & 3) * 1024); vhi[i] = vtr(vp0 + (VS) + ((i) >> 2) * 4096 + ((i) & 3) * 1024 + 512); } while (0)
#define ATT_SCR(SC0, SC1, j) ((j) < 16 ? SC0[(j) & 15] : SC1[(j) & 15])
#define ATT_EXP4(SC0, SC1, g) do { if ((g) < 4) { _Pragma("unroll") for (int j_ = 0; j_ < 4; ++j_) SC0[4 * (g) + j_] = __builtin_amdgcn_exp2f(SC0[4 * (g) + j_]); } \
                                   else { _Pragma("unroll") for (int j_ = 0; j_ < 4; ++j_) SC1[4 * ((g) - 4) + j_] = __builtin_amdgcn_exp2f(SC1[4 * ((g) - 4) + j_]); } } while (0)
#define ATT_ADD4(SC0, SC1, g) do { if ((g) < 4) sacc_ += (SC0[4 * (g)] + SC0[4 * (g) + 1]) + (SC0[4 * (g) + 2] + SC0[4 * (g) + 3]); else sacc_ += (SC1[4 * ((g) - 4)] + SC1[4 * ((g) - 4) + 1]) + (SC1[4 * ((g) - 4) + 2] + SC1[4 * ((g) - 4) + 3]); } while (0)
#define ATT_CVT4(SC0, SC1, g) do { if ((g) < 4) { pw[(g) >> 1][2 * ((g) & 1)] = cvtpk(SC0[4 * (g)], SC0[4 * (g) + 1]); pw[(g) >> 1][2 * ((g) & 1) + 1] = cvtpk(SC0[4 * (g) + 2], SC0[4 * (g) + 3]); } \
                                   else { pw[(g) >> 1][2 * ((g) & 1)] = cvtpk(SC1[4 * ((g) - 4)], SC1[4 * ((g) - 4) + 1]); pw[(g) >> 1][2 * ((g) & 1) + 1] = cvtpk(SC1[4 * ((g) - 4) + 2], SC1[4 * ((g) - 4) + 3]); } } while (0)
#define ATT_GAPA(i, SC0, SC1, SN0, SN1) do { \
        if (((i) & 1) == 0) SN0 = __builtin_amdgcn_mfma_f32_32x32x16_bf16(kf[i], qr[(i) >> 1], SN0, 0, 0, 0); else SN1 = __builtin_amdgcn_mfma_f32_32x32x16_bf16(kf[i], qr[(i) >> 1], SN1, 0, 0, 0); \
        if ((i) < 8) { ATT_VLD(ATT_PJ(i), vs_); ATT_EXP4(SC0, SC1, i); } \
        if ((i) >= 1 && (i) <= 8) ATT_ADD4(SC0, SC1, (i) - 1); \
        if ((i) >= 2 && (i) <= 9) ATT_CVT4(SC0, SC1, (i) - 2); \
        ATT_SB(); } while (0)
#define ATT_PJ(j) ((((j) & 1) << 2) | ((j) >> 1))
#define ATT_VF(j) (bf16x8){vlo[j][0], vlo[j][1], vlo[j][2], vlo[j][3], vhi[j][0], vhi[j][1], vhi[j][2], vhi[j][3]}
#define ATT_GAPB(j, SN0, SN1) do { \
        o[ATT_PJ(j) >> 2] = __builtin_amdgcn_mfma_f32_32x32x16_bf16(ATT_VF(ATT_PJ(j)), __builtin_bit_cast(bf16x8, pw[ATT_PJ(j) & 3]), o[ATT_PJ(j) >> 2], 0, 0, 0);     \
        if ((j) < 6) { ATT_KLD(2 * (j), ks2_); ATT_KLD(2 * (j) + 1, ks2_); } \
        if ((j) >= 2 && (j) < 6) { const int b_ = 4 * ((j) - 2); ma_ = fmaxf(fmaxf(ma_, SN0[b_]), SN0[b_ + 1]); mb_ = fmaxf(fmaxf(mb_, SN0[b_ + 2]), SN0[b_ + 3]); ma_ = fmaxf(fmaxf(ma_, SN1[b_]), SN1[b_ + 1]); mb_ = fmaxf(fmaxf(mb_, SN1[b_ + 2]), SN1[b_ + 3]); } \
        ATT_SB(); } while (0)
#define ATT_FAST(SC0, SC1, SN0, SN1, T) do { const int vs_ = ATT_VS(T), ks2_ = ATT_KS((T) + 2); \
        { const unsigned long long bal_ = __builtin_amdgcn_ballot_w64(rm > 10.0f); float f_ = 1.f; \
          if (bal_ != 0ull) { const float mn_ = att_bf16_up(mhat + fmaxf(rm, 0.f)), dl_ = mn_ - mhat; f_ = __builtin_amdgcn_exp2f(-dl_); mhat = mn_; l_reg *= f_; \
            _Pragma("unroll") for (int r = 0; r < 16; ++r) { SC0[r] -= dl_; SC1[r] -= dl_; } \
            qx[0] = (hi == 0) ? (short)(__float_as_uint(-mhat) >> 16) : (short)0; } \
            \
          _Pragma("unroll") for (int g_ = 0; g_ < 4; ++g_) { const int d_ = g_ >> 1, b_ = 8 * (g_ & 1); \
            asm volatile("s_cmp_eq_u64 %[b], 0\n\ts_cbranch_scc1 .Lsk%=\n\tv_mul_f32_e32 %0, %[f], %0\n\tv_mul_f32_e32 %1, %[f], %1\n\tv_mul_f32_e32 %2, %[f], %2\n\tv_mul_f32_e32 %3, %[f], %3\n\t" \
                         "v_mul_f32_e32 %4, %[f], %4\n\tv_mul_f32_e32 %5, %[f], %5\n\tv_mul_f32_e32 %6, %[f], %6\n\tv_mul_f32_e32 %7, %[f], %7\n.Lsk%=:" \
                         : "+v"(o[d_][b_]), "+v"(o[d_][b_ + 1]), "+v"(o[d_][b_ + 2]), "+v"(o[d_][b_ + 3]), "+v"(o[d_][b_ + 4]), "+v"(o[d_][b_ + 5]), "+v"(o[d_][b_ + 6]), "+v"(o[d_][b_ + 7]) \
                         : [f] "v"(f_), [b] "s"(bal_) : "scc"); } } \
        ATT_SB(); \
        float sacc_ = 0.f; \
        SN0 = __builtin_amdgcn_mfma_f32_32x32x16_bf16(kx, qx, f32x16{}, 0, 0, 0); SN1 = __builtin_amdgcn_mfma_f32_32x32x16_bf16(kx, qx, f32x16{}, 0, 0, 0);     \
        ATT_GAPA(0, SC0, SC1, SN0, SN1); ATT_GAPA(1, SC0, SC1, SN0, SN1); ATT_GAPA(2, SC0, SC1, SN0, SN1); ATT_GAPA(3, SC0, SC1, SN0, SN1); \
        ATT_GAPA(4, SC0, SC1, SN0, SN1); ATT_GAPA(5, SC0, SC1, SN0, SN1); ATT_GAPA(6, SC0, SC1, SN0, SN1); ATT_GAPA(7, SC0, SC1, SN0, SN1); \
        ATT_GAPA(8, SC0, SC1, SN0, SN1); ATT_GAPA(9, SC0, SC1, SN0, SN1); ATT_GAPA(10, SC0, SC1, SN0, SN1); ATT_GAPA(11, SC0, SC1, SN0, SN1); \
        l_reg += sacc_; \
        float ma_ = -INFINITY, mb_ = -INFINITY; \
        ATT_GAPB(0, SN0, SN1); ATT_GAPB(1, SN0, SN1); ATT_GAPB(2, SN0, SN1); ATT_GAPB(3, SN0, SN1); ATT_GAPB(4, SN0, SN1); ATT_GAPB(5, SN0, SN1); ATT_GAPB(6, SN0, SN1); ATT_GAPB(7, SN0, SN1); \
        rm = fmaxf(ma_, mb_); \
        { auto rr_ = __builtin_amdgcn_permlane32_swap(__float_as_uint(rm), __float_as_uint(rm), false, false); rm = fmaxf(__uint_as_float(rr_[0]), __uint_as_float(rr_[1])); } \
        ATT_SB(); \
        ATT_WAIT_BAR(); ATT_DMA((T) + 4, ATT_KS(T), vs_); } while (0)
        bf16x8 kf[12]; s16x4 vlo[8], vhi[8]; u32x4 pw[4];
        float rm = pA0[0];
#pragma unroll
        for (int r = 1; r < 16; ++r) rm = fmaxf(rm, pA0[r]);
#pragma unroll
        for (int r = 0; r < 16; ++r) rm = fmaxf(rm, pA1[r]);
        { auto rr_ = __builtin_amdgcn_permlane32_swap(__float_as_uint(rm), __float_as_uint(rm), false, false); rm = fmaxf(__uint_as_float(rr_[0]), __uint_as_float(rr_[1])); }
        mhat = att_bf16_up(rm);
#pragma unroll
        for (int r = 0; r < 16; ++r) { pA0[r] -= mhat; pA1[r] -= mhat; }
        rm -= mhat;
        const bf16x8 kx = (bf16x8){(short)0x3F80, 0, 0, 0, 0, 0, 0, 0};
        bf16x8 qx = (bf16x8){0, 0, 0, 0, 0, 0, 0, 0};
        if (hi == 0) qx[0] = (short)(__float_as_uint(-mhat) >> 16);
#pragma unroll
        for (int i = 0; i < 12; ++i) ATT_KLD(i, KSLOT);
        if (wid >= 4) __builtin_amdgcn_s_setprio(1);
        for (; t + 4 < NT; t += 2) { ATT_FAST(pA0, pA1, pB0, pB1, t); ATT_FAST(pB0, pB1, pA0, pA1, t + 1); }
        if (wid >= 4) __builtin_amdgcn_s_setprio(0);
#pragma unroll
        for (int r = 0; r < 16; ++r) { pA0[r] += mhat; pA1[r] += mhat; }
#undef ATT_FAST
#undef ATT_GAPA
#undef ATT_GAPB
#undef ATT_VF
#undef ATT_PJ
#undef ATT_EXP4
#undef ATT_ADD4
#undef ATT_CVT4
#undef ATT_SCR
#undef ATT_KLD
#undef ATT_VLD
#undef ATT_SB
    }
    for (; t < NT; t += 2) {
        ATT_ITER(pA0, pA1, pB0, pB1, t);
        if (t + 1 < NT) ATT_ITER(pB0, pB1, pA0, pA1, t + 1);
    }
#undef ATT_QKT
#undef ATT_SMPV
#undef ATT_ACT
#undef ATT_ITER
    { auto rr = __builtin_amdgcn_permlane32_swap(__float_as_uint(l_reg), __float_as_uint(l_reg), false, false); l_reg = __uint_as_float(rr[0]) + __uint_as_float(rr[1]); }
    { const float rl = __builtin_amdgcn_rcpf(l_reg);
      bf16_t* prow = U.O + (size_t)(U.q0 + wid * 32 + r32) * U.o_pitch + 8 * hi;
#pragma unroll
      for (int dh = 0; dh < 2; ++dh)
#pragma unroll
        for (int jp = 0; jp < 2; ++jp) {
            unsigned a0 = cvtpk(o[dh][8 * jp] * rl, o[dh][8 * jp + 1] * rl), a1 = cvtpk(o[dh][8 * jp + 2] * rl, o[dh][8 * jp + 3] * rl);
            unsigned b0 = cvtpk(o[dh][8 * jp + 4] * rl, o[dh][8 * jp + 5] * rl), b1 = cvtpk(o[dh][8 * jp + 6] * rl, o[dh][8 * jp + 7] * rl);
            const auto s0 = __builtin_amdgcn_permlane32_swap(a0, b0, false, false); const auto s1 = __builtin_amdgcn_permlane32_swap(a1, b1, false, false);
            *(u32x4*)(prow + 32 * dh + 16 * jp) = (u32x4){s0[0], s1[0], s0[1], s1[1]}; } }
    asm volatile("s_waitcnt vmcnt(0) lgkmcnt(0)\n\ts_barrier" ::: "memory");
#undef ATT_DMA
}
}

namespace att {
constexpr int MB_REG = 65536, MB_TILE = 16384, MB_V = 8192, MB_POSK = 131072, MB_PRE = MB_POSK + 3072, MB_UT = MB_PRE + 2048, MB_NUT = 62, MB_TM = MB_UT + 1024, MB_KB = 140288, MB_ENT = MB_KB + 8192, MB_END = MB_ENT + 2048;
struct MobaCtx { const bf16_t* mqkv; const float* posf; bf16_t* part; float* plse; const unsigned* lists; const unsigned* cnt; int total, vcu, G; };
struct MobaDesc { int own, h, n; };
__device__ __forceinline__ unsigned att_bf16_rne(float f) { unsigned u = __float_as_uint(f); return (u + 0x7fffu + ((u >> 16) & 1u)) >> 16; }
__device__ __forceinline__ float att_bf2f(unsigned b) { return __uint_as_float(b << 16); }
__device__ __forceinline__ void att_split3(float c, unsigned& w1, unsigned& w2) { const unsigned c0 = att_bf16_rne(c); const float r1 = c - att_bf2f(c0); const unsigned c1 = att_bf16_rne(r1); const float r2 = r1 - att_bf2f(c1);
    w1 = c0 | (c1 << 16); w2 = att_bf16_rne(r2); }

__device__ __forceinline__ u32x4 moba_get(const MobaCtx& C, ATT_LAS const int* pre, int i) {
    const int ng = (C.vcu < C.total) ? (C.total - C.vcu + C.G - 1) / C.G : 0;
    if (i < ng) { const int gI = C.vcu + i * C.G; int lo = 0, hi = 511;
        while (lo < hi) { const int mid = (lo + hi) >> 1; if (pre[mid] > gI) hi = mid; else lo = mid + 1; }
        const int hn = lo, c = gI - (hn ? pre[hn - 1] : 0); const int len = (int)C.cnt[hn] - c * 256;
        return (u32x4){1u | ((unsigned)(hn >> 6) << 2) | ((unsigned)(hn & 63) << 5), (unsigned)(len < 256 ? len : 256), (unsigned)hn * 16384u + (unsigned)c * 256u, 0u}; }
    const int u = C.vcu + (i - ng) * C.G; if (u >= 512) return (u32x4){0u, 0u, 0u, 0u};
    return (u32x4){1u | 2u | ((unsigned)(u & 7) << 2) | ((unsigned)(u >> 3) << 5), 256u, 0u, 0u};
}
__device__ __forceinline__ void glds4(const void* gsrc, unsigned lds_dst) { unsigned keep;
    asm volatile("s_mov_b32 %0, m0\n\ts_mov_b32 m0, %2\n\ts_nop 0\n\tglobal_load_lds_dword %1, off\n\ts_mov_b32 m0, %0" : "=&s"(keep) : "v"(gsrc), "s"(lds_dst) : "memory"); }

template <int PROBE> __device__ __forceinline__ void moba_run(const MobaCtx& C, char* shm, const int wid) {
    const int lane = pg8::lane_id_v(), tid = wid * 64 + lane, r32 = lane & 31, hi = lane >> 5;
    const unsigned lds0 = (unsigned)(uintptr_t)shm; const lds_cptr shm3 = (lds_cptr)shm;
    ATT_LAS const int* pre = (ATT_LAS const int*)(shm3 + MB_PRE);
    const float* pmax = C.posf + 16384;
    const int km_ = (r32 >> 1) & 7;
    const int ka0 = r32 * 128 + 32 * (km_ >> 1) + 16 * (hi ^ (km_ & 1));
    const int vpl = MB_V + ((lane >> 4) & 1) * 32 + (lane & 3) * 8 + (4 * hi + ((lane & 15) >> 2)) * 64;
    const unsigned koff = (unsigned)((8 * wid + (lane >> 3)) * 1536 + (((lane & 7) ^ ((4 * wid + (lane >> 4)) & 7)) * 8)) * 2u;
    const unsigned voff = (unsigned)((16 * (wid & 3) + (lane >> 2)) * 1536 + (wid >> 2) * 32 + (lane & 3) * 8) * 2u;
#define MB_UNPACK(X_, D_) do { (D_).own = (int)(((X_) >> 1) & 1u); (D_).h = (int)(((X_) >> 2) & 7u); (D_).n = (PROBE & 4) ? 0 : (int)((X_) >> 5); } while (0)
#define MB_DMA(D_, R_) do { const char* kb_ = (const char*)(C.mqkv + 512 + (D_).h * 64 + (size_t)(D_).n * 256 * 1536); const char* vb_ = kb_ + 1024; \
        unsigned db_ = (unsigned)(lds0 + (R_) + wid * 1024); asm volatile("" : "+s"(db_));     \
        _Pragma("unroll") for (int t_ = 0; t_ < 4; ++t_) { glds16(kb_ + koff + (size_t)t_ * (64 * 1536 * 2), db_ + t_ * MB_TILE); \
                                                           glds16(vb_ + voff + (size_t)t_ * (64 * 1536 * 2), db_ + t_ * MB_TILE + MB_V); } } while (0)
#define MB_FETCH(I_, E_, X_) do { E_ = ((const ATT_LAS u32x4*)(shm3 + MB_UT))[(I_)]; X_ = (unsigned)__builtin_amdgcn_readfirstlane((int)E_[0]); } while (0)
#define MB_SMALL(U_, E_, D_) do { \
        if (!(D_).own) { const int e = wid * 32 + r32; if (hi == 0 && e < (int)E_[1]) glds4(C.lists + E_[2] + e, (unsigned)(lds0 + MB_ENT + ((U_) & 1) * 1024 + wid * 128)); } \
        if (wid < 4) glds4(C.posf + (D_).n * 256 + tid, (unsigned)(lds0 + MB_POSK + ((U_) % 3) * 1024 + wid * 256)); \
        if (tid < 4) glds4(pmax + 4 * (D_).n + tid, (unsigned)(lds0 + MB_TM + ((U_) % 3) * 16)); } while (0)
#define MB_STAGE(U_, D_) do { if (tid < 256) { const ATT_LAS float* pp_ = (const ATT_LAS float*)(shm3 + MB_POSK + ((U_) % 3) * 1024); \
            const float v_ = exp2f(-(float)((D_).h + 1)) * 1.4426950408889634f * (pp_[tid] - pp_[0]); const unsigned vh_ = att_bf16_rne(v_), vl_ = att_bf16_rne(v_ - att_bf2f(vh_)); \
            ((ATT_LAS u32x4*)(shm3 + MB_KB + ((U_) & 1) * 4096))[tid] = (u32x4){vh_ | (vl_ << 16), 0x3F803F80u, 0x00003F80u, 0u}; } } while (0)
#define MB_QROW(U_, E_, D_, META_, QR_, PQ_) do { const int e_ = wid * 32 + r32; \
        if ((D_).own) META_ = (((D_).n * 256 + e_) << 2); \
        else { const unsigned en_ = ((const ATT_LAS unsigned*)(shm3 + MB_ENT + ((U_) & 1) * 1024))[e_]; META_ = (e_ < (int)E_[1]) ? (int)(((en_ & 0x3FFFu) << 2) | (1u + ((en_ >> 14) & 3u))) : -1; } \
        const int qr_ = (PROBE & 4) ? (16128 + e_) : ((META_) >= 0 ? ((META_) >> 2) : 0); const bf16_t* Qw_ = C.mqkv + (D_).h * 64 + (size_t)qr_ * 1536 + hi * 8; \
        _Pragma("unroll") for (int d0 = 0; d0 < 4; ++d0) QR_[d0] = *reinterpret_cast<const bf16x8*>(Qw_ + d0 * 16); PQ_ = C.posf[qr_]; } while (0)
#define MB_CHEAP(U_, D_, META_, PQ_, CM_) do { const f32x4 tm_ = *(const ATT_LAS f32x4*)(shm3 + MB_TM + ((U_) % 3) * 16); CM_ = 0; \
        _Pragma("unroll") for (int t_ = 0; t_ < 4; ++t_) { bool ok_ = __all((META_) < 0 || (PQ_) >= tm_[t_]); if ((D_).own) ok_ = ok_ && (64 * t_ + 63 <= wid * 32); if (ok_) CM_ |= 1 << t_; } } while (0)
  for (int base = 0; ; base += MB_NUT) {
    __syncthreads();
    if (tid < MB_NUT) ((ATT_LAS u32x4*)(shm3 + MB_UT))[tid] = moba_get(C, pre, base + tid);
    if (tid == MB_NUT || tid == MB_NUT + 1) ((ATT_LAS u32x4*)(shm3 + MB_UT))[tid] = (u32x4){0u, 0u, 0u, 0u};
    __syncthreads();
    u32x4 ent_; unsigned xc, xn, xnn = 0u; MobaDesc D, Dn;
    MB_FETCH(0, ent_, xc);
    if (!(xc & 1u)) break;
    MB_UNPACK(xc, D);
    MB_DMA(D, 0); MB_SMALL(0, ent_, D);
    { u32x4 e1_; MB_FETCH(1, e1_, xn); MB_UNPACK(xn, Dn); if (xn & 1u) MB_SMALL(1, e1_, Dn); }
    __builtin_amdgcn_s_waitcnt(0); __builtin_amdgcn_s_barrier();
    int meta = -1, cm = 0; float pq = 0.f, pbase = 0.f; bf16x8 qr[4];
    MB_STAGE(0, D); MB_QROW(0, ent_, D, meta, qr, pq);
    pbase = ((const ATT_LAS float*)(shm3 + MB_POSK))[0];
    __builtin_amdgcn_s_waitcnt(0); __builtin_amdgcn_s_barrier();
    MB_CHEAP(0, D, meta, pq, cm);
    if (xn & 1u) MB_DMA(Dn, MB_REG);
    int i = 0;
    for (; xc & 1u; ++i) {
        int meta_n = -1; float pq_n = 0.f;
        MB_UNPACK(xn, Dn);
        const int cur = i & 1, rb = cur * MB_REG; const float slope2 = exp2f(-(float)(D.h + 1)) * 1.4426950408889634f;
        const bool valid = meta >= 0; const int qrow = valid ? (meta >> 2) : 0, slot = meta & 3;
        const ATT_LAS float* posk = (const ATT_LAS float*)(shm3 + MB_POSK + (i % 3) * 1024);
        const lds_cptr kbx = shm3 + MB_KB + cur * 4096 + r32 * 16;
        float mhat = 0.f, l_reg = 0.f; bool first_ = true; f32x16 o[2]; o[0] = f32x16{}; o[1] = f32x16{};
        unsigned qxa0 = 0u, qxa1 = 0u, qxa2 = 0u, qxr1 = 0u, qxr2 = 0u;
#define MB_QX() do { unsigned a1_, a2_, r1_, r2_; att_split3(-slope2 * (pq - pbase) - mhat, a1_, a2_); att_split3(-mhat, r1_, r2_); \
            qxa0 = hi == 0 ? 0x3F803F80u : 0u; qxa1 = hi == 0 ? a1_ : 0u; qxa2 = hi == 0 ? a2_ : 0u; qxr1 = hi == 0 ? r1_ : 0u; qxr2 = hi == 0 ? r2_ : 0u; } while (0)
        MB_QX();
        f32x16 pA0, pA1, pB0, pB1; float mA = 0.f, mB = 0.f;
#define MB_ACT(T) (!D.own || (64 * (T) <= wid * 32 + 31))
#define MB_CH(T) ((cm >> (T)) & 1)
#define MB_QKT(P0, P1, MR, T) do { bf16x8 kk_[8]; const lds_cptr kb_ = shm3 + rb + (T) * MB_TILE; \
            const bf16x8 kx0_ = *(const ATT_LAS bf16x8*)(kbx + (T) * 1024), kx1_ = *(const ATT_LAS bf16x8*)(kbx + (T) * 1024 + 512); \
            _Pragma("unroll") for (int d0 = 0; d0 < 4; ++d0) { kk_[2 * d0] = *(const ATT_LAS bf16x8*)(kb_ + (ka0 ^ (d0 << 5))); kk_[2 * d0 + 1] = *(const ATT_LAS bf16x8*)(kb_ + (ka0 ^ (d0 << 5)) + 4096); } \
            const bool ch_ = MB_CH(T); const u32x4 qs_ = (u32x4){ch_ ? qxa0 : 0u, ch_ ? qxa1 : qxr1, ch_ ? qxa2 : qxr2, 0u}; \
            __builtin_amdgcn_sched_barrier(0); \
            P0 = __builtin_amdgcn_mfma_f32_32x32x16_bf16(kx0_, __builtin_bit_cast(bf16x8, qs_), f32x16{}, 0, 0, 0); P1 = __builtin_amdgcn_mfma_f32_32x32x16_bf16(kx1_, __builtin_bit_cast(bf16x8, qs_), f32x16{}, 0, 0, 0); \
            _Pragma("unroll") for (int d0 = 0; d0 < 4; ++d0) { P0 = __builtin_amdgcn_mfma_f32_32x32x16_bf16(kk_[2 * d0], qr[d0], P0, 0, 0, 0); P1 = __builtin_amdgcn_mfma_f32_32x32x16_bf16(kk_[2 * d0 + 1], qr[d0], P1, 0, 0, 0); } \
            MR = mhat; } while (0)
#define MB_SMPV(P0, P1, MC, T) do { \
            if (__any(MC != mhat)) { const float d_ = mhat - MC; _Pragma("unroll") for (int r = 0; r < 16; ++r) { P0[r] -= d_; P1[r] -= d_; } }     \
            if (!MB_CH(T)) { const ATT_LAS float* pk_ = posk + 64 * (T) + 4 * hi; \
                _Pragma("unroll") for (int g = 0; g < 4; ++g) { const f32x4 a_ = *(const ATT_LAS f32x4*)(pk_ + 8 * g), b_ = *(const ATT_LAS f32x4*)(pk_ + 8 * g + 32); \
                    _Pragma("unroll") for (int j = 0; j < 4; ++j) { P0[4 * g + j] -= slope2 * __builtin_fabsf(pq - a_[j]); P1[4 * g + j] -= slope2 * __builtin_fabsf(pq - b_[j]); } } } \
            if (D.own && 64 * (T) + 63 > wid * 32) { int dq_ = wid * 32 + r32 - 64 * (T) - 4 * hi; asm volatile("" : "+v"(dq_));     \
                _Pragma("unroll") for (int r = 0; r < 16; ++r) { const int c_ = (r & 3) + 8 * (r >> 2); if (c_ > dq_) P0[r] = -INFINITY; if (c_ + 32 > dq_) P1[r] = -INFINITY; } } \
            float rm_ = P0[0]; \
            _Pragma("unroll") for (int r = 1; r < 16; ++r) rm_ = fmaxf(rm_, P0[r]); \
            _Pragma("unroll") for (int r = 0; r < 16; ++r) rm_ = fmaxf(rm_, P1[r]); \
            { auto rr_ = __builtin_amdgcn_permlane32_swap(__float_as_uint(rm_), __float_as_uint(rm_), false, false); rm_ = fmaxf(__uint_as_float(rr_[0]), __uint_as_float(rr_[1])); } \
            if (first_ || __any(rm_ > 10.0f)) { const float dl_ = first_ ? rm_ : fmaxf(rm_, 0.f); mhat += dl_; \
                _Pragma("unroll") for (int r = 0; r < 16; ++r) { P0[r] -= dl_; P1[r] -= dl_; } \
                if (!first_) { const float f_ = __builtin_amdgcn_exp2f(-dl_); l_reg *= f_; \
                    _Pragma("unroll") for (int r = 0; r < 16; ++r) { o[0][r] *= f_; o[1][r] *= f_; } }                        \
                first_ = false; MB_QX(); } \
            float sacc_ = 0.f; \
            _Pragma("unroll") for (int r = 0; r < 16; ++r) { P0[r] = __builtin_amdgcn_exp2f(P0[r]); P1[r] = __builtin_amdgcn_exp2f(P1[r]); sacc_ += P0[r] + P1[r]; } \
            l_reg += sacc_; \
            u32x4 pw_[4]; \
            _Pragma("unroll") for (int s_ = 0; s_ < 2; ++s_) { \
                pw_[s_] = (u32x4){cvtpk(P0[8 * s_], P0[8 * s_ + 1]), cvtpk(P0[8 * s_ + 2], P0[8 * s_ + 3]), cvtpk(P0[8 * s_ + 4], P0[8 * s_ + 5]), cvtpk(P0[8 * s_ + 6], P0[8 * s_ + 7])}; \
                pw_[2 + s_] = (u32x4){cvtpk(P1[8 * s_], P1[8 * s_ + 1]), cvtpk(P1[8 * s_ + 2], P1[8 * s_ + 3]), cvtpk(P1[8 * s_ + 4], P1[8 * s_ + 5]), cvtpk(P1[8 * s_ + 6], P1[8 * s_ + 7])}; } \
            const lds_cptr vp_ = shm3 + rb + (T) * MB_TILE + vpl; s16x4 vl_[8], vh_[8]; \
            _Pragma("unroll") for (int i_ = 0; i_ < 8; ++i_) { vl_[i_] = vtr(vp_ + (i_ >> 2) * 4096 + (i_ & 3) * 1024); vh_[i_] = vtr(vp_ + (i_ >> 2) * 4096 + (i_ & 3) * 1024 + 512); } \
            __builtin_amdgcn_sched_barrier(0); \
            _Pragma("unroll") for (int i_ = 0; i_ < 8; ++i_) { \
                const bf16x8 vf_ = (bf16x8){vl_[i_][0], vl_[i_][1], vl_[i_][2], vl_[i_][3], vh_[i_][0], vh_[i_][1], vh_[i_][2], vh_[i_][3]}; \
                o[i_ >> 2] = __builtin_amdgcn_mfma_f32_32x32x16_bf16(vf_, __builtin_bit_cast(bf16x8, pw_[i_ & 3]), o[i_ >> 2], 0, 0, 0); } } while (0)
        if (!(PROBE & 1)) {
        if (MB_ACT(3)) MB_QKT(pA0, pA1, mA, 3);
        if (MB_ACT(2)) MB_QKT(pB0, pB1, mB, 2);
        if (MB_ACT(3)) MB_SMPV(pA0, pA1, mA, 3);
        }
        if (xn & 1u) { MB_STAGE(i + 1, Dn);
            MB_FETCH(i + 2, ent_, xnn); if (xnn & 1u) { MobaDesc Dnn; MB_UNPACK(xnn, Dnn); MB_SMALL(i + 2, ent_, Dnn); } } else xnn = 0u;
        if (!(PROBE & 1)) {
        if (!(PROBE & 64)) if (MB_ACT(1)) MB_QKT(pA0, pA1, mA, 1);
        if (MB_ACT(2)) MB_SMPV(pB0, pB1, mB, 2);
        if (!(PROBE & 64)) MB_QKT(pB0, pB1, mB, 0);
        }
        if (xn & 1u) { MB_FETCH(i + 1, ent_, xn); MB_QROW(i + 1, ent_, Dn, meta_n, qr, pq_n); }
        if (!(PROBE & 1)) {
        if (!(PROBE & 64)) if (MB_ACT(1)) MB_SMPV(pA0, pA1, mA, 1);
        if (!(PROBE & 64)) MB_SMPV(pB0, pB1, mB, 0);
        }
#undef MB_QKT
#undef MB_SMPV
#undef MB_ACT
#undef MB_CH
#undef MB_QX
        __builtin_amdgcn_s_waitcnt(0); __builtin_amdgcn_s_barrier();
        const int h_o = D.h; const bool valid_o = valid; const int qrow_o = qrow, slot_o = slot;
        xc = xn; xn = xnn; D = Dn; meta = meta_n; pq = pq_n;
        if (xc & 1u) { pbase = ((const ATT_LAS float*)(shm3 + MB_POSK + ((i + 1) % 3) * 1024))[0]; MB_CHEAP(i + 1, D, meta, pq, cm); }
        if (xn & 1u) { MobaDesc Dt; MB_UNPACK(xn, Dt); MB_DMA(Dt, cur * MB_REG); }
        { auto rr = __builtin_amdgcn_permlane32_swap(__float_as_uint(l_reg), __float_as_uint(l_reg), false, false); l_reg = __uint_as_float(rr[0]) + __uint_as_float(rr[1]); }
        { const float rl = __builtin_amdgcn_rcpf(l_reg);
          bf16_t* prow = C.part + ((((size_t)(qrow_o * 8 + h_o) * 4 + slot_o) * 64) & (PROBE ? ((PROBE & 4) ? (size_t)0x3FFC0 : (size_t)0x7FFFC0) : ~(size_t)0)) + 8 * hi;
#pragma unroll
          for (int dh = 0; dh < 2; ++dh)
#pragma unroll
            for (int jp = 0; jp < 2; ++jp) {
                unsigned a0 = cvtpk(o[dh][8 * jp] * rl, o[dh][8 * jp + 1] * rl), a1 = cvtpk(o[dh][8 * jp + 2] * rl, o[dh][8 * jp + 3] * rl);
                unsigned b0 = cvtpk(o[dh][8 * jp + 4] * rl, o[dh][8 * jp + 5] * rl), b1 = cvtpk(o[dh][8 * jp + 6] * rl, o[dh][8 * jp + 7] * rl);
                const auto s0 = __builtin_amdgcn_permlane32_swap(a0, b0, false, false); const auto s1 = __builtin_amdgcn_permlane32_swap(a1, b1, false, false);
                if (!(PROBE & 2)) if (valid_o) *(u32x4*)(prow + 32 * dh + 16 * jp) = (u32x4){s0[0], s1[0], s0[1], s1[1]}; }
          if (!(PROBE & 2)) if (hi == 0 && valid_o) C.plse[(size_t)(qrow_o * 8 + h_o) * 4 + slot_o] = mhat + __builtin_log2f(l_reg); }
    }
    if (i < MB_NUT) break;
  }
#undef MB_UNPACK
#undef MB_DMA
#undef MB_FETCH
#undef MB_SMALL
#undef MB_STAGE
#undef MB_QROW
#undef MB_CHEAP
}
}

namespace xb {
#define LAS __attribute__((address_space(3)))
#define XB_TMO      128
#define XB_XCNT(j)  (256  + 64 * (j))
#define XB_XSUB(j)  (1280 + 64 * (j))
#define XB_XGEN(j)  (2304 + 64 * (j))
#define XB_TOP      3328
#define XB_TOPGEN   3392
#define XCD_BAR_WORDS 3456
#define XB_SPIN_CAP (1u << 21)

__device__ __forceinline__ unsigned xb_ld(unsigned* p)              { return __hip_atomic_load(p, __ATOMIC_RELAXED, __HIP_MEMORY_SCOPE_AGENT); }
__device__ __forceinline__ unsigned xb_add(unsigned* p, unsigned v) { return __hip_atomic_fetch_add(p, v, __ATOMIC_RELAXED, __HIP_MEMORY_SCOPE_AGENT); }
__device__ __forceinline__ unsigned xb_xcc_id() { return (unsigned)__builtin_amdgcn_s_getreg((3 << 11) | 20) & 0xFu; }
#define XB_SPIN(cond, bar) do { unsigned _sp = 0; while (cond) { __builtin_amdgcn_s_sleep(1); \
    if ((++_sp & 255u) == 0u) { if (xb_ld(&(bar)[XB_TMO])) break; if (_sp > XB_SPIN_CAP) { atomicAdd(&(bar)[XB_TMO], 1u); break; } } } } while (0)

struct XcdBarrier {
    unsigned* bar; unsigned x;
    volatile LAS unsigned* st;
};

__device__ __forceinline__ XcdBarrier xcd_barrier_post(unsigned* bar, volatile LAS unsigned* st, bool leader) {
    XcdBarrier b; b.bar = bar; b.x = xb_xcc_id(); b.st = st;
    if (leader) (void)xb_add(&bar[XB_XCNT(b.x)], 1u);
    return b;
}
__device__ __forceinline__ void xcd_barrier_complete(unsigned* bar, unsigned x, unsigned& nloc, unsigned& nx) {
    const unsigned G = gridDim.x * gridDim.y * gridDim.z;
    unsigned sum, cnt, mine, sp = 0u;
    for (;;) {
        sum = 0u; cnt = 0u; mine = 0u;
#pragma unroll
        for (unsigned j = 0; j < 16; ++j) { const unsigned c = xb_ld(&bar[XB_XCNT(j)]); sum += c; cnt += (c > 0u) ? 1u : 0u; mine = (j == x) ? c : mine; }
        if (sum == G) break;
        __builtin_amdgcn_s_sleep(1);
        if ((++sp & 255u) == 0u) { if (xb_ld(&bar[XB_TMO])) break; if (sp > XB_SPIN_CAP) { atomicAdd(&bar[XB_TMO], 1u); break; } }
    }
    nloc = mine > 0u ? mine : 1u; nx = cnt > 0u ? cnt : 1u;
}

__device__ __forceinline__ void xcd_barrier(const XcdBarrier& b, bool leader) {
    asm volatile("s_waitcnt vmcnt(0)" ::: "memory");
    __syncthreads();
    if (leader) {
        unsigned* bar = b.bar;
        __builtin_amdgcn_s_waitcnt(0);
        unsigned nloc = b.st[0], nx = b.st[1];
        if (nloc == 0u) { xcd_barrier_complete(bar, b.x, nloc, nx); b.st[0] = nloc; b.st[1] = nx; }
        const unsigned old = xb_add(&bar[XB_XSUB(b.x)], 1u);
        const unsigned gen = old / nloc;
        if (old + 1u == (gen + 1u) * nloc) {
            __builtin_amdgcn_fence(__ATOMIC_RELEASE, "agent");
            asm volatile("s_waitcnt vmcnt(0)" ::: "memory");
            const unsigned og = xb_add(&bar[XB_TOP], 1u);
            const unsigned tg = og / nx;
            if (og + 1u == (tg + 1u) * nx) xb_add(&bar[XB_TOPGEN], 1u);
            else XB_SPIN(xb_ld(&bar[XB_TOPGEN]) == tg, bar);
            __builtin_amdgcn_fence(__ATOMIC_ACQUIRE, "agent");
            xb_add(&bar[XB_XGEN(b.x)], 1u);
            asm volatile("s_waitcnt vmcnt(0)" ::: "memory");
        } else {
            XB_SPIN(xb_ld(&bar[XB_XGEN(b.x)]) == gen, bar);
            __builtin_amdgcn_fence(__ATOMIC_ACQUIRE, "agent");
            asm volatile("s_waitcnt vmcnt(0)" ::: "memory");
        }
    }
    __syncthreads();
}

#undef LAS
}
namespace mk {
typedef unsigned short bf16;
typedef unsigned v4u __attribute__((ext_vector_type(4)));
typedef float f32x4 __attribute__((ext_vector_type(4)));
#define MK_LAS __attribute__((address_space(3)))
using namespace mkc;
constexpr int NWAVES = 8;
constexpr int RING_BYTES = 131072, LDS_EXTRA = RING_BYTES, LDS_MISC = RING_BYTES + 8192, LDS_BYTES = 150528;
constexpr size_t WS_BAR = 4096, BAR_BYTES = 32768;

struct Args { const float* in[18]; float* out; unsigned char* ws; int ph_lo, ph_hi; };
struct Frame { MK_LAS unsigned char* lds; int tid, lane, wave, vcu, G; };
typedef const __attribute__((address_space(4))) Args* kargs_t;
__device__ __forceinline__ kargs_t kargs() { kargs_t p = (kargs_t)__builtin_amdgcn_kernarg_segment_ptr(); asm volatile("" : "+s"(p)); return p; }
__device__ __forceinline__ Frame mkframe(MK_LAS unsigned char* lds, int wave) { Frame F; F.lds = lds; F.wave = wave; F.lane = pg8::lane_id_v(); F.tid = wave * 64 + F.lane; F.G = gridDim.x;
    { const int bx = blockIdx.x; F.vcu = (F.G % 8 == 0) ? (bx % 8) * (F.G / 8) + bx / 8 : bx; } return F; }

__device__ __forceinline__ unsigned f2bf(float f) { unsigned u = __builtin_bit_cast(unsigned, f); return (u + 0x7fffu + ((u >> 16) & 1u)) >> 16; }
__device__ __forceinline__ unsigned pk2(float lo, float hi) { return f2bf(lo) | (f2bf(hi) << 16); }
__device__ __forceinline__ float bf2f(unsigned short b) { return __builtin_bit_cast(float, (unsigned)b << 16); }
__device__ __forceinline__ float wave_sum(float v) {
#pragma unroll
    for (int o = 1; o < 64; o <<= 1) v += __shfl_xor(v, o);
    return v;
}
__constant__ float ROPE_INV[16] = {1.000000000e+00f, 5.623413324e-01f, 3.162277639e-01f, 1.778279394e-01f, 1.000000015e-01f, 5.623413250e-02f, 3.162277490e-02f, 1.778279431e-02f,
                                   9.999999776e-03f, 5.623413250e-03f, 3.162277630e-03f, 1.778279431e-03f, 1.000000047e-03f, 5.623413017e-04f, 3.162277571e-04f, 1.778279402e-04f};
__device__ __forceinline__ int rope_phys(int L) { return L < 16 ? 8 * (L >> 2) + (L & 3) : 8 * ((L - 16) >> 2) + 4 + ((L - 16) & 3); }

__device__ __forceinline__ void p0_item(const float* W, int K, int N, bf16* WT, const float* gain, int kind, MK_LAS float* scr, int item, int lane) {
    const int nblk = N / 32, kb = item / nblk, nb = item % nblk, k0 = 64 * kb, n0 = 32 * nb;
    int dbase = n0; bool perm = false; float mul = 1.0f;
    if (kind == 1) dbase = (n0 >> 7) * 256 + (n0 & 127);
    else if (kind == 2) dbase = (n0 >> 7) * 256 + 128 + (n0 & 127);
    else if (kind == 3) { if (n0 == 640) perm = true; else if (n0 >= 672) { dbase = n0 + 96; if (n0 < 1184) mul = C2M; } }
    else if (kind == 4) { perm = (n0 % 96) == 64; mul = C2Q; }
    else if (kind == 5) { const int h = n0 >> 7, e = n0 & 127; dbase = e < 64 ? h * 64 + e : 512 + h * 64 + (e - 64); }
    float wv[32];
#pragma unroll
    for (int i = 0; i < 32; ++i) wv[i] = W[(size_t)(k0 + 2 * i + (lane >> 5)) * N + n0 + (lane & 31)];
#pragma unroll
    for (int i = 0; i < 32; ++i) { const int kk = 2 * i + (lane >> 5); const float g = gain ? gain[k0 + kk] * mul : mul; scr[kk * 33 + (lane & 31)] = wv[i] * g; }
    asm volatile("s_waitcnt lgkmcnt(0)" ::: "memory");
    const int c = lane & 7;
#pragma unroll
    for (int j = 0; j < 4; ++j) { const int n = (lane >> 3) + 8 * j; const MK_LAS float* s = scr + (8 * c) * 33 + n;
        v4u o; o.x = pk2(s[0 * 33], s[1 * 33]); o.y = pk2(s[2 * 33], s[3 * 33]); o.z = pk2(s[4 * 33], s[5 * 33]); o.w = pk2(s[6 * 33], s[7 * 33]);
        const int drow = dbase + (perm ? rope_phys(n) : n);
        *(v4u*)(WT + (size_t)drow * K + k0 + 8 * c) = o; }
    asm volatile("s_waitcnt lgkmcnt(0)" ::: "memory");
}
constexpr int I_G = (DM / 64) * (DFF / 32), I_D = (DFF / 64) * (DM / 32), I_IN = (DM / 64) * (2208 / 32), I_UQ = (384 / 64) * (768 / 32), I_UKV = (256 / 64) * (1024 / 32), I_O = (DM / 64) * (DM / 32);
constexpr int NITEMS = 4 * I_G + 2 * I_D + I_IN + I_UQ + I_UKV + I_O;
__device__ __forceinline__ void p0_one_item(kargs_t ap, unsigned char* ws, MK_LAS float* scr, int it, int lane) {
    int r = it;
    if (r < I_G) { p0_item(ap->in[3], DM, DFF, (bf16*)(ws + WS_WGU1), ap->in[2], 1, scr, r, lane); return; } r -= I_G;
    if (r < I_G) { p0_item(ap->in[4], DM, DFF, (bf16*)(ws + WS_WGU1), ap->in[2], 2, scr, r, lane); return; } r -= I_G;
    if (r < I_D) { p0_item(ap->in[5], DFF, DM, (bf16*)(ws + WS_WD1), nullptr, 0, scr, r, lane); return; } r -= I_D;
    if (r < I_G) { p0_item(ap->in[14], DM, DFF, (bf16*)(ws + WS_WGU2), ap->in[13], 1, scr, r, lane); return; } r -= I_G;
    if (r < I_G) { p0_item(ap->in[15], DM, DFF, (bf16*)(ws + WS_WGU2), ap->in[13], 2, scr, r, lane); return; } r -= I_G;
    if (r < I_D) { p0_item(ap->in[16], DFF, DM, (bf16*)(ws + WS_WD2), nullptr, 0, scr, r, lane); return; } r -= I_D;
    if (r < I_IN) { p0_item(ap->in[7], DM, 2208, (bf16*)(ws + WS_WIN), ap->in[6], 3, scr, r, lane); return; } r -= I_IN;
    if (r < I_UQ) { p0_item(ap->in[9], 384, 768, (bf16*)(ws + WS_WUQ), ap->in[8], 4, scr, r, lane); return; } r -= I_UQ;
    if (r < I_UKV) { p0_item(ap->in[11], 256, 1024, (bf16*)(ws + WS_WUKV), ap->in[10], 5, scr, r, lane); return; } r -= I_UKV;
    p0_item(ap->in[12], DM, DM, (bf16*)(ws + WS_WOUT), nullptr, 0, scr, r, lane);
}
__device__ __forceinline__ void p0_tables_and_zero(kargs_t ap, const int gt, const int NGT) {
    unsigned char* ws = ap->ws;
    const int* pos = (const int*)ap->in[1]; float* posf = (float*)(ws + WS_POSF); float* cosT = (float*)(ws + WS_COS); float* sinT = (float*)(ws + WS_SIN);
    for (int e = gt; e < S * 16; e += NGT) { const int s_ = e >> 4, i = e & 15; const float ang = (float)pos[s_] * ROPE_INV[i]; float sn, cs; sincosf(ang, &sn, &cs); cosT[e] = cs; sinT[e] = sn; if (i == 0) posf[s_] = (float)pos[s_]; }
    for (int e = gt; e < S / 64; e += NGT) { int m_ = pos[64 * e]; for (int j = 1; j < 64; ++j) m_ = max(m_, pos[64 * e + j]); posf[S + e] = (float)m_; }
    float* z = (float*)(ws + WS_SS2);
    for (int e = gt; e < 5 * S; e += NGT) z[e] = 0.f;
    float* km = (float*)(ws + WS_KMS);
    for (int e = gt; e < 64 * 512; e += NGT) km[e] = 0.f;
    unsigned* cnt = (unsigned*)(ws + WS_CNT);
    for (int e = gt; e < 512; e += NGT) cnt[e] = 0u;
    unsigned* padz = (unsigned*)((bf16*)(ws + WS_WIN) + (size_t)672 * DM);
    for (int e = gt; e < 96 * DM / 2; e += NGT) padz[e] = 0u;
}
__device__ __forceinline__ void p0_late_items(const Frame& F, kargs_t ap) {
    unsigned char* ws = ap->ws; MK_LAS float* scr = (MK_LAS float*)(F.lds + F.wave * 16384);
    const int w = ((int)blockIdx.x - 128) * NWAVES + F.wave, NW_ = 128 * NWAVES;
    for (int it = 2 * I_G + w; it < NITEMS; it += NW_) p0_one_item(ap, ws, scr, it, F.lane);
    p0_tables_and_zero(ap, w * 64 + F.lane, NW_ * 64);
}
__device__ __forceinline__ void p0_prologue(const Frame& F, kargs_t ap) {
    unsigned char* ws = ap->ws;
    MK_LAS float* scr = (MK_LAS float*)(F.lds + F.wave * 16384);
    const int gw = F.vcu * NWAVES + F.wave, NGW = F.G * NWAVES;
    constexpr int N_EARLY = 2 * I_G;
    const int n_here = (F.G == 256) ? N_EARLY : NITEMS;
    for (int it = gw; it < n_here; it += NGW) p0_one_item(ap, ws, scr, it, F.lane);
    const float* x = ap->in[0]; bf16* xb = (bf16*)(ws + WS_XB); float* ss1 = (float*)(ws + WS_SS1);
    for (int m = gw; m < S; m += 4 * NGW) {
        f32x4 v[4][4];
#pragma unroll
        for (int r = 0; r < 4; ++r) { const int mr = m + r * NGW; if (mr < S) { const f32x4* xr = (const f32x4*)(x + (size_t)mr * DM) + F.lane;
#pragma unroll
            for (int j = 0; j < 4; ++j) v[r][j] = xr[64 * j]; } }
#pragma unroll
        for (int r = 0; r < 4; ++r) { const int mr = m + r * NGW; if (mr < S) { unsigned long long* o8 = (unsigned long long*)(xb + (size_t)mr * DM) + F.lane; float s = 0.f;
#pragma unroll
            for (int j = 0; j < 4; ++j) { const f32x4 w = v[r][j]; s += (w[0] * w[0] + w[1] * w[1]) + (w[2] * w[2] + w[3] * w[3]); o8[64 * j] = (unsigned long long)pk2(w[0], w[1]) | ((unsigned long long)pk2(w[2], w[3]) << 32); }
            s = wave_sum(s); if (F.lane == 0) ss1[mr] = s; } }
    }
    if (F.G != 256) p0_tables_and_zero(ap, (F.vcu * NWAVES + F.wave) * 64 + F.lane, NGW * 64);
}

__device__ __forceinline__ void p4_krope(const Frame& F, kargs_t ap) { unsigned char* const wsb = ap->ws;
    const bf16* cqkv = (const bf16*)(wsb + WS_CQKV); bf16* Kr = (bf16*)(wsb + WS_KR); const float* cosT = (const float*)(wsb + WS_COS); const float* sinT = (const float*)(wsb + WS_SIN);
    const int gt = (F.vcu * NWAVES + F.wave) * 64 + F.lane, NGT = F.G * NWAVES * 64;
    for (int e = gt; e < S * 16; e += NGT) { const int s_ = e >> 4, i = e & 15, g = i >> 2, j = i & 3;
        const float x1 = bf2f(cqkv[(size_t)s_ * 768 + 640 + 8 * g + j]), x2 = bf2f(cqkv[(size_t)s_ * 768 + 640 + 8 * g + 4 + j]); const float c = cosT[e], sn = sinT[e];
        Kr[(size_t)s_ * 32 + 8 * g + j] = (bf16)f2bf(x1 * c - x2 * sn); Kr[(size_t)s_ * 32 + 8 * g + 4 + j] = (bf16)f2bf(x1 * sn + x2 * c); }
}
__device__ __forceinline__ void p4_gating(const Frame& F, kargs_t ap) { unsigned char* const wsb = ap->ws;
    const bf16* mqkv = (const bf16*)(wsb + WS_MQKV); const float* kms = (const float*)(wsb + WS_KMS); unsigned* cnt = (unsigned*)(wsb + WS_CNT); unsigned* lists = (unsigned*)(wsb + WS_LIST);
    MK_LAS float* km = (MK_LAS float*)F.lds;
    const int u0 = (F.G == 256) ? ((int)blockIdx.x < 192 ? (int)blockIdx.x : 256) : F.vcu, ustep = (F.G == 256) ? 192 : F.G;
    for (int u = u0; u < 256; u += ustep) {
        const int h = u & 7, q = (u >> 3) * 512 + F.tid, own = q >> 8;
        __syncthreads();
        for (int e = F.tid; e < 4096; e += 512) km[e] = kms[(size_t)(e >> 6) * 512 + h * 64 + (e & 63)] * (1.0f / 256.0f);
        __syncthreads();
        float qv[64];
        { const v4u* qp = (const v4u*)(mqkv + (size_t)q * 1536 + h * 64);
#pragma unroll
          for (int c = 0; c < 8; ++c) { const v4u w = qp[c];
#pragma unroll
              for (int j = 0; j < 4; ++j) { qv[8 * c + 2 * j] = __builtin_bit_cast(float, w[j] << 16); qv[8 * c + 2 * j + 1] = __builtin_bit_cast(float, w[j] & 0xFFFF0000u); } } }
        float g0 = -3e38f, g1 = -3e38f, g2 = -3e38f; int i0 = -1, i1 = -1, i2 = -1;
        const int own_max = __builtin_amdgcn_readfirstlane(own);
        for (int n = 0; n < own_max; ++n) {
            float g = 0.f;
#pragma unroll
            for (int c = 0; c < 16; ++c) { const f32x4 kk = *(const MK_LAS f32x4*)(km + n * 64 + 4 * c); g = fmaf(qv[4 * c], kk[0], g); g = fmaf(qv[4 * c + 1], kk[1], g); g = fmaf(qv[4 * c + 2], kk[2], g); g = fmaf(qv[4 * c + 3], kk[3], g); }
            if (g > g0) { g2 = g1; i2 = i1; g1 = g0; i1 = i0; g0 = g; i0 = n; }
            else if (g > g1) { g2 = g1; i2 = i1; g1 = g; i1 = n; }
            else if (g > g2) { g2 = g; i2 = n; }
        }
        MK_LAS unsigned* lcnt = (MK_LAS unsigned*)(F.lds + 16384);
        __syncthreads();
        if (F.tid < 64) lcnt[F.tid] = 0u;
        __syncthreads();
        unsigned r0 = 0u, r1 = 0u, r2 = 0u;
        if (i0 >= 0) r0 = __hip_atomic_fetch_add(lcnt + i0, 1u, __ATOMIC_RELAXED, __HIP_MEMORY_SCOPE_WORKGROUP);
        if (i1 >= 0) r1 = __hip_atomic_fetch_add(lcnt + i1, 1u, __ATOMIC_RELAXED, __HIP_MEMORY_SCOPE_WORKGROUP);
        if (i2 >= 0) r2 = __hip_atomic_fetch_add(lcnt + i2, 1u, __ATOMIC_RELAXED, __HIP_MEMORY_SCOPE_WORKGROUP);
        __syncthreads();
        if (F.tid < 64) { const unsigned c = lcnt[F.tid]; lcnt[64 + F.tid] = c ? atomicAdd(cnt + h * 64 + F.tid, c) : 0u; }
        __syncthreads();
        if (i0 >= 0) lists[(size_t)(h * 64 + i0) * S + lcnt[64 + i0] + r0] = (unsigned)(q | (0 << 14));
        if (i1 >= 0) lists[(size_t)(h * 64 + i1) * S + lcnt[64 + i1] + r1] = (unsigned)(q | (1 << 14));
        if (i2 >= 0) lists[(size_t)(h * 64 + i2) * S + lcnt[64 + i2] + r2] = (unsigned)(q | (2 << 14));
    }
    __syncthreads();
}
__device__ __forceinline__ void p5_combine(const Frame& F, kargs_t ap) { unsigned char* const wsb = ap->ws;
    const bf16* part = (const bf16*)ap->out;     const float* plse = (const float*)(wsb + WS_PLSE); bf16* cat = (bf16*)(wsb + WS_CAT);
    const int gt = (F.vcu * NWAVES + F.wave) * 64 + F.lane, NGT = F.G * NWAVES * 64;
    for (int e = gt; e < S * 8 * 8; e += NGT) { const int dg = e & 7, qh = e >> 3, q = qh >> 3, h = qh & 7; const int ns = 1 + min(3, q >> 8);
        const f32x4 ls = *(const f32x4*)(plse + (size_t)qh * 4);
        float M = ls[0]; for (int s = 1; s < 4; ++s) if (s < ns) M = fmaxf(M, ls[s]);
        float acc[8], wsum = 0.f;
#pragma unroll
        for (int j = 0; j < 8; ++j) acc[j] = 0.f;
#pragma unroll
        for (int s = 0; s < 4; ++s) if (s < ns) { const float w = __builtin_amdgcn_exp2f(ls[s] - M); wsum += w; const v4u v = *(const v4u*)(part + ((size_t)qh * 4 + s) * 64 + dg * 8);
#pragma unroll
            for (int j = 0; j < 4; ++j) { acc[2 * j] += w * __builtin_bit_cast(float, v[j] << 16); acc[2 * j + 1] += w * __builtin_bit_cast(float, v[j] & 0xFFFF0000u); } }
        const float r = 1.0f / wsum; v4u o; o.x = pk2(acc[0] * r, acc[1] * r); o.y = pk2(acc[2] * r, acc[3] * r); o.z = pk2(acc[4] * r, acc[5] * r); o.w = pk2(acc[6] * r, acc[7] * r);
        *(v4u*)(cat + (size_t)q * 1024 + 512 + h * 64 + dg * 8) = o; }
}
__device__ __forceinline__ void p9_final(const Frame& F, kargs_t ap) { unsigned char* const wsb = ap->ws;
    const float* ss = (const float*)(wsb + WS_SS4); const float* g = ap->in[17];
    const int gw = F.vcu * NWAVES + F.wave, NGW = F.G * NWAVES;
    float tsc = 1.0f;
#ifdef MK_TS
    { const unsigned long long* ts = (const unsigned long long*)(wsb + 2048); tsc = 1.0f + (float)(ts[MK_TS + 1] - ts[MK_TS]) * (float)MK_TS_SCALE; }
#endif
    for (int m = gw; m < S; m += NGW) { const float rs = tsc / sqrtf(ss[m] * (1.0f / 1024.0f) + 1e-6f); f32x4* xr = (f32x4*)(ap->out + (size_t)m * DM) + F.lane; const f32x4* gr = (const f32x4*)g + F.lane;
#pragma unroll
        for (int j = 0; j < 4; ++j) { const f32x4 v = xr[64 * j]; xr[64 * j] = v * rs * gr[64 * j]; } }
}

__global__ void __launch_bounds__(NWAVES * 64, 2) mk_fwd(Args a_unused) {
    extern __shared__ __attribute__((aligned(16))) unsigned char lds[];
    const int wave = __builtin_amdgcn_readfirstlane(threadIdx.x >> 6);
    MK_LAS unsigned char* const ldsp = (MK_LAS unsigned char*)lds;
    int lo, hi; { kargs_t ap = kargs(); lo = ap->ph_lo; hi = ap->ph_hi; }
#ifndef MK_ONLY
#define MK_ONLY -1
#endif
#define IN(k) ((MK_ONLY < 0 || MK_ONLY == (k)) && lo <= (k) && (k) < hi)
    const bool multi = (hi - lo) > 1;
    if (multi) {
        const int l0 = pg8::lane_id_v();
        if (wave == 0 && l0 < 2) ((volatile MK_LAS unsigned*)(ldsp + LDS_MISC))[l0] = 0u;
        __syncthreads();
        kargs_t ap = kargs(); (void)xb::xcd_barrier_post((unsigned*)(ap->ws + WS_BAR), (volatile MK_LAS unsigned*)(ldsp + LDS_MISC), wave == 0 && l0 == 0);
    }
    if (lo < -1) cg::this_grid().sync();
#ifdef MK_TS
#define MK_STAMP(i) do { if (blockIdx.x == 0 && wave == 0 && pg8::lane_id_v() == 0) { kargs_t ap__ = kargs(); ((unsigned long long*)(ap__->ws + 2048))[(i)] = __builtin_amdgcn_s_memrealtime(); } } while (0)
#else
#define MK_STAMP(i) do { } while (0)
#endif
    MK_STAMP(0);
#define SEAM(k) do { if (IN(k) && IN((k) + 1)) { kargs_t ap_ = kargs(); xb::XcdBarrier b_; b_.bar = (unsigned*)(ap_->ws + WS_BAR); b_.x = xb::xb_xcc_id(); b_.st = (volatile MK_LAS unsigned*)(ldsp + LDS_MISC); \
        xb::xcd_barrier(b_, wave == 0 && pg8::lane_id_v() == 0); MK_STAMP((k) + 1); } } while (0)
    if (IN(0)) { kargs_t ap = kargs(); const Frame F = mkframe(ldsp, wave); p0_prologue(F, ap); } SEAM(0);
    if (IN(1)) { kargs_t ap = kargs(); unsigned char* ws = ap->ws; pg8::Gemm g{(const bf16*)(ws + WS_XB), (const bf16*)(ws + WS_WGU1), S, NGU, DM, DM}; pg8::StaticOrder So; So.init(S, NGU, (int)gridDim.x, (int)blockIdx.x);
        pg8::EpiSwiGLU E{ws, 0}; pg8::gemm_phase<pg8::EpiSwiGLU, pg8::StaticOrder, true, true>(ldsp, g, So, E, wave);
        if (gridDim.x == 256 && blockIdx.x >= 128) { kargs_t ap2 = kargs(); const Frame F = mkframe(ldsp, wave); __syncthreads(); p0_late_items(F, ap2); } } SEAM(1);
    if (IN(2)) { kargs_t ap = kargs(); unsigned char* ws = ap->ws; pg8::Gemm g{(const bf16*)(ws + WS_ACT), (const bf16*)(ws + WS_WD1), S, DM, DFF, DFF}; pg8::StaticOrder So; So.init(S, DM, (int)gridDim.x, (int)blockIdx.x);
        pg8::EpiResid E{nullptr, ws, (int)WS_SS2, 0.5f}; pg8::gemm_phase<pg8::EpiResid, pg8::StaticOrder, true, true>(ldsp, g, So, E, wave); } SEAM(2);
    if (IN(3)) { kargs_t ap = kargs(); unsigned char* ws = ap->ws; pg8::Gemm g{(const bf16*)(ws + WS_XB), (const bf16*)(ws + WS_WIN), S, NWIN, DM, DM}; pg8::StaticOrder So; So.init(S, gridDim.x == 256 ? NWIN - 256 : NWIN, (int)gridDim.x, (int)blockIdx.x);
        pg8::EpiWin E{ws, 0}; pg8::gemm_phase<pg8::EpiWin, pg8::StaticOrder, true, true>(ldsp, g, So, E, wave); } SEAM(3);
    if (IN(4)) {
        { kargs_t ap = kargs(); unsigned char* ws = ap->ws; pg8::Gemm g{(const bf16*)(ws + WS_CQKV) + 384, (const bf16*)(ws + WS_WUKV), S, 1024, 256, 768}; pg8::StaticOrder So; So.init(S, 1024, (int)gridDim.x, (int)blockIdx.x);
          pg8::EpiKV E{ws}; pg8::gemm_phase<pg8::EpiKV, pg8::StaticOrder, true, true>(ldsp, g, So, E, wave); }
        { kargs_t ap = kargs(); unsigned char* ws = ap->ws; pg8::Gemm g{(const bf16*)(ws + WS_CQKV), (const bf16*)(ws + WS_WUQ), S, 768, 384, 768}; pg8::StaticOrder So; So.init(S, 768, (int)gridDim.x, (int)blockIdx.x);
          pg8::EpiQ E{ws}; pg8::gemm_phase<pg8::EpiQ, pg8::StaticOrder, true, true>(ldsp, g, So, E, wave); }
        if (gridDim.x == 256) { kargs_t ap = kargs(); unsigned char* ws = ap->ws; pg8::Gemm g{(const bf16*)(ws + WS_XB), (const bf16*)(ws + WS_WIN), S, NWIN, DM, DM}; pg8::TailOrder So; So.init(S, 8, (int)gridDim.x, (int)blockIdx.x);
          pg8::EpiWin E{ws, 0}; pg8::gemm_phase<pg8::EpiWin, pg8::TailOrder, true, true>(ldsp, g, So, E, wave); }
        { kargs_t ap = kargs(); const Frame F = mkframe(ldsp, wave); p4_krope(F, ap); }
#ifndef MK_NO_GATE
        { kargs_t ap = kargs(); const Frame F = mkframe(ldsp, wave); p4_gating(F, ap); }
#endif
    } SEAM(4);
#ifndef MK_NO_ATT5
    if (IN(5)) {
        kargs_t ap = kargs(); unsigned char* ws = ap->ws; const Frame F = mkframe(ldsp, wave);
        MK_LAS int* pre = (MK_LAS int*)(ldsp + att::MB_PRE);
        const unsigned* cnt = (const unsigned*)(ws + WS_CNT);
        __syncthreads();
        { const int c = (int)cnt[F.tid]; pre[F.tid] = (c + 255) >> 8; }
        __syncthreads();
        for (int o = 1; o < 512; o <<= 1) { const int v = pre[F.tid] + (F.tid >= o ? pre[F.tid - o] : 0); __syncthreads(); pre[F.tid] = v; __syncthreads(); }
        att::MobaCtx C; C.mqkv = (const bf16*)(ws + WS_MQKV); C.posf = (const float*)(ws + WS_POSF); C.part = (bf16*)ap->out; C.plse = (float*)(ws + WS_PLSE);
        C.lists = (const unsigned*)(ws + WS_LIST); C.cnt = cnt; C.total = pre[511]; C.vcu = F.vcu; C.G = F.G;
        att::moba_run<0>(C, (char*)lds, wave);
#ifdef MK_PROBE5
        __syncthreads(); C.part = (bf16*)(ws + WS_CQKV); C.plse = (float*)(ws + WS_CQKV + (16u << 20)); att::moba_run<MK_PROBE5>(C, (char*)lds, wave);
#endif
    }
#endif
    SEAM(5);
    if (IN(6)) {
        { kargs_t ap = kargs(); const Frame F = mkframe(ldsp, wave); p5_combine(F, ap); }
#ifndef MK_NO_ATT6
        kargs_t ap = kargs(); unsigned char* ws = ap->ws; const Frame F = mkframe(ldsp, wave);
        att::Unit U; U.posf = nullptr; U.part = nullptr; U.plse = nullptr; U.list = nullptr; U.len = 0; U.slope2 = 0.f; U.q_pitch = 768; U.k_pitch = 512; U.v_pitch = 512; U.o_pitch = 1024; U.key0 = 0; U.Kr = (const bf16*)(ws + WS_KR);
        for (int v = F.vcu; v < 256; v += F.G) { const int h = v >> 5, s_ = v & 31;
            for (int i = 0; i < 2; ++i) { const int qb = i == 0 ? 63 - s_ : s_;
                U.h = h; U.Q = (const bf16*)(ws + WS_Q) + h * 96; U.K = (const bf16*)(ws + WS_KN) + h * 64; U.V = (const bf16*)(ws + WS_V) + h * 64; U.O = (bf16*)(ws + WS_CAT) + h * 64; U.q0 = qb * 256; U.ntiles = 4 * (qb + 1);
                att::unit<0>(U, (char*)lds, wave); } }
#endif
    } SEAM(6);
    if (IN(7)) { kargs_t ap = kargs(); unsigned char* ws = ap->ws; pg8::Gemm g{(const bf16*)(ws + WS_CAT), (const bf16*)(ws + WS_WOUT), S, DM, DM, DM}; pg8::StaticOrder So; So.init(S, DM, (int)gridDim.x, (int)blockIdx.x);
        pg8::EpiResid E{nullptr, ws, (int)WS_SS3, 1.0f}; pg8::gemm_phase<pg8::EpiResid, pg8::StaticOrder, true, true>(ldsp, g, So, E, wave); } SEAM(7);
    if (IN(8)) { kargs_t ap = kargs(); unsigned char* ws = ap->ws; pg8::Gemm g{(const bf16*)(ws + WS_XB), (const bf16*)(ws + WS_WGU2), S, NGU, DM, DM}; pg8::StaticOrder So; So.init(S, NGU, (int)gridDim.x, (int)blockIdx.x);
        pg8::EpiSwiGLU E{ws, 1}; pg8::gemm_phase<pg8::EpiSwiGLU, pg8::StaticOrder, true, true>(ldsp, g, So, E, wave); } SEAM(8);
    if (IN(9)) { kargs_t ap = kargs(); unsigned char* ws = ap->ws; pg8::Gemm g{(const bf16*)(ws + WS_ACT), (const bf16*)(ws + WS_WD2), S, DM, DFF, DFF}; pg8::StaticOrder So; So.init(S, DM, (int)gridDim.x, (int)blockIdx.x);
        if (gridDim.x == 256) { pg8::EpiResidNorm E{ap->out, ws, ap->in[17], 0.5f}; pg8::gemm_phase<pg8::EpiResidNorm, pg8::StaticOrder, false, true>(ldsp, g, So, E, wave); }
        else { pg8::EpiResid E{ap->out, ws, (int)WS_SS4, 0.5f}; pg8::gemm_phase<pg8::EpiResid, pg8::StaticOrder, true, true>(ldsp, g, So, E, wave); } }
    if (gridDim.x != 256) SEAM(9);
    if (IN(10) && gridDim.x != 256) { kargs_t ap = kargs(); const Frame F = mkframe(ldsp, wave); p9_final(F, ap); }
#undef IN
#undef SEAM
}
constexpr int N_PHASES = 11;
}
#ifndef MK_BRINGUP
#define MK_BRINGUP 0
#endif
extern "C" void kernel_launch(void* const* d_in, const int* in_sizes, int n_in, void* d_out, int out_size, void* d_ws, size_t ws_size, hipStream_t stream) {
    static int grid = 0;
    if (grid == 0) {
        if (hipFuncSetAttribute((const void*)mk::mk_fwd, hipFuncAttributeMaxDynamicSharedMemorySize, mk::LDS_BYTES) != hipSuccess) { fprintf(stderr, "kernel_launch: hipFuncSetAttribute failed\n"); grid = -1; return; }
        int dev = 0, cus = 0, per_cu = 0;
        hipGetDevice(&dev); hipDeviceGetAttribute(&cus, hipDeviceAttributeMultiprocessorCount, dev);
        hipOccupancyMaxActiveBlocksPerMultiprocessor(&per_cu, (const void*)mk::mk_fwd, mk::NWAVES * 64, mk::LDS_BYTES);
        (void)hipGetLastError();
        grid = cus * (per_cu < 1 ? 1 : (per_cu > 1 ? 1 : per_cu));
        if (grid % 8 != 0 || grid <= 0) grid = 256;
        if (ws_size < mk::WS_END) { fprintf(stderr, "kernel_launch: workspace too small (%zu)\n", ws_size); grid = -1; return; }
    }
    if (grid < 0) return;
    mk::Args a{};
    for (int i = 0; i < 18; ++i) a.in[i] = (const float*)d_in[i];
    a.out = (float*)d_out; a.ws = (unsigned char*)d_ws;
#if MK_BRINGUP == 0
    if (hipMemsetAsync((char*)d_ws + mk::WS_BAR, 0, mk::BAR_BYTES, stream) != hipSuccess) { fprintf(stderr, "kernel_launch: memset failed\n"); return; }
    a.ph_lo = 0; a.ph_hi = mk::N_PHASES;
    void* args[] = {&a};
    hipError_t e = hipLaunchCooperativeKernel((const void*)mk::mk_fwd, dim3(grid), dim3(mk::NWAVES * 64), args, mk::LDS_BYTES, stream);
    if (e != hipSuccess) fprintf(stderr, "cooperative launch failed: %s (grid %d)\n", hipGetErrorString(e), grid);
#else
    const int nph = MK_BRINGUP == 1 ? 3 : MK_BRINGUP == 2 ? 8 : mk::N_PHASES;
    for (int ph = 0; ph < nph; ++ph) { a.ph_lo = ph; a.ph_hi = ph + 1; hipLaunchKernelGGL(mk::mk_fwd, dim3(grid), dim3(mk::NWAVES * 64), mk::LDS_BYTES, stream, a); }
#if MK_BRINGUP == 1
    nv::part_mix(d_in, (float*)d_out, d_ws, stream); nv::part_ffn2_final(d_in, (float*)d_out, d_ws, stream);
#elif MK_BRINGUP == 2
    nv::part_ffn2_final(d_in, (float*)d_out, d_ws, stream);
#endif
#endif
}
```

```cpp
#define MK_BRINGUP 0
#include <hip/hip_runtime.h>
#include <cstdio>
#include <cstdint>
#include <cmath>
#include <hip/hip_cooperative_groups.h>
namespace cg = cooperative_groups;

namespace mkc {
constexpr int S = 16384, DM = 1024, DFF = 2816, NGU = 2 * DFF, NWIN = 2304;
constexpr float LOG2E = 1.4426950408889634f;
constexpr float C2Q = 0.10206207261596577f * LOG2E;
constexpr float C2M = 0.125f * LOG2E;
constexpr size_t MiB = 1u << 20;
constexpr size_t WS_PANEL = 4096 + 16384;
constexpr size_t WS_CNT = 0;
constexpr size_t WS_SS1 = 1 * MiB, WS_SS2 = WS_SS1 + 65536, WS_SSQ = WS_SS2 + 65536, WS_SSKV = WS_SSQ + 65536, WS_SS3 = WS_SSKV + 65536, WS_SS4 = WS_SS3 + 65536;
constexpr size_t WS_KMS = WS_SS1 + 512 * 1024;
constexpr size_t WS_SSDUMMY = WS_SS1 + 384 * 1024, WS_KMSDUMMY = WS_SS1 + 640 * 1024;
constexpr size_t WS_POSF = 2 * MiB, WS_COS = 3 * MiB, WS_SIN = 4 * MiB;
constexpr size_t WS_WGU1 = 6 * MiB, WS_WD1 = 17 * MiB, WS_WGU2 = WS_WD1 + 5632 * 1024, WS_WD2 = WS_WGU2 + 11 * MiB, WS_WIN = 39 * MiB, WS_WUQ = WS_WIN + 4608 * 1024, WS_WUKV = WS_WUQ + 768 * 1024, WS_WOUT = 45 * MiB;
constexpr size_t WS_XB = 48 * MiB, WS_CQKV = 80 * MiB, WS_PLSE = 112 * MiB;
constexpr size_t WS_ACT = 114 * MiB, WS_MQKV = 114 * MiB, WS_CAT = 114 * MiB, WS_Q = 162 * MiB, WS_KN = 186 * MiB, WS_V = 202 * MiB, WS_KR = 218 * MiB, WS_LIST = 220 * MiB, WS_END = 252 * MiB;
static_assert(WS_WD2 + 5632 * 1024 <= WS_WIN && WS_WUKV + 512 * 1024 <= WS_WOUT && WS_WOUT + 2 * MiB <= WS_XB, "weight map");
}
namespace pg8 {
#define PG8_LAS __attribute__((address_space(3)))
typedef unsigned short bf16_t;
typedef short bf16x8 __attribute__((ext_vector_type(8)));
typedef float f32x4 __attribute__((ext_vector_type(4)));
typedef unsigned u32x4 __attribute__((ext_vector_type(4)));
__device__ __forceinline__ int lane_id_v() { int l; asm volatile("v_mbcnt_lo_u32_b32 %0, -1, 0\n\tv_mbcnt_hi_u32_b32 %0, -1, %0" : "=v"(l)); return l; }
constexpr int BM = 256, BK = 64, HALF = 128, HTB = HALF * BK * 2  , STAGE_BYTES = 8 * HTB, NXCD = 8, WGM = 4;

__host__ __device__ __forceinline__ int lds_byte(int r, int c) { const int st = (r >> 4) * 2 + (c >> 5), rr = r & 15, cc = c & 31, ob = rr * 64 + cc * 2; return st * 1024 + (ob ^ (((ob >> 9) & 1) << 5)); }
__host__ __device__ __forceinline__ void stage_rc(int b, int& R, int& C) { const int st = b / 1024, sb = b % 1024, swz = sb ^ (((sb >> 9) & 1) << 5); R = (st >> 1) * 16 + swz / 64; C = (st & 1) * 32 + (swz % 64) / 2; }
__host__ __device__ __forceinline__ int perm32(int rho) { const int n = rho >> 4, i = rho & 15; return 8 * (i >> 2) + 4 * n + (i & 3); }

struct Unit { int pm, pn; };
struct Gemm { const bf16_t* A; const bf16_t* Bt; int M, N, K, lda; };

struct StaticOrder {
    int nM, nN, nwg, G, c;
    __host__ __device__ void init(int M, int N, int G_, int c_) { nM = M / BM; nN = N / BM; nwg = nM * nN; G = G_; c = c_; }
    __host__ __device__ bool next(int i, Unit& u) const {
        const long L = (long)i * G + c; if (L >= nwg) return false;
        int wgid = (int)L; { const int q = nwg / NXCD, r = nwg % NXCD, xcd = wgid % NXCD, off = wgid / NXCD; wgid = (xcd < r ? xcd * (q + 1) : r * (q + 1) + (xcd - r) * q) + off; }
        const int nig = WGM * nN, gid = wgid / nig, fm = gid * WGM, gsz = (nM - fm) < WGM ? (nM - fm) : WGM;
        u.pm = fm + ((wgid % nig) % gsz); u.pn = (wgid % nig) / gsz; return true;
    }
    __device__ __forceinline__ void a_ready(const Unit&) const {}
    __device__ __forceinline__ void done(const Unit&) const {}
};
struct TailOrder {
    int nM, pn, G, c;
    __host__ __device__ void init(int M, int pn_, int G_, int c_) { nM = M / BM; pn = pn_; G = G_; c = c_; }
    __host__ __device__ bool next(int i, Unit& u) const { const int j = c - (G - nM); if (i != 0 || j < 0 || j >= nM) return false; u.pm = j; u.pn = pn; return true; }
    __device__ __forceinline__ void a_ready(const Unit&) const {}
    __device__ __forceinline__ void done(const Unit&) const {}
};
__device__ __forceinline__ unsigned cvt_pk_bf16(float lo, float hi) { unsigned r; asm volatile("v_cvt_pk_bf16_f32 %0, %1, %2" : "=v"(r) : "v"(lo), "v"(hi)); return r; }
typedef unsigned u32x2 __attribute__((ext_vector_type(2)));
constexpr float RMS_EPS = 1e-6f;
__device__ __forceinline__ float rs_of(const float* ss, int row, float invn) { return __builtin_amdgcn_rsqf(ss[row] * invn + RMS_EPS); }
__device__ __forceinline__ float silu_f(float g) { return g * __builtin_amdgcn_rcpf(1.0f + __builtin_amdgcn_exp2f(-1.4426950408889634f * g)); }
__device__ __forceinline__ u32x4 pack8(const f32x4 a, const f32x4 b) { u32x4 w; w.x = cvt_pk_bf16(a[0], a[1]); w.y = cvt_pk_bf16(a[2], a[3]); w.z = cvt_pk_bf16(b[0], b[1]); w.w = cvt_pk_bf16(b[2], b[3]); return w; }

struct EpiSwiGLU {
    static constexpr bool PERM = true, AFTER_DRAIN = false;
    unsigned char* ws; int which;
    __device__ __forceinline__ void operator()(const f32x4 (&acc)[2][2][4][2], const Unit& u, int wr, int wc, int fr, int fq) const {
        bf16_t* O = (bf16_t*)(ws + mkc::WS_ACT); const int ldo = mkc::DFF; const float* ss = (const float*)(ws + (which ? mkc::WS_SS3 : mkc::WS_SS1)); const float invn = 1.0f / 1024.0f;
        const int row0 = u.pm * BM + wr * 64 + fr, col0 = u.pn * HALF + wc * 32 + 8 * fq;
#pragma unroll
        for (int ai = 0; ai < 2; ++ai)
#pragma unroll
            for (int m = 0; m < 4; ++m) { const int row = row0 + ai * HALF + m * 16; const float rs = rs_of(ss, row, invn);
                f32x4 a0, a1;
#pragma unroll
                for (int j = 0; j < 4; ++j) { a0[j] = silu_f(acc[ai][0][m][0][j] * rs) * (acc[ai][1][m][0][j] * rs); a1[j] = silu_f(acc[ai][0][m][1][j] * rs) * (acc[ai][1][m][1][j] * rs); }
                *(u32x4*)(O + (size_t)row * ldo + col0) = pack8(a0, a1); }
    }
};
__device__ __forceinline__ f32x4 bf4_to_f32(const u32x2 w) { f32x4 r; r[0] = __builtin_bit_cast(float, w.x << 16); r[1] = __builtin_bit_cast(float, w.x & 0xFFFF0000u); r[2] = __builtin_bit_cast(float, w.y << 16); r[3] = __builtin_bit_cast(float, w.y & 0xFFFF0000u); return r; }
struct EpiResid {
    static constexpr bool PERM = false, AFTER_DRAIN = false;
    float* out; unsigned char* ws; int ss_off; float alpha;
    __device__ __forceinline__ void operator()(const f32x4 (&acc)[2][2][4][2], const Unit& u, int wr, int wc, int fr, int fq) const {
        bf16_t* xb = (bf16_t*)(ws + mkc::WS_XB); float* ss_out = (float*)(ws + ss_off);
        const int row0 = u.pm * BM + wr * 64 + fr, col0 = u.pn * BM + wc * 32 + 4 * fq;
#pragma unroll
        for (int ai = 0; ai < 2; ++ai)
#pragma unroll
            for (int m = 0; m < 4; ++m) { const int row = row0 + ai * HALF + m * 16; const size_t off = (size_t)row * 1024 + col0; float s = 0.f;
#pragma unroll
                for (int bj = 0; bj < 2; ++bj)
#pragma unroll
                    for (int n = 0; n < 2; ++n) { const f32x4 b = bf4_to_f32(*(const u32x2*)(xb + off + bj * HALF + n * 16)); const f32x4 o = b + acc[ai][bj][m][n] * alpha;
                        if (out) *(f32x4*)(out + off + bj * HALF + n * 16) = o;
                        s += (o[0] * o[0] + o[1] * o[1]) + (o[2] * o[2] + o[3] * o[3]);
                        u32x2 w; w.x = cvt_pk_bf16(o[0], o[1]); w.y = cvt_pk_bf16(o[2], o[3]); *(u32x2*)(xb + off + bj * HALF + n * 16) = w; }
                s += __shfl_xor(s, 16); s += __shfl_xor(s, 32);
                if (fq == 0) atomicAdd(ss_out + row, s);
                asm volatile("" ::: "memory"); }
    }
};
struct EpiWin {
    static constexpr bool PERM = true, AFTER_DRAIN = false;
    unsigned char* ws; int dummy;
    __device__ __forceinline__ void operator()(const f32x4 (&acc)[2][2][4][2], const Unit& u, int wr, int wc, int fr, int fq) const {
        bf16_t* cqkv = (bf16_t*)(ws + mkc::WS_CQKV); bf16_t* mqkv = (bf16_t*)(ws + mkc::WS_MQKV); const float* ss_in = (const float*)(ws + mkc::WS_SS2);
        float* ssq = (float*)(ws + (dummy ? mkc::WS_SSDUMMY : mkc::WS_SSQ)); float* sskv = (float*)(ws + (dummy ? mkc::WS_SSDUMMY + 65536 : mkc::WS_SSKV)); float* kmsum = (float*)(ws + (dummy ? mkc::WS_KMSDUMMY : mkc::WS_KMS));
        const int row0 = u.pm * BM + wr * 64 + fr;
        const bool is_mk = (u.pn == 5 || u.pn == 6);
        f32x4 cs[2][2];
#pragma unroll
        for (int bj = 0; bj < 2; ++bj)
#pragma unroll
            for (int n = 0; n < 2; ++n) cs[bj][n] = (f32x4){0.f, 0.f, 0.f, 0.f};
#pragma unroll
        for (int ai = 0; ai < 2; ++ai)
#pragma unroll
            for (int m = 0; m < 4; ++m) { const int row = row0 + ai * HALF + m * 16; const float rs = rs_of(ss_in, row, 1.0f / 1024.0f);
#pragma unroll
                for (int bj = 0; bj < 2; ++bj) { const int colt = u.pn * BM + bj * HALF, col0 = colt + wc * 32 + 8 * fq;
                    const f32x4 v0 = acc[ai][bj][m][0] * rs, v1 = acc[ai][bj][m][1] * rs;
                    bf16_t* dst = (colt < 768) ? (cqkv + (size_t)row * 768 + col0) : (mqkv + (size_t)row * 1536 + (col0 - 768));
                    *(u32x4*)dst = pack8(v0, v1);
                    if (colt < 640) { float s = (v0[0] * v0[0] + v0[1] * v0[1]) + (v0[2] * v0[2] + v0[3] * v0[3]) + (v1[0] * v1[0] + v1[1] * v1[1]) + (v1[2] * v1[2] + v1[3] * v1[3]);
                        s += __shfl_xor(s, 16); s += __shfl_xor(s, 32);
                        if (fq == 0) atomicAdd((colt < 384 ? ssq : sskv) + row, s); }
                    if (is_mk) { cs[bj][0] += v0; cs[bj][1] += v1; } } }
        if (is_mk) {
#pragma unroll
            for (int bj = 0; bj < 2; ++bj)
#pragma unroll
                for (int n = 0; n < 2; ++n)
#pragma unroll
                    for (int j = 0; j < 4; ++j) { float s = cs[bj][n][j]; s += __shfl_xor(s, 1); s += __shfl_xor(s, 2); s += __shfl_xor(s, 4); s += __shfl_xor(s, 8);
                        if (fr == 0) atomicAdd(kmsum + (size_t)u.pm * 512 + (u.pn * BM + bj * HALF + wc * 32 + 8 * fq + 4 * n + j - 1280), s); }
        }
    }
};
struct EpiKV {
    static constexpr bool PERM = true, AFTER_DRAIN = false;
    unsigned char* ws;
    __device__ __forceinline__ void operator()(const f32x4 (&acc)[2][2][4][2], const Unit& u, int wr, int wc, int fr, int fq) const {
        bf16_t* Kn = (bf16_t*)(ws + mkc::WS_KN); bf16_t* V = (bf16_t*)(ws + mkc::WS_V); const float* ss = (const float*)(ws + mkc::WS_SSKV);
        const int row0 = u.pm * BM + wr * 64 + fr;
#pragma unroll
        for (int ai = 0; ai < 2; ++ai)
#pragma unroll
            for (int m = 0; m < 4; ++m) { const int row = row0 + ai * HALF + m * 16; const float rs = rs_of(ss, row, 1.0f / 256.0f);
#pragma unroll
                for (int bj = 0; bj < 2; ++bj) { const int colt = u.pn * BM + bj * HALF, col0 = colt + wc * 32 + 8 * fq;
                    bf16_t* dst = (colt < 512) ? (Kn + (size_t)row * 512 + col0) : (V + (size_t)row * 512 + (col0 - 512));
                    *(u32x4*)dst = pack8(acc[ai][bj][m][0] * rs, acc[ai][bj][m][1] * rs); } }
    }
};
struct EpiQ {
    static constexpr bool PERM = true, AFTER_DRAIN = false;
    unsigned char* ws;
    __device__ __forceinline__ void operator()(const f32x4 (&acc)[2][2][4][2], const Unit& u, int wr, int wc, int fr, int fq) const {
        bf16_t* Q = (bf16_t*)(ws + mkc::WS_Q); const float* ss = (const float*)(ws + mkc::WS_SSQ); const float* cosT = (const float*)(ws + mkc::WS_COS); const float* sinT = (const float*)(ws + mkc::WS_SIN);
        const int row0 = u.pm * BM + wr * 64 + fr;
#pragma unroll
        for (int ai = 0; ai < 2; ++ai)
#pragma unroll
            for (int m = 0; m < 4; ++m) { const int row = row0 + ai * HALF + m * 16; const float rs = rs_of(ss, row, 1.0f / 384.0f);
#pragma unroll
                for (int bj = 0; bj < 2; ++bj) { const int col0 = u.pn * BM + bj * HALF + wc * 32 + 8 * fq; const int d = col0 % 96;
                    f32x4 v0 = acc[ai][bj][m][0] * rs, v1 = acc[ai][bj][m][1] * rs;
                    if (d >= 64) { const int g = (d - 64) >> 3; const f32x4 c = *(const f32x4*)(cosT + (size_t)row * 16 + 4 * g), s = *(const f32x4*)(sinT + (size_t)row * 16 + 4 * g);
                        const f32x4 o0 = v0 * c - v1 * s, o1 = v0 * s + v1 * c; v0 = o0; v1 = o1; }
                    *(u32x4*)(Q + (size_t)row * 768 + col0) = pack8(v0, v1); }
                asm volatile("" ::: "memory"); }
    }
};
struct EpiResidNorm {
    static constexpr bool PERM = false, AFTER_DRAIN = true;
    float* out; unsigned char* ws; const float* gain; float alpha;
    __device__ __forceinline__ void fused(f32x4 (&acc)[2][2][4][2], const Unit& u, int wr, int wc, int fr, int fq, PG8_LAS unsigned char* lds, int wid, int lane) const {
        float* ss = (float*)(ws + mkc::WS_SS4); unsigned* pcnt = (unsigned*)(ws + mkc::WS_PANEL) + 64 * u.pm; const bf16_t* xb = (const bf16_t*)(ws + mkc::WS_XB);
        const int row0 = u.pm * BM + wr * 64 + fr, col0 = u.pn * BM + wc * 32 + 4 * fq;
#pragma unroll
        for (int ai = 0; ai < 2; ++ai)
#pragma unroll
            for (int m = 0; m < 4; ++m) { const int row = row0 + ai * HALF + m * 16; const size_t off = (size_t)row * 1024 + col0; float s = 0.f;
#pragma unroll
                for (int bj = 0; bj < 2; ++bj)
#pragma unroll
                    for (int n = 0; n < 2; ++n) { const f32x4 b = bf4_to_f32(*(const u32x2*)(xb + off + bj * HALF + n * 16)); const f32x4 o = b + acc[ai][bj][m][n] * alpha; acc[ai][bj][m][n] = o;
                        s += (o[0] * o[0] + o[1] * o[1]) + (o[2] * o[2] + o[3] * o[3]); }
                s += __shfl_xor(s, 16); s += __shfl_xor(s, 32);
                if (fq == 0) atomicAdd(ss + row, s);
                asm volatile("" : "+v"(acc[ai][0][m][0]), "+v"(acc[ai][0][m][1]), "+v"(acc[ai][1][m][0]), "+v"(acc[ai][1][m][1]));
                if (m & 1) asm volatile("" ::: "memory"); }
        asm volatile("s_waitcnt vmcnt(0)" ::: "memory"); __builtin_amdgcn_s_barrier(); asm volatile("" ::: "memory");
        if (wid == 0) {
            if (lane == 0) { __builtin_amdgcn_fence(__ATOMIC_RELEASE, "agent"); asm volatile("s_waitcnt vmcnt(0)" ::: "memory"); __hip_atomic_fetch_add(pcnt, 1u, __ATOMIC_RELAXED, __HIP_MEMORY_SCOPE_AGENT); }
            unsigned spins = 0;
            while ((unsigned)__builtin_amdgcn_readfirstlane(__hip_atomic_load(pcnt, __ATOMIC_RELAXED, __HIP_MEMORY_SCOPE_AGENT)) < 4u) { __builtin_amdgcn_s_sleep(2); if (++spins > (1u << 22)) break; }
            __builtin_amdgcn_fence(__ATOMIC_ACQUIRE, "agent");
        }
        asm volatile("s_waitcnt vmcnt(0) lgkmcnt(0)" ::: "memory"); __builtin_amdgcn_s_barrier(); asm volatile("" ::: "memory");
        f32x4 gv[2][2];
#pragma unroll
        for (int bj = 0; bj < 2; ++bj)
#pragma unroll
            for (int n = 0; n < 2; ++n) gv[bj][n] = *(const f32x4*)(gain + col0 + bj * HALF + n * 16);
#pragma unroll
        for (int ai = 0; ai < 2; ++ai)
#pragma unroll
            for (int m = 0; m < 4; ++m) { const int row = row0 + ai * HALF + m * 16; const size_t off = (size_t)row * 1024 + col0;
                const float tot = __hip_atomic_load(ss + row, __ATOMIC_RELAXED, __HIP_MEMORY_SCOPE_AGENT); const float rs = __builtin_amdgcn_rsqf(tot * (1.0f / 1024.0f) + RMS_EPS);
#pragma unroll
                for (int bj = 0; bj < 2; ++bj)
#pragma unroll
                    for (int n = 0; n < 2; ++n) *(f32x4*)(out + off + bj * HALF + n * 16) = acc[ai][bj][m][n] * rs * gv[bj][n]; }
    }
};

template <class Epi, class Sched, bool ALIGN_EPI = false, bool SP2 = false>
__device__ __forceinline__ void gemm_phase(PG8_LAS unsigned char* lds, const Gemm g, const Sched& S, const Epi& E, const int wid) {
    const int lane = lane_id_v(), tid = wid * 64 + lane, wr = wid >> 2, wc = wid & 3, fr = lane & 15, fq = lane >> 4;
    const int K = g.K, nt = K / BK, lda = g.lda;
    unsigned voffA[2], voffB[2];
#pragma unroll
    for (int i = 0; i < 2; ++i) { int R, C; stage_rc(tid * 16 + i * 8192, R, C); const int Rb = Epi::PERM ? ((R & ~31) + perm32(R & 31)) : R;
        voffA[i] = (unsigned)(R * lda + C) * 2u; voffB[i] = (unsigned)(Rb * K + C) * 2u; }
    const size_t kstep = (size_t)(BK * 2);
    const size_t hstep = (size_t)HALF * K * 2;
    const size_t tstep = 2 * hstep; const size_t hstepA = (size_t)HALF * lda * 2, tstepA = 2 * hstepA;
    const unsigned ldsw = (unsigned)wid * 1024u;
    const int aoff = lds_byte(wr * 64 + fr, fq * 8), boff = lds_byte(wc * 32 + fr, fq * 8);
#define PG8_SA(b, h) (((b) * 2 + (h)) * HTB)
#define PG8_SB(b, h) ((4 + (b) * 2 + (h)) * HTB)
#define PG8_STAGE(bufoff, gbase, voff) do { _Pragma("unroll") for (int _i = 0; _i < 2; ++_i) \
        __builtin_amdgcn_global_load_lds((const unsigned*)((const char*)(gbase) + (voff)[_i]), (PG8_LAS unsigned*)(lds + (bufoff) + ldsw + _i * 8192), 16, 0, 0); } while (0)
#define PG8_LDA(dst, b, h) do { _Pragma("unroll") for (int m = 0; m < 4; ++m) _Pragma("unroll") for (int k = 0; k < 2; ++k) dst[m][k] = *(const PG8_LAS bf16x8*)(lds + PG8_SA(b, h) + aoff + m * 2048 + k * 1024); } while (0)
#define PG8_LDB(dst, b, h) do { _Pragma("unroll") for (int n = 0; n < 2; ++n) _Pragma("unroll") for (int k = 0; k < 2; ++k) dst[n][k] = *(const PG8_LAS bf16x8*)(lds + PG8_SB(b, h) + boff + n * 2048 + k * 1024); } while (0)
#define PG8_MMA(ai, bj, At, Bt) do { __builtin_amdgcn_s_setprio(1); _Pragma("unroll") for (int m = 0; m < 4; ++m) _Pragma("unroll") for (int n = 0; n < 2; ++n) _Pragma("unroll") for (int k = 0; k < 2; ++k) \
        acc[ai][bj][m][n] = __builtin_amdgcn_mfma_f32_16x16x32_bf16(Bt[n][k], At[m][k], acc[ai][bj][m][n], 0, 0, 0); __builtin_amdgcn_s_setprio(0); } while (0)
#define PG8_WAIT_V(n) asm volatile("s_waitcnt vmcnt(" #n ")" ::: "memory")
#define PG8_WAIT_L(n) asm volatile("s_waitcnt lgkmcnt(" #n ")" ::: "memory")
#define PG8_BAR __builtin_amdgcn_s_barrier()
#define PG8_SCHED __builtin_amdgcn_sched_barrier(0)
    Unit cur, nxt; int ui = 0;
    if (!S.next(0, cur)) return;
    f32x4 acc[2][2][4][2];
#pragma unroll
    for (int a = 0; a < 2; ++a)
#pragma unroll
        for (int b = 0; b < 2; ++b)
#pragma unroll
            for (int m = 0; m < 4; ++m)
#pragma unroll
                for (int n = 0; n < 2; ++n) acc[a][b][m][n] = (f32x4){0.f, 0.f, 0.f, 0.f};
    bf16x8 At[4][2], B0[2][2], B1[2][2];
    const char* cA = (const char*)g.A + (size_t)cur.pm * tstepA; const char* cB = (const char*)g.Bt + (size_t)cur.pn * tstep;
    S.a_ready(cur);
    if constexpr (SP2) {
        PG8_STAGE(PG8_SB(0, 0), cB, voffB); PG8_STAGE(PG8_SB(0, 1), cB + hstep, voffB); PG8_STAGE(PG8_SA(0, 0), cA, voffA); PG8_STAGE(PG8_SA(0, 1), cA + hstepA, voffA);
        if (wr == 1) PG8_BAR;
        PG8_WAIT_V(2); PG8_BAR;
        PG8_STAGE(PG8_SB(1, 0), cB + kstep, voffB); PG8_STAGE(PG8_SA(1, 0), cA + kstep, voffA); PG8_STAGE(PG8_SB(1, 1), cB + hstep + kstep, voffB);
        PG8_WAIT_V(6); PG8_BAR;
    } else {
        PG8_STAGE(PG8_SB(0, 0), cB, voffB); PG8_STAGE(PG8_SA(0, 0), cA, voffA); PG8_STAGE(PG8_SB(0, 1), cB + hstep, voffB); PG8_STAGE(PG8_SA(0, 1), cA + hstepA, voffA);
        if (wr == 1) PG8_BAR;
        PG8_WAIT_V(4); PG8_BAR;
        PG8_STAGE(PG8_SB(1, 0), cB + kstep, voffB); PG8_STAGE(PG8_SA(1, 0), cA + kstep, voffA); PG8_STAGE(PG8_SB(1, 1), cB + hstep + kstep, voffB);
        PG8_WAIT_V(6); PG8_BAR;
    }
    for (;;) {
        const bool has_next = S.next(ui + 1, nxt);
        const char* nA = has_next ? (const char*)g.A + (size_t)nxt.pm * tstepA : cA; const char* nB = has_next ? (const char*)g.Bt + (size_t)nxt.pn * tstep : cB;
#pragma nounroll
        for (int t = 0; t < nt; t += 2) {
            const bool last = (t == nt - 2);
            const char* a1 = cA + (size_t)(t + 1) * kstep;
            const char* a2 = last ? nA : cA + (size_t)(t + 2) * kstep; const char* b2 = last ? nB : cB + (size_t)(t + 2) * kstep;
            const char* a3 = a2 + kstep; const char* b3 = b2 + kstep;
            if (last && has_next) S.a_ready(nxt);
            if constexpr (SP2) {
            PG8_LDB(B0, 0, 0); PG8_LDB(B1, 0, 1); PG8_SCHED; PG8_LDA(At, 0, 0); PG8_STAGE(PG8_SA(1, 1), a1 + hstepA, voffA);
            PG8_WAIT_V(8); PG8_WAIT_L(0); PG8_BAR; PG8_MMA(0, 0, At, B0); PG8_MMA(0, 1, At, B1); PG8_BAR; PG8_SCHED;
            PG8_LDA(At, 0, 1); PG8_STAGE(PG8_SB(0, 0), b2, voffB); PG8_STAGE(PG8_SB(0, 1), b2 + hstep, voffB); PG8_STAGE(PG8_SA(0, 0), a2, voffA);
            PG8_WAIT_V(8); PG8_WAIT_L(0); PG8_BAR; PG8_MMA(1, 0, At, B0); PG8_MMA(1, 1, At, B1); PG8_BAR; PG8_SCHED;
            PG8_LDB(B0, 1, 0); PG8_LDB(B1, 1, 1); PG8_SCHED; PG8_LDA(At, 1, 0); PG8_STAGE(PG8_SA(0, 1), a2 + hstepA, voffA);
            PG8_WAIT_V(8); PG8_WAIT_L(0); PG8_BAR; PG8_MMA(0, 0, At, B0); PG8_MMA(0, 1, At, B1); PG8_BAR; PG8_SCHED;
            PG8_LDA(At, 1, 1); PG8_STAGE(PG8_SB(1, 0), b3, voffB); PG8_STAGE(PG8_SB(1, 1), b3 + hstep, voffB); PG8_STAGE(PG8_SA(1, 0), a3, voffA);
            PG8_WAIT_V(8); PG8_WAIT_L(0); PG8_BAR; PG8_MMA(1, 0, At, B0); PG8_MMA(1, 1, At, B1); PG8_BAR; PG8_SCHED;
            } else {
            PG8_LDB(B0, 0, 0); PG8_SCHED; PG8_LDA(At, 0, 0); PG8_STAGE(PG8_SA(1, 1), a1 + hstepA, voffA);
            PG8_WAIT_L(8); PG8_BAR; PG8_WAIT_L(0); PG8_MMA(0, 0, At, B0); PG8_BAR; PG8_SCHED;
            PG8_LDB(B1, 0, 1); PG8_STAGE(PG8_SB(0, 0), b2, voffB);
            PG8_BAR; PG8_WAIT_L(0); PG8_MMA(0, 1, At, B1); PG8_BAR;
            PG8_LDA(At, 0, 1); PG8_STAGE(PG8_SA(0, 0), a2, voffA);
            PG8_BAR; PG8_WAIT_L(0); PG8_MMA(1, 0, At, B0); PG8_BAR; PG8_SCHED;
            PG8_STAGE(PG8_SB(0, 1), b2 + hstep, voffB);
            PG8_WAIT_V(6); PG8_BAR; PG8_MMA(1, 1, At, B1); PG8_BAR;
            PG8_LDB(B0, 1, 0); PG8_SCHED; PG8_LDA(At, 1, 0); PG8_STAGE(PG8_SA(0, 1), a2 + hstepA, voffA);
            PG8_WAIT_L(8); PG8_BAR; PG8_WAIT_L(0); PG8_MMA(0, 0, At, B0); PG8_BAR; PG8_SCHED;
            PG8_LDB(B1, 1, 1); PG8_STAGE(PG8_SB(1, 0), b3, voffB);
            PG8_BAR; PG8_WAIT_L(0); PG8_MMA(0, 1, At, B1); PG8_BAR;
            PG8_LDA(At, 1, 1); PG8_STAGE(PG8_SA(1, 0), a3, voffA);
            PG8_BAR; PG8_WAIT_L(0); PG8_MMA(1, 0, At, B0); PG8_BAR; PG8_SCHED;
            PG8_STAGE(PG8_SB(1, 1), b3 + hstep, voffB);
            PG8_WAIT_V(6); PG8_BAR; PG8_MMA(1, 1, At, B1); PG8_BAR;
            }
        }
        if constexpr (ALIGN_EPI) { if (wr == 0) PG8_BAR; }
        if constexpr (!Epi::AFTER_DRAIN) { E(acc, cur, wr, wc, fr, fq); S.done(cur); }
        if (!has_next) break;
#pragma unroll
        for (int a = 0; a < 2; ++a)
#pragma unroll
            for (int b = 0; b < 2; ++b)
#pragma unroll
                for (int m = 0; m < 4; ++m)
#pragma unroll
                    for (int n = 0; n < 2; ++n) acc[a][b][m][n] = (f32x4){0.f, 0.f, 0.f, 0.f};
        cur = nxt; cA = nA; cB = nB; ++ui;
        if constexpr (ALIGN_EPI) { if (wr == 1) PG8_BAR; }
    }
    PG8_WAIT_V(0);
    if constexpr (!ALIGN_EPI) { if (wr == 0) PG8_BAR; }
    PG8_BAR;
    if constexpr (Epi::AFTER_DRAIN) { E.fused(acc, cur, wr, wc, fr, fq, lds, wid, lane); S.done(cur); }
#undef PG8_SA
#undef PG8_SB
#undef PG8_STAGE
#undef PG8_LDA
#undef PG8_LDB
#undef PG8_MMA
#undef PG8_WAIT_V
#undef PG8_WAIT_L
#undef PG8_BAR
#undef PG8_SCHED
}
}
namespace att {
typedef unsigned short bf16_t;
using bf16x8 = __attribute__((ext_vector_type(8))) short;
using s16x4 = __attribute__((ext_vector_type(4))) short;
using f32x16 = __attribute__((ext_vector_type(16))) float;
using f32x4 = __attribute__((ext_vector_type(4))) float;
using u32x4 = __attribute__((ext_vector_type(4))) unsigned;
typedef short v4i16_t __attribute__((ext_vector_type(4)));
#define ATT_LAS __attribute__((address_space(3)))
typedef ATT_LAS const char* lds_cptr;
constexpr int NW = 8, KVBLK = 64;
constexpr int KSLOT = 12288, VSLOT = 8192, NSLOT = 4;
constexpr int LDS_K = 0, LDS_V = NSLOT * KSLOT, LDS_WS = LDS_V + NSLOT * VSLOT, LDS_OST = LDS_WS + NW * 64 * 4, LDS_POSK = LDS_OST + NW * 4096, LDS_BYTES = LDS_POSK + 1024;
__device__ __forceinline__ int crow(int r, int hi) { return (r & 3) + 8 * (r >> 2) + 4 * hi; }
__device__ __forceinline__ void glds16(const void* gsrc, unsigned lds_dst) { unsigned keep;
    asm volatile("s_mov_b32 %0, m0\n\ts_mov_b32 m0, %2\n\ts_nop 0\n\tglobal_load_lds_dwordx4 %1, off\n\ts_mov_b32 m0, %0" : "=&s"(keep) : "v"(gsrc), "s"(lds_dst) : "memory"); }
typedef float f32x2_t __attribute__((ext_vector_type(2))); typedef __bf16 bf16x2_t __attribute__((ext_vector_type(2)));
__device__ __forceinline__ unsigned cvtpk(float lo, float hi) { f32x2_t v = {lo, hi}; bf16x2_t b = __builtin_convertvector(v, bf16x2_t); return __builtin_bit_cast(unsigned, b); }
__device__ __forceinline__ float att_bf16_up(float x) { unsigned u = __float_as_uint(x); if (u & 0xFFFFu) { u &= 0xFFFF0000u; if (x > 0.f) u += 0x10000u; } return __uint_as_float(u); }
__device__ __forceinline__ s16x4 vtr(lds_cptr p) { return __builtin_bit_cast(s16x4, __builtin_amdgcn_ds_read_tr16_b64_v4i16((ATT_LAS v4i16_t*)p)); }
#define ATT_KS(j) (((j) & (NSLOT - 1)) * KSLOT)
#define ATT_VS(j) (((j) & (NSLOT - 1)) * VSLOT)
#define ATT_WAIT_BAR() asm volatile("s_waitcnt vmcnt(0) lgkmcnt(0)\n\ts_barrier" ::: "memory")
#define ATT_WAIT_BAR_N(three) do { if (three) asm volatile("s_waitcnt vmcnt(3) lgkmcnt(0)\n\ts_barrier" ::: "memory"); else asm volatile("s_waitcnt vmcnt(2) lgkmcnt(0)\n\ts_barrier" ::: "memory"); } while (0)

struct Unit {
    const bf16_t* Q; int q_pitch;
    const bf16_t* K; int k_pitch;
    const bf16_t* Kr;
    const bf16_t* V; int v_pitch;
    int key0, ntiles;
    int q0;
    const unsigned short* list; int len;
    const float* posf;
    float slope2;
    bf16_t* O; int o_pitch;
    bf16_t* part; float* plse; int h;
};

template <int MODE> __device__ __forceinline__ void unit(const Unit& U, char* shm, const int wid) {
    constexpr int DQK = (MODE == 0) ? 96 : 64, ND0 = DQK / 16;
    const int lane = pg8::lane_id_v(), tid = wid * 64 + lane, r32 = lane & 31, hi = lane >> 5;
    const unsigned lds0 = (unsigned)(uintptr_t)shm;
    const lds_cptr shm3 = (lds_cptr)shm;
    ATT_LAS float* wsf = (ATT_LAS float*)(shm3 + LDS_WS) + wid * 64;
    int qrow, slot = 0; bool valid = true;
    if (MODE == 2) { const int e = wid * 32 + r32; valid = e < U.len; const unsigned ent = valid ? (unsigned)U.list[e] : (unsigned)U.list[0]; qrow = (int)(ent & 0x3FFFu); slot = 1 + (int)(ent >> 14); }
    else qrow = U.q0 + wid * 32 + r32;
    const unsigned koff = (unsigned)((U.key0 + 8 * wid + (lane >> 3)) * U.k_pitch + (((lane & 7) ^ ((4 * wid + (lane >> 4)) & 7)) * 8)) * 2u;
    const unsigned kroff = (MODE == 0) ? (unsigned)((U.key0 + 16 * (wid & 3) + (lane >> 2)) * 32 + (((lane & 3) ^ ((lane >> 4) & 3)) * 8)) * 2u : 0u;
    const unsigned voff = (unsigned)((U.key0 + 16 * (wid & 3) + (lane >> 2)) * U.v_pitch + (wid >> 2) * 32 + (lane & 3) * 8) * 2u;
#define ATT_DMA(t, ks, vs) do { glds16((const char*)U.K + koff + (size_t)(t) * (KVBLK * 2) * U.k_pitch, (unsigned)(lds0 + LDS_K + wid * 1024 + (ks))); \
        if (MODE == 0 && wid < 4) glds16((const char*)U.Kr + kroff + (size_t)(t) * (KVBLK * 64), (unsigned)(lds0 + LDS_K + (8 + (wid & 3)) * 1024 + (ks))); \
        glds16((const char*)U.V + voff + (size_t)(t) * (KVBLK * 2) * U.v_pitch, (unsigned)(lds0 + LDS_V + wid * 1024 + (vs))); } while (0)
    const int NT = U.ntiles;
    ATT_DMA(0, 0, 0);
    if (NT > 1) ATT_DMA(1, KSLOT, VSLOT);
    bf16x8 qr[ND0];
    { const bf16_t* Qw = U.Q + (size_t)qrow * U.q_pitch + hi * 8;
#pragma unroll
      for (int d0 = 0; d0 < ND0; ++d0) qr[d0] = *reinterpret_cast<const bf16x8*>(Qw + d0 * 16); }
    float pq = 0.f;
    if (MODE != 0) { pq = U.posf[qrow]; if (tid < 256) ((ATT_LAS float*)(shm3 + LDS_POSK))[tid] = U.posf[U.key0 + tid]; }
    float mhat = -1e30f, l_reg = 0.f; f32x16 o[2]; o[0] = f32x16{}; o[1] = f32x16{};
    const int km_ = (r32 >> 1) & 7, kmr_ = (r32 >> 2) & 3;
    const int ka0 = LDS_K + r32 * 128 + 32 * (km_ >> 1) + 16 * (hi ^ (km_ & 1));
    const int kb0 = LDS_K + 8192 + r32 * 64 + 32 * (kmr_ >> 1) + 16 * (hi ^ (kmr_ & 1));
#define ATT_KADDR(d0, half, KS) (shm3 + (KS) + (((d0) < 4) ? ((ka0 ^ ((d0) << 5)) + (half) * 4096) : ((kb0 ^ (((d0) - 4) << 5)) + (half) * 2048)))
    const lds_cptr vp0 = shm3 + LDS_V + ((lane >> 4) & 1) * 32 + (lane & 3) * 8 + (4 * hi + ((lane & 15) >> 2)) * 64;
#define ATT_QKT(P0, P1, KS) do { P0 = f32x16{}; P1 = f32x16{}; bf16x8 kk_[2 * ND0]; \
        _Pragma("unroll") for (int d0 = 0; d0 < ND0; ++d0) { kk_[2 * d0] = *(const ATT_LAS bf16x8*)ATT_KADDR(d0, 0, KS); kk_[2 * d0 + 1] = *(const ATT_LAS bf16x8*)ATT_KADDR(d0, 1, KS); }     \
        __builtin_amdgcn_sched_barrier(0); \
        _Pragma("unroll") for (int d0 = 0; d0 < ND0; ++d0) { \
            P0 = __builtin_amdgcn_mfma_f32_32x32x16_bf16(kk_[2 * d0], qr[d0], P0, 0, 0, 0); P1 = __builtin_amdgcn_mfma_f32_32x32x16_bf16(kk_[2 * d0 + 1], qr[d0], P1, 0, 0, 0); } } while (0)
#define ATT_SMPV(P0, P1, T, VS) do { \
        if (MODE != 0) { const ATT_LAS float* pk_ = (const ATT_LAS float*)(shm3 + LDS_POSK) + 64 * (T) + 4 * hi; \
            _Pragma("unroll") for (int g = 0; g < 4; ++g) { const f32x4 a_ = *(const ATT_LAS f32x4*)(pk_ + 8 * g), b_ = *(const ATT_LAS f32x4*)(pk_ + 8 * g + 32); \
                _Pragma("unroll") for (int j = 0; j < 4; ++j) { P0[4 * g + j] -= U.slope2 * __builtin_fabsf(pq - a_[j]); P1[4 * g + j] -= U.slope2 * __builtin_fabsf(pq - b_[j]); } } } \
        if (MODE == 0 || MODE == 1) { const int kb_ = U.key0 + 64 * (T); \
            if (kb_ + 63 > U.q0 + wid * 32) { const int dq_ = qrow - kb_ - 4 * hi; \
                _Pragma("unroll") for (int r = 0; r < 16; ++r) { const int c_ = (r & 3) + 8 * (r >> 2); if (c_ > dq_) P0[r] = -INFINITY; if (c_ + 32 > dq_) P1[r] = -INFINITY; } } } \
        float rm_ = P0[0]; \
        _Pragma("unroll") for (int r = 1; r < 16; ++r) rm_ = fmaxf(rm_, P0[r]); \
        _Pragma("unroll") for (int r = 0; r < 16; ++r) rm_ = fmaxf(rm_, P1[r]); \
        { auto rr_ = __builtin_amdgcn_permlane32_swap(__float_as_uint(rm_), __float_as_uint(rm_), false, false); rm_ = fmaxf(__uint_as_float(rr_[0]), __uint_as_float(rr_[1])); } \
        if (__any(rm_ > mhat + 10.0f)) { const float mn_ = fmaxf(mhat, rm_), f_ = __builtin_amdgcn_exp2f(mhat - mn_); mhat = mn_; l_reg *= f_; \
            _Pragma("unroll") for (int r = 0; r < 16; ++r) { o[0][r] *= f_; o[1][r] *= f_; } }                        \
        float sacc_ = 0.f; \
        _Pragma("unroll") for (int r = 0; r < 16; ++r) { P0[r] = __builtin_amdgcn_exp2f(P0[r] - mhat); P1[r] = __builtin_amdgcn_exp2f(P1[r] - mhat); sacc_ += P0[r] + P1[r]; } \
        l_reg += sacc_; \
        u32x4 pw_[4]; \
        _Pragma("unroll") for (int s_ = 0; s_ < 2; ++s_) { \
            pw_[s_] = (u32x4){cvtpk(P0[8 * s_], P0[8 * s_ + 1]), cvtpk(P0[8 * s_ + 2], P0[8 * s_ + 3]), cvtpk(P0[8 * s_ + 4], P0[8 * s_ + 5]), cvtpk(P0[8 * s_ + 6], P0[8 * s_ + 7])}; \
            pw_[2 + s_] = (u32x4){cvtpk(P1[8 * s_], P1[8 * s_ + 1]), cvtpk(P1[8 * s_ + 2], P1[8 * s_ + 3]), cvtpk(P1[8 * s_ + 4], P1[8 * s_ + 5]), cvtpk(P1[8 * s_ + 6], P1[8 * s_ + 7])}; } \
        const lds_cptr vp_ = vp0 + (VS); s16x4 vl_[8], vh_[8]; \
        _Pragma("unroll") for (int i_ = 0; i_ < 8; ++i_) { vl_[i_] = vtr(vp_ + (i_ >> 2) * 4096 + (i_ & 3) * 1024); vh_[i_] = vtr(vp_ + (i_ >> 2) * 4096 + (i_ & 3) * 1024 + 512); }     \
        __builtin_amdgcn_sched_barrier(0); \
        _Pragma("unroll") for (int i_ = 0; i_ < 8; ++i_) { \
            const bf16x8 vf_ = (bf16x8){vl_[i_][0], vl_[i_][1], vl_[i_][2], vl_[i_][3], vh_[i_][0], vh_[i_][1], vh_[i_][2], vh_[i_][3]}; \
            o[i_ >> 2] = __builtin_amdgcn_mfma_f32_32x32x16_bf16(vf_, __builtin_bit_cast(bf16x8, pw_[i_ & 3]), o[i_ >> 2], 0, 0, 0); } } while (0)
#define ATT_ACT(T) (MODE != 1 || (64 * (T) <= wid * 32 + 31))
#define ATT_ITER(SC0, SC1, SN0, SN1, T) do { const bool has_next_ = (T) + 1 < NT; \
        if (has_next_ && ATT_ACT((T) + 1)) ATT_QKT(SN0, SN1, ATT_KS((T) + 1)); \
        if (ATT_ACT(T)) ATT_SMPV(SC0, SC1, T, ATT_VS(T)); \
        if (has_next_ && (MODE == 0 || NT > NSLOT)) { if ((T) + 3 < NT) ATT_WAIT_BAR_N(dma3); else ATT_WAIT_BAR(); if ((T) + 4 < NT) ATT_DMA((T) + 4, ATT_KS(T), ATT_VS(T)); }   \
        } while (0)
    const bool dma3 = (MODE == 0) && wid < 4;
    if (NT > 2) ATT_DMA(2, 2 * KSLOT, 2 * VSLOT);
    if (NT > 3) ATT_DMA(3, 3 * KSLOT, 3 * VSLOT);
    if (MODE == 0 && NT > 3) ATT_WAIT_BAR_N(dma3); else ATT_WAIT_BAR();
    f32x16 pA0, pA1, pB0, pB1;
    ATT_QKT(pA0, pA1, 0);
    int t = 0;
    if (MODE == 0 && NT > 4) {
#define ATT_SB() __builtin_amdgcn_sched_barrier(0)
#define ATT_KLD(i, KS) kf[i] = *(const ATT_LAS bf16x8*)ATT_KADDR((i) >> 1, (i) & 1, KS)
#define ATT_VLD(i, VS) do { vlo[i] = vtr(vp0 + (VS) + ((i) >> 2) * 4096 + ((i) & 3) * 1024); vhi[i] = vtr(vp0 + (VS) + ((i) >> 2) * 4096 + ((i) & 3) * 1024 + 512); } while (0)
#define ATT_SCR(SC0, SC1, j) ((j) < 16 ? SC0[(j) & 15] : SC1[(j) & 15])
#define ATT_EXP4(SC0, SC1, g) do { if ((g) < 4) { _Pragma("unroll") for (int j_ = 0; j_ < 4; ++j_) SC0[4 * (g) + j_] = __builtin_amdgcn_exp2f(SC0[4 * (g) + j_]); } \
                                   else { _Pragma("unroll") for (int j_ = 0; j_ < 4; ++j_) SC1[4 * ((g) - 4) + j_] = __builtin_amdgcn_exp2f(SC1[4 * ((g) - 4) + j_]); } } while (0)
#define ATT_ADD4(SC0, SC1, g) do { if ((g) < 4) sacc_ += (SC0[4 * (g)] + SC0[4 * (g) + 1]) + (SC0[4 * (g) + 2] + SC0[4 * (g) + 3]); else sacc_ += (SC1[4 * ((g) - 4)] + SC1[4 * ((g) - 4) + 1]) + (SC1[4 * ((g) - 4) + 2] + SC1[4 * ((g) - 4) + 3]); } while (0)
#define ATT_CVT4(SC0, SC1, g) do { if ((g) < 4) { pw[(g) >> 1][2 * ((g) & 1)] = cvtpk(SC0[4 * (g)], SC0[4 * (g) + 1]); pw[(g) >> 1][2 * ((g) & 1) + 1] = cvtpk(SC0[4 * (g) + 2], SC0[4 * (g) + 3]); } \
                                   else { pw[(g) >> 1][2 * ((g) & 1)] = cvtpk(SC1[4 * ((g) - 4)], SC1[4 * ((g) - 4) + 1]); pw[(g) >> 1][2 * ((g) & 1) + 1] = cvtpk(SC1[4 * ((g) - 4) + 2], SC1[4 * ((g) - 4) + 3]); } } while (0)
#define ATT_GAPA(i, SC0, SC1, SN0, SN1) do { \
        if (((i) & 1) == 0) SN0 = __builtin_amdgcn_mfma_f32_32x32x16_bf16(kf[i], qr[(i) >> 1], SN0, 0, 0, 0); else SN1 = __builtin_amdgcn_mfma_f32_32x32x16_bf16(kf[i], qr[(i) >> 1], SN1, 0, 0, 0); \
        if ((i) < 8) { ATT_VLD(ATT_PJ(i), vs_); ATT_EXP4(SC0, SC1, i); } \
        if ((i) >= 1 && (i) <= 8) ATT_ADD4(SC0, SC1, (i) - 1); \
        if ((i) >= 2 && (i) <= 9) ATT_CVT4(SC0, SC1, (i) - 2); \
        ATT_SB(); } while (0)
#define ATT_PJ(j) ((((j) & 1) << 2) | ((j) >> 1))
#define ATT_VF(j) (bf16x8){vlo[j][0], vlo[j][1], vlo[j][2], vlo[j][3], vhi[j][0], vhi[j][1], vhi[j][2], vhi[j][3]}
#define ATT_GAPB(j, SN0, SN1) do { \
        o[ATT_PJ(j) >> 2] = __builtin_amdgcn_mfma_f32_32x32x16_bf16(ATT_VF(ATT_PJ(j)), __builtin_bit_cast(bf16x8, pw[ATT_PJ(j) & 3]), o[ATT_PJ(j) >> 2], 0, 0, 0);     \
        if ((j) < 6) { ATT_KLD(2 * (j), ks2_); ATT_KLD(2 * (j) + 1, ks2_); } \
        if ((j) >= 2 && (j) < 6) { const int b_ = 4 * ((j) - 2); ma_ = fmaxf(fmaxf(ma_, SN0[b_]), SN0[b_ + 1]); mb_ = fmaxf(fmaxf(mb_, SN0[b_ + 2]), SN0[b_ + 3]); ma_ = fmaxf(fmaxf(ma_, SN1[b_]), SN1[b_ + 1]); mb_ = fmaxf(fmaxf(mb_, SN1[b_ + 2]), SN1[b_ + 3]); } \
        ATT_SB(); } while (0)
#define ATT_FAST(SC0, SC1, SN0, SN1, T) do { const int vs_ = ATT_VS(T), ks2_ = ATT_KS((T) + 2); \
        { const unsigned long long bal_ = __builtin_amdgcn_ballot_w64(rm > 10.0f); float f_ = 1.f; \
          if (bal_ != 0ull) { const float mn_ = att_bf16_up(mhat + fmaxf(rm, 0.f)), dl_ = mn_ - mhat; f_ = __builtin_amdgcn_exp2f(-dl_); mhat = mn_; l_reg *= f_; \
            _Pragma("unroll") for (int r = 0; r < 16; ++r) { SC0[r] -= dl_; SC1[r] -= dl_; } \
            qx[0] = (hi == 0) ? (short)(__float_as_uint(-mhat) >> 16) : (short)0; } \
            \
          _Pragma("unroll") for (int g_ = 0; g_ < 4; ++g_) { const int d_ = g_ >> 1, b_ = 8 * (g_ & 1); \
            asm volatile("s_cmp_eq_u64 %[b], 0\n\ts_cbranch_scc1 .Lsk%=\n\tv_mul_f32_e32 %0, %[f], %0\n\tv_mul_f32_e32 %1, %[f], %1\n\tv_mul_f32_e32 %2, %[f], %2\n\tv_mul_f32_e32 %3, %[f], %3\n\t" \
                         "v_mul_f32_e32 %4, %[f], %4\n\tv_mul_f32_e32 %5, %[f], %5\n\tv_mul_f32_e32 %6, %[f], %6\n\tv_mul_f32_e32 %7, %[f], %7\n.Lsk%=:" \
                         : "+v"(o[d_][b_]), "+v"(o[d_][b_ + 1]), "+v"(o[d_][b_ + 2]), "+v"(o[d_][b_ + 3]), "+v"(o[d_][b_ + 4]), "+v"(o[d_][b_ + 5]), "+v"(o[d_][b_ + 6]), "+v"(o[d_][b_ + 7]) \
                         : [f] "v"(f_), [b] "s"(bal_) : "scc"); } } \
        ATT_SB(); \
        float sacc_ = 0.f; \
        SN0 = __builtin_amdgcn_mfma_f32_32x32x16_bf16(kx, qx, f32x16{}, 0, 0, 0); SN1 = __builtin_amdgcn_mfma_f32_32x32x16_bf16(kx, qx, f32x16{}, 0, 0, 0);     \
        ATT_GAPA(0, SC0, SC1, SN0, SN1); ATT_GAPA(1, SC0, SC1, SN0, SN1); ATT_GAPA(2, SC0, SC1, SN0, SN1); ATT_GAPA(3, SC0, SC1, SN0, SN1); \
        ATT_GAPA(4, SC0, SC1, SN0, SN1); ATT_GAPA(5, SC0, SC1, SN0, SN1); ATT_GAPA(6, SC0, SC1, SN0, SN1); ATT_GAPA(7, SC0, SC1, SN0, SN1); \
        ATT_GAPA(8, SC0, SC1, SN0, SN1); ATT_GAPA(9, SC0, SC1, SN0, SN1); ATT_GAPA(10, SC0, SC1, SN0, SN1); ATT_GAPA(11, SC0, SC1, SN0, SN1); \
        l_reg += sacc_; \
        float ma_ = -INFINITY, mb_ = -INFINITY; \
        ATT_GAPB(0, SN0, SN1); ATT_GAPB(1, SN0, SN1); ATT_GAPB(2, SN0, SN1); ATT_GAPB(3, SN0, SN1); ATT_GAPB(4, SN0, SN1); ATT_GAPB(5, SN0, SN1); ATT_GAPB(6, SN0, SN1); ATT_GAPB(7, SN0, SN1); \
        rm = fmaxf(ma_, mb_); \
        { auto rr_ = __builtin_amdgcn_permlane32_swap(__float_as_uint(rm), __float_as_uint(rm), false, false); rm = fmaxf(__uint_as_float(rr_[0]), __uint_as_float(rr_[1])); } \
        ATT_SB(); \
        ATT_WAIT_BAR(); ATT_DMA((T) + 4, ATT_KS(T), vs_); } while (0)
        bf16x8 kf[12]; s16x4 vlo[8], vhi[8]; u32x4 pw[4];
        float rm = pA0[0];
#pragma unroll
        for (int r = 1; r < 16; ++r) rm = fmaxf(rm, pA0[r]);
#pragma unroll
        for (int r = 0; r < 16; ++r) rm = fmaxf(rm, pA1[r]);
        { auto rr_ = __builtin_amdgcn_permlane32_swap(__float_as_uint(rm), __float_as_uint(rm), false, false); rm = fmaxf(__uint_as_float(rr_[0]), __uint_as_float(rr_[1])); }
        mhat = att_bf16_up(rm);
#pragma unroll
        for (int r = 0; r < 16; ++r) { pA0[r] -= mhat; pA1[r] -= mhat; }
        rm -= mhat;
        const bf16x8 kx = (bf16x8){(short)0x3F80, 0, 0, 0, 0, 0, 0, 0};
        bf16x8 qx = (bf16x8){0, 0, 0, 0, 0, 0, 0, 0};
        if (hi == 0) qx[0] = (short)(__float_as_uint(-mhat) >> 16);
#pragma unroll
        for (int i = 0; i < 12; ++i) ATT_KLD(i, KSLOT);
        if (wid >= 4) __builtin_amdgcn_s_setprio(1);
        for (; t + 4 < NT; t += 2) { ATT_FAST(pA0, pA1, pB0, pB1, t); ATT_FAST(pB0, pB1, pA0, pA1, t + 1); }
        if (wid >= 4) __builtin_amdgcn_s_setprio(0);
#pragma unroll
        for (int r = 0; r < 16; ++r) { pA0[r] += mhat; pA1[r] += mhat; }
#undef ATT_FAST
#undef ATT_GAPA
#undef ATT_GAPB
#undef ATT_VF
#undef ATT_PJ
#undef ATT_EXP4
#undef ATT_ADD4
#undef ATT_CVT4
#undef ATT_SCR
#undef ATT_KLD
#undef ATT_VLD
#undef ATT_SB
    }
    for (; t < NT; t += 2) {
        ATT_ITER(pA0, pA1, pB0, pB1, t);
        if (t + 1 < NT) ATT_ITER(pB0, pB1, pA0, pA1, t + 1);
    }
#undef ATT_QKT
#undef ATT_SMPV
#undef ATT_ACT
#undef ATT_ITER
    { auto rr = __builtin_amdgcn_permlane32_swap(__float_as_uint(l_reg), __float_as_uint(l_reg), false, false); l_reg = __uint_as_float(rr[0]) + __uint_as_float(rr[1]); }
    { const float rl = __builtin_amdgcn_rcpf(l_reg);
      bf16_t* prow = U.O + (size_t)(U.q0 + wid * 32 + r32) * U.o_pitch + 8 * hi;
#pragma unroll
      for (int dh = 0; dh < 2; ++dh)
#pragma unroll
        for (int jp = 0; jp < 2; ++jp) {
            unsigned a0 = cvtpk(o[dh][8 * jp] * rl, o[dh][8 * jp + 1] * rl), a1 = cvtpk(o[dh][8 * jp + 2] * rl, o[dh][8 * jp + 3] * rl);
            unsigned b0 = cvtpk(o[dh][8 * jp + 4] * rl, o[dh][8 * jp + 5] * rl), b1 = cvtpk(o[dh][8 * jp + 6] * rl, o[dh][8 * jp + 7] * rl);
            const auto s0 = __builtin_amdgcn_permlane32_swap(a0, b0, false, false); const auto s1 = __builtin_amdgcn_permlane32_swap(a1, b1, false, false);
            *(u32x4*)(prow + 32 * dh + 16 * jp) = (u32x4){s0[0], s1[0], s0[1], s1[1]}; } }
    asm volatile("s_waitcnt vmcnt(0) lgkmcnt(0)\n\ts_barrier" ::: "memory");
#undef ATT_DMA
}
}

namespace att {
constexpr int MB_REG = 65536, MB_TILE = 16384, MB_V = 8192, MB_POSK = 131072, MB_PRE = MB_POSK + 3072, MB_UT = MB_PRE + 2048, MB_NUT = 62, MB_TM = MB_UT + 1024, MB_KB = 140288, MB_ENT = MB_KB + 8192, MB_END = MB_ENT + 2048;
struct MobaCtx { const bf16_t* mqkv; const float* posf; bf16_t* part; float* plse; const unsigned* lists; const unsigned* cnt; int total, vcu, G; };
struct MobaDesc { int own, h, n; };
__device__ __forceinline__ unsigned att_bf16_rne(float f) { unsigned u = __float_as_uint(f); return (u + 0x7fffu + ((u >> 16) & 1u)) >> 16; }
__device__ __forceinline__ float att_bf2f(unsigned b) { return __uint_as_float(b << 16); }
__device__ __forceinline__ void att_split3(float c, unsigned& w1, unsigned& w2) { const unsigned c0 = att_bf16_rne(c); const float r1 = c - att_bf2f(c0); const unsigned c1 = att_bf16_rne(r1); const float r2 = r1 - att_bf2f(c1);
    w1 = c0 | (c1 << 16); w2 = att_bf16_rne(r2); }

__device__ __forceinline__ u32x4 moba_get(const MobaCtx& C, ATT_LAS const int* pre, int i) {
    const int ng = (C.vcu < C.total) ? (C.total - C.vcu + C.G - 1) / C.G : 0;
    if (i < ng) { const int gI = C.vcu + i * C.G; int lo = 0, hi = 511;
        while (lo < hi) { const int mid = (lo + hi) >> 1; if (pre[mid] > gI) hi = mid; else lo = mid + 1; }
        const int hn = lo, c = gI - (hn ? pre[hn - 1] : 0); const int len = (int)C.cnt[hn] - c * 256;
        return (u32x4){1u | ((unsigned)(hn >> 6) << 2) | ((unsigned)(hn & 63) << 5), (unsigned)(len < 256 ? len : 256), (unsigned)hn * 16384u + (unsigned)c * 256u, 0u}; }
    const int u = C.vcu + (i - ng) * C.G; if (u >= 512) return (u32x4){0u, 0u, 0u, 0u};
    return (u32x4){1u | 2u | ((unsigned)(u & 7) << 2) | ((unsigned)(u >> 3) << 5), 256u, 0u, 0u};
}
__device__ __forceinline__ void glds4(const void* gsrc, unsigned lds_dst) { unsigned keep;
    asm volatile("s_mov_b32 %0, m0\n\ts_mov_b32 m0, %2\n\ts_nop 0\n\tglobal_load_lds_dword %1, off\n\ts_mov_b32 m0, %0" : "=&s"(keep) : "v"(gsrc), "s"(lds_dst) : "memory"); }

template <int PROBE> __device__ __forceinline__ void moba_run(const MobaCtx& C, char* shm, const int wid) {
    const int lane = pg8::lane_id_v(), tid = wid * 64 + lane, r32 = lane & 31, hi = lane >> 5;
    const unsigned lds0 = (unsigned)(uintptr_t)shm; const lds_cptr shm3 = (lds_cptr)shm;
    ATT_LAS const int* pre = (ATT_LAS const int*)(shm3 + MB_PRE);
    const float* pmax = C.posf + 16384;
    const int km_ = (r32 >> 1) & 7;
    const int ka0 = r32 * 128 + 32 * (km_ >> 1) + 16 * (hi ^ (km_ & 1));
    const int vpl = MB_V + ((lane >> 4) & 1) * 32 + (lane & 3) * 8 + (4 * hi + ((lane & 15) >> 2)) * 64;
    const unsigned koff = (unsigned)((8 * wid + (lane >> 3)) * 1536 + (((lane & 7) ^ ((4 * wid + (lane >> 4)) & 7)) * 8)) * 2u;
    const unsigned voff = (unsigned)((16 * (wid & 3) + (lane >> 2)) * 1536 + (wid >> 2) * 32 + (lane & 3) * 8) * 2u;
#define MB_UNPACK(X_, D_) do { (D_).own = (int)(((X_) >> 1) & 1u); (D_).h = (int)(((X_) >> 2) & 7u); (D_).n = (PROBE & 4) ? 0 : (int)((X_) >> 5); } while (0)
#define MB_DMA(D_, R_) do { const char* kb_ = (const char*)(C.mqkv + 512 + (D_).h * 64 + (size_t)(D_).n * 256 * 1536); const char* vb_ = kb_ + 1024; \
        unsigned db_ = (unsigned)(lds0 + (R_) + wid * 1024); asm volatile("" : "+s"(db_));     \
        _Pragma("unroll") for (int t_ = 0; t_ < 4; ++t_) { glds16(kb_ + koff + (size_t)t_ * (64 * 1536 * 2), db_ + t_ * MB_TILE); \
                                                           glds16(vb_ + voff + (size_t)t_ * (64 * 1536 * 2), db_ + t_ * MB_TILE + MB_V); } } while (0)
#define MB_FETCH(I_, E_, X_) do { E_ = ((const ATT_LAS u32x4*)(shm3 + MB_UT))[(I_)]; X_ = (unsigned)__builtin_amdgcn_readfirstlane((int)E_[0]); } while (0)
#define MB_SMALL(U_, E_, D_) do { \
        if (!(D_).own) { const int e = wid * 32 + r32; if (hi == 0 && e < (int)E_[1]) glds4(C.lists + E_[2] + e, (unsigned)(lds0 + MB_ENT + ((U_) & 1) * 1024 + wid * 128)); } \
        if (wid < 4) glds4(C.posf + (D_).n * 256 + tid, (unsigned)(lds0 + MB_POSK + ((U_) % 3) * 1024 + wid * 256)); \
        if (tid < 4) glds4(pmax + 4 * (D_).n + tid, (unsigned)(lds0 + MB_TM + ((U_) % 3) * 16)); } while (0)
#define MB_STAGE(U_, D_) do { if (tid < 256) { const ATT_LAS float* pp_ = (const ATT_LAS float*)(shm3 + MB_POSK + ((U_) % 3) * 1024); \
            const float v_ = exp2f(-(float)((D_).h + 1)) * 1.4426950408889634f * (pp_[tid] - pp_[0]); const unsigned vh_ = att_bf16_rne(v_), vl_ = att_bf16_rne(v_ - att_bf2f(vh_)); \
            ((ATT_LAS u32x4*)(shm3 + MB_KB + ((U_) & 1) * 4096))[tid] = (u32x4){vh_ | (vl_ << 16), 0x3F803F80u, 0x00003F80u, 0u}; } } while (0)
#define MB_QROW(U_, E_, D_, META_, QR_, PQ_) do { const int e_ = wid * 32 + r32; \
        if ((D_).own) META_ = (((D_).n * 256 + e_) << 2); \
        else { const unsigned en_ = ((const ATT_LAS unsigned*)(shm3 + MB_ENT + ((U_) & 1) * 1024))[e_]; META_ = (e_ < (int)E_[1]) ? (int)(((en_ & 0x3FFFu) << 2) | (1u + ((en_ >> 14) & 3u))) : -1; } \
        const int qr_ = (PROBE & 4) ? (16128 + e_) : ((META_) >= 0 ? ((META_) >> 2) : 0); const bf16_t* Qw_ = C.mqkv + (D_).h * 64 + (size_t)qr_ * 1536 + hi * 8; \
        _Pragma("unroll") for (int d0 = 0; d0 < 4; ++d0) QR_[d0] = *reinterpret_cast<const bf16x8*>(Qw_ + d0 * 16); PQ_ = C.posf[qr_]; } while (0)
#define MB_CHEAP(U_, D_, META_, PQ_, CM_) do { const f32x4 tm_ = *(const ATT_LAS f32x4*)(shm3 + MB_TM + ((U_) % 3) * 16); CM_ = 0; \
        _Pragma("unroll") for (int t_ = 0; t_ < 4; ++t_) { bool ok_ = __all((META_) < 0 || (PQ_) >= tm_[t_]); if ((D_).own) ok_ = ok_ && (64 * t_ + 63 <= wid * 32); if (ok_) CM_ |= 1 << t_; } } while (0)
  for (int base = 0; ; base += MB_NUT) {
    __syncthreads();
    if (tid < MB_NUT) ((ATT_LAS u32x4*)(shm3 + MB_UT))[tid] = moba_get(C, pre, base + tid);
    if (tid == MB_NUT || tid == MB_NUT + 1) ((ATT_LAS u32x4*)(shm3 + MB_UT))[tid] = (u32x4){0u, 0u, 0u, 0u};
    __syncthreads();
    u32x4 ent_; unsigned xc, xn, xnn = 0u; MobaDesc D, Dn;
    MB_FETCH(0, ent_, xc);
    if (!(xc & 1u)) break;
    MB_UNPACK(xc, D);
    MB_DMA(D, 0); MB_SMALL(0, ent_, D);
    { u32x4 e1_; MB_FETCH(1, e1_, xn); MB_UNPACK(xn, Dn); if (xn & 1u) MB_SMALL(1, e1_, Dn); }
    asm volatile("" ::: "memory"); __builtin_amdgcn_s_waitcnt(0); __builtin_amdgcn_s_barrier(); asm volatile("" ::: "memory");
    int meta = -1, cm = 0; float pq = 0.f, pbase = 0.f; bf16x8 qr[4];
    MB_STAGE(0, D); MB_QROW(0, ent_, D, meta, qr, pq);
    pbase = ((const ATT_LAS float*)(shm3 + MB_POSK))[0];
    asm volatile("" ::: "memory"); __builtin_amdgcn_s_waitcnt(0); __builtin_amdgcn_s_barrier(); asm volatile("" ::: "memory");
    MB_CHEAP(0, D, meta, pq, cm);
    if (xn & 1u) MB_DMA(Dn, MB_REG);
    int i = 0;
    for (; xc & 1u; ++i) {
        int meta_n = -1; float pq_n = 0.f;
        MB_UNPACK(xn, Dn);
        const int cur = i & 1, rb = cur * MB_REG; const float slope2 = exp2f(-(float)(D.h + 1)) * 1.4426950408889634f;
        const bool valid = meta >= 0; const int qrow = valid ? (meta >> 2) : 0, slot = meta & 3;
        const ATT_LAS float* posk = (const ATT_LAS float*)(shm3 + MB_POSK + (i % 3) * 1024);
        const lds_cptr kbx = shm3 + MB_KB + cur * 4096 + r32 * 16;
        float mhat = 0.f, l_reg = 0.f; bool first_ = true; f32x16 o[2]; o[0] = f32x16{}; o[1] = f32x16{};
        unsigned qxa0 = 0u, qxa1 = 0u, qxa2 = 0u, qxr1 = 0u, qxr2 = 0u;
#define MB_QX() do { unsigned a1_, a2_, r1_, r2_; att_split3(-slope2 * (pq - pbase) - mhat, a1_, a2_); att_split3(-mhat, r1_, r2_); \
            qxa0 = hi == 0 ? 0x3F803F80u : 0u; qxa1 = hi == 0 ? a1_ : 0u; qxa2 = hi == 0 ? a2_ : 0u; qxr1 = hi == 0 ? r1_ : 0u; qxr2 = hi == 0 ? r2_ : 0u; } while (0)
        MB_QX();
        f32x16 pA0, pA1, pB0, pB1; float mA = 0.f, mB = 0.f;
#define MB_ACT(T) (!D.own || (64 * (T) <= wid * 32 + 31))
#define MB_CH(T) ((cm >> (T)) & 1)
#define MB_QKT(P0, P1, MR, T) do { bf16x8 kk_[8]; const lds_cptr kb_ = shm3 + rb + (T) * MB_TILE; \
            const bf16x8 kx0_ = *(const ATT_LAS bf16x8*)(kbx + (T) * 1024), kx1_ = *(const ATT_LAS bf16x8*)(kbx + (T) * 1024 + 512); \
            _Pragma("unroll") for (int d0 = 0; d0 < 4; ++d0) { kk_[2 * d0] = *(const ATT_LAS bf16x8*)(kb_ + (ka0 ^ (d0 << 5))); kk_[2 * d0 + 1] = *(const ATT_LAS bf16x8*)(kb_ + (ka0 ^ (d0 << 5)) + 4096); } \
            const bool ch_ = MB_CH(T); const u32x4 qs_ = (u32x4){ch_ ? qxa0 : 0u, ch_ ? qxa1 : qxr1, ch_ ? qxa2 : qxr2, 0u}; \
            __builtin_amdgcn_sched_barrier(0); \
            P0 = __builtin_amdgcn_mfma_f32_32x32x16_bf16(kx0_, __builtin_bit_cast(bf16x8, qs_), f32x16{}, 0, 0, 0); P1 = __builtin_amdgcn_mfma_f32_32x32x16_bf16(kx1_, __builtin_bit_cast(bf16x8, qs_), f32x16{}, 0, 0, 0); \
            _Pragma("unroll") for (int d0 = 0; d0 < 4; ++d0) { P0 = __builtin_amdgcn_mfma_f32_32x32x16_bf16(kk_[2 * d0], qr[d0], P0, 0, 0, 0); P1 = __builtin_amdgcn_mfma_f32_32x32x16_bf16(kk_[2 * d0 + 1], qr[d0], P1, 0, 0, 0); } \
            MR = mhat; } while (0)
#define MB_SMPV(P0, P1, MC, T) do { \
            if (__any(MC != mhat)) { const float d_ = mhat - MC; _Pragma("unroll") for (int r = 0; r < 16; ++r) { P0[r] -= d_; P1[r] -= d_; } }     \
            if (!MB_CH(T)) { const ATT_LAS float* pk_ = posk + 64 * (T) + 4 * hi; \
                _Pragma("unroll") for (int g = 0; g < 4; ++g) { const f32x4 a_ = *(const ATT_LAS f32x4*)(pk_ + 8 * g), b_ = *(const ATT_LAS f32x4*)(pk_ + 8 * g + 32); \
                    _Pragma("unroll") for (int j = 0; j < 4; ++j) { P0[4 * g + j] -= slope2 * __builtin_fabsf(pq - a_[j]); P1[4 * g + j] -= slope2 * __builtin_fabsf(pq - b_[j]); } } } \
            if (D.own && 64 * (T) + 63 > wid * 32) { int dq_ = wid * 32 + r32 - 64 * (T) - 4 * hi; asm volatile("" : "+v"(dq_));     \
                _Pragma("unroll") for (int r = 0; r < 16; ++r) { const int c_ = (r & 3) + 8 * (r >> 2); if (c_ > dq_) P0[r] = -INFINITY; if (c_ + 32 > dq_) P1[r] = -INFINITY; } } \
            float rm_ = P0[0]; \
            _Pragma("unroll") for (int r = 1; r < 16; ++r) rm_ = fmaxf(rm_, P0[r]); \
            _Pragma("unroll") for (int r = 0; r < 16; ++r) rm_ = fmaxf(rm_, P1[r]); \
            { auto rr_ = __builtin_amdgcn_permlane32_swap(__float_as_uint(rm_), __float_as_uint(rm_), false, false); rm_ = fmaxf(__uint_as_float(rr_[0]), __uint_as_float(rr_[1])); } \
            if (first_ || __any(rm_ > 10.0f)) { const float dl_ = first_ ? rm_ : fmaxf(rm_, 0.f); mhat += dl_; \
                _Pragma("unroll") for (int r = 0; r < 16; ++r) { P0[r] -= dl_; P1[r] -= dl_; } \
                if (!first_) { const float f_ = __builtin_amdgcn_exp2f(-dl_); l_reg *= f_; \
                    _Pragma("unroll") for (int r = 0; r < 16; ++r) { o[0][r] *= f_; o[1][r] *= f_; } }                        \
                first_ = false; MB_QX(); } \
            _Pragma("unroll") for (int r = 0; r < 16; ++r) { P0[r] = __builtin_amdgcn_exp2f(P0[r]); P1[r] = __builtin_amdgcn_exp2f(P1[r]); } \
            { float sa_ = 0.f;     \
              _Pragma("unroll") for (int r = 0; r < 16; ++r) { sa_ += P0[r]; sa_ += P1[r]; } \
              l_reg += sa_; } \
            u32x4 pw_[4]; \
            _Pragma("unroll") for (int s_ = 0; s_ < 2; ++s_) { \
                pw_[s_] = (u32x4){cvtpk(P0[8 * s_], P0[8 * s_ + 1]), cvtpk(P0[8 * s_ + 2], P0[8 * s_ + 3]), cvtpk(P0[8 * s_ + 4], P0[8 * s_ + 5]), cvtpk(P0[8 * s_ + 6], P0[8 * s_ + 7])}; \
                pw_[2 + s_] = (u32x4){cvtpk(P1[8 * s_], P1[8 * s_ + 1]), cvtpk(P1[8 * s_ + 2], P1[8 * s_ + 3]), cvtpk(P1[8 * s_ + 4], P1[8 * s_ + 5]), cvtpk(P1[8 * s_ + 6], P1[8 * s_ + 7])}; } \
            const lds_cptr vp_ = shm3 + rb + (T) * MB_TILE + vpl; s16x4 vl_[8], vh_[8]; \
            _Pragma("unroll") for (int i_ = 0; i_ < 8; ++i_) { vl_[i_] = vtr(vp_ + (i_ >> 2) * 4096 + (i_ & 3) * 1024); vh_[i_] = vtr(vp_ + (i_ >> 2) * 4096 + (i_ & 3) * 1024 + 512); } \
            __builtin_amdgcn_sched_barrier(0); \
            _Pragma("unroll") for (int i_ = 0; i_ < 8; ++i_) { \
                const bf16x8 vf_ = (bf16x8){vl_[i_][0], vl_[i_][1], vl_[i_][2], vl_[i_][3], vh_[i_][0], vh_[i_][1], vh_[i_][2], vh_[i_][3]}; \
                o[i_ >> 2] = __builtin_amdgcn_mfma_f32_32x32x16_bf16(vf_, __builtin_bit_cast(bf16x8, pw_[i_ & 3]), o[i_ >> 2], 0, 0, 0); } } while (0)
        if (!(PROBE & 1)) {
        if (MB_ACT(3)) MB_QKT(pA0, pA1, mA, 3);
        if (MB_ACT(2)) MB_QKT(pB0, pB1, mB, 2);
        if (MB_ACT(3)) MB_SMPV(pA0, pA1, mA, 3);
        }
        if (xn & 1u) { MB_STAGE(i + 1, Dn);
            MB_FETCH(i + 2, ent_, xnn); if (xnn & 1u) { MobaDesc Dnn; MB_UNPACK(xnn, Dnn); MB_SMALL(i + 2, ent_, Dnn); } } else xnn = 0u;
        if (!(PROBE & 1)) {
        if (!(PROBE & 64)) if (MB_ACT(1)) MB_QKT(pA0, pA1, mA, 1);
        if (MB_ACT(2)) MB_SMPV(pB0, pB1, mB, 2);
        if (!(PROBE & 64)) MB_QKT(pB0, pB1, mB, 0);
        }
        if (xn & 1u) { MB_FETCH(i + 1, ent_, xn); MB_QROW(i + 1, ent_, Dn, meta_n, qr, pq_n); }
        if (!(PROBE & 1)) {
        if (!(PROBE & 64)) if (MB_ACT(1)) MB_SMPV(pA0, pA1, mA, 1);
        if (!(PROBE & 64)) MB_SMPV(pB0, pB1, mB, 0);
        }
#undef MB_QKT
#undef MB_SMPV
#undef MB_ACT
#undef MB_CH
#undef MB_QX
        asm volatile("" ::: "memory"); __builtin_amdgcn_s_waitcnt(0); __builtin_amdgcn_s_barrier(); asm volatile("" ::: "memory");
        const int h_o = D.h; const bool valid_o = valid; const int qrow_o = qrow, slot_o = slot;
        xc = xn; xn = xnn; D = Dn; meta = meta_n; pq = pq_n;
        if (xc & 1u) { pbase = ((const ATT_LAS float*)(shm3 + MB_POSK + ((i + 1) % 3) * 1024))[0]; MB_CHEAP(i + 1, D, meta, pq, cm); }
        if (xn & 1u) { MobaDesc Dt; MB_UNPACK(xn, Dt); MB_DMA(Dt, cur * MB_REG); }
        { auto rr = __builtin_amdgcn_permlane32_swap(__float_as_uint(l_reg), __float_as_uint(l_reg), false, false); l_reg = __uint_as_float(rr[0]) + __uint_as_float(rr[1]); }
        { const float rl = __builtin_amdgcn_rcpf(l_reg);
          bf16_t* prow = C.part + ((((size_t)(qrow_o * 8 + h_o) * 4 + slot_o) * 64) & (PROBE ? ((PROBE & 4) ? (size_t)0x3FFC0 : (size_t)0x7FFFC0) : ~(size_t)0)) + 8 * hi;
#pragma unroll
          for (int dh = 0; dh < 2; ++dh)
#pragma unroll
            for (int jp = 0; jp < 2; ++jp) {
                unsigned a0 = cvtpk(o[dh][8 * jp] * rl, o[dh][8 * jp + 1] * rl), a1 = cvtpk(o[dh][8 * jp + 2] * rl, o[dh][8 * jp + 3] * rl);
                unsigned b0 = cvtpk(o[dh][8 * jp + 4] * rl, o[dh][8 * jp + 5] * rl), b1 = cvtpk(o[dh][8 * jp + 6] * rl, o[dh][8 * jp + 7] * rl);
                const auto s0 = __builtin_amdgcn_permlane32_swap(a0, b0, false, false); const auto s1 = __builtin_amdgcn_permlane32_swap(a1, b1, false, false);
                if (!(PROBE & 2)) if (valid_o) *(u32x4*)(prow + 32 * dh + 16 * jp) = (u32x4){s0[0], s1[0], s0[1], s1[1]}; }
          if (!(PROBE & 2)) if (hi == 0 && valid_o) C.plse[(size_t)(qrow_o * 8 + h_o) * 4 + slot_o] = mhat + __builtin_log2f(l_reg); }
    }
    if (i < MB_NUT) break;
  }
#undef MB_UNPACK
#undef MB_DMA
#undef MB_FETCH
#undef MB_SMALL
#undef MB_STAGE
#undef MB_QROW
#undef MB_CHEAP
}
}

namespace xb {
#define LAS __attribute__((address_space(3)))
#define XB_TMO      128
#define XB_XCNT(j)  (256  + 64 * (j))
#define XB_XSUB(j)  (1280 + 64 * (j))
#define XB_XGEN(j)  (2304 + 64 * (j))
#define XB_TOP      3328
#define XB_TOPGEN   3392
#define XCD_BAR_WORDS 3456
#define XB_SPIN_CAP (1u << 21)

__device__ __forceinline__ unsigned xb_ld(unsigned* p)              { return __hip_atomic_load(p, __ATOMIC_RELAXED, __HIP_MEMORY_SCOPE_AGENT); }
__device__ __forceinline__ unsigned xb_add(unsigned* p, unsigned v) { return __hip_atomic_fetch_add(p, v, __ATOMIC_RELAXED, __HIP_MEMORY_SCOPE_AGENT); }
__device__ __forceinline__ unsigned xb_xcc_id() { return (unsigned)__builtin_amdgcn_s_getreg((3 << 11) | 20) & 0xFu; }
#define XB_SPIN(cond, bar) do { unsigned _sp = 0; while (cond) { __builtin_amdgcn_s_sleep(1); \
    if ((++_sp & 255u) == 0u) { if (xb_ld(&(bar)[XB_TMO])) break; if (_sp > XB_SPIN_CAP) { atomicAdd(&(bar)[XB_TMO], 1u); break; } } } } while (0)

struct XcdBarrier {
    unsigned* bar; unsigned x;
    volatile LAS unsigned* st;
};

__device__ __forceinline__ XcdBarrier xcd_barrier_post(unsigned* bar, volatile LAS unsigned* st, bool leader) {
    XcdBarrier b; b.bar = bar; b.x = xb_xcc_id(); b.st = st;
    if (leader) (void)xb_add(&bar[XB_XCNT(b.x)], 1u);
    return b;
}
__device__ __forceinline__ void xcd_barrier_complete(unsigned* bar, unsigned x, unsigned& nloc, unsigned& nx) {
    const unsigned G = gridDim.x * gridDim.y * gridDim.z;
    unsigned sum, cnt, mine, sp = 0u;
    for (;;) {
        sum = 0u; cnt = 0u; mine = 0u;
#pragma unroll
        for (unsigned j = 0; j < 16; ++j) { const unsigned c = xb_ld(&bar[XB_XCNT(j)]); sum += c; cnt += (c > 0u) ? 1u : 0u; mine = (j == x) ? c : mine; }
        if (sum == G) break;
        __builtin_amdgcn_s_sleep(1);
        if ((++sp & 255u) == 0u) { if (xb_ld(&bar[XB_TMO])) break; if (sp > XB_SPIN_CAP) { atomicAdd(&bar[XB_TMO], 1u); break; } }
    }
    nloc = mine > 0u ? mine : 1u; nx = cnt > 0u ? cnt : 1u;
}

__device__ __forceinline__ void xcd_barrier(const XcdBarrier& b, bool leader) {
    asm volatile("s_waitcnt vmcnt(0)" ::: "memory");
    __syncthreads();
    if (leader) {
        unsigned* bar = b.bar;
        __builtin_amdgcn_s_waitcnt(0);
        unsigned nloc = b.st[0], nx = b.st[1];
        if (nloc == 0u) { xcd_barrier_complete(bar, b.x, nloc, nx); b.st[0] = nloc; b.st[1] = nx; }
        const unsigned old = xb_add(&bar[XB_XSUB(b.x)], 1u);
        const unsigned gen = old / nloc;
        if (old + 1u == (gen + 1u) * nloc) {
            __builtin_amdgcn_fence(__ATOMIC_RELEASE, "agent");
            asm volatile("s_waitcnt vmcnt(0)" ::: "memory");
            const unsigned og = xb_add(&bar[XB_TOP], 1u);
            const unsigned tg = og / nx;
            if (og + 1u == (tg + 1u) * nx) xb_add(&bar[XB_TOPGEN], 1u);
            else XB_SPIN(xb_ld(&bar[XB_TOPGEN]) == tg, bar);
            __builtin_amdgcn_fence(__ATOMIC_ACQUIRE, "agent");
            xb_add(&bar[XB_XGEN(b.x)], 1u);
            asm volatile("s_waitcnt vmcnt(0)" ::: "memory");
        } else {
            XB_SPIN(xb_ld(&bar[XB_XGEN(b.x)]) == gen, bar);
            __builtin_amdgcn_fence(__ATOMIC_ACQUIRE, "agent");
            asm volatile("s_waitcnt vmcnt(0)" ::: "memory");
        }
    }
    __syncthreads();
}

#undef LAS
}
namespace mk {
typedef unsigned short bf16;
typedef unsigned v4u __attribute__((ext_vector_type(4)));
typedef float f32x4 __attribute__((ext_vector_type(4)));
#define MK_LAS __attribute__((address_space(3)))
using namespace mkc;
constexpr int NWAVES = 8;
constexpr int RING_BYTES = 131072, LDS_EXTRA = RING_BYTES, LDS_MISC = RING_BYTES + 8192, LDS_BYTES = 150528;
constexpr size_t WS_BAR = 4096, BAR_BYTES = 32768;

struct Args { const float* in[18]; float* out; unsigned char* ws; int ph_lo, ph_hi; };
struct Frame { MK_LAS unsigned char* lds; int tid, lane, wave, vcu, G; };
typedef const __attribute__((address_space(4))) Args* kargs_t;
__device__ __forceinline__ kargs_t kargs() { kargs_t p = (kargs_t)__builtin_amdgcn_kernarg_segment_ptr(); asm volatile("" : "+s"(p)); return p; }
__device__ __forceinline__ Frame mkframe(MK_LAS unsigned char* lds, int wave) { Frame F; F.lds = lds; F.wave = wave; F.lane = pg8::lane_id_v(); F.tid = wave * 64 + F.lane; F.G = gridDim.x;
    { const int bx = blockIdx.x; F.vcu = (F.G % 8 == 0) ? (bx % 8) * (F.G / 8) + bx / 8 : bx; } return F; }

__device__ __forceinline__ unsigned f2bf(float f) { unsigned u = __builtin_bit_cast(unsigned, f); return (u + 0x7fffu + ((u >> 16) & 1u)) >> 16; }
__device__ __forceinline__ unsigned pk2(float lo, float hi) { return f2bf(lo) | (f2bf(hi) << 16); }
__device__ __forceinline__ float bf2f(unsigned short b) { return __builtin_bit_cast(float, (unsigned)b << 16); }
__device__ __forceinline__ float wave_sum(float v) {
#pragma unroll
    for (int o = 1; o < 64; o <<= 1) v += __shfl_xor(v, o);
    return v;
}
__constant__ float ROPE_INV[16] = {1.000000000e+00f, 5.623413324e-01f, 3.162277639e-01f, 1.778279394e-01f, 1.000000015e-01f, 5.623413250e-02f, 3.162277490e-02f, 1.778279431e-02f,
                                   9.999999776e-03f, 5.623413250e-03f, 3.162277630e-03f, 1.778279431e-03f, 1.000000047e-03f, 5.623413017e-04f, 3.162277571e-04f, 1.778279402e-04f};
__device__ __forceinline__ int rope_phys(int L) { return L < 16 ? 8 * (L >> 2) + (L & 3) : 8 * ((L - 16) >> 2) + 4 + ((L - 16) & 3); }

__device__ __forceinline__ void p0_item(const float* W, int K, int N, bf16* WT, const float* gain, int kind, MK_LAS float* scr, int item, int lane) {
    const int nblk = N / 32, kb = item / nblk, nb = item % nblk, k0 = 64 * kb, n0 = 32 * nb;
    int dbase = n0; bool perm = false; float mul = 1.0f;
    if (kind == 1) dbase = (n0 >> 7) * 256 + (n0 & 127);
    else if (kind == 2) dbase = (n0 >> 7) * 256 + 128 + (n0 & 127);
    else if (kind == 3) { if (n0 == 640) perm = true; else if (n0 >= 672) { dbase = n0 + 96; if (n0 < 1184) mul = C2M; } }
    else if (kind == 4) { perm = (n0 % 96) == 64; mul = C2Q; }
    else if (kind == 5) { const int h = n0 >> 7, e = n0 & 127; dbase = e < 64 ? h * 64 + e : 512 + h * 64 + (e - 64); }
    float wv[32];
#pragma unroll
    for (int i = 0; i < 32; ++i) wv[i] = W[(size_t)(k0 + 2 * i + (lane >> 5)) * N + n0 + (lane & 31)];
#pragma unroll
    for (int i = 0; i < 32; ++i) { const int kk = 2 * i + (lane >> 5); const float g = gain ? gain[k0 + kk] * mul : mul; scr[kk * 33 + (lane & 31)] = wv[i] * g; }
    asm volatile("s_waitcnt lgkmcnt(0)" ::: "memory");
    const int c = lane & 7;
#pragma unroll
    for (int j = 0; j < 4; ++j) { const int n = (lane >> 3) + 8 * j; const MK_LAS float* s = scr + (8 * c) * 33 + n;
        v4u o; o.x = pk2(s[0 * 33], s[1 * 33]); o.y = pk2(s[2 * 33], s[3 * 33]); o.z = pk2(s[4 * 33], s[5 * 33]); o.w = pk2(s[6 * 33], s[7 * 33]);
        const int drow = dbase + (perm ? rope_phys(n) : n);
        *(v4u*)(WT + (size_t)drow * K + k0 + 8 * c) = o; }
    asm volatile("s_waitcnt lgkmcnt(0)" ::: "memory");
}
constexpr int I_G = (DM / 64) * (DFF / 32), I_D = (DFF / 64) * (DM / 32), I_IN = (DM / 64) * (2208 / 32), I_UQ = (384 / 64) * (768 / 32), I_UKV = (256 / 64) * (1024 / 32), I_O = (DM / 64) * (DM / 32);
constexpr int NITEMS = 4 * I_G + 2 * I_D + I_IN + I_UQ + I_UKV + I_O;
__device__ __forceinline__ void p0_one_item(kargs_t ap, unsigned char* ws, MK_LAS float* scr, int it, int lane) {
    int r = it;
    if (r < I_G) { p0_item(ap->in[3], DM, DFF, (bf16*)(ws + WS_WGU1), ap->in[2], 1, scr, r, lane); return; } r -= I_G;
    if (r < I_G) { p0_item(ap->in[4], DM, DFF, (bf16*)(ws + WS_WGU1), ap->in[2], 2, scr, r, lane); return; } r -= I_G;
    if (r < I_D) { p0_item(ap->in[5], DFF, DM, (bf16*)(ws + WS_WD1), nullptr, 0, scr, r, lane); return; } r -= I_D;
    if (r < I_G) { p0_item(ap->in[14], DM, DFF, (bf16*)(ws + WS_WGU2), ap->in[13], 1, scr, r, lane); return; } r -= I_G;
    if (r < I_G) { p0_item(ap->in[15], DM, DFF, (bf16*)(ws + WS_WGU2), ap->in[13], 2, scr, r, lane); return; } r -= I_G;
    if (r < I_D) { p0_item(ap->in[16], DFF, DM, (bf16*)(ws + WS_WD2), nullptr, 0, scr, r, lane); return; } r -= I_D;
    if (r < I_IN) { p0_item(ap->in[7], DM, 2208, (bf16*)(ws + WS_WIN), ap->in[6], 3, scr, r, lane); return; } r -= I_IN;
    if (r < I_UQ) { p0_item(ap->in[9], 384, 768, (bf16*)(ws + WS_WUQ), ap->in[8], 4, scr, r, lane); return; } r -= I_UQ;
    if (r < I_UKV) { p0_item(ap->in[11], 256, 1024, (bf16*)(ws + WS_WUKV), ap->in[10], 5, scr, r, lane); return; } r -= I_UKV;
    p0_item(ap->in[12], DM, DM, (bf16*)(ws + WS_WOUT), nullptr, 0, scr, r, lane);
}
__device__ __forceinline__ void p0_tables_and_zero(kargs_t ap, const int gt, const int NGT) {
    unsigned char* ws = ap->ws;
    const int* pos = (const int*)ap->in[1]; float* posf = (float*)(ws + WS_POSF); float* cosT = (float*)(ws + WS_COS); float* sinT = (float*)(ws + WS_SIN);
    for (int e = gt; e < S * 16; e += NGT) { const int s_ = e >> 4, i = e & 15; const float ang = (float)pos[s_] * ROPE_INV[i]; float sn, cs; sincosf(ang, &sn, &cs); cosT[e] = cs; sinT[e] = sn; if (i == 0) posf[s_] = (float)pos[s_]; }
    for (int e = gt >> 6; e < S / 64; e += NGT >> 6) { int m_ = pos[64 * e + (gt & 63)];
#pragma unroll
        for (int o_ = 1; o_ < 64; o_ <<= 1) m_ = max(m_, __shfl_xor(m_, o_)); if ((gt & 63) == 0) posf[S + e] = (float)m_; }
    float* z = (float*)(ws + WS_SS2);
    for (int e = gt; e < 5 * S; e += NGT) z[e] = 0.f;
    float* km = (float*)(ws + WS_KMS);
    for (int e = gt; e < 64 * 512; e += NGT) km[e] = 0.f;
    unsigned* cnt = (unsigned*)(ws + WS_CNT);
    for (int e = gt; e < 512; e += NGT) cnt[e] = 0u;
    unsigned* padz = (unsigned*)((bf16*)(ws + WS_WIN) + (size_t)672 * DM);
    for (int e = gt; e < 96 * DM / 2; e += NGT) padz[e] = 0u;
}
__device__ __forceinline__ void p0_late_items(const Frame& F, kargs_t ap) {
    unsigned char* ws = ap->ws; MK_LAS float* scr = (MK_LAS float*)(F.lds + F.wave * 16384);
    const int w = ((int)blockIdx.x - 128) * NWAVES + F.wave, NW_ = 128 * NWAVES;
    for (int it = 2 * I_G + w; it < NITEMS; it += NW_) p0_one_item(ap, ws, scr, it, F.lane);
    p0_tables_and_zero(ap, w * 64 + F.lane, NW_ * 64);
}
__device__ __forceinline__ void p0_prologue(const Frame& F, kargs_t ap) {
    unsigned char* ws = ap->ws;
    MK_LAS float* scr = (MK_LAS float*)(F.lds + F.wave * 16384);
    const int gw = F.vcu * NWAVES + F.wave, NGW = F.G * NWAVES;
    constexpr int N_EARLY = 2 * I_G;
    const int n_here = (F.G == 256) ? N_EARLY : NITEMS;
    for (int it = gw; it < n_here; it += NGW) p0_one_item(ap, ws, scr, it, F.lane);
    const float* x = ap->in[0]; bf16* xb = (bf16*)(ws + WS_XB); float* ss1 = (float*)(ws + WS_SS1);
    for (int m = gw; m < S; m += 4 * NGW) {
        f32x4 v[4][4];
#pragma unroll
        for (int r = 0; r < 4; ++r) { const int mr = m + r * NGW; if (mr < S) { const f32x4* xr = (const f32x4*)(x + (size_t)mr * DM) + F.lane;
#pragma unroll
            for (int j = 0; j < 4; ++j) v[r][j] = xr[64 * j]; } }
#pragma unroll
        for (int r = 0; r < 4; ++r) { const int mr = m + r * NGW; if (mr < S) { unsigned long long* o8 = (unsigned long long*)(xb + (size_t)mr * DM) + F.lane; float s = 0.f;
#pragma unroll
            for (int j = 0; j < 4; ++j) { const f32x4 w = v[r][j]; s += (w[0] * w[0] + w[1] * w[1]) + (w[2] * w[2] + w[3] * w[3]); o8[64 * j] = (unsigned long long)pk2(w[0], w[1]) | ((unsigned long long)pk2(w[2], w[3]) << 32); }
            s = wave_sum(s); if (F.lane == 0) ss1[mr] = s; } }
    }
    if (F.G != 256) p0_tables_and_zero(ap, (F.vcu * NWAVES + F.wave) * 64 + F.lane, NGW * 64);
}

__device__ __forceinline__ void p4_krope(const Frame& F, kargs_t ap) { unsigned char* const wsb = ap->ws;
    const bf16* cqkv = (const bf16*)(wsb + WS_CQKV); bf16* Kr = (bf16*)(wsb + WS_KR); const float* cosT = (const float*)(wsb + WS_COS); const float* sinT = (const float*)(wsb + WS_SIN);
    const int gt = (F.vcu * NWAVES + F.wave) * 64 + F.lane, NGT = F.G * NWAVES * 64;
    for (int e = gt; e < S * 16; e += NGT) { const int s_ = e >> 4, i = e & 15, g = i >> 2, j = i & 3;
        const float x1 = bf2f(cqkv[(size_t)s_ * 768 + 640 + 8 * g + j]), x2 = bf2f(cqkv[(size_t)s_ * 768 + 640 + 8 * g + 4 + j]); const float c = cosT[e], sn = sinT[e];
        Kr[(size_t)s_ * 32 + 8 * g + j] = (bf16)f2bf(x1 * c - x2 * sn); Kr[(size_t)s_ * 32 + 8 * g + 4 + j] = (bf16)f2bf(x1 * sn + x2 * c); }
}
__device__ __forceinline__ void p4_gating(const Frame& F, kargs_t ap) { unsigned char* const wsb = ap->ws;
    const bf16* mqkv = (const bf16*)(wsb + WS_MQKV); const float* kms = (const float*)(wsb + WS_KMS); unsigned* cnt = (unsigned*)(wsb + WS_CNT); unsigned* lists = (unsigned*)(wsb + WS_LIST);
    MK_LAS float* km = (MK_LAS float*)F.lds;
    const int u0 = (F.G == 256) ? ((int)blockIdx.x < 192 ? (int)blockIdx.x : 256) : F.vcu, ustep = (F.G == 256) ? 192 : F.G;
    for (int u = u0; u < 256; u += ustep) {
        const int h = u & 7, q = (u >> 3) * 512 + F.tid, own = q >> 8;
        __syncthreads();
        for (int e = F.tid; e < 4096; e += 512) km[e] = kms[(size_t)(e >> 6) * 512 + h * 64 + (e & 63)] * (1.0f / 256.0f);
        __syncthreads();
        float qv[64];
        { const v4u* qp = (const v4u*)(mqkv + (size_t)q * 1536 + h * 64);
#pragma unroll
          for (int c = 0; c < 8; ++c) { const v4u w = qp[c];
#pragma unroll
              for (int j = 0; j < 4; ++j) { qv[8 * c + 2 * j] = __builtin_bit_cast(float, w[j] << 16); qv[8 * c + 2 * j + 1] = __builtin_bit_cast(float, w[j] & 0xFFFF0000u); } } }
        float g0 = -3e38f, g1 = -3e38f, g2 = -3e38f; int i0 = -1, i1 = -1, i2 = -1;
        const int own_max = __builtin_amdgcn_readfirstlane(own);
        for (int n = 0; n < own_max; ++n) {
            float g = 0.f;
#pragma unroll
            for (int c = 0; c < 16; ++c) { const f32x4 kk = *(const MK_LAS f32x4*)(km + n * 64 + 4 * c); g = fmaf(qv[4 * c], kk[0], g); g = fmaf(qv[4 * c + 1], kk[1], g); g = fmaf(qv[4 * c + 2], kk[2], g); g = fmaf(qv[4 * c + 3], kk[3], g); }
            if (g > g0) { g2 = g1; i2 = i1; g1 = g0; i1 = i0; g0 = g; i0 = n; }
            else if (g > g1) { g2 = g1; i2 = i1; g1 = g; i1 = n; }
            else if (g > g2) { g2 = g; i2 = n; }
        }
        MK_LAS unsigned* lcnt = (MK_LAS unsigned*)(F.lds + 16384);
        __syncthreads();
        if (F.tid < 64) lcnt[F.tid] = 0u;
        __syncthreads();
        unsigned r0 = 0u, r1 = 0u, r2 = 0u;
        if (i0 >= 0) r0 = __hip_atomic_fetch_add(lcnt + i0, 1u, __ATOMIC_RELAXED, __HIP_MEMORY_SCOPE_WORKGROUP);
        if (i1 >= 0) r1 = __hip_atomic_fetch_add(lcnt + i1, 1u, __ATOMIC_RELAXED, __HIP_MEMORY_SCOPE_WORKGROUP);
        if (i2 >= 0) r2 = __hip_atomic_fetch_add(lcnt + i2, 1u, __ATOMIC_RELAXED, __HIP_MEMORY_SCOPE_WORKGROUP);
        __syncthreads();
        if (F.tid < 64) { const unsigned c = lcnt[F.tid]; lcnt[64 + F.tid] = c ? atomicAdd(cnt + h * 64 + F.tid, c) : 0u; }
        __syncthreads();
        if (i0 >= 0) lists[(size_t)(h * 64 + i0) * S + lcnt[64 + i0] + r0] = (unsigned)(q | (0 << 14));
        if (i1 >= 0) lists[(size_t)(h * 64 + i1) * S + lcnt[64 + i1] + r1] = (unsigned)(q | (1 << 14));
        if (i2 >= 0) lists[(size_t)(h * 64 + i2) * S + lcnt[64 + i2] + r2] = (unsigned)(q | (2 << 14));
    }
    __syncthreads();
}
__device__ __forceinline__ void p5_combine(const Frame& F, kargs_t ap) { unsigned char* const wsb = ap->ws;
    const bf16* part = (const bf16*)ap->out;     const float* plse = (const float*)(wsb + WS_PLSE); bf16* cat = (bf16*)(wsb + WS_CAT);
    const int gt = (F.vcu * NWAVES + F.wave) * 64 + F.lane, NGT = F.G * NWAVES * 64;
    for (int e = gt; e < S * 8 * 8; e += NGT) { const int dg = e & 7, qh = e >> 3, q = qh >> 3, h = qh & 7; const int ns = 1 + min(3, q >> 8);
        const f32x4 ls = *(const f32x4*)(plse + (size_t)qh * 4);
        float M = ls[0]; for (int s = 1; s < 4; ++s) if (s < ns) M = fmaxf(M, ls[s]);
        float acc[8], wsum = 0.f;
#pragma unroll
        for (int j = 0; j < 8; ++j) acc[j] = 0.f;
#pragma unroll
        for (int s = 0; s < 4; ++s) if (s < ns) { const float w = __builtin_amdgcn_exp2f(ls[s] - M); wsum += w; const v4u v = *(const v4u*)(part + ((size_t)qh * 4 + s) * 64 + dg * 8);
#pragma unroll
            for (int j = 0; j < 4; ++j) { acc[2 * j] += w * __builtin_bit_cast(float, v[j] << 16); acc[2 * j + 1] += w * __builtin_bit_cast(float, v[j] & 0xFFFF0000u); } }
        const float r = 1.0f / wsum; v4u o; o.x = pk2(acc[0] * r, acc[1] * r); o.y = pk2(acc[2] * r, acc[3] * r); o.z = pk2(acc[4] * r, acc[5] * r); o.w = pk2(acc[6] * r, acc[7] * r);
        *(v4u*)(cat + (size_t)q * 1024 + 512 + h * 64 + dg * 8) = o; }
}
__device__ __forceinline__ void p9_final(const Frame& F, kargs_t ap) { unsigned char* const wsb = ap->ws;
    const float* ss = (const float*)(wsb + WS_SS4); const float* g = ap->in[17];
    const int gw = F.vcu * NWAVES + F.wave, NGW = F.G * NWAVES;
    float tsc = 1.0f;
#ifdef MK_TS
    { const unsigned long long* ts = (const unsigned long long*)(wsb + 2048); tsc = 1.0f + (float)(ts[MK_TS + 1] - ts[MK_TS]) * (float)MK_TS_SCALE; }
#endif
    for (int m = gw; m < S; m += NGW) { const float rs = tsc / sqrtf(ss[m] * (1.0f / 1024.0f) + 1e-6f); f32x4* xr = (f32x4*)(ap->out + (size_t)m * DM) + F.lane; const f32x4* gr = (const f32x4*)g + F.lane;
#pragma unroll
        for (int j = 0; j < 4; ++j) { const f32x4 v = xr[64 * j]; xr[64 * j] = v * rs * gr[64 * j]; } }
}

__global__ void __launch_bounds__(NWAVES * 64, 2) mk_fwd(Args a_unused) {
    extern __shared__ __attribute__((aligned(16))) unsigned char lds[];
    const int wave = __builtin_amdgcn_readfirstlane(threadIdx.x >> 6);
    MK_LAS unsigned char* const ldsp = (MK_LAS unsigned char*)lds;
    int lo, hi; { kargs_t ap = kargs(); lo = ap->ph_lo; hi = ap->ph_hi; }
#ifndef MK_ONLY
#define MK_ONLY -1
#endif
#define IN(k) ((MK_ONLY < 0 || MK_ONLY == (k)) && lo <= (k) && (k) < hi)
    const bool multi = (hi - lo) > 1;
    if (multi) {
        const int l0 = pg8::lane_id_v();
        if (wave == 0 && l0 < 2) ((volatile MK_LAS unsigned*)(ldsp + LDS_MISC))[l0] = 0u;
        __syncthreads();
        kargs_t ap = kargs(); (void)xb::xcd_barrier_post((unsigned*)(ap->ws + WS_BAR), (volatile MK_LAS unsigned*)(ldsp + LDS_MISC), wave == 0 && l0 == 0);
    }
    if (lo < -1) cg::this_grid().sync();
#ifdef MK_TS
#define MK_STAMP(i) do { if (blockIdx.x == 0 && wave == 0 && pg8::lane_id_v() == 0) { kargs_t ap__ = kargs(); ((unsigned long long*)(ap__->ws + 2048))[(i)] = __builtin_amdgcn_s_memrealtime(); } } while (0)
#else
#define MK_STAMP(i) do { } while (0)
#endif
    MK_STAMP(0);
#define SEAM(k) do { if (IN(k) && IN((k) + 1)) { kargs_t ap_ = kargs(); xb::XcdBarrier b_; b_.bar = (unsigned*)(ap_->ws + WS_BAR); b_.x = xb::xb_xcc_id(); b_.st = (volatile MK_LAS unsigned*)(ldsp + LDS_MISC); \
        xb::xcd_barrier(b_, wave == 0 && pg8::lane_id_v() == 0); MK_STAMP((k) + 1); } } while (0)
    if (IN(0)) { kargs_t ap = kargs(); const Frame F = mkframe(ldsp, wave); p0_prologue(F, ap); } SEAM(0);
    if (IN(1)) { kargs_t ap = kargs(); unsigned char* ws = ap->ws; pg8::Gemm g{(const bf16*)(ws + WS_XB), (const bf16*)(ws + WS_WGU1), S, NGU, DM, DM}; pg8::StaticOrder So; So.init(S, NGU, (int)gridDim.x, (int)blockIdx.x);
        pg8::EpiSwiGLU E{ws, 0}; pg8::gemm_phase<pg8::EpiSwiGLU, pg8::StaticOrder, true, true>(ldsp, g, So, E, wave);
        if (gridDim.x == 256 && blockIdx.x >= 128) { kargs_t ap2 = kargs(); const Frame F = mkframe(ldsp, wave); __syncthreads(); p0_late_items(F, ap2); } } SEAM(1);
    if (IN(2)) { kargs_t ap = kargs(); unsigned char* ws = ap->ws; pg8::Gemm g{(const bf16*)(ws + WS_ACT), (const bf16*)(ws + WS_WD1), S, DM, DFF, DFF}; pg8::StaticOrder So; So.init(S, DM, (int)gridDim.x, (int)blockIdx.x);
        pg8::EpiResid E{nullptr, ws, (int)WS_SS2, 0.5f}; pg8::gemm_phase<pg8::EpiResid, pg8::StaticOrder, true, true>(ldsp, g, So, E, wave); } SEAM(2);
    if (IN(3)) { kargs_t ap = kargs(); unsigned char* ws = ap->ws; pg8::Gemm g{(const bf16*)(ws + WS_XB), (const bf16*)(ws + WS_WIN), S, NWIN, DM, DM}; pg8::StaticOrder So; So.init(S, gridDim.x == 256 ? NWIN - 256 : NWIN, (int)gridDim.x, (int)blockIdx.x);
        pg8::EpiWin E{ws, 0}; pg8::gemm_phase<pg8::EpiWin, pg8::StaticOrder, true, true>(ldsp, g, So, E, wave); } SEAM(3);
    if (IN(4)) {
        { kargs_t ap = kargs(); unsigned char* ws = ap->ws; pg8::Gemm g{(const bf16*)(ws + WS_CQKV) + 384, (const bf16*)(ws + WS_WUKV), S, 1024, 256, 768}; pg8::StaticOrder So; So.init(S, 1024, (int)gridDim.x, (int)blockIdx.x);
          pg8::EpiKV E{ws}; pg8::gemm_phase<pg8::EpiKV, pg8::StaticOrder, true, true>(ldsp, g, So, E, wave); }
        { kargs_t ap = kargs(); unsigned char* ws = ap->ws; pg8::Gemm g{(const bf16*)(ws + WS_CQKV), (const bf16*)(ws + WS_WUQ), S, 768, 384, 768}; pg8::StaticOrder So; So.init(S, 768, (int)gridDim.x, (int)blockIdx.x);
          pg8::EpiQ E{ws}; pg8::gemm_phase<pg8::EpiQ, pg8::StaticOrder, true, true>(ldsp, g, So, E, wave); }
        if (gridDim.x == 256) { kargs_t ap = kargs(); unsigned char* ws = ap->ws; pg8::Gemm g{(const bf16*)(ws + WS_XB), (const bf16*)(ws + WS_WIN), S, NWIN, DM, DM}; pg8::TailOrder So; So.init(S, 8, (int)gridDim.x, (int)blockIdx.x);
          pg8::EpiWin E{ws, 0}; pg8::gemm_phase<pg8::EpiWin, pg8::TailOrder, true, true>(ldsp, g, So, E, wave); }
        { kargs_t ap = kargs(); const Frame F = mkframe(ldsp, wave); p4_krope(F, ap); }
#ifndef MK_NO_GATE
        { kargs_t ap = kargs(); const Frame F = mkframe(ldsp, wave); p4_gating(F, ap); }
#endif
    } SEAM(4);
#ifndef MK_NO_ATT5
    if (IN(5)) {
        kargs_t ap = kargs(); unsigned char* ws = ap->ws; const Frame F = mkframe(ldsp, wave);
        MK_LAS int* pre = (MK_LAS int*)(ldsp + att::MB_PRE);
        const unsigned* cnt = (const unsigned*)(ws + WS_CNT);
        __syncthreads();
        { const int c = (int)cnt[F.tid]; pre[F.tid] = (c + 255) >> 8; }
        __syncthreads();
        for (int o = 1; o < 512; o <<= 1) { const int v = pre[F.tid] + (F.tid >= o ? pre[F.tid - o] : 0); __syncthreads(); pre[F.tid] = v; __syncthreads(); }
        att::MobaCtx C; C.mqkv = (const bf16*)(ws + WS_MQKV); C.posf = (const float*)(ws + WS_POSF); C.part = (bf16*)ap->out; C.plse = (float*)(ws + WS_PLSE);
        C.lists = (const unsigned*)(ws + WS_LIST); C.cnt = cnt; C.total = pre[511]; C.vcu = F.vcu; C.G = F.G;
#ifdef MK_PROBE5
        { bf16* rp_ = C.part; float* rl_ = C.plse; C.part = (bf16*)(ws + WS_CQKV); C.plse = (float*)(ws + WS_CQKV + (16u << 20)); att::moba_run<MK_PROBE5>(C, (char*)lds, wave); __syncthreads(); C.part = rp_; C.plse = rl_; }
#endif
        att::moba_run<0>(C, (char*)lds, wave);
    }
#endif
    SEAM(5);
    if (IN(6)) {
        { kargs_t ap = kargs(); const Frame F = mkframe(ldsp, wave); p5_combine(F, ap); }
#ifndef MK_NO_ATT6
        kargs_t ap = kargs(); unsigned char* ws = ap->ws; const Frame F = mkframe(ldsp, wave);
        att::Unit U; U.posf = nullptr; U.part = nullptr; U.plse = nullptr; U.list = nullptr; U.len = 0; U.slope2 = 0.f; U.q_pitch = 768; U.k_pitch = 512; U.v_pitch = 512; U.o_pitch = 1024; U.key0 = 0; U.Kr = (const bf16*)(ws + WS_KR);
        int vstep6 = F.G;
#ifdef MK_PROBE6
        asm volatile("s_mov_b32 %0, 0" : "=s"(vstep6));
        int npass6 = 0;
#endif
        for (int v = F.vcu; v < 256; v += vstep6) { const int h = v >> 5, s_ = v & 31;
#ifdef MK_PROBE6
            if (npass6++ >= MK_PROBE6) break;
            U.len = (npass6 == 1) ? 1 : 0;
#endif
            for (int i = 0; i < 2; ++i) { const int qb = i == 0 ? 63 - s_ : s_;
                U.h = h; U.Q = (const bf16*)(ws + WS_Q) + h * 96; U.K = (const bf16*)(ws + WS_KN) + h * 64; U.V = (const bf16*)(ws + WS_V) + h * 64; U.O = (bf16*)(ws + WS_CAT) + h * 64; U.q0 = qb * 256; U.ntiles = 4 * (qb + 1);
                att::unit<0>(U, (char*)lds, wave); } }
#endif
    } SEAM(6);
    if (IN(7)) { kargs_t ap = kargs(); unsigned char* ws = ap->ws; pg8::Gemm g{(const bf16*)(ws + WS_CAT), (const bf16*)(ws + WS_WOUT), S, DM, DM, DM}; pg8::StaticOrder So; So.init(S, DM, (int)gridDim.x, (int)blockIdx.x);
        pg8::EpiResid E{nullptr, ws, (int)WS_SS3, 1.0f}; pg8::gemm_phase<pg8::EpiResid, pg8::StaticOrder, true, true>(ldsp, g, So, E, wave); } SEAM(7);
    if (IN(8)) { kargs_t ap = kargs(); unsigned char* ws = ap->ws; pg8::Gemm g{(const bf16*)(ws + WS_XB), (const bf16*)(ws + WS_WGU2), S, NGU, DM, DM}; pg8::StaticOrder So; So.init(S, NGU, (int)gridDim.x, (int)blockIdx.x);
        pg8::EpiSwiGLU E{ws, 1}; pg8::gemm_phase<pg8::EpiSwiGLU, pg8::StaticOrder, true, true>(ldsp, g, So, E, wave); } SEAM(8);
    if (IN(9)) { kargs_t ap = kargs(); unsigned char* ws = ap->ws; pg8::Gemm g{(const bf16*)(ws + WS_ACT), (const bf16*)(ws + WS_WD2), S, DM, DFF, DFF}; pg8::StaticOrder So; So.init(S, DM, (int)gridDim.x, (int)blockIdx.x);
        if (gridDim.x == 256) { pg8::EpiResidNorm E{ap->out, ws, ap->in[17], 0.5f}; pg8::gemm_phase<pg8::EpiResidNorm, pg8::StaticOrder, false, true>(ldsp, g, So, E, wave); }
        else { pg8::EpiResid E{ap->out, ws, (int)WS_SS4, 0.5f}; pg8::gemm_phase<pg8::EpiResid, pg8::StaticOrder, true, true>(ldsp, g, So, E, wave); } }
    if (gridDim.x != 256) SEAM(9);
    if (IN(10) && gridDim.x != 256) { kargs_t ap = kargs(); const Frame F = mkframe(ldsp, wave); p9_final(F, ap); }
#undef IN
#undef SEAM
}
constexpr int N_PHASES = 11;
}
#ifndef MK_BRINGUP
#define MK_BRINGUP 0
#endif
extern "C" void kernel_launch(void* const* d_in, const int* in_sizes, int n_in, void* d_out, int out_size, void* d_ws, size_t ws_size, hipStream_t stream) {
    static int grid = 0;
    if (grid == 0) {
        if (hipFuncSetAttribute((const void*)mk::mk_fwd, hipFuncAttributeMaxDynamicSharedMemorySize, mk::LDS_BYTES) != hipSuccess) { fprintf(stderr, "kernel_launch: hipFuncSetAttribute failed\n"); grid = -1; return; }
        int dev = 0, cus = 0, per_cu = 0;
        hipGetDevice(&dev); hipDeviceGetAttribute(&cus, hipDeviceAttributeMultiprocessorCount, dev);
        hipOccupancyMaxActiveBlocksPerMultiprocessor(&per_cu, (const void*)mk::mk_fwd, mk::NWAVES * 64, mk::LDS_BYTES);
        (void)hipGetLastError();
        grid = cus * (per_cu < 1 ? 1 : (per_cu > 1 ? 1 : per_cu));
        if (grid % 8 != 0 || grid <= 0) grid = 256;
        if (ws_size < mk::WS_END) { fprintf(stderr, "kernel_launch: workspace too small (%zu)\n", ws_size); grid = -1; return; }
    }
    if (grid < 0) return;
    mk::Args a{};
    for (int i = 0; i < 18; ++i) a.in[i] = (const float*)d_in[i];
    a.out = (float*)d_out; a.ws = (unsigned char*)d_ws;
#if MK_BRINGUP == 0
    if (hipMemsetAsync((char*)d_ws + mk::WS_BAR, 0, mk::BAR_BYTES, stream) != hipSuccess) { fprintf(stderr, "kernel_launch: memset failed\n"); return; }
    a.ph_lo = 0; a.ph_hi = mk::N_PHASES;
    void* args[] = {&a};
    hipError_t e = hipLaunchCooperativeKernel((const void*)mk::mk_fwd, dim3(grid), dim3(mk::NWAVES * 64), args, mk::LDS_BYTES, stream);
    if (e != hipSuccess) fprintf(stderr, "cooperative launch failed: %s (grid %d)\n", hipGetErrorString(e), grid);
#else
    const int nph = MK_BRINGUP == 1 ? 3 : MK_BRINGUP == 2 ? 8 : mk::N_PHASES;
    for (int ph = 0; ph < nph; ++ph) { a.ph_lo = ph; a.ph_hi = ph + 1; hipLaunchKernelGGL(mk::mk_fwd, dim3(grid), dim3(mk::NWAVES * 64), mk::LDS_BYTES, stream, a); }
#if MK_BRINGUP == 1
    nv::part_mix(d_in, (float*)d_out, d_ws, stream); nv::part_ffn2_final(d_in, (float*)d_out, d_ws, stream);
#elif MK_BRINGUP == 2
    nv::part_ffn2_final(d_in, (float*)d_out, d_ws, stream);
#endif
#endif
}
```

```cpp
#define MK_BRINGUP 0
#include <hip/hip_runtime.h>
#include <cstdio>
#include <cstdint>
#include <cmath>
#include <hip/hip_cooperative_groups.h>
namespace cg = cooperative_groups;

namespace mkc {
constexpr int S = 16384, DM = 1024, DFF = 2816, NGU = 2 * DFF, NWIN = 2304;
constexpr float LOG2E = 1.4426950408889634f;
constexpr float C2Q = 0.10206207261596577f * LOG2E;
constexpr float C2M = 0.125f * LOG2E;
constexpr size_t MiB = 1u << 20;
constexpr size_t WS_PANEL = 4096 + 16384;
constexpr size_t WS_CNT = 0;
constexpr size_t WS_SS1 = 1 * MiB, WS_SS2 = WS_SS1 + 65536, WS_SSQ = WS_SS2 + 65536, WS_SSKV = WS_SSQ + 65536, WS_SS3 = WS_SSKV + 65536, WS_SS4 = WS_SS3 + 65536;
constexpr size_t WS_KMS = WS_SS1 + 512 * 1024;
constexpr size_t WS_SSDUMMY = WS_SS1 + 384 * 1024, WS_KMSDUMMY = WS_SS1 + 640 * 1024;
constexpr size_t WS_POSF = 2 * MiB, WS_COS = 3 * MiB, WS_SIN = 4 * MiB;
constexpr size_t WS_WGU1 = 6 * MiB, WS_WD1 = 17 * MiB, WS_WGU2 = WS_WD1 + 5632 * 1024, WS_WD2 = WS_WGU2 + 11 * MiB, WS_WIN = 39 * MiB, WS_WUQ = WS_WIN + 4608 * 1024, WS_WUKV = WS_WUQ + 768 * 1024, WS_WOUT = 45 * MiB;
constexpr size_t WS_XB = 48 * MiB, WS_CQKV = 80 * MiB, WS_PLSE = 112 * MiB;
constexpr size_t WS_ACT = 114 * MiB, WS_MQKV = 114 * MiB, WS_CAT = 114 * MiB, WS_Q = 162 * MiB, WS_KN = 186 * MiB, WS_V = 202 * MiB, WS_KR = 218 * MiB, WS_LIST = 220 * MiB, WS_END = 252 * MiB;
static_assert(WS_WD2 + 5632 * 1024 <= WS_WIN && WS_WUKV + 512 * 1024 <= WS_WOUT && WS_WOUT + 2 * MiB <= WS_XB, "weight map");
}
namespace pg8 {
#define PG8_LAS __attribute__((address_space(3)))
typedef unsigned short bf16_t;
typedef short bf16x8 __attribute__((ext_vector_type(8)));
typedef float f32x4 __attribute__((ext_vector_type(4)));
typedef unsigned u32x4 __attribute__((ext_vector_type(4)));
__device__ __forceinline__ int lane_id_v() { int l; asm volatile("v_mbcnt_lo_u32_b32 %0, -1, 0\n\tv_mbcnt_hi_u32_b32 %0, -1, %0" : "=v"(l)); return l; }
constexpr int BM = 256, BK = 64, HALF = 128, HTB = HALF * BK * 2  , STAGE_BYTES = 8 * HTB, NXCD = 8, WGM = 4;

__host__ __device__ __forceinline__ int lds_byte(int r, int c) { const int st = (r >> 4) * 2 + (c >> 5), rr = r & 15, cc = c & 31, ob = rr * 64 + cc * 2; return st * 1024 + (ob ^ (((ob >> 9) & 1) << 5)); }
__host__ __device__ __forceinline__ void stage_rc(int b, int& R, int& C) { const int st = b / 1024, sb = b % 1024, swz = sb ^ (((sb >> 9) & 1) << 5); R = (st >> 1) * 16 + swz / 64; C = (st & 1) * 32 + (swz % 64) / 2; }
__host__ __device__ __forceinline__ int perm32(int rho) { const int n = rho >> 4, i = rho & 15; return 8 * (i >> 2) + 4 * n + (i & 3); }

struct Unit { int pm, pn; };
struct Gemm { const bf16_t* A; const bf16_t* Bt; int M, N, K, lda; };

struct StaticOrder {
    int nM, nN, nwg, G, c;
    __host__ __device__ void init(int M, int N, int G_, int c_) { nM = M / BM; nN = N / BM; nwg = nM * nN; G = G_; c = c_; }
    __host__ __device__ bool next(int i, Unit& u) const {
        const long L = (long)i * G + c; if (L >= nwg) return false;
        int wgid = (int)L; { const int q = nwg / NXCD, r = nwg % NXCD, xcd = wgid % NXCD, off = wgid / NXCD; wgid = (xcd < r ? xcd * (q + 1) : r * (q + 1) + (xcd - r) * q) + off; }
        const int nig = WGM * nN, gid = wgid / nig, fm = gid * WGM, gsz = (nM - fm) < WGM ? (nM - fm) : WGM;
        u.pm = fm + ((wgid % nig) % gsz); u.pn = (wgid % nig) / gsz; return true;
    }
    __device__ __forceinline__ void a_ready(const Unit&) const {}
    __device__ __forceinline__ void done(const Unit&) const {}
};
struct TailOrder {
    int nM, pn, G, c;
    __host__ __device__ void init(int M, int pn_, int G_, int c_) { nM = M / BM; pn = pn_; G = G_; c = c_; }
    __host__ __device__ bool next(int i, Unit& u) const { const int j = c - (G - nM); if (i != 0 || j < 0 || j >= nM) return false; u.pm = j; u.pn = pn; return true; }
    __device__ __forceinline__ void a_ready(const Unit&) const {}
    __device__ __forceinline__ void done(const Unit&) const {}
};
__device__ __forceinline__ unsigned cvt_pk_bf16(float lo, float hi) { unsigned r; asm volatile("v_cvt_pk_bf16_f32 %0, %1, %2" : "=v"(r) : "v"(lo), "v"(hi)); return r; }
typedef unsigned u32x2 __attribute__((ext_vector_type(2)));
constexpr float RMS_EPS = 1e-6f;
__device__ __forceinline__ float rs_of(const float* ss, int row, float invn) { return __builtin_amdgcn_rsqf(ss[row] * invn + RMS_EPS); }
__device__ __forceinline__ float silu_f(float g) { return g * __builtin_amdgcn_rcpf(1.0f + __builtin_amdgcn_exp2f(-1.4426950408889634f * g)); }
__device__ __forceinline__ u32x4 pack8(const f32x4 a, const f32x4 b) { u32x4 w; w.x = cvt_pk_bf16(a[0], a[1]); w.y = cvt_pk_bf16(a[2], a[3]); w.z = cvt_pk_bf16(b[0], b[1]); w.w = cvt_pk_bf16(b[2], b[3]); return w; }

struct EpiSwiGLU {
    static constexpr bool PERM = true, AFTER_DRAIN = false;
    unsigned char* ws; int which;
    __device__ __forceinline__ void operator()(const f32x4 (&acc)[2][2][4][2], const Unit& u, int wr, int wc, int fr, int fq) const {
        bf16_t* O = (bf16_t*)(ws + mkc::WS_ACT); const int ldo = mkc::DFF; const float* ss = (const float*)(ws + (which ? mkc::WS_SS3 : mkc::WS_SS1)); const float invn = 1.0f / 1024.0f;
        const int row0 = u.pm * BM + wr * 64 + fr, col0 = u.pn * HALF + wc * 32 + 8 * fq;
#pragma unroll
        for (int ai = 0; ai < 2; ++ai)
#pragma unroll
            for (int m = 0; m < 4; ++m) { const int row = row0 + ai * HALF + m * 16; const float rs = rs_of(ss, row, invn);
                f32x4 a0, a1;
#pragma unroll
                for (int j = 0; j < 4; ++j) { a0[j] = silu_f(acc[ai][0][m][0][j] * rs) * (acc[ai][1][m][0][j] * rs); a1[j] = silu_f(acc[ai][0][m][1][j] * rs) * (acc[ai][1][m][1][j] * rs); }
                *(u32x4*)(O + (size_t)row * ldo + col0) = pack8(a0, a1); }
    }
};
__device__ __forceinline__ f32x4 bf4_to_f32(const u32x2 w) { f32x4 r; r[0] = __builtin_bit_cast(float, w.x << 16); r[1] = __builtin_bit_cast(float, w.x & 0xFFFF0000u); r[2] = __builtin_bit_cast(float, w.y << 16); r[3] = __builtin_bit_cast(float, w.y & 0xFFFF0000u); return r; }
struct EpiResid {
    static constexpr bool PERM = false, AFTER_DRAIN = false;
    float* out; unsigned char* ws; int ss_off; float alpha;
    __device__ __forceinline__ void operator()(const f32x4 (&acc)[2][2][4][2], const Unit& u, int wr, int wc, int fr, int fq) const {
        bf16_t* xb = (bf16_t*)(ws + mkc::WS_XB); float* ss_out = (float*)(ws + ss_off);
        const int row0 = u.pm * BM + wr * 64 + fr, col0 = u.pn * BM + wc * 32 + 4 * fq;
#pragma unroll
        for (int ai = 0; ai < 2; ++ai)
#pragma unroll
            for (int m = 0; m < 4; ++m) { const int row = row0 + ai * HALF + m * 16; const size_t off = (size_t)row * 1024 + col0; float s = 0.f;
#pragma unroll
                for (int bj = 0; bj < 2; ++bj)
#pragma unroll
                    for (int n = 0; n < 2; ++n) { const f32x4 b = bf4_to_f32(*(const u32x2*)(xb + off + bj * HALF + n * 16)); const f32x4 o = b + acc[ai][bj][m][n] * alpha;
                        if (out) *(f32x4*)(out + off + bj * HALF + n * 16) = o;
                        s += (o[0] * o[0] + o[1] * o[1]) + (o[2] * o[2] + o[3] * o[3]);
                        u32x2 w; w.x = cvt_pk_bf16(o[0], o[1]); w.y = cvt_pk_bf16(o[2], o[3]); *(u32x2*)(xb + off + bj * HALF + n * 16) = w; }
                s += __shfl_xor(s, 16); s += __shfl_xor(s, 32);
                if (fq == 0) atomicAdd(ss_out + row, s);
                asm volatile("" ::: "memory"); }
    }
};
struct EpiWin {
    static constexpr bool PERM = true, AFTER_DRAIN = false;
    unsigned char* ws; int dummy;
    __device__ __forceinline__ void operator()(const f32x4 (&acc)[2][2][4][2], const Unit& u, int wr, int wc, int fr, int fq) const {
        bf16_t* cqkv = (bf16_t*)(ws + mkc::WS_CQKV); bf16_t* mqkv = (bf16_t*)(ws + mkc::WS_MQKV); const float* ss_in = (const float*)(ws + mkc::WS_SS2);
        float* ssq = (float*)(ws + (dummy ? mkc::WS_SSDUMMY : mkc::WS_SSQ)); float* sskv = (float*)(ws + (dummy ? mkc::WS_SSDUMMY + 65536 : mkc::WS_SSKV)); float* kmsum = (float*)(ws + (dummy ? mkc::WS_KMSDUMMY : mkc::WS_KMS));
        const int row0 = u.pm * BM + wr * 64 + fr;
        const bool is_mk = (u.pn == 5 || u.pn == 6);
        f32x4 cs[2][2];
#pragma unroll
        for (int bj = 0; bj < 2; ++bj)
#pragma unroll
            for (int n = 0; n < 2; ++n) cs[bj][n] = (f32x4){0.f, 0.f, 0.f, 0.f};
#pragma unroll
        for (int ai = 0; ai < 2; ++ai)
#pragma unroll
            for (int m = 0; m < 4; ++m) { const int row = row0 + ai * HALF + m * 16; const float rs = rs_of(ss_in, row, 1.0f / 1024.0f);
#pragma unroll
                for (int bj = 0; bj < 2; ++bj) { const int colt = u.pn * BM + bj * HALF, col0 = colt + wc * 32 + 8 * fq;
                    const f32x4 v0 = acc[ai][bj][m][0] * rs, v1 = acc[ai][bj][m][1] * rs;
                    bf16_t* dst = (colt < 768) ? (cqkv + (size_t)row * 768 + col0) : (mqkv + (size_t)row * 1536 + (col0 - 768));
                    *(u32x4*)dst = pack8(v0, v1);
                    if (colt < 640) { float s = (v0[0] * v0[0] + v0[1] * v0[1]) + (v0[2] * v0[2] + v0[3] * v0[3]) + (v1[0] * v1[0] + v1[1] * v1[1]) + (v1[2] * v1[2] + v1[3] * v1[3]);
                        s += __shfl_xor(s, 16); s += __shfl_xor(s, 32);
                        if (fq == 0) atomicAdd((colt < 384 ? ssq : sskv) + row, s); }
                    if (is_mk) { cs[bj][0] += v0; cs[bj][1] += v1; } } }
        if (is_mk) {
#pragma unroll
            for (int bj = 0; bj < 2; ++bj)
#pragma unroll
                for (int n = 0; n < 2; ++n)
#pragma unroll
                    for (int j = 0; j < 4; ++j) { float s = cs[bj][n][j]; s += __shfl_xor(s, 1); s += __shfl_xor(s, 2); s += __shfl_xor(s, 4); s += __shfl_xor(s, 8);
                        if (fr == 0) atomicAdd(kmsum + (size_t)u.pm * 512 + (u.pn * BM + bj * HALF + wc * 32 + 8 * fq + 4 * n + j - 1280), s); }
        }
    }
};
struct EpiKV {
    static constexpr bool PERM = true, AFTER_DRAIN = false;
    unsigned char* ws;
    __device__ __forceinline__ void operator()(const f32x4 (&acc)[2][2][4][2], const Unit& u, int wr, int wc, int fr, int fq) const {
        bf16_t* Kn = (bf16_t*)(ws + mkc::WS_KN); bf16_t* V = (bf16_t*)(ws + mkc::WS_V); const float* ss = (const float*)(ws + mkc::WS_SSKV);
        const int row0 = u.pm * BM + wr * 64 + fr;
#pragma unroll
        for (int ai = 0; ai < 2; ++ai)
#pragma unroll
            for (int m = 0; m < 4; ++m) { const int row = row0 + ai * HALF + m * 16; const float rs = rs_of(ss, row, 1.0f / 256.0f);
#pragma unroll
                for (int bj = 0; bj < 2; ++bj) { const int colt = u.pn * BM + bj * HALF, col0 = colt + wc * 32 + 8 * fq;
                    bf16_t* dst = (colt < 512) ? (Kn + (size_t)row * 512 + col0) : (V + (size_t)row * 512 + (col0 - 512));
                    *(u32x4*)dst = pack8(acc[ai][bj][m][0] * rs, acc[ai][bj][m][1] * rs); } }
    }
};
struct EpiQ {
    static constexpr bool PERM = true, AFTER_DRAIN = false;
    unsigned char* ws;
    __device__ __forceinline__ void operator()(const f32x4 (&acc)[2][2][4][2], const Unit& u, int wr, int wc, int fr, int fq) const {
        bf16_t* Q = (bf16_t*)(ws + mkc::WS_Q); const float* ss = (const float*)(ws + mkc::WS_SSQ); const float* cosT = (const float*)(ws + mkc::WS_COS); const float* sinT = (const float*)(ws + mkc::WS_SIN);
        const int row0 = u.pm * BM + wr * 64 + fr;
#pragma unroll
        for (int ai = 0; ai < 2; ++ai)
#pragma unroll
            for (int m = 0; m < 4; ++m) { const int row = row0 + ai * HALF + m * 16; const float rs = rs_of(ss, row, 1.0f / 384.0f);
#pragma unroll
                for (int bj = 0; bj < 2; ++bj) { const int col0 = u.pn * BM + bj * HALF + wc * 32 + 8 * fq; const int d = col0 % 96;
                    f32x4 v0 = acc[ai][bj][m][0] * rs, v1 = acc[ai][bj][m][1] * rs;
                    if (d >= 64) { const int g = (d - 64) >> 3; const f32x4 c = *(const f32x4*)(cosT + (size_t)row * 16 + 4 * g), s = *(const f32x4*)(sinT + (size_t)row * 16 + 4 * g);
                        const f32x4 o0 = v0 * c - v1 * s, o1 = v0 * s + v1 * c; v0 = o0; v1 = o1; }
                    *(u32x4*)(Q + (size_t)row * 768 + col0) = pack8(v0, v1); }
                asm volatile("" ::: "memory"); }
    }
};
struct EpiResidNorm {
    static constexpr bool PERM = false, AFTER_DRAIN = true;
    float* out; unsigned char* ws; const float* gain; float alpha;
    __device__ __forceinline__ void fused(f32x4 (&acc)[2][2][4][2], const Unit& u, int wr, int wc, int fr, int fq, PG8_LAS unsigned char* lds, int wid, int lane) const {
        float* ss = (float*)(ws + mkc::WS_SS4); unsigned* pcnt = (unsigned*)(ws + mkc::WS_PANEL) + 64 * u.pm; const bf16_t* xb = (const bf16_t*)(ws + mkc::WS_XB);
        const int row0 = u.pm * BM + wr * 64 + fr, col0 = u.pn * BM + wc * 32 + 4 * fq;
#pragma unroll
        for (int ai = 0; ai < 2; ++ai)
#pragma unroll
            for (int m = 0; m < 4; ++m) { const int row = row0 + ai * HALF + m * 16; const size_t off = (size_t)row * 1024 + col0; float s = 0.f;
#pragma unroll
                for (int bj = 0; bj < 2; ++bj)
#pragma unroll
                    for (int n = 0; n < 2; ++n) { const f32x4 b = bf4_to_f32(*(const u32x2*)(xb + off + bj * HALF + n * 16)); const f32x4 o = b + acc[ai][bj][m][n] * alpha; acc[ai][bj][m][n] = o;
                        s += (o[0] * o[0] + o[1] * o[1]) + (o[2] * o[2] + o[3] * o[3]); }
                s += __shfl_xor(s, 16); s += __shfl_xor(s, 32);
                if (fq == 0) atomicAdd(ss + row, s);
                asm volatile("" : "+v"(acc[ai][0][m][0]), "+v"(acc[ai][0][m][1]), "+v"(acc[ai][1][m][0]), "+v"(acc[ai][1][m][1]));
                if (m & 1) asm volatile("" ::: "memory"); }
        asm volatile("s_waitcnt vmcnt(0)" ::: "memory"); __builtin_amdgcn_s_barrier(); asm volatile("" ::: "memory");
        if (wid == 0) {
            if (lane == 0) { __builtin_amdgcn_fence(__ATOMIC_RELEASE, "agent"); asm volatile("s_waitcnt vmcnt(0)" ::: "memory"); __hip_atomic_fetch_add(pcnt, 1u, __ATOMIC_RELAXED, __HIP_MEMORY_SCOPE_AGENT); }
            unsigned spins = 0;
            while ((unsigned)__builtin_amdgcn_readfirstlane(__hip_atomic_load(pcnt, __ATOMIC_RELAXED, __HIP_MEMORY_SCOPE_AGENT)) < 4u) { __builtin_amdgcn_s_sleep(2); if (++spins > (1u << 22)) break; }
            __builtin_amdgcn_fence(__ATOMIC_ACQUIRE, "agent");
        }
        asm volatile("s_waitcnt vmcnt(0) lgkmcnt(0)" ::: "memory"); __builtin_amdgcn_s_barrier(); asm volatile("" ::: "memory");
        f32x4 gv[2][2];
#pragma unroll
        for (int bj = 0; bj < 2; ++bj)
#pragma unroll
            for (int n = 0; n < 2; ++n) gv[bj][n] = *(const f32x4*)(gain + col0 + bj * HALF + n * 16);
#pragma unroll
        for (int ai = 0; ai < 2; ++ai)
#pragma unroll
            for (int m = 0; m < 4; ++m) { const int row = row0 + ai * HALF + m * 16; const size_t off = (size_t)row * 1024 + col0;
                const float tot = __hip_atomic_load(ss + row, __ATOMIC_RELAXED, __HIP_MEMORY_SCOPE_AGENT); const float rs = __builtin_amdgcn_rsqf(tot * (1.0f / 1024.0f) + RMS_EPS);
#pragma unroll
                for (int bj = 0; bj < 2; ++bj)
#pragma unroll
                    for (int n = 0; n < 2; ++n) *(f32x4*)(out + off + bj * HALF + n * 16) = acc[ai][bj][m][n] * rs * gv[bj][n]; }
    }
};

template <class Epi, class Sched, bool ALIGN_EPI = false, bool SP2 = false>
__device__ __forceinline__ void gemm_phase(PG8_LAS unsigned char* lds, const Gemm g, const Sched& S, const Epi& E, const int wid) {
    const int lane = lane_id_v(), tid = wid * 64 + lane, wr = wid >> 2, wc = wid & 3, fr = lane & 15, fq = lane >> 4;
    const int K = g.K, nt = K / BK, lda = g.lda;
    unsigned voffA[2], voffB[2];
#pragma unroll
    for (int i = 0; i < 2; ++i) { int R, C; stage_rc(tid * 16 + i * 8192, R, C); const int Rb = Epi::PERM ? ((R & ~31) + perm32(R & 31)) : R;
        voffA[i] = (unsigned)(R * lda + C) * 2u; voffB[i] = (unsigned)(Rb * K + C) * 2u; }
    const size_t kstep = (size_t)(BK * 2);
    const size_t hstep = (size_t)HALF * K * 2;
    const size_t tstep = 2 * hstep; const size_t hstepA = (size_t)HALF * lda * 2, tstepA = 2 * hstepA;
    const unsigned ldsw = (unsigned)wid * 1024u;
    const int aoff = lds_byte(wr * 64 + fr, fq * 8), boff = lds_byte(wc * 32 + fr, fq * 8);
#define PG8_SA(b, h) (((b) * 2 + (h)) * HTB)
#define PG8_SB(b, h) ((4 + (b) * 2 + (h)) * HTB)
#define PG8_STAGE(bufoff, gbase, voff) do { _Pragma("unroll") for (int _i = 0; _i < 2; ++_i) \
        __builtin_amdgcn_global_load_lds((const unsigned*)((const char*)(gbase) + (voff)[_i]), (PG8_LAS unsigned*)(lds + (bufoff) + ldsw + _i * 8192), 16, 0, 0); } while (0)
#define PG8_LDA(dst, b, h) do { _Pragma("unroll") for (int m = 0; m < 4; ++m) _Pragma("unroll") for (int k = 0; k < 2; ++k) dst[m][k] = *(const PG8_LAS bf16x8*)(lds + PG8_SA(b, h) + aoff + m * 2048 + k * 1024); } while (0)
#define PG8_LDB(dst, b, h) do { _Pragma("unroll") for (int n = 0; n < 2; ++n) _Pragma("unroll") for (int k = 0; k < 2; ++k) dst[n][k] = *(const PG8_LAS bf16x8*)(lds + PG8_SB(b, h) + boff + n * 2048 + k * 1024); } while (0)
#define PG8_MMA(ai, bj, At, Bt) do { __builtin_amdgcn_s_setprio(1); _Pragma("unroll") for (int m = 0; m < 4; ++m) _Pragma("unroll") for (int n = 0; n < 2; ++n) _Pragma("unroll") for (int k = 0; k < 2; ++k) \
        acc[ai][bj][m][n] = __builtin_amdgcn_mfma_f32_16x16x32_bf16(Bt[n][k], At[m][k], acc[ai][bj][m][n], 0, 0, 0); __builtin_amdgcn_s_setprio(0); } while (0)
#define PG8_WAIT_V(n) asm volatile("s_waitcnt vmcnt(" #n ")" ::: "memory")
#define PG8_WAIT_L(n) asm volatile("s_waitcnt lgkmcnt(" #n ")" ::: "memory")
#define PG8_BAR __builtin_amdgcn_s_barrier()
#define PG8_SCHED __builtin_amdgcn_sched_barrier(0)
    Unit cur, nxt; int ui = 0;
    if (!S.next(0, cur)) return;
    f32x4 acc[2][2][4][2];
#pragma unroll
    for (int a = 0; a < 2; ++a)
#pragma unroll
        for (int b = 0; b < 2; ++b)
#pragma unroll
            for (int m = 0; m < 4; ++m)
#pragma unroll
                for (int n = 0; n < 2; ++n) acc[a][b][m][n] = (f32x4){0.f, 0.f, 0.f, 0.f};
    bf16x8 At[4][2], B0[2][2], B1[2][2];
    const char* cA = (const char*)g.A + (size_t)cur.pm * tstepA; const char* cB = (const char*)g.Bt + (size_t)cur.pn * tstep;
    S.a_ready(cur);
    if constexpr (SP2) {
        PG8_STAGE(PG8_SB(0, 0), cB, voffB); PG8_STAGE(PG8_SB(0, 1), cB + hstep, voffB); PG8_STAGE(PG8_SA(0, 0), cA, voffA); PG8_STAGE(PG8_SA(0, 1), cA + hstepA, voffA);
        if (wr == 1) PG8_BAR;
        PG8_WAIT_V(2); PG8_BAR;
        PG8_STAGE(PG8_SB(1, 0), cB + kstep, voffB); PG8_STAGE(PG8_SA(1, 0), cA + kstep, voffA); PG8_STAGE(PG8_SB(1, 1), cB + hstep + kstep, voffB);
        PG8_WAIT_V(6); PG8_BAR;
    } else {
        PG8_STAGE(PG8_SB(0, 0), cB, voffB); PG8_STAGE(PG8_SA(0, 0), cA, voffA); PG8_STAGE(PG8_SB(0, 1), cB + hstep, voffB); PG8_STAGE(PG8_SA(0, 1), cA + hstepA, voffA);
        if (wr == 1) PG8_BAR;
        PG8_WAIT_V(4); PG8_BAR;
        PG8_STAGE(PG8_SB(1, 0), cB + kstep, voffB); PG8_STAGE(PG8_SA(1, 0), cA + kstep, voffA); PG8_STAGE(PG8_SB(1, 1), cB + hstep + kstep, voffB);
        PG8_WAIT_V(6); PG8_BAR;
    }
    for (;;) {
        const bool has_next = S.next(ui + 1, nxt);
        const char* nA = has_next ? (const char*)g.A + (size_t)nxt.pm * tstepA : cA; const char* nB = has_next ? (const char*)g.Bt + (size_t)nxt.pn * tstep : cB;
#pragma nounroll
        for (int t = 0; t < nt; t += 2) {
            const bool last = (t == nt - 2);
            const char* a1 = cA + (size_t)(t + 1) * kstep;
            const char* a2 = last ? nA : cA + (size_t)(t + 2) * kstep; const char* b2 = last ? nB : cB + (size_t)(t + 2) * kstep;
            const char* a3 = a2 + kstep; const char* b3 = b2 + kstep;
            if (last && has_next) S.a_ready(nxt);
            if constexpr (SP2) {
            PG8_LDB(B0, 0, 0); PG8_LDB(B1, 0, 1); PG8_SCHED; PG8_LDA(At, 0, 0); PG8_STAGE(PG8_SA(1, 1), a1 + hstepA, voffA);
            PG8_WAIT_V(8); PG8_WAIT_L(0); PG8_BAR; PG8_MMA(0, 0, At, B0); PG8_MMA(0, 1, At, B1); PG8_BAR; PG8_SCHED;
            PG8_LDA(At, 0, 1); PG8_STAGE(PG8_SB(0, 0), b2, voffB); PG8_STAGE(PG8_SB(0, 1), b2 + hstep, voffB); PG8_STAGE(PG8_SA(0, 0), a2, voffA);
            PG8_WAIT_V(8); PG8_WAIT_L(0); PG8_BAR; PG8_MMA(1, 0, At, B0); PG8_MMA(1, 1, At, B1); PG8_BAR; PG8_SCHED;
            PG8_LDB(B0, 1, 0); PG8_LDB(B1, 1, 1); PG8_SCHED; PG8_LDA(At, 1, 0); PG8_STAGE(PG8_SA(0, 1), a2 + hstepA, voffA);
            PG8_WAIT_V(8); PG8_WAIT_L(0); PG8_BAR; PG8_MMA(0, 0, At, B0); PG8_MMA(0, 1, At, B1); PG8_BAR; PG8_SCHED;
            PG8_LDA(At, 1, 1); PG8_STAGE(PG8_SB(1, 0), b3, voffB); PG8_STAGE(PG8_SB(1, 1), b3 + hstep, voffB); PG8_STAGE(PG8_SA(1, 0), a3, voffA);
            PG8_WAIT_V(8); PG8_WAIT_L(0); PG8_BAR; PG8_MMA(1, 0, At, B0); PG8_MMA(1, 1, At, B1); PG8_BAR; PG8_SCHED;
            } else {
            PG8_LDB(B0, 0, 0); PG8_SCHED; PG8_LDA(At, 0, 0); PG8_STAGE(PG8_SA(1, 1), a1 + hstepA, voffA);
            PG8_WAIT_L(8); PG8_BAR; PG8_WAIT_L(0); PG8_MMA(0, 0, At, B0); PG8_BAR; PG8_SCHED;
            PG8_LDB(B1, 0, 1); PG8_STAGE(PG8_SB(0, 0), b2, voffB);
            PG8_BAR; PG8_WAIT_L(0); PG8_MMA(0, 1, At, B1); PG8_BAR;
            PG8_LDA(At, 0, 1); PG8_STAGE(PG8_SA(0, 0), a2, voffA);
            PG8_BAR; PG8_WAIT_L(0); PG8_MMA(1, 0, At, B0); PG8_BAR; PG8_SCHED;
            PG8_STAGE(PG8_SB(0, 1), b2 + hstep, voffB);
            PG8_WAIT_V(6); PG8_BAR; PG8_MMA(1, 1, At, B1); PG8_BAR;
            PG8_LDB(B0, 1, 0); PG8_SCHED; PG8_LDA(At, 1, 0); PG8_STAGE(PG8_SA(0, 1), a2 + hstepA, voffA);
            PG8_WAIT_L(8); PG8_BAR; PG8_WAIT_L(0); PG8_MMA(0, 0, At, B0); PG8_BAR; PG8_SCHED;
            PG8_LDB(B1, 1, 1); PG8_STAGE(PG8_SB(1, 0), b3, voffB);
            PG8_BAR; PG8_WAIT_L(0); PG8_MMA(0, 1, At, B1); PG8_BAR;
            PG8_LDA(At, 1, 1); PG8_STAGE(PG8_SA(1, 0), a3, voffA);
            PG8_BAR; PG8_WAIT_L(0); PG8_MMA(1, 0, At, B0); PG8_BAR; PG8_SCHED;
            PG8_STAGE(PG8_SB(1, 1), b3 + hstep, voffB);
            PG8_WAIT_V(6); PG8_BAR; PG8_MMA(1, 1, At, B1); PG8_BAR;
            }
        }
        if constexpr (ALIGN_EPI) { if (wr == 0) PG8_BAR; }
        if constexpr (!Epi::AFTER_DRAIN) { E(acc, cur, wr, wc, fr, fq); S.done(cur); }
        if (!has_next) break;
#pragma unroll
        for (int a = 0; a < 2; ++a)
#pragma unroll
            for (int b = 0; b < 2; ++b)
#pragma unroll
                for (int m = 0; m < 4; ++m)
#pragma unroll
                    for (int n = 0; n < 2; ++n) acc[a][b][m][n] = (f32x4){0.f, 0.f, 0.f, 0.f};
        cur = nxt; cA = nA; cB = nB; ++ui;
        if constexpr (ALIGN_EPI) { if (wr == 1) PG8_BAR; }
    }
    PG8_WAIT_V(0);
    if constexpr (!ALIGN_EPI) { if (wr == 0) PG8_BAR; }
    PG8_BAR;
    if constexpr (Epi::AFTER_DRAIN) { E.fused(acc, cur, wr, wc, fr, fq, lds, wid, lane); S.done(cur); }
#undef PG8_SA
#undef PG8_SB
#undef PG8_STAGE
#undef PG8_LDA
#undef PG8_LDB
#undef PG8_MMA
#undef PG8_WAIT_V
#undef PG8_WAIT_L
#undef PG8_BAR
#undef PG8_SCHED
}
}
namespace att {
typedef unsigned short bf16_t;
using bf16x8 = __attribute__((ext_vector_type(8))) short;
using s16x4 = __attribute__((ext_vector_type(4))) short;
using f32x16 = __attribute__((ext_vector_type(16))) float;
using f32x4 = __attribute__((ext_vector_type(4))) float;
using u32x4 = __attribute__((ext_vector_type(4))) unsigned;
typedef short v4i16_t __attribute__((ext_vector_type(4)));
#define ATT_LAS __attribute__((address_space(3)))
typedef ATT_LAS const char* lds_cptr;
constexpr int NW = 8, KVBLK = 64;
constexpr int KSLOT = 12288, VSLOT = 8192, NSLOT = 4;
constexpr int LDS_K = 0, LDS_V = NSLOT * KSLOT, LDS_WS = LDS_V + NSLOT * VSLOT, LDS_OST = LDS_WS + NW * 64 * 4, LDS_POSK = LDS_OST + NW * 4096, LDS_BYTES = LDS_POSK + 1024;
__device__ __forceinline__ int crow(int r, int hi) { return (r & 3) + 8 * (r >> 2) + 4 * hi; }
__device__ __forceinline__ void glds16(const void* gsrc, unsigned lds_dst) { unsigned keep;
    asm volatile("s_mov_b32 %0, m0\n\ts_mov_b32 m0, %2\n\ts_nop 0\n\tglobal_load_lds_dwordx4 %1, off\n\ts_mov_b32 m0, %0" : "=&s"(keep) : "v"(gsrc), "s"(lds_dst) : "memory"); }
typedef float f32x2_t __attribute__((ext_vector_type(2))); typedef __bf16 bf16x2_t __attribute__((ext_vector_type(2)));
__device__ __forceinline__ unsigned cvtpk(float lo, float hi) { f32x2_t v = {lo, hi}; bf16x2_t b = __builtin_convertvector(v, bf16x2_t); return __builtin_bit_cast(unsigned, b); }
__device__ __forceinline__ float att_bf16_up(float x) { unsigned u = __float_as_uint(x); if (u & 0xFFFFu) { u &= 0xFFFF0000u; if (x > 0.f) u += 0x10000u; } return __uint_as_float(u); }
__device__ __forceinline__ s16x4 vtr(lds_cptr p) { return __builtin_bit_cast(s16x4, __builtin_amdgcn_ds_read_tr16_b64_v4i16((ATT_LAS v4i16_t*)p)); }
#define ATT_KS(j) (((j) & (NSLOT - 1)) * KSLOT)
#define ATT_VS(j) (((j) & (NSLOT - 1)) * VSLOT)
#define ATT_WAIT_BAR() asm volatile("s_waitcnt vmcnt(0) lgkmcnt(0)\n\ts_barrier" ::: "memory")
#define ATT_WAIT_BAR_N(three) do { if (three) asm volatile("s_waitcnt vmcnt(3) lgkmcnt(0)\n\ts_barrier" ::: "memory"); else asm volatile("s_waitcnt vmcnt(2) lgkmcnt(0)\n\ts_barrier" ::: "memory"); } while (0)

struct Unit {
    const bf16_t* Q; int q_pitch;
    const bf16_t* K; int k_pitch;
    const bf16_t* Kr;
    const bf16_t* V; int v_pitch;
    int key0, ntiles;
    int q0;
    const unsigned short* list; int len;
    const float* posf;
    float slope2;
    bf16_t* O; int o_pitch;
    bf16_t* part; float* plse; int h;
};

template <int MODE> __device__ __forceinline__ void unit(const Unit& U, char* shm, const int wid) {
    constexpr int DQK = (MODE == 0) ? 96 : 64, ND0 = DQK / 16;
    const int lane = pg8::lane_id_v(), tid = wid * 64 + lane, r32 = lane & 31, hi = lane >> 5;
    const unsigned lds0 = (unsigned)(uintptr_t)shm;
    const lds_cptr shm3 = (lds_cptr)shm;
    ATT_LAS float* wsf = (ATT_LAS float*)(shm3 + LDS_WS) + wid * 64;
    int qrow, slot = 0; bool valid = true;
    if (MODE == 2) { const int e = wid * 32 + r32; valid = e < U.len; const unsigned ent = valid ? (unsigned)U.list[e] : (unsigned)U.list[0]; qrow = (int)(ent & 0x3FFFu); slot = 1 + (int)(ent >> 14); }
    else qrow = U.q0 + wid * 32 + r32;
    const unsigned koff = (unsigned)((U.key0 + 8 * wid + (lane >> 3)) * U.k_pitch + (((lane & 7) ^ ((4 * wid + (lane >> 4)) & 7)) * 8)) * 2u;
    const unsigned kroff = (MODE == 0) ? (unsigned)((U.key0 + 16 * (wid & 3) + (lane >> 2)) * 32 + (((lane & 3) ^ ((lane >> 4) & 3)) * 8)) * 2u : 0u;
    const unsigned voff = (unsigned)((U.key0 + 16 * (wid & 3) + (lane >> 2)) * U.v_pitch + (wid >> 2) * 32 + (lane & 3) * 8) * 2u;
#define ATT_DMA(t, ks, vs) do { glds16((const char*)U.K + koff + (size_t)(t) * (KVBLK * 2) * U.k_pitch, (unsigned)(lds0 + LDS_K + wid * 1024 + (ks))); \
        if (MODE == 0 && wid < 4) glds16((const char*)U.Kr + kroff + (size_t)(t) * (KVBLK * 64), (unsigned)(lds0 + LDS_K + (8 + (wid & 3)) * 1024 + (ks))); \
        glds16((const char*)U.V + voff + (size_t)(t) * (KVBLK * 2) * U.v_pitch, (unsigned)(lds0 + LDS_V + wid * 1024 + (vs))); } while (0)
    const int NT = U.ntiles;
    ATT_DMA(0, 0, 0);
    if (NT > 1) ATT_DMA(1, KSLOT, VSLOT);
    bf16x8 qr[ND0];
    { const bf16_t* Qw = U.Q + (size_t)qrow * U.q_pitch + hi * 8;
#pragma unroll
      for (int d0 = 0; d0 < ND0; ++d0) qr[d0] = *reinterpret_cast<const bf16x8*>(Qw + d0 * 16); }
    float pq = 0.f;
    if (MODE != 0) { pq = U.posf[qrow]; if (tid < 256) ((ATT_LAS float*)(shm3 + LDS_POSK))[tid] = U.posf[U.key0 + tid]; }
    float mhat = -1e30f, l_reg = 0.f; f32x16 o[2]; o[0] = f32x16{}; o[1] = f32x16{};
    const int km_ = (r32 >> 1) & 7, kmr_ = (r32 >> 2) & 3;
    const int ka0 = LDS_K + r32 * 128 + 32 * (km_ >> 1) + 16 * (hi ^ (km_ & 1));
    const int kb0 = LDS_K + 8192 + r32 * 64 + 32 * (kmr_ >> 1) + 16 * (hi ^ (kmr_ & 1));
#define ATT_KADDR(d0, half, KS) (shm3 + (KS) + (((d0) < 4) ? ((ka0 ^ ((d0) << 5)) + (half) * 4096) : ((kb0 ^ (((d0) - 4) << 5)) + (half) * 2048)))
    const lds_cptr vp0 = shm3 + LDS_V + ((lane >> 4) & 1) * 32 + (lane & 3) * 8 + (4 * hi + ((lane & 15) >> 2)) * 64;
#define ATT_QKT(P0, P1, KS) do { P0 = f32x16{}; P1 = f32x16{}; bf16x8 kk_[2 * ND0]; \
        _Pragma("unroll") for (int d0 = 0; d0 < ND0; ++d0) { kk_[2 * d0] = *(const ATT_LAS bf16x8*)ATT_KADDR(d0, 0, KS); kk_[2 * d0 + 1] = *(const ATT_LAS bf16x8*)ATT_KADDR(d0, 1, KS); }     \
        __builtin_amdgcn_sched_barrier(0); \
        _Pragma("unroll") for (int d0 = 0; d0 < ND0; ++d0) { \
            P0 = __builtin_amdgcn_mfma_f32_32x32x16_bf16(kk_[2 * d0], qr[d0], P0, 0, 0, 0); P1 = __builtin_amdgcn_mfma_f32_32x32x16_bf16(kk_[2 * d0 + 1], qr[d0], P1, 0, 0, 0); } } while (0)
#define ATT_SMPV(P0, P1, T, VS) do { \
        if (MODE != 0) { const ATT_LAS float* pk_ = (const ATT_LAS float*)(shm3 + LDS_POSK) + 64 * (T) + 4 * hi; \
            _Pragma("unroll") for (int g = 0; g < 4; ++g) { const f32x4 a_ = *(const ATT_LAS f32x4*)(pk_ + 8 * g), b_ = *(const ATT_LAS f32x4*)(pk_ + 8 * g + 32); \
                _Pragma("unroll") for (int j = 0; j < 4; ++j) { P0[4 * g + j] -= U.slope2 * __builtin_fabsf(pq - a_[j]); P1[4 * g + j] -= U.slope2 * __builtin_fabsf(pq - b_[j]); } } } \
        if (MODE == 0 || MODE == 1) { const int kb_ = U.key0 + 64 * (T); \
            if (kb_ + 63 > U.q0 + wid * 32) { const int dq_ = qrow - kb_ - 4 * hi; \
                _Pragma("unroll") for (int r = 0; r < 16; ++r) { const int c_ = (r & 3) + 8 * (r >> 2); if (c_ > dq_) P0[r] = -INFINITY; if (c_ + 32 > dq_) P1[r] = -INFINITY; } } } \
        float rm_ = P0[0]; \
        _Pragma("unroll") for (int r = 1; r < 16; ++r) rm_ = fmaxf(rm_, P0[r]); \
        _Pragma("unroll") for (int r = 0; r < 16; ++r) rm_ = fmaxf(rm_, P1[r]); \
        { auto rr_ = __builtin_amdgcn_permlane32_swap(__float_as_uint(rm_), __float_as_uint(rm_), false, false); rm_ = fmaxf(__uint_as_float(rr_[0]), __uint_as_float(rr_[1])); } \
        if (__any(rm_ > mhat + 10.0f)) { const float mn_ = fmaxf(mhat, rm_), f_ = __builtin_amdgcn_exp2f(mhat - mn_); mhat = mn_; l_reg *= f_; \
            _Pragma("unroll") for (int r = 0; r < 16; ++r) { o[0][r] *= f_; o[1][r] *= f_; } }                        \
        float sacc_ = 0.f; \
        _Pragma("unroll") for (int r = 0; r < 16; ++r) { P0[r] = __builtin_amdgcn_exp2f(P0[r] - mhat); P1[r] = __builtin_amdgcn_exp2f(P1[r] - mhat); sacc_ += P0[r] + P1[r]; } \
        l_reg += sacc_; \
        u32x4 pw_[4]; \
        _Pragma("unroll") for (int s_ = 0; s_ < 2; ++s_) { \
            pw_[s_] = (u32x4){cvtpk(P0[8 * s_], P0[8 * s_ + 1]), cvtpk(P0[8 * s_ + 2], P0[8 * s_ + 3]), cvtpk(P0[8 * s_ + 4], P0[8 * s_ + 5]), cvtpk(P0[8 * s_ + 6], P0[8 * s_ + 7])}; \
            pw_[2 + s_] = (u32x4){cvtpk(P1[8 * s_], P1[8 * s_ + 1]), cvtpk(P1[8 * s_ + 2], P1[8 * s_ + 3]), cvtpk(P1[8 * s_ + 4], P1[8 * s_ + 5]), cvtpk(P1[8 * s_ + 6], P1[8 * s_ + 7])}; } \
        const lds_cptr vp_ = vp0 + (VS); s16x4 vl_[8], vh_[8]; \
        _Pragma("unroll") for (int i_ = 0; i_ < 8; ++i_) { vl_[i_] = vtr(vp_ + (i_ >> 2) * 4096 + (i_ & 3) * 1024); vh_[i_] = vtr(vp_ + (i_ >> 2) * 4096 + (i_ & 3) * 1024 + 512); }     \
        __builtin_amdgcn_sched_barrier(0); \
        _Pragma("unroll") for (int i_ = 0; i_ < 8; ++i_) { \
            const bf16x8 vf_ = (bf16x8){vl_[i_][0], vl_[i_][1], vl_[i_][2], vl_[i_][3], vh_[i_][0], vh_[i_][1], vh_[i_][2], vh_[i_][3]}; \
            o[i_ >> 2] = __builtin_amdgcn_mfma_f32_32x32x16_bf16(vf_, __builtin_bit_cast(bf16x8, pw_[i_ & 3]), o[i_ >> 2], 0, 0, 0); } } while (0)
#define ATT_ACT(T) (MODE != 1 || (64 * (T) <= wid * 32 + 31))
#define ATT_ITER(SC0, SC1, SN0, SN1, T) do { const bool has_next_ = (T) + 1 < NT; \
        if (has_next_ && ATT_ACT((T) + 1)) ATT_QKT(SN0, SN1, ATT_KS((T) + 1)); \
        if (ATT_ACT(T)) ATT_SMPV(SC0, SC1, T, ATT_VS(T)); \
        if (has_next_ && (MODE == 0 || NT > NSLOT)) { if ((T) + 3 < NT) ATT_WAIT_BAR_N(dma3); else ATT_WAIT_BAR(); if ((T) + 4 < NT) ATT_DMA((T) + 4, ATT_KS(T), ATT_VS(T)); }   \
        } while (0)
    const bool dma3 = (MODE == 0) && wid < 4;
    if (NT > 2) ATT_DMA(2, 2 * KSLOT, 2 * VSLOT);
    if (NT > 3) ATT_DMA(3, 3 * KSLOT, 3 * VSLOT);
    if (MODE == 0 && NT > 3) ATT_WAIT_BAR_N(dma3); else ATT_WAIT_BAR();
    f32x16 pA0, pA1, pB0, pB1;
    ATT_QKT(pA0, pA1, 0);
    int t = 0;
    if (MODE == 0 && NT > 4) {
#define ATT_SB() __builtin_amdgcn_sched_barrier(0)
#define ATT_KLD(i, KS) kf[i] = *(const ATT_LAS bf16x8*)ATT_KADDR((i) >> 1, (i) & 1, KS)
#define ATT_VLD(i, VS) do { vlo[i] = vtr(vp0 + (VS) + ((i) >> 2) * 4096 + ((i) & 3) * 1024); vhi[i] = vtr(vp0 + (VS) + ((i) >> 2) * 4096 + ((i) & 3) * 1024 + 512); } while (0)
#define ATT_SCR(SC0, SC1, j) ((j) < 16 ? SC0[(j) & 15] : SC1[(j) & 15])
#define ATT_EXP4(SC0, SC1, g) do { if ((g) < 4) { _Pragma("unroll") for (int j_ = 0; j_ < 4; ++j_) SC0[4 * (g) + j_] = __builtin_amdgcn_exp2f(SC0[4 * (g) + j_]); } \
                                   else { _Pragma("unroll") for (int j_ = 0; j_ < 4; ++j_) SC1[4 * ((g) - 4) + j_] = __builtin_amdgcn_exp2f(SC1[4 * ((g) - 4) + j_]); } } while (0)
#define ATT_ADD4(SC0, SC1, g) do { if ((g) < 4) sacc_ += (SC0[4 * (g)] + SC0[4 * (g) + 1]) + (SC0[4 * (g) + 2] + SC0[4 * (g) + 3]); else sacc_ += (SC1[4 * ((g) - 4)] + SC1[4 * ((g) - 4) + 1]) + (SC1[4 * ((g) - 4) + 2] + SC1[4 * ((g) - 4) + 3]); } while (0)
#define ATT_CVT4(SC0, SC1, g) do { if ((g) < 4) { pw[(g) >> 1][2 * ((g) & 1)] = cvtpk(SC0[4 * (g)], SC0[4 * (g) + 1]); pw[(g) >> 1][2 * ((g) & 1) + 1] = cvtpk(SC0[4 * (g) + 2], SC0[4 * (g) + 3]); } \
                                   else { pw[(g) >> 1][2 * ((g) & 1)] = cvtpk(SC1[4 * ((g) - 4)], SC1[4 * ((g) - 4) + 1]); pw[(g) >> 1][2 * ((g) & 1) + 1] = cvtpk(SC1[4 * ((g) - 4) + 2], SC1[4 * ((g) - 4) + 3]); } } while (0)
#define ATT_GAPA(i, SC0, SC1, SN0, SN1) do { \
        if (((i) & 1) == 0) SN0 = __builtin_amdgcn_mfma_f32_32x32x16_bf16(kf[i], qr[(i) >> 1], SN0, 0, 0, 0); else SN1 = __builtin_amdgcn_mfma_f32_32x32x16_bf16(kf[i], qr[(i) >> 1], SN1, 0, 0, 0); \
        if ((i) < 8) { ATT_VLD(ATT_PJ(i), vs_); ATT_EXP4(SC0, SC1, i); } \
        if ((i) >= 1 && (i) <= 8) ATT_ADD4(SC0, SC1, (i) - 1); \
        if ((i) >= 2 && (i) <= 9) ATT_CVT4(SC0, SC1, (i) - 2); \
        ATT_SB(); } while (0)
#define ATT_PJ(j) ((((j) & 1) << 2) | ((j) >> 1))
#define ATT_VF(j) (bf16x8){vlo[j][0], vlo[j][1], vlo[j][2], vlo[j][3], vhi[j][0], vhi[j][1], vhi[j][2], vhi[j][3]}
#define ATT_GAPB(j, SN0, SN1) do { \
        o[ATT_PJ(j) >> 2] = __builtin_amdgcn_mfma_f32_32x32x16_bf16(ATT_VF(ATT_PJ(j)), __builtin_bit_cast(bf16x8, pw[ATT_PJ(j) & 3]), o[ATT_PJ(j) >> 2], 0, 0, 0);     \
        if ((j) < 6) { ATT_KLD(2 * (j), ks2_); ATT_KLD(2 * (j) + 1, ks2_); } \
        if ((j) >= 2 && (j) < 6) { const int b_ = 4 * ((j) - 2); ma_ = fmaxf(fmaxf(ma_, SN0[b_]), SN0[b_ + 1]); mb_ = fmaxf(fmaxf(mb_, SN0[b_ + 2]), SN0[b_ + 3]); ma_ = fmaxf(fmaxf(ma_, SN1[b_]), SN1[b_ + 1]); mb_ = fmaxf(fmaxf(mb_, SN1[b_ + 2]), SN1[b_ + 3]); } \
        ATT_SB(); } while (0)
#define ATT_FAST(SC0, SC1, SN0, SN1, T) do { const int vs_ = ATT_VS(T), ks2_ = ATT_KS((T) + 2); \
        { const unsigned long long bal_ = __builtin_amdgcn_ballot_w64(rm > 10.0f); float f_ = 1.f; \
          if (bal_ != 0ull) { const float mn_ = att_bf16_up(mhat + fmaxf(rm, 0.f)), dl_ = mn_ - mhat; f_ = __builtin_amdgcn_exp2f(-dl_); mhat = mn_; l_reg *= f_; \
            _Pragma("unroll") for (int r = 0; r < 16; ++r) { SC0[r] -= dl_; SC1[r] -= dl_; } \
            qx[0] = (hi == 0) ? (short)(__float_as_uint(-mhat) >> 16) : (short)0; } \
            \
          _Pragma("unroll") for (int g_ = 0; g_ < 4; ++g_) { const int d_ = g_ >> 1, b_ = 8 * (g_ & 1); \
            asm volatile("s_cmp_eq_u64 %[b], 0\n\ts_cbranch_scc1 .Lsk%=\n\ts_nop 1\n\tv_mul_f32_e32 %0, %[f], %0\n\tv_mul_f32_e32 %1, %[f], %1\n\tv_mul_f32_e32 %2, %[f], %2\n\tv_mul_f32_e32 %3, %[f], %3\n\t" \
                         "v_mul_f32_e32 %4, %[f], %4\n\tv_mul_f32_e32 %5, %[f], %5\n\tv_mul_f32_e32 %6, %[f], %6\n\tv_mul_f32_e32 %7, %[f], %7\n.Lsk%=:" \
                         : "+v"(o[d_][b_]), "+v"(o[d_][b_ + 1]), "+v"(o[d_][b_ + 2]), "+v"(o[d_][b_ + 3]), "+v"(o[d_][b_ + 4]), "+v"(o[d_][b_ + 5]), "+v"(o[d_][b_ + 6]), "+v"(o[d_][b_ + 7]) \
                         : [f] "v"(f_), [b] "s"(bal_) : "scc"); } } \
        ATT_SB(); \
        float sacc_ = 0.f; \
        SN0 = __builtin_amdgcn_mfma_f32_32x32x16_bf16(kx, qx, f32x16{}, 0, 0, 0); SN1 = __builtin_amdgcn_mfma_f32_32x32x16_bf16(kx, qx, f32x16{}, 0, 0, 0);     \
        ATT_GAPA(0, SC0, SC1, SN0, SN1); ATT_GAPA(1, SC0, SC1, SN0, SN1); ATT_GAPA(2, SC0, SC1, SN0, SN1); ATT_GAPA(3, SC0, SC1, SN0, SN1); \
        ATT_GAPA(4, SC0, SC1, SN0, SN1); ATT_GAPA(5, SC0, SC1, SN0, SN1); ATT_GAPA(6, SC0, SC1, SN0, SN1); ATT_GAPA(7, SC0, SC1, SN0, SN1); \
        ATT_GAPA(8, SC0, SC1, SN0, SN1); ATT_GAPA(9, SC0, SC1, SN0, SN1); ATT_GAPA(10, SC0, SC1, SN0, SN1); ATT_GAPA(11, SC0, SC1, SN0, SN1); \
        l_reg += sacc_; \
        float ma_ = -INFINITY, mb_ = -INFINITY; \
        ATT_GAPB(0, SN0, SN1); ATT_GAPB(1, SN0, SN1); ATT_GAPB(2, SN0, SN1); ATT_GAPB(3, SN0, SN1); ATT_GAPB(4, SN0, SN1); ATT_GAPB(5, SN0, SN1); ATT_GAPB(6, SN0, SN1); ATT_GAPB(7, SN0, SN1); \
        rm = fmaxf(ma_, mb_); \
        { auto rr_ = __builtin_amdgcn_permlane32_swap(__float_as_uint(rm), __float_as_uint(rm), false, false); rm = fmaxf(__uint_as_float(rr_[0]), __uint_as_float(rr_[1])); } \
        ATT_SB(); \
        ATT_WAIT_BAR(); ATT_DMA((T) + 4, ATT_KS(T), vs_); } while (0)
        bf16x8 kf[12]; s16x4 vlo[8], vhi[8]; u32x4 pw[4];
        float rm = pA0[0];
#pragma unroll
        for (int r = 1; r < 16; ++r) rm = fmaxf(rm, pA0[r]);
#pragma unroll
        for (int r = 0; r < 16; ++r) rm = fmaxf(rm, pA1[r]);
        { auto rr_ = __builtin_amdgcn_permlane32_swap(__float_as_uint(rm), __float_as_uint(rm), false, false); rm = fmaxf(__uint_as_float(rr_[0]), __uint_as_float(rr_[1])); }
        mhat = att_bf16_up(rm);
#pragma unroll
        for (int r = 0; r < 16; ++r) { pA0[r] -= mhat; pA1[r] -= mhat; }
        rm -= mhat;
        const bf16x8 kx = (bf16x8){(short)0x3F80, 0, 0, 0, 0, 0, 0, 0};
        bf16x8 qx = (bf16x8){0, 0, 0, 0, 0, 0, 0, 0};
        if (hi == 0) qx[0] = (short)(__float_as_uint(-mhat) >> 16);
#pragma unroll
        for (int i = 0; i < 12; ++i) ATT_KLD(i, KSLOT);
        if (wid >= 4) __builtin_amdgcn_s_setprio(1);
        for (; t + 4 < NT; t += 2) { ATT_FAST(pA0, pA1, pB0, pB1, t); ATT_FAST(pB0, pB1, pA0, pA1, t + 1); }
        if (wid >= 4) __builtin_amdgcn_s_setprio(0);
#pragma unroll
        for (int r = 0; r < 16; ++r) { pA0[r] += mhat; pA1[r] += mhat; }
#undef ATT_FAST
#undef ATT_GAPA
#undef ATT_GAPB
#undef ATT_VF
#undef ATT_PJ
#undef ATT_EXP4
#undef ATT_ADD4
#undef ATT_CVT4
#undef ATT_SCR
#undef ATT_KLD
#undef ATT_VLD
#undef ATT_SB
    }
    for (; t < NT; t += 2) {
        ATT_ITER(pA0, pA1, pB0, pB1, t);
        if (t + 1 < NT) ATT_ITER(pB0, pB1, pA0, pA1, t + 1);
    }
#undef ATT_QKT
#undef ATT_SMPV
#undef ATT_ACT
#undef ATT_ITER
    { auto rr = __builtin_amdgcn_permlane32_swap(__float_as_uint(l_reg), __float_as_uint(l_reg), false, false); l_reg = __uint_as_float(rr[0]) + __uint_as_float(rr[1]); }
    { const float rl = __builtin_amdgcn_rcpf(l_reg);
      bf16_t* prow = U.O + (size_t)(U.q0 + wid * 32 + r32) * U.o_pitch + 8 * hi;
#pragma unroll
      for (int dh = 0; dh < 2; ++dh)
#pragma unroll
        for (int jp = 0; jp < 2; ++jp) {
            unsigned a0 = cvtpk(o[dh][8 * jp] * rl, o[dh][8 * jp + 1] * rl), a1 = cvtpk(o[dh][8 * jp + 2] * rl, o[dh][8 * jp + 3] * rl);
            unsigned b0 = cvtpk(o[dh][8 * jp + 4] * rl, o[dh][8 * jp + 5] * rl), b1 = cvtpk(o[dh][8 * jp + 6] * rl, o[dh][8 * jp + 7] * rl);
            const auto s0 = __builtin_amdgcn_permlane32_swap(a0, b0, false, false); const auto s1 = __builtin_amdgcn_permlane32_swap(a1, b1, false, false);
            *(u32x4*)(prow + 32 * dh + 16 * jp) = (u32x4){s0[0], s1[0], s0[1], s1[1]}; } }
    asm volatile("s_waitcnt vmcnt(0) lgkmcnt(0)\n\ts_barrier" ::: "memory");
#undef ATT_DMA
}
}

namespace att {
constexpr int MB_REG = 65536, MB_TILE = 16384, MB_V = 8192, MB_POSK = 131072, MB_PRE = MB_POSK + 3072, MB_UT = MB_PRE + 2048, MB_NUT = 62, MB_TM = MB_UT + 1024, MB_KB = 140288, MB_ENT = MB_KB + 8192, MB_END = MB_ENT + 2048;
struct MobaCtx { const bf16_t* mqkv; const float* posf; bf16_t* part; float* plse; const unsigned* lists; const unsigned* cnt; int total, vcu, G; };
struct MobaDesc { int own, h, n; };
__device__ __forceinline__ unsigned att_bf16_rne(float f) { unsigned u = __float_as_uint(f); return (u + 0x7fffu + ((u >> 16) & 1u)) >> 16; }
__device__ __forceinline__ float att_bf2f(unsigned b) { return __uint_as_float(b << 16); }
__device__ __forceinline__ void att_split3(float c, unsigned& w1, unsigned& w2) { const unsigned c0 = att_bf16_rne(c); const float r1 = c - att_bf2f(c0); const unsigned c1 = att_bf16_rne(r1); const float r2 = r1 - att_bf2f(c1);
    w1 = c0 | (c1 << 16); w2 = att_bf16_rne(r2); }

__device__ __forceinline__ u32x4 moba_get(const MobaCtx& C, ATT_LAS const int* pre, int i) {
    const int ng = (C.vcu < C.total) ? (C.total - C.vcu + C.G - 1) / C.G : 0;
    if (i < ng) { const int gI = C.vcu + i * C.G; int lo = 0, hi = 511;
        while (lo < hi) { const int mid = (lo + hi) >> 1; if (pre[mid] > gI) hi = mid; else lo = mid + 1; }
        const int hn = lo, c = gI - (hn ? pre[hn - 1] : 0); const int len = (int)C.cnt[hn] - c * 256;
        return (u32x4){1u | ((unsigned)(hn >> 6) << 2) | ((unsigned)(hn & 63) << 5), (unsigned)(len < 256 ? len : 256), (unsigned)hn * 16384u + (unsigned)c * 256u, 0u}; }
    const int u = C.vcu + (i - ng) * C.G; if (u >= 512) return (u32x4){0u, 0u, 0u, 0u};
    return (u32x4){1u | 2u | ((unsigned)(u & 7) << 2) | ((unsigned)(u >> 3) << 5), 256u, 0u, 0u};
}
__device__ __forceinline__ void glds4(const void* gsrc, unsigned lds_dst) { unsigned keep;
    asm volatile("s_mov_b32 %0, m0\n\ts_mov_b32 m0, %2\n\ts_nop 0\n\tglobal_load_lds_dword %1, off\n\ts_mov_b32 m0, %0" : "=&s"(keep) : "v"(gsrc), "s"(lds_dst) : "memory"); }

template <int PROBE> __device__ __forceinline__ void moba_run(const MobaCtx& C, char* shm, const int wid) {
    const int lane = pg8::lane_id_v(), tid = wid * 64 + lane, r32 = lane & 31, hi = lane >> 5;
    const unsigned lds0 = (unsigned)(uintptr_t)shm; const lds_cptr shm3 = (lds_cptr)shm;
    ATT_LAS const int* pre = (ATT_LAS const int*)(shm3 + MB_PRE);
    const float* pmax = C.posf + 16384;
    const int km_ = (r32 >> 1) & 7;
    const int ka0 = r32 * 128 + 32 * (km_ >> 1) + 16 * (hi ^ (km_ & 1));
    const int vpl = MB_V + ((lane >> 4) & 1) * 32 + (lane & 3) * 8 + (4 * hi + ((lane & 15) >> 2)) * 64;
    const unsigned koff = (unsigned)((8 * wid + (lane >> 3)) * 1536 + (((lane & 7) ^ ((4 * wid + (lane >> 4)) & 7)) * 8)) * 2u;
    const unsigned voff = (unsigned)((16 * (wid & 3) + (lane >> 2)) * 1536 + (wid >> 2) * 32 + (lane & 3) * 8) * 2u;
#define MB_UNPACK(X_, D_) do { (D_).own = (int)(((X_) >> 1) & 1u); (D_).h = (int)(((X_) >> 2) & 7u); (D_).n = (PROBE & 4) ? 0 : (int)((X_) >> 5); } while (0)
#define MB_DMA(D_, R_) do { const char* kb_ = (const char*)(C.mqkv + 512 + (D_).h * 64 + (size_t)(D_).n * 256 * 1536); const char* vb_ = kb_ + 1024; \
        unsigned db_ = (unsigned)(lds0 + (R_) + wid * 1024); asm volatile("" : "+s"(db_));     \
        _Pragma("unroll") for (int t_ = 0; t_ < 4; ++t_) { glds16(kb_ + koff + (size_t)t_ * (64 * 1536 * 2), db_ + t_ * MB_TILE); \
                                                           glds16(vb_ + voff + (size_t)t_ * (64 * 1536 * 2), db_ + t_ * MB_TILE + MB_V); } } while (0)
#define MB_FETCH(I_, E_, X_) do { E_ = ((const ATT_LAS u32x4*)(shm3 + MB_UT))[(I_)]; X_ = (unsigned)__builtin_amdgcn_readfirstlane((int)E_[0]); } while (0)
#define MB_SMALL(U_, E_, D_) do { \
        if (!(D_).own) { const int e = wid * 32 + r32; if (hi == 0 && e < (int)E_[1]) glds4(C.lists + E_[2] + e, (unsigned)(lds0 + MB_ENT + ((U_) & 1) * 1024 + wid * 128)); } \
        if (wid < 4) glds4(C.posf + (D_).n * 256 + tid, (unsigned)(lds0 + MB_POSK + ((U_) % 3) * 1024 + wid * 256)); \
        if (tid < 4) glds4(pmax + 4 * (D_).n + tid, (unsigned)(lds0 + MB_TM + ((U_) % 3) * 16)); } while (0)
#define MB_STAGE(U_, D_) do { if (tid < 256) { const ATT_LAS float* pp_ = (const ATT_LAS float*)(shm3 + MB_POSK + ((U_) % 3) * 1024); \
            const float v_ = exp2f(-(float)((D_).h + 1)) * 1.4426950408889634f * (pp_[tid] - pp_[0]); const unsigned vh_ = att_bf16_rne(v_), vl_ = att_bf16_rne(v_ - att_bf2f(vh_)); \
            ((ATT_LAS u32x4*)(shm3 + MB_KB + ((U_) & 1) * 4096))[tid] = (u32x4){vh_ | (vl_ << 16), 0x3F803F80u, 0x00003F80u, 0u}; } } while (0)
#define MB_QROW(U_, E_, D_, META_, QR_, PQ_) do { const int e_ = wid * 32 + r32; \
        if ((D_).own) META_ = (((D_).n * 256 + e_) << 2); \
        else { const unsigned en_ = ((const ATT_LAS unsigned*)(shm3 + MB_ENT + ((U_) & 1) * 1024))[e_]; META_ = (e_ < (int)E_[1]) ? (int)(((en_ & 0x3FFFu) << 2) | (1u + ((en_ >> 14) & 3u))) : -1; } \
        const int qr_ = (PROBE & 4) ? (16128 + e_) : ((META_) >= 0 ? ((META_) >> 2) : 0); const bf16_t* Qw_ = C.mqkv + (D_).h * 64 + (size_t)qr_ * 1536 + hi * 8; \
        _Pragma("unroll") for (int d0 = 0; d0 < 4; ++d0) QR_[d0] = *reinterpret_cast<const bf16x8*>(Qw_ + d0 * 16); PQ_ = C.posf[qr_]; } while (0)
#define MB_CHEAP(U_, D_, META_, PQ_, CM_) do { const f32x4 tm_ = *(const ATT_LAS f32x4*)(shm3 + MB_TM + ((U_) % 3) * 16); CM_ = 0; \
        _Pragma("unroll") for (int t_ = 0; t_ < 4; ++t_) { bool ok_ = __all((META_) < 0 || (PQ_) >= tm_[t_]); if ((D_).own) ok_ = ok_ && (64 * t_ + 63 <= wid * 32); if (ok_) CM_ |= 1 << t_; } } while (0)
  for (int base = 0; ; base += MB_NUT) {
    __syncthreads();
    if (tid < MB_NUT) ((ATT_LAS u32x4*)(shm3 + MB_UT))[tid] = moba_get(C, pre, base + tid);
    if (tid == MB_NUT || tid == MB_NUT + 1) ((ATT_LAS u32x4*)(shm3 + MB_UT))[tid] = (u32x4){0u, 0u, 0u, 0u};
    __syncthreads();
    u32x4 ent_; unsigned xc, xn, xnn = 0u; MobaDesc D, Dn;
    MB_FETCH(0, ent_, xc);
    if (!(xc & 1u)) break;
    MB_UNPACK(xc, D);
    MB_DMA(D, 0); MB_SMALL(0, ent_, D);
    { u32x4 e1_; MB_FETCH(1, e1_, xn); MB_UNPACK(xn, Dn); if (xn & 1u) MB_SMALL(1, e1_, Dn); }
    asm volatile("" ::: "memory"); __builtin_amdgcn_s_waitcnt(0); __builtin_amdgcn_s_barrier(); asm volatile("" ::: "memory");
    int meta = -1, cm = 0; float pq = 0.f, pbase = 0.f; bf16x8 qr[4];
    MB_STAGE(0, D); MB_QROW(0, ent_, D, meta, qr, pq);
    pbase = ((const ATT_LAS float*)(shm3 + MB_POSK))[0];
    asm volatile("" ::: "memory"); __builtin_amdgcn_s_waitcnt(0); __builtin_amdgcn_s_barrier(); asm volatile("" ::: "memory");
    MB_CHEAP(0, D, meta, pq, cm);
    if (xn & 1u) MB_DMA(Dn, MB_REG);
    int i = 0;
    for (; xc & 1u; ++i) {
        int meta_n = -1; float pq_n = 0.f;
        MB_UNPACK(xn, Dn);
        const int cur = i & 1, rb = cur * MB_REG; const float slope2 = exp2f(-(float)(D.h + 1)) * 1.4426950408889634f;
        const bool valid = meta >= 0; const int qrow = valid ? (meta >> 2) : 0, slot = meta & 3;
        const ATT_LAS float* posk = (const ATT_LAS float*)(shm3 + MB_POSK + (i % 3) * 1024);
        const lds_cptr kbx = shm3 + MB_KB + cur * 4096 + r32 * 16;
        float mhat = 0.f, l_reg = 0.f; bool first_ = true; f32x16 o[2]; o[0] = f32x16{}; o[1] = f32x16{};
        unsigned qxa0 = 0u, qxa1 = 0u, qxa2 = 0u, qxr1 = 0u, qxr2 = 0u;
#define MB_QX() do { unsigned a1_, a2_, r1_, r2_; att_split3(-slope2 * (pq - pbase) - mhat, a1_, a2_); att_split3(-mhat, r1_, r2_); \
            qxa0 = hi == 0 ? 0x3F803F80u : 0u; qxa1 = hi == 0 ? a1_ : 0u; qxa2 = hi == 0 ? a2_ : 0u; qxr1 = hi == 0 ? r1_ : 0u; qxr2 = hi == 0 ? r2_ : 0u; } while (0)
        MB_QX();
        f32x16 pA0, pA1, pB0, pB1; float mA = 0.f, mB = 0.f;
#define MB_ACT(T) (!D.own || (64 * (T) <= wid * 32 + 31))
#define MB_CH(T) ((cm >> (T)) & 1)
#define MB_QKT(P0, P1, MR, T) do { bf16x8 kk_[8]; const lds_cptr kb_ = shm3 + rb + (T) * MB_TILE; \
            const bf16x8 kx0_ = *(const ATT_LAS bf16x8*)(kbx + (T) * 1024), kx1_ = *(const ATT_LAS bf16x8*)(kbx + (T) * 1024 + 512); \
            _Pragma("unroll") for (int d0 = 0; d0 < 4; ++d0) { kk_[2 * d0] = *(const ATT_LAS bf16x8*)(kb_ + (ka0 ^ (d0 << 5))); kk_[2 * d0 + 1] = *(const ATT_LAS bf16x8*)(kb_ + (ka0 ^ (d0 << 5)) + 4096); } \
            const bool ch_ = MB_CH(T); const u32x4 qs_ = (u32x4){ch_ ? qxa0 : 0u, ch_ ? qxa1 : qxr1, ch_ ? qxa2 : qxr2, 0u}; \
            __builtin_amdgcn_sched_barrier(0); \
            P0 = __builtin_amdgcn_mfma_f32_32x32x16_bf16(kx0_, __builtin_bit_cast(bf16x8, qs_), f32x16{}, 0, 0, 0); P1 = __builtin_amdgcn_mfma_f32_32x32x16_bf16(kx1_, __builtin_bit_cast(bf16x8, qs_), f32x16{}, 0, 0, 0); \
            _Pragma("unroll") for (int d0 = 0; d0 < 4; ++d0) { P0 = __builtin_amdgcn_mfma_f32_32x32x16_bf16(kk_[2 * d0], qr[d0], P0, 0, 0, 0); P1 = __builtin_amdgcn_mfma_f32_32x32x16_bf16(kk_[2 * d0 + 1], qr[d0], P1, 0, 0, 0); } \
            MR = mhat; } while (0)
#define MB_SMPV(P0, P1, MC, T) do { \
            if (__any(MC != mhat)) { const float d_ = mhat - MC; _Pragma("unroll") for (int r = 0; r < 16; ++r) { P0[r] -= d_; P1[r] -= d_; } }     \
            if (!MB_CH(T)) { const ATT_LAS float* pk_ = posk + 64 * (T) + 4 * hi; \
                _Pragma("unroll") for (int g = 0; g < 4; ++g) { const f32x4 a_ = *(const ATT_LAS f32x4*)(pk_ + 8 * g), b_ = *(const ATT_LAS f32x4*)(pk_ + 8 * g + 32); \
                    _Pragma("unroll") for (int j = 0; j < 4; ++j) { P0[4 * g + j] -= slope2 * __builtin_fabsf(pq - a_[j]); P1[4 * g + j] -= slope2 * __builtin_fabsf(pq - b_[j]); } } } \
            if (D.own && 64 * (T) + 63 > wid * 32) { int dq_ = wid * 32 + r32 - 64 * (T) - 4 * hi; asm volatile("" : "+v"(dq_));     \
                _Pragma("unroll") for (int r = 0; r < 16; ++r) { const int c_ = (r & 3) + 8 * (r >> 2); if (c_ > dq_) P0[r] = -INFINITY; if (c_ + 32 > dq_) P1[r] = -INFINITY; } } \
            float rm_ = P0[0]; \
            _Pragma("unroll") for (int r = 1; r < 16; ++r) rm_ = fmaxf(rm_, P0[r]); \
            _Pragma("unroll") for (int r = 0; r < 16; ++r) rm_ = fmaxf(rm_, P1[r]); \
            { auto rr_ = __builtin_amdgcn_permlane32_swap(__float_as_uint(rm_), __float_as_uint(rm_), false, false); rm_ = fmaxf(__uint_as_float(rr_[0]), __uint_as_float(rr_[1])); } \
            if (first_ || __any(rm_ > 10.0f)) { const float dl_ = first_ ? rm_ : fmaxf(rm_, 0.f); mhat += dl_; \
                _Pragma("unroll") for (int r = 0; r < 16; ++r) { P0[r] -= dl_; P1[r] -= dl_; } \
                if (!first_) { const float f_ = __builtin_amdgcn_exp2f(-dl_); l_reg *= f_; \
                    _Pragma("unroll") for (int r = 0; r < 16; ++r) { o[0][r] *= f_; o[1][r] *= f_; } }                        \
                first_ = false; MB_QX(); } \
            _Pragma("unroll") for (int r = 0; r < 16; ++r) { P0[r] = __builtin_amdgcn_exp2f(P0[r]); P1[r] = __builtin_amdgcn_exp2f(P1[r]); } \
            { float sa_ = 0.f;     \
              _Pragma("unroll") for (int r = 0; r < 16; ++r) { sa_ += P0[r]; sa_ += P1[r]; } \
              l_reg += sa_; } \
            u32x4 pw_[4]; \
            _Pragma("unroll") for (int s_ = 0; s_ < 2; ++s_) { \
                pw_[s_] = (u32x4){cvtpk(P0[8 * s_], P0[8 * s_ + 1]), cvtpk(P0[8 * s_ + 2], P0[8 * s_ + 3]), cvtpk(P0[8 * s_ + 4], P0[8 * s_ + 5]), cvtpk(P0[8 * s_ + 6], P0[8 * s_ + 7])}; \
                pw_[2 + s_] = (u32x4){cvtpk(P1[8 * s_], P1[8 * s_ + 1]), cvtpk(P1[8 * s_ + 2], P1[8 * s_ + 3]), cvtpk(P1[8 * s_ + 4], P1[8 * s_ + 5]), cvtpk(P1[8 * s_ + 6], P1[8 * s_ + 7])}; } \
            const lds_cptr vp_ = shm3 + rb + (T) * MB_TILE + vpl; s16x4 vl_[8], vh_[8]; \
            _Pragma("unroll") for (int i_ = 0; i_ < 8; ++i_) { vl_[i_] = vtr(vp_ + (i_ >> 2) * 4096 + (i_ & 3) * 1024); vh_[i_] = vtr(vp_ + (i_ >> 2) * 4096 + (i_ & 3) * 1024 + 512); } \
            __builtin_amdgcn_sched_barrier(0); \
            _Pragma("unroll") for (int i_ = 0; i_ < 8; ++i_) { \
                const bf16x8 vf_ = (bf16x8){vl_[i_][0], vl_[i_][1], vl_[i_][2], vl_[i_][3], vh_[i_][0], vh_[i_][1], vh_[i_][2], vh_[i_][3]}; \
                o[i_ >> 2] = __builtin_amdgcn_mfma_f32_32x32x16_bf16(vf_, __builtin_bit_cast(bf16x8, pw_[i_ & 3]), o[i_ >> 2], 0, 0, 0); } } while (0)
        if (!(PROBE & 1)) {
        if (MB_ACT(3)) MB_QKT(pA0, pA1, mA, 3);
        if (MB_ACT(2)) MB_QKT(pB0, pB1, mB, 2);
        if (MB_ACT(3)) MB_SMPV(pA0, pA1, mA, 3);
        }
        if (xn & 1u) { MB_STAGE(i + 1, Dn);
            MB_FETCH(i + 2, ent_, xnn); if (xnn & 1u) { MobaDesc Dnn; MB_UNPACK(xnn, Dnn); MB_SMALL(i + 2, ent_, Dnn); } } else xnn = 0u;
        if (!(PROBE & 1)) {
        if (!(PROBE & 64)) if (MB_ACT(1)) MB_QKT(pA0, pA1, mA, 1);
        if (MB_ACT(2)) MB_SMPV(pB0, pB1, mB, 2);
        if (!(PROBE & 64)) MB_QKT(pB0, pB1, mB, 0);
        }
        if (xn & 1u) { MB_FETCH(i + 1, ent_, xn); MB_QROW(i + 1, ent_, Dn, meta_n, qr, pq_n); }
        if (!(PROBE & 1)) {
        if (!(PROBE & 64)) if (MB_ACT(1)) MB_SMPV(pA0, pA1, mA, 1);
        if (!(PROBE & 64)) MB_SMPV(pB0, pB1, mB, 0);
        }
#undef MB_QKT
#undef MB_SMPV
#undef MB_ACT
#undef MB_CH
#undef MB_QX
        asm volatile("" ::: "memory"); __builtin_amdgcn_s_waitcnt(0); __builtin_amdgcn_s_barrier(); asm volatile("" ::: "memory");
        const int h_o = D.h; const bool valid_o = valid; const int qrow_o = qrow, slot_o = slot;
        xc = xn; xn = xnn; D = Dn; meta = meta_n; pq = pq_n;
        if (xc & 1u) { pbase = ((const ATT_LAS float*)(shm3 + MB_POSK + ((i + 1) % 3) * 1024))[0]; MB_CHEAP(i + 1, D, meta, pq, cm); }
        if (xn & 1u) { MobaDesc Dt; MB_UNPACK(xn, Dt); MB_DMA(Dt, cur * MB_REG); }
        { auto rr = __builtin_amdgcn_permlane32_swap(__float_as_uint(l_reg), __float_as_uint(l_reg), false, false); l_reg = __uint_as_float(rr[0]) + __uint_as_float(rr[1]); }
        { const float rl = __builtin_amdgcn_rcpf(l_reg);
          bf16_t* prow = C.part + ((((size_t)(qrow_o * 8 + h_o) * 4 + slot_o) * 64) & (PROBE ? ((PROBE & 4) ? (size_t)0x3FFC0 : (size_t)0x7FFFC0) : ~(size_t)0)) + 8 * hi;
#pragma unroll
          for (int dh = 0; dh < 2; ++dh)
#pragma unroll
            for (int jp = 0; jp < 2; ++jp) {
                unsigned a0 = cvtpk(o[dh][8 * jp] * rl, o[dh][8 * jp + 1] * rl), a1 = cvtpk(o[dh][8 * jp + 2] * rl, o[dh][8 * jp + 3] * rl);
                unsigned b0 = cvtpk(o[dh][8 * jp + 4] * rl, o[dh][8 * jp + 5] * rl), b1 = cvtpk(o[dh][8 * jp + 6] * rl, o[dh][8 * jp + 7] * rl);
                const auto s0 = __builtin_amdgcn_permlane32_swap(a0, b0, false, false); const auto s1 = __builtin_amdgcn_permlane32_swap(a1, b1, false, false);
                if (!(PROBE & 2)) if (valid_o) *(u32x4*)(prow + 32 * dh + 16 * jp) = (u32x4){s0[0], s1[0], s0[1], s1[1]}; }
          if (!(PROBE & 2)) if (hi == 0 && valid_o) C.plse[(size_t)(qrow_o * 8 + h_o) * 4 + slot_o] = mhat + __builtin_log2f(l_reg); }
    }
    if (i < MB_NUT) break;
  }
#undef MB_UNPACK
#undef MB_DMA
#undef MB_FETCH
#undef MB_SMALL
#undef MB_STAGE
#undef MB_QROW
#undef MB_CHEAP
}
}

namespace xb {
#define LAS __attribute__((address_space(3)))
#define XB_TMO      128
#define XB_XCNT(j)  (256  + 64 * (j))
#define XB_XSUB(j)  (1280 + 64 * (j))
#define XB_XGEN(j)  (2304 + 64 * (j))
#define XB_TOP      3328
#define XB_TOPGEN   3392
#define XCD_BAR_WORDS 3456
#define XB_SPIN_CAP (1u << 21)

__device__ __forceinline__ unsigned xb_ld(unsigned* p)              { return __hip_atomic_load(p, __ATOMIC_RELAXED, __HIP_MEMORY_SCOPE_AGENT); }
__device__ __forceinline__ unsigned xb_add(unsigned* p, unsigned v) { return __hip_atomic_fetch_add(p, v, __ATOMIC_RELAXED, __HIP_MEMORY_SCOPE_AGENT); }
__device__ __forceinline__ unsigned xb_xcc_id() { return (unsigned)__builtin_amdgcn_s_getreg((3 << 11) | 20) & 0xFu; }
#define XB_SPIN(cond, bar) do { unsigned _sp = 0; while (cond) { __builtin_amdgcn_s_sleep(1); \
    if ((++_sp & 255u) == 0u) { if (xb_ld(&(bar)[XB_TMO])) break; if (_sp > XB_SPIN_CAP) { atomicAdd(&(bar)[XB_TMO], 1u); break; } } } } while (0)

struct XcdBarrier {
    unsigned* bar; unsigned x;
    volatile LAS unsigned* st;
};

__device__ __forceinline__ XcdBarrier xcd_barrier_post(unsigned* bar, volatile LAS unsigned* st, bool leader) {
    XcdBarrier b; b.bar = bar; b.x = xb_xcc_id(); b.st = st;
    if (leader) (void)xb_add(&bar[XB_XCNT(b.x)], 1u);
    return b;
}
__device__ __forceinline__ void xcd_barrier_complete(unsigned* bar, unsigned x, unsigned& nloc, unsigned& nx) {
    const unsigned G = gridDim.x * gridDim.y * gridDim.z;
    unsigned sum, cnt, mine, sp = 0u;
    for (;;) {
        sum = 0u; cnt = 0u; mine = 0u;
#pragma unroll
        for (unsigned j = 0; j < 16; ++j) { const unsigned c = xb_ld(&bar[XB_XCNT(j)]); sum += c; cnt += (c > 0u) ? 1u : 0u; mine = (j == x) ? c : mine; }
        if (sum == G) break;
        __builtin_amdgcn_s_sleep(1);
        if ((++sp & 255u) == 0u) { if (xb_ld(&bar[XB_TMO])) break; if (sp > XB_SPIN_CAP) { atomicAdd(&bar[XB_TMO], 1u); break; } }
    }
    nloc = mine > 0u ? mine : 1u; nx = cnt > 0u ? cnt : 1u;
}

__device__ __forceinline__ void xcd_barrier(const XcdBarrier& b, bool leader) {
    asm volatile("s_waitcnt vmcnt(0)" ::: "memory");
    __syncthreads();
    if (leader) {
        unsigned* bar = b.bar;
        __builtin_amdgcn_s_waitcnt(0);
        unsigned nloc = b.st[0], nx = b.st[1];
        if (nloc == 0u) { xcd_barrier_complete(bar, b.x, nloc, nx); b.st[0] = nloc; b.st[1] = nx; }
        const unsigned old = xb_add(&bar[XB_XSUB(b.x)], 1u);
        const unsigned gen = old / nloc;
        if (old + 1u == (gen + 1u) * nloc) {
            __builtin_amdgcn_fence(__ATOMIC_RELEASE, "agent");
            asm volatile("s_waitcnt vmcnt(0)" ::: "memory");
            const unsigned og = xb_add(&bar[XB_TOP], 1u);
            const unsigned tg = og / nx;
            if (og + 1u == (tg + 1u) * nx) xb_add(&bar[XB_TOPGEN], 1u);
            else XB_SPIN(xb_ld(&bar[XB_TOPGEN]) == tg, bar);
            __builtin_amdgcn_fence(__ATOMIC_ACQUIRE, "agent");
            xb_add(&bar[XB_XGEN(b.x)], 1u);
            asm volatile("s_waitcnt vmcnt(0)" ::: "memory");
        } else {
            XB_SPIN(xb_ld(&bar[XB_XGEN(b.x)]) == gen, bar);
            __builtin_amdgcn_fence(__ATOMIC_ACQUIRE, "agent");
            asm volatile("s_waitcnt vmcnt(0)" ::: "memory");
        }
    }
    __syncthreads();
}

#undef LAS
}
namespace mk {
typedef unsigned short bf16;
typedef unsigned v4u __attribute__((ext_vector_type(4)));
typedef float f32x4 __attribute__((ext_vector_type(4)));
#define MK_LAS __attribute__((address_space(3)))
using namespace mkc;
constexpr int NWAVES = 8;
constexpr int RING_BYTES = 131072, LDS_EXTRA = RING_BYTES, LDS_MISC = RING_BYTES + 8192, LDS_BYTES = 150528;
constexpr size_t WS_BAR = 4096, BAR_BYTES = 32768;

struct Args { const float* in[18]; float* out; unsigned char* ws; int ph_lo, ph_hi; };
struct Frame { MK_LAS unsigned char* lds; int tid, lane, wave, vcu, G; };
typedef const __attribute__((address_space(4))) Args* kargs_t;
__device__ __forceinline__ kargs_t kargs() { kargs_t p = (kargs_t)__builtin_amdgcn_kernarg_segment_ptr(); asm volatile("" : "+s"(p)); return p; }
__device__ __forceinline__ Frame mkframe(MK_LAS unsigned char* lds, int wave) { Frame F; F.lds = lds; F.wave = wave; F.lane = pg8::lane_id_v(); F.tid = wave * 64 + F.lane; F.G = gridDim.x;
    { const int bx = blockIdx.x; F.vcu = (F.G % 8 == 0) ? (bx % 8) * (F.G / 8) + bx / 8 : bx; } return F; }

__device__ __forceinline__ unsigned f2bf(float f) { unsigned u = __builtin_bit_cast(unsigned, f); return (u + 0x7fffu + ((u >> 16) & 1u)) >> 16; }
__device__ __forceinline__ unsigned pk2(float lo, float hi) { return f2bf(lo) | (f2bf(hi) << 16); }
__device__ __forceinline__ float bf2f(unsigned short b) { return __builtin_bit_cast(float, (unsigned)b << 16); }
__device__ __forceinline__ float wave_sum(float v) {
#pragma unroll
    for (int o = 1; o < 64; o <<= 1) v += __shfl_xor(v, o);
    return v;
}
__constant__ float ROPE_INV[16] = {1.000000000e+00f, 5.623413324e-01f, 3.162277639e-01f, 1.778279394e-01f, 1.000000015e-01f, 5.623413250e-02f, 3.162277490e-02f, 1.778279431e-02f,
                                   9.999999776e-03f, 5.623413250e-03f, 3.162277630e-03f, 1.778279431e-03f, 1.000000047e-03f, 5.623413017e-04f, 3.162277571e-04f, 1.778279402e-04f};
__device__ __forceinline__ int rope_phys(int L) { return L < 16 ? 8 * (L >> 2) + (L & 3) : 8 * ((L - 16) >> 2) + 4 + ((L - 16) & 3); }

__device__ __forceinline__ void p0_item(const float* W, int K, int N, bf16* WT, const float* gain, int kind, MK_LAS float* scr, int item, int lane) {
    const int nblk = N / 32, kb = item / nblk, nb = item % nblk, k0 = 64 * kb, n0 = 32 * nb;
    int dbase = n0; bool perm = false; float mul = 1.0f;
    if (kind == 1) dbase = (n0 >> 7) * 256 + (n0 & 127);
    else if (kind == 2) dbase = (n0 >> 7) * 256 + 128 + (n0 & 127);
    else if (kind == 3) { if (n0 == 640) perm = true; else if (n0 >= 672) { dbase = n0 + 96; if (n0 < 1184) mul = C2M; } }
    else if (kind == 4) { perm = (n0 % 96) == 64; mul = C2Q; }
    else if (kind == 5) { const int h = n0 >> 7, e = n0 & 127; dbase = e < 64 ? h * 64 + e : 512 + h * 64 + (e - 64); }
    float wv[32];
#pragma unroll
    for (int i = 0; i < 32; ++i) wv[i] = W[(size_t)(k0 + 2 * i + (lane >> 5)) * N + n0 + (lane & 31)];
#pragma unroll
    for (int i = 0; i < 32; ++i) { const int kk = 2 * i + (lane >> 5); const float g = gain ? gain[k0 + kk] * mul : mul; scr[kk * 33 + (lane & 31)] = wv[i] * g; }
    asm volatile("s_waitcnt lgkmcnt(0)" ::: "memory");
    const int c = lane & 7;
#pragma unroll
    for (int j = 0; j < 4; ++j) { const int n = (lane >> 3) + 8 * j; const MK_LAS float* s = scr + (8 * c) * 33 + n;
        v4u o; o.x = pk2(s[0 * 33], s[1 * 33]); o.y = pk2(s[2 * 33], s[3 * 33]); o.z = pk2(s[4 * 33], s[5 * 33]); o.w = pk2(s[6 * 33], s[7 * 33]);
        const int drow = dbase + (perm ? rope_phys(n) : n);
        *(v4u*)(WT + (size_t)drow * K + k0 + 8 * c) = o; }
    asm volatile("s_waitcnt lgkmcnt(0)" ::: "memory");
}
constexpr int I_G = (DM / 64) * (DFF / 32), I_D = (DFF / 64) * (DM / 32), I_IN = (DM / 64) * (2208 / 32), I_UQ = (384 / 64) * (768 / 32), I_UKV = (256 / 64) * (1024 / 32), I_O = (DM / 64) * (DM / 32);
constexpr int NITEMS = 4 * I_G + 2 * I_D + I_IN + I_UQ + I_UKV + I_O;
__device__ __forceinline__ void p0_one_item(kargs_t ap, unsigned char* ws, MK_LAS float* scr, int it, int lane) {
    int r = it;
    if (r < I_G) { p0_item(ap->in[3], DM, DFF, (bf16*)(ws + WS_WGU1), ap->in[2], 1, scr, r, lane); return; } r -= I_G;
    if (r < I_G) { p0_item(ap->in[4], DM, DFF, (bf16*)(ws + WS_WGU1), ap->in[2], 2, scr, r, lane); return; } r -= I_G;
    if (r < I_D) { p0_item(ap->in[5], DFF, DM, (bf16*)(ws + WS_WD1), nullptr, 0, scr, r, lane); return; } r -= I_D;
    if (r < I_G) { p0_item(ap->in[14], DM, DFF, (bf16*)(ws + WS_WGU2), ap->in[13], 1, scr, r, lane); return; } r -= I_G;
    if (r < I_G) { p0_item(ap->in[15], DM, DFF, (bf16*)(ws + WS_WGU2), ap->in[13], 2, scr, r, lane); return; } r -= I_G;
    if (r < I_D) { p0_item(ap->in[16], DFF, DM, (bf16*)(ws + WS_WD2), nullptr, 0, scr, r, lane); return; } r -= I_D;
    if (r < I_IN) { p0_item(ap->in[7], DM, 2208, (bf16*)(ws + WS_WIN), ap->in[6], 3, scr, r, lane); return; } r -= I_IN;
    if (r < I_UQ) { p0_item(ap->in[9], 384, 768, (bf16*)(ws + WS_WUQ), ap->in[8], 4, scr, r, lane); return; } r -= I_UQ;
    if (r < I_UKV) { p0_item(ap->in[11], 256, 1024, (bf16*)(ws + WS_WUKV), ap->in[10], 5, scr, r, lane); return; } r -= I_UKV;
    p0_item(ap->in[12], DM, DM, (bf16*)(ws + WS_WOUT), nullptr, 0, scr, r, lane);
}
__device__ __forceinline__ void p0_tables_and_zero(kargs_t ap, const int gt, const int NGT) {
    unsigned char* ws = ap->ws;
    const int* pos = (const int*)ap->in[1]; float* posf = (float*)(ws + WS_POSF); float* cosT = (float*)(ws + WS_COS); float* sinT = (float*)(ws + WS_SIN);
    for (int e = gt; e < S * 16; e += NGT) { const int s_ = e >> 4, i = e & 15; const float ang = (float)pos[s_] * ROPE_INV[i]; float sn, cs; sincosf(ang, &sn, &cs); cosT[e] = cs; sinT[e] = sn; if (i == 0) posf[s_] = (float)pos[s_]; }
    for (int e = gt >> 6; e < S / 64; e += NGT >> 6) { int m_ = pos[64 * e + (gt & 63)];
#pragma unroll
        for (int o_ = 1; o_ < 64; o_ <<= 1) m_ = max(m_, __shfl_xor(m_, o_)); if ((gt & 63) == 0) posf[S + e] = (float)m_; }
    float* z = (float*)(ws + WS_SS2);
    for (int e = gt; e < 5 * S; e += NGT) z[e] = 0.f;
    float* km = (float*)(ws + WS_KMS);
    for (int e = gt; e < 64 * 512; e += NGT) km[e] = 0.f;
    unsigned* cnt = (unsigned*)(ws + WS_CNT);
    for (int e = gt; e < 512; e += NGT) cnt[e] = 0u;
    unsigned* padz = (unsigned*)((bf16*)(ws + WS_WIN) + (size_t)672 * DM);
    for (int e = gt; e < 96 * DM / 2; e += NGT) padz[e] = 0u;
}
__device__ __forceinline__ void p0_late_items(const Frame& F, kargs_t ap) {
    unsigned char* ws = ap->ws; MK_LAS float* scr = (MK_LAS float*)(F.lds + F.wave * 16384);
    const int w = ((int)blockIdx.x - 128) * NWAVES + F.wave, NW_ = 128 * NWAVES;
    for (int it = 2 * I_G + w; it < NITEMS; it += NW_) p0_one_item(ap, ws, scr, it, F.lane);
    p0_tables_and_zero(ap, w * 64 + F.lane, NW_ * 64);
}
__device__ __forceinline__ void p0_prologue(const Frame& F, kargs_t ap) {
    unsigned char* ws = ap->ws;
    MK_LAS float* scr = (MK_LAS float*)(F.lds + F.wave * 16384);
    const int gw = F.vcu * NWAVES + F.wave, NGW = F.G * NWAVES;
    constexpr int N_EARLY = 2 * I_G;
    const int n_here = (F.G == 256) ? N_EARLY : NITEMS;
    for (int it = gw; it < n_here; it += NGW) p0_one_item(ap, ws, scr, it, F.lane);
    const float* x = ap->in[0]; bf16* xb = (bf16*)(ws + WS_XB); float* ss1 = (float*)(ws + WS_SS1);
    for (int m = gw; m < S; m += 4 * NGW) {
        f32x4 v[4][4];
#pragma unroll
        for (int r = 0; r < 4; ++r) { const int mr = m + r * NGW; if (mr < S) { const f32x4* xr = (const f32x4*)(x + (size_t)mr * DM) + F.lane;
#pragma unroll
            for (int j = 0; j < 4; ++j) v[r][j] = xr[64 * j]; } }
#pragma unroll
        for (int r = 0; r < 4; ++r) { const int mr = m + r * NGW; if (mr < S) { unsigned long long* o8 = (unsigned long long*)(xb + (size_t)mr * DM) + F.lane; float s = 0.f;
#pragma unroll
            for (int j = 0; j < 4; ++j) { const f32x4 w = v[r][j]; s += (w[0] * w[0] + w[1] * w[1]) + (w[2] * w[2] + w[3] * w[3]); o8[64 * j] = (unsigned long long)pk2(w[0], w[1]) | ((unsigned long long)pk2(w[2], w[3]) << 32); }
            s = wave_sum(s); if (F.lane == 0) ss1[mr] = s; } }
    }
    if (F.G != 256) p0_tables_and_zero(ap, (F.vcu * NWAVES + F.wave) * 64 + F.lane, NGW * 64);
}

__device__ __forceinline__ void p4_krope(const Frame& F, kargs_t ap) { unsigned char* const wsb = ap->ws;
    const bf16* cqkv = (const bf16*)(wsb + WS_CQKV); bf16* Kr = (bf16*)(wsb + WS_KR); const float* cosT = (const float*)(wsb + WS_COS); const float* sinT = (const float*)(wsb + WS_SIN);
    const int gt = (F.vcu * NWAVES + F.wave) * 64 + F.lane, NGT = F.G * NWAVES * 64;
    for (int e = gt; e < S * 16; e += NGT) { const int s_ = e >> 4, i = e & 15, g = i >> 2, j = i & 3;
        const float x1 = bf2f(cqkv[(size_t)s_ * 768 + 640 + 8 * g + j]), x2 = bf2f(cqkv[(size_t)s_ * 768 + 640 + 8 * g + 4 + j]); const float c = cosT[e], sn = sinT[e];
        Kr[(size_t)s_ * 32 + 8 * g + j] = (bf16)f2bf(x1 * c - x2 * sn); Kr[(size_t)s_ * 32 + 8 * g + 4 + j] = (bf16)f2bf(x1 * sn + x2 * c); }
}
__device__ __forceinline__ void p4_gating(const Frame& F, kargs_t ap) { unsigned char* const wsb = ap->ws;
    const bf16* mqkv = (const bf16*)(wsb + WS_MQKV); const float* kms = (const float*)(wsb + WS_KMS); unsigned* cnt = (unsigned*)(wsb + WS_CNT); unsigned* lists = (unsigned*)(wsb + WS_LIST);
    MK_LAS float* km = (MK_LAS float*)F.lds;
    const int u0 = (F.G == 256) ? ((int)blockIdx.x < 192 ? (int)blockIdx.x : 256) : F.vcu, ustep = (F.G == 256) ? 192 : F.G;
    for (int u = u0; u < 256; u += ustep) {
        const int h = u & 7, q = (u >> 3) * 512 + F.tid, own = q >> 8;
        __syncthreads();
        for (int e = F.tid; e < 4096; e += 512) km[e] = kms[(size_t)(e >> 6) * 512 + h * 64 + (e & 63)] * (1.0f / 256.0f);
        __syncthreads();
        float qv[64];
        { const v4u* qp = (const v4u*)(mqkv + (size_t)q * 1536 + h * 64);
#pragma unroll
          for (int c = 0; c < 8; ++c) { const v4u w = qp[c];
#pragma unroll
              for (int j = 0; j < 4; ++j) { qv[8 * c + 2 * j] = __builtin_bit_cast(float, w[j] << 16); qv[8 * c + 2 * j + 1] = __builtin_bit_cast(float, w[j] & 0xFFFF0000u); } } }
        float g0 = -3e38f, g1 = -3e38f, g2 = -3e38f; int i0 = -1, i1 = -1, i2 = -1;
        const int own_max = __builtin_amdgcn_readfirstlane(own);
        for (int n = 0; n < own_max; ++n) {
            float g = 0.f;
#pragma unroll
            for (int c = 0; c < 16; ++c) { const f32x4 kk = *(const MK_LAS f32x4*)(km + n * 64 + 4 * c); g = fmaf(qv[4 * c], kk[0], g); g = fmaf(qv[4 * c + 1], kk[1], g); g = fmaf(qv[4 * c + 2], kk[2], g); g = fmaf(qv[4 * c + 3], kk[3], g); }
            if (g > g0) { g2 = g1; i2 = i1; g1 = g0; i1 = i0; g0 = g; i0 = n; }
            else if (g > g1) { g2 = g1; i2 = i1; g1 = g; i1 = n; }
            else if (g > g2) { g2 = g; i2 = n; }
        }
        MK_LAS unsigned* lcnt = (MK_LAS unsigned*)(F.lds + 16384);
        __syncthreads();
        if (F.tid < 64) lcnt[F.tid] = 0u;
        __syncthreads();
        unsigned r0 = 0u, r1 = 0u, r2 = 0u;
        if (i0 >= 0) r0 = __hip_atomic_fetch_add(lcnt + i0, 1u, __ATOMIC_RELAXED, __HIP_MEMORY_SCOPE_WORKGROUP);
        if (i1 >= 0) r1 = __hip_atomic_fetch_add(lcnt + i1, 1u, __ATOMIC_RELAXED, __HIP_MEMORY_SCOPE_WORKGROUP);
        if (i2 >= 0) r2 = __hip_atomic_fetch_add(lcnt + i2, 1u, __ATOMIC_RELAXED, __HIP_MEMORY_SCOPE_WORKGROUP);
        __syncthreads();
        if (F.tid < 64) { const unsigned c = lcnt[F.tid]; lcnt[64 + F.tid] = c ? atomicAdd(cnt + h * 64 + F.tid, c) : 0u; }
        __syncthreads();
        if (i0 >= 0) lists[(size_t)(h * 64 + i0) * S + lcnt[64 + i0] + r0] = (unsigned)(q | (0 << 14));
        if (i1 >= 0) lists[(size_t)(h * 64 + i1) * S + lcnt[64 + i1] + r1] = (unsigned)(q | (1 << 14));
        if (i2 >= 0) lists[(size_t)(h * 64 + i2) * S + lcnt[64 + i2] + r2] = (unsigned)(q | (2 << 14));
    }
    __syncthreads();
}
__device__ __forceinline__ void p5_combine(const Frame& F, kargs_t ap) { unsigned char* const wsb = ap->ws;
    const bf16* part = (const bf16*)ap->out;     const float* plse = (const float*)(wsb + WS_PLSE); bf16* cat = (bf16*)(wsb + WS_CAT);
    const int gt = (F.vcu * NWAVES + F.wave) * 64 + F.lane, NGT = F.G * NWAVES * 64;
    for (int e = gt; e < S * 8 * 8; e += NGT) { const int dg = e & 7, qh = e >> 3, q = qh >> 3, h = qh & 7; const int ns = 1 + min(3, q >> 8);
        const f32x4 ls = *(const f32x4*)(plse + (size_t)qh * 4);
        float M = ls[0]; for (int s = 1; s < 4; ++s) if (s < ns) M = fmaxf(M, ls[s]);
        float acc[8], wsum = 0.f;
#pragma unroll
        for (int j = 0; j < 8; ++j) acc[j] = 0.f;
#pragma unroll
        for (int s = 0; s < 4; ++s) if (s < ns) { const float w = __builtin_amdgcn_exp2f(ls[s] - M); wsum += w; const v4u v = *(const v4u*)(part + ((size_t)qh * 4 + s) * 64 + dg * 8);
#pragma unroll
            for (int j = 0; j < 4; ++j) { acc[2 * j] += w * __builtin_bit_cast(float, v[j] << 16); acc[2 * j + 1] += w * __builtin_bit_cast(float, v[j] & 0xFFFF0000u); } }
        const float r = 1.0f / wsum; v4u o; o.x = pk2(acc[0] * r, acc[1] * r); o.y = pk2(acc[2] * r, acc[3] * r); o.z = pk2(acc[4] * r, acc[5] * r); o.w = pk2(acc[6] * r, acc[7] * r);
        *(v4u*)(cat + (size_t)q * 1024 + 512 + h * 64 + dg * 8) = o; }
}
__device__ __forceinline__ void p9_final(const Frame& F, kargs_t ap) { unsigned char* const wsb = ap->ws;
    const float* ss = (const float*)(wsb + WS_SS4); const float* g = ap->in[17];
    const int gw = F.vcu * NWAVES + F.wave, NGW = F.G * NWAVES;
    float tsc = 1.0f;
#ifdef MK_TS
    { const unsigned long long* ts = (const unsigned long long*)(wsb + 2048); tsc = 1.0f + (float)(ts[MK_TS + 1] - ts[MK_TS]) * (float)MK_TS_SCALE; }
#endif
    for (int m = gw; m < S; m += NGW) { const float rs = tsc / sqrtf(ss[m] * (1.0f / 1024.0f) + 1e-6f); f32x4* xr = (f32x4*)(ap->out + (size_t)m * DM) + F.lane; const f32x4* gr = (const f32x4*)g + F.lane;
#pragma unroll
        for (int j = 0; j < 4; ++j) { const f32x4 v = xr[64 * j]; xr[64 * j] = v * rs * gr[64 * j]; } }
}

__global__ void __launch_bounds__(NWAVES * 64, 2) mk_fwd(Args a_unused) {
    extern __shared__ __attribute__((aligned(16))) unsigned char lds[];
    const int wave = __builtin_amdgcn_readfirstlane(threadIdx.x >> 6);
    MK_LAS unsigned char* const ldsp = (MK_LAS unsigned char*)lds;
    int lo, hi; { kargs_t ap = kargs(); lo = ap->ph_lo; hi = ap->ph_hi; }
#ifndef MK_ONLY
#define MK_ONLY -1
#endif
#define IN(k) ((MK_ONLY < 0 || MK_ONLY == (k)) && lo <= (k) && (k) < hi)
    const bool multi = (hi - lo) > 1;
    if (multi) {
        const int l0 = pg8::lane_id_v();
        if (wave == 0 && l0 < 2) ((volatile MK_LAS unsigned*)(ldsp + LDS_MISC))[l0] = 0u;
        __syncthreads();
        kargs_t ap = kargs(); (void)xb::xcd_barrier_post((unsigned*)(ap->ws + WS_BAR), (volatile MK_LAS unsigned*)(ldsp + LDS_MISC), wave == 0 && l0 == 0);
    }
    if (lo < -1) cg::this_grid().sync();
#ifdef MK_TS
#define MK_STAMP(i) do { if (blockIdx.x == 0 && wave == 0 && pg8::lane_id_v() == 0) { kargs_t ap__ = kargs(); ((unsigned long long*)(ap__->ws + 2048))[(i)] = __builtin_amdgcn_s_memrealtime(); } } while (0)
#else
#define MK_STAMP(i) do { } while (0)
#endif
    MK_STAMP(0);
#define SEAM(k) do { if (IN(k) && IN((k) + 1)) { kargs_t ap_ = kargs(); xb::XcdBarrier b_; b_.bar = (unsigned*)(ap_->ws + WS_BAR); b_.x = xb::xb_xcc_id(); b_.st = (volatile MK_LAS unsigned*)(ldsp + LDS_MISC); \
        xb::xcd_barrier(b_, wave == 0 && pg8::lane_id_v() == 0); MK_STAMP((k) + 1); } } while (0)
    if (IN(0)) { kargs_t ap = kargs(); const Frame F = mkframe(ldsp, wave);
#ifdef MK_PROBE0
        { int n0_; asm volatile("s_mov_b32 %0, 1" : "=s"(n0_)); for (int r0_ = 0; r0_ < n0_; ++r0_) { p0_prologue(F, ap); __syncthreads(); } }
#endif
        p0_prologue(F, ap); } SEAM(0);
    if (IN(1)) { kargs_t ap = kargs(); unsigned char* ws = ap->ws; pg8::Gemm g{(const bf16*)(ws + WS_XB), (const bf16*)(ws + WS_WGU1), S, NGU, DM, DM}; pg8::StaticOrder So; So.init(S, NGU, (int)gridDim.x, (int)blockIdx.x);
        pg8::EpiSwiGLU E{ws, 0}; pg8::gemm_phase<pg8::EpiSwiGLU, pg8::StaticOrder, true, true>(ldsp, g, So, E, wave);
        if (gridDim.x == 256 && blockIdx.x >= 128) { kargs_t ap2 = kargs(); const Frame F = mkframe(ldsp, wave); __syncthreads(); p0_late_items(F, ap2); } } SEAM(1);
    if (IN(2)) { kargs_t ap = kargs(); unsigned char* ws = ap->ws; pg8::Gemm g{(const bf16*)(ws + WS_ACT), (const bf16*)(ws + WS_WD1), S, DM, DFF, DFF}; pg8::StaticOrder So; So.init(S, DM, (int)gridDim.x, (int)blockIdx.x);
        pg8::EpiResid E{nullptr, ws, (int)WS_SS2, 0.5f}; pg8::gemm_phase<pg8::EpiResid, pg8::StaticOrder, true, true>(ldsp, g, So, E, wave); } SEAM(2);
    if (IN(3)) { kargs_t ap = kargs(); unsigned char* ws = ap->ws; pg8::Gemm g{(const bf16*)(ws + WS_XB), (const bf16*)(ws + WS_WIN), S, NWIN, DM, DM}; pg8::StaticOrder So; So.init(S, gridDim.x == 256 ? NWIN - 256 : NWIN, (int)gridDim.x, (int)blockIdx.x);
        pg8::EpiWin E{ws, 0}; pg8::gemm_phase<pg8::EpiWin, pg8::StaticOrder, true, true>(ldsp, g, So, E, wave); } SEAM(3);
    if (IN(4)) {
#ifdef MK_PROBE4
      int n4_; asm volatile("s_mov_b32 %0, 2" : "=s"(n4_));
      for (int r4_ = 0; r4_ < n4_; ++r4_) {
#endif
        { kargs_t ap = kargs(); unsigned char* ws = ap->ws; pg8::Gemm g{(const bf16*)(ws + WS_CQKV) + 384, (const bf16*)(ws + WS_WUKV), S, 1024, 256, 768}; pg8::StaticOrder So; So.init(S, 1024, (int)gridDim.x, (int)blockIdx.x);
          pg8::EpiKV E{ws}; pg8::gemm_phase<pg8::EpiKV, pg8::StaticOrder, true, true>(ldsp, g, So, E, wave); }
        { kargs_t ap = kargs(); unsigned char* ws = ap->ws; pg8::Gemm g{(const bf16*)(ws + WS_CQKV), (const bf16*)(ws + WS_WUQ), S, 768, 384, 768}; pg8::StaticOrder So; So.init(S, 768, (int)gridDim.x, (int)blockIdx.x);
          pg8::EpiQ E{ws}; pg8::gemm_phase<pg8::EpiQ, pg8::StaticOrder, true, true>(ldsp, g, So, E, wave); }
        if (gridDim.x == 256) { kargs_t ap = kargs(); unsigned char* ws = ap->ws; pg8::Gemm g{(const bf16*)(ws + WS_XB), (const bf16*)(ws + WS_WIN), S, NWIN, DM, DM}; pg8::TailOrder So; So.init(S, 8, (int)gridDim.x, (int)blockIdx.x);
          pg8::EpiWin E{ws, 0}; pg8::gemm_phase<pg8::EpiWin, pg8::TailOrder, true, true>(ldsp, g, So, E, wave); }
#if defined(MK_PROBE4) && MK_PROBE4 == 1
      __syncthreads(); }
#endif
        { kargs_t ap = kargs(); const Frame F = mkframe(ldsp, wave); p4_krope(F, ap); }
#if defined(MK_PROBE4) && MK_PROBE4 == 2
      __syncthreads(); }
#endif
#ifndef MK_NO_GATE
        { kargs_t ap = kargs(); const Frame F = mkframe(ldsp, wave); p4_gating(F, ap); }
#endif
    } SEAM(4);
#ifndef MK_NO_ATT5
    if (IN(5)) {
        kargs_t ap = kargs(); unsigned char* ws = ap->ws; const Frame F = mkframe(ldsp, wave);
        MK_LAS int* pre = (MK_LAS int*)(ldsp + att::MB_PRE);
        const unsigned* cnt = (const unsigned*)(ws + WS_CNT);
        __syncthreads();
        { const int c = (int)cnt[F.tid]; pre[F.tid] = (c + 255) >> 8; }
        __syncthreads();
        for (int o = 1; o < 512; o <<= 1) { const int v = pre[F.tid] + (F.tid >= o ? pre[F.tid - o] : 0); __syncthreads(); pre[F.tid] = v; __syncthreads(); }
        att::MobaCtx C; C.mqkv = (const bf16*)(ws + WS_MQKV); C.posf = (const float*)(ws + WS_POSF); C.part = (bf16*)ap->out; C.plse = (float*)(ws + WS_PLSE);
        C.lists = (const unsigned*)(ws + WS_LIST); C.cnt = cnt; C.total = pre[511]; C.vcu = F.vcu; C.G = F.G;
#ifdef MK_PROBE5
        { bf16* rp_ = C.part; float* rl_ = C.plse; C.part = (bf16*)(ws + WS_CQKV); C.plse = (float*)(ws + WS_CQKV + (16u << 20)); att::moba_run<MK_PROBE5>(C, (char*)lds, wave); __syncthreads(); C.part = rp_; C.plse = rl_; }
#endif
        att::moba_run<0>(C, (char*)lds, wave);
    }
#endif
    SEAM(5);
    if (IN(6)) {
#ifdef MK_PROBEC
        { int nc_; asm volatile("s_mov_b32 %0, 1" : "=s"(nc_)); for (int rc_ = 0; rc_ < nc_; ++rc_) { kargs_t ap = kargs(); const Frame F = mkframe(ldsp, wave); p5_combine(F, ap); __syncthreads(); } }
#endif
        { kargs_t ap = kargs(); const Frame F = mkframe(ldsp, wave); p5_combine(F, ap); }
#ifndef MK_NO_ATT6
        kargs_t ap = kargs(); unsigned char* ws = ap->ws; const Frame F = mkframe(ldsp, wave);
        att::Unit U; U.posf = nullptr; U.part = nullptr; U.plse = nullptr; U.list = nullptr; U.len = 0; U.slope2 = 0.f; U.q_pitch = 768; U.k_pitch = 512; U.v_pitch = 512; U.o_pitch = 1024; U.key0 = 0; U.Kr = (const bf16*)(ws + WS_KR);
        int vstep6 = F.G;
#ifdef MK_PROBE6
        asm volatile("s_mov_b32 %0, 0" : "=s"(vstep6));
        int npass6 = 0;
#endif
        for (int v = F.vcu; v < 256; v += vstep6) { const int h = v >> 5, s_ = v & 31;
#ifdef MK_PROBE6
            if (npass6++ >= MK_PROBE6) break;
            U.len = (npass6 == 1) ? 1 : 0;
#endif
            for (int i = 0; i < 2; ++i) { const int qb = i == 0 ? 63 - s_ : s_;
                U.h = h; U.Q = (const bf16*)(ws + WS_Q) + h * 96; U.K = (const bf16*)(ws + WS_KN) + h * 64; U.V = (const bf16*)(ws + WS_V) + h * 64; U.O = (bf16*)(ws + WS_CAT) + h * 64; U.q0 = qb * 256; U.ntiles = 4 * (qb + 1);
                att::unit<0>(U, (char*)lds, wave); } }
#endif
    } SEAM(6);
    if (IN(7)) { kargs_t ap = kargs(); unsigned char* ws = ap->ws; pg8::Gemm g{(const bf16*)(ws + WS_CAT), (const bf16*)(ws + WS_WOUT), S, DM, DM, DM}; pg8::StaticOrder So; So.init(S, DM, (int)gridDim.x, (int)blockIdx.x);
        pg8::EpiResid E{nullptr, ws, (int)WS_SS3, 1.0f}; pg8::gemm_phase<pg8::EpiResid, pg8::StaticOrder, true, true>(ldsp, g, So, E, wave); } SEAM(7);
    if (IN(8)) { kargs_t ap = kargs(); unsigned char* ws = ap->ws; pg8::Gemm g{(const bf16*)(ws + WS_XB), (const bf16*)(ws + WS_WGU2), S, NGU, DM, DM}; pg8::StaticOrder So; So.init(S, NGU, (int)gridDim.x, (int)blockIdx.x);
        pg8::EpiSwiGLU E{ws, 1};
#ifdef MK_PROBE8
        { int n8_; asm volatile("s_mov_b32 %0, 1" : "=s"(n8_)); for (int r8_ = 0; r8_ < n8_; ++r8_) { pg8::gemm_phase<pg8::EpiSwiGLU, pg8::StaticOrder, true, true>(ldsp, g, So, E, wave); __syncthreads(); } }
#endif
        pg8::gemm_phase<pg8::EpiSwiGLU, pg8::StaticOrder, true, true>(ldsp, g, So, E, wave); } SEAM(8);
    if (IN(9)) { kargs_t ap = kargs(); unsigned char* ws = ap->ws; pg8::Gemm g{(const bf16*)(ws + WS_ACT), (const bf16*)(ws + WS_WD2), S, DM, DFF, DFF}; pg8::StaticOrder So; So.init(S, DM, (int)gridDim.x, (int)blockIdx.x);
        if (gridDim.x == 256) { pg8::EpiResidNorm E{ap->out, ws, ap->in[17], 0.5f}; pg8::gemm_phase<pg8::EpiResidNorm, pg8::StaticOrder, false, true>(ldsp, g, So, E, wave); }
        else { pg8::EpiResid E{ap->out, ws, (int)WS_SS4, 0.5f}; pg8::gemm_phase<pg8::EpiResid, pg8::StaticOrder, true, true>(ldsp, g, So, E, wave); } }
    if (gridDim.x != 256) SEAM(9);
#ifdef MK_PROBE9
    if (IN(9)) { SEAM(9); kargs_t ap = kargs(); unsigned char* ws = ap->ws; pg8::Gemm g{(const bf16*)(ws + WS_ACT), (const bf16*)(ws + WS_WD2), S, DM, DFF, DFF}; pg8::StaticOrder So; So.init(S, DM, (int)gridDim.x, (int)blockIdx.x);
        pg8::EpiSwiGLU E{ws, 1}; pg8::gemm_phase<pg8::EpiSwiGLU, pg8::StaticOrder, true, true>(ldsp, g, So, E, wave); }
#endif
    if (IN(10) && gridDim.x != 256) { kargs_t ap = kargs(); const Frame F = mkframe(ldsp, wave); p9_final(F, ap); }
#undef IN
#undef SEAM
}
constexpr int N_PHASES = 11;
}
#ifndef MK_BRINGUP
#define MK_BRINGUP 0
#endif
extern "C" void kernel_launch(void* const* d_in, const int* in_sizes, int n_in, void* d_out, int out_size, void* d_ws, size_t ws_size, hipStream_t stream) {
    static int grid = 0;
    if (grid == 0) {
        if (hipFuncSetAttribute((const void*)mk::mk_fwd, hipFuncAttributeMaxDynamicSharedMemorySize, mk::LDS_BYTES) != hipSuccess) { fprintf(stderr, "kernel_launch: hipFuncSetAttribute failed\n"); grid = -1; return; }
        int dev = 0, cus = 0, per_cu = 0;
        hipGetDevice(&dev); hipDeviceGetAttribute(&cus, hipDeviceAttributeMultiprocessorCount, dev);
        hipOccupancyMaxActiveBlocksPerMultiprocessor(&per_cu, (const void*)mk::mk_fwd, mk::NWAVES * 64, mk::LDS_BYTES);
        (void)hipGetLastError();
        grid = cus * (per_cu < 1 ? 1 : (per_cu > 1 ? 1 : per_cu));
        if (grid % 8 != 0 || grid <= 0) grid = 256;
        if (ws_size < mk::WS_END) { fprintf(stderr, "kernel_launch: workspace too small (%zu)\n", ws_size); grid = -1; return; }
    }
    if (grid < 0) return;
    mk::Args a{};
    for (int i = 0; i < 18; ++i) a.in[i] = (const float*)d_in[i];
    a.out = (float*)d_out; a.ws = (unsigned char*)d_ws;
#if MK_BRINGUP == 0
    if (hipMemsetAsync((char*)d_ws + mk::WS_BAR, 0, mk::BAR_BYTES, stream) != hipSuccess) { fprintf(stderr, "kernel_launch: memset failed\n"); return; }
    a.ph_lo = 0; a.ph_hi = mk::N_PHASES;
    void* args[] = {&a};
    hipError_t e = hipLaunchCooperativeKernel((const void*)mk::mk_fwd, dim3(grid), dim3(mk::NWAVES * 64), args, mk::LDS_BYTES, stream);
    if (e != hipSuccess) fprintf(stderr, "cooperative launch failed: %s (grid %d)\n", hipGetErrorString(e), grid);
#else
    const int nph = MK_BRINGUP == 1 ? 3 : MK_BRINGUP == 2 ? 8 : mk::N_PHASES;
    for (int ph = 0; ph < nph; ++ph) { a.ph_lo = ph; a.ph_hi = ph + 1; hipLaunchKernelGGL(mk::mk_fwd, dim3(grid), dim3(mk::NWAVES * 64), mk::LDS_BYTES, stream, a); }
#if MK_BRINGUP == 1
    nv::part_mix(d_in, (float*)d_out, d_ws, stream); nv::part_ffn2_final(d_in, (float*)d_out, d_ws, stream);
#elif MK_BRINGUP == 2
    nv::part_ffn2_final(d_in, (float*)d_out, d_ws, stream);
#endif
#endif
}
```

```cpp
#define MK_BRINGUP 0
#include <hip/hip_runtime.h>
#include <cstdio>
#include <cstdint>
#include <cmath>
#include <hip/hip_cooperative_groups.h>
namespace cg = cooperative_groups;

namespace mkc {
constexpr int S = 16384, DM = 1024, DFF = 2816, NGU = 2 * DFF, NWIN = 2304;
constexpr float LOG2E = 1.4426950408889634f;
constexpr float C2Q = 0.10206207261596577f * LOG2E;
constexpr float C2M = 0.125f * LOG2E;
constexpr size_t MiB = 1u << 20;
constexpr size_t WS_PANEL = 4096 + 16384;
constexpr size_t WS_CNT = 0;
constexpr size_t WS_SS1 = 1 * MiB, WS_SS2 = WS_SS1 + 65536, WS_SSQ = WS_SS2 + 65536, WS_SSKV = WS_SSQ + 65536, WS_SS3 = WS_SSKV + 65536, WS_SS4 = WS_SS3 + 65536;
constexpr size_t WS_KMS = WS_SS1 + 512 * 1024;
constexpr size_t WS_SSDUMMY = WS_SS1 + 384 * 1024, WS_KMSDUMMY = WS_SS1 + 640 * 1024;
constexpr size_t WS_POSF = 2 * MiB, WS_COS = 3 * MiB, WS_SIN = 4 * MiB;
constexpr size_t WS_WGU1 = 6 * MiB, WS_WD1 = 17 * MiB, WS_WGU2 = WS_WD1 + 5632 * 1024, WS_WD2 = WS_WGU2 + 11 * MiB, WS_WIN = 39 * MiB, WS_WUQ = WS_WIN + 4608 * 1024, WS_WUKV = WS_WUQ + 768 * 1024, WS_WOUT = 45 * MiB;
constexpr size_t WS_XB = 48 * MiB, WS_CQKV = 80 * MiB, WS_PLSE = 112 * MiB;
constexpr size_t WS_ACT = 114 * MiB, WS_MQKV = 114 * MiB, WS_CAT = 114 * MiB, WS_Q = 162 * MiB, WS_KN = 186 * MiB, WS_V = 202 * MiB, WS_KR = 218 * MiB, WS_LIST = 220 * MiB, WS_END = 252 * MiB;
static_assert(WS_WD2 + 5632 * 1024 <= WS_WIN && WS_WUKV + 512 * 1024 <= WS_WOUT && WS_WOUT + 2 * MiB <= WS_XB, "weight map");
}
namespace pg8 {
#define PG8_LAS __attribute__((address_space(3)))
typedef unsigned short bf16_t;
typedef short bf16x8 __attribute__((ext_vector_type(8)));
typedef float f32x4 __attribute__((ext_vector_type(4)));
typedef unsigned u32x4 __attribute__((ext_vector_type(4)));
__device__ __forceinline__ int lane_id_v() { int l; asm volatile("v_mbcnt_lo_u32_b32 %0, -1, 0\n\tv_mbcnt_hi_u32_b32 %0, -1, %0" : "=v"(l)); return l; }
constexpr int BM = 256, BK = 64, HALF = 128, HTB = HALF * BK * 2  , STAGE_BYTES = 8 * HTB, NXCD = 8, WGM = 4;

__host__ __device__ __forceinline__ int lds_byte(int r, int c) { const int st = (r >> 4) * 2 + (c >> 5), rr = r & 15, cc = c & 31, ob = rr * 64 + cc * 2; return st * 1024 + (ob ^ (((ob >> 9) & 1) << 5)); }
__host__ __device__ __forceinline__ void stage_rc(int b, int& R, int& C) { const int st = b / 1024, sb = b % 1024, swz = sb ^ (((sb >> 9) & 1) << 5); R = (st >> 1) * 16 + swz / 64; C = (st & 1) * 32 + (swz % 64) / 2; }
__host__ __device__ __forceinline__ int perm32(int rho) { const int n = rho >> 4, i = rho & 15; return 8 * (i >> 2) + 4 * n + (i & 3); }

struct Unit { int pm, pn; };
struct Gemm { const bf16_t* A; const bf16_t* Bt; int M, N, K, lda; };

struct StaticOrder {
    int nM, nN, nwg, G, c;
    __host__ __device__ void init(int M, int N, int G_, int c_) { nM = M / BM; nN = N / BM; nwg = nM * nN; G = G_; c = c_; }
    __host__ __device__ bool next(int i, Unit& u) const {
        const long L = (long)i * G + c; if (L >= nwg) return false;
        int wgid = (int)L; { const int q = nwg / NXCD, r = nwg % NXCD, xcd = wgid % NXCD, off = wgid / NXCD; wgid = (xcd < r ? xcd * (q + 1) : r * (q + 1) + (xcd - r) * q) + off; }
        const int nig = WGM * nN, gid = wgid / nig, fm = gid * WGM, gsz = (nM - fm) < WGM ? (nM - fm) : WGM;
        u.pm = fm + ((wgid % nig) % gsz); u.pn = (wgid % nig) / gsz; return true;
    }
    __device__ __forceinline__ void a_ready(const Unit&) const {}
    __device__ __forceinline__ void done(const Unit&) const {}
};
struct TailOrder {
    int nM, pn, G, c;
    __host__ __device__ void init(int M, int pn_, int G_, int c_) { nM = M / BM; pn = pn_; G = G_; c = c_; }
    __host__ __device__ bool next(int i, Unit& u) const { const int j = c - (G - nM); if (i != 0 || j < 0 || j >= nM) return false; u.pm = j; u.pn = pn; return true; }
    __device__ __forceinline__ void a_ready(const Unit&) const {}
    __device__ __forceinline__ void done(const Unit&) const {}
};
__device__ __forceinline__ unsigned cvt_pk_bf16(float lo, float hi) { unsigned r; asm volatile("v_cvt_pk_bf16_f32 %0, %1, %2" : "=v"(r) : "v"(lo), "v"(hi)); return r; }
typedef unsigned u32x2 __attribute__((ext_vector_type(2)));
constexpr float RMS_EPS = 1e-6f;
__device__ __forceinline__ float rs_of(const float* ss, int row, float invn) { return __builtin_amdgcn_rsqf(ss[row] * invn + RMS_EPS); }
__device__ __forceinline__ float silu_f(float g) { return g * __builtin_amdgcn_rcpf(1.0f + __builtin_amdgcn_exp2f(-1.4426950408889634f * g)); }
__device__ __forceinline__ u32x4 pack8(const f32x4 a, const f32x4 b) { u32x4 w; w.x = cvt_pk_bf16(a[0], a[1]); w.y = cvt_pk_bf16(a[2], a[3]); w.z = cvt_pk_bf16(b[0], b[1]); w.w = cvt_pk_bf16(b[2], b[3]); return w; }

struct EpiSwiGLU {
    static constexpr bool PERM = true, AFTER_DRAIN = false;
    unsigned char* ws; int which;
    __device__ __forceinline__ void operator()(const f32x4 (&acc)[2][2][4][2], const Unit& u, int wr, int wc, int fr, int fq) const {
        bf16_t* O = (bf16_t*)(ws + mkc::WS_ACT); const int ldo = mkc::DFF; const float* ss = (const float*)(ws + (which ? mkc::WS_SS3 : mkc::WS_SS1)); const float invn = 1.0f / 1024.0f;
        const int row0 = u.pm * BM + wr * 64 + fr, col0 = u.pn * HALF + wc * 32 + 8 * fq;
#pragma unroll
        for (int ai = 0; ai < 2; ++ai)
#pragma unroll
            for (int m = 0; m < 4; ++m) { const int row = row0 + ai * HALF + m * 16; const float rs = rs_of(ss, row, invn);
                f32x4 a0, a1;
#pragma unroll
                for (int j = 0; j < 4; ++j) { a0[j] = silu_f(acc[ai][0][m][0][j] * rs) * (acc[ai][1][m][0][j] * rs); a1[j] = silu_f(acc[ai][0][m][1][j] * rs) * (acc[ai][1][m][1][j] * rs); }
                *(u32x4*)(O + (size_t)row * ldo + col0) = pack8(a0, a1); }
    }
};
__device__ __forceinline__ f32x4 bf4_to_f32(const u32x2 w) { f32x4 r; r[0] = __builtin_bit_cast(float, w.x << 16); r[1] = __builtin_bit_cast(float, w.x & 0xFFFF0000u); r[2] = __builtin_bit_cast(float, w.y << 16); r[3] = __builtin_bit_cast(float, w.y & 0xFFFF0000u); return r; }
struct EpiResid {
    static constexpr bool PERM = false, AFTER_DRAIN = false;
    float* out; unsigned char* ws; int ss_off; float alpha;
    __device__ __forceinline__ void operator()(const f32x4 (&acc)[2][2][4][2], const Unit& u, int wr, int wc, int fr, int fq) const {
        bf16_t* xb = (bf16_t*)(ws + mkc::WS_XB); float* ss_out = (float*)(ws + ss_off);
        const int row0 = u.pm * BM + wr * 64 + fr, col0 = u.pn * BM + wc * 32 + 4 * fq;
#pragma unroll
        for (int ai = 0; ai < 2; ++ai)
#pragma unroll
            for (int m = 0; m < 4; ++m) { const int row = row0 + ai * HALF + m * 16; const size_t off = (size_t)row * 1024 + col0; float s = 0.f;
#pragma unroll
                for (int bj = 0; bj < 2; ++bj)
#pragma unroll
                    for (int n = 0; n < 2; ++n) { const f32x4 b = bf4_to_f32(*(const u32x2*)(xb + off + bj * HALF + n * 16)); const f32x4 o = b + acc[ai][bj][m][n] * alpha;
                        if (out) *(f32x4*)(out + off + bj * HALF + n * 16) = o;
                        s += (o[0] * o[0] + o[1] * o[1]) + (o[2] * o[2] + o[3] * o[3]);
                        u32x2 w; w.x = cvt_pk_bf16(o[0], o[1]); w.y = cvt_pk_bf16(o[2], o[3]); *(u32x2*)(xb + off + bj * HALF + n * 16) = w; }
                s += __shfl_xor(s, 16); s += __shfl_xor(s, 32);
                if (fq == 0) atomicAdd(ss_out + row, s);
                asm volatile("" ::: "memory"); }
    }
};
struct EpiWin {
    static constexpr bool PERM = true, AFTER_DRAIN = false;
    unsigned char* ws; int dummy;
    __device__ __forceinline__ void operator()(const f32x4 (&acc)[2][2][4][2], const Unit& u, int wr, int wc, int fr, int fq) const {
        bf16_t* cqkv = (bf16_t*)(ws + mkc::WS_CQKV); bf16_t* mqkv = (bf16_t*)(ws + mkc::WS_MQKV); const float* ss_in = (const float*)(ws + mkc::WS_SS2);
        float* ssq = (float*)(ws + (dummy ? mkc::WS_SSDUMMY : mkc::WS_SSQ)); float* sskv = (float*)(ws + (dummy ? mkc::WS_SSDUMMY + 65536 : mkc::WS_SSKV)); float* kmsum = (float*)(ws + (dummy ? mkc::WS_KMSDUMMY : mkc::WS_KMS));
        const int row0 = u.pm * BM + wr * 64 + fr;
        const bool is_mk = (u.pn == 5 || u.pn == 6);
        f32x4 cs[2][2];
#pragma unroll
        for (int bj = 0; bj < 2; ++bj)
#pragma unroll
            for (int n = 0; n < 2; ++n) cs[bj][n] = (f32x4){0.f, 0.f, 0.f, 0.f};
#pragma unroll
        for (int ai = 0; ai < 2; ++ai)
#pragma unroll
            for (int m = 0; m < 4; ++m) { const int row = row0 + ai * HALF + m * 16; const float rs = rs_of(ss_in, row, 1.0f / 1024.0f);
#pragma unroll
                for (int bj = 0; bj < 2; ++bj) { const int colt = u.pn * BM + bj * HALF, col0 = colt + wc * 32 + 8 * fq;
                    const f32x4 v0 = acc[ai][bj][m][0] * rs, v1 = acc[ai][bj][m][1] * rs;
                    bf16_t* dst = (colt < 768) ? (cqkv + (size_t)row * 768 + col0) : (mqkv + (size_t)row * 1536 + (col0 - 768));
                    *(u32x4*)dst = pack8(v0, v1);
                    if (colt < 640) { float s = (v0[0] * v0[0] + v0[1] * v0[1]) + (v0[2] * v0[2] + v0[3] * v0[3]) + (v1[0] * v1[0] + v1[1] * v1[1]) + (v1[2] * v1[2] + v1[3] * v1[3]);
                        s += __shfl_xor(s, 16); s += __shfl_xor(s, 32);
                        if (fq == 0) atomicAdd((colt < 384 ? ssq : sskv) + row, s); }
                    if (is_mk) { cs[bj][0] += v0; cs[bj][1] += v1; } } }
        if (is_mk) {
#pragma unroll
            for (int bj = 0; bj < 2; ++bj)
#pragma unroll
                for (int n = 0; n < 2; ++n)
#pragma unroll
                    for (int j = 0; j < 4; ++j) { float s = cs[bj][n][j]; s += __shfl_xor(s, 1); s += __shfl_xor(s, 2); s += __shfl_xor(s, 4); s += __shfl_xor(s, 8);
                        if (fr == 0) atomicAdd(kmsum + (size_t)u.pm * 512 + (u.pn * BM + bj * HALF + wc * 32 + 8 * fq + 4 * n + j - 1280), s); }
        }
    }
};
struct EpiKV {
    static constexpr bool PERM = true, AFTER_DRAIN = false;
    unsigned char* ws;
    __device__ __forceinline__ void operator()(const f32x4 (&acc)[2][2][4][2], const Unit& u, int wr, int wc, int fr, int fq) const {
        bf16_t* Kn = (bf16_t*)(ws + mkc::WS_KN); bf16_t* V = (bf16_t*)(ws + mkc::WS_V); const float* ss = (const float*)(ws + mkc::WS_SSKV);
        const int row0 = u.pm * BM + wr * 64 + fr;
#pragma unroll
        for (int ai = 0; ai < 2; ++ai)
#pragma unroll
            for (int m = 0; m < 4; ++m) { const int row = row0 + ai * HALF + m * 16; const float rs = rs_of(ss, row, 1.0f / 256.0f);
#pragma unroll
                for (int bj = 0; bj < 2; ++bj) { const int colt = u.pn * BM + bj * HALF, col0 = colt + wc * 32 + 8 * fq;
                    bf16_t* dst = (colt < 512) ? (Kn + (size_t)row * 512 + col0) : (V + (size_t)row * 512 + (col0 - 512));
                    *(u32x4*)dst = pack8(acc[ai][bj][m][0] * rs, acc[ai][bj][m][1] * rs); } }
    }
};
struct EpiQ {
    static constexpr bool PERM = true, AFTER_DRAIN = false;
    unsigned char* ws;
    __device__ __forceinline__ void operator()(const f32x4 (&acc)[2][2][4][2], const Unit& u, int wr, int wc, int fr, int fq) const {
        bf16_t* Q = (bf16_t*)(ws + mkc::WS_Q); const float* ss = (const float*)(ws + mkc::WS_SSQ); const float* cosT = (const float*)(ws + mkc::WS_COS); const float* sinT = (const float*)(ws + mkc::WS_SIN);
        const int row0 = u.pm * BM + wr * 64 + fr;
#pragma unroll
        for (int ai = 0; ai < 2; ++ai)
#pragma unroll
            for (int m = 0; m < 4; ++m) { const int row = row0 + ai * HALF + m * 16; const float rs = rs_of(ss, row, 1.0f / 384.0f);
#pragma unroll
                for (int bj = 0; bj < 2; ++bj) { const int col0 = u.pn * BM + bj * HALF + wc * 32 + 8 * fq; const int d = col0 % 96;
                    f32x4 v0 = acc[ai][bj][m][0] * rs, v1 = acc[ai][bj][m][1] * rs;
                    if (d >= 64) { const int g = (d - 64) >> 3; const f32x4 c = *(const f32x4*)(cosT + (size_t)row * 16 + 4 * g), s = *(const f32x4*)(sinT + (size_t)row * 16 + 4 * g);
                        const f32x4 o0 = v0 * c - v1 * s, o1 = v0 * s + v1 * c; v0 = o0; v1 = o1; }
                    *(u32x4*)(Q + (size_t)row * 768 + col0) = pack8(v0, v1); }
                asm volatile("" ::: "memory"); }
    }
};
struct EpiResidNorm {
    static constexpr bool PERM = false, AFTER_DRAIN = true;
    float* out; unsigned char* ws; const float* gain; float alpha;
    __device__ __forceinline__ void fused(f32x4 (&acc)[2][2][4][2], const Unit& u, int wr, int wc, int fr, int fq, PG8_LAS unsigned char* lds, int wid, int lane) const {
        float* ss = (float*)(ws + mkc::WS_SS4); unsigned* pcnt = (unsigned*)(ws + mkc::WS_PANEL) + 64 * u.pm; const bf16_t* xb = (const bf16_t*)(ws + mkc::WS_XB);
        const int row0 = u.pm * BM + wr * 64 + fr, col0 = u.pn * BM + wc * 32 + 4 * fq;
#pragma unroll
        for (int ai = 0; ai < 2; ++ai)
#pragma unroll
            for (int m = 0; m < 4; ++m) { const int row = row0 + ai * HALF + m * 16; const size_t off = (size_t)row * 1024 + col0; float s = 0.f;
#pragma unroll
                for (int bj = 0; bj < 2; ++bj)
#pragma unroll
                    for (int n = 0; n < 2; ++n) { const f32x4 b = bf4_to_f32(*(const u32x2*)(xb + off + bj * HALF + n * 16)); const f32x4 o = b + acc[ai][bj][m][n] * alpha; acc[ai][bj][m][n] = o;
                        s += (o[0] * o[0] + o[1] * o[1]) + (o[2] * o[2] + o[3] * o[3]); }
                s += __shfl_xor(s, 16); s += __shfl_xor(s, 32);
                if (fq == 0) atomicAdd(ss + row, s);
                asm volatile("" : "+v"(acc[ai][0][m][0]), "+v"(acc[ai][0][m][1]), "+v"(acc[ai][1][m][0]), "+v"(acc[ai][1][m][1]));
                if (m & 1) asm volatile("" ::: "memory"); }
        asm volatile("s_waitcnt vmcnt(0)" ::: "memory"); __builtin_amdgcn_s_barrier(); asm volatile("" ::: "memory");
        if (wid == 0) {
            if (lane == 0) { __builtin_amdgcn_fence(__ATOMIC_RELEASE, "agent"); asm volatile("s_waitcnt vmcnt(0)" ::: "memory"); __hip_atomic_fetch_add(pcnt, 1u, __ATOMIC_RELAXED, __HIP_MEMORY_SCOPE_AGENT); }
            unsigned spins = 0;
            while ((unsigned)__builtin_amdgcn_readfirstlane(__hip_atomic_load(pcnt, __ATOMIC_RELAXED, __HIP_MEMORY_SCOPE_AGENT)) < 4u) { __builtin_amdgcn_s_sleep(2); if (++spins > (1u << 22)) break; }
            __builtin_amdgcn_fence(__ATOMIC_ACQUIRE, "agent");
        }
        asm volatile("s_waitcnt vmcnt(0) lgkmcnt(0)" ::: "memory"); __builtin_amdgcn_s_barrier(); asm volatile("" ::: "memory");
        f32x4 gv[2][2];
#pragma unroll
        for (int bj = 0; bj < 2; ++bj)
#pragma unroll
            for (int n = 0; n < 2; ++n) gv[bj][n] = *(const f32x4*)(gain + col0 + bj * HALF + n * 16);
#pragma unroll
        for (int ai = 0; ai < 2; ++ai)
#pragma unroll
            for (int m = 0; m < 4; ++m) { const int row = row0 + ai * HALF + m * 16; const size_t off = (size_t)row * 1024 + col0;
                const float tot = __hip_atomic_load(ss + row, __ATOMIC_RELAXED, __HIP_MEMORY_SCOPE_AGENT); const float rs = __builtin_amdgcn_rsqf(tot * (1.0f / 1024.0f) + RMS_EPS);
#pragma unroll
                for (int bj = 0; bj < 2; ++bj)
#pragma unroll
                    for (int n = 0; n < 2; ++n) *(f32x4*)(out + off + bj * HALF + n * 16) = acc[ai][bj][m][n] * rs * gv[bj][n]; }
    }
};

template <class Epi, class Sched, bool ALIGN_EPI = false, bool SP2 = false, int XP = 0>
__device__ __forceinline__ void gemm_phase(PG8_LAS unsigned char* lds, const Gemm g, const Sched& S, const Epi& E, const int wid) {
    const int lane = lane_id_v(), tid = wid * 64 + lane, wr = wid >> 2, wc = wid & 3, fr = lane & 15, fq = lane >> 4;
    const int K = g.K, nt = K / BK, lda = g.lda;
    unsigned voffA[2], voffB[2];
#pragma unroll
    for (int i = 0; i < 2; ++i) { int R, C; stage_rc(tid * 16 + i * 8192, R, C); const int Rb = Epi::PERM ? ((R & ~31) + perm32(R & 31)) : R;
        voffA[i] = (unsigned)(R * lda + C) * 2u; voffB[i] = (unsigned)(Rb * K + C) * 2u; }
    const size_t kstep = (size_t)(BK * 2);
    const size_t hstep = (size_t)HALF * K * 2;
    const size_t tstep = 2 * hstep; const size_t hstepA = (size_t)HALF * lda * 2, tstepA = 2 * hstepA;
    const unsigned ldsw = (unsigned)wid * 1024u;
    const int aoff = lds_byte(wr * 64 + fr, fq * 8), boff = lds_byte(wc * 32 + fr, fq * 8);
#define PG8_SA(b, h) (((b) * 2 + (h)) * HTB)
#define PG8_SB(b, h) ((4 + (b) * 2 + (h)) * HTB)
#define PG8_STAGE(bufoff, gbase, voff) do { if constexpr (XP & 4) break; _Pragma("unroll") for (int _i = 0; _i < 2; ++_i) \
        __builtin_amdgcn_global_load_lds((const unsigned*)((const char*)(gbase) + (voff)[_i]), (PG8_LAS unsigned*)(lds + (bufoff) + ldsw + _i * 8192), 16, 0, 0); } while (0)
#define PG8_LDA(dst, b, h) do { if constexpr (XP & 8) break; _Pragma("unroll") for (int m = 0; m < 4; ++m) _Pragma("unroll") for (int k = 0; k < 2; ++k) dst[m][k] = *(const PG8_LAS bf16x8*)(lds + PG8_SA(b, h) + aoff + m * 2048 + k * 1024); } while (0)
#define PG8_LDB(dst, b, h) do { if constexpr (XP & 8) break; _Pragma("unroll") for (int n = 0; n < 2; ++n) _Pragma("unroll") for (int k = 0; k < 2; ++k) dst[n][k] = *(const PG8_LAS bf16x8*)(lds + PG8_SB(b, h) + boff + n * 2048 + k * 1024); } while (0)
#define PG8_MMA(ai, bj, At, Bt) do { if constexpr (XP & 2) break; if constexpr (!(XP & 16)) __builtin_amdgcn_s_setprio(1); _Pragma("unroll") for (int m = 0; m < 4; ++m) _Pragma("unroll") for (int n = 0; n < 2; ++n) _Pragma("unroll") for (int k = 0; k < 2; ++k) \
        acc[ai][bj][m][n] = __builtin_amdgcn_mfma_f32_16x16x32_bf16(Bt[n][k], At[m][k], acc[ai][bj][m][n], 0, 0, 0); if constexpr (!(XP & 16)) __builtin_amdgcn_s_setprio(0); } while (0)
#define PG8_WAIT_V(n) asm volatile("s_waitcnt vmcnt(" #n ")" ::: "memory")
#define PG8_WAIT_L(n) asm volatile("s_waitcnt lgkmcnt(" #n ")" ::: "memory")
#define PG8_BAR do { if constexpr (!(XP & 1)) __builtin_amdgcn_s_barrier(); } while (0)
#define PG8_SCHED __builtin_amdgcn_sched_barrier(0)
    Unit cur, nxt; int ui = 0;
    if (!S.next(0, cur)) return;
    f32x4 acc[2][2][4][2];
#pragma unroll
    for (int a = 0; a < 2; ++a)
#pragma unroll
        for (int b = 0; b < 2; ++b)
#pragma unroll
            for (int m = 0; m < 4; ++m)
#pragma unroll
                for (int n = 0; n < 2; ++n) acc[a][b][m][n] = (f32x4){0.f, 0.f, 0.f, 0.f};
    bf16x8 At[4][2], B0[2][2], B1[2][2];
    const char* cA = (const char*)g.A + (size_t)cur.pm * tstepA; const char* cB = (const char*)g.Bt + (size_t)cur.pn * tstep;
    S.a_ready(cur);
    if constexpr (SP2) {
        PG8_STAGE(PG8_SB(0, 0), cB, voffB); PG8_STAGE(PG8_SB(0, 1), cB + hstep, voffB); PG8_STAGE(PG8_SA(0, 0), cA, voffA); PG8_STAGE(PG8_SA(0, 1), cA + hstepA, voffA);
        if (wr == 1) PG8_BAR;
        PG8_WAIT_V(2); PG8_BAR;
        PG8_STAGE(PG8_SB(1, 0), cB + kstep, voffB); PG8_STAGE(PG8_SA(1, 0), cA + kstep, voffA); PG8_STAGE(PG8_SB(1, 1), cB + hstep + kstep, voffB);
        PG8_WAIT_V(6); PG8_BAR;
    } else {
        PG8_STAGE(PG8_SB(0, 0), cB, voffB); PG8_STAGE(PG8_SA(0, 0), cA, voffA); PG8_STAGE(PG8_SB(0, 1), cB + hstep, voffB); PG8_STAGE(PG8_SA(0, 1), cA + hstepA, voffA);
        if (wr == 1) PG8_BAR;
        PG8_WAIT_V(4); PG8_BAR;
        PG8_STAGE(PG8_SB(1, 0), cB + kstep, voffB); PG8_STAGE(PG8_SA(1, 0), cA + kstep, voffA); PG8_STAGE(PG8_SB(1, 1), cB + hstep + kstep, voffB);
        PG8_WAIT_V(6); PG8_BAR;
    }
    for (;;) {
        const bool has_next = S.next(ui + 1, nxt);
        const char* nA = has_next ? (const char*)g.A + (size_t)nxt.pm * tstepA : cA; const char* nB = has_next ? (const char*)g.Bt + (size_t)nxt.pn * tstep : cB;
#pragma nounroll
        for (int t = 0; t < nt; t += 2) {
            const bool last = (t == nt - 2);
            const char* a1 = cA + (size_t)(t + 1) * kstep;
            const char* a2 = last ? nA : cA + (size_t)(t + 2) * kstep; const char* b2 = last ? nB : cB + (size_t)(t + 2) * kstep;
            const char* a3 = a2 + kstep; const char* b3 = b2 + kstep;
            if (last && has_next) S.a_ready(nxt);
            if constexpr (SP2) {
            PG8_LDB(B0, 0, 0); PG8_LDB(B1, 0, 1); PG8_SCHED; PG8_LDA(At, 0, 0); PG8_STAGE(PG8_SA(1, 1), a1 + hstepA, voffA);
            PG8_WAIT_V(8); PG8_WAIT_L(0); PG8_BAR; PG8_MMA(0, 0, At, B0); PG8_MMA(0, 1, At, B1); PG8_BAR; PG8_SCHED;
            PG8_LDA(At, 0, 1); PG8_STAGE(PG8_SB(0, 0), b2, voffB); PG8_STAGE(PG8_SB(0, 1), b2 + hstep, voffB); PG8_STAGE(PG8_SA(0, 0), a2, voffA);
            PG8_WAIT_V(8); PG8_WAIT_L(0); PG8_BAR; PG8_MMA(1, 0, At, B0); PG8_MMA(1, 1, At, B1); PG8_BAR; PG8_SCHED;
            PG8_LDB(B0, 1, 0); PG8_LDB(B1, 1, 1); PG8_SCHED; PG8_LDA(At, 1, 0); PG8_STAGE(PG8_SA(0, 1), a2 + hstepA, voffA);
            PG8_WAIT_V(8); PG8_WAIT_L(0); PG8_BAR; PG8_MMA(0, 0, At, B0); PG8_MMA(0, 1, At, B1); PG8_BAR; PG8_SCHED;
            PG8_LDA(At, 1, 1); PG8_STAGE(PG8_SB(1, 0), b3, voffB); PG8_STAGE(PG8_SB(1, 1), b3 + hstep, voffB); PG8_STAGE(PG8_SA(1, 0), a3, voffA);
            PG8_WAIT_V(8); PG8_WAIT_L(0); PG8_BAR; PG8_MMA(1, 0, At, B0); PG8_MMA(1, 1, At, B1); PG8_BAR; PG8_SCHED;
            } else {
            PG8_LDB(B0, 0, 0); PG8_SCHED; PG8_LDA(At, 0, 0); PG8_STAGE(PG8_SA(1, 1), a1 + hstepA, voffA);
            PG8_WAIT_L(8); PG8_BAR; PG8_WAIT_L(0); PG8_MMA(0, 0, At, B0); PG8_BAR; PG8_SCHED;
            PG8_LDB(B1, 0, 1); PG8_STAGE(PG8_SB(0, 0), b2, voffB);
            PG8_BAR; PG8_WAIT_L(0); PG8_MMA(0, 1, At, B1); PG8_BAR;
            PG8_LDA(At, 0, 1); PG8_STAGE(PG8_SA(0, 0), a2, voffA);
            PG8_BAR; PG8_WAIT_L(0); PG8_MMA(1, 0, At, B0); PG8_BAR; PG8_SCHED;
            PG8_STAGE(PG8_SB(0, 1), b2 + hstep, voffB);
            PG8_WAIT_V(6); PG8_BAR; PG8_MMA(1, 1, At, B1); PG8_BAR;
            PG8_LDB(B0, 1, 0); PG8_SCHED; PG8_LDA(At, 1, 0); PG8_STAGE(PG8_SA(0, 1), a2 + hstepA, voffA);
            PG8_WAIT_L(8); PG8_BAR; PG8_WAIT_L(0); PG8_MMA(0, 0, At, B0); PG8_BAR; PG8_SCHED;
            PG8_LDB(B1, 1, 1); PG8_STAGE(PG8_SB(1, 0), b3, voffB);
            PG8_BAR; PG8_WAIT_L(0); PG8_MMA(0, 1, At, B1); PG8_BAR;
            PG8_LDA(At, 1, 1); PG8_STAGE(PG8_SA(1, 0), a3, voffA);
            PG8_BAR; PG8_WAIT_L(0); PG8_MMA(1, 0, At, B0); PG8_BAR; PG8_SCHED;
            PG8_STAGE(PG8_SB(1, 1), b3 + hstep, voffB);
            PG8_WAIT_V(6); PG8_BAR; PG8_MMA(1, 1, At, B1); PG8_BAR;
            }
        }
        if constexpr (ALIGN_EPI) { if (wr == 0) PG8_BAR; }
        if constexpr (!Epi::AFTER_DRAIN) { E(acc, cur, wr, wc, fr, fq); S.done(cur); }
        if (!has_next) break;
#pragma unroll
        for (int a = 0; a < 2; ++a)
#pragma unroll
            for (int b = 0; b < 2; ++b)
#pragma unroll
                for (int m = 0; m < 4; ++m)
#pragma unroll
                    for (int n = 0; n < 2; ++n) acc[a][b][m][n] = (f32x4){0.f, 0.f, 0.f, 0.f};
        cur = nxt; cA = nA; cB = nB; ++ui;
        if constexpr (ALIGN_EPI) { if (wr == 1) PG8_BAR; }
    }
    PG8_WAIT_V(0);
    if constexpr (!ALIGN_EPI) { if (wr == 0) PG8_BAR; }
    PG8_BAR;
    if constexpr (Epi::AFTER_DRAIN) { E.fused(acc, cur, wr, wc, fr, fq, lds, wid, lane); S.done(cur); }
#undef PG8_SA
#undef PG8_SB
#undef PG8_STAGE
#undef PG8_LDA
#undef PG8_LDB
#undef PG8_MMA
#undef PG8_WAIT_V
#undef PG8_WAIT_L
#undef PG8_BAR
#undef PG8_SCHED
}
}
namespace att {
typedef unsigned short bf16_t;
using bf16x8 = __attribute__((ext_vector_type(8))) short;
using s16x4 = __attribute__((ext_vector_type(4))) short;
using f32x16 = __attribute__((ext_vector_type(16))) float;
using f32x4 = __attribute__((ext_vector_type(4))) float;
using u32x4 = __attribute__((ext_vector_type(4))) unsigned;
typedef short v4i16_t __attribute__((ext_vector_type(4)));
#define ATT_LAS __attribute__((address_space(3)))
typedef ATT_LAS const char* lds_cptr;
constexpr int NW = 8, KVBLK = 64;
constexpr int KSLOT = 12288, VSLOT = 8192, NSLOT = 4;
constexpr int LDS_K = 0, LDS_V = NSLOT * KSLOT, LDS_WS = LDS_V + NSLOT * VSLOT, LDS_OST = LDS_WS + NW * 64 * 4, LDS_POSK = LDS_OST + NW * 4096, LDS_BYTES = LDS_POSK + 1024;
__device__ __forceinline__ int crow(int r, int hi) { return (r & 3) + 8 * (r >> 2) + 4 * hi; }
__device__ __forceinline__ void glds16(const void* gsrc, unsigned lds_dst) {
    asm volatile("s_mov_b32 m0, %1\n\ts_nop 0\n\tglobal_load_lds_dwordx4 %0, off" : : "v"(gsrc), "s"(lds_dst) : "memory", "m0"); }
typedef float f32x2_t __attribute__((ext_vector_type(2))); typedef __bf16 bf16x2_t __attribute__((ext_vector_type(2)));
__device__ __forceinline__ unsigned cvtpk(float lo, float hi) { f32x2_t v = {lo, hi}; bf16x2_t b = __builtin_convertvector(v, bf16x2_t); return __builtin_bit_cast(unsigned, b); }
__device__ __forceinline__ float att_bf16_up(float x) { unsigned u = __float_as_uint(x); if (u & 0xFFFFu) { u &= 0xFFFF0000u; if (x > 0.f) u += 0x10000u; } return __uint_as_float(u); }
__device__ __forceinline__ s16x4 vtr(lds_cptr p) { return __builtin_bit_cast(s16x4, __builtin_amdgcn_ds_read_tr16_b64_v4i16((ATT_LAS v4i16_t*)p)); }
#define ATT_KS(j) (((j) & (NSLOT - 1)) * KSLOT)
#define ATT_VS(j) (((j) & (NSLOT - 1)) * VSLOT)
#define ATT_WAIT_BAR() asm volatile("s_waitcnt vmcnt(0) lgkmcnt(0)\n\ts_barrier" ::: "memory")
#define ATT_WAIT_BAR_N(three) do { if (three) asm volatile("s_waitcnt vmcnt(3) lgkmcnt(0)\n\ts_barrier" ::: "memory"); else asm volatile("s_waitcnt vmcnt(2) lgkmcnt(0)\n\ts_barrier" ::: "memory"); } while (0)

struct Unit {
    const bf16_t* Q; int q_pitch;
    const bf16_t* K; int k_pitch;
    const bf16_t* Kr;
    const bf16_t* V; int v_pitch;
    int key0, ntiles;
    int q0;
    const unsigned short* list; int len;
    const float* posf;
    float slope2;
    bf16_t* O; int o_pitch;
    bf16_t* part; float* plse; int h;
};

template <int MODE> __device__ __forceinline__ void unit(const Unit& U, char* shm, const int wid) {
    constexpr int DQK = (MODE == 0) ? 96 : 64, ND0 = DQK / 16;
    const int lane = pg8::lane_id_v(), tid = wid * 64 + lane, r32 = lane & 31, hi = lane >> 5;
    const unsigned lds0 = (unsigned)(uintptr_t)shm;
    const lds_cptr shm3 = (lds_cptr)shm;
    ATT_LAS float* wsf = (ATT_LAS float*)(shm3 + LDS_WS) + wid * 64;
    int qrow, slot = 0; bool valid = true;
    if (MODE == 2) { const int e = wid * 32 + r32; valid = e < U.len; const unsigned ent = valid ? (unsigned)U.list[e] : (unsigned)U.list[0]; qrow = (int)(ent & 0x3FFFu); slot = 1 + (int)(ent >> 14); }
    else qrow = U.q0 + wid * 32 + r32;
    const unsigned koff = (unsigned)((U.key0 + 8 * wid + (lane >> 3)) * U.k_pitch + (((lane & 7) ^ ((4 * wid + (lane >> 4)) & 7)) * 8)) * 2u;
    const unsigned kroff = (MODE == 0) ? (unsigned)((U.key0 + 16 * (wid & 3) + (lane >> 2)) * 32 + (((lane & 3) ^ ((lane >> 4) & 3)) * 8)) * 2u : 0u;
    const unsigned voff = (unsigned)((U.key0 + 16 * (wid & 3) + (lane >> 2)) * U.v_pitch + (wid >> 2) * 32 + (lane & 3) * 8) * 2u;
#define ATT_DMA(t, ks, vs) do { glds16((const char*)U.K + koff + (size_t)(t) * (KVBLK * 2) * U.k_pitch, (unsigned)(lds0 + LDS_K + wid * 1024 + (ks))); \
        if (MODE == 0 && wid < 4) glds16((const char*)U.Kr + kroff + (size_t)(t) * (KVBLK * 64), (unsigned)(lds0 + LDS_K + (8 + (wid & 3)) * 1024 + (ks))); \
        glds16((const char*)U.V + voff + (size_t)(t) * (KVBLK * 2) * U.v_pitch, (unsigned)(lds0 + LDS_V + wid * 1024 + (vs))); } while (0)
    const int NT = U.ntiles;
    ATT_DMA(0, 0, 0);
    if (NT > 1) ATT_DMA(1, KSLOT, VSLOT);
    bf16x8 qr[ND0];
    { const bf16_t* Qw = U.Q + (size_t)qrow * U.q_pitch + hi * 8;
#pragma unroll
      for (int d0 = 0; d0 < ND0; ++d0) qr[d0] = *reinterpret_cast<const bf16x8*>(Qw + d0 * 16); }
    float pq = 0.f;
    if (MODE != 0) { pq = U.posf[qrow]; if (tid < 256) ((ATT_LAS float*)(shm3 + LDS_POSK))[tid] = U.posf[U.key0 + tid]; }
    float mhat = -1e30f, l_reg = 0.f; f32x16 o[2]; o[0] = f32x16{}; o[1] = f32x16{};
    const int km_ = (r32 >> 1) & 7, kmr_ = (r32 >> 2) & 3;
    const int ka0 = LDS_K + r32 * 128 + 32 * (km_ >> 1) + 16 * (hi ^ (km_ & 1));
    const int kb0 = LDS_K + 8192 + r32 * 64 + 32 * (kmr_ >> 1) + 16 * (hi ^ (kmr_ & 1));
#define ATT_KADDR(d0, half, KS) (shm3 + (KS) + (((d0) < 4) ? ((ka0 ^ ((d0) << 5)) + (half) * 4096) : ((kb0 ^ (((d0) - 4) << 5)) + (half) * 2048)))
    const lds_cptr vp0 = shm3 + LDS_V + ((lane >> 4) & 1) * 32 + (lane & 3) * 8 + (4 * hi + ((lane & 15) >> 2)) * 64;
#define ATT_QKT(P0, P1, KS) do { P0 = f32x16{}; P1 = f32x16{}; bf16x8 kk_[2 * ND0]; \
        _Pragma("unroll") for (int d0 = 0; d0 < ND0; ++d0) { kk_[2 * d0] = *(const ATT_LAS bf16x8*)ATT_KADDR(d0, 0, KS); kk_[2 * d0 + 1] = *(const ATT_LAS bf16x8*)ATT_KADDR(d0, 1, KS); }     \
        __builtin_amdgcn_sched_barrier(0); \
        _Pragma("unroll") for (int d0 = 0; d0 < ND0; ++d0) { \
            P0 = __builtin_amdgcn_mfma_f32_32x32x16_bf16(kk_[2 * d0], qr[d0], P0, 0, 0, 0); P1 = __builtin_amdgcn_mfma_f32_32x32x16_bf16(kk_[2 * d0 + 1], qr[d0], P1, 0, 0, 0); } } while (0)
#define ATT_SMPV(P0, P1, T, VS) do { \
        if (MODE != 0) { const ATT_LAS float* pk_ = (const ATT_LAS float*)(shm3 + LDS_POSK) + 64 * (T) + 4 * hi; \
            _Pragma("unroll") for (int g = 0; g < 4; ++g) { const f32x4 a_ = *(const ATT_LAS f32x4*)(pk_ + 8 * g), b_ = *(const ATT_LAS f32x4*)(pk_ + 8 * g + 32); \
                _Pragma("unroll") for (int j = 0; j < 4; ++j) { P0[4 * g + j] -= U.slope2 * __builtin_fabsf(pq - a_[j]); P1[4 * g + j] -= U.slope2 * __builtin_fabsf(pq - b_[j]); } } } \
        if (MODE == 0 || MODE == 1) { const int kb_ = U.key0 + 64 * (T); \
            if (kb_ + 63 > U.q0 + wid * 32) { const int dq_ = qrow - kb_ - 4 * hi; \
                _Pragma("unroll") for (int r = 0; r < 16; ++r) { const int c_ = (r & 3) + 8 * (r >> 2); if (c_ > dq_) P0[r] = -INFINITY; if (c_ + 32 > dq_) P1[r] = -INFINITY; } } } \
        float rm_ = P0[0]; \
        _Pragma("unroll") for (int r = 1; r < 16; ++r) rm_ = fmaxf(rm_, P0[r]); \
        _Pragma("unroll") for (int r = 0; r < 16; ++r) rm_ = fmaxf(rm_, P1[r]); \
        { auto rr_ = __builtin_amdgcn_permlane32_swap(__float_as_uint(rm_), __float_as_uint(rm_), false, false); rm_ = fmaxf(__uint_as_float(rr_[0]), __uint_as_float(rr_[1])); } \
        if (__any(rm_ > mhat + 10.0f)) { const float mn_ = fmaxf(mhat, rm_), f_ = __builtin_amdgcn_exp2f(mhat - mn_); mhat = mn_; l_reg *= f_; \
            _Pragma("unroll") for (int r = 0; r < 16; ++r) { o[0][r] *= f_; o[1][r] *= f_; } }                        \
        float sacc_ = 0.f; \
        _Pragma("unroll") for (int r = 0; r < 16; ++r) { P0[r] = __builtin_amdgcn_exp2f(P0[r] - mhat); P1[r] = __builtin_amdgcn_exp2f(P1[r] - mhat); sacc_ += P0[r] + P1[r]; } \
        l_reg += sacc_; \
        u32x4 pw_[4]; \
        _Pragma("unroll") for (int s_ = 0; s_ < 2; ++s_) { \
            pw_[s_] = (u32x4){cvtpk(P0[8 * s_], P0[8 * s_ + 1]), cvtpk(P0[8 * s_ + 2], P0[8 * s_ + 3]), cvtpk(P0[8 * s_ + 4], P0[8 * s_ + 5]), cvtpk(P0[8 * s_ + 6], P0[8 * s_ + 7])}; \
            pw_[2 + s_] = (u32x4){cvtpk(P1[8 * s_], P1[8 * s_ + 1]), cvtpk(P1[8 * s_ + 2], P1[8 * s_ + 3]), cvtpk(P1[8 * s_ + 4], P1[8 * s_ + 5]), cvtpk(P1[8 * s_ + 6], P1[8 * s_ + 7])}; } \
        const lds_cptr vp_ = vp0 + (VS); s16x4 vl_[8], vh_[8]; \
        _Pragma("unroll") for (int i_ = 0; i_ < 8; ++i_) { vl_[i_] = vtr(vp_ + (i_ >> 2) * 4096 + (i_ & 3) * 1024); vh_[i_] = vtr(vp_ + (i_ >> 2) * 4096 + (i_ & 3) * 1024 + 512); }     \
        __builtin_amdgcn_sched_barrier(0); \
        _Pragma("unroll") for (int i_ = 0; i_ < 8; ++i_) { \
            const bf16x8 vf_ = (bf16x8){vl_[i_][0], vl_[i_][1], vl_[i_][2], vl_[i_][3], vh_[i_][0], vh_[i_][1], vh_[i_][2], vh_[i_][3]}; \
            o[i_ >> 2] = __builtin_amdgcn_mfma_f32_32x32x16_bf16(vf_, __builtin_bit_cast(bf16x8, pw_[i_ & 3]), o[i_ >> 2], 0, 0, 0); } } while (0)
#define ATT_ACT(T) (MODE != 1 || (64 * (T) <= wid * 32 + 31))
#define ATT_ITER(SC0, SC1, SN0, SN1, T) do { const bool has_next_ = (T) + 1 < NT; \
        if (has_next_ && ATT_ACT((T) + 1)) ATT_QKT(SN0, SN1, ATT_KS((T) + 1)); \
        if (ATT_ACT(T)) ATT_SMPV(SC0, SC1, T, ATT_VS(T)); \
        if (has_next_ && (MODE == 0 || NT > NSLOT)) { if ((T) + 3 < NT) ATT_WAIT_BAR_N(dma3); else ATT_WAIT_BAR(); if ((T) + 4 < NT) ATT_DMA((T) + 4, ATT_KS(T), ATT_VS(T)); }   \
        } while (0)
    const bool dma3 = (MODE == 0) && wid < 4;
    if (NT > 2) ATT_DMA(2, 2 * KSLOT, 2 * VSLOT);
    if (NT > 3) ATT_DMA(3, 3 * KSLOT, 3 * VSLOT);
    if (MODE == 0 && NT > 3) ATT_WAIT_BAR_N(dma3); else ATT_WAIT_BAR();
    f32x16 pA0, pA1, pB0, pB1;
    ATT_QKT(pA0, pA1, 0);
    int t = 0;
    if (MODE == 0 && NT > 4) {
#define ATT_SB() __builtin_amdgcn_sched_barrier(0)
#define ATT_KLD(i, KS) kf[i] = *(const ATT_LAS bf16x8*)ATT_KADDR((i) >> 1, (i) & 1, KS)
#define ATT_VLD(i, VS) do { vlo[i] = vtr(vp0 + (VS) + ((i) >> 2) * 4096 + ((i) & 3) * 1024); vhi[i] = vtr(vp0 + (VS) + ((i) >> 2) * 4096 + ((i) & 3) * 1024 + 512); } while (0)
#define ATT_SCR(SC0, SC1, j) ((j) < 16 ? SC0[(j) & 15] : SC1[(j) & 15])
#define ATT_EXP4(SC0, SC1, g) do { if ((g) < 4) { _Pragma("unroll") for (int j_ = 0; j_ < 4; ++j_) SC0[4 * (g) + j_] = __builtin_amdgcn_exp2f(SC0[4 * (g) + j_]); } \
                                   else { _Pragma("unroll") for (int j_ = 0; j_ < 4; ++j_) SC1[4 * ((g) - 4) + j_] = __builtin_amdgcn_exp2f(SC1[4 * ((g) - 4) + j_]); } } while (0)
#define ATT_ADD4(SC0, SC1, g) do { if ((g) < 4) sacc_ += (SC0[4 * (g)] + SC0[4 * (g) + 1]) + (SC0[4 * (g) + 2] + SC0[4 * (g) + 3]); else sacc_ += (SC1[4 * ((g) - 4)] + SC1[4 * ((g) - 4) + 1]) + (SC1[4 * ((g) - 4) + 2] + SC1[4 * ((g) - 4) + 3]); } while (0)
#define ATT_CVT4(SC0, SC1, g) do { if ((g) < 4) { pw[(g) >> 1][2 * ((g) & 1)] = cvtpk(SC0[4 * (g)], SC0[4 * (g) + 1]); pw[(g) >> 1][2 * ((g) & 1) + 1] = cvtpk(SC0[4 * (g) + 2], SC0[4 * (g) + 3]); } \
                                   else { pw[(g) >> 1][2 * ((g) & 1)] = cvtpk(SC1[4 * ((g) - 4)], SC1[4 * ((g) - 4) + 1]); pw[(g) >> 1][2 * ((g) & 1) + 1] = cvtpk(SC1[4 * ((g) - 4) + 2], SC1[4 * ((g) - 4) + 3]); } } while (0)
#define ATT_GAPA(i, SC0, SC1, SN0, SN1) do { \
        if (((i) & 1) == 0) SN0 = __builtin_amdgcn_mfma_f32_32x32x16_bf16(kf[i], qr[(i) >> 1], SN0, 0, 0, 0); else SN1 = __builtin_amdgcn_mfma_f32_32x32x16_bf16(kf[i], qr[(i) >> 1], SN1, 0, 0, 0); \
        if ((i) < 8) { ATT_VLD(ATT_PJ(i), vs_); ATT_EXP4(SC0, SC1, i); } \
        if ((i) >= 1 && (i) <= 8) ATT_ADD4(SC0, SC1, (i) - 1); \
        if ((i) >= 2 && (i) <= 9) ATT_CVT4(SC0, SC1, (i) - 2); \
        ATT_SB(); } while (0)
#define ATT_PJ(j) ((((j) & 1) << 2) | ((j) >> 1))
#define ATT_VF(j) (bf16x8){vlo[j][0], vlo[j][1], vlo[j][2], vlo[j][3], vhi[j][0], vhi[j][1], vhi[j][2], vhi[j][3]}
#define ATT_GAPB(j, SN0, SN1) do { \
        o[ATT_PJ(j) >> 2] = __builtin_amdgcn_mfma_f32_32x32x16_bf16(ATT_VF(ATT_PJ(j)), __builtin_bit_cast(bf16x8, pw[ATT_PJ(j) & 3]), o[ATT_PJ(j) >> 2], 0, 0, 0);     \
        if ((j) < 6) { ATT_KLD(2 * (j), ks2_); ATT_KLD(2 * (j) + 1, ks2_); } \
        if ((j) >= 2 && (j) < 6) { const int b_ = 4 * ((j) - 2); ma_ = fmaxf(fmaxf(ma_, SN0[b_]), SN0[b_ + 1]); mb_ = fmaxf(fmaxf(mb_, SN0[b_ + 2]), SN0[b_ + 3]); ma_ = fmaxf(fmaxf(ma_, SN1[b_]), SN1[b_ + 1]); mb_ = fmaxf(fmaxf(mb_, SN1[b_ + 2]), SN1[b_ + 3]); } \
        ATT_SB(); } while (0)
#define ATT_FAST(SC0, SC1, SN0, SN1, T) do { const int vs_ = ATT_VS(T), ks2_ = ATT_KS((T) + 2); \
        { const unsigned long long bal_ = __builtin_amdgcn_ballot_w64(rm > 10.0f); float f_ = 1.f; \
          if (bal_ != 0ull) { const float mn_ = att_bf16_up(mhat + fmaxf(rm, 0.f)), dl_ = mn_ - mhat; f_ = __builtin_amdgcn_exp2f(-dl_); mhat = mn_; l_reg *= f_; \
            _Pragma("unroll") for (int r = 0; r < 16; ++r) { SC0[r] -= dl_; SC1[r] -= dl_; } \
            qx[0] = (hi == 0) ? (short)(__float_as_uint(-mhat) >> 16) : (short)0; } \
            \
          _Pragma("unroll") for (int g_ = 0; g_ < 4; ++g_) { const int d_ = g_ >> 1, b_ = 8 * (g_ & 1); \
            asm volatile("s_cmp_eq_u64 %[b], 0\n\ts_cbranch_scc1 .Lsk%=\n\ts_nop 1\n\tv_mul_f32_e32 %0, %[f], %0\n\tv_mul_f32_e32 %1, %[f], %1\n\tv_mul_f32_e32 %2, %[f], %2\n\tv_mul_f32_e32 %3, %[f], %3\n\t" \
                         "v_mul_f32_e32 %4, %[f], %4\n\tv_mul_f32_e32 %5, %[f], %5\n\tv_mul_f32_e32 %6, %[f], %6\n\tv_mul_f32_e32 %7, %[f], %7\n.Lsk%=:" \
                         : "+v"(o[d_][b_]), "+v"(o[d_][b_ + 1]), "+v"(o[d_][b_ + 2]), "+v"(o[d_][b_ + 3]), "+v"(o[d_][b_ + 4]), "+v"(o[d_][b_ + 5]), "+v"(o[d_][b_ + 6]), "+v"(o[d_][b_ + 7]) \
                         : [f] "v"(f_), [b] "s"(bal_) : "scc"); } } \
        ATT_SB(); \
        float sacc_ = 0.f; \
        SN0 = __builtin_amdgcn_mfma_f32_32x32x16_bf16(kx, qx, f32x16{}, 0, 0, 0); SN1 = __builtin_amdgcn_mfma_f32_32x32x16_bf16(kx, qx, f32x16{}, 0, 0, 0);     \
        ATT_GAPA(0, SC0, SC1, SN0, SN1); ATT_GAPA(1, SC0, SC1, SN0, SN1); ATT_GAPA(2, SC0, SC1, SN0, SN1); ATT_GAPA(3, SC0, SC1, SN0, SN1); \
        ATT_GAPA(4, SC0, SC1, SN0, SN1); ATT_GAPA(5, SC0, SC1, SN0, SN1); ATT_GAPA(6, SC0, SC1, SN0, SN1); ATT_GAPA(7, SC0, SC1, SN0, SN1); \
        ATT_GAPA(8, SC0, SC1, SN0, SN1); ATT_GAPA(9, SC0, SC1, SN0, SN1); ATT_GAPA(10, SC0, SC1, SN0, SN1); ATT_GAPA(11, SC0, SC1, SN0, SN1); \
        l_reg += sacc_; \
        float ma_ = -INFINITY, mb_ = -INFINITY; \
        ATT_GAPB(0, SN0, SN1); ATT_GAPB(1, SN0, SN1); ATT_GAPB(2, SN0, SN1); ATT_GAPB(3, SN0, SN1); ATT_GAPB(4, SN0, SN1); ATT_GAPB(5, SN0, SN1); ATT_GAPB(6, SN0, SN1); ATT_GAPB(7, SN0, SN1); \
        rm = fmaxf(ma_, mb_); \
        { auto rr_ = __builtin_amdgcn_permlane32_swap(__float_as_uint(rm), __float_as_uint(rm), false, false); rm = fmaxf(__uint_as_float(rr_[0]), __uint_as_float(rr_[1])); } \
        ATT_SB(); \
        ATT_WAIT_BAR(); ATT_DMA((T) + 4, ATT_KS(T), vs_); } while (0)
        bf16x8 kf[12]; s16x4 vlo[8], vhi[8]; u32x4 pw[4];
        float rm = pA0[0];
#pragma unroll
        for (int r = 1; r < 16; ++r) rm = fmaxf(rm, pA0[r]);
#pragma unroll
        for (int r = 0; r < 16; ++r) rm = fmaxf(rm, pA1[r]);
        { auto rr_ = __builtin_amdgcn_permlane32_swap(__float_as_uint(rm), __float_as_uint(rm), false, false); rm = fmaxf(__uint_as_float(rr_[0]), __uint_as_float(rr_[1])); }
        mhat = att_bf16_up(rm);
#pragma unroll
        for (int r = 0; r < 16; ++r) { pA0[r] -= mhat; pA1[r] -= mhat; }
        rm -= mhat;
        const bf16x8 kx = (bf16x8){(short)0x3F80, 0, 0, 0, 0, 0, 0, 0};
        bf16x8 qx = (bf16x8){0, 0, 0, 0, 0, 0, 0, 0};
        if (hi == 0) qx[0] = (short)(__float_as_uint(-mhat) >> 16);
#pragma unroll
        for (int i = 0; i < 12; ++i) ATT_KLD(i, KSLOT);
        if (wid >= 4) __builtin_amdgcn_s_setprio(1);
        for (; t + 4 < NT; t += 2) { ATT_FAST(pA0, pA1, pB0, pB1, t); ATT_FAST(pB0, pB1, pA0, pA1, t + 1); }
        if (wid >= 4) __builtin_amdgcn_s_setprio(0);
#pragma unroll
        for (int r = 0; r < 16; ++r) { pA0[r] += mhat; pA1[r] += mhat; }
#undef ATT_FAST
#undef ATT_GAPA
#undef ATT_GAPB
#undef ATT_VF
#undef ATT_PJ
#undef ATT_EXP4
#undef ATT_ADD4
#undef ATT_CVT4
#undef ATT_SCR
#undef ATT_KLD
#undef ATT_VLD
#undef ATT_SB
    }
    for (; t < NT; t += 2) {
        ATT_ITER(pA0, pA1, pB0, pB1, t);
        if (t + 1 < NT) ATT_ITER(pB0, pB1, pA0, pA1, t + 1);
    }
#undef ATT_QKT
#undef ATT_SMPV
#undef ATT_ACT
#undef ATT_ITER
    { auto rr = __builtin_amdgcn_permlane32_swap(__float_as_uint(l_reg), __float_as_uint(l_reg), false, false); l_reg = __uint_as_float(rr[0]) + __uint_as_float(rr[1]); }
    { const float rl = __builtin_amdgcn_rcpf(l_reg);
      bf16_t* prow = U.O + (size_t)(U.q0 + wid * 32 + r32) * U.o_pitch + 8 * hi;
#pragma unroll
      for (int dh = 0; dh < 2; ++dh)
#pragma unroll
        for (int jp = 0; jp < 2; ++jp) {
            unsigned a0 = cvtpk(o[dh][8 * jp] * rl, o[dh][8 * jp + 1] * rl), a1 = cvtpk(o[dh][8 * jp + 2] * rl, o[dh][8 * jp + 3] * rl);
            unsigned b0 = cvtpk(o[dh][8 * jp + 4] * rl, o[dh][8 * jp + 5] * rl), b1 = cvtpk(o[dh][8 * jp + 6] * rl, o[dh][8 * jp + 7] * rl);
            const auto s0 = __builtin_amdgcn_permlane32_swap(a0, b0, false, false); const auto s1 = __builtin_amdgcn_permlane32_swap(a1, b1, false, false);
            *(u32x4*)(prow + 32 * dh + 16 * jp) = (u32x4){s0[0], s1[0], s0[1], s1[1]}; } }
    asm volatile("s_waitcnt vmcnt(0) lgkmcnt(0)\n\ts_barrier" ::: "memory");
#undef ATT_DMA
}
}

namespace att {
constexpr int MB_REG = 65536, MB_TILE = 16384, MB_V = 8192, MB_POSK = 131072, MB_PRE = MB_POSK + 3072, MB_UT = MB_PRE + 2048, MB_NUT = 62, MB_TM = MB_UT + 1024, MB_KB = 140288, MB_ENT = MB_KB + 8192, MB_END = MB_ENT + 2048;
struct MobaCtx { const bf16_t* mqkv; const float* posf; bf16_t* part; float* plse; const unsigned* lists; const unsigned* cnt; int total, vcu, G; };
struct MobaDesc { int own, h, n; };
__device__ __forceinline__ unsigned att_bf16_rne(float f) { unsigned u = __float_as_uint(f); return (u + 0x7fffu + ((u >> 16) & 1u)) >> 16; }
__device__ __forceinline__ float att_bf2f(unsigned b) { return __uint_as_float(b << 16); }
__device__ __forceinline__ void att_split3(float c, unsigned& w1, unsigned& w2) { const unsigned c0 = att_bf16_rne(c); const float r1 = c - att_bf2f(c0); const unsigned c1 = att_bf16_rne(r1); const float r2 = r1 - att_bf2f(c1);
    w1 = c0 | (c1 << 16); w2 = att_bf16_rne(r2); }

__device__ __forceinline__ u32x4 moba_get(const MobaCtx& C, ATT_LAS const int* pre, int i) {
    const int ng = (C.vcu < C.total) ? (C.total - C.vcu + C.G - 1) / C.G : 0;
    if (i < ng) { const int gI = C.vcu + i * C.G; int lo = 0, hi = 511;
        while (lo < hi) { const int mid = (lo + hi) >> 1; if (pre[mid] > gI) hi = mid; else lo = mid + 1; }
        const int hn = lo, c = gI - (hn ? pre[hn - 1] : 0); const int len = (int)C.cnt[hn] - c * 256;
        return (u32x4){1u | ((unsigned)(hn >> 6) << 2) | ((unsigned)(hn & 63) << 5), (unsigned)(len < 256 ? len : 256), (unsigned)hn * 16384u + (unsigned)c * 256u, 0u}; }
    const int u = C.vcu + (i - ng) * C.G; if (u >= 512) return (u32x4){0u, 0u, 0u, 0u};
    return (u32x4){1u | 2u | ((unsigned)(u & 7) << 2) | ((unsigned)(u >> 3) << 5), 256u, 0u, 0u};
}
__device__ __forceinline__ void glds4(const void* gsrc, unsigned lds_dst) {
    asm volatile("s_mov_b32 m0, %1\n\ts_nop 0\n\tglobal_load_lds_dword %0, off" : : "v"(gsrc), "s"(lds_dst) : "memory", "m0"); }

template <int PROBE> __device__ __forceinline__ void moba_run(const MobaCtx& C, char* shm, const int wid) {
    const int lane = pg8::lane_id_v(), tid = wid * 64 + lane, r32 = lane & 31, hi = lane >> 5;
    const unsigned lds0 = (unsigned)(uintptr_t)shm; const lds_cptr shm3 = (lds_cptr)shm;
    ATT_LAS const int* pre = (ATT_LAS const int*)(shm3 + MB_PRE);
    const float* pmax = C.posf + 16384;
    const int km_ = (r32 >> 1) & 7;
    const int ka0 = r32 * 128 + 32 * (km_ >> 1) + 16 * (hi ^ (km_ & 1));
    const int vpl = MB_V + ((lane >> 4) & 1) * 32 + (lane & 3) * 8 + (4 * hi + ((lane & 15) >> 2)) * 64;
    const unsigned koff = (unsigned)((8 * wid + (lane >> 3)) * 1536 + (((lane & 7) ^ ((4 * wid + (lane >> 4)) & 7)) * 8)) * 2u;
    const unsigned voff = (unsigned)((16 * (wid & 3) + (lane >> 2)) * 1536 + (wid >> 2) * 32 + (lane & 3) * 8) * 2u;
#define MB_UNPACK(X_, D_) do { (D_).own = (int)(((X_) >> 1) & 1u); (D_).h = (int)(((X_) >> 2) & 7u); (D_).n = (PROBE & 4) ? 0 : (int)((X_) >> 5); } while (0)
#define MB_DMA(D_, R_) do { const char* kb_ = (const char*)(C.mqkv + 512 + (D_).h * 64 + (size_t)(D_).n * 256 * 1536); const char* vb_ = kb_ + 1024; \
        unsigned db_ = (unsigned)(lds0 + (R_) + wid * 1024); asm volatile("" : "+s"(db_));     \
        _Pragma("unroll") for (int t_ = 0; t_ < 4; ++t_) { glds16(kb_ + koff + (size_t)t_ * (64 * 1536 * 2), db_ + t_ * MB_TILE); \
                                                           glds16(vb_ + voff + (size_t)t_ * (64 * 1536 * 2), db_ + t_ * MB_TILE + MB_V); } } while (0)
#define MB_FETCH(I_, E_, X_) do { E_ = ((const ATT_LAS u32x4*)(shm3 + MB_UT))[(I_)]; X_ = (unsigned)__builtin_amdgcn_readfirstlane((int)E_[0]); } while (0)
#define MB_SMALL(U_, E_, D_) do { \
        if (!(D_).own) { const int e = wid * 32 + r32; if (hi == 0 && e < (int)E_[1]) glds4(C.lists + E_[2] + e, (unsigned)(lds0 + MB_ENT + ((U_) & 1) * 1024 + wid * 128)); } \
        if (wid < 4) glds4(C.posf + (D_).n * 256 + tid, (unsigned)(lds0 + MB_POSK + ((U_) % 3) * 1024 + wid * 256)); \
        if (tid < 4) glds4(pmax + 4 * (D_).n + tid, (unsigned)(lds0 + MB_TM + ((U_) % 3) * 16)); } while (0)
#define MB_STAGE(U_, D_) do { if (tid < 256) { const ATT_LAS float* pp_ = (const ATT_LAS float*)(shm3 + MB_POSK + ((U_) % 3) * 1024); \
            const float v_ = exp2f(-(float)((D_).h + 1)) * 1.4426950408889634f * (pp_[tid] - pp_[0]); const unsigned vh_ = att_bf16_rne(v_), vl_ = att_bf16_rne(v_ - att_bf2f(vh_)); \
            ((ATT_LAS u32x4*)(shm3 + MB_KB + ((U_) & 1) * 4096))[tid] = (u32x4){vh_ | (vl_ << 16), 0x3F803F80u, 0x00003F80u, 0u}; } } while (0)
#define MB_QROW(U_, E_, D_, META_, QR_, PQ_) do { const int e_ = wid * 32 + r32; \
        if ((D_).own) META_ = (((D_).n * 256 + e_) << 2); \
        else { const unsigned en_ = ((const ATT_LAS unsigned*)(shm3 + MB_ENT + ((U_) & 1) * 1024))[e_]; META_ = (e_ < (int)E_[1]) ? (int)(((en_ & 0x3FFFu) << 2) | (1u + ((en_ >> 14) & 3u))) : -1; } \
        const int qr_ = (PROBE & 4) ? (16128 + e_) : ((META_) >= 0 ? ((META_) >> 2) : 0); const bf16_t* Qw_ = C.mqkv + (D_).h * 64 + (size_t)qr_ * 1536 + hi * 8; \
        _Pragma("unroll") for (int d0 = 0; d0 < 4; ++d0) QR_[d0] = *reinterpret_cast<const bf16x8*>(Qw_ + d0 * 16); PQ_ = C.posf[qr_]; } while (0)
#define MB_CHEAP(U_, D_, META_, PQ_, CM_) do { const f32x4 tm_ = *(const ATT_LAS f32x4*)(shm3 + MB_TM + ((U_) % 3) * 16); CM_ = 0; \
        _Pragma("unroll") for (int t_ = 0; t_ < 4; ++t_) { bool ok_ = __all((META_) < 0 || (PQ_) >= tm_[t_]); if ((D_).own) ok_ = ok_ && (64 * t_ + 63 <= wid * 32); if (ok_) CM_ |= 1 << t_; } } while (0)
  for (int base = 0; ; base += MB_NUT) {
    __syncthreads();
    if (tid < MB_NUT) ((ATT_LAS u32x4*)(shm3 + MB_UT))[tid] = moba_get(C, pre, base + tid);
    if (tid == MB_NUT || tid == MB_NUT + 1) ((ATT_LAS u32x4*)(shm3 + MB_UT))[tid] = (u32x4){0u, 0u, 0u, 0u};
    __syncthreads();
    u32x4 ent_; unsigned xc, xn, xnn = 0u; MobaDesc D, Dn;
    MB_FETCH(0, ent_, xc);
    if (!(xc & 1u)) break;
    MB_UNPACK(xc, D);
    MB_DMA(D, 0); MB_SMALL(0, ent_, D);
    { u32x4 e1_; MB_FETCH(1, e1_, xn); MB_UNPACK(xn, Dn); if (xn & 1u) MB_SMALL(1, e1_, Dn); }
    asm volatile("" ::: "memory"); __builtin_amdgcn_s_waitcnt(0); __builtin_amdgcn_s_barrier(); asm volatile("" ::: "memory");
    int meta = -1, cm = 0; float pq = 0.f, pbase = 0.f; bf16x8 qr[4];
    MB_STAGE(0, D); MB_QROW(0, ent_, D, meta, qr, pq);
    pbase = ((const ATT_LAS float*)(shm3 + MB_POSK))[0];
    asm volatile("" ::: "memory"); __builtin_amdgcn_s_waitcnt(0); __builtin_amdgcn_s_barrier(); asm volatile("" ::: "memory");
    MB_CHEAP(0, D, meta, pq, cm);
    if (xn & 1u) MB_DMA(Dn, MB_REG);
    int i = 0;
    for (; xc & 1u; ++i) {
        int meta_n = -1; float pq_n = 0.f;
        MB_UNPACK(xn, Dn);
        const int cur = i & 1, rb = cur * MB_REG; const float slope2 = exp2f(-(float)(D.h + 1)) * 1.4426950408889634f;
        const bool valid = meta >= 0; const int qrow = valid ? (meta >> 2) : 0, slot = meta & 3;
        const ATT_LAS float* posk = (const ATT_LAS float*)(shm3 + MB_POSK + (i % 3) * 1024);
        const lds_cptr kbx = shm3 + MB_KB + cur * 4096 + r32 * 16;
        float mhat = 0.f, l_reg = 0.f; bool first_ = true; f32x16 o[2]; o[0] = f32x16{}; o[1] = f32x16{};
        unsigned qxa0 = 0u, qxa1 = 0u, qxa2 = 0u, qxr1 = 0u, qxr2 = 0u;
#define MB_QX() do { unsigned a1_, a2_, r1_, r2_; att_split3(-slope2 * (pq - pbase) - mhat, a1_, a2_); att_split3(-mhat, r1_, r2_); \
            qxa0 = hi == 0 ? 0x3F803F80u : 0u; qxa1 = hi == 0 ? a1_ : 0u; qxa2 = hi == 0 ? a2_ : 0u; qxr1 = hi == 0 ? r1_ : 0u; qxr2 = hi == 0 ? r2_ : 0u; } while (0)
        MB_QX();
        f32x16 pA0, pA1, pB0, pB1; float mA = 0.f, mB = 0.f;
#define MB_ACT(T) (!D.own || (64 * (T) <= wid * 32 + 31))
#define MB_CH(T) ((cm >> (T)) & 1)
#define MB_QKT(P0, P1, MR, T) do { bf16x8 kk_[8]; const lds_cptr kb_ = shm3 + rb + (T) * MB_TILE; \
            const bf16x8 kx0_ = *(const ATT_LAS bf16x8*)(kbx + (T) * 1024), kx1_ = *(const ATT_LAS bf16x8*)(kbx + (T) * 1024 + 512); \
            _Pragma("unroll") for (int d0 = 0; d0 < 4; ++d0) { kk_[2 * d0] = *(const ATT_LAS bf16x8*)(kb_ + (ka0 ^ (d0 << 5))); kk_[2 * d0 + 1] = *(const ATT_LAS bf16x8*)(kb_ + (ka0 ^ (d0 << 5)) + 4096); } \
            const bool ch_ = MB_CH(T); const u32x4 qs_ = (u32x4){ch_ ? qxa0 : 0u, ch_ ? qxa1 : qxr1, ch_ ? qxa2 : qxr2, 0u}; \
            __builtin_amdgcn_sched_barrier(0); \
            P0 = __builtin_amdgcn_mfma_f32_32x32x16_bf16(kx0_, __builtin_bit_cast(bf16x8, qs_), f32x16{}, 0, 0, 0); P1 = __builtin_amdgcn_mfma_f32_32x32x16_bf16(kx1_, __builtin_bit_cast(bf16x8, qs_), f32x16{}, 0, 0, 0); \
            _Pragma("unroll") for (int d0 = 0; d0 < 4; ++d0) { P0 = __builtin_amdgcn_mfma_f32_32x32x16_bf16(kk_[2 * d0], qr[d0], P0, 0, 0, 0); P1 = __builtin_amdgcn_mfma_f32_32x32x16_bf16(kk_[2 * d0 + 1], qr[d0], P1, 0, 0, 0); } \
            MR = mhat; } while (0)
#define MB_SMPV(P0, P1, MC, T) do { \
            if (__any(MC != mhat)) { const float d_ = mhat - MC; _Pragma("unroll") for (int r = 0; r < 16; ++r) { P0[r] -= d_; P1[r] -= d_; } }     \
            if (!MB_CH(T)) { const ATT_LAS float* pk_ = posk + 64 * (T) + 4 * hi; \
                _Pragma("unroll") for (int g = 0; g < 4; ++g) { const f32x4 a_ = *(const ATT_LAS f32x4*)(pk_ + 8 * g), b_ = *(const ATT_LAS f32x4*)(pk_ + 8 * g + 32); \
                    _Pragma("unroll") for (int j = 0; j < 4; ++j) { P0[4 * g + j] -= slope2 * __builtin_fabsf(pq - a_[j]); P1[4 * g + j] -= slope2 * __builtin_fabsf(pq - b_[j]); } } } \
            if (D.own && 64 * (T) + 63 > wid * 32) { int dq_ = wid * 32 + r32 - 64 * (T) - 4 * hi; asm volatile("" : "+v"(dq_));     \
                _Pragma("unroll") for (int r = 0; r < 16; ++r) { const int c_ = (r & 3) + 8 * (r >> 2); if (c_ > dq_) P0[r] = -INFINITY; if (c_ + 32 > dq_) P1[r] = -INFINITY; } } \
            float rm_ = P0[0]; \
            _Pragma("unroll") for (int r = 1; r < 16; ++r) rm_ = fmaxf(rm_, P0[r]); \
            _Pragma("unroll") for (int r = 0; r < 16; ++r) rm_ = fmaxf(rm_, P1[r]); \
            { auto rr_ = __builtin_amdgcn_permlane32_swap(__float_as_uint(rm_), __float_as_uint(rm_), false, false); rm_ = fmaxf(__uint_as_float(rr_[0]), __uint_as_float(rr_[1])); } \
            if (first_ || __any(rm_ > 10.0f)) { const float dl_ = first_ ? rm_ : fmaxf(rm_, 0.f); mhat += dl_; \
                _Pragma("unroll") for (int r = 0; r < 16; ++r) { P0[r] -= dl_; P1[r] -= dl_; } \
                if (!first_) { const float f_ = __builtin_amdgcn_exp2f(-dl_); l_reg *= f_; \
                    _Pragma("unroll") for (int r = 0; r < 16; ++r) { o[0][r] *= f_; o[1][r] *= f_; } }                        \
                first_ = false; MB_QX(); } \
            _Pragma("unroll") for (int r = 0; r < 16; ++r) { P0[r] = __builtin_amdgcn_exp2f(P0[r]); P1[r] = __builtin_amdgcn_exp2f(P1[r]); } \
            { float sa_ = 0.f;     \
              _Pragma("unroll") for (int r = 0; r < 16; ++r) { sa_ += P0[r]; sa_ += P1[r]; } \
              l_reg += sa_; } \
            u32x4 pw_[4]; \
            _Pragma("unroll") for (int s_ = 0; s_ < 2; ++s_) { \
                pw_[s_] = (u32x4){cvtpk(P0[8 * s_], P0[8 * s_ + 1]), cvtpk(P0[8 * s_ + 2], P0[8 * s_ + 3]), cvtpk(P0[8 * s_ + 4], P0[8 * s_ + 5]), cvtpk(P0[8 * s_ + 6], P0[8 * s_ + 7])}; \
                pw_[2 + s_] = (u32x4){cvtpk(P1[8 * s_], P1[8 * s_ + 1]), cvtpk(P1[8 * s_ + 2], P1[8 * s_ + 3]), cvtpk(P1[8 * s_ + 4], P1[8 * s_ + 5]), cvtpk(P1[8 * s_ + 6], P1[8 * s_ + 7])}; } \
            const lds_cptr vp_ = shm3 + rb + (T) * MB_TILE + vpl; s16x4 vl_[8], vh_[8]; \
            _Pragma("unroll") for (int i_ = 0; i_ < 8; ++i_) { vl_[i_] = vtr(vp_ + (i_ >> 2) * 4096 + (i_ & 3) * 1024); vh_[i_] = vtr(vp_ + (i_ >> 2) * 4096 + (i_ & 3) * 1024 + 512); } \
            __builtin_amdgcn_sched_barrier(0); \
            _Pragma("unroll") for (int i_ = 0; i_ < 8; ++i_) { \
                const bf16x8 vf_ = (bf16x8){vl_[i_][0], vl_[i_][1], vl_[i_][2], vl_[i_][3], vh_[i_][0], vh_[i_][1], vh_[i_][2], vh_[i_][3]}; \
                o[i_ >> 2] = __builtin_amdgcn_mfma_f32_32x32x16_bf16(vf_, __builtin_bit_cast(bf16x8, pw_[i_ & 3]), o[i_ >> 2], 0, 0, 0); } } while (0)
        if (!(PROBE & 1)) {
        if (MB_ACT(3)) MB_QKT(pA0, pA1, mA, 3);
        if (MB_ACT(2)) MB_QKT(pB0, pB1, mB, 2);
        if (MB_ACT(3)) MB_SMPV(pA0, pA1, mA, 3);
        }
        if (xn & 1u) { MB_STAGE(i + 1, Dn);
            MB_FETCH(i + 2, ent_, xnn); if (xnn & 1u) { MobaDesc Dnn; MB_UNPACK(xnn, Dnn); MB_SMALL(i + 2, ent_, Dnn); } } else xnn = 0u;
        if (!(PROBE & 1)) {
        if (!(PROBE & 64)) if (MB_ACT(1)) MB_QKT(pA0, pA1, mA, 1);
        if (MB_ACT(2)) MB_SMPV(pB0, pB1, mB, 2);
        if (!(PROBE & 64)) MB_QKT(pB0, pB1, mB, 0);
        }
        if (xn & 1u) { MB_FETCH(i + 1, ent_, xn); MB_QROW(i + 1, ent_, Dn, meta_n, qr, pq_n); }
        if (!(PROBE & 1)) {
        if (!(PROBE & 64)) if (MB_ACT(1)) MB_SMPV(pA0, pA1, mA, 1);
        if (!(PROBE & 64)) MB_SMPV(pB0, pB1, mB, 0);
        }
#undef MB_QKT
#undef MB_SMPV
#undef MB_ACT
#undef MB_CH
#undef MB_QX
        asm volatile("" ::: "memory"); __builtin_amdgcn_s_waitcnt(0); __builtin_amdgcn_s_barrier(); asm volatile("" ::: "memory");
        const int h_o = D.h; const bool valid_o = valid; const int qrow_o = qrow, slot_o = slot;
        xc = xn; xn = xnn; D = Dn; meta = meta_n; pq = pq_n;
        if (xc & 1u) { pbase = ((const ATT_LAS float*)(shm3 + MB_POSK + ((i + 1) % 3) * 1024))[0]; MB_CHEAP(i + 1, D, meta, pq, cm); }
        if (xn & 1u) { MobaDesc Dt; MB_UNPACK(xn, Dt); MB_DMA(Dt, cur * MB_REG); }
        { auto rr = __builtin_amdgcn_permlane32_swap(__float_as_uint(l_reg), __float_as_uint(l_reg), false, false); l_reg = __uint_as_float(rr[0]) + __uint_as_float(rr[1]); }
        { const float rl = __builtin_amdgcn_rcpf(l_reg);
          bf16_t* prow = C.part + ((((size_t)(qrow_o * 8 + h_o) * 4 + slot_o) * 64) & (PROBE ? ((PROBE & 4) ? (size_t)0x3FFC0 : (size_t)0x7FFFC0) : ~(size_t)0)) + 8 * hi;
#pragma unroll
          for (int dh = 0; dh < 2; ++dh)
#pragma unroll
            for (int jp = 0; jp < 2; ++jp) {
                unsigned a0 = cvtpk(o[dh][8 * jp] * rl, o[dh][8 * jp + 1] * rl), a1 = cvtpk(o[dh][8 * jp + 2] * rl, o[dh][8 * jp + 3] * rl);
                unsigned b0 = cvtpk(o[dh][8 * jp + 4] * rl, o[dh][8 * jp + 5] * rl), b1 = cvtpk(o[dh][8 * jp + 6] * rl, o[dh][8 * jp + 7] * rl);
                const auto s0 = __builtin_amdgcn_permlane32_swap(a0, b0, false, false); const auto s1 = __builtin_amdgcn_permlane32_swap(a1, b1, false, false);
                if (!(PROBE & 2)) if (valid_o) *(u32x4*)(prow + 32 * dh + 16 * jp) = (u32x4){s0[0], s1[0], s0[1], s1[1]}; }
          if (!(PROBE & 2)) if (hi == 0 && valid_o) C.plse[(size_t)(qrow_o * 8 + h_o) * 4 + slot_o] = mhat + __builtin_log2f(l_reg); }
    }
    if (i < MB_NUT) break;
  }
#undef MB_UNPACK
#undef MB_DMA
#undef MB_FETCH
#undef MB_SMALL
#undef MB_STAGE
#undef MB_QROW
#undef MB_CHEAP
}
}

namespace xb {
#define LAS __attribute__((address_space(3)))
#define XB_TMO      128
#define XB_XCNT(j)  (256  + 64 * (j))
#define XB_XSUB(j)  (1280 + 64 * (j))
#define XB_XGEN(j)  (2304 + 64 * (j))
#define XB_TOP      3328
#define XB_TOPGEN   3392
#define XCD_BAR_WORDS 3456
#define XB_SPIN_CAP (1u << 21)

__device__ __forceinline__ unsigned xb_ld(unsigned* p)              { return __hip_atomic_load(p, __ATOMIC_RELAXED, __HIP_MEMORY_SCOPE_AGENT); }
__device__ __forceinline__ unsigned xb_add(unsigned* p, unsigned v) { return __hip_atomic_fetch_add(p, v, __ATOMIC_RELAXED, __HIP_MEMORY_SCOPE_AGENT); }
__device__ __forceinline__ unsigned xb_xcc_id() { return (unsigned)__builtin_amdgcn_s_getreg((3 << 11) | 20) & 0xFu; }
#define XB_SPIN(cond, bar) do { unsigned _sp = 0; while (cond) { __builtin_amdgcn_s_sleep(1); \
    if ((++_sp & 255u) == 0u) { if (xb_ld(&(bar)[XB_TMO])) break; if (_sp > XB_SPIN_CAP) { atomicAdd(&(bar)[XB_TMO], 1u); break; } } } } while (0)

struct XcdBarrier {
    unsigned* bar; unsigned x;
    volatile LAS unsigned* st;
};

__device__ __forceinline__ XcdBarrier xcd_barrier_post(unsigned* bar, volatile LAS unsigned* st, bool leader) {
    XcdBarrier b; b.bar = bar; b.x = xb_xcc_id(); b.st = st;
    if (leader) (void)xb_add(&bar[XB_XCNT(b.x)], 1u);
    return b;
}
__device__ __forceinline__ void xcd_barrier_complete(unsigned* bar, unsigned x, unsigned& nloc, unsigned& nx) {
    const unsigned G = gridDim.x * gridDim.y * gridDim.z;
    unsigned sum, cnt, mine, sp = 0u;
    for (;;) {
        sum = 0u; cnt = 0u; mine = 0u;
#pragma unroll
        for (unsigned j = 0; j < 16; ++j) { const unsigned c = xb_ld(&bar[XB_XCNT(j)]); sum += c; cnt += (c > 0u) ? 1u : 0u; mine = (j == x) ? c : mine; }
        if (sum == G) break;
        __builtin_amdgcn_s_sleep(1);
        if ((++sp & 255u) == 0u) { if (xb_ld(&bar[XB_TMO])) break; if (sp > XB_SPIN_CAP) { atomicAdd(&bar[XB_TMO], 1u); break; } }
    }
    nloc = mine > 0u ? mine : 1u; nx = cnt > 0u ? cnt : 1u;
}

__device__ __forceinline__ void xcd_barrier(const XcdBarrier& b, bool leader) {
    asm volatile("s_waitcnt vmcnt(0)" ::: "memory");
    __syncthreads();
    if (leader) {
        unsigned* bar = b.bar;
        __builtin_amdgcn_s_waitcnt(0);
        unsigned nloc = b.st[0], nx = b.st[1];
        if (nloc == 0u) { xcd_barrier_complete(bar, b.x, nloc, nx); b.st[0] = nloc; b.st[1] = nx; }
        const unsigned old = xb_add(&bar[XB_XSUB(b.x)], 1u);
        const unsigned gen = old / nloc;
        if (old + 1u == (gen + 1u) * nloc) {
            __builtin_amdgcn_fence(__ATOMIC_RELEASE, "agent");
            asm volatile("s_waitcnt vmcnt(0)" ::: "memory");
            const unsigned og = xb_add(&bar[XB_TOP], 1u);
            const unsigned tg = og / nx;
            if (og + 1u == (tg + 1u) * nx) xb_add(&bar[XB_TOPGEN], 1u);
            else XB_SPIN(xb_ld(&bar[XB_TOPGEN]) == tg, bar);
            __builtin_amdgcn_fence(__ATOMIC_ACQUIRE, "agent");
            xb_add(&bar[XB_XGEN(b.x)], 1u);
            asm volatile("s_waitcnt vmcnt(0)" ::: "memory");
        } else {
            XB_SPIN(xb_ld(&bar[XB_XGEN(b.x)]) == gen, bar);
            __builtin_amdgcn_fence(__ATOMIC_ACQUIRE, "agent");
            asm volatile("s_waitcnt vmcnt(0)" ::: "memory");
        }
    }
    __syncthreads();
}

#undef LAS
}
namespace mk {
typedef unsigned short bf16;
typedef unsigned v4u __attribute__((ext_vector_type(4)));
typedef float f32x4 __attribute__((ext_vector_type(4)));
#define MK_LAS __attribute__((address_space(3)))
using namespace mkc;
constexpr int NWAVES = 8;
constexpr int RING_BYTES = 131072, LDS_EXTRA = RING_BYTES, LDS_MISC = RING_BYTES + 8192, LDS_BYTES = 150528;
constexpr size_t WS_BAR = 4096, BAR_BYTES = 32768;

struct Args { const float* in[18]; float* out; unsigned char* ws; int ph_lo, ph_hi; };
struct Frame { MK_LAS unsigned char* lds; int tid, lane, wave, vcu, G; };
typedef const __attribute__((address_space(4))) Args* kargs_t;
__device__ __forceinline__ kargs_t kargs() { kargs_t p = (kargs_t)__builtin_amdgcn_kernarg_segment_ptr(); asm volatile("" : "+s"(p)); return p; }
__device__ __forceinline__ Frame mkframe(MK_LAS unsigned char* lds, int wave) { Frame F; F.lds = lds; F.wave = wave; F.lane = pg8::lane_id_v(); F.tid = wave * 64 + F.lane; F.G = gridDim.x;
    { const int bx = blockIdx.x; F.vcu = (F.G % 8 == 0) ? (bx % 8) * (F.G / 8) + bx / 8 : bx; } return F; }

__device__ __forceinline__ unsigned f2bf(float f) { unsigned u = __builtin_bit_cast(unsigned, f); return (u + 0x7fffu + ((u >> 16) & 1u)) >> 16; }
__device__ __forceinline__ unsigned pk2(float lo, float hi) { return f2bf(lo) | (f2bf(hi) << 16); }
__device__ __forceinline__ float bf2f(unsigned short b) { return __builtin_bit_cast(float, (unsigned)b << 16); }
__device__ __forceinline__ float wave_sum(float v) {
#pragma unroll
    for (int o = 1; o < 64; o <<= 1) v += __shfl_xor(v, o);
    return v;
}
__constant__ float ROPE_INV[16] = {1.000000000e+00f, 5.623413324e-01f, 3.162277639e-01f, 1.778279394e-01f, 1.000000015e-01f, 5.623413250e-02f, 3.162277490e-02f, 1.778279431e-02f,
                                   9.999999776e-03f, 5.623413250e-03f, 3.162277630e-03f, 1.778279431e-03f, 1.000000047e-03f, 5.623413017e-04f, 3.162277571e-04f, 1.778279402e-04f};
__device__ __forceinline__ int rope_phys(int L) { return L < 16 ? 8 * (L >> 2) + (L & 3) : 8 * ((L - 16) >> 2) + 4 + ((L - 16) & 3); }

__device__ __forceinline__ void p0_item(const float* W, int K, int N, bf16* WT, const float* gain, int kind, MK_LAS float* scr, int item, int lane) {
    const int nblk = N / 32, kb = item / nblk, nb = item % nblk, k0 = 64 * kb, n0 = 32 * nb;
    int dbase = n0; bool perm = false; float mul = 1.0f;
    if (kind == 1) dbase = (n0 >> 7) * 256 + (n0 & 127);
    else if (kind == 2) dbase = (n0 >> 7) * 256 + 128 + (n0 & 127);
    else if (kind == 3) { if (n0 == 640) perm = true; else if (n0 >= 672) { dbase = n0 + 96; if (n0 < 1184) mul = C2M; } }
    else if (kind == 4) { perm = (n0 % 96) == 64; mul = C2Q; }
    else if (kind == 5) { const int h = n0 >> 7, e = n0 & 127; dbase = e < 64 ? h * 64 + e : 512 + h * 64 + (e - 64); }
    float wv[32];
#pragma unroll
    for (int i = 0; i < 32; ++i) wv[i] = W[(size_t)(k0 + 2 * i + (lane >> 5)) * N + n0 + (lane & 31)];
#pragma unroll
    for (int i = 0; i < 32; ++i) { const int kk = 2 * i + (lane >> 5); const float g = gain ? gain[k0 + kk] * mul : mul; scr[kk * 33 + (lane & 31)] = wv[i] * g; }
    asm volatile("s_waitcnt lgkmcnt(0)" ::: "memory");
    const int c = lane & 7;
#pragma unroll
    for (int j = 0; j < 4; ++j) { const int n = (lane >> 3) + 8 * j; const MK_LAS float* s = scr + (8 * c) * 33 + n;
        v4u o; o.x = pk2(s[0 * 33], s[1 * 33]); o.y = pk2(s[2 * 33], s[3 * 33]); o.z = pk2(s[4 * 33], s[5 * 33]); o.w = pk2(s[6 * 33], s[7 * 33]);
        const int drow = dbase + (perm ? rope_phys(n) : n);
        *(v4u*)(WT + (size_t)drow * K + k0 + 8 * c) = o; }
    asm volatile("s_waitcnt lgkmcnt(0)" ::: "memory");
}
constexpr int I_G = (DM / 64) * (DFF / 32), I_D = (DFF / 64) * (DM / 32), I_IN = (DM / 64) * (2208 / 32), I_UQ = (384 / 64) * (768 / 32), I_UKV = (256 / 64) * (1024 / 32), I_O = (DM / 64) * (DM / 32);
constexpr int NITEMS = 4 * I_G + 2 * I_D + I_IN + I_UQ + I_UKV + I_O;
__device__ __forceinline__ void p0_one_item(kargs_t ap, unsigned char* ws, MK_LAS float* scr, int it, int lane) {
    int r = it;
    if (r < I_G) { p0_item(ap->in[3], DM, DFF, (bf16*)(ws + WS_WGU1), ap->in[2], 1, scr, r, lane); return; } r -= I_G;
    if (r < I_G) { p0_item(ap->in[4], DM, DFF, (bf16*)(ws + WS_WGU1), ap->in[2], 2, scr, r, lane); return; } r -= I_G;
    if (r < I_D) { p0_item(ap->in[5], DFF, DM, (bf16*)(ws + WS_WD1), nullptr, 0, scr, r, lane); return; } r -= I_D;
    if (r < I_G) { p0_item(ap->in[14], DM, DFF, (bf16*)(ws + WS_WGU2), ap->in[13], 1, scr, r, lane); return; } r -= I_G;
    if (r < I_G) { p0_item(ap->in[15], DM, DFF, (bf16*)(ws + WS_WGU2), ap->in[13], 2, scr, r, lane); return; } r -= I_G;
    if (r < I_D) { p0_item(ap->in[16], DFF, DM, (bf16*)(ws + WS_WD2), nullptr, 0, scr, r, lane); return; } r -= I_D;
    if (r < I_IN) { p0_item(ap->in[7], DM, 2208, (bf16*)(ws + WS_WIN), ap->in[6], 3, scr, r, lane); return; } r -= I_IN;
    if (r < I_UQ) { p0_item(ap->in[9], 384, 768, (bf16*)(ws + WS_WUQ), ap->in[8], 4, scr, r, lane); return; } r -= I_UQ;
    if (r < I_UKV) { p0_item(ap->in[11], 256, 1024, (bf16*)(ws + WS_WUKV), ap->in[10], 5, scr, r, lane); return; } r -= I_UKV;
    p0_item(ap->in[12], DM, DM, (bf16*)(ws + WS_WOUT), nullptr, 0, scr, r, lane);
}
__device__ __forceinline__ void p0_tables_and_zero(kargs_t ap, const int gt, const int NGT) {
    unsigned char* ws = ap->ws;
    const int* pos = (const int*)ap->in[1]; float* posf = (float*)(ws + WS_POSF); float* cosT = (float*)(ws + WS_COS); float* sinT = (float*)(ws + WS_SIN);
    for (int e = gt; e < S * 16; e += NGT) { const int s_ = e >> 4, i = e & 15; const float ang = (float)pos[s_] * ROPE_INV[i]; float sn, cs; sincosf(ang, &sn, &cs); cosT[e] = cs; sinT[e] = sn; if (i == 0) posf[s_] = (float)pos[s_]; }
    for (int e = gt >> 6; e < S / 64; e += NGT >> 6) { int m_ = pos[64 * e + (gt & 63)];
#pragma unroll
        for (int o_ = 1; o_ < 64; o_ <<= 1) m_ = max(m_, __shfl_xor(m_, o_)); if ((gt & 63) == 0) posf[S + e] = (float)m_; }
    float* z = (float*)(ws + WS_SS2);
    for (int e = gt; e < 5 * S; e += NGT) z[e] = 0.f;
    float* km = (float*)(ws + WS_KMS);
    for (int e = gt; e < 64 * 512; e += NGT) km[e] = 0.f;
    unsigned* cnt = (unsigned*)(ws + WS_CNT);
    for (int e = gt; e < 512; e += NGT) cnt[e] = 0u;
    unsigned* padz = (unsigned*)((bf16*)(ws + WS_WIN) + (size_t)672 * DM);
    for (int e = gt; e < 96 * DM / 2; e += NGT) padz[e] = 0u;
}
__device__ __forceinline__ void p0_late_items(const Frame& F, kargs_t ap) {
    unsigned char* ws = ap->ws; MK_LAS float* scr = (MK_LAS float*)(F.lds + F.wave * 16384);
    const int w = ((int)blockIdx.x - 128) * NWAVES + F.wave, NW_ = 128 * NWAVES;
    for (int it = 2 * I_G + w; it < NITEMS; it += NW_) p0_one_item(ap, ws, scr, it, F.lane);
    p0_tables_and_zero(ap, w * 64 + F.lane, NW_ * 64);
}
__device__ __forceinline__ void p0_prologue(const Frame& F, kargs_t ap) {
    unsigned char* ws = ap->ws;
    MK_LAS float* scr = (MK_LAS float*)(F.lds + F.wave * 16384);
    const int gw = F.vcu * NWAVES + F.wave, NGW = F.G * NWAVES;
    constexpr int N_EARLY = 2 * I_G;
    const int n_here = (F.G == 256) ? N_EARLY : NITEMS;
    for (int it = gw; it < n_here; it += NGW) p0_one_item(ap, ws, scr, it, F.lane);
    const float* x = ap->in[0]; bf16* xb = (bf16*)(ws + WS_XB); float* ss1 = (float*)(ws + WS_SS1);
    for (int m = gw; m < S; m += 4 * NGW) {
        f32x4 v[4][4];
#pragma unroll
        for (int r = 0; r < 4; ++r) { const int mr = m + r * NGW; if (mr < S) { const f32x4* xr = (const f32x4*)(x + (size_t)mr * DM) + F.lane;
#pragma unroll
            for (int j = 0; j < 4; ++j) v[r][j] = xr[64 * j]; } }
#pragma unroll
        for (int r = 0; r < 4; ++r) { const int mr = m + r * NGW; if (mr < S) { unsigned long long* o8 = (unsigned long long*)(xb + (size_t)mr * DM) + F.lane; float s = 0.f;
#pragma unroll
            for (int j = 0; j < 4; ++j) { const f32x4 w = v[r][j]; s += (w[0] * w[0] + w[1] * w[1]) + (w[2] * w[2] + w[3] * w[3]); o8[64 * j] = (unsigned long long)pk2(w[0], w[1]) | ((unsigned long long)pk2(w[2], w[3]) << 32); }
            s = wave_sum(s); if (F.lane == 0) ss1[mr] = s; } }
    }
    if (F.G != 256) p0_tables_and_zero(ap, (F.vcu * NWAVES + F.wave) * 64 + F.lane, NGW * 64);
}

__device__ __forceinline__ void p4_krope(const Frame& F, kargs_t ap) { unsigned char* const wsb = ap->ws;
    const bf16* cqkv = (const bf16*)(wsb + WS_CQKV); bf16* Kr = (bf16*)(wsb + WS_KR); const float* cosT = (const float*)(wsb + WS_COS); const float* sinT = (const float*)(wsb + WS_SIN);
    const int gt = (F.vcu * NWAVES + F.wave) * 64 + F.lane, NGT = F.G * NWAVES * 64;
    for (int e = gt; e < S * 16; e += NGT) { const int s_ = e >> 4, i = e & 15, g = i >> 2, j = i & 3;
        const float x1 = bf2f(cqkv[(size_t)s_ * 768 + 640 + 8 * g + j]), x2 = bf2f(cqkv[(size_t)s_ * 768 + 640 + 8 * g + 4 + j]); const float c = cosT[e], sn = sinT[e];
        Kr[(size_t)s_ * 32 + 8 * g + j] = (bf16)f2bf(x1 * c - x2 * sn); Kr[(size_t)s_ * 32 + 8 * g + 4 + j] = (bf16)f2bf(x1 * sn + x2 * c); }
}
__device__ __forceinline__ void p4_gating(const Frame& F, kargs_t ap) { unsigned char* const wsb = ap->ws;
    const bf16* mqkv = (const bf16*)(wsb + WS_MQKV); const float* kms = (const float*)(wsb + WS_KMS); unsigned* cnt = (unsigned*)(wsb + WS_CNT); unsigned* lists = (unsigned*)(wsb + WS_LIST);
    MK_LAS float* km = (MK_LAS float*)F.lds;
    const int u0 = (F.G == 256) ? ((int)blockIdx.x < 192 ? (int)blockIdx.x : 256) : F.vcu, ustep = (F.G == 256) ? 192 : F.G;
    for (int u = u0; u < 256; u += ustep) {
        const int h = u & 7, q = (u >> 3) * 512 + F.tid, own = q >> 8;
        __syncthreads();
        for (int e = F.tid; e < 4096; e += 512) km[e] = kms[(size_t)(e >> 6) * 512 + h * 64 + (e & 63)] * (1.0f / 256.0f);
        __syncthreads();
        float qv[64];
        { const v4u* qp = (const v4u*)(mqkv + (size_t)q * 1536 + h * 64);
#pragma unroll
          for (int c = 0; c < 8; ++c) { const v4u w = qp[c];
#pragma unroll
              for (int j = 0; j < 4; ++j) { qv[8 * c + 2 * j] = __builtin_bit_cast(float, w[j] << 16); qv[8 * c + 2 * j + 1] = __builtin_bit_cast(float, w[j] & 0xFFFF0000u); } } }
        float g0 = -3e38f, g1 = -3e38f, g2 = -3e38f; int i0 = -1, i1 = -1, i2 = -1;
        const int own_max = __builtin_amdgcn_readfirstlane(own);
        for (int n = 0; n < own_max; ++n) {
            float g = 0.f;
#pragma unroll
            for (int c = 0; c < 16; ++c) { const f32x4 kk = *(const MK_LAS f32x4*)(km + n * 64 + 4 * c); g = fmaf(qv[4 * c], kk[0], g); g = fmaf(qv[4 * c + 1], kk[1], g); g = fmaf(qv[4 * c + 2], kk[2], g); g = fmaf(qv[4 * c + 3], kk[3], g); }
            if (g > g0) { g2 = g1; i2 = i1; g1 = g0; i1 = i0; g0 = g; i0 = n; }
            else if (g > g1) { g2 = g1; i2 = i1; g1 = g; i1 = n; }
            else if (g > g2) { g2 = g; i2 = n; }
        }
        MK_LAS unsigned* lcnt = (MK_LAS unsigned*)(F.lds + 16384);
        __syncthreads();
        if (F.tid < 64) lcnt[F.tid] = 0u;
        __syncthreads();
        unsigned r0 = 0u, r1 = 0u, r2 = 0u;
        if (i0 >= 0) r0 = __hip_atomic_fetch_add(lcnt + i0, 1u, __ATOMIC_RELAXED, __HIP_MEMORY_SCOPE_WORKGROUP);
        if (i1 >= 0) r1 = __hip_atomic_fetch_add(lcnt + i1, 1u, __ATOMIC_RELAXED, __HIP_MEMORY_SCOPE_WORKGROUP);
        if (i2 >= 0) r2 = __hip_atomic_fetch_add(lcnt + i2, 1u, __ATOMIC_RELAXED, __HIP_MEMORY_SCOPE_WORKGROUP);
        __syncthreads();
        if (F.tid < 64) { const unsigned c = lcnt[F.tid]; lcnt[64 + F.tid] = c ? atomicAdd(cnt + h * 64 + F.tid, c) : 0u; }
        __syncthreads();
        if (i0 >= 0) lists[(size_t)(h * 64 + i0) * S + lcnt[64 + i0] + r0] = (unsigned)(q | (0 << 14));
        if (i1 >= 0) lists[(size_t)(h * 64 + i1) * S + lcnt[64 + i1] + r1] = (unsigned)(q | (1 << 14));
        if (i2 >= 0) lists[(size_t)(h * 64 + i2) * S + lcnt[64 + i2] + r2] = (unsigned)(q | (2 << 14));
    }
    __syncthreads();
}
__device__ __forceinline__ void p5_combine(const Frame& F, kargs_t ap) { unsigned char* const wsb = ap->ws;
    const bf16* part = (const bf16*)ap->out;     const float* plse = (const float*)(wsb + WS_PLSE); bf16* cat = (bf16*)(wsb + WS_CAT);
    const int gt = (F.vcu * NWAVES + F.wave) * 64 + F.lane, NGT = F.G * NWAVES * 64;
    for (int e = gt; e < S * 8 * 8; e += NGT) { const int dg = e & 7, qh = e >> 3, q = qh >> 3, h = qh & 7; const int ns = 1 + min(3, q >> 8);
        const f32x4 ls = *(const f32x4*)(plse + (size_t)qh * 4);
        float M = ls[0]; for (int s = 1; s < 4; ++s) if (s < ns) M = fmaxf(M, ls[s]);
        float acc[8], wsum = 0.f;
#pragma unroll
        for (int j = 0; j < 8; ++j) acc[j] = 0.f;
#pragma unroll
        for (int s = 0; s < 4; ++s) if (s < ns) { const float w = __builtin_amdgcn_exp2f(ls[s] - M); wsum += w; const v4u v = *(const v4u*)(part + ((size_t)qh * 4 + s) * 64 + dg * 8);
#pragma unroll
            for (int j = 0; j < 4; ++j) { acc[2 * j] += w * __builtin_bit_cast(float, v[j] << 16); acc[2 * j + 1] += w * __builtin_bit_cast(float, v[j] & 0xFFFF0000u); } }
        const float r = 1.0f / wsum; v4u o; o.x = pk2(acc[0] * r, acc[1] * r); o.y = pk2(acc[2] * r, acc[3] * r); o.z = pk2(acc[4] * r, acc[5] * r); o.w = pk2(acc[6] * r, acc[7] * r);
        *(v4u*)(cat + (size_t)q * 1024 + 512 + h * 64 + dg * 8) = o; }
}
__device__ __forceinline__ void p9_final(const Frame& F, kargs_t ap) { unsigned char* const wsb = ap->ws;
    const float* ss = (const float*)(wsb + WS_SS4); const float* g = ap->in[17];
    const int gw = F.vcu * NWAVES + F.wave, NGW = F.G * NWAVES;
    float tsc = 1.0f;
#ifdef MK_TS
    { const unsigned long long* ts = (const unsigned long long*)(wsb + 2048); tsc = 1.0f + (float)(ts[MK_TS + 1] - ts[MK_TS]) * (float)MK_TS_SCALE; }
#endif
    for (int m = gw; m < S; m += NGW) { const float rs = tsc / sqrtf(ss[m] * (1.0f / 1024.0f) + 1e-6f); f32x4* xr = (f32x4*)(ap->out + (size_t)m * DM) + F.lane; const f32x4* gr = (const f32x4*)g + F.lane;
#pragma unroll
        for (int j = 0; j < 4; ++j) { const f32x4 v = xr[64 * j]; xr[64 * j] = v * rs * gr[64 * j]; } }
}

__global__ void __launch_bounds__(NWAVES * 64, 2) mk_fwd(Args a_unused) {
    extern __shared__ __attribute__((aligned(16))) unsigned char lds[];
    const int wave = __builtin_amdgcn_readfirstlane(threadIdx.x >> 6);
    MK_LAS unsigned char* const ldsp = (MK_LAS unsigned char*)lds;
    int lo, hi; { kargs_t ap = kargs(); lo = ap->ph_lo; hi = ap->ph_hi; }
#ifndef MK_ONLY
#define MK_ONLY -1
#endif
#define IN(k) ((MK_ONLY < 0 || MK_ONLY == (k)) && lo <= (k) && (k) < hi)
    const bool multi = (hi - lo) > 1;
    if (multi) {
        const int l0 = pg8::lane_id_v();
        if (wave == 0 && l0 < 2) ((volatile MK_LAS unsigned*)(ldsp + LDS_MISC))[l0] = 0u;
        __syncthreads();
        kargs_t ap = kargs(); (void)xb::xcd_barrier_post((unsigned*)(ap->ws + WS_BAR), (volatile MK_LAS unsigned*)(ldsp + LDS_MISC), wave == 0 && l0 == 0);
    }
    if (lo < -1) cg::this_grid().sync();
#ifdef MK_TS
#define MK_STAMP(i) do { if (blockIdx.x == 0 && wave == 0 && pg8::lane_id_v() == 0) { kargs_t ap__ = kargs(); ((unsigned long long*)(ap__->ws + 2048))[(i)] = __builtin_amdgcn_s_memrealtime(); } } while (0)
#else
#define MK_STAMP(i) do { } while (0)
#endif
    MK_STAMP(0);
#define SEAM(k) do { if (IN(k) && IN((k) + 1)) { kargs_t ap_ = kargs(); xb::XcdBarrier b_; b_.bar = (unsigned*)(ap_->ws + WS_BAR); b_.x = xb::xb_xcc_id(); b_.st = (volatile MK_LAS unsigned*)(ldsp + LDS_MISC); \
        xb::xcd_barrier(b_, wave == 0 && pg8::lane_id_v() == 0); MK_STAMP((k) + 1); } } while (0)
    if (IN(0)) { kargs_t ap = kargs(); const Frame F = mkframe(ldsp, wave);
#ifdef MK_PROBE0
        { int n0_; asm volatile("s_mov_b32 %0, 1" : "=s"(n0_)); for (int r0_ = 0; r0_ < n0_; ++r0_) { p0_prologue(F, ap); __syncthreads(); } }
#endif
        p0_prologue(F, ap); } SEAM(0);
    if (IN(1)) { kargs_t ap = kargs(); unsigned char* ws = ap->ws; pg8::Gemm g{(const bf16*)(ws + WS_XB), (const bf16*)(ws + WS_WGU1), S, NGU, DM, DM}; pg8::StaticOrder So; So.init(S, NGU, (int)gridDim.x, (int)blockIdx.x);
        pg8::EpiSwiGLU E{ws, 0}; pg8::gemm_phase<pg8::EpiSwiGLU, pg8::StaticOrder, true, true>(ldsp, g, So, E, wave);
        if (gridDim.x == 256 && blockIdx.x >= 128) { kargs_t ap2 = kargs(); const Frame F = mkframe(ldsp, wave); __syncthreads(); p0_late_items(F, ap2); } } SEAM(1);
    if (IN(2)) { kargs_t ap = kargs(); unsigned char* ws = ap->ws; pg8::Gemm g{(const bf16*)(ws + WS_ACT), (const bf16*)(ws + WS_WD1), S, DM, DFF, DFF}; pg8::StaticOrder So; So.init(S, DM, (int)gridDim.x, (int)blockIdx.x);
        pg8::EpiResid E{nullptr, ws, (int)WS_SS2, 0.5f}; pg8::gemm_phase<pg8::EpiResid, pg8::StaticOrder, true, true>(ldsp, g, So, E, wave); } SEAM(2);
    if (IN(3)) { kargs_t ap = kargs(); unsigned char* ws = ap->ws; pg8::Gemm g{(const bf16*)(ws + WS_XB), (const bf16*)(ws + WS_WIN), S, NWIN, DM, DM}; pg8::StaticOrder So; So.init(S, gridDim.x == 256 ? NWIN - 256 : NWIN, (int)gridDim.x, (int)blockIdx.x);
        pg8::EpiWin E{ws, 0}; pg8::gemm_phase<pg8::EpiWin, pg8::StaticOrder, true, true>(ldsp, g, So, E, wave); } SEAM(3);
    if (IN(4)) {
#ifdef MK_PROBE4
      int n4_; asm volatile("s_mov_b32 %0, 2" : "=s"(n4_));
      for (int r4_ = 0; r4_ < n4_; ++r4_) {
#endif
        { kargs_t ap = kargs(); unsigned char* ws = ap->ws; pg8::Gemm g{(const bf16*)(ws + WS_CQKV) + 384, (const bf16*)(ws + WS_WUKV), S, 1024, 256, 768}; pg8::StaticOrder So; So.init(S, 1024, (int)gridDim.x, (int)blockIdx.x);
          pg8::EpiKV E{ws}; pg8::gemm_phase<pg8::EpiKV, pg8::StaticOrder, true, true>(ldsp, g, So, E, wave); }
        { kargs_t ap = kargs(); unsigned char* ws = ap->ws; pg8::Gemm g{(const bf16*)(ws + WS_CQKV), (const bf16*)(ws + WS_WUQ), S, 768, 384, 768}; pg8::StaticOrder So; So.init(S, 768, (int)gridDim.x, (int)blockIdx.x);
          pg8::EpiQ E{ws}; pg8::gemm_phase<pg8::EpiQ, pg8::StaticOrder, true, true>(ldsp, g, So, E, wave); }
        if (gridDim.x == 256) { kargs_t ap = kargs(); unsigned char* ws = ap->ws; pg8::Gemm g{(const bf16*)(ws + WS_XB), (const bf16*)(ws + WS_WIN), S, NWIN, DM, DM}; pg8::TailOrder So; So.init(S, 8, (int)gridDim.x, (int)blockIdx.x);
          pg8::EpiWin E{ws, 0}; pg8::gemm_phase<pg8::EpiWin, pg8::TailOrder, true, true>(ldsp, g, So, E, wave); }
#if defined(MK_PROBE4) && MK_PROBE4 == 1
      __syncthreads(); }
#endif
        { kargs_t ap = kargs(); const Frame F = mkframe(ldsp, wave); p4_krope(F, ap); }
#if defined(MK_PROBE4) && MK_PROBE4 == 2
      __syncthreads(); }
#endif
#ifndef MK_NO_GATE
        { kargs_t ap = kargs(); const Frame F = mkframe(ldsp, wave); p4_gating(F, ap); }
#endif
    } SEAM(4);
#ifndef MK_NO_ATT5
    if (IN(5)) {
        kargs_t ap = kargs(); unsigned char* ws = ap->ws; const Frame F = mkframe(ldsp, wave);
        MK_LAS int* pre = (MK_LAS int*)(ldsp + att::MB_PRE);
        const unsigned* cnt = (const unsigned*)(ws + WS_CNT);
        __syncthreads();
        { const int c = (int)cnt[F.tid]; pre[F.tid] = (c + 255) >> 8; }
        __syncthreads();
        for (int o = 1; o < 512; o <<= 1) { const int v = pre[F.tid] + (F.tid >= o ? pre[F.tid - o] : 0); __syncthreads(); pre[F.tid] = v; __syncthreads(); }
        att::MobaCtx C; C.mqkv = (const bf16*)(ws + WS_MQKV); C.posf = (const float*)(ws + WS_POSF); C.part = (bf16*)ap->out; C.plse = (float*)(ws + WS_PLSE);
        C.lists = (const unsigned*)(ws + WS_LIST); C.cnt = cnt; C.total = pre[511]; C.vcu = F.vcu; C.G = F.G;
#ifdef MK_PROBE5
        { bf16* rp_ = C.part; float* rl_ = C.plse; C.part = (bf16*)(ws + WS_CQKV); C.plse = (float*)(ws + WS_CQKV + (16u << 20)); att::moba_run<MK_PROBE5>(C, (char*)lds, wave); __syncthreads(); C.part = rp_; C.plse = rl_; }
#endif
        att::moba_run<0>(C, (char*)lds, wave);
    }
#endif
    SEAM(5);
    if (IN(6)) {
#ifdef MK_PROBEC
        { int nc_; asm volatile("s_mov_b32 %0, 1" : "=s"(nc_)); for (int rc_ = 0; rc_ < nc_; ++rc_) { kargs_t ap = kargs(); const Frame F = mkframe(ldsp, wave); p5_combine(F, ap); __syncthreads(); } }
#endif
        { kargs_t ap = kargs(); const Frame F = mkframe(ldsp, wave); p5_combine(F, ap); }
#ifndef MK_NO_ATT6
        kargs_t ap = kargs(); unsigned char* ws = ap->ws; const Frame F = mkframe(ldsp, wave);
        att::Unit U; U.posf = nullptr; U.part = nullptr; U.plse = nullptr; U.list = nullptr; U.len = 0; U.slope2 = 0.f; U.q_pitch = 768; U.k_pitch = 512; U.v_pitch = 512; U.o_pitch = 1024; U.key0 = 0; U.Kr = (const bf16*)(ws + WS_KR);
        int vstep6 = F.G;
#ifdef MK_PROBE6
        asm volatile("s_mov_b32 %0, 0" : "=s"(vstep6));
        int npass6 = 0;
#endif
        for (int v = F.vcu; v < 256; v += vstep6) { const int h = v >> 5, s_ = v & 31;
#ifdef MK_PROBE6
            if (npass6++ >= MK_PROBE6) break;
            U.len = (npass6 == 1) ? 1 : 0;
#endif
            for (int i = 0; i < 2; ++i) { const int qb = i == 0 ? 63 - s_ : s_;
                U.h = h; U.Q = (const bf16*)(ws + WS_Q) + h * 96; U.K = (const bf16*)(ws + WS_KN) + h * 64; U.V = (const bf16*)(ws + WS_V) + h * 64; U.O = (bf16*)(ws + WS_CAT) + h * 64; U.q0 = qb * 256; U.ntiles = 4 * (qb + 1);
                att::unit<0>(U, (char*)lds, wave); } }
#endif
    } SEAM(6);
    if (IN(7)) { kargs_t ap = kargs(); unsigned char* ws = ap->ws; pg8::Gemm g{(const bf16*)(ws + WS_CAT), (const bf16*)(ws + WS_WOUT), S, DM, DM, DM}; pg8::StaticOrder So; So.init(S, DM, (int)gridDim.x, (int)blockIdx.x);
        pg8::EpiResid E{nullptr, ws, (int)WS_SS3, 1.0f}; pg8::gemm_phase<pg8::EpiResid, pg8::StaticOrder, true, true>(ldsp, g, So, E, wave); } SEAM(7);
    if (IN(8)) { kargs_t ap = kargs(); unsigned char* ws = ap->ws; pg8::Gemm g{(const bf16*)(ws + WS_XB), (const bf16*)(ws + WS_WGU2), S, NGU, DM, DM}; pg8::StaticOrder So; So.init(S, NGU, (int)gridDim.x, (int)blockIdx.x);
        pg8::EpiSwiGLU E{ws, 1};
#ifdef MK_PROBE8
        { int n8_; asm volatile("s_mov_b32 %0, 1" : "=s"(n8_)); for (int r8_ = 0; r8_ < n8_; ++r8_) { pg8::gemm_phase<pg8::EpiSwiGLU, pg8::StaticOrder, true, true>(ldsp, g, So, E, wave); __syncthreads(); } }
#endif
        pg8::gemm_phase<pg8::EpiSwiGLU, pg8::StaticOrder, true, true>(ldsp, g, So, E, wave); } SEAM(8);
    if (IN(9)) { kargs_t ap = kargs(); unsigned char* ws = ap->ws; pg8::Gemm g{(const bf16*)(ws + WS_ACT), (const bf16*)(ws + WS_WD2), S, DM, DFF, DFF}; pg8::StaticOrder So; So.init(S, DM, (int)gridDim.x, (int)blockIdx.x);
        if (gridDim.x == 256) { pg8::EpiResidNorm E{ap->out, ws, ap->in[17], 0.5f}; pg8::gemm_phase<pg8::EpiResidNorm, pg8::StaticOrder, false, true>(ldsp, g, So, E, wave); }
        else { pg8::EpiResid E{ap->out, ws, (int)WS_SS4, 0.5f}; pg8::gemm_phase<pg8::EpiResid, pg8::StaticOrder, true, true>(ldsp, g, So, E, wave); } }
    if (gridDim.x != 256) SEAM(9);
#ifdef MK_PROBE9
    if (IN(9)) { SEAM(9); kargs_t ap = kargs(); unsigned char* ws = ap->ws; pg8::Gemm g{(const bf16*)(ws + WS_ACT), (const bf16*)(ws + WS_WD2), S, DM, DFF, DFF}; pg8::StaticOrder So; So.init(S, DM, (int)gridDim.x, (int)blockIdx.x);
        pg8::EpiSwiGLU E{ws, 1}; pg8::gemm_phase<pg8::EpiSwiGLU, pg8::StaticOrder, true, true, MK_PROBE9 - 1>(ldsp, g, So, E, wave); }
#endif
    if (IN(10) && gridDim.x != 256) { kargs_t ap = kargs(); const Frame F = mkframe(ldsp, wave); p9_final(F, ap); }
#undef IN
#undef SEAM
}
constexpr int N_PHASES = 11;
}
#ifndef MK_BRINGUP
#define MK_BRINGUP 0
#endif
extern "C" void kernel_launch(void* const* d_in, const int* in_sizes, int n_in, void* d_out, int out_size, void* d_ws, size_t ws_size, hipStream_t stream) {
    static int grid = 0;
    if (grid == 0) {
        if (hipFuncSetAttribute((const void*)mk::mk_fwd, hipFuncAttributeMaxDynamicSharedMemorySize, mk::LDS_BYTES) != hipSuccess) { fprintf(stderr, "kernel_launch: hipFuncSetAttribute failed\n"); grid = -1; return; }
        int dev = 0, cus = 0, per_cu = 0;
        hipGetDevice(&dev); hipDeviceGetAttribute(&cus, hipDeviceAttributeMultiprocessorCount, dev);
        hipOccupancyMaxActiveBlocksPerMultiprocessor(&per_cu, (const void*)mk::mk_fwd, mk::NWAVES * 64, mk::LDS_BYTES);
        (void)hipGetLastError();
        grid = cus * (per_cu < 1 ? 1 : (per_cu > 1 ? 1 : per_cu));
        if (grid % 8 != 0 || grid <= 0) grid = 256;
        if (ws_size < mk::WS_END) { fprintf(stderr, "kernel_launch: workspace too small (%zu)\n", ws_size); grid = -1; return; }
    }
    if (grid < 0) return;
    mk::Args a{};
    for (int i = 0; i < 18; ++i) a.in[i] = (const float*)d_in[i];
    a.out = (float*)d_out; a.ws = (unsigned char*)d_ws;
#if MK_BRINGUP == 0
    if (hipMemsetAsync((char*)d_ws + mk::WS_BAR, 0, mk::BAR_BYTES, stream) != hipSuccess) { fprintf(stderr, "kernel_launch: memset failed\n"); return; }
    a.ph_lo = 0; a.ph_hi = mk::N_PHASES;
    void* args[] = {&a};
    hipError_t e = hipLaunchCooperativeKernel((const void*)mk::mk_fwd, dim3(grid), dim3(mk::NWAVES * 64), args, mk::LDS_BYTES, stream);
    if (e != hipSuccess) fprintf(stderr, "cooperative launch failed: %s (grid %d)\n", hipGetErrorString(e), grid);
#else
    const int nph = MK_BRINGUP == 1 ? 3 : MK_BRINGUP == 2 ? 8 : mk::N_PHASES;
    for (int ph = 0; ph < nph; ++ph) { a.ph_lo = ph; a.ph_hi = ph + 1; hipLaunchKernelGGL(mk::mk_fwd, dim3(grid), dim3(mk::NWAVES * 64), mk::LDS_BYTES, stream, a); }
#if MK_BRINGUP == 1
    nv::part_mix(d_in, (float*)d_out, d_ws, stream); nv::part_ffn2_final(d_in, (float*)d_out, d_ws, stream);
#elif MK_BRINGUP == 2
    nv::part_ffn2_final(d_in, (float*)d_out, d_ws, stream);
#endif
#endif
}
```

```cpp
#define MK_BRINGUP 0
#include <hip/hip_runtime.h>
#include <cstdio>
#include <cstdint>
#include <cmath>
#include <hip/hip_cooperative_groups.h>
namespace cg = cooperative_groups;

namespace mkc {
constexpr int S = 16384, DM = 1024, DFF = 2816, NGU = 2 * DFF, NWIN = 2304;
constexpr float LOG2E = 1.4426950408889634f;
constexpr float C2Q = 0.10206207261596577f * LOG2E;
constexpr float C2M = 0.125f * LOG2E;
constexpr size_t MiB = 1u << 20;
constexpr size_t WS_PANEL = 4096 + 16384;
constexpr size_t WS_CNT = 0;
constexpr size_t WS_SS1 = 1 * MiB, WS_SS2 = WS_SS1 + 65536, WS_SSQ = WS_SS2 + 65536, WS_SSKV = WS_SSQ + 65536, WS_SS3 = WS_SSKV + 65536, WS_SS4 = WS_SS3 + 65536;
constexpr size_t WS_KMS = WS_SS1 + 512 * 1024;
constexpr size_t WS_SSDUMMY = WS_SS1 + 384 * 1024, WS_KMSDUMMY = WS_SS1 + 640 * 1024;
constexpr size_t WS_POSF = 2 * MiB, WS_COS = 3 * MiB, WS_SIN = 4 * MiB;
constexpr size_t WS_WGU1 = 6 * MiB, WS_WD1 = 17 * MiB, WS_WGU2 = WS_WD1 + 5632 * 1024, WS_WD2 = WS_WGU2 + 11 * MiB, WS_WIN = 39 * MiB, WS_WUQ = WS_WIN + 4608 * 1024, WS_WUKV = WS_WUQ + 768 * 1024, WS_WOUT = 45 * MiB;
constexpr size_t WS_XB = 48 * MiB, WS_CQKV = 80 * MiB, WS_PLSE = 112 * MiB;
constexpr size_t WS_ACT = 114 * MiB, WS_MQKV = 114 * MiB, WS_CAT = 114 * MiB, WS_Q = 162 * MiB, WS_KN = 186 * MiB, WS_V = 202 * MiB, WS_KR = 218 * MiB, WS_LIST = 220 * MiB, WS_END = 252 * MiB;
static_assert(WS_WD2 + 5632 * 1024 <= WS_WIN && WS_WUKV + 512 * 1024 <= WS_WOUT && WS_WOUT + 2 * MiB <= WS_XB, "weight map");
}
namespace pg8 {
#define PG8_LAS __attribute__((address_space(3)))
typedef unsigned short bf16_t;
typedef short bf16x8 __attribute__((ext_vector_type(8)));
typedef float f32x4 __attribute__((ext_vector_type(4)));
typedef unsigned u32x4 __attribute__((ext_vector_type(4)));
__device__ __forceinline__ int lane_id_v() { int l; asm volatile("v_mbcnt_lo_u32_b32 %0, -1, 0\n\tv_mbcnt_hi_u32_b32 %0, -1, %0" : "=v"(l)); return l; }
constexpr int BM = 256, BK = 64, HALF = 128, HTB = HALF * BK * 2  , STAGE_BYTES = 8 * HTB, NXCD = 8, WGM = 4;

__host__ __device__ __forceinline__ int lds_byte(int r, int c) { const int st = (r >> 4) * 2 + (c >> 5), rr = r & 15, cc = c & 31, ob = rr * 64 + cc * 2; return st * 1024 + (ob ^ (((ob >> 9) & 1) << 5)); }
__host__ __device__ __forceinline__ void stage_rc(int b, int& R, int& C) { const int st = b / 1024, sb = b % 1024, swz = sb ^ (((sb >> 9) & 1) << 5); R = (st >> 1) * 16 + swz / 64; C = (st & 1) * 32 + (swz % 64) / 2; }
__host__ __device__ __forceinline__ int perm32(int rho) { const int n = rho >> 4, i = rho & 15; return 8 * (i >> 2) + 4 * n + (i & 3); }

struct Unit { int pm, pn; };
struct Gemm { const bf16_t* A; const bf16_t* Bt; int M, N, K, lda; };

struct StaticOrder {
    int nM, nN, nwg, G, c;
    __host__ __device__ void init(int M, int N, int G_, int c_) { nM = M / BM; nN = N / BM; nwg = nM * nN; G = G_; c = c_; }
    __host__ __device__ bool next(int i, Unit& u) const {
        const long L = (long)i * G + c; if (L >= nwg) return false;
        int wgid = (int)L; { const int q = nwg / NXCD, r = nwg % NXCD, xcd = wgid % NXCD, off = wgid / NXCD; wgid = (xcd < r ? xcd * (q + 1) : r * (q + 1) + (xcd - r) * q) + off; }
        const int nig = WGM * nN, gid = wgid / nig, fm = gid * WGM, gsz = (nM - fm) < WGM ? (nM - fm) : WGM;
        u.pm = fm + ((wgid % nig) % gsz); u.pn = (wgid % nig) / gsz; return true;
    }
    __device__ __forceinline__ void a_ready(const Unit&) const {}
    __device__ __forceinline__ void done(const Unit&) const {}
};
struct TailOrder {
    int nM, pn, G, c;
    __host__ __device__ void init(int M, int pn_, int G_, int c_) { nM = M / BM; pn = pn_; G = G_; c = c_; }
    __host__ __device__ bool next(int i, Unit& u) const { const int j = c - (G - nM); if (i != 0 || j < 0 || j >= nM) return false; u.pm = j; u.pn = pn; return true; }
    __device__ __forceinline__ void a_ready(const Unit&) const {}
    __device__ __forceinline__ void done(const Unit&) const {}
};
__device__ __forceinline__ unsigned cvt_pk_bf16(float lo, float hi) { unsigned r; asm volatile("v_cvt_pk_bf16_f32 %0, %1, %2" : "=v"(r) : "v"(lo), "v"(hi)); return r; }
typedef unsigned u32x2 __attribute__((ext_vector_type(2)));
constexpr float RMS_EPS = 1e-6f;
__device__ __forceinline__ float rs_of(const float* ss, int row, float invn) { return __builtin_amdgcn_rsqf(ss[row] * invn + RMS_EPS); }
__device__ __forceinline__ float silu_f(float g) { return g * __builtin_amdgcn_rcpf(1.0f + __builtin_amdgcn_exp2f(-1.4426950408889634f * g)); }
__device__ __forceinline__ u32x4 pack8(const f32x4 a, const f32x4 b) { u32x4 w; w.x = cvt_pk_bf16(a[0], a[1]); w.y = cvt_pk_bf16(a[2], a[3]); w.z = cvt_pk_bf16(b[0], b[1]); w.w = cvt_pk_bf16(b[2], b[3]); return w; }

struct EpiSwiGLU {
    static constexpr bool PERM = true, AFTER_DRAIN = false;
    unsigned char* ws; int which;
    __device__ __forceinline__ void operator()(const f32x4 (&acc)[2][2][4][2], const Unit& u, int wr, int wc, int fr, int fq) const {
        bf16_t* O = (bf16_t*)(ws + mkc::WS_ACT); const int ldo = mkc::DFF; const float* ss = (const float*)(ws + (which ? mkc::WS_SS3 : mkc::WS_SS1)); const float invn = 1.0f / 1024.0f;
        const int row0 = u.pm * BM + wr * 64 + fr, col0 = u.pn * HALF + wc * 32 + 8 * fq;
#pragma unroll
        for (int ai = 0; ai < 2; ++ai)
#pragma unroll
            for (int m = 0; m < 4; ++m) { const int row = row0 + ai * HALF + m * 16; const float rs = rs_of(ss, row, invn);
                f32x4 a0, a1;
#pragma unroll
                for (int j = 0; j < 4; ++j) { a0[j] = silu_f(acc[ai][0][m][0][j] * rs) * (acc[ai][1][m][0][j] * rs); a1[j] = silu_f(acc[ai][0][m][1][j] * rs) * (acc[ai][1][m][1][j] * rs); }
                *(u32x4*)(O + (size_t)row * ldo + col0) = pack8(a0, a1); }
    }
};
__device__ __forceinline__ f32x4 bf4_to_f32(const u32x2 w) { f32x4 r; r[0] = __builtin_bit_cast(float, w.x << 16); r[1] = __builtin_bit_cast(float, w.x & 0xFFFF0000u); r[2] = __builtin_bit_cast(float, w.y << 16); r[3] = __builtin_bit_cast(float, w.y & 0xFFFF0000u); return r; }
struct EpiResid {
    static constexpr bool PERM = false, AFTER_DRAIN = false;
    float* out; unsigned char* ws; int ss_off; float alpha;
    __device__ __forceinline__ void operator()(const f32x4 (&acc)[2][2][4][2], const Unit& u, int wr, int wc, int fr, int fq) const {
        bf16_t* xb = (bf16_t*)(ws + mkc::WS_XB); float* ss_out = (float*)(ws + ss_off);
        const int row0 = u.pm * BM + wr * 64 + fr, col0 = u.pn * BM + wc * 32 + 4 * fq;
#pragma unroll
        for (int ai = 0; ai < 2; ++ai)
#pragma unroll
            for (int m = 0; m < 4; ++m) { const int row = row0 + ai * HALF + m * 16; const size_t off = (size_t)row * 1024 + col0; float s = 0.f;
#pragma unroll
                for (int bj = 0; bj < 2; ++bj)
#pragma unroll
                    for (int n = 0; n < 2; ++n) { const f32x4 b = bf4_to_f32(*(const u32x2*)(xb + off + bj * HALF + n * 16)); const f32x4 o = b + acc[ai][bj][m][n] * alpha;
                        if (out) *(f32x4*)(out + off + bj * HALF + n * 16) = o;
                        s += (o[0] * o[0] + o[1] * o[1]) + (o[2] * o[2] + o[3] * o[3]);
                        u32x2 w; w.x = cvt_pk_bf16(o[0], o[1]); w.y = cvt_pk_bf16(o[2], o[3]); *(u32x2*)(xb + off + bj * HALF + n * 16) = w; }
                s += __shfl_xor(s, 16); s += __shfl_xor(s, 32);
                if (fq == 0) atomicAdd(ss_out + row, s);
                asm volatile("" ::: "memory"); }
    }
};
struct EpiWin {
    static constexpr bool PERM = true, AFTER_DRAIN = false;
    unsigned char* ws; int dummy;
    __device__ __forceinline__ void operator()(const f32x4 (&acc)[2][2][4][2], const Unit& u, int wr, int wc, int fr, int fq) const {
        bf16_t* cqkv = (bf16_t*)(ws + mkc::WS_CQKV); bf16_t* mqkv = (bf16_t*)(ws + mkc::WS_MQKV); const float* ss_in = (const float*)(ws + mkc::WS_SS2);
        float* ssq = (float*)(ws + (dummy ? mkc::WS_SSDUMMY : mkc::WS_SSQ)); float* sskv = (float*)(ws + (dummy ? mkc::WS_SSDUMMY + 65536 : mkc::WS_SSKV)); float* kmsum = (float*)(ws + (dummy ? mkc::WS_KMSDUMMY : mkc::WS_KMS));
        const int row0 = u.pm * BM + wr * 64 + fr;
        const bool is_mk = (u.pn == 5 || u.pn == 6);
        f32x4 cs[2][2];
#pragma unroll
        for (int bj = 0; bj < 2; ++bj)
#pragma unroll
            for (int n = 0; n < 2; ++n) cs[bj][n] = (f32x4){0.f, 0.f, 0.f, 0.f};
#pragma unroll
        for (int ai = 0; ai < 2; ++ai)
#pragma unroll
            for (int m = 0; m < 4; ++m) { const int row = row0 + ai * HALF + m * 16; const float rs = rs_of(ss_in, row, 1.0f / 1024.0f);
#pragma unroll
                for (int bj = 0; bj < 2; ++bj) { const int colt = u.pn * BM + bj * HALF, col0 = colt + wc * 32 + 8 * fq;
                    const f32x4 v0 = acc[ai][bj][m][0] * rs, v1 = acc[ai][bj][m][1] * rs;
                    bf16_t* dst = (colt < 768) ? (cqkv + (size_t)row * 768 + col0) : (mqkv + (size_t)row * 1536 + (col0 - 768));
                    *(u32x4*)dst = pack8(v0, v1);
                    if (colt < 640) { float s = (v0[0] * v0[0] + v0[1] * v0[1]) + (v0[2] * v0[2] + v0[3] * v0[3]) + (v1[0] * v1[0] + v1[1] * v1[1]) + (v1[2] * v1[2] + v1[3] * v1[3]);
                        s += __shfl_xor(s, 16); s += __shfl_xor(s, 32);
                        if (fq == 0) atomicAdd((colt < 384 ? ssq : sskv) + row, s); }
                    if (is_mk) { cs[bj][0] += v0; cs[bj][1] += v1; } } }
        if (is_mk) {
#pragma unroll
            for (int bj = 0; bj < 2; ++bj)
#pragma unroll
                for (int n = 0; n < 2; ++n)
#pragma unroll
                    for (int j = 0; j < 4; ++j) { float s = cs[bj][n][j]; s += __shfl_xor(s, 1); s += __shfl_xor(s, 2); s += __shfl_xor(s, 4); s += __shfl_xor(s, 8);
                        if (fr == 0) atomicAdd(kmsum + (size_t)u.pm * 512 + (u.pn * BM + bj * HALF + wc * 32 + 8 * fq + 4 * n + j - 1280), s); }
        }
    }
};
struct EpiKV {
    static constexpr bool PERM = true, AFTER_DRAIN = false;
    unsigned char* ws;
    __device__ __forceinline__ void operator()(const f32x4 (&acc)[2][2][4][2], const Unit& u, int wr, int wc, int fr, int fq) const {
        bf16_t* Kn = (bf16_t*)(ws + mkc::WS_KN); bf16_t* V = (bf16_t*)(ws + mkc::WS_V); const float* ss = (const float*)(ws + mkc::WS_SSKV);
        const int row0 = u.pm * BM + wr * 64 + fr;
#pragma unroll
        for (int ai = 0; ai < 2; ++ai)
#pragma unroll
            for (int m = 0; m < 4; ++m) { const int row = row0 + ai * HALF + m * 16; const float rs = rs_of(ss, row, 1.0f / 256.0f);
#pragma unroll
                for (int bj = 0; bj < 2; ++bj) { const int colt = u.pn * BM + bj * HALF, col0 = colt + wc * 32 + 8 * fq;
                    bf16_t* dst = (colt < 512) ? (Kn + (size_t)row * 512 + col0) : (V + (size_t)row * 512 + (col0 - 512));
                    *(u32x4*)dst = pack8(acc[ai][bj][m][0] * rs, acc[ai][bj][m][1] * rs); } }
    }
};
struct EpiQ {
    static constexpr bool PERM = true, AFTER_DRAIN = false;
    unsigned char* ws;
    __device__ __forceinline__ void operator()(const f32x4 (&acc)[2][2][4][2], const Unit& u, int wr, int wc, int fr, int fq) const {
        bf16_t* Q = (bf16_t*)(ws + mkc::WS_Q); const float* ss = (const float*)(ws + mkc::WS_SSQ); const float* cosT = (const float*)(ws + mkc::WS_COS); const float* sinT = (const float*)(ws + mkc::WS_SIN);
        const int row0 = u.pm * BM + wr * 64 + fr;
#pragma unroll
        for (int ai = 0; ai < 2; ++ai)
#pragma unroll
            for (int m = 0; m < 4; ++m) { const int row = row0 + ai * HALF + m * 16; const float rs = rs_of(ss, row, 1.0f / 384.0f);
#pragma unroll
                for (int bj = 0; bj < 2; ++bj) { const int col0 = u.pn * BM + bj * HALF + wc * 32 + 8 * fq; const int d = col0 % 96;
                    f32x4 v0 = acc[ai][bj][m][0] * rs, v1 = acc[ai][bj][m][1] * rs;
                    if (d >= 64) { const int g = (d - 64) >> 3; const f32x4 c = *(const f32x4*)(cosT + (size_t)row * 16 + 4 * g), s = *(const f32x4*)(sinT + (size_t)row * 16 + 4 * g);
                        const f32x4 o0 = v0 * c - v1 * s, o1 = v0 * s + v1 * c; v0 = o0; v1 = o1; }
                    *(u32x4*)(Q + (size_t)row * 768 + col0) = pack8(v0, v1); }
                asm volatile("" ::: "memory"); }
    }
};
struct EpiResidNorm {
    static constexpr bool PERM = false, AFTER_DRAIN = true;
    float* out; unsigned char* ws; const float* gain; float alpha;
    __device__ __forceinline__ void fused(f32x4 (&acc)[2][2][4][2], const Unit& u, int wr, int wc, int fr, int fq, PG8_LAS unsigned char* lds, int wid, int lane) const {
        float* ss = (float*)(ws + mkc::WS_SS4); unsigned* pcnt = (unsigned*)(ws + mkc::WS_PANEL) + 64 * u.pm; const bf16_t* xb = (const bf16_t*)(ws + mkc::WS_XB);
        const int row0 = u.pm * BM + wr * 64 + fr, col0 = u.pn * BM + wc * 32 + 4 * fq;
#pragma unroll
        for (int ai = 0; ai < 2; ++ai)
#pragma unroll
            for (int m = 0; m < 4; ++m) { const int row = row0 + ai * HALF + m * 16; const size_t off = (size_t)row * 1024 + col0; float s = 0.f;
#pragma unroll
                for (int bj = 0; bj < 2; ++bj)
#pragma unroll
                    for (int n = 0; n < 2; ++n) { const f32x4 b = bf4_to_f32(*(const u32x2*)(xb + off + bj * HALF + n * 16)); const f32x4 o = b + acc[ai][bj][m][n] * alpha; acc[ai][bj][m][n] = o;
                        s += (o[0] * o[0] + o[1] * o[1]) + (o[2] * o[2] + o[3] * o[3]); }
                s += __shfl_xor(s, 16); s += __shfl_xor(s, 32);
                if (fq == 0) atomicAdd(ss + row, s);
                asm volatile("" : "+v"(acc[ai][0][m][0]), "+v"(acc[ai][0][m][1]), "+v"(acc[ai][1][m][0]), "+v"(acc[ai][1][m][1]));
                if (m & 1) asm volatile("" ::: "memory"); }
        asm volatile("s_waitcnt vmcnt(0)" ::: "memory"); __builtin_amdgcn_s_barrier(); asm volatile("" ::: "memory");
        if (wid == 0) {
            if (lane == 0) { __builtin_amdgcn_fence(__ATOMIC_RELEASE, "agent"); asm volatile("s_waitcnt vmcnt(0)" ::: "memory"); __hip_atomic_fetch_add(pcnt, 1u, __ATOMIC_RELAXED, __HIP_MEMORY_SCOPE_AGENT); }
            unsigned spins = 0;
            while ((unsigned)__builtin_amdgcn_readfirstlane(__hip_atomic_load(pcnt, __ATOMIC_RELAXED, __HIP_MEMORY_SCOPE_AGENT)) < 4u) { __builtin_amdgcn_s_sleep(2); if (++spins > (1u << 22)) break; }
            __builtin_amdgcn_fence(__ATOMIC_ACQUIRE, "agent");
        }
        asm volatile("s_waitcnt vmcnt(0) lgkmcnt(0)" ::: "memory"); __builtin_amdgcn_s_barrier(); asm volatile("" ::: "memory");
        f32x4 gv[2][2];
#pragma unroll
        for (int bj = 0; bj < 2; ++bj)
#pragma unroll
            for (int n = 0; n < 2; ++n) gv[bj][n] = *(const f32x4*)(gain + col0 + bj * HALF + n * 16);
#pragma unroll
        for (int ai = 0; ai < 2; ++ai)
#pragma unroll
            for (int m = 0; m < 4; ++m) { const int row = row0 + ai * HALF + m * 16; const size_t off = (size_t)row * 1024 + col0;
                const float tot = __hip_atomic_load(ss + row, __ATOMIC_RELAXED, __HIP_MEMORY_SCOPE_AGENT); const float rs = __builtin_amdgcn_rsqf(tot * (1.0f / 1024.0f) + RMS_EPS);
#pragma unroll
                for (int bj = 0; bj < 2; ++bj)
#pragma unroll
                    for (int n = 0; n < 2; ++n) *(f32x4*)(out + off + bj * HALF + n * 16) = acc[ai][bj][m][n] * rs * gv[bj][n]; }
    }
};

template <class Epi, class Sched, bool ALIGN_EPI = false, bool SP2 = false, int XP = 0>
__device__ __forceinline__ void gemm_phase(PG8_LAS unsigned char* lds, const Gemm g, const Sched& S, const Epi& E, const int wid) {
    const int lane = lane_id_v(), tid = wid * 64 + lane, wr = wid >> 2, wc = wid & 3, fr = lane & 15, fq = lane >> 4;
    const int K = g.K, nt = K / BK, lda = g.lda;
    unsigned voffA[2], voffB[2];
#pragma unroll
    for (int i = 0; i < 2; ++i) { int R, C; stage_rc(tid * 16 + i * 8192, R, C); const int Rb = Epi::PERM ? ((R & ~31) + perm32(R & 31)) : R;
        voffA[i] = (unsigned)(R * lda + C) * 2u; voffB[i] = (unsigned)(Rb * K + C) * 2u; }
    const size_t kstep = (size_t)(BK * 2);
    const size_t hstep = (size_t)HALF * K * 2;
    const size_t tstep = 2 * hstep; const size_t hstepA = (size_t)HALF * lda * 2, tstepA = 2 * hstepA;
    const unsigned ldsw = (unsigned)wid * 1024u;
    const int aoff = lds_byte(wr * 64 + fr, fq * 8), boff = lds_byte(wc * 32 + fr, fq * 8);
#define PG8_SA(b, h) (((b) * 2 + (h)) * HTB)
#define PG8_SB(b, h) ((4 + (b) * 2 + (h)) * HTB)
#define PG8_STAGE(bufoff, gbase, voff) do { if constexpr (XP & 4) break; _Pragma("unroll") for (int _i = 0; _i < 2; ++_i) \
        __builtin_amdgcn_global_load_lds((const unsigned*)((const char*)(gbase) + (voff)[_i]), (PG8_LAS unsigned*)(lds + (bufoff) + ldsw + _i * 8192), 16, 0, 0); } while (0)
#define PG8_LDA(dst, b, h) do { if constexpr (XP & 8) break; _Pragma("unroll") for (int m = 0; m < 4; ++m) _Pragma("unroll") for (int k = 0; k < 2; ++k) dst[m][k] = *(const PG8_LAS bf16x8*)(lds + PG8_SA(b, h) + aoff + m * 2048 + k * 1024); } while (0)
#define PG8_LDB(dst, b, h) do { if constexpr (XP & 8) break; _Pragma("unroll") for (int n = 0; n < 2; ++n) _Pragma("unroll") for (int k = 0; k < 2; ++k) dst[n][k] = *(const PG8_LAS bf16x8*)(lds + PG8_SB(b, h) + boff + n * 2048 + k * 1024); } while (0)
#define PG8_MMA(ai, bj, At, Bt) do { if constexpr (XP & 2) break; if constexpr (!(XP & 16)) __builtin_amdgcn_s_setprio(1); _Pragma("unroll") for (int m = 0; m < 4; ++m) _Pragma("unroll") for (int n = 0; n < 2; ++n) _Pragma("unroll") for (int k = 0; k < 2; ++k) \
        acc[ai][bj][m][n] = __builtin_amdgcn_mfma_f32_16x16x32_bf16(Bt[n][k], At[m][k], acc[ai][bj][m][n], 0, 0, 0); if constexpr (!(XP & 16)) __builtin_amdgcn_s_setprio(0); } while (0)
#define PG8_WAIT_V(n) do { if constexpr (XP & 32) __builtin_amdgcn_s_setprio(0); asm volatile("s_waitcnt vmcnt(" #n ")" ::: "memory"); } while (0)
#define PG8_WAIT_L(n) asm volatile("s_waitcnt lgkmcnt(" #n ")" ::: "memory")
#define PG8_BAR do { if constexpr (!(XP & 1)) __builtin_amdgcn_s_barrier(); if constexpr (XP & 32) __builtin_amdgcn_s_setprio(2); } while (0)
#define PG8_SCHED __builtin_amdgcn_sched_barrier(0)
    Unit cur, nxt; int ui = 0;
    if (!S.next(0, cur)) return;
    f32x4 acc[2][2][4][2];
#pragma unroll
    for (int a = 0; a < 2; ++a)
#pragma unroll
        for (int b = 0; b < 2; ++b)
#pragma unroll
            for (int m = 0; m < 4; ++m)
#pragma unroll
                for (int n = 0; n < 2; ++n) acc[a][b][m][n] = (f32x4){0.f, 0.f, 0.f, 0.f};
    bf16x8 At[4][2], B0[2][2], B1[2][2];
    const char* cA = (const char*)g.A + (size_t)cur.pm * tstepA; const char* cB = (const char*)g.Bt + (size_t)cur.pn * tstep;
    S.a_ready(cur);
    if constexpr (SP2) {
        PG8_STAGE(PG8_SB(0, 0), cB, voffB); PG8_STAGE(PG8_SB(0, 1), cB + hstep, voffB); PG8_STAGE(PG8_SA(0, 0), cA, voffA); PG8_STAGE(PG8_SA(0, 1), cA + hstepA, voffA);
        if (wr == 1) PG8_BAR;
        PG8_WAIT_V(2); PG8_BAR;
        PG8_STAGE(PG8_SB(1, 0), cB + kstep, voffB); PG8_STAGE(PG8_SA(1, 0), cA + kstep, voffA); PG8_STAGE(PG8_SB(1, 1), cB + hstep + kstep, voffB);
        PG8_WAIT_V(6); PG8_BAR;
    } else {
        PG8_STAGE(PG8_SB(0, 0), cB, voffB); PG8_STAGE(PG8_SA(0, 0), cA, voffA); PG8_STAGE(PG8_SB(0, 1), cB + hstep, voffB); PG8_STAGE(PG8_SA(0, 1), cA + hstepA, voffA);
        if (wr == 1) PG8_BAR;
        PG8_WAIT_V(4); PG8_BAR;
        PG8_STAGE(PG8_SB(1, 0), cB + kstep, voffB); PG8_STAGE(PG8_SA(1, 0), cA + kstep, voffA); PG8_STAGE(PG8_SB(1, 1), cB + hstep + kstep, voffB);
        PG8_WAIT_V(6); PG8_BAR;
    }
    for (;;) {
        const bool has_next = S.next(ui + 1, nxt);
        const char* nA = has_next ? (const char*)g.A + (size_t)nxt.pm * tstepA : cA; const char* nB = has_next ? (const char*)g.Bt + (size_t)nxt.pn * tstep : cB;
#pragma nounroll
        for (int t = 0; t < nt; t += 2) {
            const bool last = (t == nt - 2);
            const char* a1 = cA + (size_t)(t + 1) * kstep;
            const char* a2 = last ? nA : cA + (size_t)(t + 2) * kstep; const char* b2 = last ? nB : cB + (size_t)(t + 2) * kstep;
            const char* a3 = a2 + kstep; const char* b3 = b2 + kstep;
            if (last && has_next) S.a_ready(nxt);
            if constexpr (SP2) {
            PG8_LDB(B0, 0, 0); PG8_LDB(B1, 0, 1); PG8_SCHED; PG8_LDA(At, 0, 0); PG8_STAGE(PG8_SA(1, 1), a1 + hstepA, voffA);
            PG8_WAIT_V(8); PG8_WAIT_L(0); PG8_BAR; PG8_MMA(0, 0, At, B0); PG8_MMA(0, 1, At, B1); PG8_BAR; PG8_SCHED;
            PG8_LDA(At, 0, 1); PG8_STAGE(PG8_SB(0, 0), b2, voffB); PG8_STAGE(PG8_SB(0, 1), b2 + hstep, voffB); PG8_STAGE(PG8_SA(0, 0), a2, voffA);
            PG8_WAIT_V(8); PG8_WAIT_L(0); PG8_BAR; PG8_MMA(1, 0, At, B0); PG8_MMA(1, 1, At, B1); PG8_BAR; PG8_SCHED;
            PG8_LDB(B0, 1, 0); PG8_LDB(B1, 1, 1); PG8_SCHED; PG8_LDA(At, 1, 0); PG8_STAGE(PG8_SA(0, 1), a2 + hstepA, voffA);
            PG8_WAIT_V(8); PG8_WAIT_L(0); PG8_BAR; PG8_MMA(0, 0, At, B0); PG8_MMA(0, 1, At, B1); PG8_BAR; PG8_SCHED;
            PG8_LDA(At, 1, 1); PG8_STAGE(PG8_SB(1, 0), b3, voffB); PG8_STAGE(PG8_SB(1, 1), b3 + hstep, voffB); PG8_STAGE(PG8_SA(1, 0), a3, voffA);
            PG8_WAIT_V(8); PG8_WAIT_L(0); PG8_BAR; PG8_MMA(1, 0, At, B0); PG8_MMA(1, 1, At, B1); PG8_BAR; PG8_SCHED;
            } else {
            PG8_LDB(B0, 0, 0); PG8_SCHED; PG8_LDA(At, 0, 0); PG8_STAGE(PG8_SA(1, 1), a1 + hstepA, voffA);
            PG8_WAIT_L(8); PG8_BAR; PG8_WAIT_L(0); PG8_MMA(0, 0, At, B0); PG8_BAR; PG8_SCHED;
            PG8_LDB(B1, 0, 1); PG8_STAGE(PG8_SB(0, 0), b2, voffB);
            PG8_BAR; PG8_WAIT_L(0); PG8_MMA(0, 1, At, B1); PG8_BAR;
            PG8_LDA(At, 0, 1); PG8_STAGE(PG8_SA(0, 0), a2, voffA);
            PG8_BAR; PG8_WAIT_L(0); PG8_MMA(1, 0, At, B0); PG8_BAR; PG8_SCHED;
            PG8_STAGE(PG8_SB(0, 1), b2 + hstep, voffB);
            PG8_WAIT_V(6); PG8_BAR; PG8_MMA(1, 1, At, B1); PG8_BAR;
            PG8_LDB(B0, 1, 0); PG8_SCHED; PG8_LDA(At, 1, 0); PG8_STAGE(PG8_SA(0, 1), a2 + hstepA, voffA);
            PG8_WAIT_L(8); PG8_BAR; PG8_WAIT_L(0); PG8_MMA(0, 0, At, B0); PG8_BAR; PG8_SCHED;
            PG8_LDB(B1, 1, 1); PG8_STAGE(PG8_SB(1, 0), b3, voffB);
            PG8_BAR; PG8_WAIT_L(0); PG8_MMA(0, 1, At, B1); PG8_BAR;
            PG8_LDA(At, 1, 1); PG8_STAGE(PG8_SA(1, 0), a3, voffA);
            PG8_BAR; PG8_WAIT_L(0); PG8_MMA(1, 0, At, B0); PG8_BAR; PG8_SCHED;
            PG8_STAGE(PG8_SB(1, 1), b3 + hstep, voffB);
            PG8_WAIT_V(6); PG8_BAR; PG8_MMA(1, 1, At, B1); PG8_BAR;
            }
        }
        if constexpr (ALIGN_EPI) { if (wr == 0) PG8_BAR; }
        if constexpr (!Epi::AFTER_DRAIN) { E(acc, cur, wr, wc, fr, fq); S.done(cur); }
        if (!has_next) break;
#pragma unroll
        for (int a = 0; a < 2; ++a)
#pragma unroll
            for (int b = 0; b < 2; ++b)
#pragma unroll
                for (int m = 0; m < 4; ++m)
#pragma unroll
                    for (int n = 0; n < 2; ++n) acc[a][b][m][n] = (f32x4){0.f, 0.f, 0.f, 0.f};
        cur = nxt; cA = nA; cB = nB; ++ui;
        if constexpr (ALIGN_EPI) { if (wr == 1) PG8_BAR; }
    }
    PG8_WAIT_V(0);
    if constexpr (!ALIGN_EPI) { if (wr == 0) PG8_BAR; }
    PG8_BAR;
    if constexpr (Epi::AFTER_DRAIN) { E.fused(acc, cur, wr, wc, fr, fq, lds, wid, lane); S.done(cur); }
#undef PG8_SA
#undef PG8_SB
#undef PG8_STAGE
#undef PG8_LDA
#undef PG8_LDB
#undef PG8_MMA
#undef PG8_WAIT_V
#undef PG8_WAIT_L
#undef PG8_BAR
#undef PG8_SCHED
}
}
namespace att {
typedef unsigned short bf16_t;
using bf16x8 = __attribute__((ext_vector_type(8))) short;
using s16x4 = __attribute__((ext_vector_type(4))) short;
using f32x16 = __attribute__((ext_vector_type(16))) float;
using f32x4 = __attribute__((ext_vector_type(4))) float;
using u32x4 = __attribute__((ext_vector_type(4))) unsigned;
typedef short v4i16_t __attribute__((ext_vector_type(4)));
#define ATT_LAS __attribute__((address_space(3)))
typedef ATT_LAS const char* lds_cptr;
constexpr int NW = 8, KVBLK = 64;
constexpr int KSLOT = 12288, VSLOT = 8192, NSLOT = 4;
constexpr int LDS_K = 0, LDS_V = NSLOT * KSLOT, LDS_WS = LDS_V + NSLOT * VSLOT, LDS_OST = LDS_WS + NW * 64 * 4, LDS_POSK = LDS_OST + NW * 4096, LDS_BYTES = LDS_POSK + 1024;
__device__ __forceinline__ int crow(int r, int hi) { return (r & 3) + 8 * (r >> 2) + 4 * hi; }
__device__ __forceinline__ void glds16(const void* gsrc, unsigned lds_dst) {
    asm volatile("s_mov_b32 m0, %1\n\ts_nop 0\n\tglobal_load_lds_dwordx4 %0, off" : : "v"(gsrc), "s"(lds_dst) : "memory", "m0"); }
typedef float f32x2_t __attribute__((ext_vector_type(2))); typedef __bf16 bf16x2_t __attribute__((ext_vector_type(2)));
__device__ __forceinline__ unsigned cvtpk(float lo, float hi) { f32x2_t v = {lo, hi}; bf16x2_t b = __builtin_convertvector(v, bf16x2_t); return __builtin_bit_cast(unsigned, b); }
__device__ __forceinline__ float att_bf16_up(float x) { unsigned u = __float_as_uint(x); if (u & 0xFFFFu) { u &= 0xFFFF0000u; if (x > 0.f) u += 0x10000u; } return __uint_as_float(u); }
__device__ __forceinline__ s16x4 vtr(lds_cptr p) { return __builtin_bit_cast(s16x4, __builtin_amdgcn_ds_read_tr16_b64_v4i16((ATT_LAS v4i16_t*)p)); }
#define ATT_KS(j) (((j) & (NSLOT - 1)) * KSLOT)
#define ATT_VS(j) (((j) & (NSLOT - 1)) * VSLOT)
#define ATT_WAIT_BAR() asm volatile("s_waitcnt vmcnt(0) lgkmcnt(0)\n\ts_barrier" ::: "memory")
#define ATT_WAIT_BAR_N(three) do { if (three) asm volatile("s_waitcnt vmcnt(3) lgkmcnt(0)\n\ts_barrier" ::: "memory"); else asm volatile("s_waitcnt vmcnt(2) lgkmcnt(0)\n\ts_barrier" ::: "memory"); } while (0)

struct Unit {
    const bf16_t* Q; int q_pitch;
    const bf16_t* K; int k_pitch;
    const bf16_t* Kr;
    const bf16_t* V; int v_pitch;
    int key0, ntiles;
    int q0;
    const unsigned short* list; int len;
    const float* posf;
    float slope2;
    bf16_t* O; int o_pitch;
    bf16_t* part; float* plse; int h;
};

template <int MODE> __device__ __forceinline__ void unit(const Unit& U, char* shm, const int wid) {
    constexpr int DQK = (MODE == 0) ? 96 : 64, ND0 = DQK / 16;
    const int lane = pg8::lane_id_v(), tid = wid * 64 + lane, r32 = lane & 31, hi = lane >> 5;
    const unsigned lds0 = (unsigned)(uintptr_t)shm;
    const lds_cptr shm3 = (lds_cptr)shm;
    ATT_LAS float* wsf = (ATT_LAS float*)(shm3 + LDS_WS) + wid * 64;
    int qrow, slot = 0; bool valid = true;
    if (MODE == 2) { const int e = wid * 32 + r32; valid = e < U.len; const unsigned ent = valid ? (unsigned)U.list[e] : (unsigned)U.list[0]; qrow = (int)(ent & 0x3FFFu); slot = 1 + (int)(ent >> 14); }
    else qrow = U.q0 + wid * 32 + r32;
    const unsigned koff = (unsigned)((U.key0 + 8 * wid + (lane >> 3)) * U.k_pitch + (((lane & 7) ^ ((4 * wid + (lane >> 4)) & 7)) * 8)) * 2u;
    const unsigned kroff = (MODE == 0) ? (unsigned)((U.key0 + 16 * (wid & 3) + (lane >> 2)) * 32 + (((lane & 3) ^ ((lane >> 4) & 3)) * 8)) * 2u : 0u;
    const unsigned voff = (unsigned)((U.key0 + 16 * (wid & 3) + (lane >> 2)) * U.v_pitch + (wid >> 2) * 32 + (lane & 3) * 8) * 2u;
#define ATT_DMA(t, ks, vs) do { glds16((const char*)U.K + koff + (size_t)(t) * (KVBLK * 2) * U.k_pitch, (unsigned)(lds0 + LDS_K + wid * 1024 + (ks))); \
        if (MODE == 0 && wid < 4) glds16((const char*)U.Kr + kroff + (size_t)(t) * (KVBLK * 64), (unsigned)(lds0 + LDS_K + (8 + (wid & 3)) * 1024 + (ks))); \
        glds16((const char*)U.V + voff + (size_t)(t) * (KVBLK * 2) * U.v_pitch, (unsigned)(lds0 + LDS_V + wid * 1024 + (vs))); } while (0)
    const int NT = U.ntiles;
    ATT_DMA(0, 0, 0);
    if (NT > 1) ATT_DMA(1, KSLOT, VSLOT);
    bf16x8 qr[ND0];
    { const bf16_t* Qw = U.Q + (size_t)qrow * U.q_pitch + hi * 8;
#pragma unroll
      for (int d0 = 0; d0 < ND0; ++d0) qr[d0] = *reinterpret_cast<const bf16x8*>(Qw + d0 * 16); }
    float pq = 0.f;
    if (MODE != 0) { pq = U.posf[qrow]; if (tid < 256) ((ATT_LAS float*)(shm3 + LDS_POSK))[tid] = U.posf[U.key0 + tid]; }
    float mhat = -1e30f, l_reg = 0.f; f32x16 o[2]; o[0] = f32x16{}; o[1] = f32x16{};
    const int km_ = (r32 >> 1) & 7, kmr_ = (r32 >> 2) & 3;
    const int ka0 = LDS_K + r32 * 128 + 32 * (km_ >> 1) + 16 * (hi ^ (km_ & 1));
    const int kb0 = LDS_K + 8192 + r32 * 64 + 32 * (kmr_ >> 1) + 16 * (hi ^ (kmr_ & 1));
#define ATT_KADDR(d0, half, KS) (shm3 + (KS) + (((d0) < 4) ? ((ka0 ^ ((d0) << 5)) + (half) * 4096) : ((kb0 ^ (((d0) - 4) << 5)) + (half) * 2048)))
    const lds_cptr vp0 = shm3 + LDS_V + ((lane >> 4) & 1) * 32 + (lane & 3) * 8 + (4 * hi + ((lane & 15) >> 2)) * 64;
#define ATT_QKT(P0, P1, KS) do { P0 = f32x16{}; P1 = f32x16{}; bf16x8 kk_[2 * ND0]; \
        _Pragma("unroll") for (int d0 = 0; d0 < ND0; ++d0) { kk_[2 * d0] = *(const ATT_LAS bf16x8*)ATT_KADDR(d0, 0, KS); kk_[2 * d0 + 1] = *(const ATT_LAS bf16x8*)ATT_KADDR(d0, 1, KS); }     \
        __builtin_amdgcn_sched_barrier(0); \
        _Pragma("unroll") for (int d0 = 0; d0 < ND0; ++d0) { \
            P0 = __builtin_amdgcn_mfma_f32_32x32x16_bf16(kk_[2 * d0], qr[d0], P0, 0, 0, 0); P1 = __builtin_amdgcn_mfma_f32_32x32x16_bf16(kk_[2 * d0 + 1], qr[d0], P1, 0, 0, 0); } } while (0)
#define ATT_SMPV(P0, P1, T, VS) do { \
        if (MODE != 0) { const ATT_LAS float* pk_ = (const ATT_LAS float*)(shm3 + LDS_POSK) + 64 * (T) + 4 * hi; \
            _Pragma("unroll") for (int g = 0; g < 4; ++g) { const f32x4 a_ = *(const ATT_LAS f32x4*)(pk_ + 8 * g), b_ = *(const ATT_LAS f32x4*)(pk_ + 8 * g + 32); \
                _Pragma("unroll") for (int j = 0; j < 4; ++j) { P0[4 * g + j] -= U.slope2 * __builtin_fabsf(pq - a_[j]); P1[4 * g + j] -= U.slope2 * __builtin_fabsf(pq - b_[j]); } } } \
        if (MODE == 0 || MODE == 1) { const int kb_ = U.key0 + 64 * (T); \
            if (kb_ + 63 > U.q0 + wid * 32) { const int dq_ = qrow - kb_ - 4 * hi; \
                _Pragma("unroll") for (int r = 0; r < 16; ++r) { const int c_ = (r & 3) + 8 * (r >> 2); if (c_ > dq_) P0[r] = -INFINITY; if (c_ + 32 > dq_) P1[r] = -INFINITY; } } } \
        float rm_ = P0[0]; \
        _Pragma("unroll") for (int r = 1; r < 16; ++r) rm_ = fmaxf(rm_, P0[r]); \
        _Pragma("unroll") for (int r = 0; r < 16; ++r) rm_ = fmaxf(rm_, P1[r]); \
        { auto rr_ = __builtin_amdgcn_permlane32_swap(__float_as_uint(rm_), __float_as_uint(rm_), false, false); rm_ = fmaxf(__uint_as_float(rr_[0]), __uint_as_float(rr_[1])); } \
        if (__any(rm_ > mhat + 10.0f)) { const float mn_ = fmaxf(mhat, rm_), f_ = __builtin_amdgcn_exp2f(mhat - mn_); mhat = mn_; l_reg *= f_; \
            _Pragma("unroll") for (int r = 0; r < 16; ++r) { o[0][r] *= f_; o[1][r] *= f_; } }                        \
        float sacc_ = 0.f; \
        _Pragma("unroll") for (int r = 0; r < 16; ++r) { P0[r] = __builtin_amdgcn_exp2f(P0[r] - mhat); P1[r] = __builtin_amdgcn_exp2f(P1[r] - mhat); sacc_ += P0[r] + P1[r]; } \
        l_reg += sacc_; \
        u32x4 pw_[4]; \
        _Pragma("unroll") for (int s_ = 0; s_ < 2; ++s_) { \
            pw_[s_] = (u32x4){cvtpk(P0[8 * s_], P0[8 * s_ + 1]), cvtpk(P0[8 * s_ + 2], P0[8 * s_ + 3]), cvtpk(P0[8 * s_ + 4], P0[8 * s_ + 5]), cvtpk(P0[8 * s_ + 6], P0[8 * s_ + 7])}; \
            pw_[2 + s_] = (u32x4){cvtpk(P1[8 * s_], P1[8 * s_ + 1]), cvtpk(P1[8 * s_ + 2], P1[8 * s_ + 3]), cvtpk(P1[8 * s_ + 4], P1[8 * s_ + 5]), cvtpk(P1[8 * s_ + 6], P1[8 * s_ + 7])}; } \
        const lds_cptr vp_ = vp0 + (VS); s16x4 vl_[8], vh_[8]; \
        _Pragma("unroll") for (int i_ = 0; i_ < 8; ++i_) { vl_[i_] = vtr(vp_ + (i_ >> 2) * 4096 + (i_ & 3) * 1024); vh_[i_] = vtr(vp_ + (i_ >> 2) * 4096 + (i_ & 3) * 1024 + 512); }     \
        __builtin_amdgcn_sched_barrier(0); \
        _Pragma("unroll") for (int i_ = 0; i_ < 8; ++i_) { \
            const bf16x8 vf_ = (bf16x8){vl_[i_][0], vl_[i_][1], vl_[i_][2], vl_[i_][3], vh_[i_][0], vh_[i_][1], vh_[i_][2], vh_[i_][3]}; \
            o[i_ >> 2] = __builtin_amdgcn_mfma_f32_32x32x16_bf16(vf_, __builtin_bit_cast(bf16x8, pw_[i_ & 3]), o[i_ >> 2], 0, 0, 0); } } while (0)
#define ATT_ACT(T) (MODE != 1 || (64 * (T) <= wid * 32 + 31))
#define ATT_ITER(SC0, SC1, SN0, SN1, T) do { const bool has_next_ = (T) + 1 < NT; \
        if (has_next_ && ATT_ACT((T) + 1)) ATT_QKT(SN0, SN1, ATT_KS((T) + 1)); \
        if (ATT_ACT(T)) ATT_SMPV(SC0, SC1, T, ATT_VS(T)); \
        if (has_next_ && (MODE == 0 || NT > NSLOT)) { if ((T) + 3 < NT) ATT_WAIT_BAR_N(dma3); else ATT_WAIT_BAR(); if ((T) + 4 < NT) ATT_DMA((T) + 4, ATT_KS(T), ATT_VS(T)); }   \
        } while (0)
    const bool dma3 = (MODE == 0) && wid < 4;
    if (NT > 2) ATT_DMA(2, 2 * KSLOT, 2 * VSLOT);
    if (NT > 3) ATT_DMA(3, 3 * KSLOT, 3 * VSLOT);
    if (MODE == 0 && NT > 3) ATT_WAIT_BAR_N(dma3); else ATT_WAIT_BAR();
    f32x16 pA0, pA1, pB0, pB1;
    ATT_QKT(pA0, pA1, 0);
    int t = 0;
    if (MODE == 0 && NT > 4) {
#define ATT_SB() __builtin_amdgcn_sched_barrier(0)
#define ATT_KLD(i, KS) kf[i] = *(const ATT_LAS bf16x8*)ATT_KADDR((i) >> 1, (i) & 1, KS)
#define ATT_VLD(i, VS) do { vlo[i] = vtr(vp0 + (VS) + ((i) >> 2) * 4096 + ((i) & 3) * 1024); vhi[i] = vtr(vp0 + (VS) + ((i) >> 2) * 4096 + ((i) & 3) * 1024 + 512); } while (0)
#define ATT_SCR(SC0, SC1, j) ((j) < 16 ? SC0[(j) & 15] : SC1[(j) & 15])
#define ATT_EXP4(SC0, SC1, g) do { if ((g) < 4) { _Pragma("unroll") for (int j_ = 0; j_ < 4; ++j_) SC0[4 * (g) + j_] = __builtin_amdgcn_exp2f(SC0[4 * (g) + j_]); } \
                                   else { _Pragma("unroll") for (int j_ = 0; j_ < 4; ++j_) SC1[4 * ((g) - 4) + j_] = __builtin_amdgcn_exp2f(SC1[4 * ((g) - 4) + j_]); } } while (0)
#define ATT_ADD4(SC0, SC1, g) do { if ((g) < 4) sacc_ += (SC0[4 * (g)] + SC0[4 * (g) + 1]) + (SC0[4 * (g) + 2] + SC0[4 * (g) + 3]); else sacc_ += (SC1[4 * ((g) - 4)] + SC1[4 * ((g) - 4) + 1]) + (SC1[4 * ((g) - 4) + 2] + SC1[4 * ((g) - 4) + 3]); } while (0)
#define ATT_CVT4(SC0, SC1, g) do { if ((g) < 4) { pw[(g) >> 1][2 * ((g) & 1)] = cvtpk(SC0[4 * (g)], SC0[4 * (g) + 1]); pw[(g) >> 1][2 * ((g) & 1) + 1] = cvtpk(SC0[4 * (g) + 2], SC0[4 * (g) + 3]); } \
                                   else { pw[(g) >> 1][2 * ((g) & 1)] = cvtpk(SC1[4 * ((g) - 4)], SC1[4 * ((g) - 4) + 1]); pw[(g) >> 1][2 * ((g) & 1) + 1] = cvtpk(SC1[4 * ((g) - 4) + 2], SC1[4 * ((g) - 4) + 3]); } } while (0)
#define ATT_GAPA(i, SC0, SC1, SN0, SN1) do { \
        if (((i) & 1) == 0) SN0 = __builtin_amdgcn_mfma_f32_32x32x16_bf16(kf[i], qr[(i) >> 1], SN0, 0, 0, 0); else SN1 = __builtin_amdgcn_mfma_f32_32x32x16_bf16(kf[i], qr[(i) >> 1], SN1, 0, 0, 0); \
        if ((i) < 8) { ATT_VLD(ATT_PJ(i), vs_); ATT_EXP4(SC0, SC1, i); } \
        if ((i) >= 1 && (i) <= 8) ATT_ADD4(SC0, SC1, (i) - 1); \
        if ((i) >= 2 && (i) <= 9) ATT_CVT4(SC0, SC1, (i) - 2); \
        ATT_SB(); } while (0)
#define ATT_PJ(j) ((((j) & 1) << 2) | ((j) >> 1))
#define ATT_VF(j) (bf16x8){vlo[j][0], vlo[j][1], vlo[j][2], vlo[j][3], vhi[j][0], vhi[j][1], vhi[j][2], vhi[j][3]}
#define ATT_GAPB(j, SN0, SN1) do { \
        o[ATT_PJ(j) >> 2] = __builtin_amdgcn_mfma_f32_32x32x16_bf16(ATT_VF(ATT_PJ(j)), __builtin_bit_cast(bf16x8, pw[ATT_PJ(j) & 3]), o[ATT_PJ(j) >> 2], 0, 0, 0);     \
        if ((j) < 6) { ATT_KLD(2 * (j), ks2_); ATT_KLD(2 * (j) + 1, ks2_); } \
        ATT_SB(); } while (0)
#define ATT_FAST(SC0, SC1, SN0, SN1, T) do { const int vs_ = ATT_VS(T), ks2_ = ATT_KS((T) + 2); \
        { const unsigned long long bal_ = __builtin_amdgcn_ballot_w64(sprev > 1048576.0f); float f_ = 1.f;     \
          if (bal_ != 0ull) { float s2_ = sprev; { auto rr_ = __builtin_amdgcn_permlane32_swap(__float_as_uint(s2_), __float_as_uint(s2_), false, false); s2_ = fmaxf(__uint_as_float(rr_[0]), __uint_as_float(rr_[1])); }     \
            const float e_ = (s2_ > 1048576.0f) ? (float)((int)((__float_as_uint(s2_) >> 23) & 0xFFu) - 127) : 0.f; \
            const float mn_ = att_bf16_up(mhat + e_), dl_ = mn_ - mhat; f_ = __builtin_amdgcn_exp2f(-dl_); mhat = mn_; l_reg *= f_; \
            _Pragma("unroll") for (int r = 0; r < 16; ++r) { SC0[r] -= dl_; SC1[r] -= dl_; } \
            qx[0] = (hi == 0) ? (short)(__float_as_uint(-mhat) >> 16) : (short)0; } \
            \
          _Pragma("unroll") for (int g_ = 0; g_ < 4; ++g_) { const int d_ = g_ >> 1, b_ = 8 * (g_ & 1); \
            asm volatile("s_cmp_eq_u64 %[b], 0\n\ts_cbranch_scc1 .Lsk%=\n\ts_nop 1\n\tv_mul_f32_e32 %0, %[f], %0\n\tv_mul_f32_e32 %1, %[f], %1\n\tv_mul_f32_e32 %2, %[f], %2\n\tv_mul_f32_e32 %3, %[f], %3\n\t" \
                         "v_mul_f32_e32 %4, %[f], %4\n\tv_mul_f32_e32 %5, %[f], %5\n\tv_mul_f32_e32 %6, %[f], %6\n\tv_mul_f32_e32 %7, %[f], %7\n.Lsk%=:" \
                         : "+v"(o[d_][b_]), "+v"(o[d_][b_ + 1]), "+v"(o[d_][b_ + 2]), "+v"(o[d_][b_ + 3]), "+v"(o[d_][b_ + 4]), "+v"(o[d_][b_ + 5]), "+v"(o[d_][b_ + 6]), "+v"(o[d_][b_ + 7]) \
                         : [f] "v"(f_), [b] "s"(bal_) : "scc"); } } \
        ATT_SB(); \
        float sacc_ = 0.f; \
        SN0 = __builtin_amdgcn_mfma_f32_32x32x16_bf16(kx, qx, f32x16{}, 0, 0, 0); SN1 = __builtin_amdgcn_mfma_f32_32x32x16_bf16(kx, qx, f32x16{}, 0, 0, 0);     \
        ATT_GAPA(0, SC0, SC1, SN0, SN1); ATT_GAPA(1, SC0, SC1, SN0, SN1); ATT_GAPA(2, SC0, SC1, SN0, SN1); ATT_GAPA(3, SC0, SC1, SN0, SN1); \
        ATT_GAPA(4, SC0, SC1, SN0, SN1); ATT_GAPA(5, SC0, SC1, SN0, SN1); ATT_GAPA(6, SC0, SC1, SN0, SN1); ATT_GAPA(7, SC0, SC1, SN0, SN1); \
        ATT_GAPA(8, SC0, SC1, SN0, SN1); ATT_GAPA(9, SC0, SC1, SN0, SN1); ATT_GAPA(10, SC0, SC1, SN0, SN1); ATT_GAPA(11, SC0, SC1, SN0, SN1); \
        l_reg += sacc_; sprev = sacc_; \
        ATT_GAPB(0, SN0, SN1); ATT_GAPB(1, SN0, SN1); ATT_GAPB(2, SN0, SN1); ATT_GAPB(3, SN0, SN1); ATT_GAPB(4, SN0, SN1); ATT_GAPB(5, SN0, SN1); ATT_GAPB(6, SN0, SN1); ATT_GAPB(7, SN0, SN1); \
        ATT_SB(); \
        ATT_WAIT_BAR(); ATT_DMA((T) + 4, ATT_KS(T), vs_); } while (0)
        bf16x8 kf[12]; s16x4 vlo[8], vhi[8]; u32x4 pw[4];
        float rm = pA0[0];
#pragma unroll
        for (int r = 1; r < 16; ++r) rm = fmaxf(rm, pA0[r]);
#pragma unroll
        for (int r = 0; r < 16; ++r) rm = fmaxf(rm, pA1[r]);
        { auto rr_ = __builtin_amdgcn_permlane32_swap(__float_as_uint(rm), __float_as_uint(rm), false, false); rm = fmaxf(__uint_as_float(rr_[0]), __uint_as_float(rr_[1])); }
        mhat = att_bf16_up(rm);
#pragma unroll
        for (int r = 0; r < 16; ++r) { pA0[r] -= mhat; pA1[r] -= mhat; }
        float sprev = 0.f;
        const bf16x8 kx = (bf16x8){(short)0x3F80, 0, 0, 0, 0, 0, 0, 0};
        bf16x8 qx = (bf16x8){0, 0, 0, 0, 0, 0, 0, 0};
        if (hi == 0) qx[0] = (short)(__float_as_uint(-mhat) >> 16);
#pragma unroll
        for (int i = 0; i < 12; ++i) ATT_KLD(i, KSLOT);
        if (wid >= 4) __builtin_amdgcn_s_setprio(1);
        for (; t + 4 < NT; t += 2) { ATT_FAST(pA0, pA1, pB0, pB1, t); ATT_FAST(pB0, pB1, pA0, pA1, t + 1); }
        if (wid >= 4) __builtin_amdgcn_s_setprio(0);
#pragma unroll
        for (int r = 0; r < 16; ++r) { pA0[r] += mhat; pA1[r] += mhat; }
#undef ATT_FAST
#undef ATT_GAPA
#undef ATT_GAPB
#undef ATT_VF
#undef ATT_PJ
#undef ATT_EXP4
#undef ATT_ADD4
#undef ATT_CVT4
#undef ATT_SCR
#undef ATT_KLD
#undef ATT_VLD
#undef ATT_SB
    }
    for (; t < NT; t += 2) {
        ATT_ITER(pA0, pA1, pB0, pB1, t);
        if (t + 1 < NT) ATT_ITER(pB0, pB1, pA0, pA1, t + 1);
    }
#undef ATT_QKT
#undef ATT_SMPV
#undef ATT_ACT
#undef ATT_ITER
    { auto rr = __builtin_amdgcn_permlane32_swap(__float_as_uint(l_reg), __float_as_uint(l_reg), false, false); l_reg = __uint_as_float(rr[0]) + __uint_as_float(rr[1]); }
    { const float rl = __builtin_amdgcn_rcpf(l_reg);
      bf16_t* prow = U.O + (size_t)(U.q0 + wid * 32 + r32) * U.o_pitch + 8 * hi;
#pragma unroll
      for (int dh = 0; dh < 2; ++dh)
#pragma unroll
        for (int jp = 0; jp < 2; ++jp) {
            unsigned a0 = cvtpk(o[dh][8 * jp] * rl, o[dh][8 * jp + 1] * rl), a1 = cvtpk(o[dh][8 * jp + 2] * rl, o[dh][8 * jp + 3] * rl);
            unsigned b0 = cvtpk(o[dh][8 * jp + 4] * rl, o[dh][8 * jp + 5] * rl), b1 = cvtpk(o[dh][8 * jp + 6] * rl, o[dh][8 * jp + 7] * rl);
            const auto s0 = __builtin_amdgcn_permlane32_swap(a0, b0, false, false); const auto s1 = __builtin_amdgcn_permlane32_swap(a1, b1, false, false);
            *(u32x4*)(prow + 32 * dh + 16 * jp) = (u32x4){s0[0], s1[0], s0[1], s1[1]}; } }
    asm volatile("s_waitcnt vmcnt(0) lgkmcnt(0)\n\ts_barrier" ::: "memory");
#undef ATT_DMA
}
}

namespace att {
constexpr int MB_REG = 65536, MB_TILE = 16384, MB_V = 8192, MB_POSK = 131072, MB_PRE = MB_POSK + 3072, MB_UT = MB_PRE + 2048, MB_NUT = 62, MB_TM = MB_UT + 1024, MB_KB = 140288, MB_ENT = MB_KB + 8192, MB_END = MB_ENT + 2048;
struct MobaCtx { const bf16_t* mqkv; const float* posf; bf16_t* part; float* plse; const unsigned* lists; const unsigned* cnt; int total, vcu, G; };
struct MobaDesc { int own, h, n; };
__device__ __forceinline__ unsigned att_bf16_rne(float f) { unsigned u = __float_as_uint(f); return (u + 0x7fffu + ((u >> 16) & 1u)) >> 16; }
__device__ __forceinline__ float att_bf2f(unsigned b) { return __uint_as_float(b << 16); }
__device__ __forceinline__ void att_split3(float c, unsigned& w1, unsigned& w2) { const unsigned c0 = att_bf16_rne(c); const float r1 = c - att_bf2f(c0); const unsigned c1 = att_bf16_rne(r1); const float r2 = r1 - att_bf2f(c1);
    w1 = c0 | (c1 << 16); w2 = att_bf16_rne(r2); }

__device__ __forceinline__ u32x4 moba_get(const MobaCtx& C, ATT_LAS const int* pre, int i) {
    const int ng = (C.vcu < C.total) ? (C.total - C.vcu + C.G - 1) / C.G : 0;
    if (i < ng) { const int gI = C.vcu + i * C.G; int lo = 0, hi = 511;
        while (lo < hi) { const int mid = (lo + hi) >> 1; if (pre[mid] > gI) hi = mid; else lo = mid + 1; }
        const int hn = lo, c = gI - (hn ? pre[hn - 1] : 0); const int len = (int)C.cnt[hn] - c * 256;
        return (u32x4){1u | ((unsigned)(hn >> 6) << 2) | ((unsigned)(hn & 63) << 5), (unsigned)(len < 256 ? len : 256), (unsigned)hn * 16384u + (unsigned)c * 256u, 0u}; }
    const int u = C.vcu + (i - ng) * C.G; if (u >= 512) return (u32x4){0u, 0u, 0u, 0u};
    return (u32x4){1u | 2u | ((unsigned)(u & 7) << 2) | ((unsigned)(u >> 3) << 5), 256u, 0u, 0u};
}
__device__ __forceinline__ void glds4(const void* gsrc, unsigned lds_dst) {
    asm volatile("s_mov_b32 m0, %1\n\ts_nop 0\n\tglobal_load_lds_dword %0, off" : : "v"(gsrc), "s"(lds_dst) : "memory", "m0"); }

template <int PROBE> __device__ __forceinline__ void moba_run(const MobaCtx& C, char* shm, const int wid) {
    const int lane = pg8::lane_id_v(), tid = wid * 64 + lane, r32 = lane & 31, hi = lane >> 5;
    const unsigned lds0 = (unsigned)(uintptr_t)shm; const lds_cptr shm3 = (lds_cptr)shm;
    ATT_LAS const int* pre = (ATT_LAS const int*)(shm3 + MB_PRE);
    const float* pmax = C.posf + 16384;
    const int km_ = (r32 >> 1) & 7;
    const int ka0 = r32 * 128 + 32 * (km_ >> 1) + 16 * (hi ^ (km_ & 1));
    const int vpl = MB_V + ((lane >> 4) & 1) * 32 + (lane & 3) * 8 + (4 * hi + ((lane & 15) >> 2)) * 64;
    const unsigned koff = (unsigned)((8 * wid + (lane >> 3)) * 1536 + (((lane & 7) ^ ((4 * wid + (lane >> 4)) & 7)) * 8)) * 2u;
    const unsigned voff = (unsigned)((16 * (wid & 3) + (lane >> 2)) * 1536 + (wid >> 2) * 32 + (lane & 3) * 8) * 2u;
#define MB_UNPACK(X_, D_) do { (D_).own = (int)(((X_) >> 1) & 1u); (D_).h = (int)(((X_) >> 2) & 7u); (D_).n = (PROBE & 4) ? 0 : (int)((X_) >> 5); } while (0)
#define MB_DMA(D_, R_) do { const char* kb_ = (const char*)(C.mqkv + 512 + (D_).h * 64 + (size_t)(D_).n * 256 * 1536); const char* vb_ = kb_ + 1024; \
        unsigned db_ = (unsigned)(lds0 + (R_) + wid * 1024); asm volatile("" : "+s"(db_));     \
        _Pragma("unroll") for (int t_ = 0; t_ < 4; ++t_) { glds16(kb_ + koff + (size_t)t_ * (64 * 1536 * 2), db_ + t_ * MB_TILE); \
                                                           glds16(vb_ + voff + (size_t)t_ * (64 * 1536 * 2), db_ + t_ * MB_TILE + MB_V); } } while (0)
#define MB_FETCH(I_, E_, X_) do { E_ = ((const ATT_LAS u32x4*)(shm3 + MB_UT))[(I_)]; X_ = (unsigned)__builtin_amdgcn_readfirstlane((int)E_[0]); } while (0)
#define MB_SMALL(U_, E_, D_) do { \
        if (!(D_).own) { const int e = wid * 32 + r32; if (hi == 0 && e < (int)E_[1]) glds4(C.lists + E_[2] + e, (unsigned)(lds0 + MB_ENT + ((U_) & 1) * 1024 + wid * 128)); } \
        if (wid < 4) glds4(C.posf + (D_).n * 256 + tid, (unsigned)(lds0 + MB_POSK + ((U_) % 3) * 1024 + wid * 256)); \
        if (tid < 4) glds4(pmax + 4 * (D_).n + tid, (unsigned)(lds0 + MB_TM + ((U_) % 3) * 16)); } while (0)
#define MB_STAGE(U_, D_) do { if (tid < 256) { const ATT_LAS float* pp_ = (const ATT_LAS float*)(shm3 + MB_POSK + ((U_) % 3) * 1024); \
            const float v_ = exp2f(-(float)((D_).h + 1)) * 1.4426950408889634f * (pp_[tid] - pp_[0]); const unsigned vh_ = att_bf16_rne(v_), vl_ = att_bf16_rne(v_ - att_bf2f(vh_)); \
            ((ATT_LAS u32x4*)(shm3 + MB_KB + ((U_) & 1) * 4096))[tid] = (u32x4){vh_ | (vl_ << 16), 0x3F803F80u, 0x00003F80u, 0u}; } } while (0)
#define MB_QROW(U_, E_, D_, META_, QR_, PQ_) do { const int e_ = wid * 32 + r32; \
        if ((D_).own) META_ = (((D_).n * 256 + e_) << 2); \
        else { const unsigned en_ = ((const ATT_LAS unsigned*)(shm3 + MB_ENT + ((U_) & 1) * 1024))[e_]; META_ = (e_ < (int)E_[1]) ? (int)(((en_ & 0x3FFFu) << 2) | (1u + ((en_ >> 14) & 3u))) : -1; } \
        const int qr_ = (PROBE & 4) ? (16128 + e_) : ((META_) >= 0 ? ((META_) >> 2) : 0); const bf16_t* Qw_ = C.mqkv + (D_).h * 64 + (size_t)qr_ * 1536 + hi * 8; \
        _Pragma("unroll") for (int d0 = 0; d0 < 4; ++d0) QR_[d0] = *reinterpret_cast<const bf16x8*>(Qw_ + d0 * 16); PQ_ = C.posf[qr_]; } while (0)
#define MB_CHEAP(U_, D_, META_, PQ_, CM_) do { const f32x4 tm_ = *(const ATT_LAS f32x4*)(shm3 + MB_TM + ((U_) % 3) * 16); CM_ = 0; \
        _Pragma("unroll") for (int t_ = 0; t_ < 4; ++t_) { bool ok_ = __all((META_) < 0 || (PQ_) >= tm_[t_]); if ((D_).own) ok_ = ok_ && (64 * t_ + 63 <= wid * 32); if (ok_) CM_ |= 1 << t_; } } while (0)
  for (int base = 0; ; base += MB_NUT) {
    __syncthreads();
    if (tid < MB_NUT) ((ATT_LAS u32x4*)(shm3 + MB_UT))[tid] = moba_get(C, pre, base + tid);
    if (tid == MB_NUT || tid == MB_NUT + 1) ((ATT_LAS u32x4*)(shm3 + MB_UT))[tid] = (u32x4){0u, 0u, 0u, 0u};
    __syncthreads();
    u32x4 ent_; unsigned xc, xn, xnn = 0u; MobaDesc D, Dn;
    MB_FETCH(0, ent_, xc);
    if (!(xc & 1u)) break;
    MB_UNPACK(xc, D);
    MB_DMA(D, 0); MB_SMALL(0, ent_, D);
    { u32x4 e1_; MB_FETCH(1, e1_, xn); MB_UNPACK(xn, Dn); if (xn & 1u) MB_SMALL(1, e1_, Dn); }
    asm volatile("" ::: "memory"); __builtin_amdgcn_s_waitcnt(0); __builtin_amdgcn_s_barrier(); asm volatile("" ::: "memory");
    int meta = -1, cm = 0; float pq = 0.f, pbase = 0.f; bf16x8 qr[4];
    MB_STAGE(0, D); MB_QROW(0, ent_, D, meta, qr, pq);
    pbase = ((const ATT_LAS float*)(shm3 + MB_POSK))[0];
    asm volatile("" ::: "memory"); __builtin_amdgcn_s_waitcnt(0); __builtin_amdgcn_s_barrier(); asm volatile("" ::: "memory");
    MB_CHEAP(0, D, meta, pq, cm);
    if (xn & 1u) MB_DMA(Dn, MB_REG);
    int i = 0;
    for (; xc & 1u; ++i) {
        int meta_n = -1; float pq_n = 0.f;
        MB_UNPACK(xn, Dn);
        const int cur = i & 1, rb = cur * MB_REG; const float slope2 = exp2f(-(float)(D.h + 1)) * 1.4426950408889634f;
        const bool valid = meta >= 0; const int qrow = valid ? (meta >> 2) : 0, slot = meta & 3;
        const ATT_LAS float* posk = (const ATT_LAS float*)(shm3 + MB_POSK + (i % 3) * 1024);
        const lds_cptr kbx = shm3 + MB_KB + cur * 4096 + r32 * 16;
        float mhat = 0.f, l_reg = 0.f; bool first_ = true; f32x16 o[2]; o[0] = f32x16{}; o[1] = f32x16{};
        unsigned qxa0 = 0u, qxa1 = 0u, qxa2 = 0u, qxr1 = 0u, qxr2 = 0u;
#define MB_QX() do { unsigned a1_, a2_, r1_, r2_; att_split3(-slope2 * (pq - pbase) - mhat, a1_, a2_); att_split3(-mhat, r1_, r2_); \
            qxa0 = hi == 0 ? 0x3F803F80u : 0u; qxa1 = hi == 0 ? a1_ : 0u; qxa2 = hi == 0 ? a2_ : 0u; qxr1 = hi == 0 ? r1_ : 0u; qxr2 = hi == 0 ? r2_ : 0u; } while (0)
        MB_QX();
        f32x16 pA0, pA1, pB0, pB1; float mA = 0.f, mB = 0.f;
#define MB_ACT(T) (!D.own || (64 * (T) <= wid * 32 + 31))
#define MB_CH(T) ((cm >> (T)) & 1)
#define MB_QKT(P0, P1, MR, T) do { bf16x8 kk_[8]; const lds_cptr kb_ = shm3 + rb + (T) * MB_TILE; \
            const bf16x8 kx0_ = *(const ATT_LAS bf16x8*)(kbx + (T) * 1024), kx1_ = *(const ATT_LAS bf16x8*)(kbx + (T) * 1024 + 512); \
            _Pragma("unroll") for (int d0 = 0; d0 < 4; ++d0) { kk_[2 * d0] = *(const ATT_LAS bf16x8*)(kb_ + (ka0 ^ (d0 << 5))); kk_[2 * d0 + 1] = *(const ATT_LAS bf16x8*)(kb_ + (ka0 ^ (d0 << 5)) + 4096); } \
            const bool ch_ = MB_CH(T); const u32x4 qs_ = (u32x4){ch_ ? qxa0 : 0u, ch_ ? qxa1 : qxr1, ch_ ? qxa2 : qxr2, 0u}; \
            __builtin_amdgcn_sched_barrier(0); \
            P0 = __builtin_amdgcn_mfma_f32_32x32x16_bf16(kx0_, __builtin_bit_cast(bf16x8, qs_), f32x16{}, 0, 0, 0); P1 = __builtin_amdgcn_mfma_f32_32x32x16_bf16(kx1_, __builtin_bit_cast(bf16x8, qs_), f32x16{}, 0, 0, 0); \
            _Pragma("unroll") for (int d0 = 0; d0 < 4; ++d0) { P0 = __builtin_amdgcn_mfma_f32_32x32x16_bf16(kk_[2 * d0], qr[d0], P0, 0, 0, 0); P1 = __builtin_amdgcn_mfma_f32_32x32x16_bf16(kk_[2 * d0 + 1], qr[d0], P1, 0, 0, 0); } \
            MR = mhat; } while (0)
#define MB_SMPV(P0, P1, MC, T) do { \
            if (__any(MC != mhat)) { const float d_ = mhat - MC; _Pragma("unroll") for (int r = 0; r < 16; ++r) { P0[r] -= d_; P1[r] -= d_; } }     \
            if (!MB_CH(T)) { const ATT_LAS float* pk_ = posk + 64 * (T) + 4 * hi; \
                _Pragma("unroll") for (int g = 0; g < 4; ++g) { const f32x4 a_ = *(const ATT_LAS f32x4*)(pk_ + 8 * g), b_ = *(const ATT_LAS f32x4*)(pk_ + 8 * g + 32); \
                    _Pragma("unroll") for (int j = 0; j < 4; ++j) { P0[4 * g + j] -= slope2 * __builtin_fabsf(pq - a_[j]); P1[4 * g + j] -= slope2 * __builtin_fabsf(pq - b_[j]); } } } \
            if (D.own && 64 * (T) + 63 > wid * 32) { int dq_ = wid * 32 + r32 - 64 * (T) - 4 * hi; asm volatile("" : "+v"(dq_));     \
                _Pragma("unroll") for (int r = 0; r < 16; ++r) { const int c_ = (r & 3) + 8 * (r >> 2); if (c_ > dq_) P0[r] = -INFINITY; if (c_ + 32 > dq_) P1[r] = -INFINITY; } } \
            float rm_ = P0[0]; \
            _Pragma("unroll") for (int r = 1; r < 16; ++r) rm_ = fmaxf(rm_, P0[r]); \
            _Pragma("unroll") for (int r = 0; r < 16; ++r) rm_ = fmaxf(rm_, P1[r]); \
            { auto rr_ = __builtin_amdgcn_permlane32_swap(__float_as_uint(rm_), __float_as_uint(rm_), false, false); rm_ = fmaxf(__uint_as_float(rr_[0]), __uint_as_float(rr_[1])); } \
            if (first_ || __any(rm_ > 10.0f)) { const float dl_ = first_ ? rm_ : fmaxf(rm_, 0.f); mhat += dl_; \
                _Pragma("unroll") for (int r = 0; r < 16; ++r) { P0[r] -= dl_; P1[r] -= dl_; } \
                if (!first_) { const float f_ = __builtin_amdgcn_exp2f(-dl_); l_reg *= f_; \
                    _Pragma("unroll") for (int r = 0; r < 16; ++r) { o[0][r] *= f_; o[1][r] *= f_; } }                        \
                first_ = false; MB_QX(); } \
            _Pragma("unroll") for (int r = 0; r < 16; ++r) { P0[r] = __builtin_amdgcn_exp2f(P0[r]); P1[r] = __builtin_amdgcn_exp2f(P1[r]); } \
            { float sa_ = 0.f;     \
              _Pragma("unroll") for (int r = 0; r < 16; ++r) { sa_ += P0[r]; sa_ += P1[r]; } \
              l_reg += sa_; } \
            u32x4 pw_[4]; \
            _Pragma("unroll") for (int s_ = 0; s_ < 2; ++s_) { \
                pw_[s_] = (u32x4){cvtpk(P0[8 * s_], P0[8 * s_ + 1]), cvtpk(P0[8 * s_ + 2], P0[8 * s_ + 3]), cvtpk(P0[8 * s_ + 4], P0[8 * s_ + 5]), cvtpk(P0[8 * s_ + 6], P0[8 * s_ + 7])}; \
                pw_[2 + s_] = (u32x4){cvtpk(P1[8 * s_], P1[8 * s_ + 1]), cvtpk(P1[8 * s_ + 2], P1[8 * s_ + 3]), cvtpk(P1[8 * s_ + 4], P1[8 * s_ + 5]), cvtpk(P1[8 * s_ + 6], P1[8 * s_ + 7])}; } \
            const lds_cptr vp_ = shm3 + rb + (T) * MB_TILE + vpl; s16x4 vl_[8], vh_[8]; \
            _Pragma("unroll") for (int i_ = 0; i_ < 8; ++i_) { vl_[i_] = vtr(vp_ + (i_ >> 2) * 4096 + (i_ & 3) * 1024); vh_[i_] = vtr(vp_ + (i_ >> 2) * 4096 + (i_ & 3) * 1024 + 512); } \
            __builtin_amdgcn_sched_barrier(0); \
            _Pragma("unroll") for (int i_ = 0; i_ < 8; ++i_) { \
                const bf16x8 vf_ = (bf16x8){vl_[i_][0], vl_[i_][1], vl_[i_][2], vl_[i_][3], vh_[i_][0], vh_[i_][1], vh_[i_][2], vh_[i_][3]}; \
                o[i_ >> 2] = __builtin_amdgcn_mfma_f32_32x32x16_bf16(vf_, __builtin_bit_cast(bf16x8, pw_[i_ & 3]), o[i_ >> 2], 0, 0, 0); } } while (0)
        if (!(PROBE & 1)) {
        if (MB_ACT(3)) MB_QKT(pA0, pA1, mA, 3);
        if (MB_ACT(2)) MB_QKT(pB0, pB1, mB, 2);
        if (MB_ACT(3)) MB_SMPV(pA0, pA1, mA, 3);
        }
        if (xn & 1u) { MB_STAGE(i + 1, Dn);
            MB_FETCH(i + 2, ent_, xnn); if (xnn & 1u) { MobaDesc Dnn; MB_UNPACK(xnn, Dnn); MB_SMALL(i + 2, ent_, Dnn); } } else xnn = 0u;
        if (!(PROBE & 1)) {
        if (!(PROBE & 64)) if (MB_ACT(1)) MB_QKT(pA0, pA1, mA, 1);
        if (MB_ACT(2)) MB_SMPV(pB0, pB1, mB, 2);
        if (!(PROBE & 64)) MB_QKT(pB0, pB1, mB, 0);
        }
        if (xn & 1u) { MB_FETCH(i + 1, ent_, xn); MB_QROW(i + 1, ent_, Dn, meta_n, qr, pq_n); }
        if (!(PROBE & 1)) {
        if (!(PROBE & 64)) if (MB_ACT(1)) MB_SMPV(pA0, pA1, mA, 1);
        if (!(PROBE & 64)) MB_SMPV(pB0, pB1, mB, 0);
        }
#undef MB_QKT
#undef MB_SMPV
#undef MB_ACT
#undef MB_CH
#undef MB_QX
        asm volatile("" ::: "memory"); __builtin_amdgcn_s_waitcnt(0); __builtin_amdgcn_s_barrier(); asm volatile("" ::: "memory");
        const int h_o = D.h; const bool valid_o = valid; const int qrow_o = qrow, slot_o = slot;
        xc = xn; xn = xnn; D = Dn; meta = meta_n; pq = pq_n;
        if (xc & 1u) { pbase = ((const ATT_LAS float*)(shm3 + MB_POSK + ((i + 1) % 3) * 1024))[0]; MB_CHEAP(i + 1, D, meta, pq, cm); }
        if (xn & 1u) { MobaDesc Dt; MB_UNPACK(xn, Dt); MB_DMA(Dt, cur * MB_REG); }
        { auto rr = __builtin_amdgcn_permlane32_swap(__float_as_uint(l_reg), __float_as_uint(l_reg), false, false); l_reg = __uint_as_float(rr[0]) + __uint_as_float(rr[1]); }
        { const float rl = __builtin_amdgcn_rcpf(l_reg);
          bf16_t* prow = C.part + ((((size_t)(qrow_o * 8 + h_o) * 4 + slot_o) * 64) & (PROBE ? ((PROBE & 4) ? (size_t)0x3FFC0 : (size_t)0x7FFFC0) : ~(size_t)0)) + 8 * hi;
#pragma unroll
          for (int dh = 0; dh < 2; ++dh)
#pragma unroll
            for (int jp = 0; jp < 2; ++jp) {
                unsigned a0 = cvtpk(o[dh][8 * jp] * rl, o[dh][8 * jp + 1] * rl), a1 = cvtpk(o[dh][8 * jp + 2] * rl, o[dh][8 * jp + 3] * rl);
                unsigned b0 = cvtpk(o[dh][8 * jp + 4] * rl, o[dh][8 * jp + 5] * rl), b1 = cvtpk(o[dh][8 * jp + 6] * rl, o[dh][8 * jp + 7] * rl);
                const auto s0 = __builtin_amdgcn_permlane32_swap(a0, b0, false, false); const auto s1 = __builtin_amdgcn_permlane32_swap(a1, b1, false, false);
                if (!(PROBE & 2)) if (valid_o) *(u32x4*)(prow + 32 * dh + 16 * jp) = (u32x4){s0[0], s1[0], s0[1], s1[1]}; }
          if (!(PROBE & 2)) if (hi == 0 && valid_o) C.plse[(size_t)(qrow_o * 8 + h_o) * 4 + slot_o] = mhat + __builtin_log2f(l_reg); }
    }
    if (i < MB_NUT) break;
  }
#undef MB_UNPACK
#undef MB_DMA
#undef MB_FETCH
#undef MB_SMALL
#undef MB_STAGE
#undef MB_QROW
#undef MB_CHEAP
}
}

namespace xb {
#define LAS __attribute__((address_space(3)))
#define XB_TMO      128
#define XB_XCNT(j)  (256  + 64 * (j))
#define XB_XSUB(j)  (1280 + 64 * (j))
#define XB_XGEN(j)  (2304 + 64 * (j))
#define XB_TOP      3328
#define XB_TOPGEN   3392
#define XCD_BAR_WORDS 3456
#define XB_SPIN_CAP (1u << 21)

__device__ __forceinline__ unsigned xb_ld(unsigned* p)              { return __hip_atomic_load(p, __ATOMIC_RELAXED, __HIP_MEMORY_SCOPE_AGENT); }
__device__ __forceinline__ unsigned xb_add(unsigned* p, unsigned v) { return __hip_atomic_fetch_add(p, v, __ATOMIC_RELAXED, __HIP_MEMORY_SCOPE_AGENT); }
__device__ __forceinline__ unsigned xb_xcc_id() { return (unsigned)__builtin_amdgcn_s_getreg((3 << 11) | 20) & 0xFu; }
#define XB_SPIN(cond, bar) do { unsigned _sp = 0; while (cond) { __builtin_amdgcn_s_sleep(1); \
    if ((++_sp & 255u) == 0u) { if (xb_ld(&(bar)[XB_TMO])) break; if (_sp > XB_SPIN_CAP) { atomicAdd(&(bar)[XB_TMO], 1u); break; } } } } while (0)

struct XcdBarrier {
    unsigned* bar; unsigned x;
    volatile LAS unsigned* st;
};

__device__ __forceinline__ XcdBarrier xcd_barrier_post(unsigned* bar, volatile LAS unsigned* st, bool leader) {
    XcdBarrier b; b.bar = bar; b.x = xb_xcc_id(); b.st = st;
    if (leader) (void)xb_add(&bar[XB_XCNT(b.x)], 1u);
    return b;
}
__device__ __forceinline__ void xcd_barrier_complete(unsigned* bar, unsigned x, unsigned& nloc, unsigned& nx) {
    const unsigned G = gridDim.x * gridDim.y * gridDim.z;
    unsigned sum, cnt, mine, sp = 0u;
    for (;;) {
        sum = 0u; cnt = 0u; mine = 0u;
#pragma unroll
        for (unsigned j = 0; j < 16; ++j) { const unsigned c = xb_ld(&bar[XB_XCNT(j)]); sum += c; cnt += (c > 0u) ? 1u : 0u; mine = (j == x) ? c : mine; }
        if (sum == G) break;
        __builtin_amdgcn_s_sleep(1);
        if ((++sp & 255u) == 0u) { if (xb_ld(&bar[XB_TMO])) break; if (sp > XB_SPIN_CAP) { atomicAdd(&bar[XB_TMO], 1u); break; } }
    }
    nloc = mine > 0u ? mine : 1u; nx = cnt > 0u ? cnt : 1u;
}

__device__ __forceinline__ void xcd_barrier(const XcdBarrier& b, bool leader) {
    asm volatile("s_waitcnt vmcnt(0)" ::: "memory");
    __syncthreads();
    if (leader) {
        unsigned* bar = b.bar;
        __builtin_amdgcn_s_waitcnt(0);
        unsigned nloc = b.st[0], nx = b.st[1];
        if (nloc == 0u) { xcd_barrier_complete(bar, b.x, nloc, nx); b.st[0] = nloc; b.st[1] = nx; }
        const unsigned old = xb_add(&bar[XB_XSUB(b.x)], 1u);
        const unsigned gen = old / nloc;
        if (old + 1u == (gen + 1u) * nloc) {
            __builtin_amdgcn_fence(__ATOMIC_RELEASE, "agent");
            asm volatile("s_waitcnt vmcnt(0)" ::: "memory");
            const unsigned og = xb_add(&bar[XB_TOP], 1u);
            const unsigned tg = og / nx;
            if (og + 1u == (tg + 1u) * nx) xb_add(&bar[XB_TOPGEN], 1u);
            else XB_SPIN(xb_ld(&bar[XB_TOPGEN]) == tg, bar);
            __builtin_amdgcn_fence(__ATOMIC_ACQUIRE, "agent");
            xb_add(&bar[XB_XGEN(b.x)], 1u);
            asm volatile("s_waitcnt vmcnt(0)" ::: "memory");
        } else {
            XB_SPIN(xb_ld(&bar[XB_XGEN(b.x)]) == gen, bar);
            __builtin_amdgcn_fence(__ATOMIC_ACQUIRE, "agent");
            asm volatile("s_waitcnt vmcnt(0)" ::: "memory");
        }
    }
    __syncthreads();
}

#undef LAS
}
namespace mk {
typedef unsigned short bf16;
typedef unsigned v4u __attribute__((ext_vector_type(4)));
typedef float f32x4 __attribute__((ext_vector_type(4)));
#define MK_LAS __attribute__((address_space(3)))
using namespace mkc;
constexpr int NWAVES = 8;
constexpr int RING_BYTES = 131072, LDS_EXTRA = RING_BYTES, LDS_MISC = RING_BYTES + 8192, LDS_BYTES = 150528;
constexpr size_t WS_BAR = 4096, BAR_BYTES = 32768;

struct Args { const float* in[18]; float* out; unsigned char* ws; int ph_lo, ph_hi; };
struct Frame { MK_LAS unsigned char* lds; int tid, lane, wave, vcu, G; };
typedef const __attribute__((address_space(4))) Args* kargs_t;
__device__ __forceinline__ kargs_t kargs() { kargs_t p = (kargs_t)__builtin_amdgcn_kernarg_segment_ptr(); asm volatile("" : "+s"(p)); return p; }
__device__ __forceinline__ Frame mkframe(MK_LAS unsigned char* lds, int wave) { Frame F; F.lds = lds; F.wave = wave; F.lane = pg8::lane_id_v(); F.tid = wave * 64 + F.lane; F.G = gridDim.x;
    { const int bx = blockIdx.x; F.vcu = (F.G % 8 == 0) ? (bx % 8) * (F.G / 8) + bx / 8 : bx; } return F; }

__device__ __forceinline__ unsigned f2bf(float f) { unsigned u = __builtin_bit_cast(unsigned, f); return (u + 0x7fffu + ((u >> 16) & 1u)) >> 16; }
__device__ __forceinline__ unsigned pk2(float lo, float hi) { return f2bf(lo) | (f2bf(hi) << 16); }
__device__ __forceinline__ float bf2f(unsigned short b) { return __builtin_bit_cast(float, (unsigned)b << 16); }
__device__ __forceinline__ float wave_sum(float v) {
#pragma unroll
    for (int o = 1; o < 64; o <<= 1) v += __shfl_xor(v, o);
    return v;
}
__constant__ float ROPE_INV[16] = {1.000000000e+00f, 5.623413324e-01f, 3.162277639e-01f, 1.778279394e-01f, 1.000000015e-01f, 5.623413250e-02f, 3.162277490e-02f, 1.778279431e-02f,
                                   9.999999776e-03f, 5.623413250e-03f, 3.162277630e-03f, 1.778279431e-03f, 1.000000047e-03f, 5.623413017e-04f, 3.162277571e-04f, 1.778279402e-04f};
__device__ __forceinline__ int rope_phys(int L) { return L < 16 ? 8 * (L >> 2) + (L & 3) : 8 * ((L - 16) >> 2) + 4 + ((L - 16) & 3); }

__device__ __forceinline__ void p0_item(const float* W, int K, int N, bf16* WT, const float* gain, int kind, MK_LAS float* scr, int item, int lane) {
    const int nblk = N / 32, kb = item / nblk, nb = item % nblk, k0 = 64 * kb, n0 = 32 * nb;
    int dbase = n0; bool perm = false; float mul = 1.0f;
    if (kind == 1) dbase = (n0 >> 7) * 256 + (n0 & 127);
    else if (kind == 2) dbase = (n0 >> 7) * 256 + 128 + (n0 & 127);
    else if (kind == 3) { if (n0 == 640) perm = true; else if (n0 >= 672) { dbase = n0 + 96; if (n0 < 1184) mul = C2M; } }
    else if (kind == 4) { perm = (n0 % 96) == 64; mul = C2Q; }
    else if (kind == 5) { const int h = n0 >> 7, e = n0 & 127; dbase = e < 64 ? h * 64 + e : 512 + h * 64 + (e - 64); }
    float wv[32];
#pragma unroll
    for (int i = 0; i < 32; ++i) wv[i] = W[(size_t)(k0 + 2 * i + (lane >> 5)) * N + n0 + (lane & 31)];
#pragma unroll
    for (int i = 0; i < 32; ++i) { const int kk = 2 * i + (lane >> 5); const float g = gain ? gain[k0 + kk] * mul : mul; scr[kk * 33 + (lane & 31)] = wv[i] * g; }
    asm volatile("s_waitcnt lgkmcnt(0)" ::: "memory");
    const int c = lane & 7;
#pragma unroll
    for (int j = 0; j < 4; ++j) { const int n = (lane >> 3) + 8 * j; const MK_LAS float* s = scr + (8 * c) * 33 + n;
        v4u o; o.x = pk2(s[0 * 33], s[1 * 33]); o.y = pk2(s[2 * 33], s[3 * 33]); o.z = pk2(s[4 * 33], s[5 * 33]); o.w = pk2(s[6 * 33], s[7 * 33]);
        const int drow = dbase + (perm ? rope_phys(n) : n);
        *(v4u*)(WT + (size_t)drow * K + k0 + 8 * c) = o; }
    asm volatile("s_waitcnt lgkmcnt(0)" ::: "memory");
}
constexpr int I_G = (DM / 64) * (DFF / 32), I_D = (DFF / 64) * (DM / 32), I_IN = (DM / 64) * (2208 / 32), I_UQ = (384 / 64) * (768 / 32), I_UKV = (256 / 64) * (1024 / 32), I_O = (DM / 64) * (DM / 32);
constexpr int NITEMS = 4 * I_G + 2 * I_D + I_IN + I_UQ + I_UKV + I_O;
__device__ __forceinline__ void p0_one_item(kargs_t ap, unsigned char* ws, MK_LAS float* scr, int it, int lane) {
    int r = it;
    if (r < I_G) { p0_item(ap->in[3], DM, DFF, (bf16*)(ws + WS_WGU1), ap->in[2], 1, scr, r, lane); return; } r -= I_G;
    if (r < I_G) { p0_item(ap->in[4], DM, DFF, (bf16*)(ws + WS_WGU1), ap->in[2], 2, scr, r, lane); return; } r -= I_G;
    if (r < I_D) { p0_item(ap->in[5], DFF, DM, (bf16*)(ws + WS_WD1), nullptr, 0, scr, r, lane); return; } r -= I_D;
    if (r < I_G) { p0_item(ap->in[14], DM, DFF, (bf16*)(ws + WS_WGU2), ap->in[13], 1, scr, r, lane); return; } r -= I_G;
    if (r < I_G) { p0_item(ap->in[15], DM, DFF, (bf16*)(ws + WS_WGU2), ap->in[13], 2, scr, r, lane); return; } r -= I_G;
    if (r < I_D) { p0_item(ap->in[16], DFF, DM, (bf16*)(ws + WS_WD2), nullptr, 0, scr, r, lane); return; } r -= I_D;
    if (r < I_IN) { p0_item(ap->in[7], DM, 2208, (bf16*)(ws + WS_WIN), ap->in[6], 3, scr, r, lane); return; } r -= I_IN;
    if (r < I_UQ) { p0_item(ap->in[9], 384, 768, (bf16*)(ws + WS_WUQ), ap->in[8], 4, scr, r, lane); return; } r -= I_UQ;
    if (r < I_UKV) { p0_item(ap->in[11], 256, 1024, (bf16*)(ws + WS_WUKV), ap->in[10], 5, scr, r, lane); return; } r -= I_UKV;
    p0_item(ap->in[12], DM, DM, (bf16*)(ws + WS_WOUT), nullptr, 0, scr, r, lane);
}
__device__ __forceinline__ void p0_tables_and_zero(kargs_t ap, const int gt, const int NGT) {
    unsigned char* ws = ap->ws;
    const int* pos = (const int*)ap->in[1]; float* posf = (float*)(ws + WS_POSF); float* cosT = (float*)(ws + WS_COS); float* sinT = (float*)(ws + WS_SIN);
    for (int e = gt; e < S * 16; e += NGT) { const int s_ = e >> 4, i = e & 15; const float ang = (float)pos[s_] * ROPE_INV[i]; float sn, cs; sincosf(ang, &sn, &cs); cosT[e] = cs; sinT[e] = sn; if (i == 0) posf[s_] = (float)pos[s_]; }
    for (int e = gt >> 6; e < S / 64; e += NGT >> 6) { int m_ = pos[64 * e + (gt & 63)];
#pragma unroll
        for (int o_ = 1; o_ < 64; o_ <<= 1) m_ = max(m_, __shfl_xor(m_, o_)); if ((gt & 63) == 0) posf[S + e] = (float)m_; }
    float* z = (float*)(ws + WS_SS2);
    for (int e = gt; e < 5 * S; e += NGT) z[e] = 0.f;
    float* km = (float*)(ws + WS_KMS);
    for (int e = gt; e < 64 * 512; e += NGT) km[e] = 0.f;
    unsigned* cnt = (unsigned*)(ws + WS_CNT);
    for (int e = gt; e < 512; e += NGT) cnt[e] = 0u;
    unsigned* padz = (unsigned*)((bf16*)(ws + WS_WIN) + (size_t)672 * DM);
    for (int e = gt; e < 96 * DM / 2; e += NGT) padz[e] = 0u;
}
__device__ __forceinline__ void p0_late_items(const Frame& F, kargs_t ap) {
    unsigned char* ws = ap->ws; MK_LAS float* scr = (MK_LAS float*)(F.lds + F.wave * 16384);
    const int w = ((int)blockIdx.x - 128) * NWAVES + F.wave, NW_ = 128 * NWAVES;
    for (int it = 2 * I_G + w; it < NITEMS; it += NW_) p0_one_item(ap, ws, scr, it, F.lane);
    p0_tables_and_zero(ap, w * 64 + F.lane, NW_ * 64);
}
__device__ __forceinline__ void p0_prologue(const Frame& F, kargs_t ap) {
    unsigned char* ws = ap->ws;
    MK_LAS float* scr = (MK_LAS float*)(F.lds + F.wave * 16384);
    const int gw = F.vcu * NWAVES + F.wave, NGW = F.G * NWAVES;
    constexpr int N_EARLY = 2 * I_G;
    const int n_here = (F.G == 256) ? N_EARLY : NITEMS;
    for (int it = gw; it < n_here; it += NGW) p0_one_item(ap, ws, scr, it, F.lane);
    const float* x = ap->in[0]; bf16* xb = (bf16*)(ws + WS_XB); float* ss1 = (float*)(ws + WS_SS1);
    for (int m = gw; m < S; m += 4 * NGW) {
        f32x4 v[4][4];
#pragma unroll
        for (int r = 0; r < 4; ++r) { const int mr = m + r * NGW; if (mr < S) { const f32x4* xr = (const f32x4*)(x + (size_t)mr * DM) + F.lane;
#pragma unroll
            for (int j = 0; j < 4; ++j) v[r][j] = xr[64 * j]; } }
#pragma unroll
        for (int r = 0; r < 4; ++r) { const int mr = m + r * NGW; if (mr < S) { unsigned long long* o8 = (unsigned long long*)(xb + (size_t)mr * DM) + F.lane; float s = 0.f;
#pragma unroll
            for (int j = 0; j < 4; ++j) { const f32x4 w = v[r][j]; s += (w[0] * w[0] + w[1] * w[1]) + (w[2] * w[2] + w[3] * w[3]); o8[64 * j] = (unsigned long long)pk2(w[0], w[1]) | ((unsigned long long)pk2(w[2], w[3]) << 32); }
            s = wave_sum(s); if (F.lane == 0) ss1[mr] = s; } }
    }
    if (F.G != 256) p0_tables_and_zero(ap, (F.vcu * NWAVES + F.wave) * 64 + F.lane, NGW * 64);
}

__device__ __forceinline__ void p4_krope(const Frame& F, kargs_t ap) { unsigned char* const wsb = ap->ws;
    const bf16* cqkv = (const bf16*)(wsb + WS_CQKV); bf16* Kr = (bf16*)(wsb + WS_KR); const float* cosT = (const float*)(wsb + WS_COS); const float* sinT = (const float*)(wsb + WS_SIN);
    const int gt = (F.vcu * NWAVES + F.wave) * 64 + F.lane, NGT = F.G * NWAVES * 64;
    for (int e = gt; e < S * 16; e += NGT) { const int s_ = e >> 4, i = e & 15, g = i >> 2, j = i & 3;
        const float x1 = bf2f(cqkv[(size_t)s_ * 768 + 640 + 8 * g + j]), x2 = bf2f(cqkv[(size_t)s_ * 768 + 640 + 8 * g + 4 + j]); const float c = cosT[e], sn = sinT[e];
        Kr[(size_t)s_ * 32 + 8 * g + j] = (bf16)f2bf(x1 * c - x2 * sn); Kr[(size_t)s_ * 32 + 8 * g + 4 + j] = (bf16)f2bf(x1 * sn + x2 * c); }
}
__device__ __forceinline__ void p4_gating(const Frame& F, kargs_t ap) { unsigned char* const wsb = ap->ws;
    const bf16* mqkv = (const bf16*)(wsb + WS_MQKV); const float* kms = (const float*)(wsb + WS_KMS); unsigned* cnt = (unsigned*)(wsb + WS_CNT); unsigned* lists = (unsigned*)(wsb + WS_LIST);
    MK_LAS float* km = (MK_LAS float*)F.lds;
    const int u0 = (F.G == 256) ? ((int)blockIdx.x < 192 ? (int)blockIdx.x : 256) : F.vcu, ustep = (F.G == 256) ? 192 : F.G;
    for (int u = u0; u < 256; u += ustep) {
        const int h = u & 7, q = (u >> 3) * 512 + F.tid, own = q >> 8;
        __syncthreads();
        for (int e = F.tid; e < 4096; e += 512) km[e] = kms[(size_t)(e >> 6) * 512 + h * 64 + (e & 63)] * (1.0f / 256.0f);
        __syncthreads();
        float qv[64];
        { const v4u* qp = (const v4u*)(mqkv + (size_t)q * 1536 + h * 64);
#pragma unroll
          for (int c = 0; c < 8; ++c) { const v4u w = qp[c];
#pragma unroll
              for (int j = 0; j < 4; ++j) { qv[8 * c + 2 * j] = __builtin_bit_cast(float, w[j] << 16); qv[8 * c + 2 * j + 1] = __builtin_bit_cast(float, w[j] & 0xFFFF0000u); } } }
        float g0 = -3e38f, g1 = -3e38f, g2 = -3e38f; int i0 = -1, i1 = -1, i2 = -1;
        const int own_max = __builtin_amdgcn_readfirstlane(own);
        for (int n = 0; n < own_max; ++n) {
            float g = 0.f;
#pragma unroll
            for (int c = 0; c < 16; ++c) { const f32x4 kk = *(const MK_LAS f32x4*)(km + n * 64 + 4 * c); g = fmaf(qv[4 * c], kk[0], g); g = fmaf(qv[4 * c + 1], kk[1], g); g = fmaf(qv[4 * c + 2], kk[2], g); g = fmaf(qv[4 * c + 3], kk[3], g); }
            if (g > g0) { g2 = g1; i2 = i1; g1 = g0; i1 = i0; g0 = g; i0 = n; }
            else if (g > g1) { g2 = g1; i2 = i1; g1 = g; i1 = n; }
            else if (g > g2) { g2 = g; i2 = n; }
        }
        MK_LAS unsigned* lcnt = (MK_LAS unsigned*)(F.lds + 16384);
        __syncthreads();
        if (F.tid < 64) lcnt[F.tid] = 0u;
        __syncthreads();
        unsigned r0 = 0u, r1 = 0u, r2 = 0u;
        if (i0 >= 0) r0 = __hip_atomic_fetch_add(lcnt + i0, 1u, __ATOMIC_RELAXED, __HIP_MEMORY_SCOPE_WORKGROUP);
        if (i1 >= 0) r1 = __hip_atomic_fetch_add(lcnt + i1, 1u, __ATOMIC_RELAXED, __HIP_MEMORY_SCOPE_WORKGROUP);
        if (i2 >= 0) r2 = __hip_atomic_fetch_add(lcnt + i2, 1u, __ATOMIC_RELAXED, __HIP_MEMORY_SCOPE_WORKGROUP);
        __syncthreads();
        if (F.tid < 64) { const unsigned c = lcnt[F.tid]; lcnt[64 + F.tid] = c ? atomicAdd(cnt + h * 64 + F.tid, c) : 0u; }
        __syncthreads();
        if (i0 >= 0) lists[(size_t)(h * 64 + i0) * S + lcnt[64 + i0] + r0] = (unsigned)(q | (0 << 14));
        if (i1 >= 0) lists[(size_t)(h * 64 + i1) * S + lcnt[64 + i1] + r1] = (unsigned)(q | (1 << 14));
        if (i2 >= 0) lists[(size_t)(h * 64 + i2) * S + lcnt[64 + i2] + r2] = (unsigned)(q | (2 << 14));
    }
    __syncthreads();
}
__device__ __forceinline__ void p5_combine(const Frame& F, kargs_t ap) { unsigned char* const wsb = ap->ws;
    const bf16* part = (const bf16*)ap->out;     const float* plse = (const float*)(wsb + WS_PLSE); bf16* cat = (bf16*)(wsb + WS_CAT);
    const int gt = (F.vcu * NWAVES + F.wave) * 64 + F.lane, NGT = F.G * NWAVES * 64;
    for (int e = gt; e < S * 8 * 8; e += NGT) { const int dg = e & 7, qh = e >> 3, q = qh >> 3, h = qh & 7; const int ns = 1 + min(3, q >> 8);
        const f32x4 ls = *(const f32x4*)(plse + (size_t)qh * 4);
        float M = ls[0]; for (int s = 1; s < 4; ++s) if (s < ns) M = fmaxf(M, ls[s]);
        float acc[8], wsum = 0.f;
#pragma unroll
        for (int j = 0; j < 8; ++j) acc[j] = 0.f;
#pragma unroll
        for (int s = 0; s < 4; ++s) if (s < ns) { const float w = __builtin_amdgcn_exp2f(ls[s] - M); wsum += w; const v4u v = *(const v4u*)(part + ((size_t)qh * 4 + s) * 64 + dg * 8);
#pragma unroll
            for (int j = 0; j < 4; ++j) { acc[2 * j] += w * __builtin_bit_cast(float, v[j] << 16); acc[2 * j + 1] += w * __builtin_bit_cast(float, v[j] & 0xFFFF0000u); } }
        const float r = 1.0f / wsum; v4u o; o.x = pk2(acc[0] * r, acc[1] * r); o.y = pk2(acc[2] * r, acc[3] * r); o.z = pk2(acc[4] * r, acc[5] * r); o.w = pk2(acc[6] * r, acc[7] * r);
        *(v4u*)(cat + (size_t)q * 1024 + 512 + h * 64 + dg * 8) = o; }
}
__device__ __forceinline__ void p9_final(const Frame& F, kargs_t ap) { unsigned char* const wsb = ap->ws;
    const float* ss = (const float*)(wsb + WS_SS4); const float* g = ap->in[17];
    const int gw = F.vcu * NWAVES + F.wave, NGW = F.G * NWAVES;
    float tsc = 1.0f;
#ifdef MK_TS
    { const unsigned long long* ts = (const unsigned long long*)(wsb + 2048); tsc = 1.0f + (float)(ts[MK_TS + 1] - ts[MK_TS]) * (float)MK_TS_SCALE; }
#endif
    for (int m = gw; m < S; m += NGW) { const float rs = tsc / sqrtf(ss[m] * (1.0f / 1024.0f) + 1e-6f); f32x4* xr = (f32x4*)(ap->out + (size_t)m * DM) + F.lane; const f32x4* gr = (const f32x4*)g + F.lane;
#pragma unroll
        for (int j = 0; j < 4; ++j) { const f32x4 v = xr[64 * j]; xr[64 * j] = v * rs * gr[64 * j]; } }
}

__global__ void __launch_bounds__(NWAVES * 64, 2) mk_fwd(Args a_unused) {
    extern __shared__ __attribute__((aligned(16))) unsigned char lds[];
    const int wave = __builtin_amdgcn_readfirstlane(threadIdx.x >> 6);
    MK_LAS unsigned char* const ldsp = (MK_LAS unsigned char*)lds;
    int lo, hi; { kargs_t ap = kargs(); lo = ap->ph_lo; hi = ap->ph_hi; }
#ifndef MK_ONLY
#define MK_ONLY -1
#endif
#define IN(k) ((MK_ONLY < 0 || MK_ONLY == (k)) && lo <= (k) && (k) < hi)
    const bool multi = (hi - lo) > 1;
    if (multi) {
        const int l0 = pg8::lane_id_v();
        if (wave == 0 && l0 < 2) ((volatile MK_LAS unsigned*)(ldsp + LDS_MISC))[l0] = 0u;
        __syncthreads();
        kargs_t ap = kargs(); (void)xb::xcd_barrier_post((unsigned*)(ap->ws + WS_BAR), (volatile MK_LAS unsigned*)(ldsp + LDS_MISC), wave == 0 && l0 == 0);
    }
    if (lo < -1) cg::this_grid().sync();
#ifdef MK_TS
#define MK_STAMP(i) do { if (blockIdx.x == 0 && wave == 0 && pg8::lane_id_v() == 0) { kargs_t ap__ = kargs(); ((unsigned long long*)(ap__->ws + 2048))[(i)] = __builtin_amdgcn_s_memrealtime(); } } while (0)
#else
#define MK_STAMP(i) do { } while (0)
#endif
    MK_STAMP(0);
#define SEAM(k) do { if (IN(k) && IN((k) + 1)) { kargs_t ap_ = kargs(); xb::XcdBarrier b_; b_.bar = (unsigned*)(ap_->ws + WS_BAR); b_.x = xb::xb_xcc_id(); b_.st = (volatile MK_LAS unsigned*)(ldsp + LDS_MISC); \
        xb::xcd_barrier(b_, wave == 0 && pg8::lane_id_v() == 0); MK_STAMP((k) + 1); } } while (0)
    if (IN(0)) { kargs_t ap = kargs(); const Frame F = mkframe(ldsp, wave);
#ifdef MK_PROBE0
        { int n0_; asm volatile("s_mov_b32 %0, 1" : "=s"(n0_)); for (int r0_ = 0; r0_ < n0_; ++r0_) { p0_prologue(F, ap); __syncthreads(); } }
#endif
        p0_prologue(F, ap); } SEAM(0);
    if (IN(1)) { kargs_t ap = kargs(); unsigned char* ws = ap->ws; pg8::Gemm g{(const bf16*)(ws + WS_XB), (const bf16*)(ws + WS_WGU1), S, NGU, DM, DM}; pg8::StaticOrder So; So.init(S, NGU, (int)gridDim.x, (int)blockIdx.x);
        pg8::EpiSwiGLU E{ws, 0}; pg8::gemm_phase<pg8::EpiSwiGLU, pg8::StaticOrder, true, true>(ldsp, g, So, E, wave);
        if (gridDim.x == 256 && blockIdx.x >= 128) { kargs_t ap2 = kargs(); const Frame F = mkframe(ldsp, wave); __syncthreads(); p0_late_items(F, ap2); } } SEAM(1);
    if (IN(2)) { kargs_t ap = kargs(); unsigned char* ws = ap->ws; pg8::Gemm g{(const bf16*)(ws + WS_ACT), (const bf16*)(ws + WS_WD1), S, DM, DFF, DFF}; pg8::StaticOrder So; So.init(S, DM, (int)gridDim.x, (int)blockIdx.x);
        pg8::EpiResid E{nullptr, ws, (int)WS_SS2, 0.5f}; pg8::gemm_phase<pg8::EpiResid, pg8::StaticOrder, true, true>(ldsp, g, So, E, wave); } SEAM(2);
    if (IN(3)) { kargs_t ap = kargs(); unsigned char* ws = ap->ws; pg8::Gemm g{(const bf16*)(ws + WS_XB), (const bf16*)(ws + WS_WIN), S, NWIN, DM, DM}; pg8::StaticOrder So; So.init(S, gridDim.x == 256 ? NWIN - 256 : NWIN, (int)gridDim.x, (int)blockIdx.x);
        pg8::EpiWin E{ws, 0}; pg8::gemm_phase<pg8::EpiWin, pg8::StaticOrder, true, true>(ldsp, g, So, E, wave); } SEAM(3);
    if (IN(4)) {
#ifdef MK_PROBE4
      int n4_; asm volatile("s_mov_b32 %0, 2" : "=s"(n4_));
      for (int r4_ = 0; r4_ < n4_; ++r4_) {
#endif
        { kargs_t ap = kargs(); unsigned char* ws = ap->ws; pg8::Gemm g{(const bf16*)(ws + WS_CQKV) + 384, (const bf16*)(ws + WS_WUKV), S, 1024, 256, 768}; pg8::StaticOrder So; So.init(S, 1024, (int)gridDim.x, (int)blockIdx.x);
          pg8::EpiKV E{ws}; pg8::gemm_phase<pg8::EpiKV, pg8::StaticOrder, true, true>(ldsp, g, So, E, wave); }
        { kargs_t ap = kargs(); unsigned char* ws = ap->ws; pg8::Gemm g{(const bf16*)(ws + WS_CQKV), (const bf16*)(ws + WS_WUQ), S, 768, 384, 768}; pg8::StaticOrder So; So.init(S, 768, (int)gridDim.x, (int)blockIdx.x);
          pg8::EpiQ E{ws}; pg8::gemm_phase<pg8::EpiQ, pg8::StaticOrder, true, true>(ldsp, g, So, E, wave); }
        if (gridDim.x == 256) { kargs_t ap = kargs(); unsigned char* ws = ap->ws; pg8::Gemm g{(const bf16*)(ws + WS_XB), (const bf16*)(ws + WS_WIN), S, NWIN, DM, DM}; pg8::TailOrder So; So.init(S, 8, (int)gridDim.x, (int)blockIdx.x);
          pg8::EpiWin E{ws, 0}; pg8::gemm_phase<pg8::EpiWin, pg8::TailOrder, true, true>(ldsp, g, So, E, wave); }
#if defined(MK_PROBE4) && MK_PROBE4 == 1
      __syncthreads(); }
#endif
        { kargs_t ap = kargs(); const Frame F = mkframe(ldsp, wave); p4_krope(F, ap); }
#if defined(MK_PROBE4) && MK_PROBE4 == 2
      __syncthreads(); }
#endif
#ifndef MK_NO_GATE
        { kargs_t ap = kargs(); const Frame F = mkframe(ldsp, wave); p4_gating(F, ap); }
#endif
    } SEAM(4);
#ifndef MK_NO_ATT5
    if (IN(5)) {
        kargs_t ap = kargs(); unsigned char* ws = ap->ws; const Frame F = mkframe(ldsp, wave);
        MK_LAS int* pre = (MK_LAS int*)(ldsp + att::MB_PRE);
        const unsigned* cnt = (const unsigned*)(ws + WS_CNT);
        __syncthreads();
        { const int c = (int)cnt[F.tid]; pre[F.tid] = (c + 255) >> 8; }
        __syncthreads();
        for (int o = 1; o < 512; o <<= 1) { const int v = pre[F.tid] + (F.tid >= o ? pre[F.tid - o] : 0); __syncthreads(); pre[F.tid] = v; __syncthreads(); }
        att::MobaCtx C; C.mqkv = (const bf16*)(ws + WS_MQKV); C.posf = (const float*)(ws + WS_POSF); C.part = (bf16*)ap->out; C.plse = (float*)(ws + WS_PLSE);
        C.lists = (const unsigned*)(ws + WS_LIST); C.cnt = cnt; C.total = pre[511]; C.vcu = F.vcu; C.G = F.G;
#ifdef MK_PROBE5
        { bf16* rp_ = C.part; float* rl_ = C.plse; C.part = (bf16*)(ws + WS_CQKV); C.plse = (float*)(ws + WS_CQKV + (16u << 20)); att::moba_run<MK_PROBE5>(C, (char*)lds, wave); __syncthreads(); C.part = rp_; C.plse = rl_; }
#endif
        att::moba_run<0>(C, (char*)lds, wave);
    }
#endif
    SEAM(5);
    if (IN(6)) {
#ifdef MK_PROBEC
        { int nc_; asm volatile("s_mov_b32 %0, 1" : "=s"(nc_)); for (int rc_ = 0; rc_ < nc_; ++rc_) { kargs_t ap = kargs(); const Frame F = mkframe(ldsp, wave); p5_combine(F, ap); __syncthreads(); } }
#endif
        { kargs_t ap = kargs(); const Frame F = mkframe(ldsp, wave); p5_combine(F, ap); }
#ifndef MK_NO_ATT6
        kargs_t ap = kargs(); unsigned char* ws = ap->ws; const Frame F = mkframe(ldsp, wave);
        att::Unit U; U.posf = nullptr; U.part = nullptr; U.plse = nullptr; U.list = nullptr; U.len = 0; U.slope2 = 0.f; U.q_pitch = 768; U.k_pitch = 512; U.v_pitch = 512; U.o_pitch = 1024; U.key0 = 0; U.Kr = (const bf16*)(ws + WS_KR);
        int vstep6 = F.G;
#ifdef MK_PROBE6
        asm volatile("s_mov_b32 %0, 0" : "=s"(vstep6));
        int npass6 = 0;
#endif
        for (int v = F.vcu; v < 256; v += vstep6) { const int h = v >> 5, s_ = v & 31;
#ifdef MK_PROBE6
            if (npass6++ >= MK_PROBE6) break;
            U.len = (npass6 == 1) ? 1 : 0;
#endif
            for (int i = 0; i < 2; ++i) { const int qb = i == 0 ? 63 - s_ : s_;
                U.h = h; U.Q = (const bf16*)(ws + WS_Q) + h * 96; U.K = (const bf16*)(ws + WS_KN) + h * 64; U.V = (const bf16*)(ws + WS_V) + h * 64; U.O = (bf16*)(ws + WS_CAT) + h * 64; U.q0 = qb * 256; U.ntiles = 4 * (qb + 1);
                att::unit<0>(U, (char*)lds, wave); } }
#endif
    } SEAM(6);
    if (IN(7)) { kargs_t ap = kargs(); unsigned char* ws = ap->ws; pg8::Gemm g{(const bf16*)(ws + WS_CAT), (const bf16*)(ws + WS_WOUT), S, DM, DM, DM}; pg8::StaticOrder So; So.init(S, DM, (int)gridDim.x, (int)blockIdx.x);
        pg8::EpiResid E{nullptr, ws, (int)WS_SS3, 1.0f}; pg8::gemm_phase<pg8::EpiResid, pg8::StaticOrder, true, true>(ldsp, g, So, E, wave); } SEAM(7);
    if (IN(8)) { kargs_t ap = kargs(); unsigned char* ws = ap->ws; pg8::Gemm g{(const bf16*)(ws + WS_XB), (const bf16*)(ws + WS_WGU2), S, NGU, DM, DM}; pg8::StaticOrder So; So.init(S, NGU, (int)gridDim.x, (int)blockIdx.x);
        pg8::EpiSwiGLU E{ws, 1};
#ifdef MK_PROBE8
        { int n8_; asm volatile("s_mov_b32 %0, 1" : "=s"(n8_)); for (int r8_ = 0; r8_ < n8_; ++r8_) { pg8::gemm_phase<pg8::EpiSwiGLU, pg8::StaticOrder, true, true>(ldsp, g, So, E, wave); __syncthreads(); } }
#endif
        pg8::gemm_phase<pg8::EpiSwiGLU, pg8::StaticOrder, true, true>(ldsp, g, So, E, wave); } SEAM(8);
    if (IN(9)) { kargs_t ap = kargs(); unsigned char* ws = ap->ws; pg8::Gemm g{(const bf16*)(ws + WS_ACT), (const bf16*)(ws + WS_WD2), S, DM, DFF, DFF}; pg8::StaticOrder So; So.init(S, DM, (int)gridDim.x, (int)blockIdx.x);
        if (gridDim.x == 256) { pg8::EpiResidNorm E{ap->out, ws, ap->in[17], 0.5f}; pg8::gemm_phase<pg8::EpiResidNorm, pg8::StaticOrder, false, true>(ldsp, g, So, E, wave); }
        else { pg8::EpiResid E{ap->out, ws, (int)WS_SS4, 0.5f}; pg8::gemm_phase<pg8::EpiResid, pg8::StaticOrder, true, true>(ldsp, g, So, E, wave); } }
    if (gridDim.x != 256) SEAM(9);
#ifdef MK_PROBE9
    if (IN(9)) { SEAM(9); kargs_t ap = kargs(); unsigned char* ws = ap->ws; pg8::Gemm g{(const bf16*)(ws + WS_ACT), (const bf16*)(ws + WS_WD2), S, DM, DFF, DFF}; pg8::StaticOrder So; So.init(S, DM, (int)gridDim.x, (int)blockIdx.x);
        pg8::EpiSwiGLU E{ws, 1}; pg8::gemm_phase<pg8::EpiSwiGLU, pg8::StaticOrder, true, true, MK_PROBE9 - 1>(ldsp, g, So, E, wave); }
#endif
    if (IN(10) && gridDim.x != 256) { kargs_t ap = kargs(); const Frame F = mkframe(ldsp, wave); p9_final(F, ap); }
#undef IN
#undef SEAM
}
constexpr int N_PHASES = 11;
}
#ifndef MK_BRINGUP
#define MK_BRINGUP 0
#endif
extern "C" void kernel_launch(void* const* d_in, const int* in_sizes, int n_in, void* d_out, int out_size, void* d_ws, size_t ws_size, hipStream_t stream) {
    static int grid = 0;
    if (grid == 0) {
        if (hipFuncSetAttribute((const void*)mk::mk_fwd, hipFuncAttributeMaxDynamicSharedMemorySize, mk::LDS_BYTES) != hipSuccess) { fprintf(stderr, "kernel_launch: hipFuncSetAttribute failed\n"); grid = -1; return; }
        int dev = 0, cus = 0, per_cu = 0;
        hipGetDevice(&dev); hipDeviceGetAttribute(&cus, hipDeviceAttributeMultiprocessorCount, dev);
        hipOccupancyMaxActiveBlocksPerMultiprocessor(&per_cu, (const void*)mk::mk_fwd, mk::NWAVES * 64, mk::LDS_BYTES);
        (void)hipGetLastError();
        grid = cus * (per_cu < 1 ? 1 : (per_cu > 1 ? 1 : per_cu));
        if (grid % 8 != 0 || grid <= 0) grid = 256;
        if (ws_size < mk::WS_END) { fprintf(stderr, "kernel_launch: workspace too small (%zu)\n", ws_size); grid = -1; return; }
    }
    if (grid < 0) return;
    mk::Args a{};
    for (int i = 0; i < 18; ++i) a.in[i] = (const float*)d_in[i];
    a.out = (float*)d_out; a.ws = (unsigned char*)d_ws;
#if MK_BRINGUP == 0
    if (hipMemsetAsync((char*)d_ws + mk::WS_BAR, 0, mk::BAR_BYTES, stream) != hipSuccess) { fprintf(stderr, "kernel_launch: memset failed\n"); return; }
    a.ph_lo = 0; a.ph_hi = mk::N_PHASES;
    void* args[] = {&a};
    hipError_t e = hipLaunchCooperativeKernel((const void*)mk::mk_fwd, dim3(grid), dim3(mk::NWAVES * 64), args, mk::LDS_BYTES, stream);
    if (e != hipSuccess) fprintf(stderr, "cooperative launch failed: %s (grid %d)\n", hipGetErrorString(e), grid);
#else
    const int nph = MK_BRINGUP == 1 ? 3 : MK_BRINGUP == 2 ? 8 : mk::N_PHASES;
    for (int ph = 0; ph < nph; ++ph) { a.ph_lo = ph; a.ph_hi = ph + 1; hipLaunchKernelGGL(mk::mk_fwd, dim3(grid), dim3(mk::NWAVES * 64), mk::LDS_BYTES, stream, a); }
#if MK_BRINGUP == 1
    nv::part_mix(d_in, (float*)d_out, d_ws, stream); nv::part_ffn2_final(d_in, (float*)d_out, d_ws, stream);
#elif MK_BRINGUP == 2
    nv::part_ffn2_final(d_in, (float*)d_out, d_ws, stream);
#endif
#endif
}
```

```cpp
#define MK_BRINGUP 0
#include <hip/hip_runtime.h>
#include <cstdio>
#include <cstdint>
#include <cmath>
#include <hip/hip_cooperative_groups.h>
namespace cg = cooperative_groups;

namespace mkc {
constexpr int S = 16384, DM = 1024, DFF = 2816, NGU = 2 * DFF, NWIN = 2304;
constexpr float LOG2E = 1.4426950408889634f;
constexpr float C2Q = 0.10206207261596577f * LOG2E;
constexpr float C2M = 0.125f * LOG2E;
constexpr size_t MiB = 1u << 20;
constexpr size_t WS_PANEL = 4096 + 16384;
constexpr size_t WS_CNT = 0;
constexpr size_t WS_SS1 = 1 * MiB, WS_SS2 = WS_SS1 + 65536, WS_SSQ = WS_SS2 + 65536, WS_SSKV = WS_SSQ + 65536, WS_SS3 = WS_SSKV + 65536, WS_SS4 = WS_SS3 + 65536;
constexpr size_t WS_KMS = WS_SS1 + 512 * 1024;
constexpr size_t WS_SSDUMMY = WS_SS1 + 384 * 1024, WS_KMSDUMMY = WS_SS1 + 640 * 1024;
constexpr size_t WS_POSF = 2 * MiB, WS_COS = 3 * MiB, WS_SIN = 4 * MiB;
constexpr size_t WS_WGU1 = 6 * MiB, WS_WD1 = 17 * MiB, WS_WGU2 = WS_WD1 + 5632 * 1024, WS_WD2 = WS_WGU2 + 11 * MiB, WS_WIN = 39 * MiB, WS_WUQ = WS_WIN + 4608 * 1024, WS_WUKV = WS_WUQ + 768 * 1024, WS_WOUT = 45 * MiB;
constexpr size_t WS_XB = 48 * MiB, WS_CQKV = 80 * MiB, WS_PLSE = 112 * MiB;
constexpr size_t WS_ACT = 114 * MiB, WS_MQKV = 114 * MiB, WS_CAT = 114 * MiB, WS_Q = 162 * MiB, WS_KN = 186 * MiB, WS_V = 202 * MiB, WS_KR = 218 * MiB, WS_LIST = 220 * MiB, WS_END = 252 * MiB;
static_assert(WS_WD2 + 5632 * 1024 <= WS_WIN && WS_WUKV + 512 * 1024 <= WS_WOUT && WS_WOUT + 2 * MiB <= WS_XB, "weight map");
}
namespace pg8 {
#define PG8_LAS __attribute__((address_space(3)))
typedef unsigned short bf16_t;
typedef short bf16x8 __attribute__((ext_vector_type(8)));
typedef float f32x4 __attribute__((ext_vector_type(4)));
typedef unsigned u32x4 __attribute__((ext_vector_type(4)));
__device__ __forceinline__ int lane_id_v() { int l; asm volatile("v_mbcnt_lo_u32_b32 %0, -1, 0\n\tv_mbcnt_hi_u32_b32 %0, -1, %0" : "=v"(l)); return l; }
constexpr int BM = 256, BK = 64, HALF = 128, HTB = HALF * BK * 2  , STAGE_BYTES = 8 * HTB, NXCD = 8, WGM = 4;

__host__ __device__ __forceinline__ int lds_byte(int r, int c) { const int st = (r >> 4) * 2 + (c >> 5), rr = r & 15, cc = c & 31, ob = rr * 64 + cc * 2; return st * 1024 + (ob ^ (((ob >> 9) & 1) << 5)); }
__host__ __device__ __forceinline__ void stage_rc(int b, int& R, int& C) { const int st = b / 1024, sb = b % 1024, swz = sb ^ (((sb >> 9) & 1) << 5); R = (st >> 1) * 16 + swz / 64; C = (st & 1) * 32 + (swz % 64) / 2; }
__host__ __device__ __forceinline__ int perm32(int rho) { const int n = rho >> 4, i = rho & 15; return 8 * (i >> 2) + 4 * n + (i & 3); }

struct Unit { int pm, pn; };
struct Gemm { const bf16_t* A; const bf16_t* Bt; int M, N, K, lda; };

struct StaticOrder {
    int nM, nN, nwg, G, c;
    __host__ __device__ void init(int M, int N, int G_, int c_) { nM = M / BM; nN = N / BM; nwg = nM * nN; G = G_; c = c_; }
    __host__ __device__ bool next(int i, Unit& u) const {
        const long L = (long)i * G + c; if (L >= nwg) return false;
        int wgid = (int)L; { const int q = nwg / NXCD, r = nwg % NXCD, xcd = wgid % NXCD, off = wgid / NXCD; wgid = (xcd < r ? xcd * (q + 1) : r * (q + 1) + (xcd - r) * q) + off; }
        const int nig = WGM * nN, gid = wgid / nig, fm = gid * WGM, gsz = (nM - fm) < WGM ? (nM - fm) : WGM;
        u.pm = fm + ((wgid % nig) % gsz); u.pn = (wgid % nig) / gsz; return true;
    }
    __device__ __forceinline__ void a_ready(const Unit&) const {}
    __device__ __forceinline__ void done(const Unit&) const {}
};
struct TailOrder {
    int nM, pn, G, c;
    __host__ __device__ void init(int M, int pn_, int G_, int c_) { nM = M / BM; pn = pn_; G = G_; c = c_; }
    __host__ __device__ bool next(int i, Unit& u) const { const int j = c - (G - nM); if (i != 0 || j < 0 || j >= nM) return false; u.pm = j; u.pn = pn; return true; }
    __device__ __forceinline__ void a_ready(const Unit&) const {}
    __device__ __forceinline__ void done(const Unit&) const {}
};
__device__ __forceinline__ unsigned cvt_pk_bf16(float lo, float hi) { unsigned r; asm volatile("v_cvt_pk_bf16_f32 %0, %1, %2" : "=v"(r) : "v"(lo), "v"(hi)); return r; }
typedef unsigned u32x2 __attribute__((ext_vector_type(2)));
constexpr float RMS_EPS = 1e-6f;
__device__ __forceinline__ float rs_of(const float* ss, int row, float invn) { return __builtin_amdgcn_rsqf(ss[row] * invn + RMS_EPS); }
__device__ __forceinline__ float silu_f(float g) { return g * __builtin_amdgcn_rcpf(1.0f + __builtin_amdgcn_exp2f(-1.4426950408889634f * g)); }
__device__ __forceinline__ u32x4 pack8(const f32x4 a, const f32x4 b) { u32x4 w; w.x = cvt_pk_bf16(a[0], a[1]); w.y = cvt_pk_bf16(a[2], a[3]); w.z = cvt_pk_bf16(b[0], b[1]); w.w = cvt_pk_bf16(b[2], b[3]); return w; }

struct EpiSwiGLU {
    static constexpr bool PERM = true, AFTER_DRAIN = false;
    unsigned char* ws; int which;
    __device__ __forceinline__ void operator()(const f32x4 (&acc)[2][2][4][2], const Unit& u, int wr, int wc, int fr, int fq) const {
        bf16_t* O = (bf16_t*)(ws + mkc::WS_ACT); const int ldo = mkc::DFF; const float* ss = (const float*)(ws + (which ? mkc::WS_SS3 : mkc::WS_SS1)); const float invn = 1.0f / 1024.0f;
        const int row0 = u.pm * BM + wr * 64 + fr, col0 = u.pn * HALF + wc * 32 + 8 * fq;
#pragma unroll
        for (int ai = 0; ai < 2; ++ai)
#pragma unroll
            for (int m = 0; m < 4; ++m) { const int row = row0 + ai * HALF + m * 16; const float rs = rs_of(ss, row, invn);
                f32x4 a0, a1;
#pragma unroll
                for (int j = 0; j < 4; ++j) { a0[j] = silu_f(acc[ai][0][m][0][j] * rs) * (acc[ai][1][m][0][j] * rs); a1[j] = silu_f(acc[ai][0][m][1][j] * rs) * (acc[ai][1][m][1][j] * rs); }
                *(u32x4*)(O + (size_t)row * ldo + col0) = pack8(a0, a1); }
    }
};
__device__ __forceinline__ f32x4 bf4_to_f32(const u32x2 w) { f32x4 r; r[0] = __builtin_bit_cast(float, w.x << 16); r[1] = __builtin_bit_cast(float, w.x & 0xFFFF0000u); r[2] = __builtin_bit_cast(float, w.y << 16); r[3] = __builtin_bit_cast(float, w.y & 0xFFFF0000u); return r; }
struct EpiResid {
    static constexpr bool PERM = false, AFTER_DRAIN = false;
    float* out; unsigned char* ws; int ss_off; float alpha;
    __device__ __forceinline__ void operator()(const f32x4 (&acc)[2][2][4][2], const Unit& u, int wr, int wc, int fr, int fq) const {
        bf16_t* xb = (bf16_t*)(ws + mkc::WS_XB); float* ss_out = (float*)(ws + ss_off);
        const int row0 = u.pm * BM + wr * 64 + fr, col0 = u.pn * BM + wc * 32 + 4 * fq;
#pragma unroll
        for (int ai = 0; ai < 2; ++ai)
#pragma unroll
            for (int m = 0; m < 4; ++m) { const int row = row0 + ai * HALF + m * 16; const size_t off = (size_t)row * 1024 + col0; float s = 0.f;
#pragma unroll
                for (int bj = 0; bj < 2; ++bj)
#pragma unroll
                    for (int n = 0; n < 2; ++n) { const f32x4 b = bf4_to_f32(*(const u32x2*)(xb + off + bj * HALF + n * 16)); const f32x4 o = b + acc[ai][bj][m][n] * alpha;
                        if (out) *(f32x4*)(out + off + bj * HALF + n * 16) = o;
                        s += (o[0] * o[0] + o[1] * o[1]) + (o[2] * o[2] + o[3] * o[3]);
                        u32x2 w; w.x = cvt_pk_bf16(o[0], o[1]); w.y = cvt_pk_bf16(o[2], o[3]); *(u32x2*)(xb + off + bj * HALF + n * 16) = w; }
                s += __shfl_xor(s, 16); s += __shfl_xor(s, 32);
                if (fq == 0) atomicAdd(ss_out + row, s);
                asm volatile("" ::: "memory"); }
    }
};
struct EpiWin {
    static constexpr bool PERM = true, AFTER_DRAIN = false;
    unsigned char* ws; int dummy;
    __device__ __forceinline__ void operator()(const f32x4 (&acc)[2][2][4][2], const Unit& u, int wr, int wc, int fr, int fq) const {
        bf16_t* cqkv = (bf16_t*)(ws + mkc::WS_CQKV); bf16_t* mqkv = (bf16_t*)(ws + mkc::WS_MQKV); const float* ss_in = (const float*)(ws + mkc::WS_SS2);
        float* ssq = (float*)(ws + (dummy ? mkc::WS_SSDUMMY : mkc::WS_SSQ)); float* sskv = (float*)(ws + (dummy ? mkc::WS_SSDUMMY + 65536 : mkc::WS_SSKV)); float* kmsum = (float*)(ws + (dummy ? mkc::WS_KMSDUMMY : mkc::WS_KMS));
        const int row0 = u.pm * BM + wr * 64 + fr;
        const bool is_mk = (u.pn == 5 || u.pn == 6);
        f32x4 cs[2][2];
#pragma unroll
        for (int bj = 0; bj < 2; ++bj)
#pragma unroll
            for (int n = 0; n < 2; ++n) cs[bj][n] = (f32x4){0.f, 0.f, 0.f, 0.f};
#pragma unroll
        for (int ai = 0; ai < 2; ++ai)
#pragma unroll
            for (int m = 0; m < 4; ++m) { const int row = row0 + ai * HALF + m * 16; const float rs = rs_of(ss_in, row, 1.0f / 1024.0f);
#pragma unroll
                for (int bj = 0; bj < 2; ++bj) { const int colt = u.pn * BM + bj * HALF, col0 = colt + wc * 32 + 8 * fq;
                    const f32x4 v0 = acc[ai][bj][m][0] * rs, v1 = acc[ai][bj][m][1] * rs;
                    bf16_t* dst = (colt < 768) ? (cqkv + (size_t)row * 768 + col0) : (mqkv + (size_t)row * 1536 + (col0 - 768));
                    *(u32x4*)dst = pack8(v0, v1);
                    if (colt < 640) { float s = (v0[0] * v0[0] + v0[1] * v0[1]) + (v0[2] * v0[2] + v0[3] * v0[3]) + (v1[0] * v1[0] + v1[1] * v1[1]) + (v1[2] * v1[2] + v1[3] * v1[3]);
                        s += __shfl_xor(s, 16); s += __shfl_xor(s, 32);
                        if (fq == 0) atomicAdd((colt < 384 ? ssq : sskv) + row, s); }
                    if (is_mk) { cs[bj][0] += v0; cs[bj][1] += v1; } } }
        if (is_mk) {
#pragma unroll
            for (int bj = 0; bj < 2; ++bj)
#pragma unroll
                for (int n = 0; n < 2; ++n)
#pragma unroll
                    for (int j = 0; j < 4; ++j) { float s = cs[bj][n][j]; s += __shfl_xor(s, 1); s += __shfl_xor(s, 2); s += __shfl_xor(s, 4); s += __shfl_xor(s, 8);
                        if (fr == 0) atomicAdd(kmsum + (size_t)u.pm * 512 + (u.pn * BM + bj * HALF + wc * 32 + 8 * fq + 4 * n + j - 1280), s); }
        }
    }
};
struct EpiKV {
    static constexpr bool PERM = true, AFTER_DRAIN = false;
    unsigned char* ws;
    __device__ __forceinline__ void operator()(const f32x4 (&acc)[2][2][4][2], const Unit& u, int wr, int wc, int fr, int fq) const {
        bf16_t* Kn = (bf16_t*)(ws + mkc::WS_KN); bf16_t* V = (bf16_t*)(ws + mkc::WS_V); const float* ss = (const float*)(ws + mkc::WS_SSKV);
        const int row0 = u.pm * BM + wr * 64 + fr;
#pragma unroll
        for (int ai = 0; ai < 2; ++ai)
#pragma unroll
            for (int m = 0; m < 4; ++m) { const int row = row0 + ai * HALF + m * 16; const float rs = rs_of(ss, row, 1.0f / 256.0f);
#pragma unroll
                for (int bj = 0; bj < 2; ++bj) { const int colt = u.pn * BM + bj * HALF, col0 = colt + wc * 32 + 8 * fq;
                    bf16_t* dst = (colt < 512) ? (Kn + (size_t)row * 512 + col0) : (V + (size_t)row * 512 + (col0 - 512));
                    *(u32x4*)dst = pack8(acc[ai][bj][m][0] * rs, acc[ai][bj][m][1] * rs); } }
    }
};
struct EpiQ {
    static constexpr bool PERM = true, AFTER_DRAIN = false;
    unsigned char* ws;
    __device__ __forceinline__ void operator()(const f32x4 (&acc)[2][2][4][2], const Unit& u, int wr, int wc, int fr, int fq) const {
        bf16_t* Q = (bf16_t*)(ws + mkc::WS_Q); const float* ss = (const float*)(ws + mkc::WS_SSQ); const float* cosT = (const float*)(ws + mkc::WS_COS); const float* sinT = (const float*)(ws + mkc::WS_SIN);
        const int row0 = u.pm * BM + wr * 64 + fr;
#pragma unroll
        for (int ai = 0; ai < 2; ++ai)
#pragma unroll
            for (int m = 0; m < 4; ++m) { const int row = row0 + ai * HALF + m * 16; const float rs = rs_of(ss, row, 1.0f / 384.0f);
#pragma unroll
                for (int bj = 0; bj < 2; ++bj) { const int col0 = u.pn * BM + bj * HALF + wc * 32 + 8 * fq; const int d = col0 % 96;
                    f32x4 v0 = acc[ai][bj][m][0] * rs, v1 = acc[ai][bj][m][1] * rs;
                    if (d >= 64) { const int g = (d - 64) >> 3; const f32x4 c = *(const f32x4*)(cosT + (size_t)row * 16 + 4 * g), s = *(const f32x4*)(sinT + (size_t)row * 16 + 4 * g);
                        const f32x4 o0 = v0 * c - v1 * s, o1 = v0 * s + v1 * c; v0 = o0; v1 = o1; }
                    *(u32x4*)(Q + (size_t)row * 768 + col0) = pack8(v0, v1); }
                asm volatile("" ::: "memory"); }
    }
};
struct EpiResidNorm {
    static constexpr bool PERM = false, AFTER_DRAIN = true;
    float* out; unsigned char* ws; const float* gain; float alpha;
    __device__ __forceinline__ void fused(f32x4 (&acc)[2][2][4][2], const Unit& u, int wr, int wc, int fr, int fq, PG8_LAS unsigned char* lds, int wid, int lane) const {
        float* ss = (float*)(ws + mkc::WS_SS4); unsigned* pcnt = (unsigned*)(ws + mkc::WS_PANEL) + 64 * u.pm; const bf16_t* xb = (const bf16_t*)(ws + mkc::WS_XB);
        const int row0 = u.pm * BM + wr * 64 + fr, col0 = u.pn * BM + wc * 32 + 4 * fq;
#pragma unroll
        for (int ai = 0; ai < 2; ++ai)
#pragma unroll
            for (int m = 0; m < 4; ++m) { const int row = row0 + ai * HALF + m * 16; const size_t off = (size_t)row * 1024 + col0; float s = 0.f;
#pragma unroll
                for (int bj = 0; bj < 2; ++bj)
#pragma unroll
                    for (int n = 0; n < 2; ++n) { const f32x4 b = bf4_to_f32(*(const u32x2*)(xb + off + bj * HALF + n * 16)); const f32x4 o = b + acc[ai][bj][m][n] * alpha; acc[ai][bj][m][n] = o;
                        s += (o[0] * o[0] + o[1] * o[1]) + (o[2] * o[2] + o[3] * o[3]); }
                s += __shfl_xor(s, 16); s += __shfl_xor(s, 32);
                if (fq == 0) atomicAdd(ss + row, s);
                asm volatile("" : "+v"(acc[ai][0][m][0]), "+v"(acc[ai][0][m][1]), "+v"(acc[ai][1][m][0]), "+v"(acc[ai][1][m][1]));
                if (m & 1) asm volatile("" ::: "memory"); }
        asm volatile("s_waitcnt vmcnt(0)" ::: "memory"); __builtin_amdgcn_s_barrier(); asm volatile("" ::: "memory");
        if (wid == 0) {
            if (lane == 0) { __builtin_amdgcn_fence(__ATOMIC_RELEASE, "agent"); asm volatile("s_waitcnt vmcnt(0)" ::: "memory"); __hip_atomic_fetch_add(pcnt, 1u, __ATOMIC_RELAXED, __HIP_MEMORY_SCOPE_AGENT); }
            unsigned spins = 0;
            while ((unsigned)__builtin_amdgcn_readfirstlane(__hip_atomic_load(pcnt, __ATOMIC_RELAXED, __HIP_MEMORY_SCOPE_AGENT)) < 4u) { __builtin_amdgcn_s_sleep(2); if (++spins > (1u << 22)) break; }
            __builtin_amdgcn_fence(__ATOMIC_ACQUIRE, "agent");
        }
        asm volatile("s_waitcnt vmcnt(0) lgkmcnt(0)" ::: "memory"); __builtin_amdgcn_s_barrier(); asm volatile("" ::: "memory");
        f32x4 gv[2][2];
#pragma unroll
        for (int bj = 0; bj < 2; ++bj)
#pragma unroll
            for (int n = 0; n < 2; ++n) gv[bj][n] = *(const f32x4*)(gain + col0 + bj * HALF + n * 16);
#pragma unroll
        for (int ai = 0; ai < 2; ++ai)
#pragma unroll
            for (int m = 0; m < 4; ++m) { const int row = row0 + ai * HALF + m * 16; const size_t off = (size_t)row * 1024 + col0;
                const float tot = __hip_atomic_load(ss + row, __ATOMIC_RELAXED, __HIP_MEMORY_SCOPE_AGENT); const float rs = __builtin_amdgcn_rsqf(tot * (1.0f / 1024.0f) + RMS_EPS);
#pragma unroll
                for (int bj = 0; bj < 2; ++bj)
#pragma unroll
                    for (int n = 0; n < 2; ++n) *(f32x4*)(out + off + bj * HALF + n * 16) = acc[ai][bj][m][n] * rs * gv[bj][n]; }
    }
};

template <class Epi, class Sched, bool ALIGN_EPI = false, bool SP2 = false, int XP = 0>
__device__ __forceinline__ void gemm_phase(PG8_LAS unsigned char* lds, const Gemm g, const Sched& S, const Epi& E, const int wid) {
    const int lane = lane_id_v(), tid = wid * 64 + lane, wr = wid >> 2, wc = wid & 3, fr = lane & 15, fq = lane >> 4;
    const int K = g.K, nt = K / BK, lda = g.lda;
    unsigned voffA[2], voffB[2];
#pragma unroll
    for (int i = 0; i < 2; ++i) { int R, C; stage_rc(tid * 16 + i * 8192, R, C); const int Rb = Epi::PERM ? ((R & ~31) + perm32(R & 31)) : R;
        voffA[i] = (unsigned)(R * lda + C) * 2u; voffB[i] = (unsigned)(Rb * K + C) * 2u; }
    const size_t kstep = (size_t)(BK * 2);
    const size_t hstep = (size_t)HALF * K * 2;
    const size_t tstep = 2 * hstep; const size_t hstepA = (size_t)HALF * lda * 2, tstepA = 2 * hstepA;
    const unsigned ldsw = (unsigned)wid * 1024u;
    const int aoff = lds_byte(wr * 64 + fr, fq * 8), boff = lds_byte(wc * 32 + fr, fq * 8);
#define PG8_SA(b, h) (((b) * 2 + (h)) * HTB)
#define PG8_SB(b, h) ((4 + (b) * 2 + (h)) * HTB)
#define PG8_STAGE(bufoff, gbase, voff) do { if constexpr (XP & 4) break; _Pragma("unroll") for (int _i = 0; _i < 2; ++_i) \
        __builtin_amdgcn_global_load_lds((const unsigned*)((const char*)(gbase) + (voff)[_i]), (PG8_LAS unsigned*)(lds + (bufoff) + ldsw + _i * 8192), 16, 0, 0); } while (0)
#define PG8_LDA(dst, b, h) do { if constexpr (XP & 8) break; _Pragma("unroll") for (int m = 0; m < 4; ++m) _Pragma("unroll") for (int k = 0; k < 2; ++k) dst[m][k] = *(const PG8_LAS bf16x8*)(lds + PG8_SA(b, h) + aoff + m * 2048 + k * 1024); } while (0)
#define PG8_LDB(dst, b, h) do { if constexpr (XP & 8) break; _Pragma("unroll") for (int n = 0; n < 2; ++n) _Pragma("unroll") for (int k = 0; k < 2; ++k) dst[n][k] = *(const PG8_LAS bf16x8*)(lds + PG8_SB(b, h) + boff + n * 2048 + k * 1024); } while (0)
#define PG8_MMA(ai, bj, At, Bt) do { if constexpr (XP & 2) break; if constexpr (!(XP & 16)) __builtin_amdgcn_s_setprio(1); _Pragma("unroll") for (int m = 0; m < 4; ++m) _Pragma("unroll") for (int n = 0; n < 2; ++n) _Pragma("unroll") for (int k = 0; k < 2; ++k) \
        acc[ai][bj][m][n] = __builtin_amdgcn_mfma_f32_16x16x32_bf16(Bt[n][k], At[m][k], acc[ai][bj][m][n], 0, 0, 0); if constexpr (!(XP & 16)) __builtin_amdgcn_s_setprio(0); } while (0)
#define PG8_WAIT_V(n) do { if constexpr (XP & 32) __builtin_amdgcn_s_setprio(0); asm volatile("s_waitcnt vmcnt(" #n ")" ::: "memory"); } while (0)
#define PG8_WAIT_L(n) asm volatile("s_waitcnt lgkmcnt(" #n ")" ::: "memory")
#define PG8_BAR do { if constexpr (!(XP & 1)) __builtin_amdgcn_s_barrier(); if constexpr (XP & 32) __builtin_amdgcn_s_setprio(2); } while (0)
#define PG8_SCHED __builtin_amdgcn_sched_barrier(0)
    Unit cur, nxt; int ui = 0;
    if (!S.next(0, cur)) return;
    f32x4 acc[2][2][4][2];
#pragma unroll
    for (int a = 0; a < 2; ++a)
#pragma unroll
        for (int b = 0; b < 2; ++b)
#pragma unroll
            for (int m = 0; m < 4; ++m)
#pragma unroll
                for (int n = 0; n < 2; ++n) acc[a][b][m][n] = (f32x4){0.f, 0.f, 0.f, 0.f};
    bf16x8 At[4][2], B0[2][2], B1[2][2];
    const char* cA = (const char*)g.A + (size_t)cur.pm * tstepA; const char* cB = (const char*)g.Bt + (size_t)cur.pn * tstep;
    S.a_ready(cur);
    if constexpr (SP2) {
        PG8_STAGE(PG8_SB(0, 0), cB, voffB); PG8_STAGE(PG8_SB(0, 1), cB + hstep, voffB); PG8_STAGE(PG8_SA(0, 0), cA, voffA); PG8_STAGE(PG8_SA(0, 1), cA + hstepA, voffA);
        if (wr == 1) PG8_BAR;
        PG8_WAIT_V(2); PG8_BAR;
        PG8_STAGE(PG8_SB(1, 0), cB + kstep, voffB); PG8_STAGE(PG8_SA(1, 0), cA + kstep, voffA); PG8_STAGE(PG8_SB(1, 1), cB + hstep + kstep, voffB);
        PG8_WAIT_V(6); PG8_BAR;
    } else {
        PG8_STAGE(PG8_SB(0, 0), cB, voffB); PG8_STAGE(PG8_SA(0, 0), cA, voffA); PG8_STAGE(PG8_SB(0, 1), cB + hstep, voffB); PG8_STAGE(PG8_SA(0, 1), cA + hstepA, voffA);
        if (wr == 1) PG8_BAR;
        PG8_WAIT_V(4); PG8_BAR;
        PG8_STAGE(PG8_SB(1, 0), cB + kstep, voffB); PG8_STAGE(PG8_SA(1, 0), cA + kstep, voffA); PG8_STAGE(PG8_SB(1, 1), cB + hstep + kstep, voffB);
        PG8_WAIT_V(6); PG8_BAR;
    }
    for (;;) {
        const bool has_next = S.next(ui + 1, nxt);
        const char* nA = has_next ? (const char*)g.A + (size_t)nxt.pm * tstepA : cA; const char* nB = has_next ? (const char*)g.Bt + (size_t)nxt.pn * tstep : cB;
#pragma nounroll
        for (int t = 0; t < nt; t += 2) {
            const bool last = (t == nt - 2);
            const char* a1 = cA + (size_t)(t + 1) * kstep;
            const char* a2 = last ? nA : cA + (size_t)(t + 2) * kstep; const char* b2 = last ? nB : cB + (size_t)(t + 2) * kstep;
            const char* a3 = a2 + kstep; const char* b3 = b2 + kstep;
            if (last && has_next) S.a_ready(nxt);
            if constexpr (SP2) {
            PG8_LDB(B0, 0, 0); PG8_LDB(B1, 0, 1); PG8_SCHED; PG8_LDA(At, 0, 0); PG8_STAGE(PG8_SA(1, 1), a1 + hstepA, voffA);
            PG8_WAIT_V(8); PG8_WAIT_L(0); PG8_BAR; PG8_MMA(0, 0, At, B0); PG8_MMA(0, 1, At, B1); PG8_BAR; PG8_SCHED;
            PG8_LDA(At, 0, 1); PG8_STAGE(PG8_SB(0, 0), b2, voffB); PG8_STAGE(PG8_SB(0, 1), b2 + hstep, voffB); PG8_STAGE(PG8_SA(0, 0), a2, voffA);
            PG8_WAIT_V(8); PG8_WAIT_L(0); PG8_BAR; PG8_MMA(1, 0, At, B0); PG8_MMA(1, 1, At, B1); PG8_BAR; PG8_SCHED;
            PG8_LDB(B0, 1, 0); PG8_LDB(B1, 1, 1); PG8_SCHED; PG8_LDA(At, 1, 0); PG8_STAGE(PG8_SA(0, 1), a2 + hstepA, voffA);
            PG8_WAIT_V(8); PG8_WAIT_L(0); PG8_BAR; PG8_MMA(0, 0, At, B0); PG8_MMA(0, 1, At, B1); PG8_BAR; PG8_SCHED;
            PG8_LDA(At, 1, 1); PG8_STAGE(PG8_SB(1, 0), b3, voffB); PG8_STAGE(PG8_SB(1, 1), b3 + hstep, voffB); PG8_STAGE(PG8_SA(1, 0), a3, voffA);
            PG8_WAIT_V(8); PG8_WAIT_L(0); PG8_BAR; PG8_MMA(1, 0, At, B0); PG8_MMA(1, 1, At, B1); PG8_BAR; PG8_SCHED;
            } else {
            PG8_LDB(B0, 0, 0); PG8_SCHED; PG8_LDA(At, 0, 0); PG8_STAGE(PG8_SA(1, 1), a1 + hstepA, voffA);
            PG8_WAIT_L(8); PG8_BAR; PG8_WAIT_L(0); PG8_MMA(0, 0, At, B0); PG8_BAR; PG8_SCHED;
            PG8_LDB(B1, 0, 1); PG8_STAGE(PG8_SB(0, 0), b2, voffB);
            PG8_BAR; PG8_WAIT_L(0); PG8_MMA(0, 1, At, B1); PG8_BAR;
            PG8_LDA(At, 0, 1); PG8_STAGE(PG8_SA(0, 0), a2, voffA);
            PG8_BAR; PG8_WAIT_L(0); PG8_MMA(1, 0, At, B0); PG8_BAR; PG8_SCHED;
            PG8_STAGE(PG8_SB(0, 1), b2 + hstep, voffB);
            PG8_WAIT_V(6); PG8_BAR; PG8_MMA(1, 1, At, B1); PG8_BAR;
            PG8_LDB(B0, 1, 0); PG8_SCHED; PG8_LDA(At, 1, 0); PG8_STAGE(PG8_SA(0, 1), a2 + hstepA, voffA);
            PG8_WAIT_L(8); PG8_BAR; PG8_WAIT_L(0); PG8_MMA(0, 0, At, B0); PG8_BAR; PG8_SCHED;
            PG8_LDB(B1, 1, 1); PG8_STAGE(PG8_SB(1, 0), b3, voffB);
            PG8_BAR; PG8_WAIT_L(0); PG8_MMA(0, 1, At, B1); PG8_BAR;
            PG8_LDA(At, 1, 1); PG8_STAGE(PG8_SA(1, 0), a3, voffA);
            PG8_BAR; PG8_WAIT_L(0); PG8_MMA(1, 0, At, B0); PG8_BAR; PG8_SCHED;
            PG8_STAGE(PG8_SB(1, 1), b3 + hstep, voffB);
            PG8_WAIT_V(6); PG8_BAR; PG8_MMA(1, 1, At, B1); PG8_BAR;
            }
        }
        if constexpr (ALIGN_EPI) { if (wr == 0) PG8_BAR; }
        if constexpr (!Epi::AFTER_DRAIN) { E(acc, cur, wr, wc, fr, fq); S.done(cur); }
        if (!has_next) break;
#pragma unroll
        for (int a = 0; a < 2; ++a)
#pragma unroll
            for (int b = 0; b < 2; ++b)
#pragma unroll
                for (int m = 0; m < 4; ++m)
#pragma unroll
                    for (int n = 0; n < 2; ++n) acc[a][b][m][n] = (f32x4){0.f, 0.f, 0.f, 0.f};
        cur = nxt; cA = nA; cB = nB; ++ui;
        if constexpr (ALIGN_EPI) { if (wr == 1) PG8_BAR; }
    }
    PG8_WAIT_V(0);
    if constexpr (!ALIGN_EPI) { if (wr == 0) PG8_BAR; }
    PG8_BAR;
    if constexpr (Epi::AFTER_DRAIN) { E.fused(acc, cur, wr, wc, fr, fq, lds, wid, lane); S.done(cur); }
#undef PG8_SA
#undef PG8_SB
#undef PG8_STAGE
#undef PG8_LDA
#undef PG8_LDB
#undef PG8_MMA
#undef PG8_WAIT_V
#undef PG8_WAIT_L
#undef PG8_BAR
#undef PG8_SCHED
}
}
namespace att {
typedef unsigned short bf16_t;
using bf16x8 = __attribute__((ext_vector_type(8))) short;
using s16x4 = __attribute__((ext_vector_type(4))) short;
using f32x16 = __attribute__((ext_vector_type(16))) float;
using f32x4 = __attribute__((ext_vector_type(4))) float;
using u32x4 = __attribute__((ext_vector_type(4))) unsigned;
typedef short v4i16_t __attribute__((ext_vector_type(4)));
#define ATT_LAS __attribute__((address_space(3)))
typedef ATT_LAS const char* lds_cptr;
constexpr int NW = 8, KVBLK = 64;
constexpr int KSLOT = 12288, VSLOT = 8192, NSLOT = 4;
constexpr int LDS_K = 0, LDS_V = NSLOT * KSLOT, LDS_WS = LDS_V + NSLOT * VSLOT, LDS_OST = LDS_WS + NW * 64 * 4, LDS_POSK = LDS_OST + NW * 4096, LDS_BYTES = LDS_POSK + 1024;
__device__ __forceinline__ int crow(int r, int hi) { return (r & 3) + 8 * (r >> 2) + 4 * hi; }
__device__ __forceinline__ void glds16(const void* gsrc, unsigned lds_dst) {
    asm volatile("s_mov_b32 m0, %1\n\ts_nop 0\n\tglobal_load_lds_dwordx4 %0, off" : : "v"(gsrc), "s"(lds_dst) : "memory", "m0"); }
typedef float f32x2_t __attribute__((ext_vector_type(2))); typedef __bf16 bf16x2_t __attribute__((ext_vector_type(2)));
__device__ __forceinline__ unsigned cvtpk(float lo, float hi) { f32x2_t v = {lo, hi}; bf16x2_t b = __builtin_convertvector(v, bf16x2_t); return __builtin_bit_cast(unsigned, b); }
__device__ __forceinline__ float att_bf16_up(float x) { unsigned u = __float_as_uint(x); if (u & 0xFFFFu) { u &= 0xFFFF0000u; if (x > 0.f) u += 0x10000u; } return __uint_as_float(u); }
__device__ __forceinline__ s16x4 vtr(lds_cptr p) { return __builtin_bit_cast(s16x4, __builtin_amdgcn_ds_read_tr16_b64_v4i16((ATT_LAS v4i16_t*)p)); }
#define ATT_KS(j) (((j) & (NSLOT - 1)) * KSLOT)
#define ATT_VS(j) (((j) & (NSLOT - 1)) * VSLOT)
#define ATT_WAIT_BAR() asm volatile("s_waitcnt vmcnt(0) lgkmcnt(0)\n\ts_barrier" ::: "memory")
#define ATT_WAIT_BAR_N(three) do { if (three) asm volatile("s_waitcnt vmcnt(3) lgkmcnt(0)\n\ts_barrier" ::: "memory"); else asm volatile("s_waitcnt vmcnt(2) lgkmcnt(0)\n\ts_barrier" ::: "memory"); } while (0)

struct Unit {
    const bf16_t* Q; int q_pitch;
    const bf16_t* K; int k_pitch;
    const bf16_t* Kr;
    const bf16_t* V; int v_pitch;
    int key0, ntiles;
    int q0;
    const unsigned short* list; int len;
    const float* posf;
    float slope2;
    bf16_t* O; int o_pitch;
    bf16_t* part; float* plse; int h;
};

template <int MODE> __device__ __forceinline__ void unit(const Unit& U, char* shm, const int wid) {
    constexpr int DQK = (MODE == 0) ? 96 : 64, ND0 = DQK / 16;
    const int lane = pg8::lane_id_v(), tid = wid * 64 + lane, r32 = lane & 31, hi = lane >> 5;
    const unsigned lds0 = (unsigned)(uintptr_t)shm;
    const lds_cptr shm3 = (lds_cptr)shm;
    ATT_LAS float* wsf = (ATT_LAS float*)(shm3 + LDS_WS) + wid * 64;
    int qrow, slot = 0; bool valid = true;
    if (MODE == 2) { const int e = wid * 32 + r32; valid = e < U.len; const unsigned ent = valid ? (unsigned)U.list[e] : (unsigned)U.list[0]; qrow = (int)(ent & 0x3FFFu); slot = 1 + (int)(ent >> 14); }
    else qrow = U.q0 + wid * 32 + r32;
    const unsigned koff = (unsigned)((U.key0 + 8 * wid + (lane >> 3)) * U.k_pitch + (((lane & 7) ^ ((4 * wid + (lane >> 4)) & 7)) * 8)) * 2u;
    const unsigned kroff = (MODE == 0) ? (unsigned)((U.key0 + 16 * (wid & 3) + (lane >> 2)) * 32 + (((lane & 3) ^ ((lane >> 4) & 3)) * 8)) * 2u : 0u;
    const unsigned voff = (unsigned)((U.key0 + 16 * (wid & 3) + (lane >> 2)) * U.v_pitch + (wid >> 2) * 32 + (lane & 3) * 8) * 2u;
#define ATT_DMA(t, ks, vs) do { glds16((const char*)U.K + koff + (size_t)(t) * (KVBLK * 2) * U.k_pitch, (unsigned)(lds0 + LDS_K + wid * 1024 + (ks))); \
        if (MODE == 0 && wid < 4) glds16((const char*)U.Kr + kroff + (size_t)(t) * (KVBLK * 64), (unsigned)(lds0 + LDS_K + (8 + (wid & 3)) * 1024 + (ks))); \
        glds16((const char*)U.V + voff + (size_t)(t) * (KVBLK * 2) * U.v_pitch, (unsigned)(lds0 + LDS_V + wid * 1024 + (vs))); } while (0)
    const int NT = U.ntiles;
    ATT_DMA(0, 0, 0);
    if (NT > 1) ATT_DMA(1, KSLOT, VSLOT);
    bf16x8 qr[ND0];
    { const bf16_t* Qw = U.Q + (size_t)qrow * U.q_pitch + hi * 8;
#pragma unroll
      for (int d0 = 0; d0 < ND0; ++d0) qr[d0] = *reinterpret_cast<const bf16x8*>(Qw + d0 * 16); }
    float pq = 0.f;
    if (MODE != 0) { pq = U.posf[qrow]; if (tid < 256) ((ATT_LAS float*)(shm3 + LDS_POSK))[tid] = U.posf[U.key0 + tid]; }
    float mhat = -1e30f, l_reg = 0.f; f32x16 o[2]; o[0] = f32x16{}; o[1] = f32x16{};
    const int km_ = (r32 >> 1) & 7, kmr_ = (r32 >> 2) & 3;
    const int ka0 = LDS_K + r32 * 128 + 32 * (km_ >> 1) + 16 * (hi ^ (km_ & 1));
    const int kb0 = LDS_K + 8192 + r32 * 64 + 32 * (kmr_ >> 1) + 16 * (hi ^ (kmr_ & 1));
#define ATT_KADDR(d0, half, KS) (shm3 + (KS) + (((d0) < 4) ? ((ka0 ^ ((d0) << 5)) + (half) * 4096) : ((kb0 ^ (((d0) - 4) << 5)) + (half) * 2048)))
    const lds_cptr vp0 = shm3 + LDS_V + ((lane >> 4) & 1) * 32 + (lane & 3) * 8 + (4 * hi + ((lane & 15) >> 2)) * 64;
#define ATT_QKT(P0, P1, KS) do { P0 = f32x16{}; P1 = f32x16{}; bf16x8 kk_[2 * ND0]; \
        _Pragma("unroll") for (int d0 = 0; d0 < ND0; ++d0) { kk_[2 * d0] = *(const ATT_LAS bf16x8*)ATT_KADDR(d0, 0, KS); kk_[2 * d0 + 1] = *(const ATT_LAS bf16x8*)ATT_KADDR(d0, 1, KS); }     \
        __builtin_amdgcn_sched_barrier(0); \
        _Pragma("unroll") for (int d0 = 0; d0 < ND0; ++d0) { \
            P0 = __builtin_amdgcn_mfma_f32_32x32x16_bf16(kk_[2 * d0], qr[d0], P0, 0, 0, 0); P1 = __builtin_amdgcn_mfma_f32_32x32x16_bf16(kk_[2 * d0 + 1], qr[d0], P1, 0, 0, 0); } } while (0)
#define ATT_SMPV(P0, P1, T, VS) do { \
        if (MODE != 0) { const ATT_LAS float* pk_ = (const ATT_LAS float*)(shm3 + LDS_POSK) + 64 * (T) + 4 * hi; \
            _Pragma("unroll") for (int g = 0; g < 4; ++g) { const f32x4 a_ = *(const ATT_LAS f32x4*)(pk_ + 8 * g), b_ = *(const ATT_LAS f32x4*)(pk_ + 8 * g + 32); \
                _Pragma("unroll") for (int j = 0; j < 4; ++j) { P0[4 * g + j] -= U.slope2 * __builtin_fabsf(pq - a_[j]); P1[4 * g + j] -= U.slope2 * __builtin_fabsf(pq - b_[j]); } } } \
        if (MODE == 0 || MODE == 1) { const int kb_ = U.key0 + 64 * (T); \
            if (kb_ + 63 > U.q0 + wid * 32) { const int dq_ = qrow - kb_ - 4 * hi; \
                _Pragma("unroll") for (int r = 0; r < 16; ++r) { const int c_ = (r & 3) + 8 * (r >> 2); if (c_ > dq_) P0[r] = -INFINITY; if (c_ + 32 > dq_) P1[r] = -INFINITY; } } } \
        float rm_ = P0[0]; \
        _Pragma("unroll") for (int r = 1; r < 16; ++r) rm_ = fmaxf(rm_, P0[r]); \
        _Pragma("unroll") for (int r = 0; r < 16; ++r) rm_ = fmaxf(rm_, P1[r]); \
        { auto rr_ = __builtin_amdgcn_permlane32_swap(__float_as_uint(rm_), __float_as_uint(rm_), false, false); rm_ = fmaxf(__uint_as_float(rr_[0]), __uint_as_float(rr_[1])); } \
        if (__any(rm_ > mhat + 10.0f)) { const float mn_ = fmaxf(mhat, rm_), f_ = __builtin_amdgcn_exp2f(mhat - mn_); mhat = mn_; l_reg *= f_; \
            _Pragma("unroll") for (int r = 0; r < 16; ++r) { o[0][r] *= f_; o[1][r] *= f_; } }                        \
        float sacc_ = 0.f; \
        _Pragma("unroll") for (int r = 0; r < 16; ++r) { P0[r] = __builtin_amdgcn_exp2f(P0[r] - mhat); P1[r] = __builtin_amdgcn_exp2f(P1[r] - mhat); sacc_ += P0[r] + P1[r]; } \
        l_reg += sacc_; \
        u32x4 pw_[4]; \
        _Pragma("unroll") for (int s_ = 0; s_ < 2; ++s_) { \
            pw_[s_] = (u32x4){cvtpk(P0[8 * s_], P0[8 * s_ + 1]), cvtpk(P0[8 * s_ + 2], P0[8 * s_ + 3]), cvtpk(P0[8 * s_ + 4], P0[8 * s_ + 5]), cvtpk(P0[8 * s_ + 6], P0[8 * s_ + 7])}; \
            pw_[2 + s_] = (u32x4){cvtpk(P1[8 * s_], P1[8 * s_ + 1]), cvtpk(P1[8 * s_ + 2], P1[8 * s_ + 3]), cvtpk(P1[8 * s_ + 4], P1[8 * s_ + 5]), cvtpk(P1[8 * s_ + 6], P1[8 * s_ + 7])}; } \
        const lds_cptr vp_ = vp0 + (VS); s16x4 vl_[8], vh_[8]; \
        _Pragma("unroll") for (int i_ = 0; i_ < 8; ++i_) { vl_[i_] = vtr(vp_ + (i_ >> 2) * 4096 + (i_ & 3) * 1024); vh_[i_] = vtr(vp_ + (i_ >> 2) * 4096 + (i_ & 3) * 1024 + 512); }     \
        __builtin_amdgcn_sched_barrier(0); \
        _Pragma("unroll") for (int i_ = 0; i_ < 8; ++i_) { \
            const bf16x8 vf_ = (bf16x8){vl_[i_][0], vl_[i_][1], vl_[i_][2], vl_[i_][3], vh_[i_][0], vh_[i_][1], vh_[i_][2], vh_[i_][3]}; \
            o[i_ >> 2] = __builtin_amdgcn_mfma_f32_32x32x16_bf16(vf_, __builtin_bit_cast(bf16x8, pw_[i_ & 3]), o[i_ >> 2], 0, 0, 0); } } while (0)
#define ATT_ACT(T) (MODE != 1 || (64 * (T) <= wid * 32 + 31))
#define ATT_ITER(SC0, SC1, SN0, SN1, T) do { const bool has_next_ = (T) + 1 < NT; \
        if (has_next_ && ATT_ACT((T) + 1)) ATT_QKT(SN0, SN1, ATT_KS((T) + 1)); \
        if (ATT_ACT(T)) ATT_SMPV(SC0, SC1, T, ATT_VS(T)); \
        if (has_next_ && (MODE == 0 || NT > NSLOT)) { if ((T) + 3 < NT) ATT_WAIT_BAR_N(dma3); else ATT_WAIT_BAR(); if ((T) + 4 < NT) ATT_DMA((T) + 4, ATT_KS(T), ATT_VS(T)); }   \
        } while (0)
    const bool dma3 = (MODE == 0) && wid < 4;
    if (NT > 2) ATT_DMA(2, 2 * KSLOT, 2 * VSLOT);
    if (NT > 3) ATT_DMA(3, 3 * KSLOT, 3 * VSLOT);
    if (MODE == 0 && NT > 3) ATT_WAIT_BAR_N(dma3); else ATT_WAIT_BAR();
    f32x16 pA0, pA1, pB0, pB1;
    ATT_QKT(pA0, pA1, 0);
    int t = 0;
    if (MODE == 0 && NT > 4) {
#define ATT_SB() __builtin_amdgcn_sched_barrier(0)
#define ATT_KLD(i, KS) kf[i] = *(const ATT_LAS bf16x8*)ATT_KADDR((i) >> 1, (i) & 1, KS)
#define ATT_VLD(i, VS) do { vlo[i] = vtr(vp0 + (VS) + ((i) >> 2) * 4096 + ((i) & 3) * 1024); vhi[i] = vtr(vp0 + (VS) + ((i) >> 2) * 4096 + ((i) & 3) * 1024 + 512); } while (0)
#define ATT_SCR(SC0, SC1, j) ((j) < 16 ? SC0[(j) & 15] : SC1[(j) & 15])
#define ATT_EXP4(SC0, SC1, g) do { if ((g) < 4) { _Pragma("unroll") for (int j_ = 0; j_ < 4; ++j_) SC0[4 * (g) + j_] = __builtin_amdgcn_exp2f(SC0[4 * (g) + j_]); } \
                                   else { _Pragma("unroll") for (int j_ = 0; j_ < 4; ++j_) SC1[4 * ((g) - 4) + j_] = __builtin_amdgcn_exp2f(SC1[4 * ((g) - 4) + j_]); } } while (0)
#define ATT_ADD4(SC0, SC1, g) do { if ((g) < 4) sacc_ += (SC0[4 * (g)] + SC0[4 * (g) + 1]) + (SC0[4 * (g) + 2] + SC0[4 * (g) + 3]); else sacc_ += (SC1[4 * ((g) - 4)] + SC1[4 * ((g) - 4) + 1]) + (SC1[4 * ((g) - 4) + 2] + SC1[4 * ((g) - 4) + 3]); } while (0)
#define ATT_CVT4(SC0, SC1, g) do { if ((g) < 4) { pw[(g) >> 1][2 * ((g) & 1)] = cvtpk(SC0[4 * (g)], SC0[4 * (g) + 1]); pw[(g) >> 1][2 * ((g) & 1) + 1] = cvtpk(SC0[4 * (g) + 2], SC0[4 * (g) + 3]); } \
                                   else { pw[(g) >> 1][2 * ((g) & 1)] = cvtpk(SC1[4 * ((g) - 4)], SC1[4 * ((g) - 4) + 1]); pw[(g) >> 1][2 * ((g) & 1) + 1] = cvtpk(SC1[4 * ((g) - 4) + 2], SC1[4 * ((g) - 4) + 3]); } } while (0)
#define ATT_GAPA(i, SC0, SC1, SN0, SN1) do { \
        if (((i) & 1) == 0) SN0 = __builtin_amdgcn_mfma_f32_32x32x16_bf16(kf[i], qr[(i) >> 1], SN0, 0, 0, 0); else SN1 = __builtin_amdgcn_mfma_f32_32x32x16_bf16(kf[i], qr[(i) >> 1], SN1, 0, 0, 0); \
        if ((i) < 8) { ATT_VLD(ATT_PJ(i), vs_); ATT_EXP4(SC0, SC1, i); } \
        if ((i) >= 1 && (i) <= 8) ATT_ADD4(SC0, SC1, (i) - 1); \
        if ((i) >= 2 && (i) <= 9) ATT_CVT4(SC0, SC1, (i) - 2); \
        ATT_SB(); } while (0)
#define ATT_PJ(j) ((((j) & 1) << 2) | ((j) >> 1))
#define ATT_VF(j) (bf16x8){vlo[j][0], vlo[j][1], vlo[j][2], vlo[j][3], vhi[j][0], vhi[j][1], vhi[j][2], vhi[j][3]}
#define ATT_GAPB(j, SN0, SN1) do { \
        o[ATT_PJ(j) >> 2] = __builtin_amdgcn_mfma_f32_32x32x16_bf16(ATT_VF(ATT_PJ(j)), __builtin_bit_cast(bf16x8, pw[ATT_PJ(j) & 3]), o[ATT_PJ(j) >> 2], 0, 0, 0);     \
        if ((j) < 6) { ATT_KLD(2 * (j), ks2_); ATT_KLD(2 * (j) + 1, ks2_); } \
        ATT_SB(); } while (0)
#define ATT_FAST(SC0, SC1, SN0, SN1, T) do { const int vs_ = ATT_VS(T), ks2_ = ATT_KS((T) + 2); \
        ATT_SB(); \
        float sacc_ = 0.f; \
        SN0 = __builtin_amdgcn_mfma_f32_32x32x16_bf16(kx, qx, f32x16{}, 0, 0, 0); SN1 = __builtin_amdgcn_mfma_f32_32x32x16_bf16(kx, qx, f32x16{}, 0, 0, 0);     \
        ATT_GAPA(0, SC0, SC1, SN0, SN1); ATT_GAPA(1, SC0, SC1, SN0, SN1); ATT_GAPA(2, SC0, SC1, SN0, SN1); ATT_GAPA(3, SC0, SC1, SN0, SN1); \
        ATT_GAPA(4, SC0, SC1, SN0, SN1); ATT_GAPA(5, SC0, SC1, SN0, SN1); ATT_GAPA(6, SC0, SC1, SN0, SN1); ATT_GAPA(7, SC0, SC1, SN0, SN1); \
        ATT_GAPA(8, SC0, SC1, SN0, SN1); ATT_GAPA(9, SC0, SC1, SN0, SN1); ATT_GAPA(10, SC0, SC1, SN0, SN1); ATT_GAPA(11, SC0, SC1, SN0, SN1); \
        l_reg += sacc_; \
        ATT_GAPB(0, SN0, SN1); ATT_GAPB(1, SN0, SN1); ATT_GAPB(2, SN0, SN1); ATT_GAPB(3, SN0, SN1); ATT_GAPB(4, SN0, SN1); ATT_GAPB(5, SN0, SN1); ATT_GAPB(6, SN0, SN1); ATT_GAPB(7, SN0, SN1); \
        ATT_SB(); \
        ATT_WAIT_BAR(); ATT_DMA((T) + 4, ATT_KS(T), vs_); \
        { const unsigned long long bal_ = __builtin_amdgcn_ballot_w64(sacc_ > 1048576.0f); float f_ = 1.f;     \
          if (bal_ != 0ull) { float s2_ = sacc_; { auto rr_ = __builtin_amdgcn_permlane32_swap(__float_as_uint(s2_), __float_as_uint(s2_), false, false); s2_ = fmaxf(__uint_as_float(rr_[0]), __uint_as_float(rr_[1])); }     \
            const float e_ = (s2_ > 1048576.0f) ? (float)((int)((__float_as_uint(s2_) >> 23) & 0xFFu) - 127) : 0.f; \
            const float mn_ = att_bf16_up(mhat + e_), dl_ = mn_ - mhat; f_ = __builtin_amdgcn_exp2f(-dl_); mhat = mn_; l_reg *= f_; \
            _Pragma("unroll") for (int r = 0; r < 16; ++r) { SN0[r] -= dl_; SN1[r] -= dl_; } \
            qx[0] = (hi == 0) ? (short)(__float_as_uint(-mhat) >> 16) : (short)0; } \
            \
          asm volatile("s_cmp_eq_u64 %[b], 0\n\ts_cbranch_scc1 .Lsk%=\n\ts_nop 1\n\tv_mul_f32_e32 %0, %[f], %0\n\tv_mul_f32_e32 %1, %[f], %1\n\tv_mul_f32_e32 %2, %[f], %2\n\tv_mul_f32_e32 %3, %[f], %3\n\tv_mul_f32_e32 %4, %[f], %4\n\tv_mul_f32_e32 %5, %[f], %5\n\tv_mul_f32_e32 %6, %[f], %6\n\tv_mul_f32_e32 %7, %[f], %7\n\tv_mul_f32_e32 %8, %[f], %8\n\tv_mul_f32_e32 %9, %[f], %9\n\tv_mul_f32_e32 %10, %[f], %10\n\tv_mul_f32_e32 %11, %[f], %11\n\tv_mul_f32_e32 %12, %[f], %12\n.Lsk%=:" : "+v"(o[0][0]), "+v"(o[0][1]), "+v"(o[0][2]), "+v"(o[0][3]), "+v"(o[0][4]), "+v"(o[0][5]), "+v"(o[0][6]), "+v"(o[0][7]), "+v"(o[0][8]), "+v"(o[0][9]), "+v"(o[0][10]), "+v"(o[0][11]), "+v"(o[0][12]) : [f] "v"(f_), [b] "s"(bal_) : "scc"); \
          asm volatile("s_cmp_eq_u64 %[b], 0\n\ts_cbranch_scc1 .Lsk%=\n\tv_mul_f32_e32 %0, %[f], %0\n\tv_mul_f32_e32 %1, %[f], %1\n\tv_mul_f32_e32 %2, %[f], %2\n\tv_mul_f32_e32 %3, %[f], %3\n\tv_mul_f32_e32 %4, %[f], %4\n\tv_mul_f32_e32 %5, %[f], %5\n\tv_mul_f32_e32 %6, %[f], %6\n\tv_mul_f32_e32 %7, %[f], %7\n\tv_mul_f32_e32 %8, %[f], %8\n\tv_mul_f32_e32 %9, %[f], %9\n\tv_mul_f32_e32 %10, %[f], %10\n\tv_mul_f32_e32 %11, %[f], %11\n\tv_mul_f32_e32 %12, %[f], %12\n.Lsk%=:" : "+v"(o[0][13]), "+v"(o[0][14]), "+v"(o[0][15]), "+v"(o[1][0]), "+v"(o[1][1]), "+v"(o[1][2]), "+v"(o[1][3]), "+v"(o[1][4]), "+v"(o[1][5]), "+v"(o[1][6]), "+v"(o[1][7]), "+v"(o[1][8]), "+v"(o[1][9]) : [f] "v"(f_), [b] "s"(bal_) : "scc"); \
          asm volatile("s_cmp_eq_u64 %[b], 0\n\ts_cbranch_scc1 .Lsk%=\n\tv_mul_f32_e32 %0, %[f], %0\n\tv_mul_f32_e32 %1, %[f], %1\n\tv_mul_f32_e32 %2, %[f], %2\n\tv_mul_f32_e32 %3, %[f], %3\n\tv_mul_f32_e32 %4, %[f], %4\n\tv_mul_f32_e32 %5, %[f], %5\n.Lsk%=:" : "+v"(o[1][10]), "+v"(o[1][11]), "+v"(o[1][12]), "+v"(o[1][13]), "+v"(o[1][14]), "+v"(o[1][15]) : [f] "v"(f_), [b] "s"(bal_) : "scc"); } \
        } while (0)
        bf16x8 kf[12]; s16x4 vlo[8], vhi[8]; u32x4 pw[4];
        float rm = pA0[0];
#pragma unroll
        for (int r = 1; r < 16; ++r) rm = fmaxf(rm, pA0[r]);
#pragma unroll
        for (int r = 0; r < 16; ++r) rm = fmaxf(rm, pA1[r]);
        { auto rr_ = __builtin_amdgcn_permlane32_swap(__float_as_uint(rm), __float_as_uint(rm), false, false); rm = fmaxf(__uint_as_float(rr_[0]), __uint_as_float(rr_[1])); }
        mhat = att_bf16_up(rm);
#pragma unroll
        for (int r = 0; r < 16; ++r) { pA0[r] -= mhat; pA1[r] -= mhat; }
        const bf16x8 kx = (bf16x8){(short)0x3F80, 0, 0, 0, 0, 0, 0, 0};
        bf16x8 qx = (bf16x8){0, 0, 0, 0, 0, 0, 0, 0};
        if (hi == 0) qx[0] = (short)(__float_as_uint(-mhat) >> 16);
#pragma unroll
        for (int i = 0; i < 12; ++i) ATT_KLD(i, KSLOT);
        if (wid >= 4) __builtin_amdgcn_s_setprio(1);
        for (; t + 4 < NT; t += 2) { ATT_FAST(pA0, pA1, pB0, pB1, t); ATT_FAST(pB0, pB1, pA0, pA1, t + 1); }
        if (wid >= 4) __builtin_amdgcn_s_setprio(0);
#pragma unroll
        for (int r = 0; r < 16; ++r) { pA0[r] += mhat; pA1[r] += mhat; }
#undef ATT_FAST
#undef ATT_GAPA
#undef ATT_GAPB
#undef ATT_VF
#undef ATT_PJ
#undef ATT_EXP4
#undef ATT_ADD4
#undef ATT_CVT4
#undef ATT_SCR
#undef ATT_KLD
#undef ATT_VLD
#undef ATT_SB
    }
    for (; t < NT; t += 2) {
        ATT_ITER(pA0, pA1, pB0, pB1, t);
        if (t + 1 < NT) ATT_ITER(pB0, pB1, pA0, pA1, t + 1);
    }
#undef ATT_QKT
#undef ATT_SMPV
#undef ATT_ACT
#undef ATT_ITER
    { auto rr = __builtin_amdgcn_permlane32_swap(__float_as_uint(l_reg), __float_as_uint(l_reg), false, false); l_reg = __uint_as_float(rr[0]) + __uint_as_float(rr[1]); }
    { const float rl = __builtin_amdgcn_rcpf(l_reg);
      bf16_t* prow = U.O + (size_t)(U.q0 + wid * 32 + r32) * U.o_pitch + 8 * hi;
#pragma unroll
      for (int dh = 0; dh < 2; ++dh)
#pragma unroll
        for (int jp = 0; jp < 2; ++jp) {
            unsigned a0 = cvtpk(o[dh][8 * jp] * rl, o[dh][8 * jp + 1] * rl), a1 = cvtpk(o[dh][8 * jp + 2] * rl, o[dh][8 * jp + 3] * rl);
            unsigned b0 = cvtpk(o[dh][8 * jp + 4] * rl, o[dh][8 * jp + 5] * rl), b1 = cvtpk(o[dh][8 * jp + 6] * rl, o[dh][8 * jp + 7] * rl);
            const auto s0 = __builtin_amdgcn_permlane32_swap(a0, b0, false, false); const auto s1 = __builtin_amdgcn_permlane32_swap(a1, b1, false, false);
            *(u32x4*)(prow + 32 * dh + 16 * jp) = (u32x4){s0[0], s1[0], s0[1], s1[1]}; } }
    asm volatile("s_waitcnt vmcnt(0) lgkmcnt(0)\n\ts_barrier" ::: "memory");
#undef ATT_DMA
}
}

namespace att {
constexpr int MB_REG = 65536, MB_TILE = 16384, MB_V = 8192, MB_POSK = 131072, MB_PRE = MB_POSK + 3072, MB_UT = MB_PRE + 2048, MB_NUT = 62, MB_TM = MB_UT + 1024, MB_KB = 140288, MB_ENT = MB_KB + 8192, MB_END = MB_ENT + 2048;
struct MobaCtx { const bf16_t* mqkv; const float* posf; bf16_t* part; float* plse; const unsigned* lists; const unsigned* cnt; int total, vcu, G; };
struct MobaDesc { int own, h, n; };
__device__ __forceinline__ unsigned att_bf16_rne(float f) { unsigned u = __float_as_uint(f); return (u + 0x7fffu + ((u >> 16) & 1u)) >> 16; }
__device__ __forceinline__ float att_bf2f(unsigned b) { return __uint_as_float(b << 16); }
__device__ __forceinline__ void att_split3(float c, unsigned& w1, unsigned& w2) { const unsigned c0 = att_bf16_rne(c); const float r1 = c - att_bf2f(c0); const unsigned c1 = att_bf16_rne(r1); const float r2 = r1 - att_bf2f(c1);
    w1 = c0 | (c1 << 16); w2 = att_bf16_rne(r2); }

__device__ __forceinline__ u32x4 moba_get(const MobaCtx& C, ATT_LAS const int* pre, int i) {
    const int ng = (C.vcu < C.total) ? (C.total - C.vcu + C.G - 1) / C.G : 0;
    if (i < ng) { const int gI = C.vcu + i * C.G; int lo = 0, hi = 511;
        while (lo < hi) { const int mid = (lo + hi) >> 1; if (pre[mid] > gI) hi = mid; else lo = mid + 1; }
        const int hn = lo, c = gI - (hn ? pre[hn - 1] : 0); const int len = (int)C.cnt[hn] - c * 256;
        return (u32x4){1u | ((unsigned)(hn >> 6) << 2) | ((unsigned)(hn & 63) << 5), (unsigned)(len < 256 ? len : 256), (unsigned)hn * 16384u + (unsigned)c * 256u, 0u}; }
    const int u = C.vcu + (i - ng) * C.G; if (u >= 512) return (u32x4){0u, 0u, 0u, 0u};
    return (u32x4){1u | 2u | ((unsigned)(u & 7) << 2) | ((unsigned)(u >> 3) << 5), 256u, 0u, 0u};
}
__device__ __forceinline__ void glds4(const void* gsrc, unsigned lds_dst) {
    asm volatile("s_mov_b32 m0, %1\n\ts_nop 0\n\tglobal_load_lds_dword %0, off" : : "v"(gsrc), "s"(lds_dst) : "memory", "m0"); }

template <int PROBE> __device__ __forceinline__ void moba_run(const MobaCtx& C, char* shm, const int wid) {
    const int lane = pg8::lane_id_v(), tid = wid * 64 + lane, r32 = lane & 31, hi = lane >> 5;
    const unsigned lds0 = (unsigned)(uintptr_t)shm; const lds_cptr shm3 = (lds_cptr)shm;
    ATT_LAS const int* pre = (ATT_LAS const int*)(shm3 + MB_PRE);
    const float* pmax = C.posf + 16384;
    const int km_ = (r32 >> 1) & 7;
    const int ka0 = r32 * 128 + 32 * (km_ >> 1) + 16 * (hi ^ (km_ & 1));
    const int vpl = MB_V + ((lane >> 4) & 1) * 32 + (lane & 3) * 8 + (4 * hi + ((lane & 15) >> 2)) * 64;
    const unsigned koff = (unsigned)((8 * wid + (lane >> 3)) * 1536 + (((lane & 7) ^ ((4 * wid + (lane >> 4)) & 7)) * 8)) * 2u;
    const unsigned voff = (unsigned)((16 * (wid & 3) + (lane >> 2)) * 1536 + (wid >> 2) * 32 + (lane & 3) * 8) * 2u;
#define MB_UNPACK(X_, D_) do { (D_).own = (int)(((X_) >> 1) & 1u); (D_).h = (int)(((X_) >> 2) & 7u); (D_).n = (PROBE & 4) ? 0 : (int)((X_) >> 5); } while (0)
#define MB_DMA(D_, R_) do { const char* kb_ = (const char*)(C.mqkv + 512 + (D_).h * 64 + (size_t)(D_).n * 256 * 1536); const char* vb_ = kb_ + 1024; \
        unsigned db_ = (unsigned)(lds0 + (R_) + wid * 1024); asm volatile("" : "+s"(db_));     \
        _Pragma("unroll") for (int t_ = 0; t_ < 4; ++t_) { glds16(kb_ + koff + (size_t)t_ * (64 * 1536 * 2), db_ + t_ * MB_TILE); \
                                                           glds16(vb_ + voff + (size_t)t_ * (64 * 1536 * 2), db_ + t_ * MB_TILE + MB_V); } } while (0)
#define MB_FETCH(I_, E_, X_) do { E_ = ((const ATT_LAS u32x4*)(shm3 + MB_UT))[(I_)]; X_ = (unsigned)__builtin_amdgcn_readfirstlane((int)E_[0]); } while (0)
#define MB_SMALL(U_, E_, D_) do { \
        if (!(D_).own) { const int e = wid * 32 + r32; if (hi == 0 && e < (int)E_[1]) glds4(C.lists + E_[2] + e, (unsigned)(lds0 + MB_ENT + ((U_) & 1) * 1024 + wid * 128)); } \
        if (wid < 4) glds4(C.posf + (D_).n * 256 + tid, (unsigned)(lds0 + MB_POSK + ((U_) % 3) * 1024 + wid * 256)); \
        if (tid < 4) glds4(pmax + 4 * (D_).n + tid, (unsigned)(lds0 + MB_TM + ((U_) % 3) * 16)); } while (0)
#define MB_STAGE(U_, D_) do { if (tid < 256) { const ATT_LAS float* pp_ = (const ATT_LAS float*)(shm3 + MB_POSK + ((U_) % 3) * 1024); \
            const float v_ = exp2f(-(float)((D_).h + 1)) * 1.4426950408889634f * (pp_[tid] - pp_[0]); const unsigned vh_ = att_bf16_rne(v_), vl_ = att_bf16_rne(v_ - att_bf2f(vh_)); \
            ((ATT_LAS u32x4*)(shm3 + MB_KB + ((U_) & 1) * 4096))[tid] = (u32x4){vh_ | (vl_ << 16), 0x3F803F80u, 0x00003F80u, 0u}; } } while (0)
#define MB_QROW(U_, E_, D_, META_, QR_, PQ_) do { const int e_ = wid * 32 + r32; \
        if ((D_).own) META_ = (((D_).n * 256 + e_) << 2); \
        else { const unsigned en_ = ((const ATT_LAS unsigned*)(shm3 + MB_ENT + ((U_) & 1) * 1024))[e_]; META_ = (e_ < (int)E_[1]) ? (int)(((en_ & 0x3FFFu) << 2) | (1u + ((en_ >> 14) & 3u))) : -1; } \
        const int qr_ = (PROBE & 4) ? (16128 + e_) : ((META_) >= 0 ? ((META_) >> 2) : 0); const bf16_t* Qw_ = C.mqkv + (D_).h * 64 + (size_t)qr_ * 1536 + hi * 8; \
        _Pragma("unroll") for (int d0 = 0; d0 < 4; ++d0) QR_[d0] = *reinterpret_cast<const bf16x8*>(Qw_ + d0 * 16); PQ_ = C.posf[qr_]; } while (0)
#define MB_CHEAP(U_, D_, META_, PQ_, CM_) do { const f32x4 tm_ = *(const ATT_LAS f32x4*)(shm3 + MB_TM + ((U_) % 3) * 16); CM_ = 0; \
        _Pragma("unroll") for (int t_ = 0; t_ < 4; ++t_) { bool ok_ = __all((META_) < 0 || (PQ_) >= tm_[t_]); if ((D_).own) ok_ = ok_ && (64 * t_ + 63 <= wid * 32); if (ok_) CM_ |= 1 << t_; } } while (0)
  for (int base = 0; ; base += MB_NUT) {
    __syncthreads();
    if (tid < MB_NUT) ((ATT_LAS u32x4*)(shm3 + MB_UT))[tid] = moba_get(C, pre, base + tid);
    if (tid == MB_NUT || tid == MB_NUT + 1) ((ATT_LAS u32x4*)(shm3 + MB_UT))[tid] = (u32x4){0u, 0u, 0u, 0u};
    __syncthreads();
    u32x4 ent_; unsigned xc, xn, xnn = 0u; MobaDesc D, Dn;
    MB_FETCH(0, ent_, xc);
    if (!(xc & 1u)) break;
    MB_UNPACK(xc, D);
    MB_DMA(D, 0); MB_SMALL(0, ent_, D);
    { u32x4 e1_; MB_FETCH(1, e1_, xn); MB_UNPACK(xn, Dn); if (xn & 1u) MB_SMALL(1, e1_, Dn); }
    asm volatile("" ::: "memory"); __builtin_amdgcn_s_waitcnt(0); __builtin_amdgcn_s_barrier(); asm volatile("" ::: "memory");
    int meta = -1, cm = 0; float pq = 0.f, pbase = 0.f; bf16x8 qr[4];
    MB_STAGE(0, D); MB_QROW(0, ent_, D, meta, qr, pq);
    pbase = ((const ATT_LAS float*)(shm3 + MB_POSK))[0];
    asm volatile("" ::: "memory"); __builtin_amdgcn_s_waitcnt(0); __builtin_amdgcn_s_barrier(); asm volatile("" ::: "memory");
    MB_CHEAP(0, D, meta, pq, cm);
    if (xn & 1u) MB_DMA(Dn, MB_REG);
    int i = 0;
    for (; xc & 1u; ++i) {
        int meta_n = -1; float pq_n = 0.f;
        MB_UNPACK(xn, Dn);
        const int cur = i & 1, rb = cur * MB_REG; const float slope2 = exp2f(-(float)(D.h + 1)) * 1.4426950408889634f;
        const bool valid = meta >= 0; const int qrow = valid ? (meta >> 2) : 0, slot = meta & 3;
        const ATT_LAS float* posk = (const ATT_LAS float*)(shm3 + MB_POSK + (i % 3) * 1024);
        const lds_cptr kbx = shm3 + MB_KB + cur * 4096 + r32 * 16;
        float mhat = 0.f, l_reg = 0.f; bool first_ = true; f32x16 o[2]; o[0] = f32x16{}; o[1] = f32x16{};
        unsigned qxa0 = 0u, qxa1 = 0u, qxa2 = 0u, qxr1 = 0u, qxr2 = 0u;
#define MB_QX() do { unsigned a1_, a2_, r1_, r2_; att_split3(-slope2 * (pq - pbase) - mhat, a1_, a2_); att_split3(-mhat, r1_, r2_); \
            qxa0 = hi == 0 ? 0x3F803F80u : 0u; qxa1 = hi == 0 ? a1_ : 0u; qxa2 = hi == 0 ? a2_ : 0u; qxr1 = hi == 0 ? r1_ : 0u; qxr2 = hi == 0 ? r2_ : 0u; } while (0)
        MB_QX();
        f32x16 pA0, pA1, pB0, pB1; float mA = 0.f, mB = 0.f;
#define MB_ACT(T) (!D.own || (64 * (T) <= wid * 32 + 31))
#define MB_CH(T) ((cm >> (T)) & 1)
#define MB_QKT(P0, P1, MR, T) do { bf16x8 kk_[8]; const lds_cptr kb_ = shm3 + rb + (T) * MB_TILE; \
            const bf16x8 kx0_ = *(const ATT_LAS bf16x8*)(kbx + (T) * 1024), kx1_ = *(const ATT_LAS bf16x8*)(kbx + (T) * 1024 + 512); \
            _Pragma("unroll") for (int d0 = 0; d0 < 4; ++d0) { kk_[2 * d0] = *(const ATT_LAS bf16x8*)(kb_ + (ka0 ^ (d0 << 5))); kk_[2 * d0 + 1] = *(const ATT_LAS bf16x8*)(kb_ + (ka0 ^ (d0 << 5)) + 4096); } \
            const bool ch_ = MB_CH(T); const u32x4 qs_ = (u32x4){ch_ ? qxa0 : 0u, ch_ ? qxa1 : qxr1, ch_ ? qxa2 : qxr2, 0u}; \
            __builtin_amdgcn_sched_barrier(0); \
            P0 = __builtin_amdgcn_mfma_f32_32x32x16_bf16(kx0_, __builtin_bit_cast(bf16x8, qs_), f32x16{}, 0, 0, 0); P1 = __builtin_amdgcn_mfma_f32_32x32x16_bf16(kx1_, __builtin_bit_cast(bf16x8, qs_), f32x16{}, 0, 0, 0); \
            _Pragma("unroll") for (int d0 = 0; d0 < 4; ++d0) { P0 = __builtin_amdgcn_mfma_f32_32x32x16_bf16(kk_[2 * d0], qr[d0], P0, 0, 0, 0); P1 = __builtin_amdgcn_mfma_f32_32x32x16_bf16(kk_[2 * d0 + 1], qr[d0], P1, 0, 0, 0); } \
            MR = mhat; } while (0)
#define MB_SMPV(P0, P1, MC, T) do { \
            if (__any(MC != mhat)) { const float d_ = mhat - MC; _Pragma("unroll") for (int r = 0; r < 16; ++r) { P0[r] -= d_; P1[r] -= d_; } }     \
            if (!MB_CH(T)) { const ATT_LAS float* pk_ = posk + 64 * (T) + 4 * hi; \
                _Pragma("unroll") for (int g = 0; g < 4; ++g) { const f32x4 a_ = *(const ATT_LAS f32x4*)(pk_ + 8 * g), b_ = *(const ATT_LAS f32x4*)(pk_ + 8 * g + 32); \
                    _Pragma("unroll") for (int j = 0; j < 4; ++j) { P0[4 * g + j] -= slope2 * __builtin_fabsf(pq - a_[j]); P1[4 * g + j] -= slope2 * __builtin_fabsf(pq - b_[j]); } } } \
            if (D.own && 64 * (T) + 63 > wid * 32) { int dq_ = wid * 32 + r32 - 64 * (T) - 4 * hi; asm volatile("" : "+v"(dq_));     \
                _Pragma("unroll") for (int r = 0; r < 16; ++r) { const int c_ = (r & 3) + 8 * (r >> 2); if (c_ > dq_) P0[r] = -INFINITY; if (c_ + 32 > dq_) P1[r] = -INFINITY; } } \
            float rm_ = P0[0]; \
            _Pragma("unroll") for (int r = 1; r < 16; ++r) rm_ = fmaxf(rm_, P0[r]); \
            _Pragma("unroll") for (int r = 0; r < 16; ++r) rm_ = fmaxf(rm_, P1[r]); \
            { auto rr_ = __builtin_amdgcn_permlane32_swap(__float_as_uint(rm_), __float_as_uint(rm_), false, false); rm_ = fmaxf(__uint_as_float(rr_[0]), __uint_as_float(rr_[1])); } \
            if (first_ || __any(rm_ > 10.0f)) { const float dl_ = first_ ? rm_ : fmaxf(rm_, 0.f); mhat += dl_; \
                _Pragma("unroll") for (int r = 0; r < 16; ++r) { P0[r] -= dl_; P1[r] -= dl_; } \
                if (!first_) { const float f_ = __builtin_amdgcn_exp2f(-dl_); l_reg *= f_; \
                    _Pragma("unroll") for (int r = 0; r < 16; ++r) { o[0][r] *= f_; o[1][r] *= f_; } }                        \
                first_ = false; MB_QX(); } \
            _Pragma("unroll") for (int r = 0; r < 16; ++r) { P0[r] = __builtin_amdgcn_exp2f(P0[r]); P1[r] = __builtin_amdgcn_exp2f(P1[r]); } \
            { float sa_ = 0.f;     \
              _Pragma("unroll") for (int r = 0; r < 16; ++r) { sa_ += P0[r]; sa_ += P1[r]; } \
              l_reg += sa_; } \
            u32x4 pw_[4]; \
            _Pragma("unroll") for (int s_ = 0; s_ < 2; ++s_) { \
                pw_[s_] = (u32x4){cvtpk(P0[8 * s_], P0[8 * s_ + 1]), cvtpk(P0[8 * s_ + 2], P0[8 * s_ + 3]), cvtpk(P0[8 * s_ + 4], P0[8 * s_ + 5]), cvtpk(P0[8 * s_ + 6], P0[8 * s_ + 7])}; \
                pw_[2 + s_] = (u32x4){cvtpk(P1[8 * s_], P1[8 * s_ + 1]), cvtpk(P1[8 * s_ + 2], P1[8 * s_ + 3]), cvtpk(P1[8 * s_ + 4], P1[8 * s_ + 5]), cvtpk(P1[8 * s_ + 6], P1[8 * s_ + 7])}; } \
            const lds_cptr vp_ = shm3 + rb + (T) * MB_TILE + vpl; s16x4 vl_[8], vh_[8]; \
            _Pragma("unroll") for (int i_ = 0; i_ < 8; ++i_) { vl_[i_] = vtr(vp_ + (i_ >> 2) * 4096 + (i_ & 3) * 1024); vh_[i_] = vtr(vp_ + (i_ >> 2) * 4096 + (i_ & 3) * 1024 + 512); } \
            __builtin_amdgcn_sched_barrier(0); \
            _Pragma("unroll") for (int i_ = 0; i_ < 8; ++i_) { \
                const bf16x8 vf_ = (bf16x8){vl_[i_][0], vl_[i_][1], vl_[i_][2], vl_[i_][3], vh_[i_][0], vh_[i_][1], vh_[i_][2], vh_[i_][3]}; \
                o[i_ >> 2] = __builtin_amdgcn_mfma_f32_32x32x16_bf16(vf_, __builtin_bit_cast(bf16x8, pw_[i_ & 3]), o[i_ >> 2], 0, 0, 0); } } while (0)
        if (!(PROBE & 1)) {
        if (MB_ACT(3)) MB_QKT(pA0, pA1, mA, 3);
        if (MB_ACT(2)) MB_QKT(pB0, pB1, mB, 2);
        if (MB_ACT(3)) MB_SMPV(pA0, pA1, mA, 3);
        }
        if (xn & 1u) { MB_STAGE(i + 1, Dn);
            MB_FETCH(i + 2, ent_, xnn); if (xnn & 1u) { MobaDesc Dnn; MB_UNPACK(xnn, Dnn); MB_SMALL(i + 2, ent_, Dnn); } } else xnn = 0u;
        if (!(PROBE & 1)) {
        if (!(PROBE & 64)) if (MB_ACT(1)) MB_QKT(pA0, pA1, mA, 1);
        if (MB_ACT(2)) MB_SMPV(pB0, pB1, mB, 2);
        if (!(PROBE & 64)) MB_QKT(pB0, pB1, mB, 0);
        }
        if (xn & 1u) { MB_FETCH(i + 1, ent_, xn); MB_QROW(i + 1, ent_, Dn, meta_n, qr, pq_n); }
        if (!(PROBE & 1)) {
        if (!(PROBE & 64)) if (MB_ACT(1)) MB_SMPV(pA0, pA1, mA, 1);
        if (!(PROBE & 64)) MB_SMPV(pB0, pB1, mB, 0);
        }
#undef MB_QKT
#undef MB_SMPV
#undef MB_ACT
#undef MB_CH
#undef MB_QX
        asm volatile("" ::: "memory"); __builtin_amdgcn_s_waitcnt(0); __builtin_amdgcn_s_barrier(); asm volatile("" ::: "memory");
        const int h_o = D.h; const bool valid_o = valid; const int qrow_o = qrow, slot_o = slot;
        xc = xn; xn = xnn; D = Dn; meta = meta_n; pq = pq_n;
        if (xc & 1u) { pbase = ((const ATT_LAS float*)(shm3 + MB_POSK + ((i + 1) % 3) * 1024))[0]; MB_CHEAP(i + 1, D, meta, pq, cm); }
        if (xn & 1u) { MobaDesc Dt; MB_UNPACK(xn, Dt); MB_DMA(Dt, cur * MB_REG); }
        { auto rr = __builtin_amdgcn_permlane32_swap(__float_as_uint(l_reg), __float_as_uint(l_reg), false, false); l_reg = __uint_as_float(rr[0]) + __uint_as_float(rr[1]); }
        { const float rl = __builtin_amdgcn_rcpf(l_reg);
          bf16_t* prow = C.part + ((((size_t)(qrow_o * 8 + h_o) * 4 + slot_o) * 64) & (PROBE ? ((PROBE & 4) ? (size_t)0x3FFC0 : (size_t)0x7FFFC0) : ~(size_t)0)) + 8 * hi;
#pragma unroll
          for (int dh = 0; dh < 2; ++dh)
#pragma unroll
            for (int jp = 0; jp < 2; ++jp) {
                unsigned a0 = cvtpk(o[dh][8 * jp] * rl, o[dh][8 * jp + 1] * rl), a1 = cvtpk(o[dh][8 * jp + 2] * rl, o[dh][8 * jp + 3] * rl);
                unsigned b0 = cvtpk(o[dh][8 * jp + 4] * rl, o[dh][8 * jp + 5] * rl), b1 = cvtpk(o[dh][8 * jp + 6] * rl, o[dh][8 * jp + 7] * rl);
                const auto s0 = __builtin_amdgcn_permlane32_swap(a0, b0, false, false); const auto s1 = __builtin_amdgcn_permlane32_swap(a1, b1, false, false);
                if (!(PROBE & 2)) if (valid_o) *(u32x4*)(prow + 32 * dh + 16 * jp) = (u32x4){s0[0], s1[0], s0[1], s1[1]}; }
          if (!(PROBE & 2)) if (hi == 0 && valid_o) C.plse[(size_t)(qrow_o * 8 + h_o) * 4 + slot_o] = mhat + __builtin_log2f(l_reg); }
    }
    if (i < MB_NUT) break;
  }
#undef MB_UNPACK
#undef MB_DMA
#undef MB_FETCH
#undef MB_SMALL
#undef MB_STAGE
#undef MB_QROW
#undef MB_CHEAP
}
}

namespace xb {
#define LAS __attribute__((address_space(3)))
#define XB_TMO      128
#define XB_XCNT(j)  (256  + 64 * (j))
#define XB_XSUB(j)  (1280 + 64 * (j))
#define XB_XGEN(j)  (2304 + 64 * (j))
#define XB_TOP      3328
#define XB_TOPGEN   3392
#define XCD_BAR_WORDS 3456
#define XB_SPIN_CAP (1u << 21)

__device__ __forceinline__ unsigned xb_ld(unsigned* p)              { return __hip_atomic_load(p, __ATOMIC_RELAXED, __HIP_MEMORY_SCOPE_AGENT); }
__device__ __forceinline__ unsigned xb_add(unsigned* p, unsigned v) { return __hip_atomic_fetch_add(p, v, __ATOMIC_RELAXED, __HIP_MEMORY_SCOPE_AGENT); }
__device__ __forceinline__ unsigned xb_xcc_id() { return (unsigned)__builtin_amdgcn_s_getreg((3 << 11) | 20) & 0xFu; }
#define XB_SPIN(cond, bar) do { unsigned _sp = 0; while (cond) { __builtin_amdgcn_s_sleep(1); \
    if ((++_sp & 255u) == 0u) { if (xb_ld(&(bar)[XB_TMO])) break; if (_sp > XB_SPIN_CAP) { atomicAdd(&(bar)[XB_TMO], 1u); break; } } } } while (0)

struct XcdBarrier {
    unsigned* bar; unsigned x;
    volatile LAS unsigned* st;
};

__device__ __forceinline__ XcdBarrier xcd_barrier_post(unsigned* bar, volatile LAS unsigned* st, bool leader) {
    XcdBarrier b; b.bar = bar; b.x = xb_xcc_id(); b.st = st;
    if (leader) (void)xb_add(&bar[XB_XCNT(b.x)], 1u);
    return b;
}
__device__ __forceinline__ void xcd_barrier_complete(unsigned* bar, unsigned x, unsigned& nloc, unsigned& nx) {
    const unsigned G = gridDim.x * gridDim.y * gridDim.z;
    unsigned sum, cnt, mine, sp = 0u;
    for (;;) {
        sum = 0u; cnt = 0u; mine = 0u;
#pragma unroll
        for (unsigned j = 0; j < 16; ++j) { const unsigned c = xb_ld(&bar[XB_XCNT(j)]); sum += c; cnt += (c > 0u) ? 1u : 0u; mine = (j == x) ? c : mine; }
        if (sum == G) break;
        __builtin_amdgcn_s_sleep(1);
        if ((++sp & 255u) == 0u) { if (xb_ld(&bar[XB_TMO])) break; if (sp > XB_SPIN_CAP) { atomicAdd(&bar[XB_TMO], 1u); break; } }
    }
    nloc = mine > 0u ? mine : 1u; nx = cnt > 0u ? cnt : 1u;
}

__device__ __forceinline__ void xcd_barrier(const XcdBarrier& b, bool leader) {
    asm volatile("s_waitcnt vmcnt(0)" ::: "memory");
    __syncthreads();
    if (leader) {
        unsigned* bar = b.bar;
        __builtin_amdgcn_s_waitcnt(0);
        unsigned nloc = b.st[0], nx = b.st[1];
        if (nloc == 0u) { xcd_barrier_complete(bar, b.x, nloc, nx); b.st[0] = nloc; b.st[1] = nx; }
        const unsigned old = xb_add(&bar[XB_XSUB(b.x)], 1u);
        const unsigned gen = old / nloc;
        if (old + 1u == (gen + 1u) * nloc) {
            __builtin_amdgcn_fence(__ATOMIC_RELEASE, "agent");
            asm volatile("s_waitcnt vmcnt(0)" ::: "memory");
            const unsigned og = xb_add(&bar[XB_TOP], 1u);
            const unsigned tg = og / nx;
            if (og + 1u == (tg + 1u) * nx) xb_add(&bar[XB_TOPGEN], 1u);
            else XB_SPIN(xb_ld(&bar[XB_TOPGEN]) == tg, bar);
            __builtin_amdgcn_fence(__ATOMIC_ACQUIRE, "agent");
            xb_add(&bar[XB_XGEN(b.x)], 1u);
            asm volatile("s_waitcnt vmcnt(0)" ::: "memory");
        } else {
            XB_SPIN(xb_ld(&bar[XB_XGEN(b.x)]) == gen, bar);
            __builtin_amdgcn_fence(__ATOMIC_ACQUIRE, "agent");
            asm volatile("s_waitcnt vmcnt(0)" ::: "memory");
        }
    }
    __syncthreads();
}

#undef LAS
}
namespace mk {
typedef unsigned short bf16;
typedef unsigned v4u __attribute__((ext_vector_type(4)));
typedef float f32x4 __attribute__((ext_vector_type(4)));
#define MK_LAS __attribute__((address_space(3)))
using namespace mkc;
constexpr int NWAVES = 8;
constexpr int RING_BYTES = 131072, LDS_EXTRA = RING_BYTES, LDS_MISC = RING_BYTES + 8192, LDS_BYTES = 150528;
constexpr size_t WS_BAR = 4096, BAR_BYTES = 32768;

struct Args { const float* in[18]; float* out; unsigned char* ws; int ph_lo, ph_hi; };
struct Frame { MK_LAS unsigned char* lds; int tid, lane, wave, vcu, G; };
typedef const __attribute__((address_space(4))) Args* kargs_t;
__device__ __forceinline__ kargs_t kargs() { kargs_t p = (kargs_t)__builtin_amdgcn_kernarg_segment_ptr(); asm volatile("" : "+s"(p)); return p; }
__device__ __forceinline__ Frame mkframe(MK_LAS unsigned char* lds, int wave) { Frame F; F.lds = lds; F.wave = wave; F.lane = pg8::lane_id_v(); F.tid = wave * 64 + F.lane; F.G = gridDim.x;
    { const int bx = blockIdx.x; F.vcu = (F.G % 8 == 0) ? (bx % 8) * (F.G / 8) + bx / 8 : bx; } return F; }

__device__ __forceinline__ unsigned f2bf(float f) { unsigned u = __builtin_bit_cast(unsigned, f); return (u + 0x7fffu + ((u >> 16) & 1u)) >> 16; }
__device__ __forceinline__ unsigned pk2(float lo, float hi) { return f2bf(lo) | (f2bf(hi) << 16); }
__device__ __forceinline__ float bf2f(unsigned short b) { return __builtin_bit_cast(float, (unsigned)b << 16); }
__device__ __forceinline__ float wave_sum(float v) {
#pragma unroll
    for (int o = 1; o < 64; o <<= 1) v += __shfl_xor(v, o);
    return v;
}
__constant__ float ROPE_INV[16] = {1.000000000e+00f, 5.623413324e-01f, 3.162277639e-01f, 1.778279394e-01f, 1.000000015e-01f, 5.623413250e-02f, 3.162277490e-02f, 1.778279431e-02f,
                                   9.999999776e-03f, 5.623413250e-03f, 3.162277630e-03f, 1.778279431e-03f, 1.000000047e-03f, 5.623413017e-04f, 3.162277571e-04f, 1.778279402e-04f};
__device__ __forceinline__ int rope_phys(int L) { return L < 16 ? 8 * (L >> 2) + (L & 3) : 8 * ((L - 16) >> 2) + 4 + ((L - 16) & 3); }

__device__ __forceinline__ void p0_item(const float* W, int K, int N, bf16* WT, const float* gain, int kind, MK_LAS float* scr, int item, int lane) {
    const int nblk = N / 32, kb = item / nblk, nb = item % nblk, k0 = 64 * kb, n0 = 32 * nb;
    int dbase = n0; bool perm = false; float mul = 1.0f;
    if (kind == 1) dbase = (n0 >> 7) * 256 + (n0 & 127);
    else if (kind == 2) dbase = (n0 >> 7) * 256 + 128 + (n0 & 127);
    else if (kind == 3) { if (n0 == 640) perm = true; else if (n0 >= 672) { dbase = n0 + 96; if (n0 < 1184) mul = C2M; } }
    else if (kind == 4) { perm = (n0 % 96) == 64; mul = C2Q; }
    else if (kind == 5) { const int h = n0 >> 7, e = n0 & 127; dbase = e < 64 ? h * 64 + e : 512 + h * 64 + (e - 64); }
    float wv[32];
#pragma unroll
    for (int i = 0; i < 32; ++i) wv[i] = W[(size_t)(k0 + 2 * i + (lane >> 5)) * N + n0 + (lane & 31)];
#pragma unroll
    for (int i = 0; i < 32; ++i) { const int kk = 2 * i + (lane >> 5); const float g = gain ? gain[k0 + kk] * mul : mul; scr[kk * 33 + (lane & 31)] = wv[i] * g; }
    asm volatile("s_waitcnt lgkmcnt(0)" ::: "memory");
    const int c = lane & 7;
#pragma unroll
    for (int j = 0; j < 4; ++j) { const int n = (lane >> 3) + 8 * j; const MK_LAS float* s = scr + (8 * c) * 33 + n;
        v4u o; o.x = pk2(s[0 * 33], s[1 * 33]); o.y = pk2(s[2 * 33], s[3 * 33]); o.z = pk2(s[4 * 33], s[5 * 33]); o.w = pk2(s[6 * 33], s[7 * 33]);
        const int drow = dbase + (perm ? rope_phys(n) : n);
        *(v4u*)(WT + (size_t)drow * K + k0 + 8 * c) = o; }
    asm volatile("s_waitcnt lgkmcnt(0)" ::: "memory");
}
constexpr int I_G = (DM / 64) * (DFF / 32), I_D = (DFF / 64) * (DM / 32), I_IN = (DM / 64) * (2208 / 32), I_UQ = (384 / 64) * (768 / 32), I_UKV = (256 / 64) * (1024 / 32), I_O = (DM / 64) * (DM / 32);
constexpr int NITEMS = 4 * I_G + 2 * I_D + I_IN + I_UQ + I_UKV + I_O;
__device__ __forceinline__ void p0_one_item(kargs_t ap, unsigned char* ws, MK_LAS float* scr, int it, int lane) {
    int r = it;
    if (r < I_G) { p0_item(ap->in[3], DM, DFF, (bf16*)(ws + WS_WGU1), ap->in[2], 1, scr, r, lane); return; } r -= I_G;
    if (r < I_G) { p0_item(ap->in[4], DM, DFF, (bf16*)(ws + WS_WGU1), ap->in[2], 2, scr, r, lane); return; } r -= I_G;
    if (r < I_D) { p0_item(ap->in[5], DFF, DM, (bf16*)(ws + WS_WD1), nullptr, 0, scr, r, lane); return; } r -= I_D;
    if (r < I_G) { p0_item(ap->in[14], DM, DFF, (bf16*)(ws + WS_WGU2), ap->in[13], 1, scr, r, lane); return; } r -= I_G;
    if (r < I_G) { p0_item(ap->in[15], DM, DFF, (bf16*)(ws + WS_WGU2), ap->in[13], 2, scr, r, lane); return; } r -= I_G;
    if (r < I_D) { p0_item(ap->in[16], DFF, DM, (bf16*)(ws + WS_WD2), nullptr, 0, scr, r, lane); return; } r -= I_D;
    if (r < I_IN) { p0_item(ap->in[7], DM, 2208, (bf16*)(ws + WS_WIN), ap->in[6], 3, scr, r, lane); return; } r -= I_IN;
    if (r < I_UQ) { p0_item(ap->in[9], 384, 768, (bf16*)(ws + WS_WUQ), ap->in[8], 4, scr, r, lane); return; } r -= I_UQ;
    if (r < I_UKV) { p0_item(ap->in[11], 256, 1024, (bf16*)(ws + WS_WUKV), ap->in[10], 5, scr, r, lane); return; } r -= I_UKV;
    p0_item(ap->in[12], DM, DM, (bf16*)(ws + WS_WOUT), nullptr, 0, scr, r, lane);
}
__device__ __forceinline__ void p0_tables_and_zero(kargs_t ap, const int gt, const int NGT) {
    unsigned char* ws = ap->ws;
    const int* pos = (const int*)ap->in[1]; float* posf = (float*)(ws + WS_POSF); float* cosT = (float*)(ws + WS_COS); float* sinT = (float*)(ws + WS_SIN);
    for (int e = gt; e < S * 16; e += NGT) { const int s_ = e >> 4, i = e & 15; const float ang = (float)pos[s_] * ROPE_INV[i]; float sn, cs; sincosf(ang, &sn, &cs); cosT[e] = cs; sinT[e] = sn; if (i == 0) posf[s_] = (float)pos[s_]; }
    for (int e = gt >> 6; e < S / 64; e += NGT >> 6) { int m_ = pos[64 * e + (gt & 63)];
#pragma unroll
        for (int o_ = 1; o_ < 64; o_ <<= 1) m_ = max(m_, __shfl_xor(m_, o_)); if ((gt & 63) == 0) posf[S + e] = (float)m_; }
    float* z = (float*)(ws + WS_SS2);
    for (int e = gt; e < 5 * S; e += NGT) z[e] = 0.f;
    float* km = (float*)(ws + WS_KMS);
    for (int e = gt; e < 64 * 512; e += NGT) km[e] = 0.f;
    unsigned* cnt = (unsigned*)(ws + WS_CNT);
    for (int e = gt; e < 512; e += NGT) cnt[e] = 0u;
    unsigned* padz = (unsigned*)((bf16*)(ws + WS_WIN) + (size_t)672 * DM);
    for (int e = gt; e < 96 * DM / 2; e += NGT) padz[e] = 0u;
}
__device__ __forceinline__ void p0_late_items(const Frame& F, kargs_t ap) {
    unsigned char* ws = ap->ws; MK_LAS float* scr = (MK_LAS float*)(F.lds + F.wave * 16384);
    const int w = ((int)blockIdx.x - 128) * NWAVES + F.wave, NW_ = 128 * NWAVES;
    for (int it = 2 * I_G + w; it < NITEMS; it += NW_) p0_one_item(ap, ws, scr, it, F.lane);
    p0_tables_and_zero(ap, w * 64 + F.lane, NW_ * 64);
}
__device__ __forceinline__ void p0_prologue(const Frame& F, kargs_t ap) {
    unsigned char* ws = ap->ws;
    MK_LAS float* scr = (MK_LAS float*)(F.lds + F.wave * 16384);
    const int gw = F.vcu * NWAVES + F.wave, NGW = F.G * NWAVES;
    constexpr int N_EARLY = 2 * I_G;
    const int n_here = (F.G == 256) ? N_EARLY : NITEMS;
    for (int it = gw; it < n_here; it += NGW) p0_one_item(ap, ws, scr, it, F.lane);
    const float* x = ap->in[0]; bf16* xb = (bf16*)(ws + WS_XB); float* ss1 = (float*)(ws + WS_SS1);
    for (int m = gw; m < S; m += 4 * NGW) {
        f32x4 v[4][4];
#pragma unroll
        for (int r = 0; r < 4; ++r) { const int mr = m + r * NGW; if (mr < S) { const f32x4* xr = (const f32x4*)(x + (size_t)mr * DM) + F.lane;
#pragma unroll
            for (int j = 0; j < 4; ++j) v[r][j] = xr[64 * j]; } }
#pragma unroll
        for (int r = 0; r < 4; ++r) { const int mr = m + r * NGW; if (mr < S) { unsigned long long* o8 = (unsigned long long*)(xb + (size_t)mr * DM) + F.lane; float s = 0.f;
#pragma unroll
            for (int j = 0; j < 4; ++j) { const f32x4 w = v[r][j]; s += (w[0] * w[0] + w[1] * w[1]) + (w[2] * w[2] + w[3] * w[3]); o8[64 * j] = (unsigned long long)pk2(w[0], w[1]) | ((unsigned long long)pk2(w[2], w[3]) << 32); }
            s = wave_sum(s); if (F.lane == 0) ss1[mr] = s; } }
    }
    if (F.G != 256) p0_tables_and_zero(ap, (F.vcu * NWAVES + F.wave) * 64 + F.lane, NGW * 64);
}

__device__ __forceinline__ void p4_krope(const Frame& F, kargs_t ap) { unsigned char* const wsb = ap->ws;
    const bf16* cqkv = (const bf16*)(wsb + WS_CQKV); bf16* Kr = (bf16*)(wsb + WS_KR); const float* cosT = (const float*)(wsb + WS_COS); const float* sinT = (const float*)(wsb + WS_SIN);
    const int gt = (F.vcu * NWAVES + F.wave) * 64 + F.lane, NGT = F.G * NWAVES * 64;
    for (int e = gt; e < S * 16; e += NGT) { const int s_ = e >> 4, i = e & 15, g = i >> 2, j = i & 3;
        const float x1 = bf2f(cqkv[(size_t)s_ * 768 + 640 + 8 * g + j]), x2 = bf2f(cqkv[(size_t)s_ * 768 + 640 + 8 * g + 4 + j]); const float c = cosT[e], sn = sinT[e];
        Kr[(size_t)s_ * 32 + 8 * g + j] = (bf16)f2bf(x1 * c - x2 * sn); Kr[(size_t)s_ * 32 + 8 * g + 4 + j] = (bf16)f2bf(x1 * sn + x2 * c); }
}
__device__ __forceinline__ void p4_gating(const Frame& F, kargs_t ap) { unsigned char* const wsb = ap->ws;
    const bf16* mqkv = (const bf16*)(wsb + WS_MQKV); const float* kms = (const float*)(wsb + WS_KMS); unsigned* cnt = (unsigned*)(wsb + WS_CNT); unsigned* lists = (unsigned*)(wsb + WS_LIST);
    MK_LAS float* km = (MK_LAS float*)F.lds;
    const int u0 = (F.G == 256) ? ((int)blockIdx.x < 192 ? (int)blockIdx.x : 256) : F.vcu, ustep = (F.G == 256) ? 192 : F.G;
    for (int u = u0; u < 256; u += ustep) {
        const int h = u & 7, q = (u >> 3) * 512 + F.tid, own = q >> 8;
        __syncthreads();
        for (int e = F.tid; e < 4096; e += 512) km[e] = kms[(size_t)(e >> 6) * 512 + h * 64 + (e & 63)] * (1.0f / 256.0f);
        __syncthreads();
        float qv[64];
        { const v4u* qp = (const v4u*)(mqkv + (size_t)q * 1536 + h * 64);
#pragma unroll
          for (int c = 0; c < 8; ++c) { const v4u w = qp[c];
#pragma unroll
              for (int j = 0; j < 4; ++j) { qv[8 * c + 2 * j] = __builtin_bit_cast(float, w[j] << 16); qv[8 * c + 2 * j + 1] = __builtin_bit_cast(float, w[j] & 0xFFFF0000u); } } }
        float g0 = -3e38f, g1 = -3e38f, g2 = -3e38f; int i0 = -1, i1 = -1, i2 = -1;
        const int own_max = __builtin_amdgcn_readfirstlane(own);
        for (int n = 0; n < own_max; ++n) {
            float g = 0.f;
#pragma unroll
            for (int c = 0; c < 16; ++c) { const f32x4 kk = *(const MK_LAS f32x4*)(km + n * 64 + 4 * c); g = fmaf(qv[4 * c], kk[0], g); g = fmaf(qv[4 * c + 1], kk[1], g); g = fmaf(qv[4 * c + 2], kk[2], g); g = fmaf(qv[4 * c + 3], kk[3], g); }
            if (g > g0) { g2 = g1; i2 = i1; g1 = g0; i1 = i0; g0 = g; i0 = n; }
            else if (g > g1) { g2 = g1; i2 = i1; g1 = g; i1 = n; }
            else if (g > g2) { g2 = g; i2 = n; }
        }
        MK_LAS unsigned* lcnt = (MK_LAS unsigned*)(F.lds + 16384);
        __syncthreads();
        if (F.tid < 64) lcnt[F.tid] = 0u;
        __syncthreads();
        unsigned r0 = 0u, r1 = 0u, r2 = 0u;
        if (i0 >= 0) r0 = __hip_atomic_fetch_add(lcnt + i0, 1u, __ATOMIC_RELAXED, __HIP_MEMORY_SCOPE_WORKGROUP);
        if (i1 >= 0) r1 = __hip_atomic_fetch_add(lcnt + i1, 1u, __ATOMIC_RELAXED, __HIP_MEMORY_SCOPE_WORKGROUP);
        if (i2 >= 0) r2 = __hip_atomic_fetch_add(lcnt + i2, 1u, __ATOMIC_RELAXED, __HIP_MEMORY_SCOPE_WORKGROUP);
        __syncthreads();
        if (F.tid < 64) { const unsigned c = lcnt[F.tid]; lcnt[64 + F.tid] = c ? atomicAdd(cnt + h * 64 + F.tid, c) : 0u; }
        __syncthreads();
        if (i0 >= 0) lists[(size_t)(h * 64 + i0) * S + lcnt[64 + i0] + r0] = (unsigned)(q | (0 << 14));
        if (i1 >= 0) lists[(size_t)(h * 64 + i1) * S + lcnt[64 + i1] + r1] = (unsigned)(q | (1 << 14));
        if (i2 >= 0) lists[(size_t)(h * 64 + i2) * S + lcnt[64 + i2] + r2] = (unsigned)(q | (2 << 14));
    }
    __syncthreads();
}
__device__ __forceinline__ void p5_combine(const Frame& F, kargs_t ap) { unsigned char* const wsb = ap->ws;
    const bf16* part = (const bf16*)ap->out;     const float* plse = (const float*)(wsb + WS_PLSE); bf16* cat = (bf16*)(wsb + WS_CAT);
    const int gt = (F.vcu * NWAVES + F.wave) * 64 + F.lane, NGT = F.G * NWAVES * 64;
    for (int e = gt; e < S * 8 * 8; e += NGT) { const int dg = e & 7, qh = e >> 3, q = qh >> 3, h = qh & 7; const int ns = 1 + min(3, q >> 8);
        const f32x4 ls = *(const f32x4*)(plse + (size_t)qh * 4);
        float M = ls[0]; for (int s = 1; s < 4; ++s) if (s < ns) M = fmaxf(M, ls[s]);
        float acc[8], wsum = 0.f;
#pragma unroll
        for (int j = 0; j < 8; ++j) acc[j] = 0.f;
#pragma unroll
        for (int s = 0; s < 4; ++s) if (s < ns) { const float w = __builtin_amdgcn_exp2f(ls[s] - M); wsum += w; const v4u v = *(const v4u*)(part + ((size_t)qh * 4 + s) * 64 + dg * 8);
#pragma unroll
            for (int j = 0; j < 4; ++j) { acc[2 * j] += w * __builtin_bit_cast(float, v[j] << 16); acc[2 * j + 1] += w * __builtin_bit_cast(float, v[j] & 0xFFFF0000u); } }
        const float r = 1.0f / wsum; v4u o; o.x = pk2(acc[0] * r, acc[1] * r); o.y = pk2(acc[2] * r, acc[3] * r); o.z = pk2(acc[4] * r, acc[5] * r); o.w = pk2(acc[6] * r, acc[7] * r);
        *(v4u*)(cat + (size_t)q * 1024 + 512 + h * 64 + dg * 8) = o; }
}
__device__ __forceinline__ void p9_final(const Frame& F, kargs_t ap) { unsigned char* const wsb = ap->ws;
    const float* ss = (const float*)(wsb + WS_SS4); const float* g = ap->in[17];
    const int gw = F.vcu * NWAVES + F.wave, NGW = F.G * NWAVES;
    float tsc = 1.0f;
#ifdef MK_TS
    { const unsigned long long* ts = (const unsigned long long*)(wsb + 2048); tsc = 1.0f + (float)(ts[MK_TS + 1] - ts[MK_TS]) * (float)MK_TS_SCALE; }
#endif
    for (int m = gw; m < S; m += NGW) { const float rs = tsc / sqrtf(ss[m] * (1.0f / 1024.0f) + 1e-6f); f32x4* xr = (f32x4*)(ap->out + (size_t)m * DM) + F.lane; const f32x4* gr = (const f32x4*)g + F.lane;
#pragma unroll
        for (int j = 0; j < 4; ++j) { const f32x4 v = xr[64 * j]; xr[64 * j] = v * rs * gr[64 * j]; } }
}

__global__ void __launch_bounds__(NWAVES * 64, 2) mk_fwd(Args a_unused) {
    extern __shared__ __attribute__((aligned(16))) unsigned char lds[];
    const int wave = __builtin_amdgcn_readfirstlane(threadIdx.x >> 6);
    MK_LAS unsigned char* const ldsp = (MK_LAS unsigned char*)lds;
    int lo, hi; { kargs_t ap = kargs(); lo = ap->ph_lo; hi = ap->ph_hi; }
#ifndef MK_ONLY
#define MK_ONLY -1
#endif
#define IN(k) ((MK_ONLY < 0 || MK_ONLY == (k)) && lo <= (k) && (k) < hi)
    const bool multi = (hi - lo) > 1;
    if (multi) {
        const int l0 = pg8::lane_id_v();
        if (wave == 0 && l0 < 2) ((volatile MK_LAS unsigned*)(ldsp + LDS_MISC))[l0] = 0u;
        __syncthreads();
        kargs_t ap = kargs(); (void)xb::xcd_barrier_post((unsigned*)(ap->ws + WS_BAR), (volatile MK_LAS unsigned*)(ldsp + LDS_MISC), wave == 0 && l0 == 0);
    }
    if (lo < -1) cg::this_grid().sync();
#ifdef MK_TS
#define MK_STAMP(i) do { if (blockIdx.x == 0 && wave == 0 && pg8::lane_id_v() == 0) { kargs_t ap__ = kargs(); ((unsigned long long*)(ap__->ws + 2048))[(i)] = __builtin_amdgcn_s_memrealtime(); } } while (0)
#else
#define MK_STAMP(i) do { } while (0)
#endif
    MK_STAMP(0);
#define SEAM(k) do { if (IN(k) && IN((k) + 1)) { kargs_t ap_ = kargs(); xb::XcdBarrier b_; b_.bar = (unsigned*)(ap_->ws + WS_BAR); b_.x = xb::xb_xcc_id(); b_.st = (volatile MK_LAS unsigned*)(ldsp + LDS_MISC); \
        xb::xcd_barrier(b_, wave == 0 && pg8::lane_id_v() == 0); MK_STAMP((k) + 1); } } while (0)
    if (IN(0)) { kargs_t ap = kargs(); const Frame F = mkframe(ldsp, wave);
#ifdef MK_PROBE0
        { int n0_; asm volatile("s_mov_b32 %0, 1" : "=s"(n0_)); for (int r0_ = 0; r0_ < n0_; ++r0_) { p0_prologue(F, ap); __syncthreads(); } }
#endif
        p0_prologue(F, ap); } SEAM(0);
    if (IN(1)) { kargs_t ap = kargs(); unsigned char* ws = ap->ws; pg8::Gemm g{(const bf16*)(ws + WS_XB), (const bf16*)(ws + WS_WGU1), S, NGU, DM, DM}; pg8::StaticOrder So; So.init(S, NGU, (int)gridDim.x, (int)blockIdx.x);
        pg8::EpiSwiGLU E{ws, 0}; pg8::gemm_phase<pg8::EpiSwiGLU, pg8::StaticOrder, true, true>(ldsp, g, So, E, wave);
        if (gridDim.x == 256 && blockIdx.x >= 128) { kargs_t ap2 = kargs(); const Frame F = mkframe(ldsp, wave); __syncthreads(); p0_late_items(F, ap2); } } SEAM(1);
    if (IN(2)) { kargs_t ap = kargs(); unsigned char* ws = ap->ws; pg8::Gemm g{(const bf16*)(ws + WS_ACT), (const bf16*)(ws + WS_WD1), S, DM, DFF, DFF}; pg8::StaticOrder So; So.init(S, DM, (int)gridDim.x, (int)blockIdx.x);
        pg8::EpiResid E{nullptr, ws, (int)WS_SS2, 0.5f}; pg8::gemm_phase<pg8::EpiResid, pg8::StaticOrder, true, true>(ldsp, g, So, E, wave); } SEAM(2);
    if (IN(3)) { kargs_t ap = kargs(); unsigned char* ws = ap->ws; pg8::Gemm g{(const bf16*)(ws + WS_XB), (const bf16*)(ws + WS_WIN), S, NWIN, DM, DM}; pg8::StaticOrder So; So.init(S, gridDim.x == 256 ? NWIN - 256 : NWIN, (int)gridDim.x, (int)blockIdx.x);
        pg8::EpiWin E{ws, 0}; pg8::gemm_phase<pg8::EpiWin, pg8::StaticOrder, true, true>(ldsp, g, So, E, wave); } SEAM(3);
    if (IN(4)) {
#ifdef MK_PROBE4
      int n4_; asm volatile("s_mov_b32 %0, 2" : "=s"(n4_));
      for (int r4_ = 0; r4_ < n4_; ++r4_) {
#endif
        { kargs_t ap = kargs(); unsigned char* ws = ap->ws; pg8::Gemm g{(const bf16*)(ws + WS_CQKV) + 384, (const bf16*)(ws + WS_WUKV), S, 1024, 256, 768}; pg8::StaticOrder So; So.init(S, 1024, (int)gridDim.x, (int)blockIdx.x);
          pg8::EpiKV E{ws}; pg8::gemm_phase<pg8::EpiKV, pg8::StaticOrder, true, true>(ldsp, g, So, E, wave); }
        { kargs_t ap = kargs(); unsigned char* ws = ap->ws; pg8::Gemm g{(const bf16*)(ws + WS_CQKV), (const bf16*)(ws + WS_WUQ), S, 768, 384, 768}; pg8::StaticOrder So; So.init(S, 768, (int)gridDim.x, (int)blockIdx.x);
          pg8::EpiQ E{ws}; pg8::gemm_phase<pg8::EpiQ, pg8::StaticOrder, true, true>(ldsp, g, So, E, wave); }
        if (gridDim.x == 256) { kargs_t ap = kargs(); unsigned char* ws = ap->ws; pg8::Gemm g{(const bf16*)(ws + WS_XB), (const bf16*)(ws + WS_WIN), S, NWIN, DM, DM}; pg8::TailOrder So; So.init(S, 8, (int)gridDim.x, (int)blockIdx.x);
          pg8::EpiWin E{ws, 0}; pg8::gemm_phase<pg8::EpiWin, pg8::TailOrder, true, true>(ldsp, g, So, E, wave); }
#if defined(MK_PROBE4) && MK_PROBE4 == 1
      __syncthreads(); }
#endif
        { kargs_t ap = kargs(); const Frame F = mkframe(ldsp, wave); p4_krope(F, ap); }
#if defined(MK_PROBE4) && MK_PROBE4 == 2
      __syncthreads(); }
#endif
#ifndef MK_NO_GATE
        { kargs_t ap = kargs(); const Frame F = mkframe(ldsp, wave); p4_gating(F, ap); }
#endif
    } SEAM(4);
#ifndef MK_NO_ATT5
    if (IN(5)) {
        kargs_t ap = kargs(); unsigned char* ws = ap->ws; const Frame F = mkframe(ldsp, wave);
        MK_LAS int* pre = (MK_LAS int*)(ldsp + att::MB_PRE);
        const unsigned* cnt = (const unsigned*)(ws + WS_CNT);
        __syncthreads();
        { const int c = (int)cnt[F.tid]; pre[F.tid] = (c + 255) >> 8; }
        __syncthreads();
        for (int o = 1; o < 512; o <<= 1) { const int v = pre[F.tid] + (F.tid >= o ? pre[F.tid - o] : 0); __syncthreads(); pre[F.tid] = v; __syncthreads(); }
        att::MobaCtx C; C.mqkv = (const bf16*)(ws + WS_MQKV); C.posf = (const float*)(ws + WS_POSF); C.part = (bf16*)ap->out; C.plse = (float*)(ws + WS_PLSE);
        C.lists = (const unsigned*)(ws + WS_LIST); C.cnt = cnt; C.total = pre[511]; C.vcu = F.vcu; C.G = F.G;
#ifdef MK_PROBE5
        { bf16* rp_ = C.part; float* rl_ = C.plse; C.part = (bf16*)(ws + WS_CQKV); C.plse = (float*)(ws + WS_CQKV + (16u << 20)); att::moba_run<MK_PROBE5>(C, (char*)lds, wave); __syncthreads(); C.part = rp_; C.plse = rl_; }
#endif
        att::moba_run<0>(C, (char*)lds, wave);
    }
#endif
    SEAM(5);
    if (IN(6)) {
#ifdef MK_PROBEC
        { int nc_; asm volatile("s_mov_b32 %0, 1" : "=s"(nc_)); for (int rc_ = 0; rc_ < nc_; ++rc_) { kargs_t ap = kargs(); const Frame F = mkframe(ldsp, wave); p5_combine(F, ap); __syncthreads(); } }
#endif
        { kargs_t ap = kargs(); const Frame F = mkframe(ldsp, wave); p5_combine(F, ap); }
#ifndef MK_NO_ATT6
        kargs_t ap = kargs(); unsigned char* ws = ap->ws; const Frame F = mkframe(ldsp, wave);
        att::Unit U; U.posf = nullptr; U.part = nullptr; U.plse = nullptr; U.list = nullptr; U.len = 0; U.slope2 = 0.f; U.q_pitch = 768; U.k_pitch = 512; U.v_pitch = 512; U.o_pitch = 1024; U.key0 = 0; U.Kr = (const bf16*)(ws + WS_KR);
        int vstep6 = F.G;
#ifdef MK_PROBE6
        asm volatile("s_mov_b32 %0, 0" : "=s"(vstep6));
        int npass6 = 0;
#endif
        for (int v = F.vcu; v < 256; v += vstep6) { const int h = v >> 5, s_ = v & 31;
#ifdef MK_PROBE6
            if (npass6++ >= MK_PROBE6) break;
            U.len = (npass6 == 1) ? 1 : 0;
#endif
            for (int i = 0; i < 2; ++i) { const int qb = i == 0 ? 63 - s_ : s_;
                U.h = h; U.Q = (const bf16*)(ws + WS_Q) + h * 96; U.K = (const bf16*)(ws + WS_KN) + h * 64; U.V = (const bf16*)(ws + WS_V) + h * 64; U.O = (bf16*)(ws + WS_CAT) + h * 64; U.q0 = qb * 256; U.ntiles = 4 * (qb + 1);
                att::unit<0>(U, (char*)lds, wave); } }
#endif
    } SEAM(6);
    if (IN(7)) { kargs_t ap = kargs(); unsigned char* ws = ap->ws; pg8::Gemm g{(const bf16*)(ws + WS_CAT), (const bf16*)(ws + WS_WOUT), S, DM, DM, DM}; pg8::StaticOrder So; So.init(S, DM, (int)gridDim.x, (int)blockIdx.x);
        pg8::EpiResid E{nullptr, ws, (int)WS_SS3, 1.0f}; pg8::gemm_phase<pg8::EpiResid, pg8::StaticOrder, true, true>(ldsp, g, So, E, wave); } SEAM(7);
    if (IN(8)) { kargs_t ap = kargs(); unsigned char* ws = ap->ws; pg8::Gemm g{(const bf16*)(ws + WS_XB), (const bf16*)(ws + WS_WGU2), S, NGU, DM, DM}; pg8::StaticOrder So; So.init(S, NGU, (int)gridDim.x, (int)blockIdx.x);
        pg8::EpiSwiGLU E{ws, 1};
#ifdef MK_PROBE8
        { int n8_; asm volatile("s_mov_b32 %0, 1" : "=s"(n8_)); for (int r8_ = 0; r8_ < n8_; ++r8_) { pg8::gemm_phase<pg8::EpiSwiGLU, pg8::StaticOrder, true, true>(ldsp, g, So, E, wave); __syncthreads(); } }
#endif
        pg8::gemm_phase<pg8::EpiSwiGLU, pg8::StaticOrder, true, true>(ldsp, g, So, E, wave); } SEAM(8);
    if (IN(9)) { kargs_t ap = kargs(); unsigned char* ws = ap->ws; pg8::Gemm g{(const bf16*)(ws + WS_ACT), (const bf16*)(ws + WS_WD2), S, DM, DFF, DFF}; pg8::StaticOrder So; So.init(S, DM, (int)gridDim.x, (int)blockIdx.x);
        if (gridDim.x == 256) { pg8::EpiResidNorm E{ap->out, ws, ap->in[17], 0.5f}; pg8::gemm_phase<pg8::EpiResidNorm, pg8::StaticOrder, false, true>(ldsp, g, So, E, wave); }
        else { pg8::EpiResid E{ap->out, ws, (int)WS_SS4, 0.5f}; pg8::gemm_phase<pg8::EpiResid, pg8::StaticOrder, true, true>(ldsp, g, So, E, wave); } }
    if (gridDim.x != 256) SEAM(9);
#ifdef MK_PROBE9
    if (IN(9)) { SEAM(9); kargs_t ap = kargs(); unsigned char* ws = ap->ws; pg8::Gemm g{(const bf16*)(ws + WS_ACT), (const bf16*)(ws + WS_WD2), S, DM, DFF, DFF}; pg8::StaticOrder So; So.init(S, DM, (int)gridDim.x, (int)blockIdx.x);
        pg8::EpiSwiGLU E{ws, 1}; pg8::gemm_phase<pg8::EpiSwiGLU, pg8::StaticOrder, true, true, MK_PROBE9 - 1>(ldsp, g, So, E, wave); }
#endif
    if (IN(10) && gridDim.x != 256) { kargs_t ap = kargs(); const Frame F = mkframe(ldsp, wave); p9_final(F, ap); }
#undef IN
#undef SEAM
}
constexpr int N_PHASES = 11;
}
#ifndef MK_BRINGUP
#define MK_BRINGUP 0
#endif
extern "C" void kernel_launch(void* const* d_in, const int* in_sizes, int n_in, void* d_out, int out_size, void* d_ws, size_t ws_size, hipStream_t stream) {
    static int grid = 0;
    if (grid == 0) {
        if (hipFuncSetAttribute((const void*)mk::mk_fwd, hipFuncAttributeMaxDynamicSharedMemorySize, mk::LDS_BYTES) != hipSuccess) { fprintf(stderr, "kernel_launch: hipFuncSetAttribute failed\n"); grid = -1; return; }
        int dev = 0, cus = 0, per_cu = 0;
        hipGetDevice(&dev); hipDeviceGetAttribute(&cus, hipDeviceAttributeMultiprocessorCount, dev);
        hipOccupancyMaxActiveBlocksPerMultiprocessor(&per_cu, (const void*)mk::mk_fwd, mk::NWAVES * 64, mk::LDS_BYTES);
        (void)hipGetLastError();
        grid = cus * (per_cu < 1 ? 1 : (per_cu > 1 ? 1 : per_cu));
        if (grid % 8 != 0 || grid <= 0) grid = 256;
        if (ws_size < mk::WS_END) { fprintf(stderr, "kernel_launch: workspace too small (%zu)\n", ws_size); grid = -1; return; }
    }
    if (grid < 0) return;
    mk::Args a{};
    for (int i = 0; i < 18; ++i) a.in[i] = (const float*)d_in[i];
    a.out = (float*)d_out; a.ws = (unsigned char*)d_ws;
#if MK_BRINGUP == 0
    if (hipMemsetAsync((char*)d_ws + mk::WS_BAR, 0, mk::BAR_BYTES, stream) != hipSuccess) { fprintf(stderr, "kernel_launch: memset failed\n"); return; }
    a.ph_lo = 0; a.ph_hi = mk::N_PHASES;
    void* args[] = {&a};
    hipError_t e = hipLaunchCooperativeKernel((const void*)mk::mk_fwd, dim3(grid), dim3(mk::NWAVES * 64), args, mk::LDS_BYTES, stream);
    if (e != hipSuccess) fprintf(stderr, "cooperative launch failed: %s (grid %d)\n", hipGetErrorString(e), grid);
#else
    const int nph = MK_BRINGUP == 1 ? 3 : MK_BRINGUP == 2 ? 8 : mk::N_PHASES;
    for (int ph = 0; ph < nph; ++ph) { a.ph_lo = ph; a.ph_hi = ph + 1; hipLaunchKernelGGL(mk::mk_fwd, dim3(grid), dim3(mk::NWAVES * 64), mk::LDS_BYTES, stream, a); }
#if MK_BRINGUP == 1
    nv::part_mix(d_in, (float*)d_out, d_ws, stream); nv::part_ffn2_final(d_in, (float*)d_out, d_ws, stream);
#elif MK_BRINGUP == 2
    nv::part_ffn2_final(d_in, (float*)d_out, d_ws, stream);
#endif
#endif
}
```

```cpp
#define MK_BRINGUP 0
#include <hip/hip_runtime.h>
#include <cstdio>
#include <cstdint>
#include <cmath>
#include <hip/hip_cooperative_groups.h>
namespace cg = cooperative_groups;

namespace mkc {
constexpr int S = 16384, DM = 1024, DFF = 2816, NGU = 2 * DFF, NWIN = 2304;
constexpr float LOG2E = 1.4426950408889634f;
constexpr float C2Q = 0.10206207261596577f * LOG2E;
constexpr float C2M = 0.125f * LOG2E;
constexpr size_t MiB = 1u << 20;
constexpr size_t WS_PANEL = 4096 + 16384;
constexpr size_t WS_CNT = 0;
constexpr size_t WS_SS1 = 1 * MiB, WS_SS2 = WS_SS1 + 65536, WS_SSQ = WS_SS2 + 65536, WS_SSKV = WS_SSQ + 65536, WS_SS3 = WS_SSKV + 65536, WS_SS4 = WS_SS3 + 65536;
constexpr size_t WS_KMS = WS_SS1 + 512 * 1024;
constexpr size_t WS_SSDUMMY = WS_SS1 + 384 * 1024, WS_KMSDUMMY = WS_SS1 + 640 * 1024;
constexpr size_t WS_POSF = 2 * MiB, WS_COS = 3 * MiB, WS_SIN = 4 * MiB;
constexpr size_t WS_WGU1 = 6 * MiB, WS_WD1 = 17 * MiB, WS_WGU2 = WS_WD1 + 5632 * 1024, WS_WD2 = WS_WGU2 + 11 * MiB, WS_WIN = 39 * MiB, WS_WUQ = WS_WIN + 4608 * 1024, WS_WUKV = WS_WUQ + 768 * 1024, WS_WOUT = 45 * MiB;
constexpr size_t WS_XB = 48 * MiB, WS_CQKV = 80 * MiB, WS_PLSE = 112 * MiB;
constexpr size_t WS_ACT = 114 * MiB, WS_MQKV = 114 * MiB, WS_CAT = 114 * MiB, WS_Q = 162 * MiB, WS_KN = 186 * MiB, WS_V = 202 * MiB, WS_KR = 218 * MiB, WS_LIST = 220 * MiB, WS_END = 252 * MiB;
static_assert(WS_WD2 + 5632 * 1024 <= WS_WIN && WS_WUKV + 512 * 1024 <= WS_WOUT && WS_WOUT + 2 * MiB <= WS_XB, "weight map");
}
namespace pg8 {
#define PG8_LAS __attribute__((address_space(3)))
typedef unsigned short bf16_t;
typedef short bf16x8 __attribute__((ext_vector_type(8)));
typedef float f32x4 __attribute__((ext_vector_type(4)));
typedef unsigned u32x4 __attribute__((ext_vector_type(4)));
__device__ __forceinline__ int lane_id_v() { int l; asm volatile("v_mbcnt_lo_u32_b32 %0, -1, 0\n\tv_mbcnt_hi_u32_b32 %0, -1, %0" : "=v"(l)); return l; }
constexpr int BM = 256, BK = 64, HALF = 128, HTB = HALF * BK * 2  , STAGE_BYTES = 8 * HTB, NXCD = 8, WGM = 4;

__host__ __device__ __forceinline__ int lds_byte(int r, int c) { const int st = (r >> 4) * 2 + (c >> 5), rr = r & 15, cc = c & 31, ob = rr * 64 + cc * 2; return st * 1024 + (ob ^ (((ob >> 9) & 1) << 5)); }
__host__ __device__ __forceinline__ void stage_rc(int b, int& R, int& C) { const int st = b / 1024, sb = b % 1024, swz = sb ^ (((sb >> 9) & 1) << 5); R = (st >> 1) * 16 + swz / 64; C = (st & 1) * 32 + (swz % 64) / 2; }
__host__ __device__ __forceinline__ int perm32(int rho) { const int n = rho >> 4, i = rho & 15; return 8 * (i >> 2) + 4 * n + (i & 3); }

struct Unit { int pm, pn; };
struct Gemm { const bf16_t* A; const bf16_t* Bt; int M, N, K, lda; };

struct StaticOrder {
    int nM, nN, nwg, G, c;
    __host__ __device__ void init(int M, int N, int G_, int c_) { nM = M / BM; nN = N / BM; nwg = nM * nN; G = G_; c = c_; }
    __host__ __device__ bool next(int i, Unit& u) const {
        const long L = (long)i * G + c; if (L >= nwg) return false;
        int wgid = (int)L; { const int q = nwg / NXCD, r = nwg % NXCD, xcd = wgid % NXCD, off = wgid / NXCD; wgid = (xcd < r ? xcd * (q + 1) : r * (q + 1) + (xcd - r) * q) + off; }
        const int nig = WGM * nN, gid = wgid / nig, fm = gid * WGM, gsz = (nM - fm) < WGM ? (nM - fm) : WGM;
        u.pm = fm + ((wgid % nig) % gsz); u.pn = (wgid % nig) / gsz; return true;
    }
    __device__ __forceinline__ void a_ready(const Unit&) const {}
    __device__ __forceinline__ void done(const Unit&) const {}
};
struct TailOrder {
    int nM, pn, G, c;
    __host__ __device__ void init(int M, int pn_, int G_, int c_) { nM = M / BM; pn = pn_; G = G_; c = c_; }
    __host__ __device__ bool next(int i, Unit& u) const { const int j = c - (G - nM); if (i != 0 || j < 0 || j >= nM) return false; u.pm = j; u.pn = pn; return true; }
    __device__ __forceinline__ void a_ready(const Unit&) const {}
    __device__ __forceinline__ void done(const Unit&) const {}
};
__device__ __forceinline__ unsigned cvt_pk_bf16(float lo, float hi) { unsigned r; asm volatile("v_cvt_pk_bf16_f32 %0, %1, %2" : "=v"(r) : "v"(lo), "v"(hi)); return r; }
typedef unsigned u32x2 __attribute__((ext_vector_type(2)));
constexpr float RMS_EPS = 1e-6f;
__device__ __forceinline__ float rs_of(const float* ss, int row, float invn) { return __builtin_amdgcn_rsqf(ss[row] * invn + RMS_EPS); }
__device__ __forceinline__ float silu_f(float g) { return g * __builtin_amdgcn_rcpf(1.0f + __builtin_amdgcn_exp2f(-1.4426950408889634f * g)); }
__device__ __forceinline__ u32x4 pack8(const f32x4 a, const f32x4 b) { u32x4 w; w.x = cvt_pk_bf16(a[0], a[1]); w.y = cvt_pk_bf16(a[2], a[3]); w.z = cvt_pk_bf16(b[0], b[1]); w.w = cvt_pk_bf16(b[2], b[3]); return w; }

struct EpiSwiGLU {
    static constexpr bool PERM = true, AFTER_DRAIN = false;
    unsigned char* ws; int which;
    __device__ __forceinline__ void operator()(const f32x4 (&acc)[2][2][4][2], const Unit& u, int wr, int wc, int fr, int fq) const {
        bf16_t* O = (bf16_t*)(ws + mkc::WS_ACT); const int ldo = mkc::DFF; const float* ss = (const float*)(ws + (which ? mkc::WS_SS3 : mkc::WS_SS1)); const float invn = 1.0f / 1024.0f;
        const int row0 = u.pm * BM + wr * 64 + fr, col0 = u.pn * HALF + wc * 32 + 8 * fq;
        float sv[2][4];
#pragma unroll
        for (int ai = 0; ai < 2; ++ai)
#pragma unroll
            for (int m = 0; m < 4; ++m) sv[ai][m] = ss[row0 + ai * HALF + m * 16];
#pragma unroll
        for (int ai = 0; ai < 2; ++ai)
#pragma unroll
            for (int m = 0; m < 4; ++m) { const int row = row0 + ai * HALF + m * 16;
                const float rs = __builtin_amdgcn_rsqf(sv[ai][m] * invn + RMS_EPS), rs2 = rs * -1.4426950408889634f, rsq = rs * rs;
                f32x4 a[2];
#pragma unroll
                for (int n = 0; n < 2; ++n) { const f32x4 g = acc[ai][0][m][n], t = g * rs2; f32x4 d;
#pragma unroll
                    for (int j = 0; j < 4; ++j) d[j] = __builtin_amdgcn_exp2f(t[j]);
                    d = d + 1.0f;
#pragma unroll
                    for (int j = 0; j < 4; ++j) d[j] = __builtin_amdgcn_rcpf(d[j]);
                    a[n] = (g * acc[ai][1][m][n]) * (d * rsq); }
                *(u32x4*)(O + (size_t)row * ldo + col0) = pack8(a[0], a[1]); }
    }
};
__device__ __forceinline__ f32x4 bf4_to_f32(const u32x2 w) { f32x4 r; r[0] = __builtin_bit_cast(float, w.x << 16); r[1] = __builtin_bit_cast(float, w.x & 0xFFFF0000u); r[2] = __builtin_bit_cast(float, w.y << 16); r[3] = __builtin_bit_cast(float, w.y & 0xFFFF0000u); return r; }
struct EpiResid {
    static constexpr bool PERM = false, AFTER_DRAIN = false;
    float* out; unsigned char* ws; int ss_off; float alpha;
    __device__ __forceinline__ void operator()(const f32x4 (&acc)[2][2][4][2], const Unit& u, int wr, int wc, int fr, int fq) const {
        bf16_t* xb = (bf16_t*)(ws + mkc::WS_XB); float* ss_out = (float*)(ws + ss_off);
        const int row0 = u.pm * BM + wr * 64 + fr, col0 = u.pn * BM + wc * 32 + 4 * fq;
        u32x2 bw[2][4][2][2];
#pragma unroll
        for (int ai = 0; ai < 2; ++ai)
#pragma unroll
            for (int m = 0; m < 4; ++m)
#pragma unroll
                for (int bj = 0; bj < 2; ++bj)
#pragma unroll
                    for (int n = 0; n < 2; ++n) bw[ai][m][bj][n] = *(const u32x2*)(xb + (size_t)(row0 + ai * HALF + m * 16) * 1024 + col0 + bj * HALF + n * 16);
#pragma unroll
        for (int ai = 0; ai < 2; ++ai)
#pragma unroll
            for (int m = 0; m < 4; ++m) { const int row = row0 + ai * HALF + m * 16; const size_t off = (size_t)row * 1024 + col0; float s = 0.f;
#pragma unroll
                for (int bj = 0; bj < 2; ++bj)
#pragma unroll
                    for (int n = 0; n < 2; ++n) { const f32x4 b = bf4_to_f32(bw[ai][m][bj][n]); const f32x4 o = b + acc[ai][bj][m][n] * alpha;
                        if (out) *(f32x4*)(out + off + bj * HALF + n * 16) = o;
                        s += (o[0] * o[0] + o[1] * o[1]) + (o[2] * o[2] + o[3] * o[3]);
                        u32x2 w; w.x = cvt_pk_bf16(o[0], o[1]); w.y = cvt_pk_bf16(o[2], o[3]); *(u32x2*)(xb + off + bj * HALF + n * 16) = w; }
                s += __shfl_xor(s, 16); s += __shfl_xor(s, 32);
                if (fq == 0) atomicAdd(ss_out + row, s);
                asm volatile("" ::: "memory"); }
    }
};
struct EpiWin {
    static constexpr bool PERM = true, AFTER_DRAIN = false;
    unsigned char* ws; int dummy;
    __device__ __forceinline__ void operator()(const f32x4 (&acc)[2][2][4][2], const Unit& u, int wr, int wc, int fr, int fq) const {
        bf16_t* cqkv = (bf16_t*)(ws + mkc::WS_CQKV); bf16_t* mqkv = (bf16_t*)(ws + mkc::WS_MQKV); const float* ss_in = (const float*)(ws + mkc::WS_SS2);
        float* ssq = (float*)(ws + (dummy ? mkc::WS_SSDUMMY : mkc::WS_SSQ)); float* sskv = (float*)(ws + (dummy ? mkc::WS_SSDUMMY + 65536 : mkc::WS_SSKV)); float* kmsum = (float*)(ws + (dummy ? mkc::WS_KMSDUMMY : mkc::WS_KMS));
        const int row0 = u.pm * BM + wr * 64 + fr;
        const bool is_mk = (u.pn == 5 || u.pn == 6);
        f32x4 cs[2][2];
#pragma unroll
        for (int bj = 0; bj < 2; ++bj)
#pragma unroll
            for (int n = 0; n < 2; ++n) cs[bj][n] = (f32x4){0.f, 0.f, 0.f, 0.f};
        float sv[2][4];
#pragma unroll
        for (int ai = 0; ai < 2; ++ai)
#pragma unroll
            for (int m = 0; m < 4; ++m) sv[ai][m] = ss_in[row0 + ai * HALF + m * 16];
#pragma unroll
        for (int ai = 0; ai < 2; ++ai)
#pragma unroll
            for (int m = 0; m < 4; ++m) { const int row = row0 + ai * HALF + m * 16; const float rs = __builtin_amdgcn_rsqf(sv[ai][m] * (1.0f / 1024.0f) + RMS_EPS);
#pragma unroll
                for (int bj = 0; bj < 2; ++bj) { const int colt = u.pn * BM + bj * HALF, col0 = colt + wc * 32 + 8 * fq;
                    const f32x4 v0 = acc[ai][bj][m][0] * rs, v1 = acc[ai][bj][m][1] * rs;
                    bf16_t* dst = (colt < 768) ? (cqkv + (size_t)row * 768 + col0) : (mqkv + (size_t)row * 1536 + (col0 - 768));
                    *(u32x4*)dst = pack8(v0, v1);
                    if (colt < 640) { float s = (v0[0] * v0[0] + v0[1] * v0[1]) + (v0[2] * v0[2] + v0[3] * v0[3]) + (v1[0] * v1[0] + v1[1] * v1[1]) + (v1[2] * v1[2] + v1[3] * v1[3]);
                        s += __shfl_xor(s, 16); s += __shfl_xor(s, 32);
                        if (fq == 0) atomicAdd((colt < 384 ? ssq : sskv) + row, s); }
                    if (is_mk) { cs[bj][0] += v0; cs[bj][1] += v1; } } }
        if (is_mk) {
#pragma unroll
            for (int bj = 0; bj < 2; ++bj)
#pragma unroll
                for (int n = 0; n < 2; ++n)
#pragma unroll
                    for (int j = 0; j < 4; ++j) { float s = cs[bj][n][j]; s += __shfl_xor(s, 1); s += __shfl_xor(s, 2); s += __shfl_xor(s, 4); s += __shfl_xor(s, 8);
                        if (fr == 0) atomicAdd(kmsum + (size_t)u.pm * 512 + (u.pn * BM + bj * HALF + wc * 32 + 8 * fq + 4 * n + j - 1280), s); }
        }
    }
};
struct EpiKV {
    static constexpr bool PERM = true, AFTER_DRAIN = false;
    unsigned char* ws;
    __device__ __forceinline__ void operator()(const f32x4 (&acc)[2][2][4][2], const Unit& u, int wr, int wc, int fr, int fq) const {
        bf16_t* Kn = (bf16_t*)(ws + mkc::WS_KN); bf16_t* V = (bf16_t*)(ws + mkc::WS_V); const float* ss = (const float*)(ws + mkc::WS_SSKV);
        const int row0 = u.pm * BM + wr * 64 + fr;
        float sv[2][4];
#pragma unroll
        for (int ai = 0; ai < 2; ++ai)
#pragma unroll
            for (int m = 0; m < 4; ++m) sv[ai][m] = ss[row0 + ai * HALF + m * 16];
#pragma unroll
        for (int ai = 0; ai < 2; ++ai)
#pragma unroll
            for (int m = 0; m < 4; ++m) { const int row = row0 + ai * HALF + m * 16; const float rs = __builtin_amdgcn_rsqf(sv[ai][m] * (1.0f / 256.0f) + RMS_EPS);
#pragma unroll
                for (int bj = 0; bj < 2; ++bj) { const int colt = u.pn * BM + bj * HALF, col0 = colt + wc * 32 + 8 * fq;
                    bf16_t* dst = (colt < 512) ? (Kn + (size_t)row * 512 + col0) : (V + (size_t)row * 512 + (col0 - 512));
                    *(u32x4*)dst = pack8(acc[ai][bj][m][0] * rs, acc[ai][bj][m][1] * rs); } }
    }
};
struct EpiQ {
    static constexpr bool PERM = true, AFTER_DRAIN = false;
    unsigned char* ws;
    __device__ __forceinline__ void operator()(const f32x4 (&acc)[2][2][4][2], const Unit& u, int wr, int wc, int fr, int fq) const {
        bf16_t* Q = (bf16_t*)(ws + mkc::WS_Q); const float* ss = (const float*)(ws + mkc::WS_SSQ); const float* cosT = (const float*)(ws + mkc::WS_COS); const float* sinT = (const float*)(ws + mkc::WS_SIN);
        const int row0 = u.pm * BM + wr * 64 + fr;
        float sv[2][4];
#pragma unroll
        for (int ai = 0; ai < 2; ++ai)
#pragma unroll
            for (int m = 0; m < 4; ++m) sv[ai][m] = ss[row0 + ai * HALF + m * 16];
#pragma unroll
        for (int ai = 0; ai < 2; ++ai)
#pragma unroll
            for (int m = 0; m < 4; ++m) { const int row = row0 + ai * HALF + m * 16; const float rs = __builtin_amdgcn_rsqf(sv[ai][m] * (1.0f / 384.0f) + RMS_EPS);
#pragma unroll
                for (int bj = 0; bj < 2; ++bj) { const int col0 = u.pn * BM + bj * HALF + wc * 32 + 8 * fq; const int d = col0 % 96;
                    f32x4 v0 = acc[ai][bj][m][0] * rs, v1 = acc[ai][bj][m][1] * rs;
                    if (d >= 64) { const int g = (d - 64) >> 3; const f32x4 c = *(const f32x4*)(cosT + (size_t)row * 16 + 4 * g), s = *(const f32x4*)(sinT + (size_t)row * 16 + 4 * g);
                        const f32x4 o0 = v0 * c - v1 * s, o1 = v0 * s + v1 * c; v0 = o0; v1 = o1; }
                    *(u32x4*)(Q + (size_t)row * 768 + col0) = pack8(v0, v1); }
                asm volatile("" ::: "memory"); }
    }
};
struct EpiResidNorm {
    static constexpr bool PERM = false, AFTER_DRAIN = true;
    float* out; unsigned char* ws; const float* gain; float alpha;
    __device__ __forceinline__ void fused(f32x4 (&acc)[2][2][4][2], const Unit& u, int wr, int wc, int fr, int fq, PG8_LAS unsigned char* lds, int wid, int lane) const {
        float* ss = (float*)(ws + mkc::WS_SS4); unsigned* pcnt = (unsigned*)(ws + mkc::WS_PANEL) + 64 * u.pm; const bf16_t* xb = (const bf16_t*)(ws + mkc::WS_XB);
        const int row0 = u.pm * BM + wr * 64 + fr, col0 = u.pn * BM + wc * 32 + 4 * fq;
#pragma unroll
        for (int ai = 0; ai < 2; ++ai)
#pragma unroll
            for (int m = 0; m < 4; ++m) { const int row = row0 + ai * HALF + m * 16; const size_t off = (size_t)row * 1024 + col0; float s = 0.f;
#pragma unroll
                for (int bj = 0; bj < 2; ++bj)
#pragma unroll
                    for (int n = 0; n < 2; ++n) { const f32x4 b = bf4_to_f32(*(const u32x2*)(xb + off + bj * HALF + n * 16)); const f32x4 o = b + acc[ai][bj][m][n] * alpha; acc[ai][bj][m][n] = o;
                        s += (o[0] * o[0] + o[1] * o[1]) + (o[2] * o[2] + o[3] * o[3]); }
                s += __shfl_xor(s, 16); s += __shfl_xor(s, 32);
                if (fq == 0) atomicAdd(ss + row, s);
                asm volatile("" : "+v"(acc[ai][0][m][0]), "+v"(acc[ai][0][m][1]), "+v"(acc[ai][1][m][0]), "+v"(acc[ai][1][m][1]));
                if (m & 1) asm volatile("" ::: "memory"); }
        asm volatile("s_waitcnt vmcnt(0)" ::: "memory"); __builtin_amdgcn_s_barrier(); asm volatile("" ::: "memory");
        if (wid == 0) {
            if (lane == 0) { __builtin_amdgcn_fence(__ATOMIC_RELEASE, "agent"); asm volatile("s_waitcnt vmcnt(0)" ::: "memory"); __hip_atomic_fetch_add(pcnt, 1u, __ATOMIC_RELAXED, __HIP_MEMORY_SCOPE_AGENT); }
            unsigned spins = 0;
            while ((unsigned)__builtin_amdgcn_readfirstlane(__hip_atomic_load(pcnt, __ATOMIC_RELAXED, __HIP_MEMORY_SCOPE_AGENT)) < 4u) { __builtin_amdgcn_s_sleep(2); if (++spins > (1u << 22)) break; }
            __builtin_amdgcn_fence(__ATOMIC_ACQUIRE, "agent");
        }
        asm volatile("s_waitcnt vmcnt(0) lgkmcnt(0)" ::: "memory"); __builtin_amdgcn_s_barrier(); asm volatile("" ::: "memory");
        f32x4 gv[2][2];
#pragma unroll
        for (int bj = 0; bj < 2; ++bj)
#pragma unroll
            for (int n = 0; n < 2; ++n) gv[bj][n] = *(const f32x4*)(gain + col0 + bj * HALF + n * 16);
#pragma unroll
        for (int ai = 0; ai < 2; ++ai)
#pragma unroll
            for (int m = 0; m < 4; ++m) { const int row = row0 + ai * HALF + m * 16; const size_t off = (size_t)row * 1024 + col0;
                const float tot = __hip_atomic_load(ss + row, __ATOMIC_RELAXED, __HIP_MEMORY_SCOPE_AGENT); const float rs = __builtin_amdgcn_rsqf(tot * (1.0f / 1024.0f) + RMS_EPS);
#pragma unroll
                for (int bj = 0; bj < 2; ++bj)
#pragma unroll
                    for (int n = 0; n < 2; ++n) *(f32x4*)(out + off + bj * HALF + n * 16) = acc[ai][bj][m][n] * rs * gv[bj][n]; }
    }
};

template <class Epi, class Sched, bool ALIGN_EPI = false, bool SP2 = false>
__device__ __forceinline__ void gemm_phase(PG8_LAS unsigned char* lds, const Gemm g, const Sched& S, const Epi& E, const int wid) {
    const int lane = lane_id_v(), tid = wid * 64 + lane, wr = wid >> 2, wc = wid & 3, fr = lane & 15, fq = lane >> 4;
    const int K = g.K, nt = K / BK, lda = g.lda;
    unsigned voffA[2], voffB[2];
#pragma unroll
    for (int i = 0; i < 2; ++i) { int R, C; stage_rc(tid * 16 + i * 8192, R, C); const int Rb = Epi::PERM ? ((R & ~31) + perm32(R & 31)) : R;
        voffA[i] = (unsigned)(R * lda + C) * 2u; voffB[i] = (unsigned)(Rb * K + C) * 2u; }
    const size_t kstep = (size_t)(BK * 2);
    const size_t hstep = (size_t)HALF * K * 2;
    const size_t tstep = 2 * hstep; const size_t hstepA = (size_t)HALF * lda * 2, tstepA = 2 * hstepA;
    const unsigned ldsw = (unsigned)wid * 1024u;
    const int aoff = lds_byte(wr * 64 + fr, fq * 8), boff = lds_byte(wc * 32 + fr, fq * 8);
#define PG8_SA(b, h) (((b) * 2 + (h)) * HTB)
#define PG8_SB(b, h) ((4 + (b) * 2 + (h)) * HTB)
#define PG8_STAGE(bufoff, gbase, voff) do { _Pragma("unroll") for (int _i = 0; _i < 2; ++_i) \
        __builtin_amdgcn_global_load_lds((const unsigned*)((const char*)(gbase) + (voff)[_i]), (PG8_LAS unsigned*)(lds + (bufoff) + ldsw + _i * 8192), 16, 0, 0); } while (0)
#define PG8_LDA(dst, b, h) do { _Pragma("unroll") for (int m = 0; m < 4; ++m) _Pragma("unroll") for (int k = 0; k < 2; ++k) dst[m][k] = *(const PG8_LAS bf16x8*)(lds + PG8_SA(b, h) + aoff + m * 2048 + k * 1024); } while (0)
#define PG8_LDB(dst, b, h) do { _Pragma("unroll") for (int n = 0; n < 2; ++n) _Pragma("unroll") for (int k = 0; k < 2; ++k) dst[n][k] = *(const PG8_LAS bf16x8*)(lds + PG8_SB(b, h) + boff + n * 2048 + k * 1024); } while (0)
#define PG8_MMA(ai, bj, At, Bt) do { __builtin_amdgcn_s_setprio(1); _Pragma("unroll") for (int m = 0; m < 4; ++m) _Pragma("unroll") for (int n = 0; n < 2; ++n) _Pragma("unroll") for (int k = 0; k < 2; ++k) \
        acc[ai][bj][m][n] = __builtin_amdgcn_mfma_f32_16x16x32_bf16(Bt[n][k], At[m][k], acc[ai][bj][m][n], 0, 0, 0); __builtin_amdgcn_s_setprio(0); } while (0)
#define PG8_WAIT_V(n) asm volatile("s_waitcnt vmcnt(" #n ")" ::: "memory")
#define PG8_WAIT_L(n) asm volatile("s_waitcnt lgkmcnt(" #n ")" ::: "memory")
#define PG8_BAR __builtin_amdgcn_s_barrier()
#define PG8_SCHED __builtin_amdgcn_sched_barrier(0)
    Unit cur, nxt; int ui = 0;
    if (!S.next(0, cur)) return;
    f32x4 acc[2][2][4][2];
#pragma unroll
    for (int a = 0; a < 2; ++a)
#pragma unroll
        for (int b = 0; b < 2; ++b)
#pragma unroll
            for (int m = 0; m < 4; ++m)
#pragma unroll
                for (int n = 0; n < 2; ++n) acc[a][b][m][n] = (f32x4){0.f, 0.f, 0.f, 0.f};
    bf16x8 At[4][2], B0[2][2], B1[2][2];
    const char* cA = (const char*)g.A + (size_t)cur.pm * tstepA; const char* cB = (const char*)g.Bt + (size_t)cur.pn * tstep;
    S.a_ready(cur);
    if constexpr (SP2) {
        PG8_STAGE(PG8_SB(0, 0), cB, voffB); PG8_STAGE(PG8_SB(0, 1), cB + hstep, voffB); PG8_STAGE(PG8_SA(0, 0), cA, voffA); PG8_STAGE(PG8_SA(0, 1), cA + hstepA, voffA);
        if (wr == 1) PG8_BAR;
        PG8_WAIT_V(2); PG8_BAR;
        PG8_STAGE(PG8_SB(1, 0), cB + kstep, voffB); PG8_STAGE(PG8_SA(1, 0), cA + kstep, voffA); PG8_STAGE(PG8_SB(1, 1), cB + hstep + kstep, voffB);
        PG8_WAIT_V(6); PG8_BAR;
    } else {
        PG8_STAGE(PG8_SB(0, 0), cB, voffB); PG8_STAGE(PG8_SA(0, 0), cA, voffA); PG8_STAGE(PG8_SB(0, 1), cB + hstep, voffB); PG8_STAGE(PG8_SA(0, 1), cA + hstepA, voffA);
        if (wr == 1) PG8_BAR;
        PG8_WAIT_V(4); PG8_BAR;
        PG8_STAGE(PG8_SB(1, 0), cB + kstep, voffB); PG8_STAGE(PG8_SA(1, 0), cA + kstep, voffA); PG8_STAGE(PG8_SB(1, 1), cB + hstep + kstep, voffB);
        PG8_WAIT_V(6); PG8_BAR;
    }
    for (;;) {
        const bool has_next = S.next(ui + 1, nxt);
        const char* nA = has_next ? (const char*)g.A + (size_t)nxt.pm * tstepA : cA; const char* nB = has_next ? (const char*)g.Bt + (size_t)nxt.pn * tstep : cB;
#pragma nounroll
        for (int t = 0; t < nt; t += 2) {
            const bool last = (t == nt - 2);
            const char* a1 = cA + (size_t)(t + 1) * kstep;
            const char* a2 = last ? nA : cA + (size_t)(t + 2) * kstep; const char* b2 = last ? nB : cB + (size_t)(t + 2) * kstep;
            const char* a3 = a2 + kstep; const char* b3 = b2 + kstep;
            if (last && has_next) S.a_ready(nxt);
            if constexpr (SP2) {
            PG8_LDB(B0, 0, 0); PG8_LDB(B1, 0, 1); PG8_SCHED; PG8_LDA(At, 0, 0); PG8_STAGE(PG8_SA(1, 1), a1 + hstepA, voffA);
            PG8_WAIT_V(8); PG8_WAIT_L(0); PG8_BAR; PG8_MMA(0, 0, At, B0); PG8_MMA(0, 1, At, B1); PG8_BAR; PG8_SCHED;
            PG8_LDA(At, 0, 1); PG8_STAGE(PG8_SB(0, 0), b2, voffB); PG8_STAGE(PG8_SB(0, 1), b2 + hstep, voffB); PG8_STAGE(PG8_SA(0, 0), a2, voffA);
            PG8_WAIT_V(8); PG8_WAIT_L(0); PG8_BAR; PG8_MMA(1, 0, At, B0); PG8_MMA(1, 1, At, B1); PG8_BAR; PG8_SCHED;
            PG8_LDB(B0, 1, 0); PG8_LDB(B1, 1, 1); PG8_SCHED; PG8_LDA(At, 1, 0); PG8_STAGE(PG8_SA(0, 1), a2 + hstepA, voffA);
            PG8_WAIT_V(8); PG8_WAIT_L(0); PG8_BAR; PG8_MMA(0, 0, At, B0); PG8_MMA(0, 1, At, B1); PG8_BAR; PG8_SCHED;
            PG8_LDA(At, 1, 1); PG8_STAGE(PG8_SB(1, 0), b3, voffB); PG8_STAGE(PG8_SB(1, 1), b3 + hstep, voffB); PG8_STAGE(PG8_SA(1, 0), a3, voffA);
            PG8_WAIT_V(8); PG8_WAIT_L(0); PG8_BAR; PG8_MMA(1, 0, At, B0); PG8_MMA(1, 1, At, B1); PG8_BAR; PG8_SCHED;
            } else {
            PG8_LDB(B0, 0, 0); PG8_SCHED; PG8_LDA(At, 0, 0); PG8_STAGE(PG8_SA(1, 1), a1 + hstepA, voffA);
            PG8_WAIT_L(8); PG8_BAR; PG8_WAIT_L(0); PG8_MMA(0, 0, At, B0); PG8_BAR; PG8_SCHED;
            PG8_LDB(B1, 0, 1); PG8_STAGE(PG8_SB(0, 0), b2, voffB);
            PG8_BAR; PG8_WAIT_L(0); PG8_MMA(0, 1, At, B1); PG8_BAR;
            PG8_LDA(At, 0, 1); PG8_STAGE(PG8_SA(0, 0), a2, voffA);
            PG8_BAR; PG8_WAIT_L(0); PG8_MMA(1, 0, At, B0); PG8_BAR; PG8_SCHED;
            PG8_STAGE(PG8_SB(0, 1), b2 + hstep, voffB);
            PG8_WAIT_V(6); PG8_BAR; PG8_MMA(1, 1, At, B1); PG8_BAR;
            PG8_LDB(B0, 1, 0); PG8_SCHED; PG8_LDA(At, 1, 0); PG8_STAGE(PG8_SA(0, 1), a2 + hstepA, voffA);
            PG8_WAIT_L(8); PG8_BAR; PG8_WAIT_L(0); PG8_MMA(0, 0, At, B0); PG8_BAR; PG8_SCHED;
            PG8_LDB(B1, 1, 1); PG8_STAGE(PG8_SB(1, 0), b3, voffB);
            PG8_BAR; PG8_WAIT_L(0); PG8_MMA(0, 1, At, B1); PG8_BAR;
            PG8_LDA(At, 1, 1); PG8_STAGE(PG8_SA(1, 0), a3, voffA);
            PG8_BAR; PG8_WAIT_L(0); PG8_MMA(1, 0, At, B0); PG8_BAR; PG8_SCHED;
            PG8_STAGE(PG8_SB(1, 1), b3 + hstep, voffB);
            PG8_WAIT_V(6); PG8_BAR; PG8_MMA(1, 1, At, B1); PG8_BAR;
            }
        }
        if constexpr (ALIGN_EPI) { if (wr == 0) PG8_BAR; }
        if constexpr (!Epi::AFTER_DRAIN) { E(acc, cur, wr, wc, fr, fq); S.done(cur); }
        if (!has_next) break;
#pragma unroll
        for (int a = 0; a < 2; ++a)
#pragma unroll
            for (int b = 0; b < 2; ++b)
#pragma unroll
                for (int m = 0; m < 4; ++m)
#pragma unroll
                    for (int n = 0; n < 2; ++n) acc[a][b][m][n] = (f32x4){0.f, 0.f, 0.f, 0.f};
        cur = nxt; cA = nA; cB = nB; ++ui;
        if constexpr (ALIGN_EPI) { if (wr == 1) PG8_BAR; }
    }
    PG8_WAIT_V(0);
    if constexpr (!ALIGN_EPI) { if (wr == 0) PG8_BAR; }
    PG8_BAR;
    if constexpr (Epi::AFTER_DRAIN) { E.fused(acc, cur, wr, wc, fr, fq, lds, wid, lane); S.done(cur); }
#undef PG8_SA
#undef PG8_SB
#undef PG8_STAGE
#undef PG8_LDA
#undef PG8_LDB
#undef PG8_MMA
#undef PG8_WAIT_V
#undef PG8_WAIT_L
#undef PG8_BAR
#undef PG8_SCHED
}
}
namespace att {
typedef unsigned short bf16_t;
using bf16x8 = __attribute__((ext_vector_type(8))) short;
using s16x4 = __attribute__((ext_vector_type(4))) short;
using f32x16 = __attribute__((ext_vector_type(16))) float;
using f32x4 = __attribute__((ext_vector_type(4))) float;
using u32x4 = __attribute__((ext_vector_type(4))) unsigned;
typedef short v4i16_t __attribute__((ext_vector_type(4)));
#define ATT_LAS __attribute__((address_space(3)))
typedef ATT_LAS const char* lds_cptr;
constexpr int NW = 8, KVBLK = 64;
constexpr int KSLOT = 12288, VSLOT = 8192, NSLOT = 4;
constexpr int LDS_K = 0, LDS_V = NSLOT * KSLOT, LDS_WS = LDS_V + NSLOT * VSLOT, LDS_OST = LDS_WS + NW * 64 * 4, LDS_POSK = LDS_OST + NW * 4096, LDS_BYTES = LDS_POSK + 1024;
__device__ __forceinline__ int crow(int r, int hi) { return (r & 3) + 8 * (r >> 2) + 4 * hi; }
__device__ __forceinline__ void glds16(const void* gsrc, unsigned lds_dst) {
    asm volatile("s_mov_b32 m0, %1\n\ts_nop 0\n\tglobal_load_lds_dwordx4 %0, off" : : "v"(gsrc), "s"(lds_dst) : "memory", "m0"); }
typedef float f32x2_t __attribute__((ext_vector_type(2))); typedef __bf16 bf16x2_t __attribute__((ext_vector_type(2)));
__device__ __forceinline__ unsigned cvtpk(float lo, float hi) { f32x2_t v = {lo, hi}; bf16x2_t b = __builtin_convertvector(v, bf16x2_t); return __builtin_bit_cast(unsigned, b); }
__device__ __forceinline__ float att_bf16_up(float x) { unsigned u = __float_as_uint(x); if (u & 0xFFFFu) { u &= 0xFFFF0000u; if (x > 0.f) u += 0x10000u; } return __uint_as_float(u); }
__device__ __forceinline__ s16x4 vtr(lds_cptr p) { return __builtin_bit_cast(s16x4, __builtin_amdgcn_ds_read_tr16_b64_v4i16((ATT_LAS v4i16_t*)p)); }
#define ATT_KS(j) (((j) & (NSLOT - 1)) * KSLOT)
#define ATT_VS(j) (((j) & (NSLOT - 1)) * VSLOT)
#define ATT_WAIT_BAR() asm volatile("s_waitcnt vmcnt(0) lgkmcnt(0)\n\ts_barrier" ::: "memory")
#define ATT_WAIT_BAR_N(three) do { if (three) asm volatile("s_waitcnt vmcnt(3) lgkmcnt(0)\n\ts_barrier" ::: "memory"); else asm volatile("s_waitcnt vmcnt(2) lgkmcnt(0)\n\ts_barrier" ::: "memory"); } while (0)

struct Unit {
    const bf16_t* Q; int q_pitch;
    const bf16_t* K; int k_pitch;
    const bf16_t* Kr;
    const bf16_t* V; int v_pitch;
    int key0, ntiles;
    int q0;
    const unsigned short* list; int len;
    const float* posf;
    float slope2;
    bf16_t* O; int o_pitch;
    bf16_t* part; float* plse; int h;
};

template <int MODE> __device__ __forceinline__ void unit(const Unit& U, char* shm, const int wid) {
    constexpr int DQK = (MODE == 0) ? 96 : 64, ND0 = DQK / 16;
    const int lane = pg8::lane_id_v(), tid = wid * 64 + lane, r32 = lane & 31, hi = lane >> 5;
    const unsigned lds0 = (unsigned)(uintptr_t)shm;
    const lds_cptr shm3 = (lds_cptr)shm;
    ATT_LAS float* wsf = (ATT_LAS float*)(shm3 + LDS_WS) + wid * 64;
    int qrow, slot = 0; bool valid = true;
    if (MODE == 2) { const int e = wid * 32 + r32; valid = e < U.len; const unsigned ent = valid ? (unsigned)U.list[e] : (unsigned)U.list[0]; qrow = (int)(ent & 0x3FFFu); slot = 1 + (int)(ent >> 14); }
    else qrow = U.q0 + wid * 32 + r32;
    const unsigned koff = (unsigned)((U.key0 + 8 * wid + (lane >> 3)) * U.k_pitch + (((lane & 7) ^ ((4 * wid + (lane >> 4)) & 7)) * 8)) * 2u;
    const unsigned kroff = (MODE == 0) ? (unsigned)((U.key0 + 16 * (wid & 3) + (lane >> 2)) * 32 + (((lane & 3) ^ ((lane >> 4) & 3)) * 8)) * 2u : 0u;
    const unsigned voff = (unsigned)((U.key0 + 16 * (wid & 3) + (lane >> 2)) * U.v_pitch + (wid >> 2) * 32 + (lane & 3) * 8) * 2u;
#define ATT_DMA(t, ks, vs) do { glds16((const char*)U.K + koff + (size_t)(t) * (KVBLK * 2) * U.k_pitch, (unsigned)(lds0 + LDS_K + wid * 1024 + (ks))); \
        if (MODE == 0 && wid < 4) glds16((const char*)U.Kr + kroff + (size_t)(t) * (KVBLK * 64), (unsigned)(lds0 + LDS_K + (8 + (wid & 3)) * 1024 + (ks))); \
        glds16((const char*)U.V + voff + (size_t)(t) * (KVBLK * 2) * U.v_pitch, (unsigned)(lds0 + LDS_V + wid * 1024 + (vs))); } while (0)
    const int NT = U.ntiles;
    ATT_DMA(0, 0, 0);
    if (NT > 1) ATT_DMA(1, KSLOT, VSLOT);
    bf16x8 qr[ND0];
    { const bf16_t* Qw = U.Q + (size_t)qrow * U.q_pitch + hi * 8;
#pragma unroll
      for (int d0 = 0; d0 < ND0; ++d0) qr[d0] = *reinterpret_cast<const bf16x8*>(Qw + d0 * 16); }
    float pq = 0.f;
    if (MODE != 0) { pq = U.posf[qrow]; if (tid < 256) ((ATT_LAS float*)(shm3 + LDS_POSK))[tid] = U.posf[U.key0 + tid]; }
    float mhat = -1e30f, l_reg = 0.f; f32x16 o[2]; o[0] = f32x16{}; o[1] = f32x16{};
    const int km_ = (r32 >> 1) & 7, kmr_ = (r32 >> 2) & 3;
    const int ka0 = LDS_K + r32 * 128 + 32 * (km_ >> 1) + 16 * (hi ^ (km_ & 1));
    const int kb0 = LDS_K + 8192 + r32 * 64 + 32 * (kmr_ >> 1) + 16 * (hi ^ (kmr_ & 1));
#define ATT_KADDR(d0, half, KS) (shm3 + (KS) + (((d0) < 4) ? ((ka0 ^ ((d0) << 5)) + (half) * 4096) : ((kb0 ^ (((d0) - 4) << 5)) + (half) * 2048)))
    const lds_cptr vp0 = shm3 + LDS_V + ((lane >> 4) & 1) * 32 + (lane & 3) * 8 + (4 * hi + ((lane & 15) >> 2)) * 64;
#define ATT_QKT(P0, P1, KS) do { P0 = f32x16{}; P1 = f32x16{}; bf16x8 kk_[2 * ND0]; \
        _Pragma("unroll") for (int d0 = 0; d0 < ND0; ++d0) { kk_[2 * d0] = *(const ATT_LAS bf16x8*)ATT_KADDR(d0, 0, KS); kk_[2 * d0 + 1] = *(const ATT_LAS bf16x8*)ATT_KADDR(d0, 1, KS); }     \
        __builtin_amdgcn_sched_barrier(0); \
        _Pragma("unroll") for (int d0 = 0; d0 < ND0; ++d0) { \
            P0 = __builtin_amdgcn_mfma_f32_32x32x16_bf16(kk_[2 * d0], qr[d0], P0, 0, 0, 0); P1 = __builtin_amdgcn_mfma_f32_32x32x16_bf16(kk_[2 * d0 + 1], qr[d0], P1, 0, 0, 0); } } while (0)
#define ATT_SMPV(P0, P1, T, VS) do { \
        if (MODE != 0) { const ATT_LAS float* pk_ = (const ATT_LAS float*)(shm3 + LDS_POSK) + 64 * (T) + 4 * hi; \
            _Pragma("unroll") for (int g = 0; g < 4; ++g) { const f32x4 a_ = *(const ATT_LAS f32x4*)(pk_ + 8 * g), b_ = *(const ATT_LAS f32x4*)(pk_ + 8 * g + 32); \
                _Pragma("unroll") for (int j = 0; j < 4; ++j) { P0[4 * g + j] -= U.slope2 * __builtin_fabsf(pq - a_[j]); P1[4 * g + j] -= U.slope2 * __builtin_fabsf(pq - b_[j]); } } } \
        if (MODE == 0 || MODE == 1) { const int kb_ = U.key0 + 64 * (T); \
            if (kb_ + 63 > U.q0 + wid * 32) { const int dq_ = qrow - kb_ - 4 * hi; \
                _Pragma("unroll") for (int r = 0; r < 16; ++r) { const int c_ = (r & 3) + 8 * (r >> 2); if (c_ > dq_) P0[r] = -INFINITY; if (c_ + 32 > dq_) P1[r] = -INFINITY; } } } \
        float rm_ = P0[0]; \
        _Pragma("unroll") for (int r = 1; r < 16; ++r) rm_ = fmaxf(rm_, P0[r]); \
        _Pragma("unroll") for (int r = 0; r < 16; ++r) rm_ = fmaxf(rm_, P1[r]); \
        { auto rr_ = __builtin_amdgcn_permlane32_swap(__float_as_uint(rm_), __float_as_uint(rm_), false, false); rm_ = fmaxf(__uint_as_float(rr_[0]), __uint_as_float(rr_[1])); } \
        if (__any(rm_ > mhat + 10.0f)) { const float mn_ = fmaxf(mhat, rm_), f_ = __builtin_amdgcn_exp2f(mhat - mn_); mhat = mn_; l_reg *= f_; \
            _Pragma("unroll") for (int r = 0; r < 16; ++r) { o[0][r] *= f_; o[1][r] *= f_; } }                        \
        float sacc_ = 0.f; \
        _Pragma("unroll") for (int r = 0; r < 16; ++r) { P0[r] = __builtin_amdgcn_exp2f(P0[r] - mhat); P1[r] = __builtin_amdgcn_exp2f(P1[r] - mhat); sacc_ += P0[r] + P1[r]; } \
        l_reg += sacc_; \
        u32x4 pw_[4]; \
        _Pragma("unroll") for (int s_ = 0; s_ < 2; ++s_) { \
            pw_[s_] = (u32x4){cvtpk(P0[8 * s_], P0[8 * s_ + 1]), cvtpk(P0[8 * s_ + 2], P0[8 * s_ + 3]), cvtpk(P0[8 * s_ + 4], P0[8 * s_ + 5]), cvtpk(P0[8 * s_ + 6], P0[8 * s_ + 7])}; \
            pw_[2 + s_] = (u32x4){cvtpk(P1[8 * s_], P1[8 * s_ + 1]), cvtpk(P1[8 * s_ + 2], P1[8 * s_ + 3]), cvtpk(P1[8 * s_ + 4], P1[8 * s_ + 5]), cvtpk(P1[8 * s_ + 6], P1[8 * s_ + 7])}; } \
        const lds_cptr vp_ = vp0 + (VS); s16x4 vl_[8], vh_[8]; \
        _Pragma("unroll") for (int i_ = 0; i_ < 8; ++i_) { vl_[i_] = vtr(vp_ + (i_ >> 2) * 4096 + (i_ & 3) * 1024); vh_[i_] = vtr(vp_ + (i_ >> 2) * 4096 + (i_ & 3) * 1024 + 512); }     \
        __builtin_amdgcn_sched_barrier(0); \
        _Pragma("unroll") for (int i_ = 0; i_ < 8; ++i_) { \
            const bf16x8 vf_ = (bf16x8){vl_[i_][0], vl_[i_][1], vl_[i_][2], vl_[i_][3], vh_[i_][0], vh_[i_][1], vh_[i_][2], vh_[i_][3]}; \
            o[i_ >> 2] = __builtin_amdgcn_mfma_f32_32x32x16_bf16(vf_, __builtin_bit_cast(bf16x8, pw_[i_ & 3]), o[i_ >> 2], 0, 0, 0); } } while (0)
#define ATT_ACT(T) (MODE != 1 || (64 * (T) <= wid * 32 + 31))
#define ATT_ITER(SC0, SC1, SN0, SN1, T) do { const bool has_next_ = (T) + 1 < NT; \
        if (has_next_ && ATT_ACT((T) + 1)) ATT_QKT(SN0, SN1, ATT_KS((T) + 1)); \
        if (ATT_ACT(T)) ATT_SMPV(SC0, SC1, T, ATT_VS(T)); \
        if (has_next_ && (MODE == 0 || NT > NSLOT)) { if ((T) + 3 < NT) ATT_WAIT_BAR_N(dma3); else ATT_WAIT_BAR(); if ((T) + 4 < NT) ATT_DMA((T) + 4, ATT_KS(T), ATT_VS(T)); }   \
        } while (0)
    const bool dma3 = (MODE == 0) && wid < 4;
    if (NT > 2) ATT_DMA(2, 2 * KSLOT, 2 * VSLOT);
    if (NT > 3) ATT_DMA(3, 3 * KSLOT, 3 * VSLOT);
    if (MODE == 0 && NT > 3) ATT_WAIT_BAR_N(dma3); else ATT_WAIT_BAR();
    f32x16 pA0, pA1, pB0, pB1;
    ATT_QKT(pA0, pA1, 0);
    int t = 0;
    if (MODE == 0 && NT > 4) {
#define ATT_SB() __builtin_amdgcn_sched_barrier(0)
#define ATT_KLD(i, KS) kf[i] = *(const ATT_LAS bf16x8*)ATT_KADDR((i) >> 1, (i) & 1, KS)
#define ATT_VLD(i, VS) do { vlo[i] = vtr(vp0 + (VS) + ((i) >> 2) * 4096 + ((i) & 3) * 1024); vhi[i] = vtr(vp0 + (VS) + ((i) >> 2) * 4096 + ((i) & 3) * 1024 + 512); } while (0)
#define ATT_SCR(SC0, SC1, j) ((j) < 16 ? SC0[(j) & 15] : SC1[(j) & 15])
#define ATT_EXP4(SC0, SC1, g) do { if ((g) < 4) { _Pragma("unroll") for (int j_ = 0; j_ < 4; ++j_) SC0[4 * (g) + j_] = __builtin_amdgcn_exp2f(SC0[4 * (g) + j_]); } \
                                   else { _Pragma("unroll") for (int j_ = 0; j_ < 4; ++j_) SC1[4 * ((g) - 4) + j_] = __builtin_amdgcn_exp2f(SC1[4 * ((g) - 4) + j_]); } } while (0)
#define ATT_ADD4(SC0, SC1, g) do { if ((g) < 4) sacc_ += (SC0[4 * (g)] + SC0[4 * (g) + 1]) + (SC0[4 * (g) + 2] + SC0[4 * (g) + 3]); else sacc_ += (SC1[4 * ((g) - 4)] + SC1[4 * ((g) - 4) + 1]) + (SC1[4 * ((g) - 4) + 2] + SC1[4 * ((g) - 4) + 3]); } while (0)
#define ATT_CVT4(SC0, SC1, g) do { if ((g) < 4) { pw[(g) >> 1][2 * ((g) & 1)] = cvtpk(SC0[4 * (g)], SC0[4 * (g) + 1]); pw[(g) >> 1][2 * ((g) & 1) + 1] = cvtpk(SC0[4 * (g) + 2], SC0[4 * (g) + 3]); } \
                                   else { pw[(g) >> 1][2 * ((g) & 1)] = cvtpk(SC1[4 * ((g) - 4)], SC1[4 * ((g) - 4) + 1]); pw[(g) >> 1][2 * ((g) & 1) + 1] = cvtpk(SC1[4 * ((g) - 4) + 2], SC1[4 * ((g) - 4) + 3]); } } while (0)
#define ATT_GAPA(i, SC0, SC1, SN0, SN1) do { \
        if (((i) & 1) == 0) SN0 = __builtin_amdgcn_mfma_f32_32x32x16_bf16(kf[i], qr[(i) >> 1], SN0, 0, 0, 0); else SN1 = __builtin_amdgcn_mfma_f32_32x32x16_bf16(kf[i], qr[(i) >> 1], SN1, 0, 0, 0); \
        if ((i) < 8) { ATT_VLD(ATT_PJ(i), vs_); ATT_EXP4(SC0, SC1, i); } \
        if ((i) >= 1 && (i) <= 8) ATT_ADD4(SC0, SC1, (i) - 1); \
        if ((i) >= 2 && (i) <= 9) ATT_CVT4(SC0, SC1, (i) - 2); \
        ATT_SB(); } while (0)
#define ATT_PJ(j) ((((j) & 1) << 2) | ((j) >> 1))
#define ATT_VF(j) (bf16x8){vlo[j][0], vlo[j][1], vlo[j][2], vlo[j][3], vhi[j][0], vhi[j][1], vhi[j][2], vhi[j][3]}
#define ATT_GAPB(j, SN0, SN1) do { \
        o[ATT_PJ(j) >> 2] = __builtin_amdgcn_mfma_f32_32x32x16_bf16(ATT_VF(ATT_PJ(j)), __builtin_bit_cast(bf16x8, pw[ATT_PJ(j) & 3]), o[ATT_PJ(j) >> 2], 0, 0, 0);     \
        if ((j) < 6) { ATT_KLD(2 * (j), ks2_); ATT_KLD(2 * (j) + 1, ks2_); } \
        ATT_SB(); } while (0)
#define ATT_FAST(SC0, SC1, SN0, SN1, T) do { const int vs_ = ATT_VS(T), ks2_ = ATT_KS((T) + 2); \
        ATT_SB(); \
        float sacc_ = 0.f; \
        SN0 = __builtin_amdgcn_mfma_f32_32x32x16_bf16(kx, qx, f32x16{}, 0, 0, 0); SN1 = __builtin_amdgcn_mfma_f32_32x32x16_bf16(kx, qx, f32x16{}, 0, 0, 0);     \
        ATT_GAPA(0, SC0, SC1, SN0, SN1); ATT_GAPA(1, SC0, SC1, SN0, SN1); ATT_GAPA(2, SC0, SC1, SN0, SN1); ATT_GAPA(3, SC0, SC1, SN0, SN1); \
        ATT_GAPA(4, SC0, SC1, SN0, SN1); ATT_GAPA(5, SC0, SC1, SN0, SN1); ATT_GAPA(6, SC0, SC1, SN0, SN1); ATT_GAPA(7, SC0, SC1, SN0, SN1); \
        ATT_GAPA(8, SC0, SC1, SN0, SN1); ATT_GAPA(9, SC0, SC1, SN0, SN1); ATT_GAPA(10, SC0, SC1, SN0, SN1); ATT_GAPA(11, SC0, SC1, SN0, SN1); \
        l_reg += sacc_; \
        ATT_GAPB(0, SN0, SN1); ATT_GAPB(1, SN0, SN1); ATT_GAPB(2, SN0, SN1); ATT_GAPB(3, SN0, SN1); ATT_GAPB(4, SN0, SN1); ATT_GAPB(5, SN0, SN1); ATT_GAPB(6, SN0, SN1); ATT_GAPB(7, SN0, SN1); \
        ATT_SB(); \
        ATT_WAIT_BAR(); ATT_DMA((T) + 4, ATT_KS(T), vs_); \
        { const unsigned long long bal_ = __builtin_amdgcn_ballot_w64(sacc_ > 1048576.0f); float f_ = 1.f;     \
          if (bal_ != 0ull) { float s2_ = sacc_; { auto rr_ = __builtin_amdgcn_permlane32_swap(__float_as_uint(s2_), __float_as_uint(s2_), false, false); s2_ = fmaxf(__uint_as_float(rr_[0]), __uint_as_float(rr_[1])); }     \
            const float e_ = (s2_ > 1048576.0f) ? (float)((int)((__float_as_uint(s2_) >> 23) & 0xFFu) - 127) : 0.f; \
            const float mn_ = att_bf16_up(mhat + e_), dl_ = mn_ - mhat; f_ = __builtin_amdgcn_exp2f(-dl_); mhat = mn_; l_reg *= f_; \
            _Pragma("unroll") for (int r = 0; r < 16; ++r) { SN0[r] -= dl_; SN1[r] -= dl_; } \
            qx[0] = (hi == 0) ? (short)(__float_as_uint(-mhat) >> 16) : (short)0; } \
            \
          asm volatile("s_cmp_eq_u64 %[b], 0\n\ts_cbranch_scc1 .Lsk%=\n\ts_nop 1\n\tv_mul_f32_e32 %0, %[f], %0\n\tv_mul_f32_e32 %1, %[f], %1\n\tv_mul_f32_e32 %2, %[f], %2\n\tv_mul_f32_e32 %3, %[f], %3\n\tv_mul_f32_e32 %4, %[f], %4\n\tv_mul_f32_e32 %5, %[f], %5\n\tv_mul_f32_e32 %6, %[f], %6\n\tv_mul_f32_e32 %7, %[f], %7\n\tv_mul_f32_e32 %8, %[f], %8\n\tv_mul_f32_e32 %9, %[f], %9\n\tv_mul_f32_e32 %10, %[f], %10\n\tv_mul_f32_e32 %11, %[f], %11\n\tv_mul_f32_e32 %12, %[f], %12\n.Lsk%=:" : "+v"(o[0][0]), "+v"(o[0][1]), "+v"(o[0][2]), "+v"(o[0][3]), "+v"(o[0][4]), "+v"(o[0][5]), "+v"(o[0][6]), "+v"(o[0][7]), "+v"(o[0][8]), "+v"(o[0][9]), "+v"(o[0][10]), "+v"(o[0][11]), "+v"(o[0][12]) : [f] "v"(f_), [b] "s"(bal_) : "scc"); \
          asm volatile("s_cmp_eq_u64 %[b], 0\n\ts_cbranch_scc1 .Lsk%=\n\tv_mul_f32_e32 %0, %[f], %0\n\tv_mul_f32_e32 %1, %[f], %1\n\tv_mul_f32_e32 %2, %[f], %2\n\tv_mul_f32_e32 %3, %[f], %3\n\tv_mul_f32_e32 %4, %[f], %4\n\tv_mul_f32_e32 %5, %[f], %5\n\tv_mul_f32_e32 %6, %[f], %6\n\tv_mul_f32_e32 %7, %[f], %7\n\tv_mul_f32_e32 %8, %[f], %8\n\tv_mul_f32_e32 %9, %[f], %9\n\tv_mul_f32_e32 %10, %[f], %10\n\tv_mul_f32_e32 %11, %[f], %11\n\tv_mul_f32_e32 %12, %[f], %12\n.Lsk%=:" : "+v"(o[0][13]), "+v"(o[0][14]), "+v"(o[0][15]), "+v"(o[1][0]), "+v"(o[1][1]), "+v"(o[1][2]), "+v"(o[1][3]), "+v"(o[1][4]), "+v"(o[1][5]), "+v"(o[1][6]), "+v"(o[1][7]), "+v"(o[1][8]), "+v"(o[1][9]) : [f] "v"(f_), [b] "s"(bal_) : "scc"); \
          asm volatile("s_cmp_eq_u64 %[b], 0\n\ts_cbranch_scc1 .Lsk%=\n\tv_mul_f32_e32 %0, %[f], %0\n\tv_mul_f32_e32 %1, %[f], %1\n\tv_mul_f32_e32 %2, %[f], %2\n\tv_mul_f32_e32 %3, %[f], %3\n\tv_mul_f32_e32 %4, %[f], %4\n\tv_mul_f32_e32 %5, %[f], %5\n.Lsk%=:" : "+v"(o[1][10]), "+v"(o[1][11]), "+v"(o[1][12]), "+v"(o[1][13]), "+v"(o[1][14]), "+v"(o[1][15]) : [f] "v"(f_), [b] "s"(bal_) : "scc"); } \
        } while (0)
        bf16x8 kf[12]; s16x4 vlo[8], vhi[8]; u32x4 pw[4];
        float rm = pA0[0];
#pragma unroll
        for (int r = 1; r < 16; ++r) rm = fmaxf(rm, pA0[r]);
#pragma unroll
        for (int r = 0; r < 16; ++r) rm = fmaxf(rm, pA1[r]);
        { auto rr_ = __builtin_amdgcn_permlane32_swap(__float_as_uint(rm), __float_as_uint(rm), false, false); rm = fmaxf(__uint_as_float(rr_[0]), __uint_as_float(rr_[1])); }
        mhat = att_bf16_up(rm);
#pragma unroll
        for (int r = 0; r < 16; ++r) { pA0[r] -= mhat; pA1[r] -= mhat; }
        const bf16x8 kx = (bf16x8){(short)0x3F80, 0, 0, 0, 0, 0, 0, 0};
        bf16x8 qx = (bf16x8){0, 0, 0, 0, 0, 0, 0, 0};
        if (hi == 0) qx[0] = (short)(__float_as_uint(-mhat) >> 16);
#pragma unroll
        for (int i = 0; i < 12; ++i) ATT_KLD(i, KSLOT);
        if (wid >= 4) __builtin_amdgcn_s_setprio(1);
        for (; t + 4 < NT; t += 2) { ATT_FAST(pA0, pA1, pB0, pB1, t); ATT_FAST(pB0, pB1, pA0, pA1, t + 1); }
        if (wid >= 4) __builtin_amdgcn_s_setprio(0);
#pragma unroll
        for (int r = 0; r < 16; ++r) { pA0[r] += mhat; pA1[r] += mhat; }
#undef ATT_FAST
#undef ATT_GAPA
#undef ATT_GAPB
#undef ATT_VF
#undef ATT_PJ
#undef ATT_EXP4
#undef ATT_ADD4
#undef ATT_CVT4
#undef ATT_SCR
#undef ATT_KLD
#undef ATT_VLD
#undef ATT_SB
    }
    for (; t < NT; t += 2) {
        ATT_ITER(pA0, pA1, pB0, pB1, t);
        if (t + 1 < NT) ATT_ITER(pB0, pB1, pA0, pA1, t + 1);
    }
#undef ATT_QKT
#undef ATT_SMPV
#undef ATT_ACT
#undef ATT_ITER
    { auto rr = __builtin_amdgcn_permlane32_swap(__float_as_uint(l_reg), __float_as_uint(l_reg), false, false); l_reg = __uint_as_float(rr[0]) + __uint_as_float(rr[1]); }
    { const float rl = __builtin_amdgcn_rcpf(l_reg);
      bf16_t* prow = U.O + (size_t)(U.q0 + wid * 32 + r32) * U.o_pitch + 8 * hi;
#pragma unroll
      for (int dh = 0; dh < 2; ++dh)
#pragma unroll
        for (int jp = 0; jp < 2; ++jp) {
            unsigned a0 = cvtpk(o[dh][8 * jp] * rl, o[dh][8 * jp + 1] * rl), a1 = cvtpk(o[dh][8 * jp + 2] * rl, o[dh][8 * jp + 3] * rl);
            unsigned b0 = cvtpk(o[dh][8 * jp + 4] * rl, o[dh][8 * jp + 5] * rl), b1 = cvtpk(o[dh][8 * jp + 6] * rl, o[dh][8 * jp + 7] * rl);
            const auto s0 = __builtin_amdgcn_permlane32_swap(a0, b0, false, false); const auto s1 = __builtin_amdgcn_permlane32_swap(a1, b1, false, false);
            *(u32x4*)(prow + 32 * dh + 16 * jp) = (u32x4){s0[0], s1[0], s0[1], s1[1]}; } }
    asm volatile("s_waitcnt vmcnt(0) lgkmcnt(0)\n\ts_barrier" ::: "memory");
#undef ATT_DMA
}
}

namespace att {
constexpr int MB_REG = 65536, MB_TILE = 16384, MB_V = 8192, MB_POSK = 131072, MB_PRE = MB_POSK + 3072, MB_UT = MB_PRE + 2048, MB_NUT = 62, MB_TM = MB_UT + 1024, MB_KB = 140288, MB_ENT = MB_KB + 8192, MB_END = MB_ENT + 2048;
struct MobaCtx { const bf16_t* mqkv; const float* posf; bf16_t* part; float* plse; const unsigned* lists; const unsigned* cnt; int total, vcu, G; };
struct MobaDesc { int own, h, n; };
__device__ __forceinline__ unsigned att_bf16_rne(float f) { unsigned u = __float_as_uint(f); return (u + 0x7fffu + ((u >> 16) & 1u)) >> 16; }
__device__ __forceinline__ float att_bf2f(unsigned b) { return __uint_as_float(b << 16); }
__device__ __forceinline__ void att_split3(float c, unsigned& w1, unsigned& w2) { const unsigned c0 = att_bf16_rne(c); const float r1 = c - att_bf2f(c0); const unsigned c1 = att_bf16_rne(r1); const float r2 = r1 - att_bf2f(c1);
    w1 = c0 | (c1 << 16); w2 = att_bf16_rne(r2); }

__device__ __forceinline__ u32x4 moba_get(const MobaCtx& C, ATT_LAS const int* pre, int i) {
    const int ng = (C.vcu < C.total) ? (C.total - C.vcu + C.G - 1) / C.G : 0;
    if (i < ng) { const int gI = C.vcu + i * C.G; int lo = 0, hi = 511;
        while (lo < hi) { const int mid = (lo + hi) >> 1; if (pre[mid] > gI) hi = mid; else lo = mid + 1; }
        const int hn = lo, c = gI - (hn ? pre[hn - 1] : 0); const int len = (int)C.cnt[hn] - c * 256;
        return (u32x4){1u | ((unsigned)(hn >> 6) << 2) | ((unsigned)(hn & 63) << 5), (unsigned)(len < 256 ? len : 256), (unsigned)hn * 16384u + (unsigned)c * 256u, 0u}; }
    const int u = C.vcu + (i - ng) * C.G; if (u >= 512) return (u32x4){0u, 0u, 0u, 0u};
    return (u32x4){1u | 2u | ((unsigned)(u & 7) << 2) | ((unsigned)(u >> 3) << 5), 256u, 0u, 0u};
}
__device__ __forceinline__ void glds4(const void* gsrc, unsigned lds_dst) {
    asm volatile("s_mov_b32 m0, %1\n\ts_nop 0\n\tglobal_load_lds_dword %0, off" : : "v"(gsrc), "s"(lds_dst) : "memory", "m0"); }

template <int PROBE> __device__ __forceinline__ void moba_run(const MobaCtx& C, char* shm, const int wid) {
    const int lane = pg8::lane_id_v(), tid = wid * 64 + lane, r32 = lane & 31, hi = lane >> 5;
    const unsigned lds0 = (unsigned)(uintptr_t)shm; const lds_cptr shm3 = (lds_cptr)shm;
    ATT_LAS const int* pre = (ATT_LAS const int*)(shm3 + MB_PRE);
    const float* pmax = C.posf + 16384;
    const int km_ = (r32 >> 1) & 7;
    const int ka0 = r32 * 128 + 32 * (km_ >> 1) + 16 * (hi ^ (km_ & 1));
    const int vpl = MB_V + ((lane >> 4) & 1) * 32 + (lane & 3) * 8 + (4 * hi + ((lane & 15) >> 2)) * 64;
    const unsigned koff = (unsigned)((8 * wid + (lane >> 3)) * 1536 + (((lane & 7) ^ ((4 * wid + (lane >> 4)) & 7)) * 8)) * 2u;
    const unsigned voff = (unsigned)((16 * (wid & 3) + (lane >> 2)) * 1536 + (wid >> 2) * 32 + (lane & 3) * 8) * 2u;
#define MB_UNPACK(X_, D_) do { (D_).own = (int)(((X_) >> 1) & 1u); (D_).h = (int)(((X_) >> 2) & 7u); (D_).n = (PROBE & 4) ? 0 : (int)((X_) >> 5); } while (0)
#define MB_DMA(D_, R_) do { const char* kb_ = (const char*)(C.mqkv + 512 + (D_).h * 64 + (size_t)(D_).n * 256 * 1536); const char* vb_ = kb_ + 1024; \
        unsigned db_ = (unsigned)(lds0 + (R_) + wid * 1024); asm volatile("" : "+s"(db_));     \
        _Pragma("unroll") for (int t_ = 0; t_ < 4; ++t_) { glds16(kb_ + koff + (size_t)t_ * (64 * 1536 * 2), db_ + t_ * MB_TILE); \
                                                           glds16(vb_ + voff + (size_t)t_ * (64 * 1536 * 2), db_ + t_ * MB_TILE + MB_V); } } while (0)
#define MB_FETCH(I_, E_, X_) do { E_ = ((const ATT_LAS u32x4*)(shm3 + MB_UT))[(I_)]; X_ = (unsigned)__builtin_amdgcn_readfirstlane((int)E_[0]); } while (0)
#define MB_SMALL(U_, E_, D_) do { \
        if (!(D_).own) { const int e = wid * 32 + r32; if (hi == 0 && e < (int)E_[1]) glds4(C.lists + E_[2] + e, (unsigned)(lds0 + MB_ENT + ((U_) & 1) * 1024 + wid * 128)); } \
        if (wid < 4) glds4(C.posf + (D_).n * 256 + tid, (unsigned)(lds0 + MB_POSK + ((U_) % 3) * 1024 + wid * 256)); \
        if (tid < 4) glds4(pmax + 4 * (D_).n + tid, (unsigned)(lds0 + MB_TM + ((U_) % 3) * 16)); } while (0)
#define MB_STAGE(U_, D_) do { if (tid < 256) { const ATT_LAS float* pp_ = (const ATT_LAS float*)(shm3 + MB_POSK + ((U_) % 3) * 1024); \
            const float v_ = exp2f(-(float)((D_).h + 1)) * 1.4426950408889634f * (pp_[tid] - pp_[0]); const unsigned vh_ = att_bf16_rne(v_), vl_ = att_bf16_rne(v_ - att_bf2f(vh_)); \
            ((ATT_LAS u32x4*)(shm3 + MB_KB + ((U_) & 1) * 4096))[tid] = (u32x4){vh_ | (vl_ << 16), 0x3F803F80u, 0x00003F80u, 0u}; } } while (0)
#define MB_QROW(U_, E_, D_, META_, QR_, PQ_) do { const int e_ = wid * 32 + r32; \
        if ((D_).own) META_ = (((D_).n * 256 + e_) << 2); \
        else { const unsigned en_ = ((const ATT_LAS unsigned*)(shm3 + MB_ENT + ((U_) & 1) * 1024))[e_]; META_ = (e_ < (int)E_[1]) ? (int)(((en_ & 0x3FFFu) << 2) | (1u + ((en_ >> 14) & 3u))) : -1; } \
        const int qr_ = (PROBE & 4) ? (16128 + e_) : ((META_) >= 0 ? ((META_) >> 2) : 0); const bf16_t* Qw_ = C.mqkv + (D_).h * 64 + (size_t)qr_ * 1536 + hi * 8; \
        _Pragma("unroll") for (int d0 = 0; d0 < 4; ++d0) QR_[d0] = *reinterpret_cast<const bf16x8*>(Qw_ + d0 * 16); PQ_ = C.posf[qr_]; } while (0)
#define MB_CHEAP(U_, D_, META_, PQ_, CM_) do { const f32x4 tm_ = *(const ATT_LAS f32x4*)(shm3 + MB_TM + ((U_) % 3) * 16); CM_ = 0; \
        _Pragma("unroll") for (int t_ = 0; t_ < 4; ++t_) { bool ok_ = __all((META_) < 0 || (PQ_) >= tm_[t_]); if ((D_).own) ok_ = ok_ && (64 * t_ + 63 <= wid * 32); if (ok_) CM_ |= 1 << t_; } } while (0)
  for (int base = 0; ; base += MB_NUT) {
    __syncthreads();
    if (tid < MB_NUT) ((ATT_LAS u32x4*)(shm3 + MB_UT))[tid] = moba_get(C, pre, base + tid);
    if (tid == MB_NUT || tid == MB_NUT + 1) ((ATT_LAS u32x4*)(shm3 + MB_UT))[tid] = (u32x4){0u, 0u, 0u, 0u};
    __syncthreads();
    u32x4 ent_; unsigned xc, xn, xnn = 0u; MobaDesc D, Dn;
    MB_FETCH(0, ent_, xc);
    if (!(xc & 1u)) break;
    MB_UNPACK(xc, D);
    MB_DMA(D, 0); MB_SMALL(0, ent_, D);
    { u32x4 e1_; MB_FETCH(1, e1_, xn); MB_UNPACK(xn, Dn); if (xn & 1u) MB_SMALL(1, e1_, Dn); }
    asm volatile("" ::: "memory"); __builtin_amdgcn_s_waitcnt(0); __builtin_amdgcn_s_barrier(); asm volatile("" ::: "memory");
    int meta = -1, cm = 0; float pq = 0.f, pbase = 0.f; bf16x8 qr[4];
    MB_STAGE(0, D); MB_QROW(0, ent_, D, meta, qr, pq);
    pbase = ((const ATT_LAS float*)(shm3 + MB_POSK))[0];
    asm volatile("" ::: "memory"); __builtin_amdgcn_s_waitcnt(0); __builtin_amdgcn_s_barrier(); asm volatile("" ::: "memory");
    MB_CHEAP(0, D, meta, pq, cm);
    if (xn & 1u) MB_DMA(Dn, MB_REG);
    int i = 0;
    for (; xc & 1u; ++i) {
        int meta_n = -1; float pq_n = 0.f;
        MB_UNPACK(xn, Dn);
        const int cur = i & 1, rb = cur * MB_REG; const float slope2 = exp2f(-(float)(D.h + 1)) * 1.4426950408889634f;
        const bool valid = meta >= 0; const int qrow = valid ? (meta >> 2) : 0, slot = meta & 3;
        const ATT_LAS float* posk = (const ATT_LAS float*)(shm3 + MB_POSK + (i % 3) * 1024);
        const lds_cptr kbx = shm3 + MB_KB + cur * 4096 + r32 * 16;
        float mhat = 0.f, l_reg = 0.f; bool first_ = true; f32x16 o[2]; o[0] = f32x16{}; o[1] = f32x16{};
        unsigned qxa0 = 0u, qxa1 = 0u, qxa2 = 0u, qxr1 = 0u, qxr2 = 0u;
#define MB_QX() do { unsigned a1_, a2_, r1_, r2_; att_split3(-slope2 * (pq - pbase) - mhat, a1_, a2_); att_split3(-mhat, r1_, r2_); \
            qxa0 = hi == 0 ? 0x3F803F80u : 0u; qxa1 = hi == 0 ? a1_ : 0u; qxa2 = hi == 0 ? a2_ : 0u; qxr1 = hi == 0 ? r1_ : 0u; qxr2 = hi == 0 ? r2_ : 0u; } while (0)
        MB_QX();
        f32x16 pA0, pA1, pB0, pB1; float mA = 0.f, mB = 0.f;
#define MB_ACT(T) (!D.own || (64 * (T) <= wid * 32 + 31))
#define MB_CH(T) ((cm >> (T)) & 1)
#define MB_QKT(P0, P1, MR, T) do { bf16x8 kk_[8]; const lds_cptr kb_ = shm3 + rb + (T) * MB_TILE; \
            const bf16x8 kx0_ = *(const ATT_LAS bf16x8*)(kbx + (T) * 1024), kx1_ = *(const ATT_LAS bf16x8*)(kbx + (T) * 1024 + 512); \
            _Pragma("unroll") for (int d0 = 0; d0 < 4; ++d0) { kk_[2 * d0] = *(const ATT_LAS bf16x8*)(kb_ + (ka0 ^ (d0 << 5))); kk_[2 * d0 + 1] = *(const ATT_LAS bf16x8*)(kb_ + (ka0 ^ (d0 << 5)) + 4096); } \
            const bool ch_ = MB_CH(T); const u32x4 qs_ = (u32x4){ch_ ? qxa0 : 0u, ch_ ? qxa1 : qxr1, ch_ ? qxa2 : qxr2, 0u}; \
            __builtin_amdgcn_sched_barrier(0); \
            P0 = __builtin_amdgcn_mfma_f32_32x32x16_bf16(kx0_, __builtin_bit_cast(bf16x8, qs_), f32x16{}, 0, 0, 0); P1 = __builtin_amdgcn_mfma_f32_32x32x16_bf16(kx1_, __builtin_bit_cast(bf16x8, qs_), f32x16{}, 0, 0, 0); \
            _Pragma("unroll") for (int d0 = 0; d0 < 4; ++d0) { P0 = __builtin_amdgcn_mfma_f32_32x32x16_bf16(kk_[2 * d0], qr[d0], P0, 0, 0, 0); P1 = __builtin_amdgcn_mfma_f32_32x32x16_bf16(kk_[2 * d0 + 1], qr[d0], P1, 0, 0, 0); } \
            MR = mhat; } while (0)
#define MB_SMPV(P0, P1, MC, T) do { \
            if (__any(MC != mhat)) { const float d_ = mhat - MC; _Pragma("unroll") for (int r = 0; r < 16; ++r) { P0[r] -= d_; P1[r] -= d_; } }     \
            if (!MB_CH(T)) { const ATT_LAS float* pk_ = posk + 64 * (T) + 4 * hi; \
                _Pragma("unroll") for (int g = 0; g < 4; ++g) { const f32x4 a_ = *(const ATT_LAS f32x4*)(pk_ + 8 * g), b_ = *(const ATT_LAS f32x4*)(pk_ + 8 * g + 32); \
                    _Pragma("unroll") for (int j = 0; j < 4; ++j) { P0[4 * g + j] -= slope2 * __builtin_fabsf(pq - a_[j]); P1[4 * g + j] -= slope2 * __builtin_fabsf(pq - b_[j]); } } } \
            if (D.own && 64 * (T) + 63 > wid * 32) { int dq_ = wid * 32 + r32 - 64 * (T) - 4 * hi; asm volatile("" : "+v"(dq_));     \
                _Pragma("unroll") for (int r = 0; r < 16; ++r) { const int c_ = (r & 3) + 8 * (r >> 2); if (c_ > dq_) P0[r] = -INFINITY; if (c_ + 32 > dq_) P1[r] = -INFINITY; } } \
            float rm_ = P0[0]; \
            _Pragma("unroll") for (int r = 1; r < 16; ++r) rm_ = fmaxf(rm_, P0[r]); \
            _Pragma("unroll") for (int r = 0; r < 16; ++r) rm_ = fmaxf(rm_, P1[r]); \
            { auto rr_ = __builtin_amdgcn_permlane32_swap(__float_as_uint(rm_), __float_as_uint(rm_), false, false); rm_ = fmaxf(__uint_as_float(rr_[0]), __uint_as_float(rr_[1])); } \
            if (first_ || __any(rm_ > 10.0f)) { const float dl_ = first_ ? rm_ : fmaxf(rm_, 0.f); mhat += dl_; \
                _Pragma("unroll") for (int r = 0; r < 16; ++r) { P0[r] -= dl_; P1[r] -= dl_; } \
                if (!first_) { const float f_ = __builtin_amdgcn_exp2f(-dl_); l_reg *= f_; \
                    _Pragma("unroll") for (int r = 0; r < 16; ++r) { o[0][r] *= f_; o[1][r] *= f_; } }                        \
                first_ = false; MB_QX(); } \
            _Pragma("unroll") for (int r = 0; r < 16; ++r) { P0[r] = __builtin_amdgcn_exp2f(P0[r]); P1[r] = __builtin_amdgcn_exp2f(P1[r]); } \
            { float sa_ = 0.f;     \
              _Pragma("unroll") for (int r = 0; r < 16; ++r) { sa_ += P0[r]; sa_ += P1[r]; } \
              l_reg += sa_; } \
            u32x4 pw_[4]; \
            _Pragma("unroll") for (int s_ = 0; s_ < 2; ++s_) { \
                pw_[s_] = (u32x4){cvtpk(P0[8 * s_], P0[8 * s_ + 1]), cvtpk(P0[8 * s_ + 2], P0[8 * s_ + 3]), cvtpk(P0[8 * s_ + 4], P0[8 * s_ + 5]), cvtpk(P0[8 * s_ + 6], P0[8 * s_ + 7])}; \
                pw_[2 + s_] = (u32x4){cvtpk(P1[8 * s_], P1[8 * s_ + 1]), cvtpk(P1[8 * s_ + 2], P1[8 * s_ + 3]), cvtpk(P1[8 * s_ + 4], P1[8 * s_ + 5]), cvtpk(P1[8 * s_ + 6], P1[8 * s_ + 7])}; } \
            const lds_cptr vp_ = shm3 + rb + (T) * MB_TILE + vpl; s16x4 vl_[8], vh_[8]; \
            _Pragma("unroll") for (int i_ = 0; i_ < 8; ++i_) { vl_[i_] = vtr(vp_ + (i_ >> 2) * 4096 + (i_ & 3) * 1024); vh_[i_] = vtr(vp_ + (i_ >> 2) * 4096 + (i_ & 3) * 1024 + 512); } \
            __builtin_amdgcn_sched_barrier(0); \
            _Pragma("unroll") for (int i_ = 0; i_ < 8; ++i_) { \
                const bf16x8 vf_ = (bf16x8){vl_[i_][0], vl_[i_][1], vl_[i_][2], vl_[i_][3], vh_[i_][0], vh_[i_][1], vh_[i_][2], vh_[i_][3]}; \
                o[i_ >> 2] = __builtin_amdgcn_mfma_f32_32x32x16_bf16(vf_, __builtin_bit_cast(bf16x8, pw_[i_ & 3]), o[i_ >> 2], 0, 0, 0); } } while (0)
        if (!(PROBE & 1)) {
        if (MB_ACT(3)) MB_QKT(pA0, pA1, mA, 3);
        if (MB_ACT(2)) MB_QKT(pB0, pB1, mB, 2);
        if (MB_ACT(3)) MB_SMPV(pA0, pA1, mA, 3);
        }
        if (xn & 1u) { MB_STAGE(i + 1, Dn);
            MB_FETCH(i + 2, ent_, xnn); if (xnn & 1u) { MobaDesc Dnn; MB_UNPACK(xnn, Dnn); MB_SMALL(i + 2, ent_, Dnn); } } else xnn = 0u;
        if (!(PROBE & 1)) {
        if (!(PROBE & 64)) if (MB_ACT(1)) MB_QKT(pA0, pA1, mA, 1);
        if (MB_ACT(2)) MB_SMPV(pB0, pB1, mB, 2);
        if (!(PROBE & 64)) MB_QKT(pB0, pB1, mB, 0);
        }
        if (xn & 1u) { MB_FETCH(i + 1, ent_, xn); MB_QROW(i + 1, ent_, Dn, meta_n, qr, pq_n); }
        if (!(PROBE & 1)) {
        if (!(PROBE & 64)) if (MB_ACT(1)) MB_SMPV(pA0, pA1, mA, 1);
        if (!(PROBE & 64)) MB_SMPV(pB0, pB1, mB, 0);
        }
#undef MB_QKT
#undef MB_SMPV
#undef MB_ACT
#undef MB_CH
#undef MB_QX
        asm volatile("" ::: "memory"); __builtin_amdgcn_s_waitcnt(0); __builtin_amdgcn_s_barrier(); asm volatile("" ::: "memory");
        const int h_o = D.h; const bool valid_o = valid; const int qrow_o = qrow, slot_o = slot;
        xc = xn; xn = xnn; D = Dn; meta = meta_n; pq = pq_n;
        if (xc & 1u) { pbase = ((const ATT_LAS float*)(shm3 + MB_POSK + ((i + 1) % 3) * 1024))[0]; MB_CHEAP(i + 1, D, meta, pq, cm); }
        if (xn & 1u) { MobaDesc Dt; MB_UNPACK(xn, Dt); MB_DMA(Dt, cur * MB_REG); }
        { auto rr = __builtin_amdgcn_permlane32_swap(__float_as_uint(l_reg), __float_as_uint(l_reg), false, false); l_reg = __uint_as_float(rr[0]) + __uint_as_float(rr[1]); }
        { const float rl = __builtin_amdgcn_rcpf(l_reg);
          bf16_t* prow = C.part + ((((size_t)(qrow_o * 8 + h_o) * 4 + slot_o) * 64) & (PROBE ? ((PROBE & 4) ? (size_t)0x3FFC0 : (size_t)0x7FFFC0) : ~(size_t)0)) + 8 * hi;
#pragma unroll
          for (int dh = 0; dh < 2; ++dh)
#pragma unroll
            for (int jp = 0; jp < 2; ++jp) {
                unsigned a0 = cvtpk(o[dh][8 * jp] * rl, o[dh][8 * jp + 1] * rl), a1 = cvtpk(o[dh][8 * jp + 2] * rl, o[dh][8 * jp + 3] * rl);
                unsigned b0 = cvtpk(o[dh][8 * jp + 4] * rl, o[dh][8 * jp + 5] * rl), b1 = cvtpk(o[dh][8 * jp + 6] * rl, o[dh][8 * jp + 7] * rl);
                const auto s0 = __builtin_amdgcn_permlane32_swap(a0, b0, false, false); const auto s1 = __builtin_amdgcn_permlane32_swap(a1, b1, false, false);
                if (!(PROBE & 2)) if (valid_o) *(u32x4*)(prow + 32 * dh + 16 * jp) = (u32x4){s0[0], s1[0], s0[1], s1[1]}; }
          if (!(PROBE & 2)) if (hi == 0 && valid_o) C.plse[(size_t)(qrow_o * 8 + h_o) * 4 + slot_o] = mhat + __builtin_log2f(l_reg); }
    }
    if (i < MB_NUT) break;
  }
#undef MB_UNPACK
#undef MB_DMA
#undef MB_FETCH
#undef MB_SMALL
#undef MB_STAGE
#undef MB_QROW
#undef MB_CHEAP
}
}

namespace xb {
#define LAS __attribute__((address_space(3)))
#define XB_TMO      128
#define XB_XCNT(j)  (256  + 64 * (j))
#define XB_XSUB(j)  (1280 + 64 * (j))
#define XB_XGEN(j)  (2304 + 64 * (j))
#define XB_TOP      3328
#define XB_TOPGEN   3392
#define XCD_BAR_WORDS 3456
#define XB_SPIN_CAP (1u << 21)

__device__ __forceinline__ unsigned xb_ld(unsigned* p)              { return __hip_atomic_load(p, __ATOMIC_RELAXED, __HIP_MEMORY_SCOPE_AGENT); }
__device__ __forceinline__ unsigned xb_add(unsigned* p, unsigned v) { return __hip_atomic_fetch_add(p, v, __ATOMIC_RELAXED, __HIP_MEMORY_SCOPE_AGENT); }
__device__ __forceinline__ unsigned xb_xcc_id() { return (unsigned)__builtin_amdgcn_s_getreg((3 << 11) | 20) & 0xFu; }
#define XB_SPIN(cond, bar) do { unsigned _sp = 0; while (cond) { __builtin_amdgcn_s_sleep(1); \
    if ((++_sp & 255u) == 0u) { if (xb_ld(&(bar)[XB_TMO])) break; if (_sp > XB_SPIN_CAP) { atomicAdd(&(bar)[XB_TMO], 1u); break; } } } } while (0)

struct XcdBarrier {
    unsigned* bar; unsigned x;
    volatile LAS unsigned* st;
};

__device__ __forceinline__ XcdBarrier xcd_barrier_post(unsigned* bar, volatile LAS unsigned* st, bool leader) {
    XcdBarrier b; b.bar = bar; b.x = xb_xcc_id(); b.st = st;
    if (leader) (void)xb_add(&bar[XB_XCNT(b.x)], 1u);
    return b;
}
__device__ __forceinline__ void xcd_barrier_complete(unsigned* bar, unsigned x, unsigned& nloc, unsigned& nx) {
    const unsigned G = gridDim.x * gridDim.y * gridDim.z;
    unsigned sum, cnt, mine, sp = 0u;
    for (;;) {
        sum = 0u; cnt = 0u; mine = 0u;
#pragma unroll
        for (unsigned j = 0; j < 16; ++j) { const unsigned c = xb_ld(&bar[XB_XCNT(j)]); sum += c; cnt += (c > 0u) ? 1u : 0u; mine = (j == x) ? c : mine; }
        if (sum == G) break;
        __builtin_amdgcn_s_sleep(1);
        if ((++sp & 255u) == 0u) { if (xb_ld(&bar[XB_TMO])) break; if (sp > XB_SPIN_CAP) { atomicAdd(&bar[XB_TMO], 1u); break; } }
    }
    nloc = mine > 0u ? mine : 1u; nx = cnt > 0u ? cnt : 1u;
}

__device__ __forceinline__ void xcd_barrier(const XcdBarrier& b, bool leader) {
    asm volatile("s_waitcnt vmcnt(0)" ::: "memory");
    __syncthreads();
    if (leader) {
        unsigned* bar = b.bar;
        __builtin_amdgcn_s_waitcnt(0);
        unsigned nloc = b.st[0], nx = b.st[1];
        if (nloc == 0u) { xcd_barrier_complete(bar, b.x, nloc, nx); b.st[0] = nloc; b.st[1] = nx; }
        const unsigned old = xb_add(&bar[XB_XSUB(b.x)], 1u);
        const unsigned gen = old / nloc;
        if (old + 1u == (gen + 1u) * nloc) {
            __builtin_amdgcn_fence(__ATOMIC_RELEASE, "agent");
            asm volatile("s_waitcnt vmcnt(0)" ::: "memory");
            const unsigned og = xb_add(&bar[XB_TOP], 1u);
            const unsigned tg = og / nx;
            if (og + 1u == (tg + 1u) * nx) xb_add(&bar[XB_TOPGEN], 1u);
            else XB_SPIN(xb_ld(&bar[XB_TOPGEN]) == tg, bar);
            __builtin_amdgcn_fence(__ATOMIC_ACQUIRE, "agent");
            xb_add(&bar[XB_XGEN(b.x)], 1u);
            asm volatile("s_waitcnt vmcnt(0)" ::: "memory");
        } else {
            XB_SPIN(xb_ld(&bar[XB_XGEN(b.x)]) == gen, bar);
            __builtin_amdgcn_fence(__ATOMIC_ACQUIRE, "agent");
            asm volatile("s_waitcnt vmcnt(0)" ::: "memory");
        }
    }
    __syncthreads();
}

#undef LAS
}
namespace mk {
typedef unsigned short bf16;
typedef unsigned v4u __attribute__((ext_vector_type(4)));
typedef float f32x4 __attribute__((ext_vector_type(4)));
#define MK_LAS __attribute__((address_space(3)))
using namespace mkc;
constexpr int NWAVES = 8;
constexpr int RING_BYTES = 131072, LDS_EXTRA = RING_BYTES, LDS_MISC = RING_BYTES + 8192, LDS_BYTES = 150528;
constexpr size_t WS_BAR = 4096, BAR_BYTES = 32768;

struct Args { const float* in[18]; float* out; unsigned char* ws; int ph_lo, ph_hi; };
struct Frame { MK_LAS unsigned char* lds; int tid, lane, wave, vcu, G; };
typedef const __attribute__((address_space(4))) Args* kargs_t;
__device__ __forceinline__ kargs_t kargs() { kargs_t p = (kargs_t)__builtin_amdgcn_kernarg_segment_ptr(); asm volatile("" : "+s"(p)); return p; }
__device__ __forceinline__ Frame mkframe(MK_LAS unsigned char* lds, int wave) { Frame F; F.lds = lds; F.wave = wave; F.lane = pg8::lane_id_v(); F.tid = wave * 64 + F.lane; F.G = gridDim.x;
    { const int bx = blockIdx.x; F.vcu = (F.G % 8 == 0) ? (bx % 8) * (F.G / 8) + bx / 8 : bx; } return F; }

__device__ __forceinline__ unsigned f2bf(float f) { unsigned u = __builtin_bit_cast(unsigned, f); return (u + 0x7fffu + ((u >> 16) & 1u)) >> 16; }
__device__ __forceinline__ unsigned pk2(float lo, float hi) { return f2bf(lo) | (f2bf(hi) << 16); }
__device__ __forceinline__ float bf2f(unsigned short b) { return __builtin_bit_cast(float, (unsigned)b << 16); }
__device__ __forceinline__ float wave_sum(float v) {
#pragma unroll
    for (int o = 1; o < 64; o <<= 1) v += __shfl_xor(v, o);
    return v;
}
__constant__ float ROPE_INV[16] = {1.000000000e+00f, 5.623413324e-01f, 3.162277639e-01f, 1.778279394e-01f, 1.000000015e-01f, 5.623413250e-02f, 3.162277490e-02f, 1.778279431e-02f,
                                   9.999999776e-03f, 5.623413250e-03f, 3.162277630e-03f, 1.778279431e-03f, 1.000000047e-03f, 5.623413017e-04f, 3.162277571e-04f, 1.778279402e-04f};
__device__ __forceinline__ int rope_phys(int L) { return L < 16 ? 8 * (L >> 2) + (L & 3) : 8 * ((L - 16) >> 2) + 4 + ((L - 16) & 3); }

__device__ __forceinline__ void p0_item(const float* W, int K, int N, bf16* WT, const float* gain, int kind, MK_LAS float* scr, int item, int lane) {
    const int nblk = N / 32, kb = item / nblk, nb = item % nblk, k0 = 64 * kb, n0 = 32 * nb;
    int dbase = n0; bool perm = false; float mul = 1.0f;
    if (kind == 1) dbase = (n0 >> 7) * 256 + (n0 & 127);
    else if (kind == 2) dbase = (n0 >> 7) * 256 + 128 + (n0 & 127);
    else if (kind == 3) { if (n0 == 640) perm = true; else if (n0 >= 672) { dbase = n0 + 96; if (n0 < 1184) mul = C2M; } }
    else if (kind == 4) { perm = (n0 % 96) == 64; mul = C2Q; }
    else if (kind == 5) { const int h = n0 >> 7, e = n0 & 127; dbase = e < 64 ? h * 64 + e : 512 + h * 64 + (e - 64); }
    float wv[32];
#pragma unroll
    for (int i = 0; i < 32; ++i) wv[i] = W[(size_t)(k0 + 2 * i + (lane >> 5)) * N + n0 + (lane & 31)];
#pragma unroll
    for (int i = 0; i < 32; ++i) { const int kk = 2 * i + (lane >> 5); const float g = gain ? gain[k0 + kk] * mul : mul; scr[kk * 33 + (lane & 31)] = wv[i] * g; }
    asm volatile("s_waitcnt lgkmcnt(0)" ::: "memory");
    const int c = lane & 7;
#pragma unroll
    for (int j = 0; j < 4; ++j) { const int n = (lane >> 3) + 8 * j; const MK_LAS float* s = scr + (8 * c) * 33 + n;
        v4u o; o.x = pk2(s[0 * 33], s[1 * 33]); o.y = pk2(s[2 * 33], s[3 * 33]); o.z = pk2(s[4 * 33], s[5 * 33]); o.w = pk2(s[6 * 33], s[7 * 33]);
        const int drow = dbase + (perm ? rope_phys(n) : n);
        *(v4u*)(WT + (size_t)drow * K + k0 + 8 * c) = o; }
    asm volatile("s_waitcnt lgkmcnt(0)" ::: "memory");
}
constexpr int I_G = (DM / 64) * (DFF / 32), I_D = (DFF / 64) * (DM / 32), I_IN = (DM / 64) * (2208 / 32), I_UQ = (384 / 64) * (768 / 32), I_UKV = (256 / 64) * (1024 / 32), I_O = (DM / 64) * (DM / 32);
constexpr int NITEMS = 4 * I_G + 2 * I_D + I_IN + I_UQ + I_UKV + I_O;
__device__ __forceinline__ void p0_one_item(kargs_t ap, unsigned char* ws, MK_LAS float* scr, int it, int lane) {
    int r = it;
    if (r < I_G) { p0_item(ap->in[3], DM, DFF, (bf16*)(ws + WS_WGU1), ap->in[2], 1, scr, r, lane); return; } r -= I_G;
    if (r < I_G) { p0_item(ap->in[4], DM, DFF, (bf16*)(ws + WS_WGU1), ap->in[2], 2, scr, r, lane); return; } r -= I_G;
    if (r < I_D) { p0_item(ap->in[5], DFF, DM, (bf16*)(ws + WS_WD1), nullptr, 0, scr, r, lane); return; } r -= I_D;
    if (r < I_G) { p0_item(ap->in[14], DM, DFF, (bf16*)(ws + WS_WGU2), ap->in[13], 1, scr, r, lane); return; } r -= I_G;
    if (r < I_G) { p0_item(ap->in[15], DM, DFF, (bf16*)(ws + WS_WGU2), ap->in[13], 2, scr, r, lane); return; } r -= I_G;
    if (r < I_D) { p0_item(ap->in[16], DFF, DM, (bf16*)(ws + WS_WD2), nullptr, 0, scr, r, lane); return; } r -= I_D;
    if (r < I_IN) { p0_item(ap->in[7], DM, 2208, (bf16*)(ws + WS_WIN), ap->in[6], 3, scr, r, lane); return; } r -= I_IN;
    if (r < I_UQ) { p0_item(ap->in[9], 384, 768, (bf16*)(ws + WS_WUQ), ap->in[8], 4, scr, r, lane); return; } r -= I_UQ;
    if (r < I_UKV) { p0_item(ap->in[11], 256, 1024, (bf16*)(ws + WS_WUKV), ap->in[10], 5, scr, r, lane); return; } r -= I_UKV;
    p0_item(ap->in[12], DM, DM, (bf16*)(ws + WS_WOUT), nullptr, 0, scr, r, lane);
}
__device__ __forceinline__ void p0_tables_and_zero(kargs_t ap, const int gt, const int NGT) {
    unsigned char* ws = ap->ws;
    const int* pos = (const int*)ap->in[1]; float* posf = (float*)(ws + WS_POSF); float* cosT = (float*)(ws + WS_COS); float* sinT = (float*)(ws + WS_SIN);
    for (int e = gt; e < S * 16; e += NGT) { const int s_ = e >> 4, i = e & 15; const float ang = (float)pos[s_] * ROPE_INV[i]; float sn, cs; sincosf(ang, &sn, &cs); cosT[e] = cs; sinT[e] = sn; if (i == 0) posf[s_] = (float)pos[s_]; }
    for (int e = gt >> 6; e < S / 64; e += NGT >> 6) { int m_ = pos[64 * e + (gt & 63)];
#pragma unroll
        for (int o_ = 1; o_ < 64; o_ <<= 1) m_ = max(m_, __shfl_xor(m_, o_)); if ((gt & 63) == 0) posf[S + e] = (float)m_; }
    float* z = (float*)(ws + WS_SS2);
    for (int e = gt; e < 5 * S; e += NGT) z[e] = 0.f;
    float* km = (float*)(ws + WS_KMS);
    for (int e = gt; e < 64 * 512; e += NGT) km[e] = 0.f;
    unsigned* cnt = (unsigned*)(ws + WS_CNT);
    for (int e = gt; e < 512; e += NGT) cnt[e] = 0u;
    unsigned* padz = (unsigned*)((bf16*)(ws + WS_WIN) + (size_t)672 * DM);
    for (int e = gt; e < 96 * DM / 2; e += NGT) padz[e] = 0u;
}
__device__ __forceinline__ void p0_late_items(const Frame& F, kargs_t ap) {
    unsigned char* ws = ap->ws; MK_LAS float* scr = (MK_LAS float*)(F.lds + F.wave * 16384);
    const int w = ((int)blockIdx.x - 128) * NWAVES + F.wave, NW_ = 128 * NWAVES;
    for (int it = 2 * I_G + w; it < NITEMS; it += NW_) p0_one_item(ap, ws, scr, it, F.lane);
    p0_tables_and_zero(ap, w * 64 + F.lane, NW_ * 64);
}
__device__ __forceinline__ void p0_prologue(const Frame& F, kargs_t ap) {
    unsigned char* ws = ap->ws;
    MK_LAS float* scr = (MK_LAS float*)(F.lds + F.wave * 16384);
    const int gw = F.vcu * NWAVES + F.wave, NGW = F.G * NWAVES;
    constexpr int N_EARLY = 2 * I_G;
    const int n_here = (F.G == 256) ? N_EARLY : NITEMS;
    for (int it = gw; it < n_here; it += NGW) p0_one_item(ap, ws, scr, it, F.lane);
    const float* x = ap->in[0]; bf16* xb = (bf16*)(ws + WS_XB); float* ss1 = (float*)(ws + WS_SS1);
    for (int m = gw; m < S; m += 4 * NGW) {
        f32x4 v[4][4];
#pragma unroll
        for (int r = 0; r < 4; ++r) { const int mr = m + r * NGW; if (mr < S) { const f32x4* xr = (const f32x4*)(x + (size_t)mr * DM) + F.lane;
#pragma unroll
            for (int j = 0; j < 4; ++j) v[r][j] = xr[64 * j]; } }
#pragma unroll
        for (int r = 0; r < 4; ++r) { const int mr = m + r * NGW; if (mr < S) { unsigned long long* o8 = (unsigned long long*)(xb + (size_t)mr * DM) + F.lane; float s = 0.f;
#pragma unroll
            for (int j = 0; j < 4; ++j) { const f32x4 w = v[r][j]; s += (w[0] * w[0] + w[1] * w[1]) + (w[2] * w[2] + w[3] * w[3]); o8[64 * j] = (unsigned long long)pk2(w[0], w[1]) | ((unsigned long long)pk2(w[2], w[3]) << 32); }
            s = wave_sum(s); if (F.lane == 0) ss1[mr] = s; } }
    }
    if (F.G != 256) p0_tables_and_zero(ap, (F.vcu * NWAVES + F.wave) * 64 + F.lane, NGW * 64);
}

__device__ __forceinline__ void p4_krope(const Frame& F, kargs_t ap) { unsigned char* const wsb = ap->ws;
    const bf16* cqkv = (const bf16*)(wsb + WS_CQKV); bf16* Kr = (bf16*)(wsb + WS_KR); const float* cosT = (const float*)(wsb + WS_COS); const float* sinT = (const float*)(wsb + WS_SIN);
    const int gt = (F.vcu * NWAVES + F.wave) * 64 + F.lane, NGT = F.G * NWAVES * 64;
    for (int e = gt; e < S * 16; e += NGT) { const int s_ = e >> 4, i = e & 15, g = i >> 2, j = i & 3;
        const float x1 = bf2f(cqkv[(size_t)s_ * 768 + 640 + 8 * g + j]), x2 = bf2f(cqkv[(size_t)s_ * 768 + 640 + 8 * g + 4 + j]); const float c = cosT[e], sn = sinT[e];
        Kr[(size_t)s_ * 32 + 8 * g + j] = (bf16)f2bf(x1 * c - x2 * sn); Kr[(size_t)s_ * 32 + 8 * g + 4 + j] = (bf16)f2bf(x1 * sn + x2 * c); }
}
__device__ __forceinline__ void p4_gating(const Frame& F, kargs_t ap) { unsigned char* const wsb = ap->ws;
    const bf16* mqkv = (const bf16*)(wsb + WS_MQKV); const float* kms = (const float*)(wsb + WS_KMS); unsigned* cnt = (unsigned*)(wsb + WS_CNT); unsigned* lists = (unsigned*)(wsb + WS_LIST);
    MK_LAS float* km = (MK_LAS float*)F.lds;
    const int u0 = (F.G == 256) ? ((int)blockIdx.x < 192 ? (int)blockIdx.x : 256) : F.vcu, ustep = (F.G == 256) ? 192 : F.G;
    for (int u = u0; u < 256; u += ustep) {
        const int h = u & 7, q = (u >> 3) * 512 + F.tid, own = q >> 8;
        __syncthreads();
        for (int e = F.tid; e < 4096; e += 512) km[e] = kms[(size_t)(e >> 6) * 512 + h * 64 + (e & 63)] * (1.0f / 256.0f);
        __syncthreads();
        float qv[64];
        { const v4u* qp = (const v4u*)(mqkv + (size_t)q * 1536 + h * 64);
#pragma unroll
          for (int c = 0; c < 8; ++c) { const v4u w = qp[c];
#pragma unroll
              for (int j = 0; j < 4; ++j) { qv[8 * c + 2 * j] = __builtin_bit_cast(float, w[j] << 16); qv[8 * c + 2 * j + 1] = __builtin_bit_cast(float, w[j] & 0xFFFF0000u); } } }
        float g0 = -3e38f, g1 = -3e38f, g2 = -3e38f; int i0 = -1, i1 = -1, i2 = -1;
        const int own_max = __builtin_amdgcn_readfirstlane(own);
        for (int n = 0; n < own_max; ++n) {
            float g = 0.f;
#pragma unroll
            for (int c = 0; c < 16; ++c) { const f32x4 kk = *(const MK_LAS f32x4*)(km + n * 64 + 4 * c); g = fmaf(qv[4 * c], kk[0], g); g = fmaf(qv[4 * c + 1], kk[1], g); g = fmaf(qv[4 * c + 2], kk[2], g); g = fmaf(qv[4 * c + 3], kk[3], g); }
            if (g > g0) { g2 = g1; i2 = i1; g1 = g0; i1 = i0; g0 = g; i0 = n; }
            else if (g > g1) { g2 = g1; i2 = i1; g1 = g; i1 = n; }
            else if (g > g2) { g2 = g; i2 = n; }
        }
        MK_LAS unsigned* lcnt = (MK_LAS unsigned*)(F.lds + 16384);
        __syncthreads();
        if (F.tid < 64) lcnt[F.tid] = 0u;
        __syncthreads();
        unsigned r0 = 0u, r1 = 0u, r2 = 0u;
        if (i0 >= 0) r0 = __hip_atomic_fetch_add(lcnt + i0, 1u, __ATOMIC_RELAXED, __HIP_MEMORY_SCOPE_WORKGROUP);
        if (i1 >= 0) r1 = __hip_atomic_fetch_add(lcnt + i1, 1u, __ATOMIC_RELAXED, __HIP_MEMORY_SCOPE_WORKGROUP);
        if (i2 >= 0) r2 = __hip_atomic_fetch_add(lcnt + i2, 1u, __ATOMIC_RELAXED, __HIP_MEMORY_SCOPE_WORKGROUP);
        __syncthreads();
        if (F.tid < 64) { const unsigned c = lcnt[F.tid]; lcnt[64 + F.tid] = c ? atomicAdd(cnt + h * 64 + F.tid, c) : 0u; }
        __syncthreads();
        if (i0 >= 0) lists[(size_t)(h * 64 + i0) * S + lcnt[64 + i0] + r0] = (unsigned)(q | (0 << 14));
        if (i1 >= 0) lists[(size_t)(h * 64 + i1) * S + lcnt[64 + i1] + r1] = (unsigned)(q | (1 << 14));
        if (i2 >= 0) lists[(size_t)(h * 64 + i2) * S + lcnt[64 + i2] + r2] = (unsigned)(q | (2 << 14));
    }
    __syncthreads();
}
__device__ __forceinline__ void p5_combine(const Frame& F, kargs_t ap) { unsigned char* const wsb = ap->ws;
    const bf16* part = (const bf16*)ap->out;     const float* plse = (const float*)(wsb + WS_PLSE); bf16* cat = (bf16*)(wsb + WS_CAT);
    const int gt = (F.vcu * NWAVES + F.wave) * 64 + F.lane, NGT = F.G * NWAVES * 64;
    for (int e = gt; e < S * 8 * 8; e += NGT) { const int dg = e & 7, qh = e >> 3, q = qh >> 3, h = qh & 7; const int ns = 1 + min(3, q >> 8);
        const f32x4 ls = *(const f32x4*)(plse + (size_t)qh * 4);
        float M = ls[0]; for (int s = 1; s < 4; ++s) if (s < ns) M = fmaxf(M, ls[s]);
        float acc[8], wsum = 0.f;
#pragma unroll
        for (int j = 0; j < 8; ++j) acc[j] = 0.f;
#pragma unroll
        for (int s = 0; s < 4; ++s) if (s < ns) { const float w = __builtin_amdgcn_exp2f(ls[s] - M); wsum += w; const v4u v = *(const v4u*)(part + ((size_t)qh * 4 + s) * 64 + dg * 8);
#pragma unroll
            for (int j = 0; j < 4; ++j) { acc[2 * j] += w * __builtin_bit_cast(float, v[j] << 16); acc[2 * j + 1] += w * __builtin_bit_cast(float, v[j] & 0xFFFF0000u); } }
        const float r = 1.0f / wsum; v4u o; o.x = pk2(acc[0] * r, acc[1] * r); o.y = pk2(acc[2] * r, acc[3] * r); o.z = pk2(acc[4] * r, acc[5] * r); o.w = pk2(acc[6] * r, acc[7] * r);
        *(v4u*)(cat + (size_t)q * 1024 + 512 + h * 64 + dg * 8) = o; }
}
__device__ __forceinline__ void p9_final(const Frame& F, kargs_t ap) { unsigned char* const wsb = ap->ws;
    const float* ss = (const float*)(wsb + WS_SS4); const float* g = ap->in[17];
    const int gw = F.vcu * NWAVES + F.wave, NGW = F.G * NWAVES;
    float tsc = 1.0f;
#ifdef MK_TS
    { const unsigned long long* ts = (const unsigned long long*)(wsb + 2048); tsc = 1.0f + (float)(ts[MK_TS + 1] - ts[MK_TS]) * (float)MK_TS_SCALE; }
#endif
    for (int m = gw; m < S; m += NGW) { const float rs = tsc / sqrtf(ss[m] * (1.0f / 1024.0f) + 1e-6f); f32x4* xr = (f32x4*)(ap->out + (size_t)m * DM) + F.lane; const f32x4* gr = (const f32x4*)g + F.lane;
#pragma unroll
        for (int j = 0; j < 4; ++j) { const f32x4 v = xr[64 * j]; xr[64 * j] = v * rs * gr[64 * j]; } }
}

__global__ void __launch_bounds__(NWAVES * 64, 2) mk_fwd(Args a_unused) {
    extern __shared__ __attribute__((aligned(16))) unsigned char lds[];
    const int wave = __builtin_amdgcn_readfirstlane(threadIdx.x >> 6);
    MK_LAS unsigned char* const ldsp = (MK_LAS unsigned char*)lds;
    int lo, hi; { kargs_t ap = kargs(); lo = ap->ph_lo; hi = ap->ph_hi; }
#ifndef MK_ONLY
#define MK_ONLY -1
#endif
#define IN(k) ((MK_ONLY < 0 || MK_ONLY == (k)) && lo <= (k) && (k) < hi)
    const bool multi = (hi - lo) > 1;
    if (multi) {
        const int l0 = pg8::lane_id_v();
        if (wave == 0 && l0 < 2) ((volatile MK_LAS unsigned*)(ldsp + LDS_MISC))[l0] = 0u;
        __syncthreads();
        kargs_t ap = kargs(); (void)xb::xcd_barrier_post((unsigned*)(ap->ws + WS_BAR), (volatile MK_LAS unsigned*)(ldsp + LDS_MISC), wave == 0 && l0 == 0);
    }
    if (lo < -1) cg::this_grid().sync();
#ifdef MK_TS
#define MK_STAMP(i) do { if (blockIdx.x == 0 && wave == 0 && pg8::lane_id_v() == 0) { kargs_t ap__ = kargs(); ((unsigned long long*)(ap__->ws + 2048))[(i)] = __builtin_amdgcn_s_memrealtime(); } } while (0)
#else
#define MK_STAMP(i) do { } while (0)
#endif
    MK_STAMP(0);
#define SEAM(k) do { if (IN(k) && IN((k) + 1)) { kargs_t ap_ = kargs(); xb::XcdBarrier b_; b_.bar = (unsigned*)(ap_->ws + WS_BAR); b_.x = xb::xb_xcc_id(); b_.st = (volatile MK_LAS unsigned*)(ldsp + LDS_MISC); \
        xb::xcd_barrier(b_, wave == 0 && pg8::lane_id_v() == 0); MK_STAMP((k) + 1); } } while (0)
    if (IN(0)) { kargs_t ap = kargs(); const Frame F = mkframe(ldsp, wave);
#ifdef MK_PROBE0
        { int n0_; asm volatile("s_mov_b32 %0, 1" : "=s"(n0_)); for (int r0_ = 0; r0_ < n0_; ++r0_) { p0_prologue(F, ap); __syncthreads(); } }
#endif
        p0_prologue(F, ap); } SEAM(0);
    if (IN(1)) { kargs_t ap = kargs(); unsigned char* ws = ap->ws; pg8::Gemm g{(const bf16*)(ws + WS_XB), (const bf16*)(ws + WS_WGU1), S, NGU, DM, DM}; pg8::StaticOrder So; So.init(S, NGU, (int)gridDim.x, (int)blockIdx.x);
        pg8::EpiSwiGLU E{ws, 0}; pg8::gemm_phase<pg8::EpiSwiGLU, pg8::StaticOrder, true, true>(ldsp, g, So, E, wave);
        if (gridDim.x == 256 && blockIdx.x >= 128) { kargs_t ap2 = kargs(); const Frame F = mkframe(ldsp, wave); __syncthreads(); p0_late_items(F, ap2); } } SEAM(1);
    if (IN(2)) { kargs_t ap = kargs(); unsigned char* ws = ap->ws; pg8::Gemm g{(const bf16*)(ws + WS_ACT), (const bf16*)(ws + WS_WD1), S, DM, DFF, DFF}; pg8::StaticOrder So; So.init(S, DM, (int)gridDim.x, (int)blockIdx.x);
        pg8::EpiResid E{nullptr, ws, (int)WS_SS2, 0.5f}; pg8::gemm_phase<pg8::EpiResid, pg8::StaticOrder, true, true>(ldsp, g, So, E, wave); } SEAM(2);
    if (IN(3)) { kargs_t ap = kargs(); unsigned char* ws = ap->ws; pg8::Gemm g{(const bf16*)(ws + WS_XB), (const bf16*)(ws + WS_WIN), S, NWIN, DM, DM}; pg8::StaticOrder So; So.init(S, gridDim.x == 256 ? NWIN - 256 : NWIN, (int)gridDim.x, (int)blockIdx.x);
        pg8::EpiWin E{ws, 0}; pg8::gemm_phase<pg8::EpiWin, pg8::StaticOrder, true, true>(ldsp, g, So, E, wave); } SEAM(3);
    if (IN(4)) {
#ifdef MK_PROBE4
      int n4_; asm volatile("s_mov_b32 %0, 2" : "=s"(n4_));
      for (int r4_ = 0; r4_ < n4_; ++r4_) {
#endif
        { kargs_t ap = kargs(); unsigned char* ws = ap->ws; pg8::Gemm g{(const bf16*)(ws + WS_CQKV) + 384, (const bf16*)(ws + WS_WUKV), S, 1024, 256, 768}; pg8::StaticOrder So; So.init(S, 1024, (int)gridDim.x, (int)blockIdx.x);
          pg8::EpiKV E{ws}; pg8::gemm_phase<pg8::EpiKV, pg8::StaticOrder, true, true>(ldsp, g, So, E, wave); }
        { kargs_t ap = kargs(); unsigned char* ws = ap->ws; pg8::Gemm g{(const bf16*)(ws + WS_CQKV), (const bf16*)(ws + WS_WUQ), S, 768, 384, 768}; pg8::StaticOrder So; So.init(S, 768, (int)gridDim.x, (int)blockIdx.x);
          pg8::EpiQ E{ws}; pg8::gemm_phase<pg8::EpiQ, pg8::StaticOrder, true, true>(ldsp, g, So, E, wave); }
        if (gridDim.x == 256) { kargs_t ap = kargs(); unsigned char* ws = ap->ws; pg8::Gemm g{(const bf16*)(ws + WS_XB), (const bf16*)(ws + WS_WIN), S, NWIN, DM, DM}; pg8::TailOrder So; So.init(S, 8, (int)gridDim.x, (int)blockIdx.x);
          pg8::EpiWin E{ws, 0}; pg8::gemm_phase<pg8::EpiWin, pg8::TailOrder, true, true>(ldsp, g, So, E, wave); }
#if defined(MK_PROBE4) && MK_PROBE4 == 1
      __syncthreads(); }
#endif
        { kargs_t ap = kargs(); const Frame F = mkframe(ldsp, wave); p4_krope(F, ap); }
#if defined(MK_PROBE4) && MK_PROBE4 == 2
      __syncthreads(); }
#endif
#ifndef MK_NO_GATE
        { kargs_t ap = kargs(); const Frame F = mkframe(ldsp, wave); p4_gating(F, ap); }
#endif
    } SEAM(4);
#ifndef MK_NO_ATT5
    if (IN(5)) {
        kargs_t ap = kargs(); unsigned char* ws = ap->ws; const Frame F = mkframe(ldsp, wave);
        MK_LAS int* pre = (MK_LAS int*)(ldsp + att::MB_PRE);
        const unsigned* cnt = (const unsigned*)(ws + WS_CNT);
        __syncthreads();
        { const int c = (int)cnt[F.tid]; pre[F.tid] = (c + 255) >> 8; }
        __syncthreads();
        for (int o = 1; o < 512; o <<= 1) { const int v = pre[F.tid] + (F.tid >= o ? pre[F.tid - o] : 0); __syncthreads(); pre[F.tid] = v; __syncthreads(); }
        att::MobaCtx C; C.mqkv = (const bf16*)(ws + WS_MQKV); C.posf = (const float*)(ws + WS_POSF); C.part = (bf16*)ap->out; C.plse = (float*)(ws + WS_PLSE);
        C.lists = (const unsigned*)(ws + WS_LIST); C.cnt = cnt; C.total = pre[511]; C.vcu = F.vcu; C.G = F.G;
#ifdef MK_PROBE5
        { bf16* rp_ = C.part; float* rl_ = C.plse; C.part = (bf16*)(ws + WS_CQKV); C.plse = (float*)(ws + WS_CQKV + (16u << 20)); att::moba_run<MK_PROBE5>(C, (char*)lds, wave); __syncthreads(); C.part = rp_; C.plse = rl_; }
#endif
        att::moba_run<0>(C, (char*)lds, wave);
    }
#endif
    SEAM(5);
    if (IN(6)) {
#ifdef MK_PROBEC
        { int nc_; asm volatile("s_mov_b32 %0, 1" : "=s"(nc_)); for (int rc_ = 0; rc_ < nc_; ++rc_) { kargs_t ap = kargs(); const Frame F = mkframe(ldsp, wave); p5_combine(F, ap); __syncthreads(); } }
#endif
        { kargs_t ap = kargs(); const Frame F = mkframe(ldsp, wave); p5_combine(F, ap); }
#ifndef MK_NO_ATT6
        kargs_t ap = kargs(); unsigned char* ws = ap->ws; const Frame F = mkframe(ldsp, wave);
        att::Unit U; U.posf = nullptr; U.part = nullptr; U.plse = nullptr; U.list = nullptr; U.len = 0; U.slope2 = 0.f; U.q_pitch = 768; U.k_pitch = 512; U.v_pitch = 512; U.o_pitch = 1024; U.key0 = 0; U.Kr = (const bf16*)(ws + WS_KR);
        int vstep6 = F.G;
#ifdef MK_PROBE6
        asm volatile("s_mov_b32 %0, 0" : "=s"(vstep6));
        int npass6 = 0;
#endif
        for (int v = F.vcu; v < 256; v += vstep6) { const int h = v >> 5, s_ = v & 31;
#ifdef MK_PROBE6
            if (npass6++ >= MK_PROBE6) break;
            U.len = (npass6 == 1) ? 1 : 0;
#endif
            for (int i = 0; i < 2; ++i) { const int qb = i == 0 ? 63 - s_ : s_;
                U.h = h; U.Q = (const bf16*)(ws + WS_Q) + h * 96; U.K = (const bf16*)(ws + WS_KN) + h * 64; U.V = (const bf16*)(ws + WS_V) + h * 64; U.O = (bf16*)(ws + WS_CAT) + h * 64; U.q0 = qb * 256; U.ntiles = 4 * (qb + 1);
                att::unit<0>(U, (char*)lds, wave); } }
#endif
    } SEAM(6);
    if (IN(7)) { kargs_t ap = kargs(); unsigned char* ws = ap->ws; pg8::Gemm g{(const bf16*)(ws + WS_CAT), (const bf16*)(ws + WS_WOUT), S, DM, DM, DM}; pg8::StaticOrder So; So.init(S, DM, (int)gridDim.x, (int)blockIdx.x);
        pg8::EpiResid E{nullptr, ws, (int)WS_SS3, 1.0f}; pg8::gemm_phase<pg8::EpiResid, pg8::StaticOrder, true, true>(ldsp, g, So, E, wave); } SEAM(7);
    if (IN(8)) { kargs_t ap = kargs(); unsigned char* ws = ap->ws; pg8::Gemm g{(const bf16*)(ws + WS_XB), (const bf16*)(ws + WS_WGU2), S, NGU, DM, DM}; pg8::StaticOrder So; So.init(S, NGU, (int)gridDim.x, (int)blockIdx.x);
        pg8::EpiSwiGLU E{ws, 1};
#ifdef MK_PROBE8
        { int n8_; asm volatile("s_mov_b32 %0, 1" : "=s"(n8_)); for (int r8_ = 0; r8_ < n8_; ++r8_) { pg8::gemm_phase<pg8::EpiSwiGLU, pg8::StaticOrder, true, true>(ldsp, g, So, E, wave); __syncthreads(); } }
#endif
        pg8::gemm_phase<pg8::EpiSwiGLU, pg8::StaticOrder, true, true>(ldsp, g, So, E, wave); } SEAM(8);
    if (IN(9)) { kargs_t ap = kargs(); unsigned char* ws = ap->ws; pg8::Gemm g{(const bf16*)(ws + WS_ACT), (const bf16*)(ws + WS_WD2), S, DM, DFF, DFF}; pg8::StaticOrder So; So.init(S, DM, (int)gridDim.x, (int)blockIdx.x);
        if (gridDim.x == 256) { pg8::EpiResidNorm E{ap->out, ws, ap->in[17], 0.5f}; pg8::gemm_phase<pg8::EpiResidNorm, pg8::StaticOrder, false, true>(ldsp, g, So, E, wave); }
        else { pg8::EpiResid E{ap->out, ws, (int)WS_SS4, 0.5f}; pg8::gemm_phase<pg8::EpiResid, pg8::StaticOrder, true, true>(ldsp, g, So, E, wave); } }
    if (gridDim.x != 256) SEAM(9);
#ifdef MK_PROBE9
    if (IN(9)) { SEAM(9); kargs_t ap = kargs(); unsigned char* ws = ap->ws; pg8::Gemm g{(const bf16*)(ws + WS_ACT), (const bf16*)(ws + WS_WD2), S, DM, DFF, DFF}; pg8::StaticOrder So; So.init(S, DM, (int)gridDim.x, (int)blockIdx.x);
        pg8::EpiSwiGLU E{ws, 1}; pg8::gemm_phase<pg8::EpiSwiGLU, pg8::StaticOrder, true, true, MK_PROBE9 - 1>(ldsp, g, So, E, wave); }
#endif
    if (IN(10) && gridDim.x != 256) { kargs_t ap = kargs(); const Frame F = mkframe(ldsp, wave); p9_final(F, ap); }
#undef IN
#undef SEAM
}
constexpr int N_PHASES = 11;
}
#ifndef MK_BRINGUP
#define MK_BRINGUP 0
#endif
extern "C" void kernel_launch(void* const* d_in, const int* in_sizes, int n_in, void* d_out, int out_size, void* d_ws, size_t ws_size, hipStream_t stream) {
    static int grid = 0;
    if (grid == 0) {
        if (hipFuncSetAttribute((const void*)mk::mk_fwd, hipFuncAttributeMaxDynamicSharedMemorySize, mk::LDS_BYTES) != hipSuccess) { fprintf(stderr, "kernel_launch: hipFuncSetAttribute failed\n"); grid = -1; return; }
        int dev = 0, cus = 0, per_cu = 0;
        hipGetDevice(&dev); hipDeviceGetAttribute(&cus, hipDeviceAttributeMultiprocessorCount, dev);
        hipOccupancyMaxActiveBlocksPerMultiprocessor(&per_cu, (const void*)mk::mk_fwd, mk::NWAVES * 64, mk::LDS_BYTES);
        (void)hipGetLastError();
        grid = cus * (per_cu < 1 ? 1 : (per_cu > 1 ? 1 : per_cu));
        if (grid % 8 != 0 || grid <= 0) grid = 256;
        if (ws_size < mk::WS_END) { fprintf(stderr, "kernel_launch: workspace too small (%zu)\n", ws_size); grid = -1; return; }
    }
    if (grid < 0) return;
    mk::Args a{};
    for (int i = 0; i < 18; ++i) a.in[i] = (const float*)d_in[i];
    a.out = (float*)d_out; a.ws = (unsigned char*)d_ws;
#if MK_BRINGUP == 0
    if (hipMemsetAsync((char*)d_ws + mk::WS_BAR, 0, mk::BAR_BYTES, stream) != hipSuccess) { fprintf(stderr, "kernel_launch: memset failed\n"); return; }
    a.ph_lo = 0; a.ph_hi = mk::N_PHASES;
    void* args[] = {&a};
    hipError_t e = hipLaunchCooperativeKernel((const void*)mk::mk_fwd, dim3(grid), dim3(mk::NWAVES * 64), args, mk::LDS_BYTES, stream);
    if (e != hipSuccess) fprintf(stderr, "cooperative launch failed: %s (grid %d)\n", hipGetErrorString(e), grid);
#else
    const int nph = MK_BRINGUP == 1 ? 3 : MK_BRINGUP == 2 ? 8 : mk::N_PHASES;
    for (int ph = 0; ph < nph; ++ph) { a.ph_lo = ph; a.ph_hi = ph + 1; hipLaunchKernelGGL(mk::mk_fwd, dim3(grid), dim3(mk::NWAVES * 64), mk::LDS_BYTES, stream, a); }
#if MK_BRINGUP == 1
    nv::part_mix(d_in, (float*)d_out, d_ws, stream); nv::part_ffn2_final(d_in, (float*)d_out, d_ws, stream);
#elif MK_BRINGUP == 2
    nv::part_ffn2_final(d_in, (float*)d_out, d_ws, stream);
#endif
#endif
}
```

```cpp
#define MK_BRINGUP 0
#include <hip/hip_runtime.h>
#include <cstdio>
#include <cstdint>
#include <cmath>
#include <hip/hip_cooperative_groups.h>
namespace cg = cooperative_groups;

namespace mkc {
constexpr int S = 16384, DM = 1024, DFF = 2816, NGU = 2 * DFF, NWIN = 2304;
constexpr float LOG2E = 1.4426950408889634f;
constexpr float C2Q = 0.10206207261596577f * LOG2E;
constexpr float C2M = 0.125f * LOG2E;
constexpr size_t MiB = 1u << 20;
constexpr size_t WS_PANEL = 4096 + 16384;
constexpr size_t WS_CNT = 0;
constexpr size_t WS_SS1 = 1 * MiB, WS_SS2 = WS_SS1 + 65536, WS_SSQ = WS_SS2 + 65536, WS_SSKV = WS_SSQ + 65536, WS_SS3 = WS_SSKV + 65536, WS_SS4 = WS_SS3 + 65536;
constexpr size_t WS_KMS = WS_SS1 + 512 * 1024;
constexpr size_t WS_SSDUMMY = WS_SS1 + 384 * 1024, WS_KMSDUMMY = WS_SS1 + 640 * 1024;
constexpr size_t WS_POSF = 2 * MiB, WS_COS = 3 * MiB, WS_SIN = 4 * MiB;
constexpr size_t WS_WGU1 = 6 * MiB, WS_WD1 = 17 * MiB, WS_WGU2 = WS_WD1 + 5632 * 1024, WS_WD2 = WS_WGU2 + 11 * MiB, WS_WIN = 39 * MiB, WS_WUQ = WS_WIN + 4608 * 1024, WS_WUKV = WS_WUQ + 768 * 1024, WS_WOUT = 45 * MiB;
constexpr size_t WS_XB = 48 * MiB, WS_CQKV = 80 * MiB, WS_PLSE = 112 * MiB;
constexpr size_t WS_ACT = 114 * MiB, WS_MQKV = 114 * MiB, WS_CAT = 114 * MiB, WS_Q = 162 * MiB, WS_KN = 186 * MiB, WS_V = 202 * MiB, WS_KR = 218 * MiB, WS_LIST = 220 * MiB, WS_END = 252 * MiB;
static_assert(WS_WD2 + 5632 * 1024 <= WS_WIN && WS_WUKV + 512 * 1024 <= WS_WOUT && WS_WOUT + 2 * MiB <= WS_XB, "weight map");
}
namespace pg8 {
#define PG8_LAS __attribute__((address_space(3)))
typedef unsigned short bf16_t;
typedef short bf16x8 __attribute__((ext_vector_type(8)));
typedef float f32x4 __attribute__((ext_vector_type(4)));
typedef unsigned u32x4 __attribute__((ext_vector_type(4)));
__device__ __forceinline__ int lane_id_v() { int l; asm volatile("v_mbcnt_lo_u32_b32 %0, -1, 0\n\tv_mbcnt_hi_u32_b32 %0, -1, %0" : "=v"(l)); return l; }
constexpr int BM = 256, BK = 64, HALF = 128, HTB = HALF * BK * 2  , STAGE_BYTES = 8 * HTB, NXCD = 8, WGM = 4;

__host__ __device__ __forceinline__ int lds_byte(int r, int c) { const int st = (r >> 4) * 2 + (c >> 5), rr = r & 15, cc = c & 31, ob = rr * 64 + cc * 2; return st * 1024 + (ob ^ (((ob >> 9) & 1) << 5)); }
__host__ __device__ __forceinline__ void stage_rc(int b, int& R, int& C) { const int st = b / 1024, sb = b % 1024, swz = sb ^ (((sb >> 9) & 1) << 5); R = (st >> 1) * 16 + swz / 64; C = (st & 1) * 32 + (swz % 64) / 2; }
__host__ __device__ __forceinline__ int perm32(int rho) { const int n = rho >> 4, i = rho & 15; return 8 * (i >> 2) + 4 * n + (i & 3); }

struct Unit { int pm, pn; };
struct Gemm { const bf16_t* A; const bf16_t* Bt; int M, N, K, lda; };

struct StaticOrder {
    int nM, nN, nwg, G, c;
    __host__ __device__ void init(int M, int N, int G_, int c_) { nM = M / BM; nN = N / BM; nwg = nM * nN; G = G_; c = c_; }
    __host__ __device__ bool next(int i, Unit& u) const {
        const long L = (long)i * G + c; if (L >= nwg) return false;
        int wgid = (int)L; { const int q = nwg / NXCD, r = nwg % NXCD, xcd = wgid % NXCD, off = wgid / NXCD; wgid = (xcd < r ? xcd * (q + 1) : r * (q + 1) + (xcd - r) * q) + off; }
        const int nig = WGM * nN, gid = wgid / nig, fm = gid * WGM, gsz = (nM - fm) < WGM ? (nM - fm) : WGM;
        u.pm = fm + ((wgid % nig) % gsz); u.pn = (wgid % nig) / gsz; return true;
    }
    __device__ __forceinline__ void a_ready(const Unit&) const {}
    __device__ __forceinline__ void done(const Unit&) const {}
};
struct TailOrder {
    int nM, pn, G, c;
    __host__ __device__ void init(int M, int pn_, int G_, int c_) { nM = M / BM; pn = pn_; G = G_; c = c_; }
    __host__ __device__ bool next(int i, Unit& u) const { const int j = c - (G - nM); if (i != 0 || j < 0 || j >= nM) return false; u.pm = j; u.pn = pn; return true; }
    __device__ __forceinline__ void a_ready(const Unit&) const {}
    __device__ __forceinline__ void done(const Unit&) const {}
};
__device__ __forceinline__ unsigned cvt_pk_bf16(float lo, float hi) { unsigned r; asm volatile("v_cvt_pk_bf16_f32 %0, %1, %2" : "=v"(r) : "v"(lo), "v"(hi)); return r; }
typedef unsigned u32x2 __attribute__((ext_vector_type(2)));
constexpr float RMS_EPS = 1e-6f;
__device__ __forceinline__ float rs_of(const float* ss, int row, float invn) { return __builtin_amdgcn_rsqf(ss[row] * invn + RMS_EPS); }
__device__ __forceinline__ float silu_f(float g) { return g * __builtin_amdgcn_rcpf(1.0f + __builtin_amdgcn_exp2f(-1.4426950408889634f * g)); }
__device__ __forceinline__ u32x4 pack8(const f32x4 a, const f32x4 b) { u32x4 w; w.x = cvt_pk_bf16(a[0], a[1]); w.y = cvt_pk_bf16(a[2], a[3]); w.z = cvt_pk_bf16(b[0], b[1]); w.w = cvt_pk_bf16(b[2], b[3]); return w; }

struct EpiSwiGLU {
    static constexpr bool PERM = true, AFTER_DRAIN = false;
    unsigned char* ws; int which;
    __device__ __forceinline__ void operator()(const f32x4 (&acc)[2][2][4][2], const Unit& u, int wr, int wc, int fr, int fq) const {
        bf16_t* O = (bf16_t*)(ws + mkc::WS_ACT); const int ldo = mkc::DFF; const float* ss = (const float*)(ws + (which ? mkc::WS_SS3 : mkc::WS_SS1)); const float invn = 1.0f / 1024.0f;
        const int row0 = u.pm * BM + wr * 64 + fr, col0 = u.pn * HALF + wc * 32 + 8 * fq;
        float sv[2][4];
#pragma unroll
        for (int ai = 0; ai < 2; ++ai)
#pragma unroll
            for (int m = 0; m < 4; ++m) sv[ai][m] = ss[row0 + ai * HALF + m * 16];
#pragma unroll
        for (int ai = 0; ai < 2; ++ai)
#pragma unroll
            for (int m = 0; m < 4; ++m) { const int row = row0 + ai * HALF + m * 16;
                const float rs = __builtin_amdgcn_rsqf(sv[ai][m] * invn + RMS_EPS), rs2 = rs * -1.4426950408889634f, rsq = rs * rs;
                f32x4 a[2];
#pragma unroll
                for (int n = 0; n < 2; ++n) { const f32x4 g = acc[ai][0][m][n], t = g * rs2; f32x4 d;
#pragma unroll
                    for (int j = 0; j < 4; ++j) d[j] = __builtin_amdgcn_exp2f(t[j]);
                    d = d + 1.0f;
#pragma unroll
                    for (int j = 0; j < 4; ++j) d[j] = __builtin_amdgcn_rcpf(d[j]);
                    a[n] = (g * acc[ai][1][m][n]) * (d * rsq); }
                *(u32x4*)(O + (size_t)row * ldo + col0) = pack8(a[0], a[1]); }
    }
};
__device__ __forceinline__ f32x4 bf4_to_f32(const u32x2 w) { f32x4 r; r[0] = __builtin_bit_cast(float, w.x << 16); r[1] = __builtin_bit_cast(float, w.x & 0xFFFF0000u); r[2] = __builtin_bit_cast(float, w.y << 16); r[3] = __builtin_bit_cast(float, w.y & 0xFFFF0000u); return r; }
struct EpiResid {
    static constexpr bool PERM = false, AFTER_DRAIN = false;
    float* out; unsigned char* ws; int ss_off; float alpha;
    __device__ __forceinline__ void operator()(const f32x4 (&acc)[2][2][4][2], const Unit& u, int wr, int wc, int fr, int fq) const {
        bf16_t* xb = (bf16_t*)(ws + mkc::WS_XB); float* ss_out = (float*)(ws + ss_off);
        const int row0 = u.pm * BM + wr * 64 + fr, col0 = u.pn * BM + wc * 32 + 4 * fq;
        u32x2 bw[2][4][2][2];
#pragma unroll
        for (int ai = 0; ai < 2; ++ai)
#pragma unroll
            for (int m = 0; m < 4; ++m)
#pragma unroll
                for (int bj = 0; bj < 2; ++bj)
#pragma unroll
                    for (int n = 0; n < 2; ++n) bw[ai][m][bj][n] = *(const u32x2*)(xb + (size_t)(row0 + ai * HALF + m * 16) * 1024 + col0 + bj * HALF + n * 16);
#pragma unroll
        for (int ai = 0; ai < 2; ++ai)
#pragma unroll
            for (int m = 0; m < 4; ++m) { const int row = row0 + ai * HALF + m * 16; const size_t off = (size_t)row * 1024 + col0; float s = 0.f;
#pragma unroll
                for (int bj = 0; bj < 2; ++bj)
#pragma unroll
                    for (int n = 0; n < 2; ++n) { const f32x4 b = bf4_to_f32(bw[ai][m][bj][n]); const f32x4 o = b + acc[ai][bj][m][n] * alpha;
                        if (out) *(f32x4*)(out + off + bj * HALF + n * 16) = o;
                        s += (o[0] * o[0] + o[1] * o[1]) + (o[2] * o[2] + o[3] * o[3]);
                        u32x2 w; w.x = cvt_pk_bf16(o[0], o[1]); w.y = cvt_pk_bf16(o[2], o[3]); *(u32x2*)(xb + off + bj * HALF + n * 16) = w; }
                s += __shfl_xor(s, 16); s += __shfl_xor(s, 32);
                if (fq == 0) atomicAdd(ss_out + row, s);
                asm volatile("" ::: "memory"); }
    }
};
struct EpiWin {
    static constexpr bool PERM = true, AFTER_DRAIN = false;
    unsigned char* ws; int dummy;
    __device__ __forceinline__ void operator()(const f32x4 (&acc)[2][2][4][2], const Unit& u, int wr, int wc, int fr, int fq) const {
        bf16_t* cqkv = (bf16_t*)(ws + mkc::WS_CQKV); bf16_t* mqkv = (bf16_t*)(ws + mkc::WS_MQKV); const float* ss_in = (const float*)(ws + mkc::WS_SS2);
        float* ssq = (float*)(ws + (dummy ? mkc::WS_SSDUMMY : mkc::WS_SSQ)); float* sskv = (float*)(ws + (dummy ? mkc::WS_SSDUMMY + 65536 : mkc::WS_SSKV)); float* kmsum = (float*)(ws + (dummy ? mkc::WS_KMSDUMMY : mkc::WS_KMS));
        const int row0 = u.pm * BM + wr * 64 + fr;
        const bool is_mk = (u.pn == 5 || u.pn == 6);
        f32x4 cs[2][2];
#pragma unroll
        for (int bj = 0; bj < 2; ++bj)
#pragma unroll
            for (int n = 0; n < 2; ++n) cs[bj][n] = (f32x4){0.f, 0.f, 0.f, 0.f};
        float sv[2][4];
#pragma unroll
        for (int ai = 0; ai < 2; ++ai)
#pragma unroll
            for (int m = 0; m < 4; ++m) sv[ai][m] = ss_in[row0 + ai * HALF + m * 16];
#pragma unroll
        for (int ai = 0; ai < 2; ++ai)
#pragma unroll
            for (int m = 0; m < 4; ++m) { const int row = row0 + ai * HALF + m * 16; const float rs = __builtin_amdgcn_rsqf(sv[ai][m] * (1.0f / 1024.0f) + RMS_EPS);
#pragma unroll
                for (int bj = 0; bj < 2; ++bj) { const int colt = u.pn * BM + bj * HALF, col0 = colt + wc * 32 + 8 * fq;
                    const f32x4 v0 = acc[ai][bj][m][0] * rs, v1 = acc[ai][bj][m][1] * rs;
                    bf16_t* dst = (colt < 768) ? (cqkv + (size_t)row * 768 + col0) : (mqkv + (size_t)row * 1536 + (col0 - 768));
                    *(u32x4*)dst = pack8(v0, v1);
                    if (colt < 640) { float s = (v0[0] * v0[0] + v0[1] * v0[1]) + (v0[2] * v0[2] + v0[3] * v0[3]) + (v1[0] * v1[0] + v1[1] * v1[1]) + (v1[2] * v1[2] + v1[3] * v1[3]);
                        s += __shfl_xor(s, 16); s += __shfl_xor(s, 32);
                        if (fq == 0) atomicAdd((colt < 384 ? ssq : sskv) + row, s); }
                    if (is_mk) { cs[bj][0] += v0; cs[bj][1] += v1; } } }
        if (is_mk) {
#pragma unroll
            for (int bj = 0; bj < 2; ++bj)
#pragma unroll
                for (int n = 0; n < 2; ++n)
#pragma unroll
                    for (int j = 0; j < 4; ++j) { float s = cs[bj][n][j]; s += __shfl_xor(s, 1); s += __shfl_xor(s, 2); s += __shfl_xor(s, 4); s += __shfl_xor(s, 8);
                        if (fr == 0) atomicAdd(kmsum + (size_t)u.pm * 512 + (u.pn * BM + bj * HALF + wc * 32 + 8 * fq + 4 * n + j - 1280), s); }
        }
    }
};
struct EpiKV {
    static constexpr bool PERM = true, AFTER_DRAIN = false;
    unsigned char* ws;
    __device__ __forceinline__ void operator()(const f32x4 (&acc)[2][2][4][2], const Unit& u, int wr, int wc, int fr, int fq) const {
        bf16_t* Kn = (bf16_t*)(ws + mkc::WS_KN); bf16_t* V = (bf16_t*)(ws + mkc::WS_V); const float* ss = (const float*)(ws + mkc::WS_SSKV);
        const int row0 = u.pm * BM + wr * 64 + fr;
        float sv[2][4];
#pragma unroll
        for (int ai = 0; ai < 2; ++ai)
#pragma unroll
            for (int m = 0; m < 4; ++m) sv[ai][m] = ss[row0 + ai * HALF + m * 16];
#pragma unroll
        for (int ai = 0; ai < 2; ++ai)
#pragma unroll
            for (int m = 0; m < 4; ++m) { const int row = row0 + ai * HALF + m * 16; const float rs = __builtin_amdgcn_rsqf(sv[ai][m] * (1.0f / 256.0f) + RMS_EPS);
#pragma unroll
                for (int bj = 0; bj < 2; ++bj) { const int colt = u.pn * BM + bj * HALF, col0 = colt + wc * 32 + 8 * fq;
                    bf16_t* dst = (colt < 512) ? (Kn + (size_t)row * 512 + col0) : (V + (size_t)row * 512 + (col0 - 512));
                    *(u32x4*)dst = pack8(acc[ai][bj][m][0] * rs, acc[ai][bj][m][1] * rs); } }
    }
};
struct EpiQ {
    static constexpr bool PERM = true, AFTER_DRAIN = false;
    unsigned char* ws;
    __device__ __forceinline__ void operator()(const f32x4 (&acc)[2][2][4][2], const Unit& u, int wr, int wc, int fr, int fq) const {
        bf16_t* Q = (bf16_t*)(ws + mkc::WS_Q); const float* ss = (const float*)(ws + mkc::WS_SSQ); const float* cosT = (const float*)(ws + mkc::WS_COS); const float* sinT = (const float*)(ws + mkc::WS_SIN);
        const int row0 = u.pm * BM + wr * 64 + fr;
        float sv[2][4];
#pragma unroll
        for (int ai = 0; ai < 2; ++ai)
#pragma unroll
            for (int m = 0; m < 4; ++m) sv[ai][m] = ss[row0 + ai * HALF + m * 16];
#pragma unroll
        for (int ai = 0; ai < 2; ++ai)
#pragma unroll
            for (int m = 0; m < 4; ++m) { const int row = row0 + ai * HALF + m * 16; const float rs = __builtin_amdgcn_rsqf(sv[ai][m] * (1.0f / 384.0f) + RMS_EPS);
#pragma unroll
                for (int bj = 0; bj < 2; ++bj) { const int col0 = u.pn * BM + bj * HALF + wc * 32 + 8 * fq; const int d = col0 % 96;
                    f32x4 v0 = acc[ai][bj][m][0] * rs, v1 = acc[ai][bj][m][1] * rs;
                    if (d >= 64) { const int g = (d - 64) >> 3; const f32x4 c = *(const f32x4*)(cosT + (size_t)row * 16 + 4 * g), s = *(const f32x4*)(sinT + (size_t)row * 16 + 4 * g);
                        const f32x4 o0 = v0 * c - v1 * s, o1 = v0 * s + v1 * c; v0 = o0; v1 = o1; }
                    *(u32x4*)(Q + (size_t)row * 768 + col0) = pack8(v0, v1); }
                asm volatile("" ::: "memory"); }
    }
};
struct EpiResidNorm {
    static constexpr bool PERM = false, AFTER_DRAIN = true;
    float* out; unsigned char* ws; const float* gain; float alpha;
    __device__ __forceinline__ void fused(f32x4 (&acc)[2][2][4][2], const Unit& u, int wr, int wc, int fr, int fq, PG8_LAS unsigned char* lds, int wid, int lane) const {
        float* ss = (float*)(ws + mkc::WS_SS4); unsigned* pcnt = (unsigned*)(ws + mkc::WS_PANEL) + 64 * u.pm; const bf16_t* xb = (const bf16_t*)(ws + mkc::WS_XB);
        const int row0 = u.pm * BM + wr * 64 + fr, col0 = u.pn * BM + wc * 32 + 4 * fq;
        u32x2 bw[2][4][2][2];
#pragma unroll
        for (int ai = 0; ai < 2; ++ai)
#pragma unroll
            for (int m = 0; m < 4; ++m)
#pragma unroll
                for (int bj = 0; bj < 2; ++bj)
#pragma unroll
                    for (int n = 0; n < 2; ++n) bw[ai][m][bj][n] = *(const u32x2*)(xb + (size_t)(row0 + ai * HALF + m * 16) * 1024 + col0 + bj * HALF + n * 16);
#pragma unroll
        for (int ai = 0; ai < 2; ++ai)
#pragma unroll
            for (int m = 0; m < 4; ++m) { const int row = row0 + ai * HALF + m * 16; float s = 0.f;
#pragma unroll
                for (int bj = 0; bj < 2; ++bj)
#pragma unroll
                    for (int n = 0; n < 2; ++n) { const f32x4 b = bf4_to_f32(bw[ai][m][bj][n]); const f32x4 o = b + acc[ai][bj][m][n] * alpha; acc[ai][bj][m][n] = o;
                        s += (o[0] * o[0] + o[1] * o[1]) + (o[2] * o[2] + o[3] * o[3]); }
                s += __shfl_xor(s, 16); s += __shfl_xor(s, 32);
                if (fq == 0) atomicAdd(ss + row, s);
                asm volatile("" : "+v"(acc[ai][0][m][0]), "+v"(acc[ai][0][m][1]), "+v"(acc[ai][1][m][0]), "+v"(acc[ai][1][m][1]));
                if (m & 1) asm volatile("" ::: "memory"); }
        asm volatile("s_waitcnt vmcnt(0)" ::: "memory"); __builtin_amdgcn_s_barrier(); asm volatile("" ::: "memory");
        if (wid == 0) {
            if (lane == 0) { __builtin_amdgcn_fence(__ATOMIC_RELEASE, "agent"); asm volatile("s_waitcnt vmcnt(0)" ::: "memory"); __hip_atomic_fetch_add(pcnt, 1u, __ATOMIC_RELAXED, __HIP_MEMORY_SCOPE_AGENT); }
            unsigned spins = 0;
            while ((unsigned)__builtin_amdgcn_readfirstlane(__hip_atomic_load(pcnt, __ATOMIC_RELAXED, __HIP_MEMORY_SCOPE_AGENT)) < 4u) { __builtin_amdgcn_s_sleep(2); if (++spins > (1u << 22)) break; }
            __builtin_amdgcn_fence(__ATOMIC_ACQUIRE, "agent");
        }
        asm volatile("s_waitcnt vmcnt(0) lgkmcnt(0)" ::: "memory"); __builtin_amdgcn_s_barrier(); asm volatile("" ::: "memory");
        f32x4 gv[2][2];
#pragma unroll
        for (int bj = 0; bj < 2; ++bj)
#pragma unroll
            for (int n = 0; n < 2; ++n) gv[bj][n] = *(const f32x4*)(gain + col0 + bj * HALF + n * 16);
        float tv[2][4];
#pragma unroll
        for (int ai = 0; ai < 2; ++ai)
#pragma unroll
            for (int m = 0; m < 4; ++m) tv[ai][m] = __hip_atomic_load(ss + row0 + ai * HALF + m * 16, __ATOMIC_RELAXED, __HIP_MEMORY_SCOPE_AGENT);
#pragma unroll
        for (int ai = 0; ai < 2; ++ai)
#pragma unroll
            for (int m = 0; m < 4; ++m) { const int row = row0 + ai * HALF + m * 16; const size_t off = (size_t)row * 1024 + col0;
                const float tot = tv[ai][m]; const float rs = __builtin_amdgcn_rsqf(tot * (1.0f / 1024.0f) + RMS_EPS);
#pragma unroll
                for (int bj = 0; bj < 2; ++bj)
#pragma unroll
                    for (int n = 0; n < 2; ++n) *(f32x4*)(out + off + bj * HALF + n * 16) = acc[ai][bj][m][n] * rs * gv[bj][n]; }
    }
};

template <class Epi, class Sched, bool ALIGN_EPI = false, bool SP2 = false>
__device__ __forceinline__ void gemm_phase(PG8_LAS unsigned char* lds, const Gemm g, const Sched& S, const Epi& E, const int wid) {
    const int lane = lane_id_v(), tid = wid * 64 + lane, wr = wid >> 2, wc = wid & 3, fr = lane & 15, fq = lane >> 4;
    const int K = g.K, nt = K / BK, lda = g.lda;
    unsigned voffA[2], voffB[2];
#pragma unroll
    for (int i = 0; i < 2; ++i) { int R, C; stage_rc(tid * 16 + i * 8192, R, C); const int Rb = Epi::PERM ? ((R & ~31) + perm32(R & 31)) : R;
        voffA[i] = (unsigned)(R * lda + C) * 2u; voffB[i] = (unsigned)(Rb * K + C) * 2u; }
    const size_t kstep = (size_t)(BK * 2);
    const size_t hstep = (size_t)HALF * K * 2;
    const size_t tstep = 2 * hstep; const size_t hstepA = (size_t)HALF * lda * 2, tstepA = 2 * hstepA;
    const unsigned ldsw = (unsigned)wid * 1024u;
    const int aoff = lds_byte(wr * 64 + fr, fq * 8), boff = lds_byte(wc * 32 + fr, fq * 8);
#define PG8_SA(b, h) (((b) * 2 + (h)) * HTB)
#define PG8_SB(b, h) ((4 + (b) * 2 + (h)) * HTB)
#define PG8_STAGE(bufoff, gbase, voff) do { _Pragma("unroll") for (int _i = 0; _i < 2; ++_i) \
        __builtin_amdgcn_global_load_lds((const unsigned*)((const char*)(gbase) + (voff)[_i]), (PG8_LAS unsigned*)(lds + (bufoff) + ldsw + _i * 8192), 16, 0, 0); } while (0)
#define PG8_LDA(dst, b, h) do { _Pragma("unroll") for (int m = 0; m < 4; ++m) _Pragma("unroll") for (int k = 0; k < 2; ++k) dst[m][k] = *(const PG8_LAS bf16x8*)(lds + PG8_SA(b, h) + aoff + m * 2048 + k * 1024); } while (0)
#define PG8_LDB(dst, b, h) do { _Pragma("unroll") for (int n = 0; n < 2; ++n) _Pragma("unroll") for (int k = 0; k < 2; ++k) dst[n][k] = *(const PG8_LAS bf16x8*)(lds + PG8_SB(b, h) + boff + n * 2048 + k * 1024); } while (0)
#define PG8_MMA(ai, bj, At, Bt) do { __builtin_amdgcn_s_setprio(1); _Pragma("unroll") for (int m = 0; m < 4; ++m) _Pragma("unroll") for (int n = 0; n < 2; ++n) _Pragma("unroll") for (int k = 0; k < 2; ++k) \
        acc[ai][bj][m][n] = __builtin_amdgcn_mfma_f32_16x16x32_bf16(Bt[n][k], At[m][k], acc[ai][bj][m][n], 0, 0, 0); __builtin_amdgcn_s_setprio(0); } while (0)
#define PG8_WAIT_V(n) asm volatile("s_waitcnt vmcnt(" #n ")" ::: "memory")
#define PG8_WAIT_L(n) asm volatile("s_waitcnt lgkmcnt(" #n ")" ::: "memory")
#define PG8_BAR __builtin_amdgcn_s_barrier()
#define PG8_SCHED __builtin_amdgcn_sched_barrier(0)
    Unit cur, nxt; int ui = 0;
    if (!S.next(0, cur)) return;
    f32x4 acc[2][2][4][2];
#pragma unroll
    for (int a = 0; a < 2; ++a)
#pragma unroll
        for (int b = 0; b < 2; ++b)
#pragma unroll
            for (int m = 0; m < 4; ++m)
#pragma unroll
                for (int n = 0; n < 2; ++n) acc[a][b][m][n] = (f32x4){0.f, 0.f, 0.f, 0.f};
    bf16x8 At[4][2], B0[2][2], B1[2][2];
    const char* cA = (const char*)g.A + (size_t)cur.pm * tstepA; const char* cB = (const char*)g.Bt + (size_t)cur.pn * tstep;
    S.a_ready(cur);
    if constexpr (SP2) {
        PG8_STAGE(PG8_SB(0, 0), cB, voffB); PG8_STAGE(PG8_SB(0, 1), cB + hstep, voffB); PG8_STAGE(PG8_SA(0, 0), cA, voffA); PG8_STAGE(PG8_SA(0, 1), cA + hstepA, voffA);
        if (wr == 1) PG8_BAR;
        PG8_WAIT_V(2); PG8_BAR;
        PG8_STAGE(PG8_SB(1, 0), cB + kstep, voffB); PG8_STAGE(PG8_SA(1, 0), cA + kstep, voffA); PG8_STAGE(PG8_SB(1, 1), cB + hstep + kstep, voffB);
        PG8_WAIT_V(6); PG8_BAR;
    } else {
        PG8_STAGE(PG8_SB(0, 0), cB, voffB); PG8_STAGE(PG8_SA(0, 0), cA, voffA); PG8_STAGE(PG8_SB(0, 1), cB + hstep, voffB); PG8_STAGE(PG8_SA(0, 1), cA + hstepA, voffA);
        if (wr == 1) PG8_BAR;
        PG8_WAIT_V(4); PG8_BAR;
        PG8_STAGE(PG8_SB(1, 0), cB + kstep, voffB); PG8_STAGE(PG8_SA(1, 0), cA + kstep, voffA); PG8_STAGE(PG8_SB(1, 1), cB + hstep + kstep, voffB);
        PG8_WAIT_V(6); PG8_BAR;
    }
    for (;;) {
        const bool has_next = S.next(ui + 1, nxt);
        const char* nA = has_next ? (const char*)g.A + (size_t)nxt.pm * tstepA : cA; const char* nB = has_next ? (const char*)g.Bt + (size_t)nxt.pn * tstep : cB;
#pragma nounroll
        for (int t = 0; t < nt; t += 2) {
            const bool last = (t == nt - 2);
            const char* a1 = cA + (size_t)(t + 1) * kstep;
            const char* a2 = last ? nA : cA + (size_t)(t + 2) * kstep; const char* b2 = last ? nB : cB + (size_t)(t + 2) * kstep;
            const char* a3 = a2 + kstep; const char* b3 = b2 + kstep;
            if (last && has_next) S.a_ready(nxt);
            if constexpr (SP2) {
            PG8_LDB(B0, 0, 0); PG8_LDB(B1, 0, 1); PG8_SCHED; PG8_LDA(At, 0, 0); PG8_STAGE(PG8_SA(1, 1), a1 + hstepA, voffA);
            PG8_WAIT_V(8); PG8_WAIT_L(0); PG8_BAR; PG8_MMA(0, 0, At, B0); PG8_MMA(0, 1, At, B1); PG8_BAR; PG8_SCHED;
            PG8_LDA(At, 0, 1); PG8_STAGE(PG8_SB(0, 0), b2, voffB); PG8_STAGE(PG8_SB(0, 1), b2 + hstep, voffB); PG8_STAGE(PG8_SA(0, 0), a2, voffA);
            PG8_WAIT_V(8); PG8_WAIT_L(0); PG8_BAR; PG8_MMA(1, 0, At, B0); PG8_MMA(1, 1, At, B1); PG8_BAR; PG8_SCHED;
            PG8_LDB(B0, 1, 0); PG8_LDB(B1, 1, 1); PG8_SCHED; PG8_LDA(At, 1, 0); PG8_STAGE(PG8_SA(0, 1), a2 + hstepA, voffA);
            PG8_WAIT_V(8); PG8_WAIT_L(0); PG8_BAR; PG8_MMA(0, 0, At, B0); PG8_MMA(0, 1, At, B1); PG8_BAR; PG8_SCHED;
            PG8_LDA(At, 1, 1); PG8_STAGE(PG8_SB(1, 0), b3, voffB); PG8_STAGE(PG8_SB(1, 1), b3 + hstep, voffB); PG8_STAGE(PG8_SA(1, 0), a3, voffA);
            PG8_WAIT_V(8); PG8_WAIT_L(0); PG8_BAR; PG8_MMA(1, 0, At, B0); PG8_MMA(1, 1, At, B1); PG8_BAR; PG8_SCHED;
            } else {
            PG8_LDB(B0, 0, 0); PG8_SCHED; PG8_LDA(At, 0, 0); PG8_STAGE(PG8_SA(1, 1), a1 + hstepA, voffA);
            PG8_WAIT_L(8); PG8_BAR; PG8_WAIT_L(0); PG8_MMA(0, 0, At, B0); PG8_BAR; PG8_SCHED;
            PG8_LDB(B1, 0, 1); PG8_STAGE(PG8_SB(0, 0), b2, voffB);
            PG8_BAR; PG8_WAIT_L(0); PG8_MMA(0, 1, At, B1); PG8_BAR;
            PG8_LDA(At, 0, 1); PG8_STAGE(PG8_SA(0, 0), a2, voffA);
            PG8_BAR; PG8_WAIT_L(0); PG8_MMA(1, 0, At, B0); PG8_BAR; PG8_SCHED;
            PG8_STAGE(PG8_SB(0, 1), b2 + hstep, voffB);
            PG8_WAIT_V(6); PG8_BAR; PG8_MMA(1, 1, At, B1); PG8_BAR;
            PG8_LDB(B0, 1, 0); PG8_SCHED; PG8_LDA(At, 1, 0); PG8_STAGE(PG8_SA(0, 1), a2 + hstepA, voffA);
            PG8_WAIT_L(8); PG8_BAR; PG8_WAIT_L(0); PG8_MMA(0, 0, At, B0); PG8_BAR; PG8_SCHED;
            PG8_LDB(B1, 1, 1); PG8_STAGE(PG8_SB(1, 0), b3, voffB);
            PG8_BAR; PG8_WAIT_L(0); PG8_MMA(0, 1, At, B1); PG8_BAR;
            PG8_LDA(At, 1, 1); PG8_STAGE(PG8_SA(1, 0), a3, voffA);
            PG8_BAR; PG8_WAIT_L(0); PG8_MMA(1, 0, At, B0); PG8_BAR; PG8_SCHED;
            PG8_STAGE(PG8_SB(1, 1), b3 + hstep, voffB);
            PG8_WAIT_V(6); PG8_BAR; PG8_MMA(1, 1, At, B1); PG8_BAR;
            }
        }
        if constexpr (ALIGN_EPI) { if (wr == 0) PG8_BAR; }
        if constexpr (!Epi::AFTER_DRAIN) { E(acc, cur, wr, wc, fr, fq); S.done(cur); }
        if (!has_next) break;
#pragma unroll
        for (int a = 0; a < 2; ++a)
#pragma unroll
            for (int b = 0; b < 2; ++b)
#pragma unroll
                for (int m = 0; m < 4; ++m)
#pragma unroll
                    for (int n = 0; n < 2; ++n) acc[a][b][m][n] = (f32x4){0.f, 0.f, 0.f, 0.f};
        cur = nxt; cA = nA; cB = nB; ++ui;
        if constexpr (ALIGN_EPI) { if (wr == 1) PG8_BAR; }
    }
    PG8_WAIT_V(0);
    if constexpr (!ALIGN_EPI) { if (wr == 0) PG8_BAR; }
    PG8_BAR;
    if constexpr (Epi::AFTER_DRAIN) { E.fused(acc, cur, wr, wc, fr, fq, lds, wid, lane); S.done(cur); }
#undef PG8_SA
#undef PG8_SB
#undef PG8_STAGE
#undef PG8_LDA
#undef PG8_LDB
#undef PG8_MMA
#undef PG8_WAIT_V
#undef PG8_WAIT_L
#undef PG8_BAR
#undef PG8_SCHED
}
}
namespace att {
typedef unsigned short bf16_t;
using bf16x8 = __attribute__((ext_vector_type(8))) short;
using s16x4 = __attribute__((ext_vector_type(4))) short;
using f32x16 = __attribute__((ext_vector_type(16))) float;
using f32x4 = __attribute__((ext_vector_type(4))) float;
using u32x4 = __attribute__((ext_vector_type(4))) unsigned;
typedef short v4i16_t __attribute__((ext_vector_type(4)));
#define ATT_LAS __attribute__((address_space(3)))
typedef ATT_LAS const char* lds_cptr;
constexpr int NW = 8, KVBLK = 64;
constexpr int KSLOT = 12288, VSLOT = 8192, NSLOT = 4;
constexpr int LDS_K = 0, LDS_V = NSLOT * KSLOT, LDS_WS = LDS_V + NSLOT * VSLOT, LDS_OST = LDS_WS + NW * 64 * 4, LDS_POSK = LDS_OST + NW * 4096, LDS_BYTES = LDS_POSK + 1024;
__device__ __forceinline__ int crow(int r, int hi) { return (r & 3) + 8 * (r >> 2) + 4 * hi; }
__device__ __forceinline__ void glds16(const void* gsrc, unsigned lds_dst) {
    asm volatile("s_mov_b32 m0, %1\n\ts_nop 0\n\tglobal_load_lds_dwordx4 %0, off" : : "v"(gsrc), "s"(lds_dst) : "memory", "m0"); }
typedef float f32x2_t __attribute__((ext_vector_type(2))); typedef __bf16 bf16x2_t __attribute__((ext_vector_type(2)));
__device__ __forceinline__ unsigned cvtpk(float lo, float hi) { f32x2_t v = {lo, hi}; bf16x2_t b = __builtin_convertvector(v, bf16x2_t); return __builtin_bit_cast(unsigned, b); }
__device__ __forceinline__ float att_bf16_up(float x) { unsigned u = __float_as_uint(x); if (u & 0xFFFFu) { u &= 0xFFFF0000u; if (x > 0.f) u += 0x10000u; } return __uint_as_float(u); }
__device__ __forceinline__ s16x4 vtr(lds_cptr p) { return __builtin_bit_cast(s16x4, __builtin_amdgcn_ds_read_tr16_b64_v4i16((ATT_LAS v4i16_t*)p)); }
#define ATT_KS(j) (((j) & (NSLOT - 1)) * KSLOT)
#define ATT_VS(j) (((j) & (NSLOT - 1)) * VSLOT)
#define ATT_WAIT_BAR() asm volatile("s_waitcnt vmcnt(0) lgkmcnt(0)\n\ts_barrier" ::: "memory")
#define ATT_WAIT_BAR_N(three) do { if (three) asm volatile("s_waitcnt vmcnt(3) lgkmcnt(0)\n\ts_barrier" ::: "memory"); else asm volatile("s_waitcnt vmcnt(2) lgkmcnt(0)\n\ts_barrier" ::: "memory"); } while (0)

struct Unit {
    const bf16_t* Q; int q_pitch;
    const bf16_t* K; int k_pitch;
    const bf16_t* Kr;
    const bf16_t* V; int v_pitch;
    int key0, ntiles;
    int q0;
    const unsigned short* list; int len;
    const float* posf;
    float slope2;
    bf16_t* O; int o_pitch;
    bf16_t* part; float* plse; int h;
};

template <int MODE> __device__ __forceinline__ void unit(const Unit& U, char* shm, const int wid) {
    constexpr int DQK = (MODE == 0) ? 96 : 64, ND0 = DQK / 16;
    const int lane = pg8::lane_id_v(), tid = wid * 64 + lane, r32 = lane & 31, hi = lane >> 5;
    const unsigned lds0 = (unsigned)(uintptr_t)shm;
    const lds_cptr shm3 = (lds_cptr)shm;
    ATT_LAS float* wsf = (ATT_LAS float*)(shm3 + LDS_WS) + wid * 64;
    int qrow, slot = 0; bool valid = true;
    if (MODE == 2) { const int e = wid * 32 + r32; valid = e < U.len; const unsigned ent = valid ? (unsigned)U.list[e] : (unsigned)U.list[0]; qrow = (int)(ent & 0x3FFFu); slot = 1 + (int)(ent >> 14); }
    else qrow = U.q0 + wid * 32 + r32;
    const unsigned koff = (unsigned)((U.key0 + 8 * wid + (lane >> 3)) * U.k_pitch + (((lane & 7) ^ ((4 * wid + (lane >> 4)) & 7)) * 8)) * 2u;
    const unsigned kroff = (MODE == 0) ? (unsigned)((U.key0 + 16 * (wid & 3) + (lane >> 2)) * 32 + (((lane & 3) ^ ((lane >> 4) & 3)) * 8)) * 2u : 0u;
    const unsigned voff = (unsigned)((U.key0 + 16 * (wid & 3) + (lane >> 2)) * U.v_pitch + (wid >> 2) * 32 + (lane & 3) * 8) * 2u;
#define ATT_DMA(t, ks, vs) do { glds16((const char*)U.K + koff + (size_t)(t) * (KVBLK * 2) * U.k_pitch, (unsigned)(lds0 + LDS_K + wid * 1024 + (ks))); \
        if (MODE == 0 && wid < 4) glds16((const char*)U.Kr + kroff + (size_t)(t) * (KVBLK * 64), (unsigned)(lds0 + LDS_K + (8 + (wid & 3)) * 1024 + (ks))); \
        glds16((const char*)U.V + voff + (size_t)(t) * (KVBLK * 2) * U.v_pitch, (unsigned)(lds0 + LDS_V + wid * 1024 + (vs))); } while (0)
    const int NT = U.ntiles;
    ATT_DMA(0, 0, 0);
    if (NT > 1) ATT_DMA(1, KSLOT, VSLOT);
    bf16x8 qr[ND0];
    { const bf16_t* Qw = U.Q + (size_t)qrow * U.q_pitch + hi * 8;
#pragma unroll
      for (int d0 = 0; d0 < ND0; ++d0) qr[d0] = *reinterpret_cast<const bf16x8*>(Qw + d0 * 16); }
    float pq = 0.f;
    if (MODE != 0) { pq = U.posf[qrow]; if (tid < 256) ((ATT_LAS float*)(shm3 + LDS_POSK))[tid] = U.posf[U.key0 + tid]; }
    float mhat = -1e30f, l_reg = 0.f; f32x16 o[2]; o[0] = f32x16{}; o[1] = f32x16{};
    const int km_ = (r32 >> 1) & 7, kmr_ = (r32 >> 2) & 3;
    const int ka0 = LDS_K + r32 * 128 + 32 * (km_ >> 1) + 16 * (hi ^ (km_ & 1));
    const int kb0 = LDS_K + 8192 + r32 * 64 + 32 * (kmr_ >> 1) + 16 * (hi ^ (kmr_ & 1));
#define ATT_KADDR(d0, half, KS) (shm3 + (KS) + (((d0) < 4) ? ((ka0 ^ ((d0) << 5)) + (half) * 4096) : ((kb0 ^ (((d0) - 4) << 5)) + (half) * 2048)))
    const lds_cptr vp0 = shm3 + LDS_V + ((lane >> 4) & 1) * 32 + (lane & 3) * 8 + (4 * hi + ((lane & 15) >> 2)) * 64;
#define ATT_QKT(P0, P1, KS) do { P0 = f32x16{}; P1 = f32x16{}; bf16x8 kk_[2 * ND0]; \
        _Pragma("unroll") for (int d0 = 0; d0 < ND0; ++d0) { kk_[2 * d0] = *(const ATT_LAS bf16x8*)ATT_KADDR(d0, 0, KS); kk_[2 * d0 + 1] = *(const ATT_LAS bf16x8*)ATT_KADDR(d0, 1, KS); }     \
        __builtin_amdgcn_sched_barrier(0); \
        _Pragma("unroll") for (int d0 = 0; d0 < ND0; ++d0) { \
            P0 = __builtin_amdgcn_mfma_f32_32x32x16_bf16(kk_[2 * d0], qr[d0], P0, 0, 0, 0); P1 = __builtin_amdgcn_mfma_f32_32x32x16_bf16(kk_[2 * d0 + 1], qr[d0], P1, 0, 0, 0); } } while (0)
#define ATT_SMPV(P0, P1, T, VS) do { \
        if (MODE != 0) { const ATT_LAS float* pk_ = (const ATT_LAS float*)(shm3 + LDS_POSK) + 64 * (T) + 4 * hi; \
            _Pragma("unroll") for (int g = 0; g < 4; ++g) { const f32x4 a_ = *(const ATT_LAS f32x4*)(pk_ + 8 * g), b_ = *(const ATT_LAS f32x4*)(pk_ + 8 * g + 32); \
                _Pragma("unroll") for (int j = 0; j < 4; ++j) { P0[4 * g + j] -= U.slope2 * __builtin_fabsf(pq - a_[j]); P1[4 * g + j] -= U.slope2 * __builtin_fabsf(pq - b_[j]); } } } \
        if (MODE == 0 || MODE == 1) { const int kb_ = U.key0 + 64 * (T); \
            if (kb_ + 63 > U.q0 + wid * 32) { const int dq_ = qrow - kb_ - 4 * hi; \
                _Pragma("unroll") for (int r = 0; r < 16; ++r) { const int c_ = (r & 3) + 8 * (r >> 2); if (c_ > dq_) P0[r] = -INFINITY; if (c_ + 32 > dq_) P1[r] = -INFINITY; } } } \
        float rm_ = P0[0]; \
        _Pragma("unroll") for (int r = 1; r < 16; ++r) rm_ = fmaxf(rm_, P0[r]); \
        _Pragma("unroll") for (int r = 0; r < 16; ++r) rm_ = fmaxf(rm_, P1[r]); \
        { auto rr_ = __builtin_amdgcn_permlane32_swap(__float_as_uint(rm_), __float_as_uint(rm_), false, false); rm_ = fmaxf(__uint_as_float(rr_[0]), __uint_as_float(rr_[1])); } \
        if (__any(rm_ > mhat + 10.0f)) { const float mn_ = fmaxf(mhat, rm_), f_ = __builtin_amdgcn_exp2f(mhat - mn_); mhat = mn_; l_reg *= f_; \
            _Pragma("unroll") for (int r = 0; r < 16; ++r) { o[0][r] *= f_; o[1][r] *= f_; } }                        \
        float sacc_ = 0.f; \
        _Pragma("unroll") for (int r = 0; r < 16; ++r) { P0[r] = __builtin_amdgcn_exp2f(P0[r] - mhat); P1[r] = __builtin_amdgcn_exp2f(P1[r] - mhat); sacc_ += P0[r] + P1[r]; } \
        l_reg += sacc_; \
        u32x4 pw_[4]; \
        _Pragma("unroll") for (int s_ = 0; s_ < 2; ++s_) { \
            pw_[s_] = (u32x4){cvtpk(P0[8 * s_], P0[8 * s_ + 1]), cvtpk(P0[8 * s_ + 2], P0[8 * s_ + 3]), cvtpk(P0[8 * s_ + 4], P0[8 * s_ + 5]), cvtpk(P0[8 * s_ + 6], P0[8 * s_ + 7])}; \
            pw_[2 + s_] = (u32x4){cvtpk(P1[8 * s_], P1[8 * s_ + 1]), cvtpk(P1[8 * s_ + 2], P1[8 * s_ + 3]), cvtpk(P1[8 * s_ + 4], P1[8 * s_ + 5]), cvtpk(P1[8 * s_ + 6], P1[8 * s_ + 7])}; } \
        const lds_cptr vp_ = vp0 + (VS); s16x4 vl_[8], vh_[8]; \
        _Pragma("unroll") for (int i_ = 0; i_ < 8; ++i_) { vl_[i_] = vtr(vp_ + (i_ >> 2) * 4096 + (i_ & 3) * 1024); vh_[i_] = vtr(vp_ + (i_ >> 2) * 4096 + (i_ & 3) * 1024 + 512); }     \
        __builtin_amdgcn_sched_barrier(0); \
        _Pragma("unroll") for (int i_ = 0; i_ < 8; ++i_) { \
            const bf16x8 vf_ = (bf16x8){vl_[i_][0], vl_[i_][1], vl_[i_][2], vl_[i_][3], vh_[i_][0], vh_[i_][1], vh_[i_][2], vh_[i_][3]}; \
            o[i_ >> 2] = __builtin_amdgcn_mfma_f32_32x32x16_bf16(vf_, __builtin_bit_cast(bf16x8, pw_[i_ & 3]), o[i_ >> 2], 0, 0, 0); } } while (0)
#define ATT_ACT(T) (MODE != 1 || (64 * (T) <= wid * 32 + 31))
#define ATT_ITER(SC0, SC1, SN0, SN1, T) do { const bool has_next_ = (T) + 1 < NT; \
        if (has_next_ && ATT_ACT((T) + 1)) ATT_QKT(SN0, SN1, ATT_KS((T) + 1)); \
        if (ATT_ACT(T)) ATT_SMPV(SC0, SC1, T, ATT_VS(T)); \
        if (has_next_ && (MODE == 0 || NT > NSLOT)) { if ((T) + 3 < NT) ATT_WAIT_BAR_N(dma3); else ATT_WAIT_BAR(); if ((T) + 4 < NT) ATT_DMA((T) + 4, ATT_KS(T), ATT_VS(T)); }   \
        } while (0)
    const bool dma3 = (MODE == 0) && wid < 4;
    if (NT > 2) ATT_DMA(2, 2 * KSLOT, 2 * VSLOT);
    if (NT > 3) ATT_DMA(3, 3 * KSLOT, 3 * VSLOT);
    if (MODE == 0 && NT > 3) ATT_WAIT_BAR_N(dma3); else ATT_WAIT_BAR();
    f32x16 pA0, pA1, pB0, pB1;
    ATT_QKT(pA0, pA1, 0);
    int t = 0;
    if (MODE == 0 && NT > 4) {
#define ATT_SB() __builtin_amdgcn_sched_barrier(0)
#define ATT_KLD(i, KS) kf[i] = *(const ATT_LAS bf16x8*)ATT_KADDR((i) >> 1, (i) & 1, KS)
#define ATT_VLD(i, VS) do { vlo[i] = vtr(vp0 + (VS) + ((i) >> 2) * 4096 + ((i) & 3) * 1024); vhi[i] = vtr(vp0 + (VS) + ((i) >> 2) * 4096 + ((i) & 3) * 1024 + 512); } while (0)
#define ATT_SCR(SC0, SC1, j) ((j) < 16 ? SC0[(j) & 15] : SC1[(j) & 15])
#define ATT_EXP4(SC0, SC1, g) do { if ((g) < 4) { _Pragma("unroll") for (int j_ = 0; j_ < 4; ++j_) SC0[4 * (g) + j_] = __builtin_amdgcn_exp2f(SC0[4 * (g) + j_]); } \
                                   else { _Pragma("unroll") for (int j_ = 0; j_ < 4; ++j_) SC1[4 * ((g) - 4) + j_] = __builtin_amdgcn_exp2f(SC1[4 * ((g) - 4) + j_]); } } while (0)
#define ATT_ADD4(SC0, SC1, g) do { if ((g) < 4) sacc_ += (SC0[4 * (g)] + SC0[4 * (g) + 1]) + (SC0[4 * (g) + 2] + SC0[4 * (g) + 3]); else sacc_ += (SC1[4 * ((g) - 4)] + SC1[4 * ((g) - 4) + 1]) + (SC1[4 * ((g) - 4) + 2] + SC1[4 * ((g) - 4) + 3]); } while (0)
#define ATT_CVT4(SC0, SC1, g) do { if ((g) < 4) { pw[(g) >> 1][2 * ((g) & 1)] = cvtpk(SC0[4 * (g)], SC0[4 * (g) + 1]); pw[(g) >> 1][2 * ((g) & 1) + 1] = cvtpk(SC0[4 * (g) + 2], SC0[4 * (g) + 3]); } \
                                   else { pw[(g) >> 1][2 * ((g) & 1)] = cvtpk(SC1[4 * ((g) - 4)], SC1[4 * ((g) - 4) + 1]); pw[(g) >> 1][2 * ((g) & 1) + 1] = cvtpk(SC1[4 * ((g) - 4) + 2], SC1[4 * ((g) - 4) + 3]); } } while (0)
#define ATT_GAPA(i, SC0, SC1, SN0, SN1) do { \
        if (((i) & 1) == 0) SN0 = __builtin_amdgcn_mfma_f32_32x32x16_bf16(kf[i], qr[(i) >> 1], SN0, 0, 0, 0); else SN1 = __builtin_amdgcn_mfma_f32_32x32x16_bf16(kf[i], qr[(i) >> 1], SN1, 0, 0, 0); \
        if ((i) < 8) { ATT_VLD(ATT_PJ(i), vs_); ATT_EXP4(SC0, SC1, i); } \
        if ((i) >= 1 && (i) <= 8) ATT_ADD4(SC0, SC1, (i) - 1); \
        if ((i) >= 2 && (i) <= 9) ATT_CVT4(SC0, SC1, (i) - 2); \
        ATT_SB(); } while (0)
#define ATT_PJ(j) ((((j) & 1) << 2) | ((j) >> 1))
#define ATT_VF(j) (bf16x8){vlo[j][0], vlo[j][1], vlo[j][2], vlo[j][3], vhi[j][0], vhi[j][1], vhi[j][2], vhi[j][3]}
#define ATT_GAPB(j, SN0, SN1) do { \
        o[ATT_PJ(j) >> 2] = __builtin_amdgcn_mfma_f32_32x32x16_bf16(ATT_VF(ATT_PJ(j)), __builtin_bit_cast(bf16x8, pw[ATT_PJ(j) & 3]), o[ATT_PJ(j) >> 2], 0, 0, 0);     \
        if ((j) < 6) { ATT_KLD(2 * (j), ks2_); ATT_KLD(2 * (j) + 1, ks2_); } \
        ATT_SB(); } while (0)
#define ATT_FAST(SC0, SC1, SN0, SN1, T) do { const int vs_ = ATT_VS(T), ks2_ = ATT_KS((T) + 2); \
        ATT_SB(); \
        float sacc_ = 0.f; \
        SN0 = __builtin_amdgcn_mfma_f32_32x32x16_bf16(kx, qx, f32x16{}, 0, 0, 0); SN1 = __builtin_amdgcn_mfma_f32_32x32x16_bf16(kx, qx, f32x16{}, 0, 0, 0);     \
        ATT_GAPA(0, SC0, SC1, SN0, SN1); ATT_GAPA(1, SC0, SC1, SN0, SN1); ATT_GAPA(2, SC0, SC1, SN0, SN1); ATT_GAPA(3, SC0, SC1, SN0, SN1); \
        ATT_GAPA(4, SC0, SC1, SN0, SN1); ATT_GAPA(5, SC0, SC1, SN0, SN1); ATT_GAPA(6, SC0, SC1, SN0, SN1); ATT_GAPA(7, SC0, SC1, SN0, SN1); \
        ATT_GAPA(8, SC0, SC1, SN0, SN1); ATT_GAPA(9, SC0, SC1, SN0, SN1); ATT_GAPA(10, SC0, SC1, SN0, SN1); ATT_GAPA(11, SC0, SC1, SN0, SN1); \
        l_reg += sacc_; \
        ATT_GAPB(0, SN0, SN1); ATT_GAPB(1, SN0, SN1); ATT_GAPB(2, SN0, SN1); ATT_GAPB(3, SN0, SN1); ATT_GAPB(4, SN0, SN1); ATT_GAPB(5, SN0, SN1); ATT_GAPB(6, SN0, SN1); ATT_GAPB(7, SN0, SN1); \
        ATT_SB(); \
        ATT_WAIT_BAR(); ATT_DMA((T) + 4, ATT_KS(T), vs_); \
        { const unsigned long long bal_ = __builtin_amdgcn_ballot_w64(sacc_ > 1048576.0f); float f_ = 1.f;     \
          if (bal_ != 0ull) { float s2_ = sacc_; { auto rr_ = __builtin_amdgcn_permlane32_swap(__float_as_uint(s2_), __float_as_uint(s2_), false, false); s2_ = fmaxf(__uint_as_float(rr_[0]), __uint_as_float(rr_[1])); }     \
            const float e_ = (s2_ > 1048576.0f) ? (float)((int)((__float_as_uint(s2_) >> 23) & 0xFFu) - 127) : 0.f; \
            const float mn_ = att_bf16_up(mhat + e_), dl_ = mn_ - mhat; f_ = __builtin_amdgcn_exp2f(-dl_); mhat = mn_; l_reg *= f_; \
            _Pragma("unroll") for (int r = 0; r < 16; ++r) { SN0[r] -= dl_; SN1[r] -= dl_; } \
            qx[0] = (hi == 0) ? (short)(__float_as_uint(-mhat) >> 16) : (short)0; } \
            \
          asm volatile("s_cmp_eq_u64 %[b], 0\n\ts_cbranch_scc1 .Lsk%=\n\ts_nop 1\n\tv_mul_f32_e32 %0, %[f], %0\n\tv_mul_f32_e32 %1, %[f], %1\n\tv_mul_f32_e32 %2, %[f], %2\n\tv_mul_f32_e32 %3, %[f], %3\n\tv_mul_f32_e32 %4, %[f], %4\n\tv_mul_f32_e32 %5, %[f], %5\n\tv_mul_f32_e32 %6, %[f], %6\n\tv_mul_f32_e32 %7, %[f], %7\n\tv_mul_f32_e32 %8, %[f], %8\n\tv_mul_f32_e32 %9, %[f], %9\n\tv_mul_f32_e32 %10, %[f], %10\n\tv_mul_f32_e32 %11, %[f], %11\n\tv_mul_f32_e32 %12, %[f], %12\n.Lsk%=:" : "+v"(o[0][0]), "+v"(o[0][1]), "+v"(o[0][2]), "+v"(o[0][3]), "+v"(o[0][4]), "+v"(o[0][5]), "+v"(o[0][6]), "+v"(o[0][7]), "+v"(o[0][8]), "+v"(o[0][9]), "+v"(o[0][10]), "+v"(o[0][11]), "+v"(o[0][12]) : [f] "v"(f_), [b] "s"(bal_) : "scc"); \
          asm volatile("s_cmp_eq_u64 %[b], 0\n\ts_cbranch_scc1 .Lsk%=\n\tv_mul_f32_e32 %0, %[f], %0\n\tv_mul_f32_e32 %1, %[f], %1\n\tv_mul_f32_e32 %2, %[f], %2\n\tv_mul_f32_e32 %3, %[f], %3\n\tv_mul_f32_e32 %4, %[f], %4\n\tv_mul_f32_e32 %5, %[f], %5\n\tv_mul_f32_e32 %6, %[f], %6\n\tv_mul_f32_e32 %7, %[f], %7\n\tv_mul_f32_e32 %8, %[f], %8\n\tv_mul_f32_e32 %9, %[f], %9\n\tv_mul_f32_e32 %10, %[f], %10\n\tv_mul_f32_e32 %11, %[f], %11\n\tv_mul_f32_e32 %12, %[f], %12\n.Lsk%=:" : "+v"(o[0][13]), "+v"(o[0][14]), "+v"(o[0][15]), "+v"(o[1][0]), "+v"(o[1][1]), "+v"(o[1][2]), "+v"(o[1][3]), "+v"(o[1][4]), "+v"(o[1][5]), "+v"(o[1][6]), "+v"(o[1][7]), "+v"(o[1][8]), "+v"(o[1][9]) : [f] "v"(f_), [b] "s"(bal_) : "scc"); \
          asm volatile("s_cmp_eq_u64 %[b], 0\n\ts_cbranch_scc1 .Lsk%=\n\tv_mul_f32_e32 %0, %[f], %0\n\tv_mul_f32_e32 %1, %[f], %1\n\tv_mul_f32_e32 %2, %[f], %2\n\tv_mul_f32_e32 %3, %[f], %3\n\tv_mul_f32_e32 %4, %[f], %4\n\tv_mul_f32_e32 %5, %[f], %5\n.Lsk%=:" : "+v"(o[1][10]), "+v"(o[1][11]), "+v"(o[1][12]), "+v"(o[1][13]), "+v"(o[1][14]), "+v"(o[1][15]) : [f] "v"(f_), [b] "s"(bal_) : "scc"); } \
        } while (0)
        bf16x8 kf[12]; s16x4 vlo[8], vhi[8]; u32x4 pw[4];
        float rm = pA0[0];
#pragma unroll
        for (int r = 1; r < 16; ++r) rm = fmaxf(rm, pA0[r]);
#pragma unroll
        for (int r = 0; r < 16; ++r) rm = fmaxf(rm, pA1[r]);
        { auto rr_ = __builtin_amdgcn_permlane32_swap(__float_as_uint(rm), __float_as_uint(rm), false, false); rm = fmaxf(__uint_as_float(rr_[0]), __uint_as_float(rr_[1])); }
        mhat = att_bf16_up(rm);
#pragma unroll
        for (int r = 0; r < 16; ++r) { pA0[r] -= mhat; pA1[r] -= mhat; }
        const bf16x8 kx = (bf16x8){(short)0x3F80, 0, 0, 0, 0, 0, 0, 0};
        bf16x8 qx = (bf16x8){0, 0, 0, 0, 0, 0, 0, 0};
        if (hi == 0) qx[0] = (short)(__float_as_uint(-mhat) >> 16);
#pragma unroll
        for (int i = 0; i < 12; ++i) ATT_KLD(i, KSLOT);
        if (wid >= 4) __builtin_amdgcn_s_setprio(1);
        for (; t + 4 < NT; t += 2) { ATT_FAST(pA0, pA1, pB0, pB1, t); ATT_FAST(pB0, pB1, pA0, pA1, t + 1); }
        if (wid >= 4) __builtin_amdgcn_s_setprio(0);
#pragma unroll
        for (int r = 0; r < 16; ++r) { pA0[r] += mhat; pA1[r] += mhat; }
#undef ATT_FAST
#undef ATT_GAPA
#undef ATT_GAPB
#undef ATT_VF
#undef ATT_PJ
#undef ATT_EXP4
#undef ATT_ADD4
#undef ATT_CVT4
#undef ATT_SCR
#undef ATT_KLD
#undef ATT_VLD
#undef ATT_SB
    }
    for (; t < NT; t += 2) {
        ATT_ITER(pA0, pA1, pB0, pB1, t);
        if (t + 1 < NT) ATT_ITER(pB0, pB1, pA0, pA1, t + 1);
    }
#undef ATT_QKT
#undef ATT_SMPV
#undef ATT_ACT
#undef ATT_ITER
    { auto rr = __builtin_amdgcn_permlane32_swap(__float_as_uint(l_reg), __float_as_uint(l_reg), false, false); l_reg = __uint_as_float(rr[0]) + __uint_as_float(rr[1]); }
    { const float rl = __builtin_amdgcn_rcpf(l_reg);
      bf16_t* prow = U.O + (size_t)(U.q0 + wid * 32 + r32) * U.o_pitch + 8 * hi;
#pragma unroll
      for (int dh = 0; dh < 2; ++dh)
#pragma unroll
        for (int jp = 0; jp < 2; ++jp) {
            unsigned a0 = cvtpk(o[dh][8 * jp] * rl, o[dh][8 * jp + 1] * rl), a1 = cvtpk(o[dh][8 * jp + 2] * rl, o[dh][8 * jp + 3] * rl);
            unsigned b0 = cvtpk(o[dh][8 * jp + 4] * rl, o[dh][8 * jp + 5] * rl), b1 = cvtpk(o[dh][8 * jp + 6] * rl, o[dh][8 * jp + 7] * rl);
            const auto s0 = __builtin_amdgcn_permlane32_swap(a0, b0, false, false); const auto s1 = __builtin_amdgcn_permlane32_swap(a1, b1, false, false);
            *(u32x4*)(prow + 32 * dh + 16 * jp) = (u32x4){s0[0], s1[0], s0[1], s1[1]}; } }
    asm volatile("s_waitcnt vmcnt(0) lgkmcnt(0)\n\ts_barrier" ::: "memory");
#undef ATT_DMA
}
}

namespace att {
constexpr int MB_REG = 65536, MB_TILE = 16384, MB_V = 8192, MB_POSK = 131072, MB_PRE = MB_POSK + 3072, MB_UT = MB_PRE + 2048, MB_NUT = 62, MB_TM = MB_UT + 1024, MB_KB = 140288, MB_ENT = MB_KB + 8192, MB_END = MB_ENT + 2048;
struct MobaCtx { const bf16_t* mqkv; const float* posf; bf16_t* part; float* plse; const unsigned* lists; const unsigned* cnt; int total, vcu, G; };
struct MobaDesc { int own, h, n; };
__device__ __forceinline__ unsigned att_bf16_rne(float f) { unsigned u = __float_as_uint(f); return (u + 0x7fffu + ((u >> 16) & 1u)) >> 16; }
__device__ __forceinline__ float att_bf2f(unsigned b) { return __uint_as_float(b << 16); }
__device__ __forceinline__ void att_split3(float c, unsigned& w1, unsigned& w2) { const unsigned c0 = att_bf16_rne(c); const float r1 = c - att_bf2f(c0); const unsigned c1 = att_bf16_rne(r1); const float r2 = r1 - att_bf2f(c1);
    w1 = c0 | (c1 << 16); w2 = att_bf16_rne(r2); }

__device__ __forceinline__ u32x4 moba_get(const MobaCtx& C, ATT_LAS const int* pre, int i) {
    const int ng = (C.vcu < C.total) ? (C.total - C.vcu + C.G - 1) / C.G : 0;
    if (i < ng) { const int gI = C.vcu + i * C.G; int lo = 0, hi = 511;
        while (lo < hi) { const int mid = (lo + hi) >> 1; if (pre[mid] > gI) hi = mid; else lo = mid + 1; }
        const int hn = lo, c = gI - (hn ? pre[hn - 1] : 0); const int len = (int)C.cnt[hn] - c * 256;
        return (u32x4){1u | ((unsigned)(hn >> 6) << 2) | ((unsigned)(hn & 63) << 5), (unsigned)(len < 256 ? len : 256), (unsigned)hn * 16384u + (unsigned)c * 256u, 0u}; }
    const int u = C.vcu + (i - ng) * C.G; if (u >= 512) return (u32x4){0u, 0u, 0u, 0u};
    return (u32x4){1u | 2u | ((unsigned)(u & 7) << 2) | ((unsigned)(u >> 3) << 5), 256u, 0u, 0u};
}
__device__ __forceinline__ void glds4(const void* gsrc, unsigned lds_dst) {
    asm volatile("s_mov_b32 m0, %1\n\ts_nop 0\n\tglobal_load_lds_dword %0, off" : : "v"(gsrc), "s"(lds_dst) : "memory", "m0"); }

template <int PROBE> __device__ __forceinline__ void moba_run(const MobaCtx& C, char* shm, const int wid) {
    const int lane = pg8::lane_id_v(), tid = wid * 64 + lane, r32 = lane & 31, hi = lane >> 5;
    const unsigned lds0 = (unsigned)(uintptr_t)shm; const lds_cptr shm3 = (lds_cptr)shm;
    ATT_LAS const int* pre = (ATT_LAS const int*)(shm3 + MB_PRE);
    const float* pmax = C.posf + 16384;
    const int km_ = (r32 >> 1) & 7;
    const int ka0 = r32 * 128 + 32 * (km_ >> 1) + 16 * (hi ^ (km_ & 1));
    const int vpl = MB_V + ((lane >> 4) & 1) * 32 + (lane & 3) * 8 + (4 * hi + ((lane & 15) >> 2)) * 64;
    const unsigned koff = (unsigned)((8 * wid + (lane >> 3)) * 1536 + (((lane & 7) ^ ((4 * wid + (lane >> 4)) & 7)) * 8)) * 2u;
    const unsigned voff = (unsigned)((16 * (wid & 3) + (lane >> 2)) * 1536 + (wid >> 2) * 32 + (lane & 3) * 8) * 2u;
#define MB_UNPACK(X_, D_) do { (D_).own = (int)(((X_) >> 1) & 1u); (D_).h = (int)(((X_) >> 2) & 7u); (D_).n = (PROBE & 4) ? 0 : (int)((X_) >> 5); } while (0)
#define MB_DMA(D_, R_) do { const char* kb_ = (const char*)(C.mqkv + 512 + (D_).h * 64 + (size_t)(D_).n * 256 * 1536); const char* vb_ = kb_ + 1024; \
        unsigned db_ = (unsigned)(lds0 + (R_) + wid * 1024); asm volatile("" : "+s"(db_));     \
        _Pragma("unroll") for (int t_ = 0; t_ < 4; ++t_) { glds16(kb_ + koff + (size_t)t_ * (64 * 1536 * 2), db_ + t_ * MB_TILE); \
                                                           glds16(vb_ + voff + (size_t)t_ * (64 * 1536 * 2), db_ + t_ * MB_TILE + MB_V); } } while (0)
#define MB_FETCH(I_, E_, X_) do { E_ = ((const ATT_LAS u32x4*)(shm3 + MB_UT))[(I_)]; X_ = (unsigned)__builtin_amdgcn_readfirstlane((int)E_[0]); } while (0)
#define MB_SMALL(U_, E_, D_) do { \
        if (!(D_).own) { const int e = wid * 32 + r32; if (hi == 0 && e < (int)E_[1]) glds4(C.lists + E_[2] + e, (unsigned)(lds0 + MB_ENT + ((U_) & 1) * 1024 + wid * 128)); } \
        if (wid < 4) glds4(C.posf + (D_).n * 256 + tid, (unsigned)(lds0 + MB_POSK + ((U_) % 3) * 1024 + wid * 256)); \
        if (tid < 4) glds4(pmax + 4 * (D_).n + tid, (unsigned)(lds0 + MB_TM + ((U_) % 3) * 16)); } while (0)
#define MB_STAGE(U_, D_) do { if (tid < 256) { const ATT_LAS float* pp_ = (const ATT_LAS float*)(shm3 + MB_POSK + ((U_) % 3) * 1024); \
            const float v_ = exp2f(-(float)((D_).h + 1)) * 1.4426950408889634f * (pp_[tid] - pp_[0]); const unsigned vh_ = att_bf16_rne(v_), vl_ = att_bf16_rne(v_ - att_bf2f(vh_)); \
            ((ATT_LAS u32x4*)(shm3 + MB_KB + ((U_) & 1) * 4096))[tid] = (u32x4){vh_ | (vl_ << 16), 0x3F803F80u, 0x00003F80u, 0u}; } } while (0)
#define MB_QROW(U_, E_, D_, META_, QR_, PQ_) do { const int e_ = wid * 32 + r32; \
        if ((D_).own) META_ = (((D_).n * 256 + e_) << 2); \
        else { const unsigned en_ = ((const ATT_LAS unsigned*)(shm3 + MB_ENT + ((U_) & 1) * 1024))[e_]; META_ = (e_ < (int)E_[1]) ? (int)(((en_ & 0x3FFFu) << 2) | (1u + ((en_ >> 14) & 3u))) : -1; } \
        const int qr_ = (PROBE & 4) ? (16128 + e_) : ((META_) >= 0 ? ((META_) >> 2) : 0); const bf16_t* Qw_ = C.mqkv + (D_).h * 64 + (size_t)qr_ * 1536 + hi * 8; \
        _Pragma("unroll") for (int d0 = 0; d0 < 4; ++d0) QR_[d0] = *reinterpret_cast<const bf16x8*>(Qw_ + d0 * 16); PQ_ = C.posf[qr_]; } while (0)
#define MB_CHEAP(U_, D_, META_, PQ_, CM_) do { const f32x4 tm_ = *(const ATT_LAS f32x4*)(shm3 + MB_TM + ((U_) % 3) * 16); CM_ = 0; \
        _Pragma("unroll") for (int t_ = 0; t_ < 4; ++t_) { bool ok_ = __all((META_) < 0 || (PQ_) >= tm_[t_]); if ((D_).own) ok_ = ok_ && (64 * t_ + 63 <= wid * 32); if (ok_) CM_ |= 1 << t_; } } while (0)
  for (int base = 0; ; base += MB_NUT) {
    __syncthreads();
    if (tid < MB_NUT) ((ATT_LAS u32x4*)(shm3 + MB_UT))[tid] = moba_get(C, pre, base + tid);
    if (tid == MB_NUT || tid == MB_NUT + 1) ((ATT_LAS u32x4*)(shm3 + MB_UT))[tid] = (u32x4){0u, 0u, 0u, 0u};
    __syncthreads();
    u32x4 ent_; unsigned xc, xn, xnn = 0u; MobaDesc D, Dn;
    MB_FETCH(0, ent_, xc);
    if (!(xc & 1u)) break;
    MB_UNPACK(xc, D);
    MB_DMA(D, 0); MB_SMALL(0, ent_, D);
    { u32x4 e1_; MB_FETCH(1, e1_, xn); MB_UNPACK(xn, Dn); if (xn & 1u) MB_SMALL(1, e1_, Dn); }
    asm volatile("" ::: "memory"); __builtin_amdgcn_s_waitcnt(0); __builtin_amdgcn_s_barrier(); asm volatile("" ::: "memory");
    int meta = -1, cm = 0; float pq = 0.f, pbase = 0.f; bf16x8 qr[4];
    MB_STAGE(0, D); MB_QROW(0, ent_, D, meta, qr, pq);
    pbase = ((const ATT_LAS float*)(shm3 + MB_POSK))[0];
    asm volatile("" ::: "memory"); __builtin_amdgcn_s_waitcnt(0); __builtin_amdgcn_s_barrier(); asm volatile("" ::: "memory");
    MB_CHEAP(0, D, meta, pq, cm);
    if (xn & 1u) MB_DMA(Dn, MB_REG);
    int i = 0;
    for (; xc & 1u; ++i) {
        int meta_n = -1; float pq_n = 0.f;
        MB_UNPACK(xn, Dn);
        const int cur = i & 1, rb = cur * MB_REG; const float slope2 = exp2f(-(float)(D.h + 1)) * 1.4426950408889634f;
        const bool valid = meta >= 0; const int qrow = valid ? (meta >> 2) : 0, slot = meta & 3;
        const ATT_LAS float* posk = (const ATT_LAS float*)(shm3 + MB_POSK + (i % 3) * 1024);
        const lds_cptr kbx = shm3 + MB_KB + cur * 4096 + r32 * 16;
        float mhat = 0.f, l_reg = 0.f; bool first_ = true; f32x16 o[2]; o[0] = f32x16{}; o[1] = f32x16{};
        unsigned qxa0 = 0u, qxa1 = 0u, qxa2 = 0u, qxr1 = 0u, qxr2 = 0u;
#define MB_QX() do { unsigned a1_, a2_, r1_, r2_; att_split3(-slope2 * (pq - pbase) - mhat, a1_, a2_); att_split3(-mhat, r1_, r2_); \
            qxa0 = hi == 0 ? 0x3F803F80u : 0u; qxa1 = hi == 0 ? a1_ : 0u; qxa2 = hi == 0 ? a2_ : 0u; qxr1 = hi == 0 ? r1_ : 0u; qxr2 = hi == 0 ? r2_ : 0u; } while (0)
        MB_QX();
        f32x16 pA0, pA1, pB0, pB1; float mA = 0.f, mB = 0.f;
#define MB_ACT(T) (!D.own || (64 * (T) <= wid * 32 + 31))
#define MB_CH(T) ((cm >> (T)) & 1)
#define MB_QKT(P0, P1, MR, T) do { bf16x8 kk_[8]; const lds_cptr kb_ = shm3 + rb + (T) * MB_TILE; \
            const bf16x8 kx0_ = *(const ATT_LAS bf16x8*)(kbx + (T) * 1024), kx1_ = *(const ATT_LAS bf16x8*)(kbx + (T) * 1024 + 512); \
            _Pragma("unroll") for (int d0 = 0; d0 < 4; ++d0) { kk_[2 * d0] = *(const ATT_LAS bf16x8*)(kb_ + (ka0 ^ (d0 << 5))); kk_[2 * d0 + 1] = *(const ATT_LAS bf16x8*)(kb_ + (ka0 ^ (d0 << 5)) + 4096); } \
            const bool ch_ = MB_CH(T); const u32x4 qs_ = (u32x4){ch_ ? qxa0 : 0u, ch_ ? qxa1 : qxr1, ch_ ? qxa2 : qxr2, 0u}; \
            __builtin_amdgcn_sched_barrier(0); \
            P0 = __builtin_amdgcn_mfma_f32_32x32x16_bf16(kx0_, __builtin_bit_cast(bf16x8, qs_), f32x16{}, 0, 0, 0); P1 = __builtin_amdgcn_mfma_f32_32x32x16_bf16(kx1_, __builtin_bit_cast(bf16x8, qs_), f32x16{}, 0, 0, 0); \
            _Pragma("unroll") for (int d0 = 0; d0 < 4; ++d0) { P0 = __builtin_amdgcn_mfma_f32_32x32x16_bf16(kk_[2 * d0], qr[d0], P0, 0, 0, 0); P1 = __builtin_amdgcn_mfma_f32_32x32x16_bf16(kk_[2 * d0 + 1], qr[d0], P1, 0, 0, 0); } \
            MR = mhat; } while (0)
#define MB_SMPV(P0, P1, MC, T) do { \
            if (__any(MC != mhat)) { const float d_ = mhat - MC; _Pragma("unroll") for (int r = 0; r < 16; ++r) { P0[r] -= d_; P1[r] -= d_; } }     \
            if (!MB_CH(T)) { const ATT_LAS float* pk_ = posk + 64 * (T) + 4 * hi; \
                _Pragma("unroll") for (int g = 0; g < 4; ++g) { const f32x4 a_ = *(const ATT_LAS f32x4*)(pk_ + 8 * g), b_ = *(const ATT_LAS f32x4*)(pk_ + 8 * g + 32); \
                    _Pragma("unroll") for (int j = 0; j < 4; ++j) { P0[4 * g + j] -= slope2 * __builtin_fabsf(pq - a_[j]); P1[4 * g + j] -= slope2 * __builtin_fabsf(pq - b_[j]); } } } \
            if (D.own && 64 * (T) + 63 > wid * 32) { int dq_ = wid * 32 + r32 - 64 * (T) - 4 * hi; asm volatile("" : "+v"(dq_));     \
                _Pragma("unroll") for (int r = 0; r < 16; ++r) { const int c_ = (r & 3) + 8 * (r >> 2); if (c_ > dq_) P0[r] = -INFINITY; if (c_ + 32 > dq_) P1[r] = -INFINITY; } } \
            float rm_ = P0[0]; \
            _Pragma("unroll") for (int r = 1; r < 16; ++r) rm_ = fmaxf(rm_, P0[r]); \
            _Pragma("unroll") for (int r = 0; r < 16; ++r) rm_ = fmaxf(rm_, P1[r]); \
            { auto rr_ = __builtin_amdgcn_permlane32_swap(__float_as_uint(rm_), __float_as_uint(rm_), false, false); rm_ = fmaxf(__uint_as_float(rr_[0]), __uint_as_float(rr_[1])); } \
            if (first_ || __any(rm_ > 10.0f)) { const float dl_ = first_ ? rm_ : fmaxf(rm_, 0.f); mhat += dl_; \
                _Pragma("unroll") for (int r = 0; r < 16; ++r) { P0[r] -= dl_; P1[r] -= dl_; } \
                if (!first_) { const float f_ = __builtin_amdgcn_exp2f(-dl_); l_reg *= f_; \
                    _Pragma("unroll") for (int r = 0; r < 16; ++r) { o[0][r] *= f_; o[1][r] *= f_; } }                        \
                first_ = false; MB_QX(); } \
            _Pragma("unroll") for (int r = 0; r < 16; ++r) { P0[r] = __builtin_amdgcn_exp2f(P0[r]); P1[r] = __builtin_amdgcn_exp2f(P1[r]); } \
            { float sa_ = 0.f;     \
              _Pragma("unroll") for (int r = 0; r < 16; ++r) { sa_ += P0[r]; sa_ += P1[r]; } \
              l_reg += sa_; } \
            u32x4 pw_[4]; \
            _Pragma("unroll") for (int s_ = 0; s_ < 2; ++s_) { \
                pw_[s_] = (u32x4){cvtpk(P0[8 * s_], P0[8 * s_ + 1]), cvtpk(P0[8 * s_ + 2], P0[8 * s_ + 3]), cvtpk(P0[8 * s_ + 4], P0[8 * s_ + 5]), cvtpk(P0[8 * s_ + 6], P0[8 * s_ + 7])}; \
                pw_[2 + s_] = (u32x4){cvtpk(P1[8 * s_], P1[8 * s_ + 1]), cvtpk(P1[8 * s_ + 2], P1[8 * s_ + 3]), cvtpk(P1[8 * s_ + 4], P1[8 * s_ + 5]), cvtpk(P1[8 * s_ + 6], P1[8 * s_ + 7])}; } \
            const lds_cptr vp_ = shm3 + rb + (T) * MB_TILE + vpl; s16x4 vl_[8], vh_[8]; \
            _Pragma("unroll") for (int i_ = 0; i_ < 8; ++i_) { vl_[i_] = vtr(vp_ + (i_ >> 2) * 4096 + (i_ & 3) * 1024); vh_[i_] = vtr(vp_ + (i_ >> 2) * 4096 + (i_ & 3) * 1024 + 512); } \
            __builtin_amdgcn_sched_barrier(0); \
            _Pragma("unroll") for (int i_ = 0; i_ < 8; ++i_) { \
                const bf16x8 vf_ = (bf16x8){vl_[i_][0], vl_[i_][1], vl_[i_][2], vl_[i_][3], vh_[i_][0], vh_[i_][1], vh_[i_][2], vh_[i_][3]}; \
                o[i_ >> 2] = __builtin_amdgcn_mfma_f32_32x32x16_bf16(vf_, __builtin_bit_cast(bf16x8, pw_[i_ & 3]), o[i_ >> 2], 0, 0, 0); } } while (0)
        if (!(PROBE & 1)) {
        if (MB_ACT(3)) MB_QKT(pA0, pA1, mA, 3);
        if (MB_ACT(2)) MB_QKT(pB0, pB1, mB, 2);
        if (MB_ACT(3)) MB_SMPV(pA0, pA1, mA, 3);
        }
        if (xn & 1u) { MB_STAGE(i + 1, Dn);
            MB_FETCH(i + 2, ent_, xnn); if (xnn & 1u) { MobaDesc Dnn; MB_UNPACK(xnn, Dnn); MB_SMALL(i + 2, ent_, Dnn); } } else xnn = 0u;
        if (!(PROBE & 1)) {
        if (!(PROBE & 64)) if (MB_ACT(1)) MB_QKT(pA0, pA1, mA, 1);
        if (MB_ACT(2)) MB_SMPV(pB0, pB1, mB, 2);
        if (!(PROBE & 64)) MB_QKT(pB0, pB1, mB, 0);
        }
        if (xn & 1u) { MB_FETCH(i + 1, ent_, xn); MB_QROW(i + 1, ent_, Dn, meta_n, qr, pq_n); }
        if (!(PROBE & 1)) {
        if (!(PROBE & 64)) if (MB_ACT(1)) MB_SMPV(pA0, pA1, mA, 1);
        if (!(PROBE & 64)) MB_SMPV(pB0, pB1, mB, 0);
        }
#undef MB_QKT
#undef MB_SMPV
#undef MB_ACT
#undef MB_CH
#undef MB_QX
        asm volatile("" ::: "memory"); __builtin_amdgcn_s_waitcnt(0); __builtin_amdgcn_s_barrier(); asm volatile("" ::: "memory");
        const int h_o = D.h; const bool valid_o = valid; const int qrow_o = qrow, slot_o = slot;
        xc = xn; xn = xnn; D = Dn; meta = meta_n; pq = pq_n;
        if (xc & 1u) { pbase = ((const ATT_LAS float*)(shm3 + MB_POSK + ((i + 1) % 3) * 1024))[0]; MB_CHEAP(i + 1, D, meta, pq, cm); }
        if (xn & 1u) { MobaDesc Dt; MB_UNPACK(xn, Dt); MB_DMA(Dt, cur * MB_REG); }
        { auto rr = __builtin_amdgcn_permlane32_swap(__float_as_uint(l_reg), __float_as_uint(l_reg), false, false); l_reg = __uint_as_float(rr[0]) + __uint_as_float(rr[1]); }
        { const float rl = __builtin_amdgcn_rcpf(l_reg);
          bf16_t* prow = C.part + ((((size_t)(qrow_o * 8 + h_o) * 4 + slot_o) * 64) & (PROBE ? ((PROBE & 4) ? (size_t)0x3FFC0 : (size_t)0x7FFFC0) : ~(size_t)0)) + 8 * hi;
#pragma unroll
          for (int dh = 0; dh < 2; ++dh)
#pragma unroll
            for (int jp = 0; jp < 2; ++jp) {
                unsigned a0 = cvtpk(o[dh][8 * jp] * rl, o[dh][8 * jp + 1] * rl), a1 = cvtpk(o[dh][8 * jp + 2] * rl, o[dh][8 * jp + 3] * rl);
                unsigned b0 = cvtpk(o[dh][8 * jp + 4] * rl, o[dh][8 * jp + 5] * rl), b1 = cvtpk(o[dh][8 * jp + 6] * rl, o[dh][8 * jp + 7] * rl);
                const auto s0 = __builtin_amdgcn_permlane32_swap(a0, b0, false, false); const auto s1 = __builtin_amdgcn_permlane32_swap(a1, b1, false, false);
                if (!(PROBE & 2)) if (valid_o) *(u32x4*)(prow + 32 * dh + 16 * jp) = (u32x4){s0[0], s1[0], s0[1], s1[1]}; }
          if (!(PROBE & 2)) if (hi == 0 && valid_o) C.plse[(size_t)(qrow_o * 8 + h_o) * 4 + slot_o] = mhat + __builtin_log2f(l_reg); }
    }
    if (i < MB_NUT) break;
  }
#undef MB_UNPACK
#undef MB_DMA
#undef MB_FETCH
#undef MB_SMALL
#undef MB_STAGE
#undef MB_QROW
#undef MB_CHEAP
}
}

namespace xb {
#define LAS __attribute__((address_space(3)))
#define XB_TMO      128
#define XB_XCNT(j)  (256  + 64 * (j))
#define XB_XSUB(j)  (1280 + 64 * (j))
#define XB_XGEN(j)  (2304 + 64 * (j))
#define XB_TOP      3328
#define XB_TOPGEN   3392
#define XCD_BAR_WORDS 3456
#define XB_SPIN_CAP (1u << 21)

__device__ __forceinline__ unsigned xb_ld(unsigned* p)              { return __hip_atomic_load(p, __ATOMIC_RELAXED, __HIP_MEMORY_SCOPE_AGENT); }
__device__ __forceinline__ unsigned xb_add(unsigned* p, unsigned v) { return __hip_atomic_fetch_add(p, v, __ATOMIC_RELAXED, __HIP_MEMORY_SCOPE_AGENT); }
__device__ __forceinline__ unsigned xb_xcc_id() { return (unsigned)__builtin_amdgcn_s_getreg((3 << 11) | 20) & 0xFu; }
#define XB_SPIN(cond, bar) do { unsigned _sp = 0; while (cond) { __builtin_amdgcn_s_sleep(1); \
    if ((++_sp & 255u) == 0u) { if (xb_ld(&(bar)[XB_TMO])) break; if (_sp > XB_SPIN_CAP) { atomicAdd(&(bar)[XB_TMO], 1u); break; } } } } while (0)

struct XcdBarrier {
    unsigned* bar; unsigned x;
    volatile LAS unsigned* st;
};

__device__ __forceinline__ XcdBarrier xcd_barrier_post(unsigned* bar, volatile LAS unsigned* st, bool leader) {
    XcdBarrier b; b.bar = bar; b.x = xb_xcc_id(); b.st = st;
    if (leader) (void)xb_add(&bar[XB_XCNT(b.x)], 1u);
    return b;
}
__device__ __forceinline__ void xcd_barrier_complete(unsigned* bar, unsigned x, unsigned& nloc, unsigned& nx) {
    const unsigned G = gridDim.x * gridDim.y * gridDim.z;
    unsigned sum, cnt, mine, sp = 0u;
    for (;;) {
        sum = 0u; cnt = 0u; mine = 0u;
#pragma unroll
        for (unsigned j = 0; j < 16; ++j) { const unsigned c = xb_ld(&bar[XB_XCNT(j)]); sum += c; cnt += (c > 0u) ? 1u : 0u; mine = (j == x) ? c : mine; }
        if (sum == G) break;
        __builtin_amdgcn_s_sleep(1);
        if ((++sp & 255u) == 0u) { if (xb_ld(&bar[XB_TMO])) break; if (sp > XB_SPIN_CAP) { atomicAdd(&bar[XB_TMO], 1u); break; } }
    }
    nloc = mine > 0u ? mine : 1u; nx = cnt > 0u ? cnt : 1u;
}

__device__ __forceinline__ void xcd_barrier(const XcdBarrier& b, bool leader) {
    asm volatile("s_waitcnt vmcnt(0)" ::: "memory");
    __syncthreads();
    if (leader) {
        unsigned* bar = b.bar;
        __builtin_amdgcn_s_waitcnt(0);
        unsigned nloc = b.st[0], nx = b.st[1];
        if (nloc == 0u) { xcd_barrier_complete(bar, b.x, nloc, nx); b.st[0] = nloc; b.st[1] = nx; }
        const unsigned old = xb_add(&bar[XB_XSUB(b.x)], 1u);
        const unsigned gen = old / nloc;
        if (old + 1u == (gen + 1u) * nloc) {
            __builtin_amdgcn_fence(__ATOMIC_RELEASE, "agent");
            asm volatile("s_waitcnt vmcnt(0)" ::: "memory");
            const unsigned og = xb_add(&bar[XB_TOP], 1u);
            const unsigned tg = og / nx;
            if (og + 1u == (tg + 1u) * nx) xb_add(&bar[XB_TOPGEN], 1u);
            else XB_SPIN(xb_ld(&bar[XB_TOPGEN]) == tg, bar);
            __builtin_amdgcn_fence(__ATOMIC_ACQUIRE, "agent");
            xb_add(&bar[XB_XGEN(b.x)], 1u);
            asm volatile("s_waitcnt vmcnt(0)" ::: "memory");
        } else {
            XB_SPIN(xb_ld(&bar[XB_XGEN(b.x)]) == gen, bar);
            __builtin_amdgcn_fence(__ATOMIC_ACQUIRE, "agent");
            asm volatile("s_waitcnt vmcnt(0)" ::: "memory");
        }
    }
    __syncthreads();
}

#undef LAS
}
namespace mk {
typedef unsigned short bf16;
typedef unsigned v4u __attribute__((ext_vector_type(4)));
typedef float f32x4 __attribute__((ext_vector_type(4)));
#define MK_LAS __attribute__((address_space(3)))
using namespace mkc;
constexpr int NWAVES = 8;
constexpr int RING_BYTES = 131072, LDS_EXTRA = RING_BYTES, LDS_MISC = RING_BYTES + 8192, LDS_BYTES = 150528;
constexpr size_t WS_BAR = 4096, BAR_BYTES = 32768;

struct Args { const float* in[18]; float* out; unsigned char* ws; int ph_lo, ph_hi; };
struct Frame { MK_LAS unsigned char* lds; int tid, lane, wave, vcu, G; };
typedef const __attribute__((address_space(4))) Args* kargs_t;
__device__ __forceinline__ kargs_t kargs() { kargs_t p = (kargs_t)__builtin_amdgcn_kernarg_segment_ptr(); asm volatile("" : "+s"(p)); return p; }
__device__ __forceinline__ Frame mkframe(MK_LAS unsigned char* lds, int wave) { Frame F; F.lds = lds; F.wave = wave; F.lane = pg8::lane_id_v(); F.tid = wave * 64 + F.lane; F.G = gridDim.x;
    { const int bx = blockIdx.x; F.vcu = (F.G % 8 == 0) ? (bx % 8) * (F.G / 8) + bx / 8 : bx; } return F; }

__device__ __forceinline__ unsigned f2bf(float f) { unsigned u = __builtin_bit_cast(unsigned, f); return (u + 0x7fffu + ((u >> 16) & 1u)) >> 16; }
__device__ __forceinline__ unsigned pk2(float lo, float hi) { return f2bf(lo) | (f2bf(hi) << 16); }
__device__ __forceinline__ float bf2f(unsigned short b) { return __builtin_bit_cast(float, (unsigned)b << 16); }
__device__ __forceinline__ float wave_sum(float v) {
#pragma unroll
    for (int o = 1; o < 64; o <<= 1) v += __shfl_xor(v, o);
    return v;
}
__constant__ float ROPE_INV[16] = {1.000000000e+00f, 5.623413324e-01f, 3.162277639e-01f, 1.778279394e-01f, 1.000000015e-01f, 5.623413250e-02f, 3.162277490e-02f, 1.778279431e-02f,
                                   9.999999776e-03f, 5.623413250e-03f, 3.162277630e-03f, 1.778279431e-03f, 1.000000047e-03f, 5.623413017e-04f, 3.162277571e-04f, 1.778279402e-04f};
__device__ __forceinline__ int rope_phys(int L) { return L < 16 ? 8 * (L >> 2) + (L & 3) : 8 * ((L - 16) >> 2) + 4 + ((L - 16) & 3); }

__device__ __forceinline__ void p0_item(const float* W, int K, int N, bf16* WT, const float* gain, int kind, MK_LAS float* scr, int item, int lane) {
    const int nblk = N / 32, kb = item / nblk, nb = item % nblk, k0 = 64 * kb, n0 = 32 * nb;
    int dbase = n0; bool perm = false; float mul = 1.0f;
    if (kind == 1) dbase = (n0 >> 7) * 256 + (n0 & 127);
    else if (kind == 2) dbase = (n0 >> 7) * 256 + 128 + (n0 & 127);
    else if (kind == 3) { if (n0 == 640) perm = true; else if (n0 >= 672) { dbase = n0 + 96; if (n0 < 1184) mul = C2M; } }
    else if (kind == 4) { perm = (n0 % 96) == 64; mul = C2Q; }
    else if (kind == 5) { const int h = n0 >> 7, e = n0 & 127; dbase = e < 64 ? h * 64 + e : 512 + h * 64 + (e - 64); }
    float wv[32];
#pragma unroll
    for (int i = 0; i < 32; ++i) wv[i] = W[(size_t)(k0 + 2 * i + (lane >> 5)) * N + n0 + (lane & 31)];
#pragma unroll
    for (int i = 0; i < 32; ++i) { const int kk = 2 * i + (lane >> 5); const float g = gain ? gain[k0 + kk] * mul : mul; scr[kk * 33 + (lane & 31)] = wv[i] * g; }
    asm volatile("s_waitcnt lgkmcnt(0)" ::: "memory");
    const int c = lane & 7;
#pragma unroll
    for (int j = 0; j < 4; ++j) { const int n = (lane >> 3) + 8 * j; const MK_LAS float* s = scr + (8 * c) * 33 + n;
        v4u o; o.x = pk2(s[0 * 33], s[1 * 33]); o.y = pk2(s[2 * 33], s[3 * 33]); o.z = pk2(s[4 * 33], s[5 * 33]); o.w = pk2(s[6 * 33], s[7 * 33]);
        const int drow = dbase + (perm ? rope_phys(n) : n);
        *(v4u*)(WT + (size_t)drow * K + k0 + 8 * c) = o; }
    asm volatile("s_waitcnt lgkmcnt(0)" ::: "memory");
}
constexpr int I_G = (DM / 64) * (DFF / 32), I_D = (DFF / 64) * (DM / 32), I_IN = (DM / 64) * (2208 / 32), I_UQ = (384 / 64) * (768 / 32), I_UKV = (256 / 64) * (1024 / 32), I_O = (DM / 64) * (DM / 32);
constexpr int NITEMS = 4 * I_G + 2 * I_D + I_IN + I_UQ + I_UKV + I_O;
__device__ __forceinline__ void p0_one_item(kargs_t ap, unsigned char* ws, MK_LAS float* scr, int it, int lane) {
    int r = it;
    if (r < I_G) { p0_item(ap->in[3], DM, DFF, (bf16*)(ws + WS_WGU1), ap->in[2], 1, scr, r, lane); return; } r -= I_G;
    if (r < I_G) { p0_item(ap->in[4], DM, DFF, (bf16*)(ws + WS_WGU1), ap->in[2], 2, scr, r, lane); return; } r -= I_G;
    if (r < I_D) { p0_item(ap->in[5], DFF, DM, (bf16*)(ws + WS_WD1), nullptr, 0, scr, r, lane); return; } r -= I_D;
    if (r < I_G) { p0_item(ap->in[14], DM, DFF, (bf16*)(ws + WS_WGU2), ap->in[13], 1, scr, r, lane); return; } r -= I_G;
    if (r < I_G) { p0_item(ap->in[15], DM, DFF, (bf16*)(ws + WS_WGU2), ap->in[13], 2, scr, r, lane); return; } r -= I_G;
    if (r < I_D) { p0_item(ap->in[16], DFF, DM, (bf16*)(ws + WS_WD2), nullptr, 0, scr, r, lane); return; } r -= I_D;
    if (r < I_IN) { p0_item(ap->in[7], DM, 2208, (bf16*)(ws + WS_WIN), ap->in[6], 3, scr, r, lane); return; } r -= I_IN;
    if (r < I_UQ) { p0_item(ap->in[9], 384, 768, (bf16*)(ws + WS_WUQ), ap->in[8], 4, scr, r, lane); return; } r -= I_UQ;
    if (r < I_UKV) { p0_item(ap->in[11], 256, 1024, (bf16*)(ws + WS_WUKV), ap->in[10], 5, scr, r, lane); return; } r -= I_UKV;
    p0_item(ap->in[12], DM, DM, (bf16*)(ws + WS_WOUT), nullptr, 0, scr, r, lane);
}
__device__ __forceinline__ void p0_tables_and_zero(kargs_t ap, const int gt, const int NGT) {
    unsigned char* ws = ap->ws;
    const int* pos = (const int*)ap->in[1]; float* posf = (float*)(ws + WS_POSF); float* cosT = (float*)(ws + WS_COS); float* sinT = (float*)(ws + WS_SIN);
    for (int e = gt; e < S * 16; e += NGT) { const int s_ = e >> 4, i = e & 15; const float ang = (float)pos[s_] * ROPE_INV[i]; float sn, cs; sincosf(ang, &sn, &cs); cosT[e] = cs; sinT[e] = sn; if (i == 0) posf[s_] = (float)pos[s_]; }
    for (int e = gt >> 6; e < S / 64; e += NGT >> 6) { int m_ = pos[64 * e + (gt & 63)];
#pragma unroll
        for (int o_ = 1; o_ < 64; o_ <<= 1) m_ = max(m_, __shfl_xor(m_, o_)); if ((gt & 63) == 0) posf[S + e] = (float)m_; }
    float* z = (float*)(ws + WS_SS2);
    for (int e = gt; e < 5 * S; e += NGT) z[e] = 0.f;
    float* km = (float*)(ws + WS_KMS);
    for (int e = gt; e < 64 * 512; e += NGT) km[e] = 0.f;
    unsigned* cnt = (unsigned*)(ws + WS_CNT);
    for (int e = gt; e < 512; e += NGT) cnt[e] = 0u;
    unsigned* padz = (unsigned*)((bf16*)(ws + WS_WIN) + (size_t)672 * DM);
    for (int e = gt; e < 96 * DM / 2; e += NGT) padz[e] = 0u;
}
__device__ __forceinline__ void p0_late_items(const Frame& F, kargs_t ap) {
    unsigned char* ws = ap->ws; MK_LAS float* scr = (MK_LAS float*)(F.lds + F.wave * 16384);
    const int w = ((int)blockIdx.x - 128) * NWAVES + F.wave, NW_ = 128 * NWAVES;
    for (int it = 2 * I_G + w; it < NITEMS; it += NW_) p0_one_item(ap, ws, scr, it, F.lane);
    p0_tables_and_zero(ap, w * 64 + F.lane, NW_ * 64);
}
__device__ __forceinline__ void p0_prologue(const Frame& F, kargs_t ap) {
    unsigned char* ws = ap->ws;
    MK_LAS float* scr = (MK_LAS float*)(F.lds + F.wave * 16384);
    const int gw = F.vcu * NWAVES + F.wave, NGW = F.G * NWAVES;
    constexpr int N_EARLY = 2 * I_G;
    const int n_here = (F.G == 256) ? N_EARLY : NITEMS;
    for (int it = gw; it < n_here; it += NGW) p0_one_item(ap, ws, scr, it, F.lane);
    const float* x = ap->in[0]; bf16* xb = (bf16*)(ws + WS_XB); float* ss1 = (float*)(ws + WS_SS1);
    for (int m = gw; m < S; m += 4 * NGW) {
        f32x4 v[4][4];
#pragma unroll
        for (int r = 0; r < 4; ++r) { const int mr = m + r * NGW; if (mr < S) { const f32x4* xr = (const f32x4*)(x + (size_t)mr * DM) + F.lane;
#pragma unroll
            for (int j = 0; j < 4; ++j) v[r][j] = xr[64 * j]; } }
#pragma unroll
        for (int r = 0; r < 4; ++r) { const int mr = m + r * NGW; if (mr < S) { unsigned long long* o8 = (unsigned long long*)(xb + (size_t)mr * DM) + F.lane; float s = 0.f;
#pragma unroll
            for (int j = 0; j < 4; ++j) { const f32x4 w = v[r][j]; s += (w[0] * w[0] + w[1] * w[1]) + (w[2] * w[2] + w[3] * w[3]); o8[64 * j] = (unsigned long long)pk2(w[0], w[1]) | ((unsigned long long)pk2(w[2], w[3]) << 32); }
            s = wave_sum(s); if (F.lane == 0) ss1[mr] = s; } }
    }
    if (F.G != 256) p0_tables_and_zero(ap, (F.vcu * NWAVES + F.wave) * 64 + F.lane, NGW * 64);
}

__device__ __forceinline__ void p4_krope(const Frame& F, kargs_t ap) { unsigned char* const wsb = ap->ws;
    const bf16* cqkv = (const bf16*)(wsb + WS_CQKV); bf16* Kr = (bf16*)(wsb + WS_KR); const float* cosT = (const float*)(wsb + WS_COS); const float* sinT = (const float*)(wsb + WS_SIN);
    const int gt = (F.vcu * NWAVES + F.wave) * 64 + F.lane, NGT = F.G * NWAVES * 64;
    for (int e = gt; e < S * 16; e += NGT) { const int s_ = e >> 4, i = e & 15, g = i >> 2, j = i & 3;
        const float x1 = bf2f(cqkv[(size_t)s_ * 768 + 640 + 8 * g + j]), x2 = bf2f(cqkv[(size_t)s_ * 768 + 640 + 8 * g + 4 + j]); const float c = cosT[e], sn = sinT[e];
        Kr[(size_t)s_ * 32 + 8 * g + j] = (bf16)f2bf(x1 * c - x2 * sn); Kr[(size_t)s_ * 32 + 8 * g + 4 + j] = (bf16)f2bf(x1 * sn + x2 * c); }
}
__device__ __forceinline__ void p4_gating(const Frame& F, kargs_t ap) { unsigned char* const wsb = ap->ws;
    const bf16* mqkv = (const bf16*)(wsb + WS_MQKV); const float* kms = (const float*)(wsb + WS_KMS); unsigned* cnt = (unsigned*)(wsb + WS_CNT); unsigned* lists = (unsigned*)(wsb + WS_LIST);
    MK_LAS float* km = (MK_LAS float*)F.lds;
    const int u0 = (F.G == 256) ? ((int)blockIdx.x < 192 ? (int)blockIdx.x : 256) : F.vcu, ustep = (F.G == 256) ? 192 : F.G;
    for (int u = u0; u < 256; u += ustep) {
        const int h = u & 7, q = (u >> 3) * 512 + F.tid, own = q >> 8;
        __syncthreads();
        for (int e = F.tid; e < 4096; e += 512) km[e] = kms[(size_t)(e >> 6) * 512 + h * 64 + (e & 63)] * (1.0f / 256.0f);
        __syncthreads();
        float qv[64];
        { const v4u* qp = (const v4u*)(mqkv + (size_t)q * 1536 + h * 64);
#pragma unroll
          for (int c = 0; c < 8; ++c) { const v4u w = qp[c];
#pragma unroll
              for (int j = 0; j < 4; ++j) { qv[8 * c + 2 * j] = __builtin_bit_cast(float, w[j] << 16); qv[8 * c + 2 * j + 1] = __builtin_bit_cast(float, w[j] & 0xFFFF0000u); } } }
        float g0 = -3e38f, g1 = -3e38f, g2 = -3e38f; int i0 = -1, i1 = -1, i2 = -1;
        const int own_max = __builtin_amdgcn_readfirstlane(own);
        for (int n = 0; n < own_max; ++n) {
            float g = 0.f;
#pragma unroll
            for (int c = 0; c < 16; ++c) { const f32x4 kk = *(const MK_LAS f32x4*)(km + n * 64 + 4 * c); g = fmaf(qv[4 * c], kk[0], g); g = fmaf(qv[4 * c + 1], kk[1], g); g = fmaf(qv[4 * c + 2], kk[2], g); g = fmaf(qv[4 * c + 3], kk[3], g); }
            if (g > g0) { g2 = g1; i2 = i1; g1 = g0; i1 = i0; g0 = g; i0 = n; }
            else if (g > g1) { g2 = g1; i2 = i1; g1 = g; i1 = n; }
            else if (g > g2) { g2 = g; i2 = n; }
        }
        MK_LAS unsigned* lcnt = (MK_LAS unsigned*)(F.lds + 16384);
        __syncthreads();
        if (F.tid < 64) lcnt[F.tid] = 0u;
        __syncthreads();
        unsigned r0 = 0u, r1 = 0u, r2 = 0u;
        if (i0 >= 0) r0 = __hip_atomic_fetch_add(lcnt + i0, 1u, __ATOMIC_RELAXED, __HIP_MEMORY_SCOPE_WORKGROUP);
        if (i1 >= 0) r1 = __hip_atomic_fetch_add(lcnt + i1, 1u, __ATOMIC_RELAXED, __HIP_MEMORY_SCOPE_WORKGROUP);
        if (i2 >= 0) r2 = __hip_atomic_fetch_add(lcnt + i2, 1u, __ATOMIC_RELAXED, __HIP_MEMORY_SCOPE_WORKGROUP);
        __syncthreads();
        if (F.tid < 64) { const unsigned c = lcnt[F.tid]; lcnt[64 + F.tid] = c ? atomicAdd(cnt + h * 64 + F.tid, c) : 0u; }
        __syncthreads();
        if (i0 >= 0) lists[(size_t)(h * 64 + i0) * S + lcnt[64 + i0] + r0] = (unsigned)(q | (0 << 14));
        if (i1 >= 0) lists[(size_t)(h * 64 + i1) * S + lcnt[64 + i1] + r1] = (unsigned)(q | (1 << 14));
        if (i2 >= 0) lists[(size_t)(h * 64 + i2) * S + lcnt[64 + i2] + r2] = (unsigned)(q | (2 << 14));
    }
    __syncthreads();
}
__device__ __forceinline__ void p5_combine(const Frame& F, kargs_t ap) { unsigned char* const wsb = ap->ws;
    const bf16* part = (const bf16*)ap->out;     const float* plse = (const float*)(wsb + WS_PLSE); bf16* cat = (bf16*)(wsb + WS_CAT);
    const int gt = (F.vcu * NWAVES + F.wave) * 64 + F.lane, NGT = F.G * NWAVES * 64;
    for (int e0 = gt; e0 < S * 8 * 8; e0 += 4 * NGT) {
        f32x4 ls[4]; v4u pv[4][4];
#pragma unroll
        for (int u = 0; u < 4; ++u) { const int e = e0 + u * NGT; if (e < S * 8 * 8) { const int dg = e & 7, qh = e >> 3, q = qh >> 3; const int ns = 1 + min(3, q >> 8);
            ls[u] = *(const f32x4*)(plse + (size_t)qh * 4);
#pragma unroll
            for (int s = 0; s < 4; ++s) if (s < ns) pv[u][s] = *(const v4u*)(part + ((size_t)qh * 4 + s) * 64 + dg * 8); } }
#pragma unroll
        for (int u = 0; u < 4; ++u) { const int e = e0 + u * NGT; if (e < S * 8 * 8) { const int dg = e & 7, qh = e >> 3, q = qh >> 3, h = qh & 7; const int ns = 1 + min(3, q >> 8);
            float M = ls[u][0];
#pragma unroll
            for (int s = 1; s < 4; ++s) if (s < ns) M = fmaxf(M, ls[u][s]);
            float acc[8], wsum = 0.f;
#pragma unroll
            for (int j = 0; j < 8; ++j) acc[j] = 0.f;
#pragma unroll
            for (int s = 0; s < 4; ++s) if (s < ns) { const float w = __builtin_amdgcn_exp2f(ls[u][s] - M); wsum += w; const v4u v = pv[u][s];
#pragma unroll
                for (int j = 0; j < 4; ++j) { acc[2 * j] += w * __builtin_bit_cast(float, v[j] << 16); acc[2 * j + 1] += w * __builtin_bit_cast(float, v[j] & 0xFFFF0000u); } }
            const float r = 1.0f / wsum; v4u o; o.x = pk2(acc[0] * r, acc[1] * r); o.y = pk2(acc[2] * r, acc[3] * r); o.z = pk2(acc[4] * r, acc[5] * r); o.w = pk2(acc[6] * r, acc[7] * r);
            *(v4u*)(cat + (size_t)q * 1024 + 512 + h * 64 + dg * 8) = o; } }
    }
}
__device__ __forceinline__ void p9_final(const Frame& F, kargs_t ap) { unsigned char* const wsb = ap->ws;
    const float* ss = (const float*)(wsb + WS_SS4); const float* g = ap->in[17];
    const int gw = F.vcu * NWAVES + F.wave, NGW = F.G * NWAVES;
    float tsc = 1.0f;
#ifdef MK_TS
    { const unsigned long long* ts = (const unsigned long long*)(wsb + 2048); tsc = 1.0f + (float)(ts[MK_TS + 1] - ts[MK_TS]) * (float)MK_TS_SCALE; }
#endif
    for (int m = gw; m < S; m += NGW) { const float rs = tsc / sqrtf(ss[m] * (1.0f / 1024.0f) + 1e-6f); f32x4* xr = (f32x4*)(ap->out + (size_t)m * DM) + F.lane; const f32x4* gr = (const f32x4*)g + F.lane;
#pragma unroll
        for (int j = 0; j < 4; ++j) { const f32x4 v = xr[64 * j]; xr[64 * j] = v * rs * gr[64 * j]; } }
}

__global__ void __launch_bounds__(NWAVES * 64, 2) mk_fwd(Args a_unused) {
    extern __shared__ __attribute__((aligned(16))) unsigned char lds[];
    const int wave = __builtin_amdgcn_readfirstlane(threadIdx.x >> 6);
    MK_LAS unsigned char* const ldsp = (MK_LAS unsigned char*)lds;
    int lo, hi; { kargs_t ap = kargs(); lo = ap->ph_lo; hi = ap->ph_hi; }
#ifndef MK_ONLY
#define MK_ONLY -1
#endif
#define IN(k) ((MK_ONLY < 0 || MK_ONLY == (k)) && lo <= (k) && (k) < hi)
    const bool multi = (hi - lo) > 1;
    if (multi) {
        const int l0 = pg8::lane_id_v();
        if (wave == 0 && l0 < 2) ((volatile MK_LAS unsigned*)(ldsp + LDS_MISC))[l0] = 0u;
        __syncthreads();
        kargs_t ap = kargs(); (void)xb::xcd_barrier_post((unsigned*)(ap->ws + WS_BAR), (volatile MK_LAS unsigned*)(ldsp + LDS_MISC), wave == 0 && l0 == 0);
    }
    if (lo < -1) cg::this_grid().sync();
#ifdef MK_TS
#define MK_STAMP(i) do { if (blockIdx.x == 0 && wave == 0 && pg8::lane_id_v() == 0) { kargs_t ap__ = kargs(); ((unsigned long long*)(ap__->ws + 2048))[(i)] = __builtin_amdgcn_s_memrealtime(); } } while (0)
#else
#define MK_STAMP(i) do { } while (0)
#endif
    MK_STAMP(0);
#define SEAM(k) do { if (IN(k) && IN((k) + 1)) { kargs_t ap_ = kargs(); xb::XcdBarrier b_; b_.bar = (unsigned*)(ap_->ws + WS_BAR); b_.x = xb::xb_xcc_id(); b_.st = (volatile MK_LAS unsigned*)(ldsp + LDS_MISC); \
        xb::xcd_barrier(b_, wave == 0 && pg8::lane_id_v() == 0); MK_STAMP((k) + 1); } } while (0)
    if (IN(0)) { kargs_t ap = kargs(); const Frame F = mkframe(ldsp, wave);
#ifdef MK_PROBE0
        { int n0_; asm volatile("s_mov_b32 %0, 1" : "=s"(n0_)); for (int r0_ = 0; r0_ < n0_; ++r0_) { p0_prologue(F, ap); __syncthreads(); } }
#endif
        p0_prologue(F, ap); } SEAM(0);
    if (IN(1)) { kargs_t ap = kargs(); unsigned char* ws = ap->ws; pg8::Gemm g{(const bf16*)(ws + WS_XB), (const bf16*)(ws + WS_WGU1), S, NGU, DM, DM}; pg8::StaticOrder So; So.init(S, NGU, (int)gridDim.x, (int)blockIdx.x);
        pg8::EpiSwiGLU E{ws, 0}; pg8::gemm_phase<pg8::EpiSwiGLU, pg8::StaticOrder, true, true>(ldsp, g, So, E, wave);
        if (gridDim.x == 256 && blockIdx.x >= 128) { kargs_t ap2 = kargs(); const Frame F = mkframe(ldsp, wave); __syncthreads(); p0_late_items(F, ap2); } } SEAM(1);
    if (IN(2)) { kargs_t ap = kargs(); unsigned char* ws = ap->ws; pg8::Gemm g{(const bf16*)(ws + WS_ACT), (const bf16*)(ws + WS_WD1), S, DM, DFF, DFF}; pg8::StaticOrder So; So.init(S, DM, (int)gridDim.x, (int)blockIdx.x);
        pg8::EpiResid E{nullptr, ws, (int)WS_SS2, 0.5f}; pg8::gemm_phase<pg8::EpiResid, pg8::StaticOrder, true, true>(ldsp, g, So, E, wave); } SEAM(2);
    if (IN(3)) { kargs_t ap = kargs(); unsigned char* ws = ap->ws; pg8::Gemm g{(const bf16*)(ws + WS_XB), (const bf16*)(ws + WS_WIN), S, NWIN, DM, DM}; pg8::StaticOrder So; So.init(S, gridDim.x == 256 ? NWIN - 256 : NWIN, (int)gridDim.x, (int)blockIdx.x);
        pg8::EpiWin E{ws, 0}; pg8::gemm_phase<pg8::EpiWin, pg8::StaticOrder, true, true>(ldsp, g, So, E, wave); } SEAM(3);
    if (IN(4)) {
#ifdef MK_PROBE4
      int n4_; asm volatile("s_mov_b32 %0, 2" : "=s"(n4_));
      for (int r4_ = 0; r4_ < n4_; ++r4_) {
#endif
        { kargs_t ap = kargs(); unsigned char* ws = ap->ws; pg8::Gemm g{(const bf16*)(ws + WS_CQKV) + 384, (const bf16*)(ws + WS_WUKV), S, 1024, 256, 768}; pg8::StaticOrder So; So.init(S, 1024, (int)gridDim.x, (int)blockIdx.x);
          pg8::EpiKV E{ws}; pg8::gemm_phase<pg8::EpiKV, pg8::StaticOrder, true, true>(ldsp, g, So, E, wave); }
        { kargs_t ap = kargs(); unsigned char* ws = ap->ws; pg8::Gemm g{(const bf16*)(ws + WS_CQKV), (const bf16*)(ws + WS_WUQ), S, 768, 384, 768}; pg8::StaticOrder So; So.init(S, 768, (int)gridDim.x, (int)blockIdx.x);
          pg8::EpiQ E{ws}; pg8::gemm_phase<pg8::EpiQ, pg8::StaticOrder, true, true>(ldsp, g, So, E, wave); }
        if (gridDim.x == 256) { kargs_t ap = kargs(); unsigned char* ws = ap->ws; pg8::Gemm g{(const bf16*)(ws + WS_XB), (const bf16*)(ws + WS_WIN), S, NWIN, DM, DM}; pg8::TailOrder So; So.init(S, 8, (int)gridDim.x, (int)blockIdx.x);
          pg8::EpiWin E{ws, 0}; pg8::gemm_phase<pg8::EpiWin, pg8::TailOrder, true, true>(ldsp, g, So, E, wave); }
#if defined(MK_PROBE4) && MK_PROBE4 == 1
      __syncthreads(); }
#endif
        { kargs_t ap = kargs(); const Frame F = mkframe(ldsp, wave); p4_krope(F, ap); }
#if defined(MK_PROBE4) && MK_PROBE4 == 2
      __syncthreads(); }
#endif
#ifndef MK_NO_GATE
        { kargs_t ap = kargs(); const Frame F = mkframe(ldsp, wave); p4_gating(F, ap); }
#endif
    } SEAM(4);
#ifndef MK_NO_ATT5
    if (IN(5)) {
        kargs_t ap = kargs(); unsigned char* ws = ap->ws; const Frame F = mkframe(ldsp, wave);
        MK_LAS int* pre = (MK_LAS int*)(ldsp + att::MB_PRE);
        const unsigned* cnt = (const unsigned*)(ws + WS_CNT);
        __syncthreads();
        { const int c = (int)cnt[F.tid]; pre[F.tid] = (c + 255) >> 8; }
        __syncthreads();
        for (int o = 1; o < 512; o <<= 1) { const int v = pre[F.tid] + (F.tid >= o ? pre[F.tid - o] : 0); __syncthreads(); pre[F.tid] = v; __syncthreads(); }
        att::MobaCtx C; C.mqkv = (const bf16*)(ws + WS_MQKV); C.posf = (const float*)(ws + WS_POSF); C.part = (bf16*)ap->out; C.plse = (float*)(ws + WS_PLSE);
        C.lists = (const unsigned*)(ws + WS_LIST); C.cnt = cnt; C.total = pre[511]; C.vcu = F.vcu; C.G = F.G;
#ifdef MK_PROBE5
        { bf16* rp_ = C.part; float* rl_ = C.plse; C.part = (bf16*)(ws + WS_CQKV); C.plse = (float*)(ws + WS_CQKV + (16u << 20)); att::moba_run<MK_PROBE5>(C, (char*)lds, wave); __syncthreads(); C.part = rp_; C.plse = rl_; }
#endif
        att::moba_run<0>(C, (char*)lds, wave);
    }
#endif
    SEAM(5);
    if (IN(6)) {
#ifdef MK_PROBEC
        { int nc_; asm volatile("s_mov_b32 %0, 1" : "=s"(nc_)); for (int rc_ = 0; rc_ < nc_; ++rc_) { kargs_t ap = kargs(); const Frame F = mkframe(ldsp, wave); p5_combine(F, ap); __syncthreads(); } }
#endif
        { kargs_t ap = kargs(); const Frame F = mkframe(ldsp, wave); p5_combine(F, ap); }
#ifndef MK_NO_ATT6
        kargs_t ap = kargs(); unsigned char* ws = ap->ws; const Frame F = mkframe(ldsp, wave);
        att::Unit U; U.posf = nullptr; U.part = nullptr; U.plse = nullptr; U.list = nullptr; U.len = 0; U.slope2 = 0.f; U.q_pitch = 768; U.k_pitch = 512; U.v_pitch = 512; U.o_pitch = 1024; U.key0 = 0; U.Kr = (const bf16*)(ws + WS_KR);
        int vstep6 = F.G;
#ifdef MK_PROBE6
        asm volatile("s_mov_b32 %0, 0" : "=s"(vstep6));
        int npass6 = 0;
#endif
        for (int v = F.vcu; v < 256; v += vstep6) { const int h = v >> 5, s_ = v & 31;
#ifdef MK_PROBE6
            if (npass6++ >= MK_PROBE6) break;
            U.len = (npass6 == 1) ? 1 : 0;
#endif
            for (int i = 0; i < 2; ++i) { const int qb = i == 0 ? 63 - s_ : s_;
                U.h = h; U.Q = (const bf16*)(ws + WS_Q) + h * 96; U.K = (const bf16*)(ws + WS_KN) + h * 64; U.V = (const bf16*)(ws + WS_V) + h * 64; U.O = (bf16*)(ws + WS_CAT) + h * 64; U.q0 = qb * 256; U.ntiles = 4 * (qb + 1);
                att::unit<0>(U, (char*)lds, wave); } }
#endif
    } SEAM(6);
    if (IN(7)) { kargs_t ap = kargs(); unsigned char* ws = ap->ws; pg8::Gemm g{(const bf16*)(ws + WS_CAT), (const bf16*)(ws + WS_WOUT), S, DM, DM, DM}; pg8::StaticOrder So; So.init(S, DM, (int)gridDim.x, (int)blockIdx.x);
        pg8::EpiResid E{nullptr, ws, (int)WS_SS3, 1.0f}; pg8::gemm_phase<pg8::EpiResid, pg8::StaticOrder, true, true>(ldsp, g, So, E, wave); } SEAM(7);
    if (IN(8)) { kargs_t ap = kargs(); unsigned char* ws = ap->ws; pg8::Gemm g{(const bf16*)(ws + WS_XB), (const bf16*)(ws + WS_WGU2), S, NGU, DM, DM}; pg8::StaticOrder So; So.init(S, NGU, (int)gridDim.x, (int)blockIdx.x);
        pg8::EpiSwiGLU E{ws, 1};
#ifdef MK_PROBE8
        { int n8_; asm volatile("s_mov_b32 %0, 1" : "=s"(n8_)); for (int r8_ = 0; r8_ < n8_; ++r8_) { pg8::gemm_phase<pg8::EpiSwiGLU, pg8::StaticOrder, true, true>(ldsp, g, So, E, wave); __syncthreads(); } }
#endif
        pg8::gemm_phase<pg8::EpiSwiGLU, pg8::StaticOrder, true, true>(ldsp, g, So, E, wave); } SEAM(8);
    if (IN(9)) { kargs_t ap = kargs(); unsigned char* ws = ap->ws; pg8::Gemm g{(const bf16*)(ws + WS_ACT), (const bf16*)(ws + WS_WD2), S, DM, DFF, DFF}; pg8::StaticOrder So; So.init(S, DM, (int)gridDim.x, (int)blockIdx.x);
        if (gridDim.x == 256) { pg8::EpiResidNorm E{ap->out, ws, ap->in[17], 0.5f}; pg8::gemm_phase<pg8::EpiResidNorm, pg8::StaticOrder, false, true>(ldsp, g, So, E, wave); }
        else { pg8::EpiResid E{ap->out, ws, (int)WS_SS4, 0.5f}; pg8::gemm_phase<pg8::EpiResid, pg8::StaticOrder, true, true>(ldsp, g, So, E, wave); } }
    if (gridDim.x != 256) SEAM(9);
#ifdef MK_PROBE9
    if (IN(9)) { SEAM(9); kargs_t ap = kargs(); unsigned char* ws = ap->ws; pg8::Gemm g{(const bf16*)(ws + WS_ACT), (const bf16*)(ws + WS_WD2), S, DM, DFF, DFF}; pg8::StaticOrder So; So.init(S, DM, (int)gridDim.x, (int)blockIdx.x);
        pg8::EpiSwiGLU E{ws, 1}; pg8::gemm_phase<pg8::EpiSwiGLU, pg8::StaticOrder, true, true, MK_PROBE9 - 1>(ldsp, g, So, E, wave); }
#endif
    if (IN(10) && gridDim.x != 256) { kargs_t ap = kargs(); const Frame F = mkframe(ldsp, wave); p9_final(F, ap); }
#undef IN
#undef SEAM
}
constexpr int N_PHASES = 11;
}
#ifndef MK_BRINGUP
#define MK_BRINGUP 0
#endif
extern "C" void kernel_launch(void* const* d_in, const int* in_sizes, int n_in, void* d_out, int out_size, void* d_ws, size_t ws_size, hipStream_t stream) {
    static int grid = 0;
    if (grid == 0) {
        if (hipFuncSetAttribute((const void*)mk::mk_fwd, hipFuncAttributeMaxDynamicSharedMemorySize, mk::LDS_BYTES) != hipSuccess) { fprintf(stderr, "kernel_launch: hipFuncSetAttribute failed\n"); grid = -1; return; }
        int dev = 0, cus = 0, per_cu = 0;
        hipGetDevice(&dev); hipDeviceGetAttribute(&cus, hipDeviceAttributeMultiprocessorCount, dev);
        hipOccupancyMaxActiveBlocksPerMultiprocessor(&per_cu, (const void*)mk::mk_fwd, mk::NWAVES * 64, mk::LDS_BYTES);
        (void)hipGetLastError();
        grid = cus * (per_cu < 1 ? 1 : (per_cu > 1 ? 1 : per_cu));
        if (grid % 8 != 0 || grid <= 0) grid = 256;
        if (ws_size < mk::WS_END) { fprintf(stderr, "kernel_launch: workspace too small (%zu)\n", ws_size); grid = -1; return; }
    }
    if (grid < 0) return;
    mk::Args a{};
    for (int i = 0; i < 18; ++i) a.in[i] = (const float*)d_in[i];
    a.out = (float*)d_out; a.ws = (unsigned char*)d_ws;
#if MK_BRINGUP == 0
    if (hipMemsetAsync((char*)d_ws + mk::WS_BAR, 0, mk::BAR_BYTES, stream) != hipSuccess) { fprintf(stderr, "kernel_launch: memset failed\n"); return; }
    a.ph_lo = 0; a.ph_hi = mk::N_PHASES;
    void* args[] = {&a};
    hipError_t e = hipLaunchCooperativeKernel((const void*)mk::mk_fwd, dim3(grid), dim3(mk::NWAVES * 64), args, mk::LDS_BYTES, stream);
    if (e != hipSuccess) fprintf(stderr, "cooperative launch failed: %s (grid %d)\n", hipGetErrorString(e), grid);
#else
    const int nph = MK_BRINGUP == 1 ? 3 : MK_BRINGUP == 2 ? 8 : mk::N_PHASES;
    for (int ph = 0; ph < nph; ++ph) { a.ph_lo = ph; a.ph_hi = ph + 1; hipLaunchKernelGGL(mk::mk_fwd, dim3(grid), dim3(mk::NWAVES * 64), mk::LDS_BYTES, stream, a); }
#if MK_BRINGUP == 1
    nv::part_mix(d_in, (float*)d_out, d_ws, stream); nv::part_ffn2_final(d_in, (float*)d_out, d_ws, stream);
#elif MK_BRINGUP == 2
    nv::part_ffn2_final(d_in, (float*)d_out, d_ws, stream);
#endif
#endif
}
```

```cpp
#define MK_BRINGUP 0
#include <hip/hip_runtime.h>
#include <cstdio>
#include <cstdint>
#include <cmath>
#include <hip/hip_cooperative_groups.h>
namespace cg = cooperative_groups;

namespace mkc {
constexpr int S = 16384, DM = 1024, DFF = 2816, NGU = 2 * DFF, NWIN = 2304;
constexpr float LOG2E = 1.4426950408889634f;
constexpr float C2Q = 0.10206207261596577f * LOG2E;
constexpr float C2M = 0.125f * LOG2E;
constexpr size_t MiB = 1u << 20;
constexpr size_t WS_PANEL = 4096 + 16384;
constexpr size_t WS_CNT = 0;
constexpr size_t WS_SS1 = 1 * MiB, WS_SS2 = WS_SS1 + 65536, WS_SSQ = WS_SS2 + 65536, WS_SSKV = WS_SSQ + 65536, WS_SS3 = WS_SSKV + 65536, WS_SS4 = WS_SS3 + 65536;
constexpr size_t WS_KMS = WS_SS1 + 512 * 1024;
constexpr size_t WS_SSDUMMY = WS_SS1 + 384 * 1024, WS_KMSDUMMY = WS_SS1 + 640 * 1024;
constexpr size_t WS_POSF = 2 * MiB, WS_COS = 3 * MiB, WS_SIN = 4 * MiB;
constexpr size_t WS_WGU1 = 6 * MiB, WS_WD1 = 17 * MiB, WS_WGU2 = WS_WD1 + 5632 * 1024, WS_WD2 = WS_WGU2 + 11 * MiB, WS_WIN = 39 * MiB, WS_WUQ = WS_WIN + 4608 * 1024, WS_WUKV = WS_WUQ + 768 * 1024, WS_WOUT = 45 * MiB;
constexpr size_t WS_XB = 48 * MiB, WS_CQKV = 80 * MiB, WS_PLSE = 112 * MiB;
constexpr size_t WS_ACT = 114 * MiB, WS_MQKV = 114 * MiB, WS_CAT = 114 * MiB, WS_Q = 162 * MiB, WS_KN = 186 * MiB, WS_V = 202 * MiB, WS_KR = 218 * MiB, WS_LIST = 220 * MiB, WS_END = 252 * MiB;
static_assert(WS_WD2 + 5632 * 1024 <= WS_WIN && WS_WUKV + 512 * 1024 <= WS_WOUT && WS_WOUT + 2 * MiB <= WS_XB, "weight map");
}
namespace pg8 {
#define PG8_LAS __attribute__((address_space(3)))
typedef unsigned short bf16_t;
typedef short bf16x8 __attribute__((ext_vector_type(8)));
typedef float f32x4 __attribute__((ext_vector_type(4)));
typedef unsigned u32x4 __attribute__((ext_vector_type(4)));
__device__ __forceinline__ int lane_id_v() { int l; asm volatile("v_mbcnt_lo_u32_b32 %0, -1, 0\n\tv_mbcnt_hi_u32_b32 %0, -1, %0" : "=v"(l)); return l; }
constexpr int BM = 256, BK = 64, HALF = 128, HTB = HALF * BK * 2  , STAGE_BYTES = 8 * HTB, NXCD = 8, WGM = 4;

__host__ __device__ __forceinline__ int lds_byte(int r, int c) { const int st = (r >> 4) * 2 + (c >> 5), rr = r & 15, cc = c & 31, ob = rr * 64 + cc * 2; return st * 1024 + (ob ^ (((ob >> 9) & 1) << 5)); }
__host__ __device__ __forceinline__ void stage_rc(int b, int& R, int& C) { const int st = b / 1024, sb = b % 1024, swz = sb ^ (((sb >> 9) & 1) << 5); R = (st >> 1) * 16 + swz / 64; C = (st & 1) * 32 + (swz % 64) / 2; }
__host__ __device__ __forceinline__ int perm32(int rho) { const int n = rho >> 4, i = rho & 15; return 8 * (i >> 2) + 4 * n + (i & 3); }

struct Unit { int pm, pn; };
struct Gemm { const bf16_t* A; const bf16_t* Bt; int M, N, K, lda; };

struct StaticOrder {
    int nM, nN, nwg, G, c;
    __host__ __device__ void init(int M, int N, int G_, int c_) { nM = M / BM; nN = N / BM; nwg = nM * nN; G = G_; c = c_; }
    __host__ __device__ bool next(int i, Unit& u) const {
        const long L = (long)i * G + c; if (L >= nwg) return false;
        int wgid = (int)L; { const int q = nwg / NXCD, r = nwg % NXCD, xcd = wgid % NXCD, off = wgid / NXCD; wgid = (xcd < r ? xcd * (q + 1) : r * (q + 1) + (xcd - r) * q) + off; }
        const int nig = WGM * nN, gid = wgid / nig, fm = gid * WGM, gsz = (nM - fm) < WGM ? (nM - fm) : WGM;
        u.pm = fm + ((wgid % nig) % gsz); u.pn = (wgid % nig) / gsz; return true;
    }
    __device__ __forceinline__ void a_ready(const Unit&) const {}
    __device__ __forceinline__ void done(const Unit&) const {}
};
struct TailOrder {
    int nM, pn, G, c;
    __host__ __device__ void init(int M, int pn_, int G_, int c_) { nM = M / BM; pn = pn_; G = G_; c = c_; }
    __host__ __device__ bool next(int i, Unit& u) const { const int j = c - (G - nM); if (i != 0 || j < 0 || j >= nM) return false; u.pm = j; u.pn = pn; return true; }
    __device__ __forceinline__ void a_ready(const Unit&) const {}
    __device__ __forceinline__ void done(const Unit&) const {}
};
__device__ __forceinline__ unsigned cvt_pk_bf16(float lo, float hi) { unsigned r; asm volatile("v_cvt_pk_bf16_f32 %0, %1, %2" : "=v"(r) : "v"(lo), "v"(hi)); return r; }
typedef unsigned u32x2 __attribute__((ext_vector_type(2)));
constexpr float RMS_EPS = 1e-6f;
__device__ __forceinline__ float row16_sum(float s) {
    s += __builtin_bit_cast(float, __builtin_amdgcn_update_dpp(0, __builtin_bit_cast(int, s), 0xB1, 0xF, 0xF, true));
    s += __builtin_bit_cast(float, __builtin_amdgcn_update_dpp(0, __builtin_bit_cast(int, s), 0x4E, 0xF, 0xF, true));
    s += __builtin_bit_cast(float, __builtin_amdgcn_update_dpp(0, __builtin_bit_cast(int, s), 0x141, 0xF, 0xF, true));
    s += __builtin_bit_cast(float, __builtin_amdgcn_update_dpp(0, __builtin_bit_cast(int, s), 0x140, 0xF, 0xF, true));
    return s; }
__device__ __forceinline__ float sum_fq(float s) { s += __shfl_xor(s, 16); float a_ = s, b_ = s; asm volatile("s_nop 1\n\tv_permlane32_swap_b32 %0, %1" : "+v"(a_), "+v"(b_)); return a_ + b_; }
__device__ __forceinline__ float rs_of(const float* ss, int row, float invn) { return __builtin_amdgcn_rsqf(ss[row] * invn + RMS_EPS); }
__device__ __forceinline__ float silu_f(float g) { return g * __builtin_amdgcn_rcpf(1.0f + __builtin_amdgcn_exp2f(-1.4426950408889634f * g)); }
__device__ __forceinline__ u32x4 pack8(const f32x4 a, const f32x4 b) { u32x4 w; w.x = cvt_pk_bf16(a[0], a[1]); w.y = cvt_pk_bf16(a[2], a[3]); w.z = cvt_pk_bf16(b[0], b[1]); w.w = cvt_pk_bf16(b[2], b[3]); return w; }

struct EpiSwiGLU {
    static constexpr bool PERM = true, AFTER_DRAIN = false;
    unsigned char* ws; int which;
    __device__ __forceinline__ void operator()(const f32x4 (&acc)[2][2][4][2], const Unit& u, int wr, int wc, int fr, int fq) const {
        bf16_t* O = (bf16_t*)(ws + mkc::WS_ACT); const int ldo = mkc::DFF; const float* ss = (const float*)(ws + (which ? mkc::WS_SS3 : mkc::WS_SS1)); const float invn = 1.0f / 1024.0f;
        const int row0 = u.pm * BM + wr * 64 + fr, col0 = u.pn * HALF + wc * 32 + 8 * fq;
        float sv[2][4];
#pragma unroll
        for (int ai = 0; ai < 2; ++ai)
#pragma unroll
            for (int m = 0; m < 4; ++m) sv[ai][m] = ss[row0 + ai * HALF + m * 16];
#pragma unroll
        for (int ai = 0; ai < 2; ++ai)
#pragma unroll
            for (int m = 0; m < 4; ++m) { const int row = row0 + ai * HALF + m * 16;
                const float rs = __builtin_amdgcn_rsqf(sv[ai][m] * invn + RMS_EPS), rs2 = rs * -1.4426950408889634f, rsq = rs * rs;
                f32x4 a[2];
#pragma unroll
                for (int n = 0; n < 2; ++n) { const f32x4 g = acc[ai][0][m][n], t = g * rs2; f32x4 d;
#pragma unroll
                    for (int j = 0; j < 4; ++j) d[j] = __builtin_amdgcn_exp2f(t[j]);
                    d = d + 1.0f;
#pragma unroll
                    for (int j = 0; j < 4; ++j) d[j] = __builtin_amdgcn_rcpf(d[j]);
                    a[n] = (g * acc[ai][1][m][n]) * (d * rsq); }
                *(u32x4*)(O + (size_t)row * ldo + col0) = pack8(a[0], a[1]); }
    }
};
__device__ __forceinline__ f32x4 bf4_to_f32(const u32x2 w) { f32x4 r; r[0] = __builtin_bit_cast(float, w.x << 16); r[1] = __builtin_bit_cast(float, w.x & 0xFFFF0000u); r[2] = __builtin_bit_cast(float, w.y << 16); r[3] = __builtin_bit_cast(float, w.y & 0xFFFF0000u); return r; }
struct EpiResid {
    static constexpr bool PERM = true, AFTER_DRAIN = false;
    float* out; unsigned char* ws; int ss_off; float alpha;
    __device__ __forceinline__ void operator()(const f32x4 (&acc)[2][2][4][2], const Unit& u, int wr, int wc, int fr, int fq) const {
        bf16_t* xb = (bf16_t*)(ws + mkc::WS_XB); float* ss_out = (float*)(ws + ss_off);
        const int row0 = u.pm * BM + wr * 64 + fr, col0 = u.pn * BM + wc * 32 + 8 * fq;
        u32x4 bw[2][4][2];
#pragma unroll
        for (int ai = 0; ai < 2; ++ai)
#pragma unroll
            for (int m = 0; m < 4; ++m)
#pragma unroll
                for (int bj = 0; bj < 2; ++bj) bw[ai][m][bj] = *(const u32x4*)(xb + (size_t)(row0 + ai * HALF + m * 16) * 1024 + col0 + bj * HALF);
#pragma unroll
        for (int ai = 0; ai < 2; ++ai)
#pragma unroll
            for (int m = 0; m < 4; ++m) { const int row = row0 + ai * HALF + m * 16; const size_t off = (size_t)row * 1024 + col0; float s = 0.f;
#pragma unroll
                for (int bj = 0; bj < 2; ++bj) { const u32x4 w = bw[ai][m][bj];
                    const f32x4 o0 = bf4_to_f32((u32x2){w.x, w.y}) + acc[ai][bj][m][0] * alpha, o1 = bf4_to_f32((u32x2){w.z, w.w}) + acc[ai][bj][m][1] * alpha;
                    if (out) { *(f32x4*)(out + off + bj * HALF) = o0; *(f32x4*)(out + off + bj * HALF + 4) = o1; }
                    s += ((o0[0] * o0[0] + o0[1] * o0[1]) + (o0[2] * o0[2] + o0[3] * o0[3])) + ((o1[0] * o1[0] + o1[1] * o1[1]) + (o1[2] * o1[2] + o1[3] * o1[3]));
                    *(u32x4*)(xb + off + bj * HALF) = pack8(o0, o1); }
                s = sum_fq(s);
                if (fq == 0) atomicAdd(ss_out + row, s); }
    }
};
struct EpiWin {
    static constexpr bool PERM = true, AFTER_DRAIN = false;
    unsigned char* ws; int dummy;
    __device__ __forceinline__ void operator()(const f32x4 (&acc)[2][2][4][2], const Unit& u, int wr, int wc, int fr, int fq) const {
        bf16_t* cqkv = (bf16_t*)(ws + mkc::WS_CQKV); bf16_t* mqkv = (bf16_t*)(ws + mkc::WS_MQKV); const float* ss_in = (const float*)(ws + mkc::WS_SS2);
        float* ssq = (float*)(ws + (dummy ? mkc::WS_SSDUMMY : mkc::WS_SSQ)); float* sskv = (float*)(ws + (dummy ? mkc::WS_SSDUMMY + 65536 : mkc::WS_SSKV)); float* kmsum = (float*)(ws + (dummy ? mkc::WS_KMSDUMMY : mkc::WS_KMS));
        const int row0 = u.pm * BM + wr * 64 + fr;
        const bool is_mk = (u.pn == 5 || u.pn == 6);
        f32x4 cs[2][2];
#pragma unroll
        for (int bj = 0; bj < 2; ++bj)
#pragma unroll
            for (int n = 0; n < 2; ++n) cs[bj][n] = (f32x4){0.f, 0.f, 0.f, 0.f};
        float sv[2][4];
#pragma unroll
        for (int ai = 0; ai < 2; ++ai)
#pragma unroll
            for (int m = 0; m < 4; ++m) sv[ai][m] = ss_in[row0 + ai * HALF + m * 16];
#pragma unroll
        for (int ai = 0; ai < 2; ++ai)
#pragma unroll
            for (int m = 0; m < 4; ++m) { const int row = row0 + ai * HALF + m * 16; const float rs = __builtin_amdgcn_rsqf(sv[ai][m] * (1.0f / 1024.0f) + RMS_EPS);
#pragma unroll
                for (int bj = 0; bj < 2; ++bj) { const int colt = u.pn * BM + bj * HALF, col0 = colt + wc * 32 + 8 * fq;
                    const f32x4 v0 = acc[ai][bj][m][0] * rs, v1 = acc[ai][bj][m][1] * rs;
                    bf16_t* dst = (colt < 768) ? (cqkv + (size_t)row * 768 + col0) : (mqkv + (size_t)row * 1536 + (col0 - 768));
                    *(u32x4*)dst = pack8(v0, v1);
                    if (colt < 640) { float s = (v0[0] * v0[0] + v0[1] * v0[1]) + (v0[2] * v0[2] + v0[3] * v0[3]) + (v1[0] * v1[0] + v1[1] * v1[1]) + (v1[2] * v1[2] + v1[3] * v1[3]);
                        s = sum_fq(s);
                        if (fq == 0) atomicAdd((colt < 384 ? ssq : sskv) + row, s); }
                    if (is_mk) { cs[bj][0] += v0; cs[bj][1] += v1; } } }
        if (is_mk) {
#pragma unroll
            for (int bj = 0; bj < 2; ++bj)
#pragma unroll
                for (int n = 0; n < 2; ++n)
#pragma unroll
                    for (int j = 0; j < 4; ++j) { float s = row16_sum(cs[bj][n][j]);
                        if (fr == 0) atomicAdd(kmsum + (size_t)u.pm * 512 + (u.pn * BM + bj * HALF + wc * 32 + 8 * fq + 4 * n + j - 1280), s); }
        }
    }
};
struct EpiKV {
    static constexpr bool PERM = true, AFTER_DRAIN = false;
    unsigned char* ws;
    __device__ __forceinline__ void operator()(const f32x4 (&acc)[2][2][4][2], const Unit& u, int wr, int wc, int fr, int fq) const {
        bf16_t* Kn = (bf16_t*)(ws + mkc::WS_KN); bf16_t* V = (bf16_t*)(ws + mkc::WS_V); const float* ss = (const float*)(ws + mkc::WS_SSKV);
        const int row0 = u.pm * BM + wr * 64 + fr;
        float sv[2][4];
#pragma unroll
        for (int ai = 0; ai < 2; ++ai)
#pragma unroll
            for (int m = 0; m < 4; ++m) sv[ai][m] = ss[row0 + ai * HALF + m * 16];
#pragma unroll
        for (int ai = 0; ai < 2; ++ai)
#pragma unroll
            for (int m = 0; m < 4; ++m) { const int row = row0 + ai * HALF + m * 16; const float rs = __builtin_amdgcn_rsqf(sv[ai][m] * (1.0f / 256.0f) + RMS_EPS);
#pragma unroll
                for (int bj = 0; bj < 2; ++bj) { const int colt = u.pn * BM + bj * HALF, col0 = colt + wc * 32 + 8 * fq;
                    bf16_t* dst = (colt < 512) ? (Kn + (size_t)row * 512 + col0) : (V + (size_t)row * 512 + (col0 - 512));
                    *(u32x4*)dst = pack8(acc[ai][bj][m][0] * rs, acc[ai][bj][m][1] * rs); } }
    }
};
struct EpiQ {
    static constexpr bool PERM = true, AFTER_DRAIN = false;
    unsigned char* ws;
    __device__ __forceinline__ void operator()(const f32x4 (&acc)[2][2][4][2], const Unit& u, int wr, int wc, int fr, int fq) const {
        bf16_t* Q = (bf16_t*)(ws + mkc::WS_Q); const float* ss = (const float*)(ws + mkc::WS_SSQ); const float* cosT = (const float*)(ws + mkc::WS_COS); const float* sinT = (const float*)(ws + mkc::WS_SIN);
        const int row0 = u.pm * BM + wr * 64 + fr;
        float sv[2][4];
#pragma unroll
        for (int ai = 0; ai < 2; ++ai)
#pragma unroll
            for (int m = 0; m < 4; ++m) sv[ai][m] = ss[row0 + ai * HALF + m * 16];
#pragma unroll
        for (int ai = 0; ai < 2; ++ai)
#pragma unroll
            for (int m = 0; m < 4; ++m) { const int row = row0 + ai * HALF + m * 16; const float rs = __builtin_amdgcn_rsqf(sv[ai][m] * (1.0f / 384.0f) + RMS_EPS);
#pragma unroll
                for (int bj = 0; bj < 2; ++bj) { const int col0 = u.pn * BM + bj * HALF + wc * 32 + 8 * fq; const int d = col0 % 96;
                    f32x4 v0 = acc[ai][bj][m][0] * rs, v1 = acc[ai][bj][m][1] * rs;
                    if (d >= 64) { const int g = (d - 64) >> 3; const f32x4 c = *(const f32x4*)(cosT + (size_t)row * 16 + 4 * g), s = *(const f32x4*)(sinT + (size_t)row * 16 + 4 * g);
                        const f32x4 o0 = v0 * c - v1 * s, o1 = v0 * s + v1 * c; v0 = o0; v1 = o1; }
                    *(u32x4*)(Q + (size_t)row * 768 + col0) = pack8(v0, v1); }
                asm volatile("" ::: "memory"); }
    }
};
struct EpiResidNorm {
    static constexpr bool PERM = true, AFTER_DRAIN = true;
    float* out; unsigned char* ws; const float* gain; float alpha;
    __device__ __forceinline__ void fused(f32x4 (&acc)[2][2][4][2], const Unit& u, int wr, int wc, int fr, int fq, PG8_LAS unsigned char* lds, int wid, int lane) const {
        float* ss = (float*)(ws + mkc::WS_SS4); unsigned* pcnt = (unsigned*)(ws + mkc::WS_PANEL) + 64 * u.pm; const bf16_t* xb = (const bf16_t*)(ws + mkc::WS_XB);
        const int row0 = u.pm * BM + wr * 64 + fr, col0 = u.pn * BM + wc * 32 + 8 * fq;
        u32x4 bw[2][4][2];
#pragma unroll
        for (int ai = 0; ai < 2; ++ai)
#pragma unroll
            for (int m = 0; m < 4; ++m)
#pragma unroll
                for (int bj = 0; bj < 2; ++bj) bw[ai][m][bj] = *(const u32x4*)(xb + (size_t)(row0 + ai * HALF + m * 16) * 1024 + col0 + bj * HALF);
#pragma unroll
        for (int ai = 0; ai < 2; ++ai)
#pragma unroll
            for (int m = 0; m < 4; ++m) { const int row = row0 + ai * HALF + m * 16; float s = 0.f;
#pragma unroll
                for (int bj = 0; bj < 2; ++bj) { const u32x4 w = bw[ai][m][bj];
                    const f32x4 o0 = bf4_to_f32((u32x2){w.x, w.y}) + acc[ai][bj][m][0] * alpha, o1 = bf4_to_f32((u32x2){w.z, w.w}) + acc[ai][bj][m][1] * alpha; acc[ai][bj][m][0] = o0; acc[ai][bj][m][1] = o1;
                    s += ((o0[0] * o0[0] + o0[1] * o0[1]) + (o0[2] * o0[2] + o0[3] * o0[3])) + ((o1[0] * o1[0] + o1[1] * o1[1]) + (o1[2] * o1[2] + o1[3] * o1[3])); }
                s = sum_fq(s);
                if (fq == 0) atomicAdd(ss + row, s);
                asm volatile("" : "+v"(acc[ai][0][m][0]), "+v"(acc[ai][0][m][1]), "+v"(acc[ai][1][m][0]), "+v"(acc[ai][1][m][1]));
                if (m & 1) asm volatile("" ::: "memory"); }
        asm volatile("s_waitcnt vmcnt(0)" ::: "memory"); __builtin_amdgcn_s_barrier(); asm volatile("" ::: "memory");
        if (wid == 0) {
            if (lane == 0) __hip_atomic_fetch_add(pcnt, 1u, __ATOMIC_RELAXED, __HIP_MEMORY_SCOPE_AGENT);
            unsigned spins = 0;
            while ((unsigned)__builtin_amdgcn_readfirstlane(__hip_atomic_load(pcnt, __ATOMIC_RELAXED, __HIP_MEMORY_SCOPE_AGENT)) < 4u) { __builtin_amdgcn_s_sleep(2); if (++spins > (1u << 22)) break; }
        }
        asm volatile("s_waitcnt vmcnt(0) lgkmcnt(0)" ::: "memory"); __builtin_amdgcn_s_barrier(); asm volatile("" ::: "memory");
        f32x4 gv[2][2];
#pragma unroll
        for (int bj = 0; bj < 2; ++bj)
#pragma unroll
            for (int n = 0; n < 2; ++n) gv[bj][n] = *(const f32x4*)(gain + col0 + bj * HALF + n * 4);
        float tv[2][4];
#pragma unroll
        for (int ai = 0; ai < 2; ++ai)
#pragma unroll
            for (int m = 0; m < 4; ++m) tv[ai][m] = __hip_atomic_load(ss + row0 + ai * HALF + m * 16, __ATOMIC_RELAXED, __HIP_MEMORY_SCOPE_AGENT);
#pragma unroll
        for (int ai = 0; ai < 2; ++ai)
#pragma unroll
            for (int m = 0; m < 4; ++m) { const int row = row0 + ai * HALF + m * 16; const size_t off = (size_t)row * 1024 + col0;
                const float tot = tv[ai][m]; const float rs = __builtin_amdgcn_rsqf(tot * (1.0f / 1024.0f) + RMS_EPS);
#pragma unroll
                for (int bj = 0; bj < 2; ++bj)
#pragma unroll
                    for (int n = 0; n < 2; ++n) *(f32x4*)(out + off + bj * HALF + n * 4) = acc[ai][bj][m][n] * rs * gv[bj][n]; }
    }
};

template <class Epi, class Sched, bool ALIGN_EPI = false, bool SP2 = false>
__device__ __forceinline__ void gemm_phase(PG8_LAS unsigned char* lds, const Gemm g, const Sched& S, const Epi& E, const int wid) {
    const int lane = lane_id_v(), tid = wid * 64 + lane, wr = wid >> 2, wc = wid & 3, fr = lane & 15, fq = lane >> 4;
    const int K = g.K, nt = K / BK, lda = g.lda;
    unsigned voffA[2], voffB[2];
#pragma unroll
    for (int i = 0; i < 2; ++i) { int R, C; stage_rc(tid * 16 + i * 8192, R, C); const int Rb = Epi::PERM ? ((R & ~31) + perm32(R & 31)) : R;
        voffA[i] = (unsigned)(R * lda + C) * 2u; voffB[i] = (unsigned)(Rb * K + C) * 2u; }
    const size_t kstep = (size_t)(BK * 2);
    const size_t hstep = (size_t)HALF * K * 2;
    const size_t tstep = 2 * hstep; const size_t hstepA = (size_t)HALF * lda * 2, tstepA = 2 * hstepA;
    const unsigned ldsw = (unsigned)wid * 1024u;
    const int aoff = lds_byte(wr * 64 + fr, fq * 8), boff = lds_byte(wc * 32 + fr, fq * 8);
#define PG8_SA(b, h) (((b) * 2 + (h)) * HTB)
#define PG8_SB(b, h) ((4 + (b) * 2 + (h)) * HTB)
#define PG8_STAGE(bufoff, gbase, voff) do { _Pragma("unroll") for (int _i = 0; _i < 2; ++_i) \
        __builtin_amdgcn_global_load_lds((const unsigned*)((const char*)(gbase) + (voff)[_i]), (PG8_LAS unsigned*)(lds + (bufoff) + ldsw + _i * 8192), 16, 0, 0); } while (0)
#define PG8_LDA(dst, b, h) do { _Pragma("unroll") for (int m = 0; m < 4; ++m) _Pragma("unroll") for (int k = 0; k < 2; ++k) dst[m][k] = *(const PG8_LAS bf16x8*)(lds + PG8_SA(b, h) + aoff + m * 2048 + k * 1024); } while (0)
#define PG8_LDB(dst, b, h) do { _Pragma("unroll") for (int n = 0; n < 2; ++n) _Pragma("unroll") for (int k = 0; k < 2; ++k) dst[n][k] = *(const PG8_LAS bf16x8*)(lds + PG8_SB(b, h) + boff + n * 2048 + k * 1024); } while (0)
#define PG8_MMA(ai, bj, At, Bt) do { __builtin_amdgcn_s_setprio(1); _Pragma("unroll") for (int m = 0; m < 4; ++m) _Pragma("unroll") for (int n = 0; n < 2; ++n) _Pragma("unroll") for (int k = 0; k < 2; ++k) \
        acc[ai][bj][m][n] = __builtin_amdgcn_mfma_f32_16x16x32_bf16(Bt[n][k], At[m][k], acc[ai][bj][m][n], 0, 0, 0); __builtin_amdgcn_s_setprio(0); } while (0)
#define PG8_WAIT_V(n) asm volatile("s_waitcnt vmcnt(" #n ")" ::: "memory")
#define PG8_WAIT_L(n) asm volatile("s_waitcnt lgkmcnt(" #n ")" ::: "memory")
#define PG8_BAR __builtin_amdgcn_s_barrier()
#define PG8_SCHED __builtin_amdgcn_sched_barrier(0)
    Unit cur, nxt; int ui = 0;
    if (!S.next(0, cur)) return;
    f32x4 acc[2][2][4][2];
#pragma unroll
    for (int a = 0; a < 2; ++a)
#pragma unroll
        for (int b = 0; b < 2; ++b)
#pragma unroll
            for (int m = 0; m < 4; ++m)
#pragma unroll
                for (int n = 0; n < 2; ++n) acc[a][b][m][n] = (f32x4){0.f, 0.f, 0.f, 0.f};
    bf16x8 At[4][2], B0[2][2], B1[2][2];
    const char* cA = (const char*)g.A + (size_t)cur.pm * tstepA; const char* cB = (const char*)g.Bt + (size_t)cur.pn * tstep;
    S.a_ready(cur);
    if constexpr (SP2) {
        PG8_STAGE(PG8_SB(0, 0), cB, voffB); PG8_STAGE(PG8_SB(0, 1), cB + hstep, voffB); PG8_STAGE(PG8_SA(0, 0), cA, voffA); PG8_STAGE(PG8_SA(0, 1), cA + hstepA, voffA);
        if (wr == 1) PG8_BAR;
        PG8_WAIT_V(2); PG8_BAR;
        PG8_STAGE(PG8_SB(1, 0), cB + kstep, voffB); PG8_STAGE(PG8_SA(1, 0), cA + kstep, voffA); PG8_STAGE(PG8_SB(1, 1), cB + hstep + kstep, voffB);
        PG8_WAIT_V(6); PG8_BAR;
    } else {
        PG8_STAGE(PG8_SB(0, 0), cB, voffB); PG8_STAGE(PG8_SA(0, 0), cA, voffA); PG8_STAGE(PG8_SB(0, 1), cB + hstep, voffB); PG8_STAGE(PG8_SA(0, 1), cA + hstepA, voffA);
        if (wr == 1) PG8_BAR;
        PG8_WAIT_V(4); PG8_BAR;
        PG8_STAGE(PG8_SB(1, 0), cB + kstep, voffB); PG8_STAGE(PG8_SA(1, 0), cA + kstep, voffA); PG8_STAGE(PG8_SB(1, 1), cB + hstep + kstep, voffB);
        PG8_WAIT_V(6); PG8_BAR;
    }
    for (;;) {
        const bool has_next = S.next(ui + 1, nxt);
        const char* nA = has_next ? (const char*)g.A + (size_t)nxt.pm * tstepA : cA; const char* nB = has_next ? (const char*)g.Bt + (size_t)nxt.pn * tstep : cB;
#pragma nounroll
        for (int t = 0; t < nt; t += 2) {
            const bool last = (t == nt - 2);
            const char* a1 = cA + (size_t)(t + 1) * kstep;
            const char* a2 = last ? nA : cA + (size_t)(t + 2) * kstep; const char* b2 = last ? nB : cB + (size_t)(t + 2) * kstep;
            const char* a3 = a2 + kstep; const char* b3 = b2 + kstep;
            if (last && has_next) S.a_ready(nxt);
            if constexpr (SP2) {
            PG8_LDB(B0, 0, 0); PG8_LDB(B1, 0, 1); PG8_SCHED; PG8_LDA(At, 0, 0); PG8_STAGE(PG8_SA(1, 1), a1 + hstepA, voffA);
            PG8_WAIT_V(8); PG8_WAIT_L(0); PG8_BAR; PG8_MMA(0, 0, At, B0); PG8_MMA(0, 1, At, B1); PG8_BAR; PG8_SCHED;
            PG8_LDA(At, 0, 1); PG8_STAGE(PG8_SB(0, 0), b2, voffB); PG8_STAGE(PG8_SB(0, 1), b2 + hstep, voffB); PG8_STAGE(PG8_SA(0, 0), a2, voffA);
            PG8_WAIT_V(8); PG8_WAIT_L(0); PG8_BAR; PG8_MMA(1, 0, At, B0); PG8_MMA(1, 1, At, B1); PG8_BAR; PG8_SCHED;
            PG8_LDB(B0, 1, 0); PG8_LDB(B1, 1, 1); PG8_SCHED; PG8_LDA(At, 1, 0); PG8_STAGE(PG8_SA(0, 1), a2 + hstepA, voffA);
            PG8_WAIT_V(8); PG8_WAIT_L(0); PG8_BAR; PG8_MMA(0, 0, At, B0); PG8_MMA(0, 1, At, B1); PG8_BAR; PG8_SCHED;
            PG8_LDA(At, 1, 1); PG8_STAGE(PG8_SB(1, 0), b3, voffB); PG8_STAGE(PG8_SB(1, 1), b3 + hstep, voffB); PG8_STAGE(PG8_SA(1, 0), a3, voffA);
            PG8_WAIT_V(8); PG8_WAIT_L(0); PG8_BAR; PG8_MMA(1, 0, At, B0); PG8_MMA(1, 1, At, B1); PG8_BAR; PG8_SCHED;
            } else {
            PG8_LDB(B0, 0, 0); PG8_SCHED; PG8_LDA(At, 0, 0); PG8_STAGE(PG8_SA(1, 1), a1 + hstepA, voffA);
            PG8_WAIT_L(8); PG8_BAR; PG8_WAIT_L(0); PG8_MMA(0, 0, At, B0); PG8_BAR; PG8_SCHED;
            PG8_LDB(B1, 0, 1); PG8_STAGE(PG8_SB(0, 0), b2, voffB);
            PG8_BAR; PG8_WAIT_L(0); PG8_MMA(0, 1, At, B1); PG8_BAR;
            PG8_LDA(At, 0, 1); PG8_STAGE(PG8_SA(0, 0), a2, voffA);
            PG8_BAR; PG8_WAIT_L(0); PG8_MMA(1, 0, At, B0); PG8_BAR; PG8_SCHED;
            PG8_STAGE(PG8_SB(0, 1), b2 + hstep, voffB);
            PG8_WAIT_V(6); PG8_BAR; PG8_MMA(1, 1, At, B1); PG8_BAR;
            PG8_LDB(B0, 1, 0); PG8_SCHED; PG8_LDA(At, 1, 0); PG8_STAGE(PG8_SA(0, 1), a2 + hstepA, voffA);
            PG8_WAIT_L(8); PG8_BAR; PG8_WAIT_L(0); PG8_MMA(0, 0, At, B0); PG8_BAR; PG8_SCHED;
            PG8_LDB(B1, 1, 1); PG8_STAGE(PG8_SB(1, 0), b3, voffB);
            PG8_BAR; PG8_WAIT_L(0); PG8_MMA(0, 1, At, B1); PG8_BAR;
            PG8_LDA(At, 1, 1); PG8_STAGE(PG8_SA(1, 0), a3, voffA);
            PG8_BAR; PG8_WAIT_L(0); PG8_MMA(1, 0, At, B0); PG8_BAR; PG8_SCHED;
            PG8_STAGE(PG8_SB(1, 1), b3 + hstep, voffB);
            PG8_WAIT_V(6); PG8_BAR; PG8_MMA(1, 1, At, B1); PG8_BAR;
            }
        }
        if constexpr (ALIGN_EPI) { if (wr == 0) PG8_BAR; }
        if constexpr (!Epi::AFTER_DRAIN) { E(acc, cur, wr, wc, fr, fq); S.done(cur); }
        if (!has_next) break;
#pragma unroll
        for (int a = 0; a < 2; ++a)
#pragma unroll
            for (int b = 0; b < 2; ++b)
#pragma unroll
                for (int m = 0; m < 4; ++m)
#pragma unroll
                    for (int n = 0; n < 2; ++n) acc[a][b][m][n] = (f32x4){0.f, 0.f, 0.f, 0.f};
        cur = nxt; cA = nA; cB = nB; ++ui;
        if constexpr (ALIGN_EPI) { if (wr == 1) PG8_BAR; }
    }
    PG8_WAIT_V(0);
    if constexpr (!ALIGN_EPI) { if (wr == 0) PG8_BAR; }
    PG8_BAR;
    if constexpr (Epi::AFTER_DRAIN) { E.fused(acc, cur, wr, wc, fr, fq, lds, wid, lane); S.done(cur); }
#undef PG8_SA
#undef PG8_SB
#undef PG8_STAGE
#undef PG8_LDA
#undef PG8_LDB
#undef PG8_MMA
#undef PG8_WAIT_V
#undef PG8_WAIT_L
#undef PG8_BAR
#undef PG8_SCHED
}
}
namespace att {
typedef unsigned short bf16_t;
using bf16x8 = __attribute__((ext_vector_type(8))) short;
using s16x4 = __attribute__((ext_vector_type(4))) short;
using f32x16 = __attribute__((ext_vector_type(16))) float;
using f32x4 = __attribute__((ext_vector_type(4))) float;
using u32x4 = __attribute__((ext_vector_type(4))) unsigned;
typedef short v4i16_t __attribute__((ext_vector_type(4)));
#define ATT_LAS __attribute__((address_space(3)))
typedef ATT_LAS const char* lds_cptr;
constexpr int NW = 8, KVBLK = 64;
constexpr int KSLOT = 12288, VSLOT = 8192, NSLOT = 4;
constexpr int LDS_K = 0, LDS_V = NSLOT * KSLOT, LDS_WS = LDS_V + NSLOT * VSLOT, LDS_OST = LDS_WS + NW * 64 * 4, LDS_POSK = LDS_OST + NW * 4096, LDS_BYTES = LDS_POSK + 1024;
__device__ __forceinline__ int crow(int r, int hi) { return (r & 3) + 8 * (r >> 2) + 4 * hi; }
__device__ __forceinline__ void glds16(const void* gsrc, unsigned lds_dst) {
    asm volatile("s_mov_b32 m0, %1\n\ts_nop 0\n\tglobal_load_lds_dwordx4 %0, off" : : "v"(gsrc), "s"(lds_dst) : "memory", "m0"); }
typedef float f32x2_t __attribute__((ext_vector_type(2))); typedef __bf16 bf16x2_t __attribute__((ext_vector_type(2)));
__device__ __forceinline__ unsigned cvtpk(float lo, float hi) { f32x2_t v = {lo, hi}; bf16x2_t b = __builtin_convertvector(v, bf16x2_t); return __builtin_bit_cast(unsigned, b); }
__device__ __forceinline__ float att_bf16_up(float x) { unsigned u = __float_as_uint(x); if (u & 0xFFFFu) { u &= 0xFFFF0000u; if (x > 0.f) u += 0x10000u; } return __uint_as_float(u); }
__device__ __forceinline__ s16x4 vtr(lds_cptr p) { return __builtin_bit_cast(s16x4, __builtin_amdgcn_ds_read_tr16_b64_v4i16((ATT_LAS v4i16_t*)p)); }
#define ATT_KS(j) (((j) & (NSLOT - 1)) * KSLOT)
#define ATT_VS(j) (((j) & (NSLOT - 1)) * VSLOT)
#define ATT_WAIT_BAR() asm volatile("s_waitcnt vmcnt(0) lgkmcnt(0)\n\ts_barrier" ::: "memory")
#define ATT_WAIT_BAR_N(three) do { if (three) asm volatile("s_waitcnt vmcnt(3) lgkmcnt(0)\n\ts_barrier" ::: "memory"); else asm volatile("s_waitcnt vmcnt(2) lgkmcnt(0)\n\ts_barrier" ::: "memory"); } while (0)

struct Unit {
    const bf16_t* Q; int q_pitch;
    const bf16_t* K; int k_pitch;
    const bf16_t* Kr;
    const bf16_t* V; int v_pitch;
    int key0, ntiles;
    int q0;
    const unsigned short* list; int len;
    const float* posf;
    float slope2;
    bf16_t* O; int o_pitch;
    bf16_t* part; float* plse; int h;
};

template <int MODE> __device__ __forceinline__ void unit(const Unit& U, char* shm, const int wid) {
    constexpr int DQK = (MODE == 0) ? 96 : 64, ND0 = DQK / 16;
    const int lane = pg8::lane_id_v(), tid = wid * 64 + lane, r32 = lane & 31, hi = lane >> 5;
    const unsigned lds0 = (unsigned)(uintptr_t)shm;
    const lds_cptr shm3 = (lds_cptr)shm;
    ATT_LAS float* wsf = (ATT_LAS float*)(shm3 + LDS_WS) + wid * 64;
    int qrow, slot = 0; bool valid = true;
    if (MODE == 2) { const int e = wid * 32 + r32; valid = e < U.len; const unsigned ent = valid ? (unsigned)U.list[e] : (unsigned)U.list[0]; qrow = (int)(ent & 0x3FFFu); slot = 1 + (int)(ent >> 14); }
    else qrow = U.q0 + wid * 32 + r32;
    const unsigned koff = (unsigned)((U.key0 + 8 * wid + (lane >> 3)) * U.k_pitch + (((lane & 7) ^ ((4 * wid + (lane >> 4)) & 7)) * 8)) * 2u;
    const unsigned kroff = (MODE == 0) ? (unsigned)((U.key0 + 16 * (wid & 3) + (lane >> 2)) * 32 + (((lane & 3) ^ ((lane >> 4) & 3)) * 8)) * 2u : 0u;
    const unsigned voff = (unsigned)((U.key0 + 16 * (wid & 3) + (lane >> 2)) * U.v_pitch + (wid >> 2) * 32 + (lane & 3) * 8) * 2u;
#define ATT_DMA(t, ks, vs) do { glds16((const char*)U.K + koff + (size_t)(t) * (KVBLK * 2) * U.k_pitch, (unsigned)(lds0 + LDS_K + wid * 1024 + (ks))); \
        if (MODE == 0 && wid < 4) glds16((const char*)U.Kr + kroff + (size_t)(t) * (KVBLK * 64), (unsigned)(lds0 + LDS_K + (8 + (wid & 3)) * 1024 + (ks))); \
        glds16((const char*)U.V + voff + (size_t)(t) * (KVBLK * 2) * U.v_pitch, (unsigned)(lds0 + LDS_V + wid * 1024 + (vs))); } while (0)
    const int NT = U.ntiles;
    ATT_DMA(0, 0, 0);
    if (NT > 1) ATT_DMA(1, KSLOT, VSLOT);
    bf16x8 qr[ND0];
    { const bf16_t* Qw = U.Q + (size_t)qrow * U.q_pitch + hi * 8;
#pragma unroll
      for (int d0 = 0; d0 < ND0; ++d0) qr[d0] = *reinterpret_cast<const bf16x8*>(Qw + d0 * 16); }
    float pq = 0.f;
    if (MODE != 0) { pq = U.posf[qrow]; if (tid < 256) ((ATT_LAS float*)(shm3 + LDS_POSK))[tid] = U.posf[U.key0 + tid]; }
    float mhat = -1e30f, l_reg = 0.f; f32x16 o[2]; o[0] = f32x16{}; o[1] = f32x16{};
    const int km_ = (r32 >> 1) & 7, kmr_ = (r32 >> 2) & 3;
    const int ka0 = LDS_K + r32 * 128 + 32 * (km_ >> 1) + 16 * (hi ^ (km_ & 1));
    const int kb0 = LDS_K + 8192 + r32 * 64 + 32 * (kmr_ >> 1) + 16 * (hi ^ (kmr_ & 1));
#define ATT_KADDR(d0, half, KS) (shm3 + (KS) + (((d0) < 4) ? ((ka0 ^ ((d0) << 5)) + (half) * 4096) : ((kb0 ^ (((d0) - 4) << 5)) + (half) * 2048)))
    const lds_cptr vp0 = shm3 + LDS_V + ((lane >> 4) & 1) * 32 + (lane & 3) * 8 + (4 * hi + ((lane & 15) >> 2)) * 64;
#define ATT_QKT(P0, P1, KS) do { P0 = f32x16{}; P1 = f32x16{}; bf16x8 kk_[2 * ND0]; \
        _Pragma("unroll") for (int d0 = 0; d0 < ND0; ++d0) { kk_[2 * d0] = *(const ATT_LAS bf16x8*)ATT_KADDR(d0, 0, KS); kk_[2 * d0 + 1] = *(const ATT_LAS bf16x8*)ATT_KADDR(d0, 1, KS); }     \
        __builtin_amdgcn_sched_barrier(0); \
        _Pragma("unroll") for (int d0 = 0; d0 < ND0; ++d0) { \
            P0 = __builtin_amdgcn_mfma_f32_32x32x16_bf16(kk_[2 * d0], qr[d0], P0, 0, 0, 0); P1 = __builtin_amdgcn_mfma_f32_32x32x16_bf16(kk_[2 * d0 + 1], qr[d0], P1, 0, 0, 0); } } while (0)
#define ATT_SMPV(P0, P1, T, VS) do { \
        if (MODE != 0) { const ATT_LAS float* pk_ = (const ATT_LAS float*)(shm3 + LDS_POSK) + 64 * (T) + 4 * hi; \
            _Pragma("unroll") for (int g = 0; g < 4; ++g) { const f32x4 a_ = *(const ATT_LAS f32x4*)(pk_ + 8 * g), b_ = *(const ATT_LAS f32x4*)(pk_ + 8 * g + 32); \
                _Pragma("unroll") for (int j = 0; j < 4; ++j) { P0[4 * g + j] -= U.slope2 * __builtin_fabsf(pq - a_[j]); P1[4 * g + j] -= U.slope2 * __builtin_fabsf(pq - b_[j]); } } } \
        if (MODE == 0 || MODE == 1) { const int kb_ = U.key0 + 64 * (T); \
            if (kb_ + 63 > U.q0 + wid * 32) { const int dq_ = qrow - kb_ - 4 * hi; \
                _Pragma("unroll") for (int r = 0; r < 16; ++r) { const int c_ = (r & 3) + 8 * (r >> 2); if (c_ > dq_) P0[r] = -INFINITY; if (c_ + 32 > dq_) P1[r] = -INFINITY; } } } \
        float rm_ = P0[0]; \
        _Pragma("unroll") for (int r = 1; r < 16; ++r) rm_ = fmaxf(rm_, P0[r]); \
        _Pragma("unroll") for (int r = 0; r < 16; ++r) rm_ = fmaxf(rm_, P1[r]); \
        { auto rr_ = __builtin_amdgcn_permlane32_swap(__float_as_uint(rm_), __float_as_uint(rm_), false, false); rm_ = fmaxf(__uint_as_float(rr_[0]), __uint_as_float(rr_[1])); } \
        if (__any(rm_ > mhat + 10.0f)) { const float mn_ = fmaxf(mhat, rm_), f_ = __builtin_amdgcn_exp2f(mhat - mn_); mhat = mn_; l_reg *= f_; \
            _Pragma("unroll") for (int r = 0; r < 16; ++r) { o[0][r] *= f_; o[1][r] *= f_; } }                        \
        float sacc_ = 0.f; \
        _Pragma("unroll") for (int r = 0; r < 16; ++r) { P0[r] = __builtin_amdgcn_exp2f(P0[r] - mhat); P1[r] = __builtin_amdgcn_exp2f(P1[r] - mhat); sacc_ += P0[r] + P1[r]; } \
        l_reg += sacc_; \
        u32x4 pw_[4]; \
        _Pragma("unroll") for (int s_ = 0; s_ < 2; ++s_) { \
            pw_[s_] = (u32x4){cvtpk(P0[8 * s_], P0[8 * s_ + 1]), cvtpk(P0[8 * s_ + 2], P0[8 * s_ + 3]), cvtpk(P0[8 * s_ + 4], P0[8 * s_ + 5]), cvtpk(P0[8 * s_ + 6], P0[8 * s_ + 7])}; \
            pw_[2 + s_] = (u32x4){cvtpk(P1[8 * s_], P1[8 * s_ + 1]), cvtpk(P1[8 * s_ + 2], P1[8 * s_ + 3]), cvtpk(P1[8 * s_ + 4], P1[8 * s_ + 5]), cvtpk(P1[8 * s_ + 6], P1[8 * s_ + 7])}; } \
        const lds_cptr vp_ = vp0 + (VS); s16x4 vl_[8], vh_[8]; \
        _Pragma("unroll") for (int i_ = 0; i_ < 8; ++i_) { vl_[i_] = vtr(vp_ + (i_ >> 2) * 4096 + (i_ & 3) * 1024); vh_[i_] = vtr(vp_ + (i_ >> 2) * 4096 + (i_ & 3) * 1024 + 512); }     \
        __builtin_amdgcn_sched_barrier(0); \
        _Pragma("unroll") for (int i_ = 0; i_ < 8; ++i_) { \
            const bf16x8 vf_ = (bf16x8){vl_[i_][0], vl_[i_][1], vl_[i_][2], vl_[i_][3], vh_[i_][0], vh_[i_][1], vh_[i_][2], vh_[i_][3]}; \
            o[i_ >> 2] = __builtin_amdgcn_mfma_f32_32x32x16_bf16(vf_, __builtin_bit_cast(bf16x8, pw_[i_ & 3]), o[i_ >> 2], 0, 0, 0); } } while (0)
#define ATT_ACT(T) (MODE != 1 || (64 * (T) <= wid * 32 + 31))
#define ATT_ITER(SC0, SC1, SN0, SN1, T) do { const bool has_next_ = (T) + 1 < NT; \
        if (has_next_ && ATT_ACT((T) + 1)) ATT_QKT(SN0, SN1, ATT_KS((T) + 1)); \
        if (ATT_ACT(T)) ATT_SMPV(SC0, SC1, T, ATT_VS(T)); \
        if (has_next_ && (MODE == 0 || NT > NSLOT)) { if ((T) + 3 < NT) ATT_WAIT_BAR_N(dma3); else ATT_WAIT_BAR(); if ((T) + 4 < NT) ATT_DMA((T) + 4, ATT_KS(T), ATT_VS(T)); }   \
        } while (0)
    const bool dma3 = (MODE == 0) && wid < 4;
    if (NT > 2) ATT_DMA(2, 2 * KSLOT, 2 * VSLOT);
    if (NT > 3) ATT_DMA(3, 3 * KSLOT, 3 * VSLOT);
    if (MODE == 0 && NT > 3) ATT_WAIT_BAR_N(dma3); else ATT_WAIT_BAR();
    f32x16 pA0, pA1, pB0, pB1;
    ATT_QKT(pA0, pA1, 0);
    int t = 0;
    if (MODE == 0 && NT > 4) {
#define ATT_SB() __builtin_amdgcn_sched_barrier(0)
#define ATT_KLD(i, KS) kf[i] = *(const ATT_LAS bf16x8*)ATT_KADDR((i) >> 1, (i) & 1, KS)
#define ATT_VLD(i, VS) do { vlo[i] = vtr(vp0 + (VS) + ((i) >> 2) * 4096 + ((i) & 3) * 1024); vhi[i] = vtr(vp0 + (VS) + ((i) >> 2) * 4096 + ((i) & 3) * 1024 + 512); } while (0)
#define ATT_SCR(SC0, SC1, j) ((j) < 16 ? SC0[(j) & 15] : SC1[(j) & 15])
#define ATT_EXP4(SC0, SC1, g) do { if ((g) < 4) { _Pragma("unroll") for (int j_ = 0; j_ < 4; ++j_) SC0[4 * (g) + j_] = __builtin_amdgcn_exp2f(SC0[4 * (g) + j_]); } \
                                   else { _Pragma("unroll") for (int j_ = 0; j_ < 4; ++j_) SC1[4 * ((g) - 4) + j_] = __builtin_amdgcn_exp2f(SC1[4 * ((g) - 4) + j_]); } } while (0)
#define ATT_ADD4(SC0, SC1, g) do { if ((g) < 4) sacc_ += (SC0[4 * (g)] + SC0[4 * (g) + 1]) + (SC0[4 * (g) + 2] + SC0[4 * (g) + 3]); else sacc_ += (SC1[4 * ((g) - 4)] + SC1[4 * ((g) - 4) + 1]) + (SC1[4 * ((g) - 4) + 2] + SC1[4 * ((g) - 4) + 3]); } while (0)
#define ATT_CVT4(SC0, SC1, g) do { if ((g) < 4) { pw[(g) >> 1][2 * ((g) & 1)] = cvtpk(SC0[4 * (g)], SC0[4 * (g) + 1]); pw[(g) >> 1][2 * ((g) & 1) + 1] = cvtpk(SC0[4 * (g) + 2], SC0[4 * (g) + 3]); } \
                                   else { pw[(g) >> 1][2 * ((g) & 1)] = cvtpk(SC1[4 * ((g) - 4)], SC1[4 * ((g) - 4) + 1]); pw[(g) >> 1][2 * ((g) & 1) + 1] = cvtpk(SC1[4 * ((g) - 4) + 2], SC1[4 * ((g) - 4) + 3]); } } while (0)
#define ATT_GAPA(i, SC0, SC1, SN0, SN1) do { \
        if (((i) & 1) == 0) SN0 = __builtin_amdgcn_mfma_f32_32x32x16_bf16(kf[i], qr[(i) >> 1], SN0, 0, 0, 0); else SN1 = __builtin_amdgcn_mfma_f32_32x32x16_bf16(kf[i], qr[(i) >> 1], SN1, 0, 0, 0); \
        if ((i) < 8) { ATT_VLD(ATT_PJ(i), vs_); ATT_EXP4(SC0, SC1, i); } \
        if ((i) >= 1 && (i) <= 8) ATT_ADD4(SC0, SC1, (i) - 1); \
        if ((i) >= 2 && (i) <= 9) ATT_CVT4(SC0, SC1, (i) - 2); \
        ATT_SB(); } while (0)
#define ATT_PJ(j) ((((j) & 1) << 2) | ((j) >> 1))
#define ATT_VF(j) (bf16x8){vlo[j][0], vlo[j][1], vlo[j][2], vlo[j][3], vhi[j][0], vhi[j][1], vhi[j][2], vhi[j][3]}
#define ATT_GAPB(j, SN0, SN1) do { \
        o[ATT_PJ(j) >> 2] = __builtin_amdgcn_mfma_f32_32x32x16_bf16(ATT_VF(ATT_PJ(j)), __builtin_bit_cast(bf16x8, pw[ATT_PJ(j) & 3]), o[ATT_PJ(j) >> 2], 0, 0, 0);     \
        if ((j) < 6) { ATT_KLD(2 * (j), ks2_); ATT_KLD(2 * (j) + 1, ks2_); } \
        ATT_SB(); } while (0)
#define ATT_FAST(SC0, SC1, SN0, SN1, T) do { const int vs_ = ATT_VS(T), ks2_ = ATT_KS((T) + 2); \
        ATT_SB(); \
        float sacc_ = 0.f; \
        SN0 = __builtin_amdgcn_mfma_f32_32x32x16_bf16(kx, qx, f32x16{}, 0, 0, 0); SN1 = __builtin_amdgcn_mfma_f32_32x32x16_bf16(kx, qx, f32x16{}, 0, 0, 0);     \
        ATT_GAPA(0, SC0, SC1, SN0, SN1); ATT_GAPA(1, SC0, SC1, SN0, SN1); ATT_GAPA(2, SC0, SC1, SN0, SN1); ATT_GAPA(3, SC0, SC1, SN0, SN1); \
        ATT_GAPA(4, SC0, SC1, SN0, SN1); ATT_GAPA(5, SC0, SC1, SN0, SN1); ATT_GAPA(6, SC0, SC1, SN0, SN1); ATT_GAPA(7, SC0, SC1, SN0, SN1); \
        ATT_GAPA(8, SC0, SC1, SN0, SN1); ATT_GAPA(9, SC0, SC1, SN0, SN1); ATT_GAPA(10, SC0, SC1, SN0, SN1); ATT_GAPA(11, SC0, SC1, SN0, SN1); \
        l_reg += sacc_; \
        ATT_GAPB(0, SN0, SN1); ATT_GAPB(1, SN0, SN1); ATT_GAPB(2, SN0, SN1); ATT_GAPB(3, SN0, SN1); ATT_GAPB(4, SN0, SN1); ATT_GAPB(5, SN0, SN1); ATT_GAPB(6, SN0, SN1); ATT_GAPB(7, SN0, SN1); \
        ATT_SB(); \
        ATT_WAIT_BAR(); ATT_DMA((T) + 4, ATT_KS(T), vs_); \
        { const unsigned long long bal_ = __builtin_amdgcn_ballot_w64(sacc_ > 1048576.0f); float f_ = 1.f;     \
          if (bal_ != 0ull) { float s2_ = sacc_; { auto rr_ = __builtin_amdgcn_permlane32_swap(__float_as_uint(s2_), __float_as_uint(s2_), false, false); s2_ = fmaxf(__uint_as_float(rr_[0]), __uint_as_float(rr_[1])); }     \
            const float e_ = (s2_ > 1048576.0f) ? (float)((int)((__float_as_uint(s2_) >> 23) & 0xFFu) - 127) : 0.f; \
            const float mn_ = att_bf16_up(mhat + e_), dl_ = mn_ - mhat; f_ = __builtin_amdgcn_exp2f(-dl_); mhat = mn_; l_reg *= f_; \
            _Pragma("unroll") for (int r = 0; r < 16; ++r) { SN0[r] -= dl_; SN1[r] -= dl_; } \
            qx[0] = (hi == 0) ? (short)(__float_as_uint(-mhat) >> 16) : (short)0; } \
            \
          asm volatile("s_cmp_eq_u64 %[b], 0\n\ts_cbranch_scc1 .Lsk%=\n\ts_nop 1\n\tv_mul_f32_e32 %0, %[f], %0\n\tv_mul_f32_e32 %1, %[f], %1\n\tv_mul_f32_e32 %2, %[f], %2\n\tv_mul_f32_e32 %3, %[f], %3\n\tv_mul_f32_e32 %4, %[f], %4\n\tv_mul_f32_e32 %5, %[f], %5\n\tv_mul_f32_e32 %6, %[f], %6\n\tv_mul_f32_e32 %7, %[f], %7\n\tv_mul_f32_e32 %8, %[f], %8\n\tv_mul_f32_e32 %9, %[f], %9\n\tv_mul_f32_e32 %10, %[f], %10\n\tv_mul_f32_e32 %11, %[f], %11\n\tv_mul_f32_e32 %12, %[f], %12\n.Lsk%=:" : "+v"(o[0][0]), "+v"(o[0][1]), "+v"(o[0][2]), "+v"(o[0][3]), "+v"(o[0][4]), "+v"(o[0][5]), "+v"(o[0][6]), "+v"(o[0][7]), "+v"(o[0][8]), "+v"(o[0][9]), "+v"(o[0][10]), "+v"(o[0][11]), "+v"(o[0][12]) : [f] "v"(f_), [b] "s"(bal_) : "scc"); \
          asm volatile("s_cmp_eq_u64 %[b], 0\n\ts_cbranch_scc1 .Lsk%=\n\tv_mul_f32_e32 %0, %[f], %0\n\tv_mul_f32_e32 %1, %[f], %1\n\tv_mul_f32_e32 %2, %[f], %2\n\tv_mul_f32_e32 %3, %[f], %3\n\tv_mul_f32_e32 %4, %[f], %4\n\tv_mul_f32_e32 %5, %[f], %5\n\tv_mul_f32_e32 %6, %[f], %6\n\tv_mul_f32_e32 %7, %[f], %7\n\tv_mul_f32_e32 %8, %[f], %8\n\tv_mul_f32_e32 %9, %[f], %9\n\tv_mul_f32_e32 %10, %[f], %10\n\tv_mul_f32_e32 %11, %[f], %11\n\tv_mul_f32_e32 %12, %[f], %12\n.Lsk%=:" : "+v"(o[0][13]), "+v"(o[0][14]), "+v"(o[0][15]), "+v"(o[1][0]), "+v"(o[1][1]), "+v"(o[1][2]), "+v"(o[1][3]), "+v"(o[1][4]), "+v"(o[1][5]), "+v"(o[1][6]), "+v"(o[1][7]), "+v"(o[1][8]), "+v"(o[1][9]) : [f] "v"(f_), [b] "s"(bal_) : "scc"); \
          asm volatile("s_cmp_eq_u64 %[b], 0\n\ts_cbranch_scc1 .Lsk%=\n\tv_mul_f32_e32 %0, %[f], %0\n\tv_mul_f32_e32 %1, %[f], %1\n\tv_mul_f32_e32 %2, %[f], %2\n\tv_mul_f32_e32 %3, %[f], %3\n\tv_mul_f32_e32 %4, %[f], %4\n\tv_mul_f32_e32 %5, %[f], %5\n.Lsk%=:" : "+v"(o[1][10]), "+v"(o[1][11]), "+v"(o[1][12]), "+v"(o[1][13]), "+v"(o[1][14]), "+v"(o[1][15]) : [f] "v"(f_), [b] "s"(bal_) : "scc"); } \
        } while (0)
        bf16x8 kf[12]; s16x4 vlo[8], vhi[8]; u32x4 pw[4];
        float rm = pA0[0];
#pragma unroll
        for (int r = 1; r < 16; ++r) rm = fmaxf(rm, pA0[r]);
#pragma unroll
        for (int r = 0; r < 16; ++r) rm = fmaxf(rm, pA1[r]);
        { auto rr_ = __builtin_amdgcn_permlane32_swap(__float_as_uint(rm), __float_as_uint(rm), false, false); rm = fmaxf(__uint_as_float(rr_[0]), __uint_as_float(rr_[1])); }
        mhat = att_bf16_up(rm);
#pragma unroll
        for (int r = 0; r < 16; ++r) { pA0[r] -= mhat; pA1[r] -= mhat; }
        const bf16x8 kx = (bf16x8){(short)0x3F80, 0, 0, 0, 0, 0, 0, 0};
        bf16x8 qx = (bf16x8){0, 0, 0, 0, 0, 0, 0, 0};
        if (hi == 0) qx[0] = (short)(__float_as_uint(-mhat) >> 16);
#pragma unroll
        for (int i = 0; i < 12; ++i) ATT_KLD(i, KSLOT);
        if (wid >= 4) __builtin_amdgcn_s_setprio(1);
        for (; t + 4 < NT; t += 2) { ATT_FAST(pA0, pA1, pB0, pB1, t); ATT_FAST(pB0, pB1, pA0, pA1, t + 1); }
        if (wid >= 4) __builtin_amdgcn_s_setprio(0);
#pragma unroll
        for (int r = 0; r < 16; ++r) { pA0[r] += mhat; pA1[r] += mhat; }
#undef ATT_FAST
#undef ATT_GAPA
#undef ATT_GAPB
#undef ATT_VF
#undef ATT_PJ
#undef ATT_EXP4
#undef ATT_ADD4
#undef ATT_CVT4
#undef ATT_SCR
#undef ATT_KLD
#undef ATT_VLD
#undef ATT_SB
    }
    for (; t < NT; t += 2) {
        ATT_ITER(pA0, pA1, pB0, pB1, t);
        if (t + 1 < NT) ATT_ITER(pB0, pB1, pA0, pA1, t + 1);
    }
#undef ATT_QKT
#undef ATT_SMPV
#undef ATT_ACT
#undef ATT_ITER
    { auto rr = __builtin_amdgcn_permlane32_swap(__float_as_uint(l_reg), __float_as_uint(l_reg), false, false); l_reg = __uint_as_float(rr[0]) + __uint_as_float(rr[1]); }
    { const float rl = __builtin_amdgcn_rcpf(l_reg);
      bf16_t* prow = U.O + (size_t)(U.q0 + wid * 32 + r32) * U.o_pitch + 8 * hi;
#pragma unroll
      for (int dh = 0; dh < 2; ++dh)
#pragma unroll
        for (int jp = 0; jp < 2; ++jp) {
            unsigned a0 = cvtpk(o[dh][8 * jp] * rl, o[dh][8 * jp + 1] * rl), a1 = cvtpk(o[dh][8 * jp + 2] * rl, o[dh][8 * jp + 3] * rl);
            unsigned b0 = cvtpk(o[dh][8 * jp + 4] * rl, o[dh][8 * jp + 5] * rl), b1 = cvtpk(o[dh][8 * jp + 6] * rl, o[dh][8 * jp + 7] * rl);
            const auto s0 = __builtin_amdgcn_permlane32_swap(a0, b0, false, false); const auto s1 = __builtin_amdgcn_permlane32_swap(a1, b1, false, false);
            *(u32x4*)(prow + 32 * dh + 16 * jp) = (u32x4){s0[0], s1[0], s0[1], s1[1]}; } }
    asm volatile("s_waitcnt vmcnt(0) lgkmcnt(0)\n\ts_barrier" ::: "memory");
#undef ATT_DMA
}
}

namespace att {
constexpr int MB_REG = 65536, MB_TILE = 16384, MB_V = 8192, MB_POSK = 131072, MB_PRE = MB_POSK + 3072, MB_UT = MB_PRE + 2048, MB_NUT = 62, MB_TM = MB_UT + 1024, MB_KB = 140288, MB_ENT = MB_KB + 8192, MB_END = MB_ENT + 2048;
struct MobaCtx { const bf16_t* mqkv; const float* posf; bf16_t* part; float* plse; const unsigned* lists; const unsigned* cnt; int total, vcu, G; };
struct MobaDesc { int own, h, n; };
__device__ __forceinline__ unsigned att_bf16_rne(float f) { unsigned u = __float_as_uint(f); return (u + 0x7fffu + ((u >> 16) & 1u)) >> 16; }
__device__ __forceinline__ float att_bf2f(unsigned b) { return __uint_as_float(b << 16); }
__device__ __forceinline__ void att_split3(float c, unsigned& w1, unsigned& w2) { const unsigned c0 = att_bf16_rne(c); const float r1 = c - att_bf2f(c0); const unsigned c1 = att_bf16_rne(r1); const float r2 = r1 - att_bf2f(c1);
    w1 = c0 | (c1 << 16); w2 = att_bf16_rne(r2); }

__device__ __forceinline__ u32x4 moba_get(const MobaCtx& C, ATT_LAS const int* pre, int i) {
    const int ng = (C.vcu < C.total) ? (C.total - C.vcu + C.G - 1) / C.G : 0;
    if (i < ng) { const int gI = C.vcu + i * C.G; int lo = 0, hi = 511;
        while (lo < hi) { const int mid = (lo + hi) >> 1; if (pre[mid] > gI) hi = mid; else lo = mid + 1; }
        const int hn = lo, c = gI - (hn ? pre[hn - 1] : 0); const int len = (int)C.cnt[hn] - c * 256;
        return (u32x4){1u | ((unsigned)(hn >> 6) << 2) | ((unsigned)(hn & 63) << 5), (unsigned)(len < 256 ? len : 256), (unsigned)hn * 16384u + (unsigned)c * 256u, 0u}; }
    const int u = C.vcu + (i - ng) * C.G; if (u >= 512) return (u32x4){0u, 0u, 0u, 0u};
    return (u32x4){1u | 2u | ((unsigned)(u & 7) << 2) | ((unsigned)(u >> 3) << 5), 256u, 0u, 0u};
}
__device__ __forceinline__ void glds4(const void* gsrc, unsigned lds_dst) {
    asm volatile("s_mov_b32 m0, %1\n\ts_nop 0\n\tglobal_load_lds_dword %0, off" : : "v"(gsrc), "s"(lds_dst) : "memory", "m0"); }

template <int PROBE> __device__ __forceinline__ void moba_run(const MobaCtx& C, char* shm, const int wid) {
    const int lane = pg8::lane_id_v(), tid = wid * 64 + lane, r32 = lane & 31, hi = lane >> 5;
    const unsigned lds0 = (unsigned)(uintptr_t)shm; const lds_cptr shm3 = (lds_cptr)shm;
    ATT_LAS const int* pre = (ATT_LAS const int*)(shm3 + MB_PRE);
    const float* pmax = C.posf + 16384;
    const int km_ = (r32 >> 1) & 7;
    const int ka0 = r32 * 128 + 32 * (km_ >> 1) + 16 * (hi ^ (km_ & 1));
    const int vpl = MB_V + ((lane >> 4) & 1) * 32 + (lane & 3) * 8 + (4 * hi + ((lane & 15) >> 2)) * 64;
    const unsigned koff = (unsigned)((8 * wid + (lane >> 3)) * 1536 + (((lane & 7) ^ ((4 * wid + (lane >> 4)) & 7)) * 8)) * 2u;
    const unsigned voff = (unsigned)((16 * (wid & 3) + (lane >> 2)) * 1536 + (wid >> 2) * 32 + (lane & 3) * 8) * 2u;
#define MB_UNPACK(X_, D_) do { (D_).own = (int)(((X_) >> 1) & 1u); (D_).h = (int)(((X_) >> 2) & 7u); (D_).n = (PROBE & 4) ? 0 : (int)((X_) >> 5); } while (0)
#define MB_DMA(D_, R_) do { const char* kb_ = (const char*)(C.mqkv + 512 + (D_).h * 64 + (size_t)(D_).n * 256 * 1536); const char* vb_ = kb_ + 1024; \
        unsigned db_ = (unsigned)(lds0 + (R_) + wid * 1024); asm volatile("" : "+s"(db_));     \
        _Pragma("unroll") for (int t_ = 0; t_ < 4; ++t_) { glds16(kb_ + koff + (size_t)t_ * (64 * 1536 * 2), db_ + t_ * MB_TILE); \
                                                           glds16(vb_ + voff + (size_t)t_ * (64 * 1536 * 2), db_ + t_ * MB_TILE + MB_V); } } while (0)
#define MB_FETCH(I_, E_, X_) do { E_ = ((const ATT_LAS u32x4*)(shm3 + MB_UT))[(I_)]; X_ = (unsigned)__builtin_amdgcn_readfirstlane((int)E_[0]); } while (0)
#define MB_SMALL(U_, E_, D_) do { \
        if (!(D_).own) { const int e = wid * 32 + r32; if (hi == 0 && e < (int)E_[1]) glds4(C.lists + E_[2] + e, (unsigned)(lds0 + MB_ENT + ((U_) & 1) * 1024 + wid * 128)); } \
        if (wid < 4) glds4(C.posf + (D_).n * 256 + tid, (unsigned)(lds0 + MB_POSK + ((U_) % 3) * 1024 + wid * 256)); \
        if (tid < 4) glds4(pmax + 4 * (D_).n + tid, (unsigned)(lds0 + MB_TM + ((U_) % 3) * 16)); } while (0)
#define MB_STAGE(U_, D_) do { if (tid < 256) { const ATT_LAS float* pp_ = (const ATT_LAS float*)(shm3 + MB_POSK + ((U_) % 3) * 1024); \
            const float v_ = exp2f(-(float)((D_).h + 1)) * 1.4426950408889634f * (pp_[tid] - pp_[0]); const unsigned vh_ = att_bf16_rne(v_), vl_ = att_bf16_rne(v_ - att_bf2f(vh_)); \
            ((ATT_LAS u32x4*)(shm3 + MB_KB + ((U_) & 1) * 4096))[tid] = (u32x4){vh_ | (vl_ << 16), 0x3F803F80u, 0x00003F80u, 0u}; } } while (0)
#define MB_QROW(U_, E_, D_, META_, QR_, PQ_) do { const int e_ = wid * 32 + r32; \
        if ((D_).own) META_ = (((D_).n * 256 + e_) << 2); \
        else { const unsigned en_ = ((const ATT_LAS unsigned*)(shm3 + MB_ENT + ((U_) & 1) * 1024))[e_]; META_ = (e_ < (int)E_[1]) ? (int)(((en_ & 0x3FFFu) << 2) | (1u + ((en_ >> 14) & 3u))) : -1; } \
        const int qr_ = (PROBE & 4) ? (16128 + e_) : ((META_) >= 0 ? ((META_) >> 2) : 0); const bf16_t* Qw_ = C.mqkv + (D_).h * 64 + (size_t)qr_ * 1536 + hi * 8; \
        _Pragma("unroll") for (int d0 = 0; d0 < 4; ++d0) QR_[d0] = *reinterpret_cast<const bf16x8*>(Qw_ + d0 * 16); PQ_ = C.posf[qr_]; } while (0)
#define MB_CHEAP(U_, D_, META_, PQ_, CM_) do { const f32x4 tm_ = *(const ATT_LAS f32x4*)(shm3 + MB_TM + ((U_) % 3) * 16); CM_ = 0; \
        _Pragma("unroll") for (int t_ = 0; t_ < 4; ++t_) { bool ok_ = __all((META_) < 0 || (PQ_) >= tm_[t_]); if ((D_).own) ok_ = ok_ && (64 * t_ + 63 <= wid * 32); if (ok_) CM_ |= 1 << t_; } } while (0)
  for (int base = 0; ; base += MB_NUT) {
    __syncthreads();
    if (tid < MB_NUT) ((ATT_LAS u32x4*)(shm3 + MB_UT))[tid] = moba_get(C, pre, base + tid);
    if (tid == MB_NUT || tid == MB_NUT + 1) ((ATT_LAS u32x4*)(shm3 + MB_UT))[tid] = (u32x4){0u, 0u, 0u, 0u};
    __syncthreads();
    u32x4 ent_; unsigned xc, xn, xnn = 0u; MobaDesc D, Dn;
    MB_FETCH(0, ent_, xc);
    if (!(xc & 1u)) break;
    MB_UNPACK(xc, D);
    MB_DMA(D, 0); MB_SMALL(0, ent_, D);
    { u32x4 e1_; MB_FETCH(1, e1_, xn); MB_UNPACK(xn, Dn); if (xn & 1u) MB_SMALL(1, e1_, Dn); }
    asm volatile("" ::: "memory"); __builtin_amdgcn_s_waitcnt(0); __builtin_amdgcn_s_barrier(); asm volatile("" ::: "memory");
    int meta = -1, cm = 0; float pq = 0.f, pbase = 0.f; bf16x8 qr[4];
    MB_STAGE(0, D); MB_QROW(0, ent_, D, meta, qr, pq);
    pbase = ((const ATT_LAS float*)(shm3 + MB_POSK))[0];
    asm volatile("" ::: "memory"); __builtin_amdgcn_s_waitcnt(0); __builtin_amdgcn_s_barrier(); asm volatile("" ::: "memory");
    MB_CHEAP(0, D, meta, pq, cm);
    if (xn & 1u) MB_DMA(Dn, MB_REG);
    int i = 0;
    for (; xc & 1u; ++i) {
        int meta_n = -1; float pq_n = 0.f;
        MB_UNPACK(xn, Dn);
        const int cur = i & 1, rb = cur * MB_REG; const float slope2 = exp2f(-(float)(D.h + 1)) * 1.4426950408889634f;
        const bool valid = meta >= 0; const int qrow = valid ? (meta >> 2) : 0, slot = meta & 3;
        const ATT_LAS float* posk = (const ATT_LAS float*)(shm3 + MB_POSK + (i % 3) * 1024);
        const lds_cptr kbx = shm3 + MB_KB + cur * 4096 + r32 * 16;
        float mhat = 0.f, l_reg = 0.f; bool first_ = true; f32x16 o[2]; o[0] = f32x16{}; o[1] = f32x16{};
        unsigned qxa0 = 0u, qxa1 = 0u, qxa2 = 0u, qxr1 = 0u, qxr2 = 0u;
#define MB_QX() do { unsigned a1_, a2_, r1_, r2_; att_split3(-slope2 * (pq - pbase) - mhat, a1_, a2_); att_split3(-mhat, r1_, r2_); \
            qxa0 = hi == 0 ? 0x3F803F80u : 0u; qxa1 = hi == 0 ? a1_ : 0u; qxa2 = hi == 0 ? a2_ : 0u; qxr1 = hi == 0 ? r1_ : 0u; qxr2 = hi == 0 ? r2_ : 0u; } while (0)
        MB_QX();
        f32x16 pA0, pA1, pB0, pB1; float mA = 0.f, mB = 0.f;
#define MB_ACT(T) (!D.own || (64 * (T) <= wid * 32 + 31))
#define MB_CH(T) ((cm >> (T)) & 1)
#define MB_QKT(P0, P1, MR, T) do { bf16x8 kk_[8]; const lds_cptr kb_ = shm3 + rb + (T) * MB_TILE; \
            const bf16x8 kx0_ = *(const ATT_LAS bf16x8*)(kbx + (T) * 1024), kx1_ = *(const ATT_LAS bf16x8*)(kbx + (T) * 1024 + 512); \
            _Pragma("unroll") for (int d0 = 0; d0 < 4; ++d0) { kk_[2 * d0] = *(const ATT_LAS bf16x8*)(kb_ + (ka0 ^ (d0 << 5))); kk_[2 * d0 + 1] = *(const ATT_LAS bf16x8*)(kb_ + (ka0 ^ (d0 << 5)) + 4096); } \
            const bool ch_ = MB_CH(T); const u32x4 qs_ = (u32x4){ch_ ? qxa0 : 0u, ch_ ? qxa1 : qxr1, ch_ ? qxa2 : qxr2, 0u}; \
            __builtin_amdgcn_sched_barrier(0); \
            P0 = __builtin_amdgcn_mfma_f32_32x32x16_bf16(kx0_, __builtin_bit_cast(bf16x8, qs_), f32x16{}, 0, 0, 0); P1 = __builtin_amdgcn_mfma_f32_32x32x16_bf16(kx1_, __builtin_bit_cast(bf16x8, qs_), f32x16{}, 0, 0, 0); \
            _Pragma("unroll") for (int d0 = 0; d0 < 4; ++d0) { P0 = __builtin_amdgcn_mfma_f32_32x32x16_bf16(kk_[2 * d0], qr[d0], P0, 0, 0, 0); P1 = __builtin_amdgcn_mfma_f32_32x32x16_bf16(kk_[2 * d0 + 1], qr[d0], P1, 0, 0, 0); } \
            MR = mhat; } while (0)
#define MB_SMPV(P0, P1, MC, T) do { \
            if (__any(MC != mhat)) { const float d_ = mhat - MC; _Pragma("unroll") for (int r = 0; r < 16; ++r) { P0[r] -= d_; P1[r] -= d_; } }     \
            if (!MB_CH(T)) { const ATT_LAS float* pk_ = posk + 64 * (T) + 4 * hi; \
                _Pragma("unroll") for (int g = 0; g < 4; ++g) { const f32x4 a_ = *(const ATT_LAS f32x4*)(pk_ + 8 * g), b_ = *(const ATT_LAS f32x4*)(pk_ + 8 * g + 32); \
                    _Pragma("unroll") for (int j = 0; j < 4; ++j) { P0[4 * g + j] -= slope2 * __builtin_fabsf(pq - a_[j]); P1[4 * g + j] -= slope2 * __builtin_fabsf(pq - b_[j]); } } } \
            if (D.own && 64 * (T) + 63 > wid * 32) { int dq_ = wid * 32 + r32 - 64 * (T) - 4 * hi; asm volatile("" : "+v"(dq_));     \
                _Pragma("unroll") for (int r = 0; r < 16; ++r) { const int c_ = (r & 3) + 8 * (r >> 2); if (c_ > dq_) P0[r] = -INFINITY; if (c_ + 32 > dq_) P1[r] = -INFINITY; } } \
            float rm_ = P0[0]; \
            _Pragma("unroll") for (int r = 1; r < 16; ++r) rm_ = fmaxf(rm_, P0[r]); \
            _Pragma("unroll") for (int r = 0; r < 16; ++r) rm_ = fmaxf(rm_, P1[r]); \
            { auto rr_ = __builtin_amdgcn_permlane32_swap(__float_as_uint(rm_), __float_as_uint(rm_), false, false); rm_ = fmaxf(__uint_as_float(rr_[0]), __uint_as_float(rr_[1])); } \
            if (first_ || __any(rm_ > 10.0f)) { const float dl_ = first_ ? rm_ : fmaxf(rm_, 0.f); mhat += dl_; \
                _Pragma("unroll") for (int r = 0; r < 16; ++r) { P0[r] -= dl_; P1[r] -= dl_; } \
                if (!first_) { const float f_ = __builtin_amdgcn_exp2f(-dl_); l_reg *= f_; \
                    _Pragma("unroll") for (int r = 0; r < 16; ++r) { o[0][r] *= f_; o[1][r] *= f_; } }                        \
                first_ = false; MB_QX(); } \
            _Pragma("unroll") for (int r = 0; r < 16; ++r) { P0[r] = __builtin_amdgcn_exp2f(P0[r]); P1[r] = __builtin_amdgcn_exp2f(P1[r]); } \
            { float sa_ = 0.f;     \
              _Pragma("unroll") for (int r = 0; r < 16; ++r) { sa_ += P0[r]; sa_ += P1[r]; } \
              l_reg += sa_; } \
            u32x4 pw_[4]; \
            _Pragma("unroll") for (int s_ = 0; s_ < 2; ++s_) { \
                pw_[s_] = (u32x4){cvtpk(P0[8 * s_], P0[8 * s_ + 1]), cvtpk(P0[8 * s_ + 2], P0[8 * s_ + 3]), cvtpk(P0[8 * s_ + 4], P0[8 * s_ + 5]), cvtpk(P0[8 * s_ + 6], P0[8 * s_ + 7])}; \
                pw_[2 + s_] = (u32x4){cvtpk(P1[8 * s_], P1[8 * s_ + 1]), cvtpk(P1[8 * s_ + 2], P1[8 * s_ + 3]), cvtpk(P1[8 * s_ + 4], P1[8 * s_ + 5]), cvtpk(P1[8 * s_ + 6], P1[8 * s_ + 7])}; } \
            const lds_cptr vp_ = shm3 + rb + (T) * MB_TILE + vpl; s16x4 vl_[8], vh_[8]; \
            _Pragma("unroll") for (int i_ = 0; i_ < 8; ++i_) { vl_[i_] = vtr(vp_ + (i_ >> 2) * 4096 + (i_ & 3) * 1024); vh_[i_] = vtr(vp_ + (i_ >> 2) * 4096 + (i_ & 3) * 1024 + 512); } \
            __builtin_amdgcn_sched_barrier(0); \
            _Pragma("unroll") for (int i_ = 0; i_ < 8; ++i_) { \
                const bf16x8 vf_ = (bf16x8){vl_[i_][0], vl_[i_][1], vl_[i_][2], vl_[i_][3], vh_[i_][0], vh_[i_][1], vh_[i_][2], vh_[i_][3]}; \
                o[i_ >> 2] = __builtin_amdgcn_mfma_f32_32x32x16_bf16(vf_, __builtin_bit_cast(bf16x8, pw_[i_ & 3]), o[i_ >> 2], 0, 0, 0); } } while (0)
        if (!(PROBE & 1)) {
        if (MB_ACT(3)) MB_QKT(pA0, pA1, mA, 3);
        if (MB_ACT(2)) MB_QKT(pB0, pB1, mB, 2);
        if (MB_ACT(3)) MB_SMPV(pA0, pA1, mA, 3);
        }
        if (xn & 1u) { MB_STAGE(i + 1, Dn);
            MB_FETCH(i + 2, ent_, xnn); if (xnn & 1u) { MobaDesc Dnn; MB_UNPACK(xnn, Dnn); MB_SMALL(i + 2, ent_, Dnn); } } else xnn = 0u;
        if (!(PROBE & 1)) {
        if (!(PROBE & 64)) if (MB_ACT(1)) MB_QKT(pA0, pA1, mA, 1);
        if (MB_ACT(2)) MB_SMPV(pB0, pB1, mB, 2);
        if (!(PROBE & 64)) MB_QKT(pB0, pB1, mB, 0);
        }
        if (xn & 1u) { MB_FETCH(i + 1, ent_, xn); MB_QROW(i + 1, ent_, Dn, meta_n, qr, pq_n); }
        if (!(PROBE & 1)) {
        if (!(PROBE & 64)) if (MB_ACT(1)) MB_SMPV(pA0, pA1, mA, 1);
        if (!(PROBE & 64)) MB_SMPV(pB0, pB1, mB, 0);
        }
#undef MB_QKT
#undef MB_SMPV
#undef MB_ACT
#undef MB_CH
#undef MB_QX
        asm volatile("" ::: "memory"); __builtin_amdgcn_s_waitcnt(0); __builtin_amdgcn_s_barrier(); asm volatile("" ::: "memory");
        const int h_o = D.h; const bool valid_o = valid; const int qrow_o = qrow, slot_o = slot;
        xc = xn; xn = xnn; D = Dn; meta = meta_n; pq = pq_n;
        if (xc & 1u) { pbase = ((const ATT_LAS float*)(shm3 + MB_POSK + ((i + 1) % 3) * 1024))[0]; MB_CHEAP(i + 1, D, meta, pq, cm); }
        if (xn & 1u) { MobaDesc Dt; MB_UNPACK(xn, Dt); MB_DMA(Dt, cur * MB_REG); }
        { auto rr = __builtin_amdgcn_permlane32_swap(__float_as_uint(l_reg), __float_as_uint(l_reg), false, false); l_reg = __uint_as_float(rr[0]) + __uint_as_float(rr[1]); }
        { const float rl = __builtin_amdgcn_rcpf(l_reg);
          bf16_t* prow = C.part + ((((size_t)(qrow_o * 8 + h_o) * 4 + slot_o) * 64) & (PROBE ? ((PROBE & 4) ? (size_t)0x3FFC0 : (size_t)0x7FFFC0) : ~(size_t)0)) + 8 * hi;
#pragma unroll
          for (int dh = 0; dh < 2; ++dh)
#pragma unroll
            for (int jp = 0; jp < 2; ++jp) {
                unsigned a0 = cvtpk(o[dh][8 * jp] * rl, o[dh][8 * jp + 1] * rl), a1 = cvtpk(o[dh][8 * jp + 2] * rl, o[dh][8 * jp + 3] * rl);
                unsigned b0 = cvtpk(o[dh][8 * jp + 4] * rl, o[dh][8 * jp + 5] * rl), b1 = cvtpk(o[dh][8 * jp + 6] * rl, o[dh][8 * jp + 7] * rl);
                const auto s0 = __builtin_amdgcn_permlane32_swap(a0, b0, false, false); const auto s1 = __builtin_amdgcn_permlane32_swap(a1, b1, false, false);
                if (!(PROBE & 2)) if (valid_o) *(u32x4*)(prow + 32 * dh + 16 * jp) = (u32x4){s0[0], s1[0], s0[1], s1[1]}; }
          if (!(PROBE & 2)) if (hi == 0 && valid_o) C.plse[(size_t)(qrow_o * 8 + h_o) * 4 + slot_o] = mhat + __builtin_log2f(l_reg); }
    }
    if (i < MB_NUT) break;
  }
#undef MB_UNPACK
#undef MB_DMA
#undef MB_FETCH
#undef MB_SMALL
#undef MB_STAGE
#undef MB_QROW
#undef MB_CHEAP
}
}

namespace xb {
#define LAS __attribute__((address_space(3)))
#define XB_TMO      128
#define XB_XCNT(j)  (256  + 64 * (j))
#define XB_XSUB(j)  (1280 + 64 * (j))
#define XB_XGEN(j)  (2304 + 64 * (j))
#define XB_TOP      3328
#define XB_TOPGEN   3392
#define XCD_BAR_WORDS 3456
#define XB_TOPR(r)  (4096 + 512 * (r) + 32)
#define XB_SPLIT    3520
#define XB_SPLX(j)  (3584 + 32 * (j))
#define XB_SPIN_CAP (1u << 21)

__device__ __forceinline__ unsigned xb_ld(unsigned* p)              { return __hip_atomic_load(p, __ATOMIC_RELAXED, __HIP_MEMORY_SCOPE_AGENT); }
__device__ __forceinline__ unsigned xb_add(unsigned* p, unsigned v) { return __hip_atomic_fetch_add(p, v, __ATOMIC_RELAXED, __HIP_MEMORY_SCOPE_AGENT); }
__device__ __forceinline__ unsigned xb_xcc_id() { return (unsigned)__builtin_amdgcn_s_getreg((3 << 11) | 20) & 0xFu; }
#define XB_SPIN(cond, bar) do { unsigned _sp = 0; while (cond) { __builtin_amdgcn_s_sleep(1); \
    if ((++_sp & 255u) == 0u) { if (xb_ld(&(bar)[XB_TMO])) break; if (_sp > XB_SPIN_CAP) { atomicAdd(&(bar)[XB_TMO], 1u); break; } } } } while (0)

struct XcdBarrier {
    unsigned* bar; unsigned x;
    volatile LAS unsigned* st;
};

__device__ __forceinline__ XcdBarrier xcd_barrier_post(unsigned* bar, volatile LAS unsigned* st, bool leader) {
    XcdBarrier b; b.bar = bar; b.x = xb_xcc_id(); b.st = st;
    if (leader) (void)xb_add(&bar[XB_XCNT(b.x)], 1u);
    return b;
}
__device__ __forceinline__ void xcd_barrier_complete(unsigned* bar, unsigned x, unsigned& nloc, unsigned& nx) {
    const unsigned G = gridDim.x * gridDim.y * gridDim.z;
    unsigned sum, cnt, mine, sp = 0u;
    for (;;) {
        sum = 0u; cnt = 0u; mine = 0u;
#pragma unroll
        for (unsigned j = 0; j < 16; ++j) { const unsigned c = xb_ld(&bar[XB_XCNT(j)]); sum += c; cnt += (c > 0u) ? 1u : 0u; mine = (j == x) ? c : mine; }
        if (sum == G) break;
        __builtin_amdgcn_s_sleep(1);
        if ((++sp & 255u) == 0u) { if (xb_ld(&bar[XB_TMO])) break; if (sp > XB_SPIN_CAP) { atomicAdd(&bar[XB_TMO], 1u); break; } }
    }
    nloc = mine > 0u ? mine : 1u; nx = cnt > 0u ? cnt : 1u;
}

__device__ __forceinline__ void xcd_barrier(const XcdBarrier& b, bool leader) {
    asm volatile("s_waitcnt vmcnt(0)" ::: "memory");
    __syncthreads();
    if (leader) {
        unsigned* bar = b.bar;
        __builtin_amdgcn_s_waitcnt(0);
        unsigned nloc = b.st[0], nx = b.st[1];
        if (nloc == 0u) { xcd_barrier_complete(bar, b.x, nloc, nx); b.st[0] = nloc; b.st[1] = nx; }
        const unsigned old = xb_add(&bar[XB_XSUB(b.x)], 1u);
        const unsigned gen = old / nloc;
        if (old + 1u == (gen + 1u) * nloc) {
            __builtin_amdgcn_fence(__ATOMIC_RELEASE, "agent");
            asm volatile("s_waitcnt vmcnt(0)" ::: "memory");
            asm volatile("buffer_inv sc1" ::: "memory");
            asm volatile("s_waitcnt vmcnt(0)" ::: "memory");
#pragma unroll
            for (unsigned r_ = 0; r_ < 8u; ++r_) (void)xb_add(&bar[XB_TOPR(r_)], 1u);
            XB_SPIN(xb_ld(&bar[XB_TOPR(b.x & 7u)]) < (gen + 1u) * nx, bar);
            asm volatile("s_waitcnt vmcnt(0)" ::: "memory");
        } else {
            asm volatile("buffer_inv sc1" ::: "memory");
            XB_SPIN(xb_ld(&bar[XB_TOPR(b.x & 7u)]) < (gen + 1u) * nx, bar);
            asm volatile("s_waitcnt vmcnt(0)" ::: "memory");
        }
    }
    __syncthreads();
}

#undef LAS
}
namespace mk {
typedef float f32x2 __attribute__((ext_vector_type(2)));
typedef unsigned short bf16;
typedef unsigned v4u __attribute__((ext_vector_type(4)));
typedef float f32x4 __attribute__((ext_vector_type(4)));
#define MK_LAS __attribute__((address_space(3)))
using namespace mkc;
constexpr int NWAVES = 8;
constexpr int RING_BYTES = 131072, LDS_EXTRA = RING_BYTES, LDS_MISC = RING_BYTES + 8192, LDS_BYTES = 150528;
constexpr size_t WS_BAR = 4096, BAR_BYTES = 32768;

struct Args { const float* in[18]; float* out; unsigned char* ws; int ph_lo, ph_hi; };
struct Frame { MK_LAS unsigned char* lds; int tid, lane, wave, vcu, G; };
typedef const __attribute__((address_space(4))) Args* kargs_t;
__device__ __forceinline__ kargs_t kargs() { kargs_t p = (kargs_t)__builtin_amdgcn_kernarg_segment_ptr(); asm volatile("" : "+s"(p)); return p; }
__device__ __forceinline__ Frame mkframe(MK_LAS unsigned char* lds, int wave) { Frame F; F.lds = lds; F.wave = wave; F.lane = pg8::lane_id_v(); F.tid = wave * 64 + F.lane; F.G = gridDim.x;
    { const int bx = blockIdx.x; F.vcu = (F.G % 8 == 0) ? (bx % 8) * (F.G / 8) + bx / 8 : bx; } return F; }

__device__ __forceinline__ unsigned f2bf(float f) { unsigned u = __builtin_bit_cast(unsigned, f); return (u + 0x7fffu + ((u >> 16) & 1u)) >> 16; }
__device__ __forceinline__ unsigned pk2(float lo, float hi) { return f2bf(lo) | (f2bf(hi) << 16); }
__device__ __forceinline__ float bf2f(unsigned short b) { return __builtin_bit_cast(float, (unsigned)b << 16); }
__device__ __forceinline__ float wave_sum(float v) {
    v += __builtin_bit_cast(float, __builtin_amdgcn_update_dpp(0, __builtin_bit_cast(int, v), 0xB1, 0xF, 0xF, true));
    v += __builtin_bit_cast(float, __builtin_amdgcn_update_dpp(0, __builtin_bit_cast(int, v), 0x4E, 0xF, 0xF, true));
    v += __builtin_bit_cast(float, __builtin_amdgcn_update_dpp(0, __builtin_bit_cast(int, v), 0x141, 0xF, 0xF, true));
    v += __builtin_bit_cast(float, __builtin_amdgcn_update_dpp(0, __builtin_bit_cast(int, v), 0x140, 0xF, 0xF, true));
    v += __shfl_xor(v, 16);
    float a_ = v, b_ = v; asm volatile("s_nop 1\n\tv_permlane32_swap_b32 %0, %1" : "+v"(a_), "+v"(b_)); return a_ + b_;
}
__constant__ float ROPE_INV[16] = {1.000000000e+00f, 5.623413324e-01f, 3.162277639e-01f, 1.778279394e-01f, 1.000000015e-01f, 5.623413250e-02f, 3.162277490e-02f, 1.778279431e-02f,
                                   9.999999776e-03f, 5.623413250e-03f, 3.162277630e-03f, 1.778279431e-03f, 1.000000047e-03f, 5.623413017e-04f, 3.162277571e-04f, 1.778279402e-04f};
__device__ __forceinline__ int rope_phys(int L) { return L < 16 ? 8 * (L >> 2) + (L & 3) : 8 * ((L - 16) >> 2) + 4 + ((L - 16) & 3); }

__device__ __forceinline__ void p0_item(const float* W, int K, int N, bf16* WT, const float* gain, int kind, MK_LAS float* scr, int item, int lane) {
    const int nblk = N / 32, kb = item / nblk, nb = item % nblk, k0 = 64 * kb, n0 = 32 * nb;
    int dbase = n0; bool perm = false; float mul = 1.0f;
    if (kind == 1) dbase = (n0 >> 7) * 256 + (n0 & 127);
    else if (kind == 2) dbase = (n0 >> 7) * 256 + 128 + (n0 & 127);
    else if (kind == 3) { if (n0 == 640) perm = true; else if (n0 >= 672) { dbase = n0 + 96; if (n0 < 1184) mul = C2M; } }
    else if (kind == 4) { perm = (n0 % 96) == 64; mul = C2Q; }
    else if (kind == 5) { const int h = n0 >> 7, e = n0 & 127; dbase = e < 64 ? h * 64 + e : 512 + h * 64 + (e - 64); }
    float wv[32];
#pragma unroll
    for (int i = 0; i < 32; ++i) wv[i] = __builtin_nontemporal_load(W + (size_t)(k0 + 2 * i + (lane >> 5)) * N + n0 + (lane & 31));
#pragma unroll
    for (int i = 0; i < 32; ++i) { const int kk = 2 * i + (lane >> 5); const float g = gain ? gain[k0 + kk] * mul : mul; scr[kk * 33 + (lane & 31)] = wv[i] * g; }
    asm volatile("s_waitcnt lgkmcnt(0)" ::: "memory");
    const int c = lane & 7;
#pragma unroll
    for (int j = 0; j < 4; ++j) { const int n = (lane >> 3) + 8 * j; const MK_LAS float* s = scr + (8 * c) * 33 + n;
        v4u o; o.x = pk2(s[0 * 33], s[1 * 33]); o.y = pk2(s[2 * 33], s[3 * 33]); o.z = pk2(s[4 * 33], s[5 * 33]); o.w = pk2(s[6 * 33], s[7 * 33]);
        const int drow = dbase + (perm ? rope_phys(n) : n);
        *(v4u*)(WT + (size_t)drow * K + k0 + 8 * c) = o; }
    asm volatile("s_waitcnt lgkmcnt(0)" ::: "memory");
}
constexpr int I_G = (DM / 64) * (DFF / 32), I_D = (DFF / 64) * (DM / 32), I_IN = (DM / 64) * (2208 / 32), I_UQ = (384 / 64) * (768 / 32), I_UKV = (256 / 64) * (1024 / 32), I_O = (DM / 64) * (DM / 32);
constexpr int NITEMS = 4 * I_G + 2 * I_D + I_IN + I_UQ + I_UKV + I_O;
__device__ __forceinline__ void p0_one_item(kargs_t ap, unsigned char* ws, MK_LAS float* scr, int it, int lane) {
    int r = it;
    if (r < I_G) { p0_item(ap->in[3], DM, DFF, (bf16*)(ws + WS_WGU1), ap->in[2], 1, scr, r, lane); return; } r -= I_G;
    if (r < I_G) { p0_item(ap->in[4], DM, DFF, (bf16*)(ws + WS_WGU1), ap->in[2], 2, scr, r, lane); return; } r -= I_G;
    if (r < I_D) { p0_item(ap->in[5], DFF, DM, (bf16*)(ws + WS_WD1), nullptr, 0, scr, r, lane); return; } r -= I_D;
    if (r < I_G) { p0_item(ap->in[14], DM, DFF, (bf16*)(ws + WS_WGU2), ap->in[13], 1, scr, r, lane); return; } r -= I_G;
    if (r < I_G) { p0_item(ap->in[15], DM, DFF, (bf16*)(ws + WS_WGU2), ap->in[13], 2, scr, r, lane); return; } r -= I_G;
    if (r < I_D) { p0_item(ap->in[16], DFF, DM, (bf16*)(ws + WS_WD2), nullptr, 0, scr, r, lane); return; } r -= I_D;
    if (r < I_IN) { p0_item(ap->in[7], DM, 2208, (bf16*)(ws + WS_WIN), ap->in[6], 3, scr, r, lane); return; } r -= I_IN;
    if (r < I_UQ) { p0_item(ap->in[9], 384, 768, (bf16*)(ws + WS_WUQ), ap->in[8], 4, scr, r, lane); return; } r -= I_UQ;
    if (r < I_UKV) { p0_item(ap->in[11], 256, 1024, (bf16*)(ws + WS_WUKV), ap->in[10], 5, scr, r, lane); return; } r -= I_UKV;
    p0_item(ap->in[12], DM, DM, (bf16*)(ws + WS_WOUT), nullptr, 0, scr, r, lane);
}
__device__ __forceinline__ void p0_tables_and_zero(kargs_t ap, const int gt, const int NGT) {
    unsigned char* ws = ap->ws;
    const int* pos = (const int*)ap->in[1]; float* posf = (float*)(ws + WS_POSF); float* cosT = (float*)(ws + WS_COS); float* sinT = (float*)(ws + WS_SIN);
    for (int e = gt; e < S * 16; e += NGT) { const int s_ = e >> 4, i = e & 15; const float ang = (float)pos[s_] * ROPE_INV[i]; float sn, cs; sincosf(ang, &sn, &cs); cosT[e] = cs; sinT[e] = sn; if (i == 0) posf[s_] = (float)pos[s_]; }
    for (int e = gt >> 6; e < S / 64; e += NGT >> 6) { int m_ = pos[64 * e + (gt & 63)];
#pragma unroll
        for (int o_ = 1; o_ < 64; o_ <<= 1) m_ = max(m_, __shfl_xor(m_, o_)); if ((gt & 63) == 0) posf[S + e] = (float)m_; }
    float* z = (float*)(ws + WS_SS2);
    for (int e = gt; e < 5 * S; e += NGT) z[e] = 0.f;
    float* km = (float*)(ws + WS_KMS);
    for (int e = gt; e < 64 * 512; e += NGT) km[e] = 0.f;
    unsigned* cnt = (unsigned*)(ws + WS_CNT);
    for (int e = gt; e < 512; e += NGT) cnt[e] = 0u;
    unsigned* padz = (unsigned*)((bf16*)(ws + WS_WIN) + (size_t)672 * DM);
    for (int e = gt; e < 96 * DM / 2; e += NGT) padz[e] = 0u;
}
__device__ __forceinline__ void p0_late_items(const Frame& F, kargs_t ap) {
    unsigned char* ws = ap->ws; MK_LAS float* scr = (MK_LAS float*)(F.lds + F.wave * 16384);
    const int w = ((int)blockIdx.x - 128) * NWAVES + F.wave, NW_ = 128 * NWAVES;
    constexpr int D2_LO = 4 * I_G + I_D, D2_HI = 4 * I_G + 2 * I_D, NL = NITEMS - 2 * I_G - I_D;
    for (int j = w; j < NL; j += NW_) { const int it = 2 * I_G + j; p0_one_item(ap, ws, scr, it < D2_LO ? it : it + I_D, F.lane); }
    p0_tables_and_zero(ap, w * 64 + F.lane, NW_ * 64);
}
__device__ __forceinline__ void p0_later_items(const Frame& F, kargs_t ap) {
    unsigned char* ws = ap->ws; MK_LAS float* scr = (MK_LAS float*)(F.lds + F.wave * 16384);
    const int w = ((int)blockIdx.x - 128) * NWAVES + F.wave, NW_ = 128 * NWAVES;
    for (int j = w; j < I_D; j += NW_) p0_one_item(ap, ws, scr, 4 * I_G + I_D + j, F.lane);
}
__device__ __forceinline__ void p0_prologue(const Frame& F, kargs_t ap) {
    unsigned char* ws = ap->ws;
    MK_LAS float* scr = (MK_LAS float*)(F.lds + F.wave * 16384);
    const int gw = F.vcu * NWAVES + F.wave, NGW = F.G * NWAVES;
    constexpr int N_EARLY = 2 * I_G;
    const int n_here = (F.G == 256) ? N_EARLY : NITEMS;
    const float* x = ap->in[0]; bf16* xb = (bf16*)(ws + WS_XB); float* ss1 = (float*)(ws + WS_SS1);
#define P0_LOADROWS(V_, M_) do { _Pragma("unroll") for (int r = 0; r < 4; ++r) { const int mr = (M_) + r * NGW; if (mr < S) { const f32x4* xr = (const f32x4*)(x + (size_t)mr * DM) + F.lane; \
        _Pragma("unroll") for (int j = 0; j < 4; ++j) V_[r][j] = __builtin_nontemporal_load(xr + 64 * j); } } } while (0)
#define P0_PUTROWS(V_, M_) do { _Pragma("unroll") for (int r = 0; r < 4; ++r) { const int mr = (M_) + r * NGW; if (mr < S) { unsigned long long* o8 = (unsigned long long*)(xb + (size_t)mr * DM) + F.lane; float s = 0.f; \
        _Pragma("unroll") for (int j = 0; j < 4; ++j) { const f32x4 w = V_[r][j]; s += (w[0] * w[0] + w[1] * w[1]) + (w[2] * w[2] + w[3] * w[3]); __builtin_nontemporal_store((unsigned long long)pk2(w[0], w[1]) | ((unsigned long long)pk2(w[2], w[3]) << 32), o8 + 64 * j); }     \
        s = wave_sum(s); if (F.lane == 0) ss1[mr] = s; } } } while (0)
    f32x4 va[4][4], vb[4][4]; const int mstep = 4 * NGW;
    P0_LOADROWS(va, gw); P0_LOADROWS(vb, gw + mstep);
    for (int it = gw; it < n_here; it += NGW) p0_one_item(ap, ws, scr, it, F.lane);
    P0_PUTROWS(va, gw); P0_PUTROWS(vb, gw + mstep);
    for (int m = gw + 2 * mstep; m < S; m += mstep) { P0_LOADROWS(va, m); P0_PUTROWS(va, m); }
#undef P0_LOADROWS
#undef P0_PUTROWS
    if (F.G != 256) p0_tables_and_zero(ap, (F.vcu * NWAVES + F.wave) * 64 + F.lane, NGW * 64);
}

__device__ __forceinline__ void p4_krope(const Frame& F, kargs_t ap) { unsigned char* const wsb = ap->ws;
    const bf16* cqkv = (const bf16*)(wsb + WS_CQKV); bf16* Kr = (bf16*)(wsb + WS_KR); const float* cosT = (const float*)(wsb + WS_COS); const float* sinT = (const float*)(wsb + WS_SIN);
    const int gt = (F.vcu * NWAVES + F.wave) * 64 + F.lane, NGT = F.G * NWAVES * 64;
    for (int e = gt; e < S * 16; e += NGT) { const int s_ = e >> 4, i = e & 15, g = i >> 2, j = i & 3;
        const float x1 = bf2f(cqkv[(size_t)s_ * 768 + 640 + 8 * g + j]), x2 = bf2f(cqkv[(size_t)s_ * 768 + 640 + 8 * g + 4 + j]); const float c = cosT[e], sn = sinT[e];
        Kr[(size_t)s_ * 32 + 8 * g + j] = (bf16)f2bf(x1 * c - x2 * sn); Kr[(size_t)s_ * 32 + 8 * g + 4 + j] = (bf16)f2bf(x1 * sn + x2 * c); }
}
__device__ __forceinline__ void p4_gating(const Frame& F, kargs_t ap) { unsigned char* const wsb = ap->ws;
    const bf16* mqkv = (const bf16*)(wsb + WS_MQKV); const float* kms = (const float*)(wsb + WS_KMS); unsigned* cnt = (unsigned*)(wsb + WS_CNT); unsigned* lists = (unsigned*)(wsb + WS_LIST);
    MK_LAS float* km = (MK_LAS float*)F.lds;
    const int u0 = (F.G == 256) ? ((int)blockIdx.x < 192 ? (int)blockIdx.x : 256) : F.vcu, ustep = (F.G == 256) ? 0 : F.G;
    const int b6 = (int)blockIdx.x, nit = (F.G == 256) ? (b6 < 128 ? 1 : (b6 < 192 ? 2 : 0)) : 0x7fffffff;
    for (int it = 0, uj = u0; it < nit && uj < 256; ++it, uj += ustep) {
        int u = uj;
        if (F.G == 256) { const int j = it == 0 ? b6 : 383 - b6; u = (31 - (j >> 3)) * 8 + (j & 7); }
        const int h = u & 7, q = (u >> 3) * 512 + F.tid, own = q >> 8;
        __syncthreads();
        for (int e = F.tid; e < 4096; e += 512) km[e] = kms[(size_t)(e >> 6) * 512 + h * 64 + (e & 63)] * (1.0f / 256.0f);
        __syncthreads();
        f32x2 qv[32];
        { const v4u* qp = (const v4u*)(mqkv + (size_t)q * 1536 + h * 64);
#pragma unroll
          for (int c = 0; c < 8; ++c) { const v4u w = qp[c];
#pragma unroll
              for (int j = 0; j < 4; ++j) qv[4 * c + j] = (f32x2){__builtin_bit_cast(float, w[j] << 16), __builtin_bit_cast(float, w[j] & 0xFFFF0000u)}; } }
        float g0 = -3e38f, g1 = -3e38f, g2 = -3e38f; int i0 = -1, i1 = -1, i2 = -1;
        const int own_max = __builtin_amdgcn_readfirstlane(own);
        for (int n = 0; n < own_max; ++n) {
            f32x2 gp = (f32x2){0.f, 0.f};
#pragma unroll
            for (int c = 0; c < 16; ++c) { const f32x4 kk = *(const MK_LAS f32x4*)(km + n * 64 + 4 * c);
                gp = __builtin_elementwise_fma(qv[2 * c], (f32x2){kk[0], kk[1]}, gp); gp = __builtin_elementwise_fma(qv[2 * c + 1], (f32x2){kk[2], kk[3]}, gp); }
            const float g = gp[0] + gp[1];
            if (g > g0) { g2 = g1; i2 = i1; g1 = g0; i1 = i0; g0 = g; i0 = n; }
            else if (g > g1) { g2 = g1; i2 = i1; g1 = g; i1 = n; }
            else if (g > g2) { g2 = g; i2 = n; }
        }
        MK_LAS unsigned* lcnt = (MK_LAS unsigned*)(F.lds + 16384);
        __syncthreads();
        if (F.tid < 64) lcnt[F.tid] = 0u;
        __syncthreads();
        unsigned r0 = 0u, r1 = 0u, r2 = 0u;
        if (i0 >= 0) r0 = __hip_atomic_fetch_add(lcnt + i0, 1u, __ATOMIC_RELAXED, __HIP_MEMORY_SCOPE_WORKGROUP);
        if (i1 >= 0) r1 = __hip_atomic_fetch_add(lcnt + i1, 1u, __ATOMIC_RELAXED, __HIP_MEMORY_SCOPE_WORKGROUP);
        if (i2 >= 0) r2 = __hip_atomic_fetch_add(lcnt + i2, 1u, __ATOMIC_RELAXED, __HIP_MEMORY_SCOPE_WORKGROUP);
        __syncthreads();
        if (F.tid < 64) { const unsigned c = lcnt[F.tid]; lcnt[64 + F.tid] = c ? atomicAdd(cnt + h * 64 + F.tid, c) : 0u; }
        __syncthreads();
        if (i0 >= 0) lists[(size_t)(h * 64 + i0) * S + lcnt[64 + i0] + r0] = (unsigned)(q | (0 << 14));
        if (i1 >= 0) lists[(size_t)(h * 64 + i1) * S + lcnt[64 + i1] + r1] = (unsigned)(q | (1 << 14));
        if (i2 >= 0) lists[(size_t)(h * 64 + i2) * S + lcnt[64 + i2] + r2] = (unsigned)(q | (2 << 14));
    }
    __syncthreads();
}
__device__ __forceinline__ void p5_combine(const Frame& F, kargs_t ap) { unsigned char* const wsb = ap->ws;
    const bf16* part = (const bf16*)ap->out;     const float* plse = (const float*)(wsb + WS_PLSE); bf16* cat = (bf16*)(wsb + WS_CAT);
    const int gt = (F.vcu * NWAVES + F.wave) * 64 + F.lane, NGT = F.G * NWAVES * 64;
    for (int e0 = gt; e0 < S * 8 * 8; e0 += 4 * NGT) {
        f32x4 ls[4]; v4u pv[4][4];
#pragma unroll
        for (int u = 0; u < 4; ++u) { const int e = e0 + u * NGT; if (e < S * 8 * 8) { const int dg = e & 7, qh = e >> 3, q = qh >> 3; const int ns = 1 + min(3, q >> 8);
            ls[u] = __builtin_nontemporal_load((const f32x4*)(plse + (size_t)qh * 4));
#pragma unroll
            for (int s = 0; s < 4; ++s) if (s < ns) pv[u][s] = __builtin_nontemporal_load((const v4u*)(part + ((size_t)qh * 4 + s) * 64 + dg * 8)); } }
#pragma unroll
        for (int u = 0; u < 4; ++u) { const int e = e0 + u * NGT; if (e < S * 8 * 8) { const int dg = e & 7, qh = e >> 3, q = qh >> 3, h = qh & 7; const int ns = 1 + min(3, q >> 8);
            float M = ls[u][0];
#pragma unroll
            for (int s = 1; s < 4; ++s) if (s < ns) M = fmaxf(M, ls[u][s]);
            float acc[8], wsum = 0.f;
#pragma unroll
            for (int j = 0; j < 8; ++j) acc[j] = 0.f;
#pragma unroll
            for (int s = 0; s < 4; ++s) if (s < ns) { const float w = __builtin_amdgcn_exp2f(ls[u][s] - M); wsum += w; const v4u v = pv[u][s];
#pragma unroll
                for (int j = 0; j < 4; ++j) { acc[2 * j] += w * __builtin_bit_cast(float, v[j] << 16); acc[2 * j + 1] += w * __builtin_bit_cast(float, v[j] & 0xFFFF0000u); } }
            const float r = 1.0f / wsum; v4u o; o.x = pk2(acc[0] * r, acc[1] * r); o.y = pk2(acc[2] * r, acc[3] * r); o.z = pk2(acc[4] * r, acc[5] * r); o.w = pk2(acc[6] * r, acc[7] * r);
            *(v4u*)(cat + (size_t)q * 1024 + 512 + h * 64 + dg * 8) = o; } }
    }
}
__device__ __forceinline__ void p9_final(const Frame& F, kargs_t ap) { unsigned char* const wsb = ap->ws;
    const float* ss = (const float*)(wsb + WS_SS4); const float* g = ap->in[17];
    const int gw = F.vcu * NWAVES + F.wave, NGW = F.G * NWAVES;
    float tsc = 1.0f;
#ifdef MK_TS
    { const unsigned long long* ts = (const unsigned long long*)(wsb + 2048); tsc = 1.0f + (float)(ts[MK_TS + 1] - ts[MK_TS]) * (float)MK_TS_SCALE; }
#endif
    for (int m = gw; m < S; m += NGW) { const float rs = tsc / sqrtf(ss[m] * (1.0f / 1024.0f) + 1e-6f); f32x4* xr = (f32x4*)(ap->out + (size_t)m * DM) + F.lane; const f32x4* gr = (const f32x4*)g + F.lane;
#pragma unroll
        for (int j = 0; j < 4; ++j) { const f32x4 v = xr[64 * j]; xr[64 * j] = v * rs * gr[64 * j]; } }
}

__global__ void __launch_bounds__(NWAVES * 64, 2) mk_fwd(Args a_unused) {
    extern __shared__ __attribute__((aligned(16))) unsigned char lds[];
    const int wave = __builtin_amdgcn_readfirstlane(threadIdx.x >> 6);
    MK_LAS unsigned char* const ldsp = (MK_LAS unsigned char*)lds;
    int lo, hi; { kargs_t ap = kargs(); lo = ap->ph_lo; hi = ap->ph_hi; }
#ifndef MK_ONLY
#define MK_ONLY -1
#endif
#define IN(k) ((MK_ONLY < 0 || MK_ONLY == (k)) && lo <= (k) && (k) < hi)
    const bool multi = (hi - lo) > 1;
    if (multi) {
        const int l0 = pg8::lane_id_v();
        if (wave == 0 && l0 < 2) ((volatile MK_LAS unsigned*)(ldsp + LDS_MISC))[l0] = 0u;
        __syncthreads();
        kargs_t ap = kargs(); (void)xb::xcd_barrier_post((unsigned*)(ap->ws + WS_BAR), (volatile MK_LAS unsigned*)(ldsp + LDS_MISC), wave == 0 && l0 == 0);
    }
    if (lo < -1) cg::this_grid().sync();
#ifdef MK_TS
#define MK_STAMP(i) do { if (blockIdx.x == 0 && wave == 0 && pg8::lane_id_v() == 0) { kargs_t ap__ = kargs(); ((unsigned long long*)(ap__->ws + 2048))[(i)] = __builtin_amdgcn_s_memrealtime(); } } while (0)
#else
#define MK_STAMP(i) do { } while (0)
#endif
    MK_STAMP(0);
#ifdef MK_PROBEB
#define MK_SEAM2(b_) xb::xcd_barrier(b_, wave == 0 && pg8::lane_id_v() == 0)
#else
#define MK_SEAM2(b_) do { } while (0)
#endif
#define SEAM(k) do { if (IN(k) && IN((k) + 1)) { kargs_t ap_ = kargs(); xb::XcdBarrier b_; b_.bar = (unsigned*)(ap_->ws + WS_BAR); b_.x = xb::xb_xcc_id(); b_.st = (volatile MK_LAS unsigned*)(ldsp + LDS_MISC); \
        xb::xcd_barrier(b_, wave == 0 && pg8::lane_id_v() == 0); MK_SEAM2(b_); MK_STAMP((k) + 1); } } while (0)
    if (IN(0)) { kargs_t ap = kargs(); const Frame F = mkframe(ldsp, wave);
#ifdef MK_PROBE0
        { int n0_; asm volatile("s_mov_b32 %0, 1" : "=s"(n0_)); for (int r0_ = 0; r0_ < n0_; ++r0_) { p0_prologue(F, ap); __syncthreads(); } }
#endif
        p0_prologue(F, ap); } SEAM(0);
    if (IN(1)) { kargs_t ap = kargs(); unsigned char* ws = ap->ws; pg8::Gemm g{(const bf16*)(ws + WS_XB), (const bf16*)(ws + WS_WGU1), S, NGU, DM, DM}; pg8::StaticOrder So; So.init(S, NGU, (int)gridDim.x, (int)blockIdx.x);
        pg8::EpiSwiGLU E{ws, 0}; pg8::gemm_phase<pg8::EpiSwiGLU, pg8::StaticOrder, true, true>(ldsp, g, So, E, wave);
        if (gridDim.x == 256 && blockIdx.x >= 128) { kargs_t ap2 = kargs(); const Frame F = mkframe(ldsp, wave); __syncthreads(); p0_late_items(F, ap2);
#ifdef MK_PROBE1
            __syncthreads(); p0_late_items(F, ap2);
#endif
        } } SEAM(1);
    if (IN(2)) { kargs_t ap = kargs(); unsigned char* ws = ap->ws; pg8::Gemm g{(const bf16*)(ws + WS_ACT), (const bf16*)(ws + WS_WD1), S, DM, DFF, DFF}; pg8::StaticOrder So; So.init(S, DM, (int)gridDim.x, (int)blockIdx.x);
        pg8::EpiResid E{nullptr, ws, (int)WS_SS2, 0.5f}; pg8::gemm_phase<pg8::EpiResid, pg8::StaticOrder, true, true>(ldsp, g, So, E, wave); } SEAM(2);
    if (IN(3)) { kargs_t ap = kargs(); unsigned char* ws = ap->ws; pg8::Gemm g{(const bf16*)(ws + WS_XB), (const bf16*)(ws + WS_WIN), S, NWIN, DM, DM}; pg8::StaticOrder So; So.init(S, gridDim.x == 256 ? NWIN - 256 : NWIN, (int)gridDim.x, (int)blockIdx.x);
        pg8::EpiWin E{ws, 0}; pg8::gemm_phase<pg8::EpiWin, pg8::StaticOrder, true, true>(ldsp, g, So, E, wave); } SEAM(3);
    if (IN(4)) {
#ifdef MK_PROBE4
      int n4_; asm volatile("s_mov_b32 %0, 2" : "=s"(n4_));
      for (int r4_ = 0; r4_ < n4_; ++r4_) {
#endif
        { kargs_t ap = kargs(); unsigned char* ws = ap->ws; pg8::Gemm g{(const bf16*)(ws + WS_CQKV) + 384, (const bf16*)(ws + WS_WUKV), S, 1024, 256, 768}; pg8::StaticOrder So; So.init(S, 1024, (int)gridDim.x, (int)blockIdx.x);
          pg8::EpiKV E{ws}; pg8::gemm_phase<pg8::EpiKV, pg8::StaticOrder, true, true>(ldsp, g, So, E, wave); }
        { kargs_t ap = kargs(); unsigned char* ws = ap->ws; pg8::Gemm g{(const bf16*)(ws + WS_CQKV), (const bf16*)(ws + WS_WUQ), S, 768, 384, 768}; pg8::StaticOrder So; So.init(S, 768, (int)gridDim.x, (int)blockIdx.x);
          pg8::EpiQ E{ws}; pg8::gemm_phase<pg8::EpiQ, pg8::StaticOrder, true, true>(ldsp, g, So, E, wave); }
        if (gridDim.x == 256) { kargs_t ap = kargs(); unsigned char* ws = ap->ws; pg8::Gemm g{(const bf16*)(ws + WS_XB), (const bf16*)(ws + WS_WIN), S, NWIN, DM, DM}; pg8::TailOrder So; So.init(S, 8, (int)gridDim.x, (int)blockIdx.x);
          pg8::EpiWin E{ws, 0}; pg8::gemm_phase<pg8::EpiWin, pg8::TailOrder, true, true>(ldsp, g, So, E, wave); }
#if defined(MK_PROBE4) && MK_PROBE4 == 1
      __syncthreads(); }
#endif
        { kargs_t ap = kargs(); const Frame F = mkframe(ldsp, wave); p4_krope(F, ap); }
#if defined(MK_PROBE4) && MK_PROBE4 == 2
      __syncthreads(); }
#endif
#ifndef MK_NO_GATE
        { kargs_t ap = kargs(); const Frame F = mkframe(ldsp, wave); p4_gating(F, ap); }
#endif
    } SEAM(4);
#ifndef MK_NO_ATT5
    if (IN(5)) {
        kargs_t ap = kargs(); unsigned char* ws = ap->ws; const Frame F = mkframe(ldsp, wave);
        MK_LAS int* pre = (MK_LAS int*)(ldsp + att::MB_PRE);
        const unsigned* cnt = (const unsigned*)(ws + WS_CNT);
        __syncthreads();
        { const int c = (int)cnt[F.tid]; int v = (c + 255) >> 8;
#pragma unroll
          for (int o = 1; o < 64; o <<= 1) { const int t = __shfl_up(v, o); if (F.lane >= o) v += t; }
          pre[F.tid] = v; __syncthreads();
          int add = 0; for (int w = 0; w < F.wave; ++w) add += pre[64 * w + 63];
          __syncthreads(); pre[F.tid] = v + add; }
        __syncthreads();
        att::MobaCtx C; C.mqkv = (const bf16*)(ws + WS_MQKV); C.posf = (const float*)(ws + WS_POSF); C.part = (bf16*)ap->out; C.plse = (float*)(ws + WS_PLSE);
        C.lists = (const unsigned*)(ws + WS_LIST); C.cnt = cnt; C.total = pre[511]; C.vcu = F.vcu; C.G = F.G;
#ifdef MK_PROBE5
        { bf16* rp_ = C.part; float* rl_ = C.plse; C.part = (bf16*)(ws + WS_CQKV); C.plse = (float*)(ws + WS_CQKV + (16u << 20)); att::moba_run<MK_PROBE5>(C, (char*)lds, wave); __syncthreads(); C.part = rp_; C.plse = rl_; }
#endif
        att::moba_run<0>(C, (char*)lds, wave);
    }
#endif
    if (IN(5) && IN(6)) {
        asm volatile("s_waitcnt vmcnt(0)" ::: "memory"); __syncthreads();
        if (wave == 0 && pg8::lane_id_v() == 0) { kargs_t ap_ = kargs(); unsigned* bar_ = (unsigned*)(ap_->ws + WS_BAR);
            volatile MK_LAS unsigned* st_ = (volatile MK_LAS unsigned*)(ldsp + LDS_MISC); unsigned nloc_ = st_[0];
            if (nloc_ == 0u) { unsigned nx0_; xb::xcd_barrier_complete(bar_, xb::xb_xcc_id(), nloc_, nx0_); st_[0] = nloc_; st_[1] = nx0_; }
            const unsigned old_ = xb::xb_add(&bar_[XB_SPLX(xb::xb_xcc_id())], 1u);
            if (old_ + 1u == nloc_) {
                __builtin_amdgcn_fence(__ATOMIC_RELEASE, "agent"); asm volatile("s_waitcnt vmcnt(0)" ::: "memory");
                asm volatile("buffer_inv sc1\n\ts_waitcnt vmcnt(0)" ::: "memory");
                (void)xb::xb_add(&bar_[XB_SPLIT], 1u); }
            else asm volatile("buffer_inv sc1" ::: "memory"); }
    }
    if (IN(6)) {
#ifdef MK_PROBEC
        { int nc_; asm volatile("s_mov_b32 %0, 1" : "=s"(nc_)); for (int rc_ = 0; rc_ < nc_; ++rc_) { kargs_t ap = kargs(); const Frame F = mkframe(ldsp, wave); p5_combine(F, ap); __syncthreads(); } }
#endif
        bool comb_done_ = false;
#define MK_WAIT_COMBINE() do { \
        if (IN(5)) { \
            if (wave == 0 && pg8::lane_id_v() == 0) { kargs_t ap_ = kargs(); unsigned* bar_ = (unsigned*)(ap_->ws + WS_BAR); \
                const unsigned nx_ = ((volatile MK_LAS unsigned*)(ldsp + LDS_MISC))[1];                        \
                using xb::xb_ld; XB_SPIN(xb_ld(&bar_[XB_SPLIT]) != nx_, bar_); \
                asm volatile("s_waitcnt vmcnt(0)" ::: "memory"); } \
            __syncthreads(); \
        } \
        { kargs_t apc_ = kargs(); const Frame Fc_ = mkframe(ldsp, wave); p5_combine(Fc_, apc_); } \
        __syncthreads(); } while (0)
#ifndef MK_NO_ATT6
        kargs_t ap = kargs(); unsigned char* ws = ap->ws; const Frame F = mkframe(ldsp, wave);
        att::Unit U; U.posf = nullptr; U.part = nullptr; U.plse = nullptr; U.list = nullptr; U.len = 0; U.slope2 = 0.f; U.q_pitch = 768; U.k_pitch = 512; U.v_pitch = 512; U.o_pitch = 1024; U.key0 = 0; U.Kr = (const bf16*)(ws + WS_KR);
        int vstep6 = F.G;
#ifdef MK_PROBE6
        asm volatile("s_mov_b32 %0, 0" : "=s"(vstep6));
        int npass6 = 0;
#endif
        for (int v = F.vcu; v < 256; v += vstep6) { const int h = v >> 5, s_ = v & 31;
#ifdef MK_PROBE6
            if (npass6++ >= MK_PROBE6) break;
            U.len = (npass6 == 1) ? 1 : 0;
#endif
            for (int i = 0; i < 2; ++i) { const int qb = i == 0 ? 63 - s_ : s_;
                U.h = h; U.Q = (const bf16*)(ws + WS_Q) + h * 96; U.K = (const bf16*)(ws + WS_KN) + h * 64; U.V = (const bf16*)(ws + WS_V) + h * 64; U.O = (bf16*)(ws + WS_CAT) + h * 64; U.q0 = qb * 256; U.ntiles = 4 * (qb + 1);
                att::unit<0>(U, (char*)lds, wave);
                if (!comb_done_) { comb_done_ = true; MK_WAIT_COMBINE(); } } }
#endif
        if (!comb_done_) { comb_done_ = true; MK_WAIT_COMBINE(); }
#undef MK_WAIT_COMBINE
    } SEAM(6);
    if (IN(7)) { kargs_t ap = kargs(); unsigned char* ws = ap->ws; pg8::Gemm g{(const bf16*)(ws + WS_CAT), (const bf16*)(ws + WS_WOUT), S, DM, DM, DM}; pg8::StaticOrder So; So.init(S, DM, (int)gridDim.x, (int)blockIdx.x);
        pg8::EpiResid E{nullptr, ws, (int)WS_SS3, 1.0f}; pg8::gemm_phase<pg8::EpiResid, pg8::StaticOrder, true, true>(ldsp, g, So, E, wave); } SEAM(7);
    if (IN(8)) { kargs_t ap = kargs(); unsigned char* ws = ap->ws; pg8::Gemm g{(const bf16*)(ws + WS_XB), (const bf16*)(ws + WS_WGU2), S, NGU, DM, DM}; pg8::StaticOrder So; So.init(S, NGU, (int)gridDim.x, (int)blockIdx.x);
        pg8::EpiSwiGLU E{ws, 1};
#ifdef MK_PROBE8
        { int n8_; asm volatile("s_mov_b32 %0, 1" : "=s"(n8_)); for (int r8_ = 0; r8_ < n8_; ++r8_) { pg8::gemm_phase<pg8::EpiSwiGLU, pg8::StaticOrder, true, true>(ldsp, g, So, E, wave); __syncthreads(); } }
#endif
        pg8::gemm_phase<pg8::EpiSwiGLU, pg8::StaticOrder, true, true>(ldsp, g, So, E, wave);
        if (gridDim.x == 256 && blockIdx.x >= 128) { kargs_t ap2 = kargs(); const Frame F = mkframe(ldsp, wave); __syncthreads(); p0_later_items(F, ap2); } } SEAM(8);
    if (IN(9)) { kargs_t ap = kargs(); unsigned char* ws = ap->ws; pg8::Gemm g{(const bf16*)(ws + WS_ACT), (const bf16*)(ws + WS_WD2), S, DM, DFF, DFF}; pg8::StaticOrder So; So.init(S, DM, (int)gridDim.x, (int)blockIdx.x);
        if (gridDim.x == 256) { pg8::EpiResidNorm E{ap->out, ws, ap->in[17], 0.5f}; pg8::gemm_phase<pg8::EpiResidNorm, pg8::StaticOrder, false, true>(ldsp, g, So, E, wave); }
        else { pg8::EpiResid E{ap->out, ws, (int)WS_SS4, 0.5f}; pg8::gemm_phase<pg8::EpiResid, pg8::StaticOrder, true, true>(ldsp, g, So, E, wave); } }
    if (gridDim.x != 256) SEAM(9);
#ifdef MK_PROBE7
    if (IN(9)) { SEAM(9); kargs_t ap = kargs(); unsigned char* ws = ap->ws; pg8::Gemm g{(const bf16*)(ws + WS_CAT), (const bf16*)(ws + WS_WOUT), S, DM, DM, DM}; pg8::StaticOrder So; So.init(S, DM, (int)gridDim.x, (int)blockIdx.x);
        pg8::EpiResid E{nullptr, ws, (int)WS_SS3, 1.0f}; pg8::gemm_phase<pg8::EpiResid, pg8::StaticOrder, true, true>(ldsp, g, So, E, wave); }
#endif
#ifdef MK_PROBE9
    if (IN(9)) { SEAM(9); kargs_t ap = kargs(); unsigned char* ws = ap->ws; pg8::Gemm g{(const bf16*)(ws + WS_ACT), (const bf16*)(ws + WS_WD2), S, DM, DFF, DFF}; pg8::StaticOrder So; So.init(S, DM, (int)gridDim.x, (int)blockIdx.x);
        pg8::EpiSwiGLU E{ws, 1}; pg8::gemm_phase<pg8::EpiSwiGLU, pg8::StaticOrder, true, true, MK_PROBE9 - 1>(ldsp, g, So, E, wave); }
#endif
    if (IN(10) && gridDim.x != 256) { kargs_t ap = kargs(); const Frame F = mkframe(ldsp, wave); p9_final(F, ap); }
#undef IN
#undef SEAM
}
constexpr int N_PHASES = 11;
}
#ifndef MK_BRINGUP
#define MK_BRINGUP 0
#endif
extern "C" void kernel_launch(void* const* d_in, const int* in_sizes, int n_in, void* d_out, int out_size, void* d_ws, size_t ws_size, hipStream_t stream) {
    static int grid = 0;
    if (grid == 0) {
        if (hipFuncSetAttribute((const void*)mk::mk_fwd, hipFuncAttributeMaxDynamicSharedMemorySize, mk::LDS_BYTES) != hipSuccess) { fprintf(stderr, "kernel_launch: hipFuncSetAttribute failed\n"); grid = -1; return; }
        int dev = 0, cus = 0, per_cu = 0;
        hipGetDevice(&dev); hipDeviceGetAttribute(&cus, hipDeviceAttributeMultiprocessorCount, dev);
        hipOccupancyMaxActiveBlocksPerMultiprocessor(&per_cu, (const void*)mk::mk_fwd, mk::NWAVES * 64, mk::LDS_BYTES);
        (void)hipGetLastError();
        grid = cus * (per_cu < 1 ? 1 : (per_cu > 1 ? 1 : per_cu));
        if (grid % 8 != 0 || grid <= 0) grid = 256;
        if (ws_size < mk::WS_END) { fprintf(stderr, "kernel_launch: workspace too small (%zu)\n", ws_size); grid = -1; return; }
    }
    if (grid < 0) return;
    mk::Args a{};
    for (int i = 0; i < 18; ++i) a.in[i] = (const float*)d_in[i];
    a.out = (float*)d_out; a.ws = (unsigned char*)d_ws;
#if MK_BRINGUP == 0
    if (hipMemsetAsync((char*)d_ws + mk::WS_BAR, 0, mk::BAR_BYTES, stream) != hipSuccess) { fprintf(stderr, "kernel_launch: memset failed\n"); return; }
    a.ph_lo = 0; a.ph_hi = mk::N_PHASES;
    void* args[] = {&a};
    hipError_t e = hipLaunchCooperativeKernel((const void*)mk::mk_fwd, dim3(grid), dim3(mk::NWAVES * 64), args, mk::LDS_BYTES, stream);
    if (e != hipSuccess) fprintf(stderr, "cooperative launch failed: %s (grid %d)\n", hipGetErrorString(e), grid);
#else
    const int nph = MK_BRINGUP == 1 ? 3 : MK_BRINGUP == 2 ? 8 : mk::N_PHASES;
    for (int ph = 0; ph < nph; ++ph) { a.ph_lo = ph; a.ph_hi = ph + 1; hipLaunchKernelGGL(mk::mk_fwd, dim3(grid), dim3(mk::NWAVES * 64), mk::LDS_BYTES, stream, a); }
#if MK_BRINGUP == 1
    nv::part_mix(d_in, (float*)d_out, d_ws, stream); nv::part_ffn2_final(d_in, (float*)d_out, d_ws, stream);
#elif MK_BRINGUP == 2
    nv::part_ffn2_final(d_in, (float*)d_out, d_ws, stream);
#endif
#endif
}
```
